# Optimizing an MI355X kernel written in HIP

```python
import math
import jax, jax.numpy as jnp
from jax import lax
import numpy as np

D_MODEL = 1024
BATCH = 4
SEQ = 4096
DEPTH = 4

N_META = 16
RWKV_HEAD_DIM = 64
RWKV_WIDTH = D_MODEL // 4
RWKV_HEADS = RWKV_WIDTH // RWKV_HEAD_DIM
DECAY_LORA = 32
AAA_LORA = 32
GATE_LORA = 64
DIFF_QK_DIM = 64
DIFF_V_DIM = 2 * DIFF_QK_DIM
DIFF_WIDTH = D_MODEL // 2
DIFF_HEADS = DIFF_WIDTH // DIFF_V_DIM
CONV_WIDTH = D_MODEL - RWKV_WIDTH - DIFF_WIDTH
CONV_K = 3
ROPE_THETA = 500000.0
ROPE_DIM = DIFF_QK_DIM // 4
Q_BLOCK = 128
D_FF = 2816
N_EXPERTS = 8
TOP_K = 2
MOE_BLOCK = 256
N_DENSE = (DEPTH + 1) // 2
N_MOE = DEPTH // 2
NORM_EPS = 1e-6
RWKV_GN_EPS = 64e-5
SUBLN_EPS = 1e-5
NEG_INF = -1e30

RWKV_COLS = 3 * RWKV_WIDTH + DECAY_LORA + AAA_LORA + GATE_LORA
DIFF_COLS = 2 * DIFF_HEADS * 2 * DIFF_QK_DIM + DIFF_HEADS * DIFF_V_DIM
CONV_COLS = 3 * CONV_WIDTH
IN_COLS = RWKV_COLS + DIFF_COLS + CONV_COLS

kernel_name = "hymba_rwkv7_diffattn_shortconv_moe"


def rms_norm(t, g, eps):
    tf = t.astype(jnp.float32)
    tf = tf * lax.rsqrt(jnp.mean(tf * tf, axis=-1, keepdims=True) + eps)
    return (tf * g.astype(jnp.float32)).astype(t.dtype)


def swiglu(t, w_gate, w_up, w_down):
    return (jax.nn.silu(t @ w_gate) * (t @ w_up)) @ w_down


def rope_tables(length):
    inv_freq = ROPE_THETA ** (-jnp.arange(0, ROPE_DIM, 2, dtype=jnp.float32) / ROPE_DIM)
    ang = jnp.arange(length, dtype=jnp.float32)[:, None] * inv_freq[None, :]
    return jnp.cos(ang), jnp.sin(ang)


def apply_partial_rope(t, cos, sin):
    half = ROPE_DIM // 2
    c = cos[None, :, None, None, :].astype(t.dtype)
    s = sin[None, :, None, None, :].astype(t.dtype)
    t1, t2 = t[..., :half], t[..., half:ROPE_DIM]
    return jnp.concatenate([t1 * c - t2 * s, t2 * c + t1 * s, t[..., ROPE_DIM:]], axis=-1)


def rwkv7_time_mix(hx, mu, w0, w_decay_up, a0, w_a_up, w_g_up, k_k, k_a, r_k, gn_g, gn_b):
    b, l, _ = hx.shape
    H, N = RWKV_HEADS, RWKV_HEAD_DIM
    prev = jnp.pad(hx, ((0, 0), (1, 0), (0, 0)))[:, :-1]
    hx = hx + (prev - hx) * mu
    s1 = RWKV_WIDTH
    r, k, v, hw, ha, hg = jnp.split(
        hx, [s1, 2 * s1, 3 * s1, 3 * s1 + DECAY_LORA, 3 * s1 + DECAY_LORA + AAA_LORA], axis=-1)
    w = -jax.nn.softplus(-(w0 + jnp.tanh(hw) @ w_decay_up)) - 0.5
    decay = jnp.exp(-jnp.exp(w.astype(jnp.float32)))
    a = jax.nn.sigmoid(a0 + ha @ w_a_up)
    g = jax.nn.sigmoid(hg) @ w_g_up
    heads = lambda t: t.reshape(b, l, H, N)
    kk = heads(k * k_k).astype(jnp.float32)
    kk = kk / jnp.maximum(jnp.sqrt(jnp.sum(kk * kk, axis=-1, keepdims=True)), 1e-12)
    k = k * (1.0 + (a - 1.0) * k_a)
    r_h, k_h, v_h = heads(r), heads(k), heads(v)
    a_h = heads(a).astype(jnp.float32)
    tm = lambda t: jnp.swapaxes(t.astype(jnp.float32), 0, 1)
    xs = (tm(r_h), tm(heads(decay)), tm(k_h), tm(v_h), tm(-kk), tm(kk * a_h))

    def step(S, inp):
        r_t, w_t, k_t, v_t, a_t, b_t = inp
        sa = jnp.einsum('bhvk,bhk->bhv', S, a_t)
        S = S * w_t[:, :, None, :] + sa[..., None] * b_t[:, :, None, :] + v_t[..., None] * k_t[:, :, None, :]
        return S, jnp.einsum('bhvk,bhk->bhv', S, r_t)

    S0 = jnp.zeros((b, H, N, N), jnp.float32)
    _, y = lax.scan(step, S0, xs)
    y = jnp.swapaxes(y, 0, 1)
    mean = jnp.mean(y, axis=-1, keepdims=True)
    var = jnp.mean(jnp.square(y - mean), axis=-1, keepdims=True)
    y = ((y - mean) * lax.rsqrt(var + RWKV_GN_EPS)).reshape(b, l, RWKV_WIDTH)
    y = (y * gn_g.astype(jnp.float32) + gn_b.astype(jnp.float32)).astype(hx.dtype)
    bonus = jnp.sum(r_h * k_h * r_k, axis=-1, keepdims=True) * v_h
    return (y + bonus.reshape(b, l, RWKV_WIDTH)) * g


def diff_attention(hx, cos, sin, q_norm_g, k_norm_g, lq1, lk1, lq2, lk2, subln_g, lam_init):
    b, l, _ = hx.shape
    H, dk, dv = DIFF_HEADS, DIFF_QK_DIM, DIFF_V_DIM
    qw = H * 2 * dk
    q, k, v = jnp.split(hx, [qw, 2 * qw], axis=-1)
    q = q.reshape(b, l, H, 2, dk)
    k = k.reshape(b, l, H, 2, dk)
    v = v.reshape(b, l, H, dv)
    q = apply_partial_rope(rms_norm(q, q_norm_g, NORM_EPS), cos, sin) * (dk ** -0.5)
    k = apply_partial_rope(rms_norm(k, k_norm_g, NORM_EPS), cos, sin)
    lam = (jnp.exp(jnp.sum(lq1.astype(jnp.float32) * lk1.astype(jnp.float32)))
           - jnp.exp(jnp.sum(lq2.astype(jnp.float32) * lk2.astype(jnp.float32))) + lam_init)
    pad = (-l) % Q_BLOCK
    lp = l + pad
    nb = lp // Q_BLOCK
    qp = jnp.pad(q, ((0, 0), (pad, 0), (0, 0), (0, 0), (0, 0)))
    kp = jnp.pad(k, ((0, 0), (pad, 0), (0, 0), (0, 0), (0, 0)))
    vp = jnp.pad(v, ((0, 0), (pad, 0), (0, 0), (0, 0)))
    qb = jnp.moveaxis(qp.reshape(b, nb, Q_BLOCK, H, 2, dk), 1, 0)
    kpos = jnp.arange(lp)

    def one_block(args):
        qi, i = args
        s = jnp.einsum('bqhcd,bkhcd->bhcqk', qi, kp).astype(jnp.float32)
        qpos = i * Q_BLOCK + jnp.arange(Q_BLOCK)
        mask = (kpos[None, :] <= qpos[:, None]) & (kpos[None, :] >= pad)
        p = jax.nn.softmax(jnp.where(mask, s, NEG_INF), axis=-1)
        pd = p[:, :, 0] - lam * p[:, :, 1]
        return jnp.einsum('bhqk,bkhe->bqhe', pd.astype(vp.dtype), vp)

    o = lax.map(one_block, (qb, jnp.arange(nb)))
    o = jnp.moveaxis(o, 0, 1).reshape(b, lp, H, dv)[:, pad:]
    o = rms_norm(o, subln_g, SUBLN_EPS) * (1.0 - lam_init)
    return o.reshape(b, l, DIFF_WIDTH)


def short_conv(hx, conv_w):
    l = hx.shape[1]
    bg, cg, u = jnp.split(hx, [CONV_WIDTH, 2 * CONV_WIDTH], axis=-1)
    z = jnp.pad(cg * u, ((0, 0), (CONV_K - 1, 0), (0, 0)))
    y = sum(conv_w[j] * z[:, j:j + l] for j in range(CONV_K))
    return bg * y


def moe_swiglu(xt, router_w, w_gate, w_up, w_down):
    T, D = xt.shape
    logits = (xt @ router_w).astype(jnp.float32)
    top_logit, top_idx = lax.top_k(logits, TOP_K)
    gates = jax.nn.softmax(top_logit, axis=-1).astype(xt.dtype)
    TK = T * TOP_K
    flat_e = top_idx.reshape(TK).astype(jnp.int32)
    flat_tok = jnp.repeat(jnp.arange(T, dtype=jnp.int32), TOP_K)
    flat_g = gates.reshape(TK)
    order = jnp.argsort(flat_e * TK + jnp.arange(TK, dtype=jnp.int32))
    se, stok, sg = flat_e[order], flat_tok[order], flat_g[order]
    counts = jnp.bincount(flat_e, length=N_EXPERTS)
    padded = (counts + MOE_BLOCK - 1) // MOE_BLOCK * MOE_BLOCK
    start = jnp.cumsum(counts) - counts
    pend = jnp.cumsum(padded)
    pstart = pend - padded
    dest = pstart[se] + jnp.arange(TK, dtype=jnp.int32) - start[se]
    NB = -(-TK // MOE_BLOCK) + N_EXPERTS
    P = NB * MOE_BLOCK
    row_tok = jnp.full((P,), T, jnp.int32).at[dest].set(stok)
    row_gate = jnp.zeros((P,), xt.dtype).at[dest].set(sg)
    block_expert = jnp.minimum(
        jnp.searchsorted(pend, jnp.arange(NB, dtype=pend.dtype) * MOE_BLOCK, side='right'), N_EXPERTS - 1)
    x_rows = jnp.concatenate([xt, jnp.zeros((1, D), xt.dtype)], axis=0)[row_tok].reshape(NB, MOE_BLOCK, D)

    def expert_block(args):
        xb, e = args
        return swiglu(xb, w_gate[e], w_up[e], w_down[e])

    y_rows = lax.map(expert_block, (x_rows, block_expert)).reshape(P, D)
    return jax.ops.segment_sum(y_rows * row_gate[:, None], row_tok, num_segments=T + 1)[:T]


def setup_inputs(seed: int = 0) -> dict:
    key = jax.random.key(seed)
    keys = iter(jax.random.split(key, 40))
    f32 = jnp.float32

    def normal(shape, scale):
        return jax.random.normal(next(keys), shape, f32) * scale

    def gain(shape):
        return 1.0 + normal(shape, 0.02)

    def uniform(shape, lo, hi):
        return jax.random.uniform(next(keys), shape, f32, lo, hi)

    return {
        "x": normal((BATCH, SEQ, D_MODEL), 1.0),
        "meta_tokens": normal((N_META, D_MODEL), 1.0),
        "mix_norm_g": gain((DEPTH, D_MODEL)),
        "w_in": normal((DEPTH, D_MODEL, IN_COLS), D_MODEL ** -0.5),
        "tm_mu": uniform((DEPTH, RWKV_COLS), 0.0, 1.0),
        "tm_w0": uniform((DEPTH, RWKV_WIDTH), -6.0, 1.0),
        "tm_w_decay_up": normal((DEPTH, DECAY_LORA, RWKV_WIDTH), 0.1),
        "tm_a0": normal((DEPTH, RWKV_WIDTH), 0.1),
        "tm_w_a_up": normal((DEPTH, AAA_LORA, RWKV_WIDTH), 0.1),
        "tm_w_g_up": normal((DEPTH, GATE_LORA, RWKV_WIDTH), GATE_LORA ** -0.5),
        "tm_k_k": 0.85 + normal((DEPTH, RWKV_WIDTH), 0.02),
        "tm_k_a": gain((DEPTH, RWKV_WIDTH)),
        "tm_r_k": normal((DEPTH, RWKV_HEADS, RWKV_HEAD_DIM), 0.1),
        "tm_gn_g": gain((DEPTH, RWKV_WIDTH)),
        "tm_gn_b": normal((DEPTH, RWKV_WIDTH), 0.02),
        "da_q_norm_g": gain((DEPTH, DIFF_QK_DIM)),
        "da_k_norm_g": gain((DEPTH, DIFF_QK_DIM)),
        "da_lambda_q1": normal((DEPTH, DIFF_QK_DIM), 0.1),
        "da_lambda_k1": normal((DEPTH, DIFF_QK_DIM), 0.1),
        "da_lambda_q2": normal((DEPTH, DIFF_QK_DIM), 0.1),
        "da_lambda_k2": normal((DEPTH, DIFF_QK_DIM), 0.1),
        "da_subln_g": gain((DEPTH, DIFF_V_DIM)),
        "sc_conv_w": normal((DEPTH, CONV_K, CONV_WIDTH), CONV_K ** -0.5),
        "w_out": normal((DEPTH, D_MODEL, D_MODEL), D_MODEL ** -0.5),
        "ffn_norm_g": gain((DEPTH, D_MODEL)),
        "ffn_w_gate": normal((N_DENSE, D_MODEL, D_FF), D_MODEL ** -0.5),
        "ffn_w_up": normal((N_DENSE, D_MODEL, D_FF), D_MODEL ** -0.5),
        "ffn_w_down": normal((N_DENSE, D_FF, D_MODEL), D_FF ** -0.5),
        "router_w": normal((N_MOE, D_MODEL, N_EXPERTS), D_MODEL ** -0.5),
        "moe_w_gate": normal((N_MOE, N_EXPERTS, D_MODEL, D_FF), D_MODEL ** -0.5),
        "moe_w_up": normal((N_MOE, N_EXPERTS, D_MODEL, D_FF), D_MODEL ** -0.5),
        "moe_w_down": normal((N_MOE, N_EXPERTS, D_FF, D_MODEL), D_FF ** -0.5),
    }


def reference(x, meta_tokens, mix_norm_g, w_in, tm_mu, tm_w0, tm_w_decay_up, tm_a0, tm_w_a_up,
              tm_w_g_up, tm_k_k, tm_k_a, tm_r_k, tm_gn_g, tm_gn_b, da_q_norm_g, da_k_norm_g,
              da_lambda_q1, da_lambda_k1, da_lambda_q2, da_lambda_k2, da_subln_g, sc_conv_w,
              w_out, ffn_norm_g, ffn_w_gate, ffn_w_up, ffn_w_down, router_w, moe_w_gate,
              moe_w_up, moe_w_down):
    b = x.shape[0]
    meta = jnp.broadcast_to(meta_tokens.astype(x.dtype)[None], (b, N_META, D_MODEL))
    h = jnp.concatenate([meta, x], axis=1)
    l = h.shape[1]
    cos, sin = rope_tables(l)
    for i in range(DEPTH):
        lam_init = 0.8 - 0.6 * math.exp(-0.3 * i)
        proj = rms_norm(h, mix_norm_g[i], NORM_EPS) @ w_in[i]
        p_a = proj[..., :RWKV_COLS]
        p_b = proj[..., RWKV_COLS:RWKV_COLS + DIFF_COLS]
        p_c = proj[..., RWKV_COLS + DIFF_COLS:]
        o_a = rwkv7_time_mix(p_a, tm_mu[i], tm_w0[i], tm_w_decay_up[i], tm_a0[i], tm_w_a_up[i],
                             tm_w_g_up[i], tm_k_k[i], tm_k_a[i], tm_r_k[i], tm_gn_g[i], tm_gn_b[i])
        o_b = diff_attention(p_b, cos, sin, da_q_norm_g[i], da_k_norm_g[i], da_lambda_q1[i],
                             da_lambda_k1[i], da_lambda_q2[i], da_lambda_k2[i], da_subln_g[i], lam_init)
        o_c = short_conv(p_c, sc_conv_w[i])
        h = h + jnp.concatenate([o_a, o_b, o_c], axis=-1) @ w_out[i]
        hn = rms_norm(h, ffn_norm_g[i], NORM_EPS)
        j = i // 2
        if i % 2 == 0:
            f = swiglu(hn, ffn_w_gate[j], ffn_w_up[j], ffn_w_down[j])
        else:
            f = moe_swiglu(hn.reshape(b * l, D_MODEL), router_w[j], moe_w_gate[j], moe_w_up[j],
                           moe_w_down[j]).reshape(b, l, D_MODEL)
        h = h + f
    return h[:, N_META:]
```

```cpp
#include <hip/hip_runtime.h>
#include <cstdio>
#include <cstdint>
namespace pg8 {
#define PG8_LAS __attribute__((address_space(3)))
typedef unsigned short bf16_t;
typedef short bf16x8 __attribute__((ext_vector_type(8)));
typedef float f32x4 __attribute__((ext_vector_type(4)));
typedef unsigned u32x4 __attribute__((ext_vector_type(4)));
constexpr int BM = 256, BK = 64, HALF = 128, HTB = HALF * BK * 2  , STAGE_BYTES = 8 * HTB, NXCD = 8, WGM = 8;

__host__ __device__ __forceinline__ int lds_byte(int r, int c) { const int st = (r >> 4) * 2 + (c >> 5), rr = r & 15, cc = c & 31, ob = rr * 64 + cc * 2; return st * 1024 + (ob ^ (((ob >> 9) & 1) << 5)); }
__host__ __device__ __forceinline__ void stage_rc(int b, int& R, int& C) { const int st = b / 1024, sb = b % 1024, swz = sb ^ (((sb >> 9) & 1) << 5); R = (st >> 1) * 16 + swz / 64; C = (st & 1) * 32 + (swz % 64) / 2; }
__host__ __device__ __forceinline__ int perm32(int rho) { const int n = rho >> 4, i = rho & 15; return 8 * (i >> 2) + 4 * n + (i & 3); }

struct Unit { int pm, pn, pc; };
struct Gemm { const bf16_t* A; const bf16_t* Bt; int M, N, K; };

struct StaticOrder {
    int nM, nN, nwg, G, c;
    __host__ __device__ void init(int M, int N, int G_, int c_) { nM = M / BM; nN = N / BM; nwg = nM * nN; G = G_; c = c_; }
    __host__ __device__ bool next(int i, Unit& u) const {
        const long L = (long)i * G + c; if (L >= nwg) return false;
        int wgid = (int)L; { const int q = nwg / NXCD, r = nwg % NXCD, xcd = wgid % NXCD, off = wgid / NXCD; wgid = (xcd < r ? xcd * (q + 1) : r * (q + 1) + (xcd - r) * q) + off; }
        const int nig = WGM * nN, gid = wgid / nig, fm = gid * WGM, gsz = (nM - fm) < WGM ? (nM - fm) : WGM;
        u.pm = fm + ((wgid % nig) % gsz); u.pn = (wgid % nig) / gsz; u.pc = u.pn; return true;
    }
    __device__ __forceinline__ void a_ready(const Unit&) const {}
    __device__ __forceinline__ void done(const Unit&) const {}
};
struct MoeOrder {
    int G, c, nN, total; int t1, t2, t3, t4, t5, t6, t7;
    __device__ __forceinline__ void init(const int* cnt, int nN_, int G_, int c_) {
        G = G_; c = c_; nN = nN_; int a = 0;
        a += (__hip_atomic_load(cnt + 0, __ATOMIC_RELAXED, __HIP_MEMORY_SCOPE_AGENT) + 255) >> 8; t1 = a;
        a += (__hip_atomic_load(cnt + 1, __ATOMIC_RELAXED, __HIP_MEMORY_SCOPE_AGENT) + 255) >> 8; t2 = a;
        a += (__hip_atomic_load(cnt + 2, __ATOMIC_RELAXED, __HIP_MEMORY_SCOPE_AGENT) + 255) >> 8; t3 = a;
        a += (__hip_atomic_load(cnt + 3, __ATOMIC_RELAXED, __HIP_MEMORY_SCOPE_AGENT) + 255) >> 8; t4 = a;
        a += (__hip_atomic_load(cnt + 4, __ATOMIC_RELAXED, __HIP_MEMORY_SCOPE_AGENT) + 255) >> 8; t5 = a;
        a += (__hip_atomic_load(cnt + 5, __ATOMIC_RELAXED, __HIP_MEMORY_SCOPE_AGENT) + 255) >> 8; t6 = a;
        a += (__hip_atomic_load(cnt + 6, __ATOMIC_RELAXED, __HIP_MEMORY_SCOPE_AGENT) + 255) >> 8; t7 = a;
        a += (__hip_atomic_load(cnt + 7, __ATOMIC_RELAXED, __HIP_MEMORY_SCOPE_AGENT) + 255) >> 8;
        total = a * nN;
    }
    __device__ __forceinline__ bool next(int i, Unit& u) const {
        const long L = (long)i * G + c; if (L >= total) return false;
        const int rt = (int)(L / nN), j = (int)(L % nN);
        const int e = (rt >= t1) + (rt >= t2) + (rt >= t3) + (rt >= t4) + (rt >= t5) + (rt >= t6) + (rt >= t7);
        u.pm = rt; u.pn = e * nN + j; u.pc = j; return true;
    }
    __device__ __forceinline__ void a_ready(const Unit&) const {}
    __device__ __forceinline__ void done(const Unit&) const {}
};

__device__ __forceinline__ unsigned cvt_pk_bf16(float lo, float hi) { unsigned r; asm volatile("v_cvt_pk_bf16_f32 %0, %1, %2" : "=v"(r) : "v"(lo), "v"(hi)); return r; }

struct EpiBf16Rs {
    static constexpr bool PERM = true, AFTER_DRAIN = false;
    bf16_t* O; int ldc; const float* rs;
    __device__ __forceinline__ void operator()(const f32x4 (&acc)[2][2][4][2], const Unit& u, int wr, int wc, int fr, int fq) const {
        const int row0 = u.pm * BM + wr * 64 + fr; const int col0 = u.pc * BM + wc * 32 + 8 * fq;
#pragma unroll
        for (int ai = 0; ai < 2; ++ai)
#pragma unroll
            for (int m = 0; m < 4; ++m) { const int row = row0 + ai * HALF + m * 16; const float s = rs ? rs[row] : 1.f; bf16_t* rowp = O + (size_t)row * ldc + col0;
#pragma unroll
                for (int bj = 0; bj < 2; ++bj) { const f32x4 v0 = acc[ai][bj][m][0] * s, v1 = acc[ai][bj][m][1] * s;
                    u32x4 w; w.x = cvt_pk_bf16(v0[0], v0[1]); w.y = cvt_pk_bf16(v0[2], v0[3]); w.z = cvt_pk_bf16(v1[0], v1[1]); w.w = cvt_pk_bf16(v1[2], v1[3]);
                    *(u32x4*)(rowp + bj * HALF) = w; } }
    }
};
struct EpiResAdd {
    static constexpr bool PERM = false, AFTER_DRAIN = false;
    float* H; int ldc;
    __device__ __forceinline__ void operator()(const f32x4 (&acc)[2][2][4][2], const Unit& u, int wr, int wc, int fr, int fq) const {
        const int row0 = u.pm * BM + wr * 64 + fr; const int col0 = u.pc * BM + wc * 32 + 4 * fq;
#pragma unroll
        for (int ai = 0; ai < 2; ++ai)
#pragma unroll
            for (int m = 0; m < 4; ++m) { float* rowp = H + (size_t)(row0 + ai * HALF + m * 16) * ldc + col0;
#pragma unroll
                for (int bj = 0; bj < 2; ++bj)
#pragma unroll
                    for (int n = 0; n < 2; ++n) { f32x4* p = (f32x4*)(rowp + bj * HALF + n * 16); *p = *p + acc[ai][bj][m][n]; } }
    }
};
struct EpiSwiglu {
    static constexpr bool PERM = true, AFTER_DRAIN = false;
    bf16_t* O; int ldc; const float* rs;
    static __device__ __forceinline__ float silu_mul(float g, float u) { return g * u * __builtin_amdgcn_rcpf(1.f + __builtin_amdgcn_exp2f(-1.4426950408889634f * g)); }
    __device__ __forceinline__ void operator()(const f32x4 (&acc)[2][2][4][2], const Unit& u, int wr, int wc, int fr, int fq) const {
        const int row0 = u.pm * BM + wr * 64 + fr; const int col0 = u.pc * HALF + wc * 32 + 8 * fq;
#pragma unroll
        for (int ai = 0; ai < 2; ++ai)
#pragma unroll
            for (int m = 0; m < 4; ++m) { const int row = row0 + ai * HALF + m * 16; const float s = rs[row]; bf16_t* rowp = O + (size_t)row * ldc + col0;
                const f32x4 g0 = acc[ai][0][m][0] * s, g1 = acc[ai][0][m][1] * s, u0 = acc[ai][1][m][0] * s, u1 = acc[ai][1][m][1] * s;
                u32x4 w; w.x = cvt_pk_bf16(silu_mul(g0[0], u0[0]), silu_mul(g0[1], u0[1])); w.y = cvt_pk_bf16(silu_mul(g0[2], u0[2]), silu_mul(g0[3], u0[3]));
                w.z = cvt_pk_bf16(silu_mul(g1[0], u1[0]), silu_mul(g1[1], u1[1])); w.w = cvt_pk_bf16(silu_mul(g1[2], u1[2]), silu_mul(g1[3], u1[3]));
                *(u32x4*)rowp = w; }
    }
};

template <class Epi, class Sched, bool ALIGN_EPI = false, bool SP2 = false>
__device__ __forceinline__ void gemm_phase(PG8_LAS unsigned char* lds, const Gemm g, const Sched& S, const Epi& E) {
    int tid_ = threadIdx.x; asm volatile("" : "+v"(tid_));
    const int tid = tid_, wid = __builtin_amdgcn_readfirstlane(tid >> 6), lane = tid & 63, wr = wid >> 2, wc = wid & 3, fr = lane & 15, fq = lane >> 4;
    const int K = g.K, nt = K / BK;
    unsigned voffA[2], voffB[2];
#pragma unroll
    for (int i = 0; i < 2; ++i) { int R, C; stage_rc(tid * 16 + i * 8192, R, C); const int Rb = Epi::PERM ? ((R & ~31) + perm32(R & 31)) : R;
        voffA[i] = (unsigned)(R * K + C) * 2u; voffB[i] = (unsigned)(Rb * K + C) * 2u; }
    const size_t kstep = (size_t)(BK * 2);
    const size_t hstep = (size_t)HALF * K * 2;
    const size_t tstep = 2 * hstep;
    const unsigned ldsw = (unsigned)wid * 1024u;
    const int aoff = lds_byte(wr * 64 + fr, fq * 8), boff = lds_byte(wc * 32 + fr, fq * 8);
#define PG8_SA(b, h) (((b) * 2 + (h)) * HTB)
#define PG8_SB(b, h) ((4 + (b) * 2 + (h)) * HTB)
#define PG8_STAGE(bufoff, gbase, voff) do { _Pragma("unroll") for (int _i = 0; _i < 2; ++_i) \
        __builtin_amdgcn_global_load_lds((const unsigned*)((const char*)(gbase) + (voff)[_i]), (PG8_LAS unsigned*)(lds + (bufoff) + ldsw + _i * 8192), 16, 0, 0); } while (0)
#define PG8_LDA(dst, b, h) do { _Pragma("unroll") for (int m = 0; m < 4; ++m) _Pragma("unroll") for (int k = 0; k < 2; ++k) dst[m][k] = *(const PG8_LAS bf16x8*)(lds + PG8_SA(b, h) + aoff + m * 2048 + k * 1024); } while (0)
#define PG8_LDB(dst, b, h) do { _Pragma("unroll") for (int n = 0; n < 2; ++n) _Pragma("unroll") for (int k = 0; k < 2; ++k) dst[n][k] = *(const PG8_LAS bf16x8*)(lds + PG8_SB(b, h) + boff + n * 2048 + k * 1024); } while (0)
#define PG8_MMA(ai, bj, At, Bt) do { __builtin_amdgcn_s_setprio(1); _Pragma("unroll") for (int m = 0; m < 4; ++m) _Pragma("unroll") for (int n = 0; n < 2; ++n) _Pragma("unroll") for (int k = 0; k < 2; ++k) \
        acc[ai][bj][m][n] = __builtin_amdgcn_mfma_f32_16x16x32_bf16(Bt[n][k], At[m][k], acc[ai][bj][m][n], 0, 0, 0); __builtin_amdgcn_s_setprio(0); } while (0)
#define PG8_WAIT_V(n) asm volatile("s_waitcnt vmcnt(" #n ")" ::: "memory")
#define PG8_WAIT_L(n) asm volatile("s_waitcnt lgkmcnt(" #n ")" ::: "memory")
#define PG8_BAR __builtin_amdgcn_s_barrier()
#define PG8_SCHED __builtin_amdgcn_sched_barrier(0)
    Unit cur, nxt; int ui = 0;
    if (!S.next(0, cur)) return;
    f32x4 acc[2][2][4][2];
#pragma unroll
    for (int a = 0; a < 2; ++a)
#pragma unroll
        for (int b = 0; b < 2; ++b)
#pragma unroll
            for (int m = 0; m < 4; ++m)
#pragma unroll
                for (int n = 0; n < 2; ++n) acc[a][b][m][n] = (f32x4){0.f, 0.f, 0.f, 0.f};
    bf16x8 At[4][2], B0[2][2], B1[2][2];
    const char* cA = (const char*)g.A + (size_t)cur.pm * tstep; const char* cB = (const char*)g.Bt + (size_t)cur.pn * tstep;
    S.a_ready(cur);
    if constexpr (SP2) {
        PG8_STAGE(PG8_SB(0, 0), cB, voffB); PG8_STAGE(PG8_SB(0, 1), cB + hstep, voffB); PG8_STAGE(PG8_SA(0, 0), cA, voffA); PG8_STAGE(PG8_SA(0, 1), cA + hstep, voffA);
        if (wr == 1) PG8_BAR;
        PG8_WAIT_V(2); PG8_BAR;
        PG8_STAGE(PG8_SB(1, 0), cB + kstep, voffB); PG8_STAGE(PG8_SA(1, 0), cA + kstep, voffA); PG8_STAGE(PG8_SB(1, 1), cB + hstep + kstep, voffB);
        PG8_WAIT_V(6); PG8_BAR;
    } else {
        PG8_STAGE(PG8_SB(0, 0), cB, voffB); PG8_STAGE(PG8_SA(0, 0), cA, voffA); PG8_STAGE(PG8_SB(0, 1), cB + hstep, voffB); PG8_STAGE(PG8_SA(0, 1), cA + hstep, voffA);
        if (wr == 1) PG8_BAR;
        PG8_WAIT_V(4); PG8_BAR;
        PG8_STAGE(PG8_SB(1, 0), cB + kstep, voffB); PG8_STAGE(PG8_SA(1, 0), cA + kstep, voffA); PG8_STAGE(PG8_SB(1, 1), cB + hstep + kstep, voffB);
        PG8_WAIT_V(6); PG8_BAR;
    }
    for (;;) {
        const bool has_next = S.next(ui + 1, nxt);
        const char* nA = has_next ? (const char*)g.A + (size_t)nxt.pm * tstep : cA; const char* nB = has_next ? (const char*)g.Bt + (size_t)nxt.pn * tstep : cB;
        for (int t = 0; t < nt; t += 2) {
            const bool last = (t == nt - 2);
            const char* a1 = cA + (size_t)(t + 1) * kstep;
            const char* a2 = last ? nA : cA + (size_t)(t + 2) * kstep; const char* b2 = last ? nB : cB + (size_t)(t + 2) * kstep;
            const char* a3 = a2 + kstep; const char* b3 = b2 + kstep;
            if (last && has_next) S.a_ready(nxt);
            if constexpr (SP2) {
            PG8_LDB(B0, 0, 0); PG8_LDB(B1, 0, 1); PG8_SCHED; PG8_LDA(At, 0, 0); PG8_STAGE(PG8_SA(1, 1), a1 + hstep, voffA);
            PG8_WAIT_V(8); PG8_WAIT_L(0); PG8_BAR; PG8_MMA(0, 0, At, B0); PG8_MMA(0, 1, At, B1); PG8_BAR; PG8_SCHED;
            PG8_LDA(At, 0, 1); PG8_STAGE(PG8_SB(0, 0), b2, voffB); PG8_STAGE(PG8_SB(0, 1), b2 + hstep, voffB); PG8_STAGE(PG8_SA(0, 0), a2, voffA);
            PG8_WAIT_V(8); PG8_WAIT_L(0); PG8_BAR; PG8_MMA(1, 0, At, B0); PG8_MMA(1, 1, At, B1); PG8_BAR; PG8_SCHED;
            PG8_LDB(B0, 1, 0); PG8_LDB(B1, 1, 1); PG8_SCHED; PG8_LDA(At, 1, 0); PG8_STAGE(PG8_SA(0, 1), a2 + hstep, voffA);
            PG8_WAIT_V(8); PG8_WAIT_L(0); PG8_BAR; PG8_MMA(0, 0, At, B0); PG8_MMA(0, 1, At, B1); PG8_BAR; PG8_SCHED;
            PG8_LDA(At, 1, 1); PG8_STAGE(PG8_SB(1, 0), b3, voffB); PG8_STAGE(PG8_SB(1, 1), b3 + hstep, voffB); PG8_STAGE(PG8_SA(1, 0), a3, voffA);
            PG8_WAIT_V(8); PG8_WAIT_L(0); PG8_BAR; PG8_MMA(1, 0, At, B0); PG8_MMA(1, 1, At, B1); PG8_BAR; PG8_SCHED;
            } else {
            PG8_LDB(B0, 0, 0); PG8_SCHED; PG8_LDA(At, 0, 0); PG8_STAGE(PG8_SA(1, 1), a1 + hstep, voffA);
            PG8_WAIT_L(8); PG8_BAR; PG8_WAIT_L(0); PG8_MMA(0, 0, At, B0); PG8_BAR; PG8_SCHED;
            PG8_LDB(B1, 0, 1); PG8_STAGE(PG8_SB(0, 0), b2, voffB);
            PG8_BAR; PG8_WAIT_L(0); PG8_MMA(0, 1, At, B1); PG8_BAR;
            PG8_LDA(At, 0, 1); PG8_STAGE(PG8_SA(0, 0), a2, voffA);
            PG8_BAR; PG8_WAIT_L(0); PG8_MMA(1, 0, At, B0); PG8_BAR; PG8_SCHED;
            PG8_STAGE(PG8_SB(0, 1), b2 + hstep, voffB);
            PG8_WAIT_V(6); PG8_BAR; PG8_MMA(1, 1, At, B1); PG8_BAR;
            PG8_LDB(B0, 1, 0); PG8_SCHED; PG8_LDA(At, 1, 0); PG8_STAGE(PG8_SA(0, 1), a2 + hstep, voffA);
            PG8_WAIT_L(8); PG8_BAR; PG8_WAIT_L(0); PG8_MMA(0, 0, At, B0); PG8_BAR; PG8_SCHED;
            PG8_LDB(B1, 1, 1); PG8_STAGE(PG8_SB(1, 0), b3, voffB);
            PG8_BAR; PG8_WAIT_L(0); PG8_MMA(0, 1, At, B1); PG8_BAR;
            PG8_LDA(At, 1, 1); PG8_STAGE(PG8_SA(1, 0), a3, voffA);
            PG8_BAR; PG8_WAIT_L(0); PG8_MMA(1, 0, At, B0); PG8_BAR; PG8_SCHED;
            PG8_STAGE(PG8_SB(1, 1), b3 + hstep, voffB);
            PG8_WAIT_V(6); PG8_BAR; PG8_MMA(1, 1, At, B1); PG8_BAR;
            }
        }
        if constexpr (ALIGN_EPI) { if (wr == 0) PG8_BAR; }
        if constexpr (!Epi::AFTER_DRAIN) { E(acc, cur, wr, wc, fr, fq); S.done(cur); }
        if (!has_next) break;
#pragma unroll
        for (int a = 0; a < 2; ++a)
#pragma unroll
            for (int b = 0; b < 2; ++b)
#pragma unroll
                for (int m = 0; m < 4; ++m)
#pragma unroll
                    for (int n = 0; n < 2; ++n) acc[a][b][m][n] = (f32x4){0.f, 0.f, 0.f, 0.f};
        cur = nxt; cA = nA; cB = nB; ++ui;
        if constexpr (ALIGN_EPI) { if (wr == 1) PG8_BAR; }
    }
    PG8_WAIT_V(0);
    if constexpr (!ALIGN_EPI) { if (wr == 0) PG8_BAR; }
    PG8_BAR;
    if constexpr (Epi::AFTER_DRAIN) { E.fused(acc, cur, wr, wc, fr, fq, lds, wid, lane); S.done(cur); }
#undef PG8_SA
#undef PG8_SB
#undef PG8_STAGE
#undef PG8_LDA
#undef PG8_LDB
#undef PG8_MMA
#undef PG8_WAIT_V
#undef PG8_WAIT_L
#undef PG8_BAR
#undef PG8_SCHED
}
}
#define GAS __attribute__((address_space(1)))
#define LAS __attribute__((address_space(3)))
typedef unsigned short bf16;
typedef unsigned v4u __attribute__((ext_vector_type(4)));
typedef float f32x4 __attribute__((ext_vector_type(4)));
typedef short bf16x8 __attribute__((ext_vector_type(8)));
typedef GAS unsigned gu32;
typedef GAS unsigned long long gu64;
#define RLX_AGENT __ATOMIC_RELAXED, __HIP_MEMORY_SCOPE_AGENT
#define LDS_WAIT() asm volatile("s_waitcnt lgkmcnt(0)" ::: "memory")
#define VM_WAIT() asm volatile("s_waitcnt vmcnt(0)" ::: "memory")
__device__ __forceinline__ unsigned long long rt() { return __builtin_amdgcn_s_memrealtime(); }
__device__ __forceinline__ unsigned f2bf(float f) { unsigned u = __builtin_bit_cast(unsigned, f); return (u + 0x7fffu + ((u >> 16) & 1u)) >> 16; }
__device__ __forceinline__ unsigned pk2(float lo, float hi) { return f2bf(lo) | (f2bf(hi) << 16); }

#define XB_TMO      128
#define XB_XCNT(j)  (256  + 64 * (j))
#define XB_XSUB(j)  (1280 + 64 * (j))
#define XB_XGEN(j)  (2304 + 64 * (j))
#define XB_TOP      3328
#define XB_TOPGEN   3392
#define XCD_BAR_WORDS 3456
#define XB_SPIN_CAP (1u << 18)

__device__ __forceinline__ unsigned xb_ld(unsigned* p)              { return __hip_atomic_load(p, __ATOMIC_RELAXED, __HIP_MEMORY_SCOPE_AGENT); }
__device__ __forceinline__ unsigned xb_add(unsigned* p, unsigned v) { return __hip_atomic_fetch_add(p, v, __ATOMIC_RELAXED, __HIP_MEMORY_SCOPE_AGENT); }
__device__ __forceinline__ unsigned xb_xcc_id() { return (unsigned)__builtin_amdgcn_s_getreg((3 << 11) | 20) & 0xFu; }
#define XB_SPIN(cond, bar) do { unsigned _sp = 0; while (cond) { __builtin_amdgcn_s_sleep(1); \
    if ((++_sp & 255u) == 0u) { if (xb_ld(&(bar)[XB_TMO])) break; if (_sp > XB_SPIN_CAP) { atomicAdd(&(bar)[XB_TMO], 1u); break; } } } } while (0)

struct XcdBarrier {
    unsigned* bar; unsigned x;
    volatile LAS unsigned* st;
};

__device__ __forceinline__ XcdBarrier xcd_barrier_post(unsigned* bar, volatile LAS unsigned* st) {
    XcdBarrier b; b.bar = bar; b.x = xb_xcc_id(); b.st = st;
    if (threadIdx.x == 0) (void)xb_add(&bar[XB_XCNT(b.x)], 1u);
    return b;
}
__device__ __forceinline__ void xcd_barrier_complete(unsigned* bar, unsigned x, unsigned& nloc, unsigned& nx) {
    const unsigned G = gridDim.x * gridDim.y * gridDim.z;
    unsigned sum, cnt, mine, sp = 0u;
    for (;;) {
        sum = 0u; cnt = 0u; mine = 0u;
#pragma unroll
        for (unsigned j = 0; j < 16; ++j) { const unsigned c = xb_ld(&bar[XB_XCNT(j)]); sum += c; cnt += (c > 0u) ? 1u : 0u; mine = (j == x) ? c : mine; }
        if (sum == G) break;
        __builtin_amdgcn_s_sleep(1);
        if ((++sp & 255u) == 0u) { if (xb_ld(&bar[XB_TMO])) break; if (sp > XB_SPIN_CAP) { atomicAdd(&bar[XB_TMO], 1u); break; } }
    }
    nloc = mine > 0u ? mine : 1u; nx = cnt > 0u ? cnt : 1u;
}

__device__ __forceinline__ void xcd_barrier(const XcdBarrier& b) {
    asm volatile("s_waitcnt vmcnt(0)" ::: "memory");
    __syncthreads();
    if (threadIdx.x == 0) {
        unsigned* bar = b.bar;
        __builtin_amdgcn_s_waitcnt(0);
        unsigned nloc = b.st[0], nx = b.st[1];
        if (nloc == 0u) { xcd_barrier_complete(bar, b.x, nloc, nx); b.st[0] = nloc; b.st[1] = nx; }
        const unsigned old = xb_add(&bar[XB_XSUB(b.x)], 1u);
        const unsigned gen = old / nloc;
        if (old + 1u == (gen + 1u) * nloc) {
            __builtin_amdgcn_fence(__ATOMIC_RELEASE, "agent");
            asm volatile("s_waitcnt vmcnt(0)" ::: "memory");
            const unsigned og = xb_add(&bar[XB_TOP], 1u);
            const unsigned tg = og / nx;
            if (og + 1u == (tg + 1u) * nx) xb_add(&bar[XB_TOPGEN], 1u);
            else XB_SPIN(xb_ld(&bar[XB_TOPGEN]) == tg, bar);
            __builtin_amdgcn_fence(__ATOMIC_ACQUIRE, "agent");
            xb_add(&bar[XB_XGEN(b.x)], 1u);
            asm volatile("s_waitcnt vmcnt(0)" ::: "memory");
        } else {
            XB_SPIN(xb_ld(&bar[XB_XGEN(b.x)]) == gen, bar);
            __builtin_amdgcn_fence(__ATOMIC_ACQUIRE, "agent");
            asm volatile("s_waitcnt vmcnt(0)" ::: "memory");
        }
    }
    __syncthreads();
}

constexpr int NWAVES = 8;
constexpr int DM = 1024, NB = 4, SEQ = 4096, NMETA = 16, DEPTH = 4;
constexpr int NREAL = NB * SEQ;
constexpr int NTOK = NREAL + NMETA;
constexpr int MPAD = 16640;
constexpr int INC = 3200, INP = 3328;
constexpr int RCOLS = 896, QOFF = 896, KOFF = 896 + 512, VOFF = 896 + 1024, COFF = 2432;
constexpr int FF = 2816, FF2 = 5632, NE = 8;
constexpr int KVROWS = 128 + SEQ;
constexpr int MOEP = 35072;
constexpr float C2Q = 0.125f * 1.4426950408889634f;

constexpr size_t MiB = 1u << 20;
constexpr size_t WS_CTL = 0, CTL_ZERO_BYTES = 1 * MiB;
constexpr size_t WS_COS = 1 * MiB, WS_SIN = 1 * MiB + 192 * 1024;
constexpr size_t WS_RSTD = 1 * MiB + 512 * 1024;
constexpr size_t WS_RSROW = 1 * MiB + 768 * 1024;
constexpr size_t WS_TOKE = 2 * MiB, WS_TOKS = 2 * MiB + 256 * 1024, WS_TOKG = 2 * MiB + 512 * 1024;
constexpr size_t WS_WIN = 4 * MiB;
constexpr size_t WS_WOUT = 30 * MiB;
constexpr size_t WS_WGU = 38 * MiB;
constexpr size_t WS_WD = 60 * MiB;
constexpr size_t WS_MWGU = 72 * MiB;
constexpr size_t WS_MWD = 160 * MiB;
constexpr size_t WS_H = 204 * MiB;
constexpr size_t WS_HB = 269 * MiB;
constexpr size_t WS_PH = 302 * MiB;
constexpr size_t WS_PROJ = WS_PH;
constexpr size_t WS_QN = 408 * MiB;
constexpr size_t WS_KP = 425 * MiB;
constexpr size_t WS_VP = 442 * MiB;
constexpr size_t WS_OC = 459 * MiB;
constexpr size_t WS_OMIX = 492 * MiB;
constexpr size_t WS_SC = 525 * MiB, SC_STRIDE = 17 * MiB;
constexpr size_t WS_MIX_END = WS_SC + 9 * SC_STRIDE;
constexpr size_t WS_G = WS_PH;
constexpr size_t WS_AROWS = 491 * MiB;
constexpr size_t WS_YM = 560 * MiB;
constexpr size_t WS_END = 680 * MiB;
static_assert(WS_PROJ + (size_t)MPAD * INP * 2 <= WS_QN && WS_G + (size_t)MOEP * FF * 2 <= WS_AROWS && WS_AROWS + (size_t)MOEP * 1024 * 2 <= WS_YM && WS_YM + (size_t)MOEP * 1024 * 2 <= WS_END, "ws map");
static_assert(WS_H + (size_t)MPAD * 1024 * 4 <= WS_HB && WS_HB + (size_t)MPAD * 1024 * 2 <= WS_PH && WS_MIX_END <= WS_END, "ws map 2");
static_assert((size_t)NTOK * 256 * 4 <= SC_STRIDE && WS_OC + (size_t)NTOK * 2048 <= WS_OMIX && WS_OMIX + (size_t)MPAD * 2048 <= WS_SC, "ws map 3");
constexpr int CW_MOECNT = 1024;
constexpr int CW_BAR = 4096;

constexpr int LDS_BYTES = 147456;
constexpr int MISC_OFF = LDS_BYTES - 128;

struct Args { const float* in[32]; float* out; unsigned char* ws; int ph_lo, ph_hi; };

__device__ __forceinline__ float bf2f(unsigned short b) { return __uint_as_float(((unsigned)b) << 16); }
__device__ __forceinline__ float wave_sum(float v) {
#pragma unroll
    for (int o = 1; o < 64; o <<= 1) v += __shfl_xor(v, o);
    return v;
}
__device__ __forceinline__ float wave_max(float v) {
#pragma unroll
    for (int o = 1; o < 64; o <<= 1) v = fmaxf(v, __shfl_xor(v, o));
    return v;
}
__device__ __forceinline__ float sum16(float v) {
#pragma unroll
    for (int o = 1; o < 16; o <<= 1) v += __shfl_xor(v, o);
    return v;
}
__device__ __forceinline__ float sigmoidf_(float x) { return 1.f / (1.f + __expf(-x)); }
__device__ __forceinline__ int prevrow(int row) { if (row < 0) return -1; if (row >= NREAL) return row == NREAL ? -1 : row - 1; return (row & (SEQ - 1)) == 0 ? NTOK - 1 : row - 1; }

__device__ __forceinline__ void tr_item(const float* W, int K, int N, bf16* WT, int rowmode, const float* gk, LAS float* scr, int item, int lane) {
    const int nblk = N / 32, kb = item / nblk, nb = item % nblk, k0 = 64 * kb, n0 = 32 * nb;
#pragma unroll 8
    for (int i = 0; i < 32; ++i) { const int kk = 2 * i + (lane >> 5); float v = W[(size_t)(k0 + kk) * N + n0 + (lane & 31)]; if (gk) v *= gk[k0 + kk]; scr[kk * 33 + (lane & 31)] = v; }
    LDS_WAIT(); asm volatile("" ::: "memory");
    const int c = lane & 7;
#pragma unroll
    for (int j = 0; j < 4; ++j) { const int n = (lane >> 3) + 8 * j; const LAS float* s = scr + (8 * c) * 33 + n;
        v4u o; o.x = pk2(s[0 * 33], s[1 * 33]); o.y = pk2(s[2 * 33], s[3 * 33]); o.z = pk2(s[4 * 33], s[5 * 33]); o.w = pk2(s[6 * 33], s[7 * 33]);
        const int nn = n0 + n; const int drow = rowmode == 0 ? nn : ((nn >> 7) * 256 + (nn & 127) + (rowmode == 2 ? 128 : 0));
        *(GAS v4u*)(WT + (size_t)drow * K + k0 + 8 * c) = o; }
    LDS_WAIT(); asm volatile("" ::: "memory");
}

__global__ void __launch_bounds__(NWAVES * 64, 2) hymba_fwd(Args args) {
    extern __shared__ __attribute__((aligned(16))) unsigned char lds_raw[];
    LAS unsigned char* lds = (LAS unsigned char*)lds_raw;
    volatile LAS unsigned* MISC = (volatile LAS unsigned*)(lds + MISC_OFF);
    const int tid0 = threadIdx.x, wave = __builtin_amdgcn_readfirstlane(tid0 >> 6);
#define PH_TID int tid = tid0; asm volatile("" : "+v"(tid)); const int lane = tid & 63; (void)lane; unsigned char* ws = ws0; asm volatile("" : "+s"(ws)); const char* ka = ka0; asm volatile("" : "+s"(ka)); (void)ka
    const int G = gridDim.x, bx = blockIdx.x;
    const int gw = bx * NWAVES + wave, NGW = G * NWAVES;
    unsigned char* const ws0 = args.ws;
    const char* const ka0 = (const char*)__builtin_amdgcn_kernarg_segment_ptr();
    if (tid0 < 32) ((LAS unsigned*)(lds + MISC_OFF))[tid0] = 0u;
    __syncthreads();
    const int lo = args.ph_lo, hi = args.ph_hi;
    const bool multi = (hi - lo) > 1;
    XcdBarrier bar; bar.bar = (unsigned*)(ws0 + WS_CTL) + CW_BAR; bar.x = 0; bar.st = nullptr;
    if (multi) bar = xcd_barrier_post((unsigned*)(ws0 + WS_CTL) + CW_BAR, MISC + 8);
#ifndef ENMASK
#define ENMASK 0xFFFF
#endif
#define EN(k) (((ENMASK) >> (k)) & 1)
#define IN(k) (lo <= (k) && (k) < hi)
#define SEAM(k) do { if (hi > (k) + 1) xcd_barrier(bar); } while (0)

#define Hf ((float*)(ws + WS_H))
#define HB ((bf16*)(ws + WS_HB))
#define RSTD ((float*)(ws + WS_RSTD))
#define PROJ ((bf16*)(ws + WS_PROJ))
#define QN ((bf16*)(ws + WS_QN))
#define KP ((bf16*)(ws + WS_KP))
#define VP ((bf16*)(ws + WS_VP))
#define OC ((bf16*)(ws + WS_OC))
#define OMIX ((bf16*)(ws + WS_OMIX))
#define SR ((float*)(ws + WS_SC + 0 * SC_STRIDE))
#define SW ((float*)(ws + WS_SC + 1 * SC_STRIDE))
#define SK ((float*)(ws + WS_SC + 2 * SC_STRIDE))
#define SV ((float*)(ws + WS_SC + 3 * SC_STRIDE))
#define SA ((float*)(ws + WS_SC + 4 * SC_STRIDE))
#define SB ((float*)(ws + WS_SC + 5 * SC_STRIDE))
#define SG ((float*)(ws + WS_SC + 6 * SC_STRIDE))
#define SBON ((float*)(ws + WS_SC + 7 * SC_STRIDE))
#define SY ((float*)(ws + WS_SC + 8 * SC_STRIDE))
#define COS ((float*)(ws + WS_COS))
#define SIN ((float*)(ws + WS_SIN))
#define GB ((bf16*)(ws + WS_G))
#define AROWS ((bf16*)(ws + WS_AROWS))
#define YM ((bf16*)(ws + WS_YM))
#define RSROW ((float*)(ws + WS_RSROW))
#define TOKE ((int*)(ws + WS_TOKE))
#define TOKS ((int*)(ws + WS_TOKS))
#define TOKG ((float*)(ws + WS_TOKG))
#define ctl ((gu32*)(ws + WS_CTL))
#define INP(i) (*(const float* const*)(ka + 8 * (i)))

    if (EN(15) && IN(0)) { PH_TID;
        LAS float* scr = (LAS float*)(lds + wave * 16384);
        constexpr int I_IN = 16 * 100, I_OUT = 16 * 32, I_GU = 16 * 88, I_DN = 44 * 32;
        constexpr int NITEMS = DEPTH * (I_IN + I_OUT) + 2 * (2 * I_GU + I_DN);
        for (int it = gw; it < NITEMS; it += NGW) {
            int r = it;
            if (r < DEPTH * I_IN) { const int l = r / I_IN; tr_item(INP(3) + (size_t)l * DM * INC, DM, INC, (bf16*)(ws + WS_WIN) + (size_t)l * INP * DM, 0, INP(2) + l * DM, scr, r % I_IN, lane); continue; } r -= DEPTH * I_IN;
            if (r < DEPTH * I_OUT) { const int l = r / I_OUT; tr_item(INP(23) + (size_t)l * DM * DM, DM, DM, (bf16*)(ws + WS_WOUT) + (size_t)l * DM * DM, 0, nullptr, scr, r % I_OUT, lane); continue; } r -= DEPTH * I_OUT;
            if (r < 2 * I_GU) { const int j = r / I_GU; tr_item(INP(25) + (size_t)j * DM * FF, DM, FF, (bf16*)(ws + WS_WGU) + (size_t)j * FF2 * DM, 1, INP(24) + (2 * j) * DM, scr, r % I_GU, lane); continue; } r -= 2 * I_GU;
            if (r < 2 * I_GU) { const int j = r / I_GU; tr_item(INP(26) + (size_t)j * DM * FF, DM, FF, (bf16*)(ws + WS_WGU) + (size_t)j * FF2 * DM, 2, INP(24) + (2 * j) * DM, scr, r % I_GU, lane); continue; } r -= 2 * I_GU;
            { const int j = r / I_DN; tr_item(INP(27) + (size_t)j * FF * DM, FF, DM, (bf16*)(ws + WS_WD) + (size_t)j * DM * FF, 0, nullptr, scr, r % I_DN, lane); }
        }
        const int gt = bx * (NWAVES * 64) + tid, NGT = G * NWAVES * 64;
        for (int i = gt; i < DEPTH * 128 * (DM / 8); i += NGT) { const int l = i / (128 * (DM / 8)), r = i % (128 * (DM / 8)); ((v4u*)((bf16*)(ws + WS_WIN) + ((size_t)l * INP + INC) * DM))[r] = (v4u){0u, 0u, 0u, 0u}; }
        for (int i = gt; i < MPAD * (DM / 4); i += NGT) { const int row = i / (DM / 4), c4 = i % (DM / 4); f32x4 v = (f32x4){0.f, 0.f, 0.f, 0.f};
            if (row < NREAL) v = ((const f32x4*)INP(0))[i]; else if (row < NTOK) v = ((const f32x4*)INP(1))[(row - NREAL) * (DM / 4) + c4];
            ((f32x4*)Hf)[i] = v; }
        for (int i = gt; i < (MPAD - NTOK) * (DM / 8); i += NGT) ((v4u*)(HB + (size_t)NTOK * DM))[i] = (v4u){0u, 0u, 0u, 0u};
        for (int i = gt; i < MPAD - NTOK; i += NGT) RSTD[NTOK + i] = 0.f;
        for (int i = gt; i < (SEQ + NMETA) * 8; i += NGT) { const int pos = i >> 3, j = i & 7;
            const float invf = j == 0 ? 1.000000000e+00f : j == 1 ? 1.939227432e-01f : j == 2 ? 3.760603070e-02f : j == 3 ? 7.292664610e-03f : j == 4 ? 1.414213562e-03f : j == 5 ? 2.742481884e-04f : j == 6 ? 5.318296098e-05f : 1.031338616e-05f;
            const float angf = (float)pos * invf; const double a = (double)angf; const double n = __builtin_rint(a * 0.15915494309189535);
            const double rr = (a - n * 6.283185307179586) - n * 2.4492935982947064e-16; const float rev = (float)(rr * 0.15915494309189535);
            COS[i] = __builtin_amdgcn_cosf(rev); SIN[i] = __builtin_amdgcn_sinf(rev); }
        SEAM(0);
    }

#pragma nounroll
    for (int layer = 0; layer < DEPTH; ++layer) {
        const int pb = 1 + 12 * layer; const bool moe = (layer & 1) != 0; const int jj = layer >> 1;
        if (hi <= pb || lo >= pb + 12) continue;
        const float lam_init = 0.8f - 0.6f * __expf(-0.3f * (float)layer);

        if (EN(0) && IN(pb + 0)) { PH_TID;
            for (int row = gw; row < NTOK; row += NGW) {
                const GAS f32x4* xr = (const GAS f32x4*)(Hf + (size_t)row * DM) + lane; f32x4 v[4]; float s = 0.f;
#pragma unroll
                for (int j = 0; j < 4; ++j) { v[j] = xr[64 * j]; s += (v[j].x * v[j].x + v[j].y * v[j].y) + (v[j].z * v[j].z + v[j].w * v[j].w); }
                s = wave_sum(s); const float rstd = 1.f / sqrtf(s * (1.f / DM) + 1e-6f);
                GAS unsigned long long* o8 = (GAS unsigned long long*)(HB + (size_t)row * DM) + lane;
#pragma unroll
                for (int j = 0; j < 4; ++j) o8[64 * j] = (unsigned long long)pk2(v[j].x, v[j].y) | ((unsigned long long)pk2(v[j].z, v[j].w) << 32);
                if (lane == 0) RSTD[row] = rstd;
            }
            if (moe) {
                LAS float* scr = (LAS float*)(lds + wave * 16384);
                constexpr int I_GU = 16 * 88, I_DN = 44 * 32, PER_E = 2 * I_GU + I_DN;
                const float* gff = INP(24) + layer * DM;
                for (int it = gw; it < NE * PER_E; it += NGW) { const int e = it / PER_E; int r = it % PER_E; const size_t eo = (size_t)(jj * NE + e) * DM * FF;
                    if (r < I_GU) { tr_item(INP(29) + eo, DM, FF, (bf16*)(ws + WS_MWGU) + (size_t)e * FF2 * DM, 1, gff, scr, r, lane); continue; } r -= I_GU;
                    if (r < I_GU) { tr_item(INP(30) + eo, DM, FF, (bf16*)(ws + WS_MWGU) + (size_t)e * FF2 * DM, 2, gff, scr, r, lane); continue; } r -= I_GU;
                    tr_item(INP(31) + eo, FF, DM, (bf16*)(ws + WS_MWD) + (size_t)e * DM * FF, 0, nullptr, scr, r, lane); }
            }
            SEAM(pb + 0);
        }
        if (EN(1) && IN(pb + 1)) { PH_TID;
            pg8::Gemm g{HB, (const bf16*)(ws + WS_WIN) + (size_t)layer * INP * DM, MPAD, INP, DM}; pg8::StaticOrder S; S.init(MPAD, INP, G, bx);
            pg8::EpiBf16Rs E{PROJ, INP, RSTD};
            pg8::gemm_phase<pg8::EpiBf16Rs, pg8::StaticOrder, true, true>(lds, g, S, E);
            SEAM(pb + 1);
        }
        if (EN(2) && IN(pb + 2)) { PH_TID;
            const int gt = bx * (NWAVES * 64) + tid, NGT = G * NWAVES * 64;
            for (int i = gt; i < NB * 112 * 64; i += NGT) { const int b = i / (112 * 64), r = (i / 64) % 112, c = i % 64; const int row = b * KVROWS + (r < 48 ? r : r + 16);
                ((v4u*)(KP + (size_t)row * 512))[c] = (v4u){0u, 0u, 0u, 0u}; ((v4u*)(VP + (size_t)row * 512))[c] = (v4u){0u, 0u, 0u, 0u}; }
            LAS float* lin = (LAS float*)lds;
            const int half = tid >> 8, c = tid & 255;
            const float* mu = INP(4) + layer * RCOLS; const float* w0 = INP(5) + layer * 256; const float* Wdu = INP(6) + layer * 32 * 256;
            const float* a0 = INP(7) + layer * 256; const float* Wau = INP(8) + layer * 32 * 256; const float* Wgu = INP(9) + layer * 64 * 256;
            const float* k_k = INP(10) + layer * 256; const float* k_a = INP(11) + layer * 256; const float* r_k = INP(12) + layer * 256;
            const float* qg = INP(15) + layer * 64; const float* kg = INP(16) + layer * 64; const float* cw = INP(22) + layer * 3 * 256;
            for (int pair = bx; pair < NTOK / 2; pair += G) {
                const int row = 2 * pair + half; const int p1 = prevrow(row), p2 = prevrow(p1);
                const bf16* pr = PROJ + (size_t)row * INP; const bf16* pp1 = PROJ + (size_t)(p1 < 0 ? 0 : p1) * INP; const bf16* pp2 = PROJ + (size_t)(p2 < 0 ? 0 : p2) * INP;
                const float m1 = p1 < 0 ? 0.f : 1.f, m2 = p2 < 0 ? 0.f : 1.f;
#define HX(col) ({ const float x_ = bf2f(pr[col]); const float p_ = m1 * bf2f(pp1[col]); x_ + (p_ - x_) * mu[col]; })
                const float r = HX(c), k = HX(256 + c), v = HX(512 + c);
                if (c < 128) { const float val = HX(768 + c); lin[half * 128 + c] = c < 32 ? tanhf(val) : (c < 64 ? val : sigmoidf_(val)); }
#undef HX
                __syncthreads();
                float wacc = w0[c], aacc = a0[c], gacc = 0.f;
#pragma unroll 8
                for (int j = 0; j < 32; ++j) { wacc += lin[half * 128 + j] * Wdu[j * 256 + c]; aacc += lin[half * 128 + 32 + j] * Wau[j * 256 + c]; }
#pragma unroll 8
                for (int j = 0; j < 64; ++j) gacc += lin[half * 128 + 64 + j] * Wgu[j * 256 + c];
                const float nx = -wacc; const float sp = fmaxf(nx, 0.f) + log1pf(__expf(-fabsf(nx)));
                const float wlog = -sp - 0.5f; const float decay = __expf(-__expf(wlog));
                const float a = sigmoidf_(aacc);
                const float kkr = k * k_k[c]; const float ss = wave_sum(kkr * kkr); const float kk = kkr / fmaxf(sqrtf(ss), 1e-12f);
                const float k2 = k * (1.f + (a - 1.f) * k_a[c]);
                const float bs = wave_sum(r * k2 * r_k[c]);
                const size_t si = (size_t)row * 256 + c;
                SR[si] = r; SW[si] = decay; SK[si] = k2; SV[si] = v; SA[si] = -kk; SB[si] = kk * a; SG[si] = gacc; SBON[si] = bs * v;
                const int pos = row >= NREAL ? row - NREAL : NMETA + (row & (SEQ - 1));
                const int d = lane; const int jr = d & 7; const float cs = COS[pos * 8 + jr], sn = SIN[pos * 8 + jr];
#pragma unroll
                for (int rep = 0; rep < 2; ++rep) { const int qi = c + 256 * rep;
                    { const float x = bf2f(pr[QOFF + qi]); const float s2 = wave_sum(x * x); float xn = x * (1.f / sqrtf(s2 * (1.f / 64.f) + 1e-6f)) * qg[d];
                      const float xp = __shfl(xn, d < 8 ? d + 8 : (d < 16 ? d - 8 : d)); if (d < 8) xn = xn * cs - xp * sn; else if (d < 16) xn = xn * cs + xp * sn;
                      QN[(size_t)row * 512 + qi] = (bf16)f2bf(xn * C2Q); }
                    { const float x = bf2f(pr[KOFF + qi]); const float s2 = wave_sum(x * x); float xn = x * (1.f / sqrtf(s2 * (1.f / 64.f) + 1e-6f)) * kg[d];
                      const float xp = __shfl(xn, d < 8 ? d + 8 : (d < 16 ? d - 8 : d)); if (d < 8) xn = xn * cs - xp * sn; else if (d < 16) xn = xn * cs + xp * sn;
                      const bf16 kb = (bf16)f2bf(xn); const bf16 vb = pr[VOFF + qi];
                      if (row < NREAL) { const size_t kr = (size_t)((row >> 12) * KVROWS + 128 + (row & (SEQ - 1))) * 512 + qi; KP[kr] = kb; VP[kr] = vb; }
                      else {
#pragma unroll
                          for (int b = 0; b < NB; ++b) { const size_t kr = (size_t)(b * KVROWS + 48 + (row - NREAL)) * 512 + qi; KP[kr] = kb; VP[kr] = vb; } } }
                }
                { const float z0 = bf2f(pr[COFF + 256 + c]) * bf2f(pr[COFF + 512 + c]);
                  const float z1 = m1 * bf2f(pp1[COFF + 256 + c]) * bf2f(pp1[COFF + 512 + c]);
                  const float z2 = m2 * bf2f(pp2[COFF + 256 + c]) * bf2f(pp2[COFF + 512 + c]);
                  const float y = cw[c] * z2 + cw[256 + c] * z1 + cw[512 + c] * z0;
                  OMIX[(size_t)row * DM + 768 + c] = (bf16)f2bf(bf2f(pr[COFF + c]) * y); }
                __syncthreads();
            }
            SEAM(pb + 2);
        }
        if (EN(3) && IN(pb + 3)) { PH_TID;
            if (wave < 4) {
                for (int item = bx * 4 + wave; item < 1024; item += G * 4) {
                    const int bh = item >> 6, vv = item & 63, b = bh >> 2, cb = (bh & 3) * 64;
                    float S = 0.f;
                    for (int t0 = 0; t0 < SEQ + NMETA; t0 += 8) {
                        const int rowb = t0 < NMETA ? NREAL + t0 : b * SEQ + t0 - NMETA;
                        float r_[8], w_[8], k_[8], a_[8], b_[8], v_[8];
#pragma unroll
                        for (int u = 0; u < 8; ++u) { const size_t idx = (size_t)(rowb + u) * 256 + cb; r_[u] = SR[idx + lane]; w_[u] = SW[idx + lane]; k_[u] = SK[idx + lane]; a_[u] = SA[idx + lane]; b_[u] = SB[idx + lane]; v_[u] = SV[idx + vv]; }
#pragma unroll
                        for (int u = 0; u < 8; ++u) { const float sa = wave_sum(S * a_[u]); S = S * w_[u] + sa * b_[u] + v_[u] * k_[u]; const float y = wave_sum(S * r_[u]);
                            if (lane == 0 && (t0 >= NMETA || b == 0)) SY[(size_t)(rowb + u) * 256 + cb + vv] = y; }
                    }
                }
            }
            __syncthreads();
            {
                LAS float* sc = (LAS float*)(lds + wave * 16896); LAS float* qs = sc + 4160;
                for (int task = gw; task < NTOK * 8; task += NGW) {
                    const int row = task >> 3, hc = task & 7, h = hc >> 1; const bool meta = row >= NREAL;
                    const int b = meta ? 0 : (row >> 12); const int nmeta = meta ? (row - NREAL + 1) : NMETA; const int nreal = meta ? 0 : ((row & (SEQ - 1)) + 1); const int n = nmeta + nreal;
                    const size_t kvb = (size_t)b * KVROWS;
                    qs[lane] = bf2f(QN[(size_t)row * 512 + hc * 64 + lane]);
                    float m = -INFINITY;
                    for (int i0 = 0; i0 < n; i0 += 64) { const int idx = i0 + lane;
                        if (idx < n) { const size_t kr = kvb + (idx < nmeta ? 48 + idx : 128 + idx - nmeta); const v4u* kp = (const v4u*)(KP + kr * 512 + hc * 64); float dot = 0.f;
#pragma unroll
                            for (int c8 = 0; c8 < 8; ++c8) { const v4u kv = kp[c8];
                                dot += qs[c8 * 8 + 0] * __uint_as_float(kv.x << 16) + qs[c8 * 8 + 1] * __uint_as_float(kv.x & 0xffff0000u) + qs[c8 * 8 + 2] * __uint_as_float(kv.y << 16) + qs[c8 * 8 + 3] * __uint_as_float(kv.y & 0xffff0000u)
                                     + qs[c8 * 8 + 4] * __uint_as_float(kv.z << 16) + qs[c8 * 8 + 5] * __uint_as_float(kv.z & 0xffff0000u) + qs[c8 * 8 + 6] * __uint_as_float(kv.w << 16) + qs[c8 * 8 + 7] * __uint_as_float(kv.w & 0xffff0000u); }
                            sc[idx] = dot; m = fmaxf(m, dot); } }
                    m = wave_max(m);
                    float l = 0.f;
                    for (int idx = lane; idx < n; idx += 64) { const float p = __builtin_amdgcn_exp2f(sc[idx] - m); sc[idx] = p; l += p; }
                    l = wave_sum(l);
                    float o0 = 0.f, o1 = 0.f;
                    for (int idx = 0; idx < n; ++idx) { const float p = sc[idx]; const size_t vr = kvb + (idx < nmeta ? 48 + idx : 128 + idx - nmeta);
                        const unsigned v2 = *(const unsigned*)(VP + vr * 512 + h * 128 + 2 * lane); o0 += p * __uint_as_float(v2 << 16); o1 += p * __uint_as_float(v2 & 0xffff0000u); }
                    const float inv = 1.f / l;
                    *(unsigned*)(OC + (size_t)row * 1024 + hc * 128 + 2 * lane) = pk2(o0 * inv, o1 * inv);
                    LDS_WAIT();
                }
            }
            SEAM(pb + 3);
        }
        if (EN(4) && IN(pb + 4)) { PH_TID;
            const float* gn_g = INP(13) + layer * 256; const float* gn_b = INP(14) + layer * 256; const float* subg = INP(21) + layer * 128;
            const float s1 = wave_sum(INP(17)[layer * 64 + lane] * INP(18)[layer * 64 + lane]); const float s2 = wave_sum(INP(19)[layer * 64 + lane] * INP(20)[layer * 64 + lane]);
            const float lam = __expf(s1) - __expf(s2) + lam_init;
            for (int row = gw; row < NTOK; row += NGW) {
                { const f32x4 y = *(const f32x4*)(SY + (size_t)row * 256 + 4 * lane); const float mean = sum16((y.x + y.y) + (y.z + y.w)) * (1.f / 64.f);
                  const f32x4 dlt = y - mean; const float var = sum16((dlt.x * dlt.x + dlt.y * dlt.y) + (dlt.z * dlt.z + dlt.w * dlt.w)) * (1.f / 64.f); const float rs = 1.f / sqrtf(var + 64e-5f);
                  const f32x4 gg = *(const f32x4*)(gn_g + 4 * lane), gb = *(const f32x4*)(gn_b + 4 * lane), bon = *(const f32x4*)(SBON + (size_t)row * 256 + 4 * lane), gt = *(const f32x4*)(SG + (size_t)row * 256 + 4 * lane);
                  const f32x4 o = (dlt * rs * gg + gb + bon) * gt;
                  *(unsigned long long*)(OMIX + (size_t)row * DM + 4 * lane) = (unsigned long long)pk2(o.x, o.y) | ((unsigned long long)pk2(o.z, o.w) << 32); }
                { const int h = lane >> 4, j8 = (lane & 15) * 8; const v4u a0 = *(const v4u*)(OC + (size_t)row * 1024 + (h * 2 + 0) * 128 + j8), a1 = *(const v4u*)(OC + (size_t)row * 1024 + (h * 2 + 1) * 128 + j8);
                  float dv[8];
                  dv[0] = __uint_as_float(a0.x << 16) - lam * __uint_as_float(a1.x << 16); dv[1] = __uint_as_float(a0.x & 0xffff0000u) - lam * __uint_as_float(a1.x & 0xffff0000u);
                  dv[2] = __uint_as_float(a0.y << 16) - lam * __uint_as_float(a1.y << 16); dv[3] = __uint_as_float(a0.y & 0xffff0000u) - lam * __uint_as_float(a1.y & 0xffff0000u);
                  dv[4] = __uint_as_float(a0.z << 16) - lam * __uint_as_float(a1.z << 16); dv[5] = __uint_as_float(a0.z & 0xffff0000u) - lam * __uint_as_float(a1.z & 0xffff0000u);
                  dv[6] = __uint_as_float(a0.w << 16) - lam * __uint_as_float(a1.w << 16); dv[7] = __uint_as_float(a0.w & 0xffff0000u) - lam * __uint_as_float(a1.w & 0xffff0000u);
                  float ss = 0.f;
#pragma unroll
                  for (int i = 0; i < 8; ++i) ss += dv[i] * dv[i];
                  ss = sum16(ss); const float sc_ = (1.f / sqrtf(ss * (1.f / 128.f) + 1e-5f)) * (1.f - lam_init);
                  const f32x4 g0 = *(const f32x4*)(subg + j8), g1 = *(const f32x4*)(subg + j8 + 4);
                  v4u o; o.x = pk2(dv[0] * sc_ * g0.x, dv[1] * sc_ * g0.y); o.y = pk2(dv[2] * sc_ * g0.z, dv[3] * sc_ * g0.w); o.z = pk2(dv[4] * sc_ * g1.x, dv[5] * sc_ * g1.y); o.w = pk2(dv[6] * sc_ * g1.z, dv[7] * sc_ * g1.w);
                  *(v4u*)(OMIX + (size_t)row * DM + 256 + h * 128 + j8) = o; }
            }
            { const int gt = bx * (NWAVES * 64) + tid, NGT = G * NWAVES * 64;
              for (int i = gt; i < (MPAD - NTOK) * (DM / 8); i += NGT) ((v4u*)(OMIX + (size_t)NTOK * DM))[i] = (v4u){0u, 0u, 0u, 0u}; }
            SEAM(pb + 4);
        }
        if (EN(5) && IN(pb + 5)) { PH_TID;
            pg8::Gemm g{OMIX, (const bf16*)(ws + WS_WOUT) + (size_t)layer * DM * DM, MPAD, DM, DM}; pg8::StaticOrder S; S.init(MPAD, DM, G, bx);
            pg8::EpiResAdd E{Hf, DM};
            pg8::gemm_phase<pg8::EpiResAdd, pg8::StaticOrder, true, true>(lds, g, S, E);
            SEAM(pb + 5);
        }
        if (EN(6) && IN(pb + 6)) { PH_TID;
            LAS int* lcnt = (LAS int*)lds; LAS int* lbase = lcnt + 8; LAS int* lrow = lcnt + 16;
            if (tid < 16) lcnt[tid] = 0;
            __syncthreads();
            const float* gff = INP(24) + layer * DM; const float* Wr = INP(28) + (size_t)jj * DM * NE;
            for (int i = wave; i < 72; i += NWAVES) { const int row = bx + G * i;
                if (row < NTOK) {
                    const GAS f32x4* xr = (const GAS f32x4*)(Hf + (size_t)row * DM) + lane; f32x4 v[4]; float s = 0.f;
#pragma unroll
                    for (int j = 0; j < 4; ++j) { v[j] = xr[64 * j]; s += (v[j].x * v[j].x + v[j].y * v[j].y) + (v[j].z * v[j].z + v[j].w * v[j].w); }
                    s = wave_sum(s); const float rstd = 1.f / sqrtf(s * (1.f / DM) + 1e-6f);
                    GAS unsigned long long* o8 = (GAS unsigned long long*)(HB + (size_t)row * DM) + lane;
#pragma unroll
                    for (int j = 0; j < 4; ++j) o8[64 * j] = (unsigned long long)pk2(v[j].x, v[j].y) | ((unsigned long long)pk2(v[j].z, v[j].w) << 32);
                    if (lane == 0) RSTD[row] = rstd;
                    if (moe) {
                        float lg[8];
#pragma unroll
                        for (int e = 0; e < 8; ++e) lg[e] = 0.f;
#pragma unroll
                        for (int j = 0; j < 4; ++j) { const int k0 = 4 * lane + 256 * j; const f32x4 gv = *(const f32x4*)(gff + k0);
#pragma unroll
                            for (int q = 0; q < 4; ++q) { const float hv = v[j][q] * gv[q]; const f32x4 wa = *(const f32x4*)(Wr + (size_t)(k0 + q) * 8), wb = *(const f32x4*)(Wr + (size_t)(k0 + q) * 8 + 4);
                                lg[0] += hv * wa.x; lg[1] += hv * wa.y; lg[2] += hv * wa.z; lg[3] += hv * wa.w; lg[4] += hv * wb.x; lg[5] += hv * wb.y; lg[6] += hv * wb.z; lg[7] += hv * wb.w; } }
#pragma unroll
                        for (int e = 0; e < 8; ++e) lg[e] = wave_sum(lg[e]) * rstd;
                        int e1 = 0; float l1 = lg[0];
#pragma unroll
                        for (int e = 1; e < 8; ++e) if (lg[e] > l1) { l1 = lg[e]; e1 = e; }
                        int e2 = -1; float l2 = -INFINITY;
#pragma unroll
                        for (int e = 0; e < 8; ++e) if (e != e1 && lg[e] > l2) { l2 = lg[e]; e2 = e; }
                        if (lane == 0) { const float g2 = 1.f / (1.f + __expf(l1 - l2)); const float g1 = 1.f - g2;
                            const int sl1 = atomicAdd((int*)&lcnt[e1], 1), sl2 = atomicAdd((int*)&lcnt[e2], 1);
                            lrow[i * 4 + 0] = e1; lrow[i * 4 + 1] = sl1; lrow[i * 4 + 2] = e2; lrow[i * 4 + 3] = sl2;
                            TOKG[row * 2 + 0] = g1; TOKG[row * 2 + 1] = g2; }
                    }
                }
            }
            if (moe) {
                __syncthreads();
                if (tid < 8) lbase[tid] = (int)__hip_atomic_fetch_add((unsigned*)(ctl + CW_MOECNT + 64 * jj + tid), (unsigned)lcnt[tid], RLX_AGENT);
                __syncthreads();
                if (tid < 72) { const int row = bx + G * tid; if (row < NTOK) { const int e1 = lrow[tid * 4 + 0], e2 = lrow[tid * 4 + 2];
                    TOKE[row * 2 + 0] = e1; TOKE[row * 2 + 1] = e2; TOKS[row * 2 + 0] = lbase[e1] + lrow[tid * 4 + 1]; TOKS[row * 2 + 1] = lbase[e2] + lrow[tid * 4 + 3]; } }
                __syncthreads();
            }
            SEAM(pb + 6);
        }
        if (!moe) {
            if (EN(7) && IN(pb + 7)) { PH_TID;
                pg8::Gemm g{HB, (const bf16*)(ws + WS_WGU) + (size_t)jj * FF2 * DM, MPAD, FF2, DM}; pg8::StaticOrder S; S.init(MPAD, FF2, G, bx);
                pg8::EpiSwiglu E{GB, FF, RSTD};
                pg8::gemm_phase<pg8::EpiSwiglu, pg8::StaticOrder, true, true>(lds, g, S, E);
                SEAM(pb + 7);
            }
            if (EN(8) && IN(pb + 8)) { PH_TID;
                pg8::Gemm g{GB, (const bf16*)(ws + WS_WD) + (size_t)jj * DM * FF, MPAD, DM, FF}; pg8::StaticOrder S; S.init(MPAD, DM, G, bx);
                pg8::EpiResAdd E{Hf, DM};
                pg8::gemm_phase<pg8::EpiResAdd, pg8::StaticOrder, true, true>(lds, g, S, E);
                SEAM(pb + 8);
            }
        } else {
#define cnt ((const int*)(ctl + CW_MOECNT + 64 * jj))
            if (EN(7) && IN(pb + 7)) { PH_TID;
                int ts[8]; { int a = 0;
#pragma unroll
                    for (int e = 0; e < 8; ++e) { ts[e] = a; a += (__hip_atomic_load(cnt + e, RLX_AGENT) + 255) >> 8; } }
                for (int pr2 = gw; pr2 < NTOK * 2; pr2 += NGW) { const int row = pr2 >> 1; const int e = TOKE[pr2], s = TOKS[pr2];
                    int tse = 0;
#pragma unroll
                    for (int q = 0; q < 8; ++q) tse = (e == q) ? ts[q] : tse;
                    const size_t p = (size_t)tse * 256 + s;
                    const v4u* src = (const v4u*)(HB + (size_t)row * DM); v4u* dst = (v4u*)(AROWS + p * DM); dst[lane] = src[lane]; dst[lane + 64] = src[lane + 64];
                    if (lane == 0) RSROW[p] = RSTD[row]; }
                SEAM(pb + 7);
            }
            if (EN(8) && IN(pb + 8)) { PH_TID;
                pg8::Gemm g{AROWS, (const bf16*)(ws + WS_MWGU), MOEP, FF2, DM}; pg8::MoeOrder S; S.init(cnt, FF2 / 256, G, bx);
                pg8::EpiSwiglu E{GB, FF, RSROW};
                pg8::gemm_phase<pg8::EpiSwiglu, pg8::MoeOrder, true, true>(lds, g, S, E);
                SEAM(pb + 8);
            }
            if (EN(9) && IN(pb + 9)) { PH_TID;
                pg8::Gemm g{GB, (const bf16*)(ws + WS_MWD), MOEP, DM, FF}; pg8::MoeOrder S; S.init(cnt, DM / 256, G, bx);
                pg8::EpiBf16Rs E{YM, DM, nullptr};
                pg8::gemm_phase<pg8::EpiBf16Rs, pg8::MoeOrder, true, true>(lds, g, S, E);
                SEAM(pb + 9);
            }
            if (EN(10) && IN(pb + 10)) { PH_TID;
                int ts[8]; { int a = 0;
#pragma unroll
                    for (int e = 0; e < 8; ++e) { ts[e] = a; a += (__hip_atomic_load(cnt + e, RLX_AGENT) + 255) >> 8; } }
                for (int row = gw; row < NTOK; row += NGW) {
                    const int e1 = TOKE[row * 2], e2 = TOKE[row * 2 + 1]; int t1 = 0, t2 = 0;
#pragma unroll
                    for (int q = 0; q < 8; ++q) { t1 = (e1 == q) ? ts[q] : t1; t2 = (e2 == q) ? ts[q] : t2; }
                    const size_t p1 = (size_t)t1 * 256 + TOKS[row * 2], p2 = (size_t)t2 * 256 + TOKS[row * 2 + 1]; const float g1 = TOKG[row * 2], g2 = TOKG[row * 2 + 1];
                    float* hr = Hf + (size_t)row * DM;
#pragma unroll
                    for (int j = 0; j < 2; ++j) { const int c8 = (lane + 64 * j) * 8; const v4u y1 = *(const v4u*)(YM + p1 * DM + c8), y2 = *(const v4u*)(YM + p2 * DM + c8);
                        f32x4 ha = *(f32x4*)(hr + c8), hb2 = *(f32x4*)(hr + c8 + 4);
                        ha.x += g1 * __uint_as_float(y1.x << 16) + g2 * __uint_as_float(y2.x << 16); ha.y += g1 * __uint_as_float(y1.x & 0xffff0000u) + g2 * __uint_as_float(y2.x & 0xffff0000u);
                        ha.z += g1 * __uint_as_float(y1.y << 16) + g2 * __uint_as_float(y2.y << 16); ha.w += g1 * __uint_as_float(y1.y & 0xffff0000u) + g2 * __uint_as_float(y2.y & 0xffff0000u);
                        hb2.x += g1 * __uint_as_float(y1.z << 16) + g2 * __uint_as_float(y2.z << 16); hb2.y += g1 * __uint_as_float(y1.z & 0xffff0000u) + g2 * __uint_as_float(y2.z & 0xffff0000u);
                        hb2.z += g1 * __uint_as_float(y1.w << 16) + g2 * __uint_as_float(y2.w << 16); hb2.w += g1 * __uint_as_float(y1.w & 0xffff0000u) + g2 * __uint_as_float(y2.w & 0xffff0000u);
                        *(f32x4*)(hr + c8) = ha; *(f32x4*)(hr + c8 + 4) = hb2; }
                }
                SEAM(pb + 10);
            }
        }
    }
    if (IN(49)) { PH_TID;
        const int gt = bx * (NWAVES * 64) + tid, NGT = G * NWAVES * 64;
        for (int i = gt; i < NREAL * (DM / 4); i += NGT) ((f32x4*)(*(float* const*)(ka + 256)))[i] = ((const f32x4*)Hf)[i];
    }
#undef IN
#undef SEAM
}

#ifndef MK_ONE_LAUNCH
#define MK_ONE_LAUNCH 0
#endif
extern "C" void kernel_launch(void* const* d_in, const int* in_sizes, int n_in, void* d_out, int out_size, void* d_ws, size_t ws_size, hipStream_t stream) {
    static int grid = 0;
    if (grid == 0) {
        if (n_in != 32 || out_size != NREAL * DM || ws_size < WS_END) { fprintf(stderr, "kernel_launch: unexpected shapes (n_in %d out %d ws %zu need %zu); nothing launched\n", n_in, out_size, ws_size, (size_t)WS_END); grid = -1; return; }
        int dev = 0, cus = 0, per_cu = 0;
        if (hipGetDevice(&dev) != hipSuccess || hipDeviceGetAttribute(&cus, hipDeviceAttributeMultiprocessorCount, dev) != hipSuccess) { grid = -1; return; }
        if (hipFuncSetAttribute((const void*)hymba_fwd, hipFuncAttributeMaxDynamicSharedMemorySize, LDS_BYTES) != hipSuccess) { fprintf(stderr, "kernel_launch: hipFuncSetAttribute failed\n"); grid = -1; return; }
        if (hipOccupancyMaxActiveBlocksPerMultiprocessor(&per_cu, (const void*)hymba_fwd, NWAVES * 64, LDS_BYTES) != hipSuccess || per_cu < 1) fprintf(stderr, "kernel_launch: occupancy query says %d\n", per_cu);
        (void)hipGetLastError();
        grid = cus;
    }
    if (grid < 0) return;
    if (hipMemsetAsync((char*)d_ws + WS_CTL, 0, CTL_ZERO_BYTES, stream) != hipSuccess) return;
    Args a{};
    for (int i = 0; i < 32; ++i) a.in[i] = (const float*)d_in[i];
    a.out = (float*)d_out; a.ws = (unsigned char*)d_ws;
#if MK_ONE_LAUNCH
    a.ph_lo = 0; a.ph_hi = 50;
    hipLaunchKernelGGL(hymba_fwd, dim3(grid), dim3(NWAVES * 64), LDS_BYTES, stream, a);
#else
    for (int ph = 0; ph < 50; ++ph) {
        if (ph >= 1 && ph <= 48) { const int l = (ph - 1) / 12, k = (ph - 1) % 12; const bool moe = l & 1; if (k == 11 || (!moe && k >= 9)) continue; }
        a.ph_lo = ph; a.ph_hi = ph + 1;
        hipLaunchKernelGGL(hymba_fwd, dim3(grid), dim3(NWAVES * 64), LDS_BYTES, stream, a);
    }
#endif
}
```

```cpp
#include <hip/hip_runtime.h>
#include <hip/hip_bf16.h>
#include <cmath>
#include <cstdio>
#include <cstdint>
namespace pg8 {
#define PG8_LAS __attribute__((address_space(3)))
typedef unsigned short bf16_t;
typedef short bf16x8 __attribute__((ext_vector_type(8)));
typedef float f32x4 __attribute__((ext_vector_type(4)));
typedef float f32x2 __attribute__((ext_vector_type(2)));
typedef unsigned u32x4 __attribute__((ext_vector_type(4)));
constexpr int BM = 256, BK = 64, HALF = 128, HTB = HALF * BK * 2  , STAGE_BYTES = 8 * HTB, NXCD = 8, WGM = 8;

__host__ __device__ __forceinline__ int lds_byte(int r, int c) { const int st = (r >> 4) * 2 + (c >> 5), rr = r & 15, cc = c & 31, ob = rr * 64 + cc * 2; return st * 1024 + (ob ^ (((ob >> 9) & 1) << 5)); }
__host__ __device__ __forceinline__ void stage_rc(int b, int& R, int& C) { const int st = b / 1024, sb = b % 1024, swz = sb ^ (((sb >> 9) & 1) << 5); R = (st >> 1) * 16 + swz / 64; C = (st & 1) * 32 + (swz % 64) / 2; }
__host__ __device__ __forceinline__ int perm32(int rho) { const int n = rho >> 4, i = rho & 15; return 8 * (i >> 2) + 4 * n + (i & 3); }

struct Unit { int pm, pn, pc; };
struct Gemm { const bf16_t* A; const bf16_t* Bt; int M, N, K; };

struct StaticOrder {
    int nM, nN, nwg, G, c;
    __host__ __device__ void init(int M, int N, int G_, int c_) { nM = M / BM; nN = N / BM; nwg = nM * nN; G = G_; c = c_; }
    __host__ __device__ bool next(int i, Unit& u) const {
        const long L = (long)i * G + c; if (L >= nwg) return false;
        int wgid = (int)L; { const int q = nwg / NXCD, r = nwg % NXCD, xcd = wgid % NXCD, off = wgid / NXCD; wgid = (xcd < r ? xcd * (q + 1) : r * (q + 1) + (xcd - r) * q) + off; }
        const int nig = WGM * nN, gid = wgid / nig, fm = gid * WGM, gsz = (nM - fm) < WGM ? (nM - fm) : WGM;
        u.pm = fm + ((wgid % nig) % gsz); u.pn = (wgid % nig) / gsz; u.pc = u.pn; return true;
    }
    __device__ __forceinline__ void a_ready(const Unit&) const {}
    __device__ __forceinline__ void done(const Unit&) const {}
};
struct MoeOrder {
    int G, c, nN, total; int t1, t2, t3, t4, t5, t6, t7;
    __device__ __forceinline__ void init(const int* cnt, int nN_, int G_, int c_) {
        G = G_; c = c_; nN = nN_; int a = 0;
        a += (__builtin_amdgcn_readfirstlane(__hip_atomic_load(cnt + 0, __ATOMIC_RELAXED, __HIP_MEMORY_SCOPE_AGENT)) + 255) >> 8; t1 = a;
        a += (__builtin_amdgcn_readfirstlane(__hip_atomic_load(cnt + 1, __ATOMIC_RELAXED, __HIP_MEMORY_SCOPE_AGENT)) + 255) >> 8; t2 = a;
        a += (__builtin_amdgcn_readfirstlane(__hip_atomic_load(cnt + 2, __ATOMIC_RELAXED, __HIP_MEMORY_SCOPE_AGENT)) + 255) >> 8; t3 = a;
        a += (__builtin_amdgcn_readfirstlane(__hip_atomic_load(cnt + 3, __ATOMIC_RELAXED, __HIP_MEMORY_SCOPE_AGENT)) + 255) >> 8; t4 = a;
        a += (__builtin_amdgcn_readfirstlane(__hip_atomic_load(cnt + 4, __ATOMIC_RELAXED, __HIP_MEMORY_SCOPE_AGENT)) + 255) >> 8; t5 = a;
        a += (__builtin_amdgcn_readfirstlane(__hip_atomic_load(cnt + 5, __ATOMIC_RELAXED, __HIP_MEMORY_SCOPE_AGENT)) + 255) >> 8; t6 = a;
        a += (__builtin_amdgcn_readfirstlane(__hip_atomic_load(cnt + 6, __ATOMIC_RELAXED, __HIP_MEMORY_SCOPE_AGENT)) + 255) >> 8; t7 = a;
        a += (__builtin_amdgcn_readfirstlane(__hip_atomic_load(cnt + 7, __ATOMIC_RELAXED, __HIP_MEMORY_SCOPE_AGENT)) + 255) >> 8;
        total = a * nN;
    }
    __device__ __forceinline__ bool next(int i, Unit& u) const {
        const int x = c & 7, per = G >> 3; const int e_ = i * per + (c >> 3);
        const int ntile = total / nN; const int mine = (ntile - x + 7) >> 3;
        if (e_ >= mine * nN) return false;
        const int rt = x + 8 * (e_ / nN), j = e_ % nN;
        const int e = (rt >= t1) + (rt >= t2) + (rt >= t3) + (rt >= t4) + (rt >= t5) + (rt >= t6) + (rt >= t7);
        u.pm = rt; u.pn = e * nN + j; u.pc = j; return true;
    }
    __device__ __forceinline__ void a_ready(const Unit&) const {}
    __device__ __forceinline__ void done(const Unit&) const {}
};

__device__ __forceinline__ unsigned cvt_pk_bf16(float lo, float hi) { unsigned r; asm volatile("v_cvt_pk_bf16_f32 %0, %1, %2" : "=v"(r) : "v"(lo), "v"(hi)); return r; }

#define PG8_GAS __attribute__((address_space(1)))
struct EpiBf16Rs {
    static constexpr bool PERM = true, AFTER_DRAIN = false;
    bf16_t* O; int ldc; const float* rs; float sc; const unsigned long long* rsq;
    __device__ __forceinline__ void operator()(const f32x4 (&acc)[2][2][4][2], const Unit& u, int wr, int wc, int fr, int fq) const {
        const int row0 = u.pm * BM + wr * 64 + fr; const int col0 = u.pc * BM + wc * 32 + 8 * fq;
        float sv[2][4];
#pragma unroll
        for (int ai = 0; ai < 2; ++ai)
#pragma unroll
            for (int m = 0; m < 4; ++m) sv[ai][m] = rsq ? sc * __builtin_amdgcn_rsqf((float)((const PG8_GAS unsigned long long*)rsq)[row0 + ai * HALF + m * 16] * (1.f / (16777216.f * 1024.f)) + 1e-6f) : (rs ? ((const PG8_GAS float*)rs)[row0 + ai * HALF + m * 16] : sc);
#pragma unroll
        for (int ai = 0; ai < 2; ++ai)
#pragma unroll
            for (int m = 0; m < 4; ++m) { const int row = row0 + ai * HALF + m * 16; const float s = sv[ai][m]; PG8_GAS bf16_t* rowp = (PG8_GAS bf16_t*)O + (size_t)row * ldc + col0;
#pragma unroll
                for (int bj = 0; bj < 2; ++bj) { const f32x4 v0 = acc[ai][bj][m][0] * s, v1 = acc[ai][bj][m][1] * s;
                    u32x4 w; w.x = cvt_pk_bf16(v0[0], v0[1]); w.y = cvt_pk_bf16(v0[2], v0[3]); w.z = cvt_pk_bf16(v1[0], v1[1]); w.w = cvt_pk_bf16(v1[2], v1[3]);
                    *(PG8_GAS u32x4*)(rowp + bj * HALF) = w; } }
    }
};
struct EpiResAdd {
    static constexpr bool PERM = false, AFTER_DRAIN = false;
    float* H; int ldc; float sc;
    __device__ __forceinline__ void operator()(const f32x4 (&acc)[2][2][4][2], const Unit& u, int wr, int wc, int fr, int fq) const {
        const int row0 = u.pm * BM + wr * 64 + fr; const int col0 = u.pc * BM + wc * 32 + 4 * fq;
#pragma unroll
        for (int ai = 0; ai < 2; ++ai)
#pragma unroll
            for (int mp = 0; mp < 2; ++mp) {
                f32x4 res[2][2][2];
#pragma unroll
                for (int m2 = 0; m2 < 2; ++m2) { const PG8_GAS float* rowp = (const PG8_GAS float*)H + (size_t)(row0 + ai * HALF + (2 * mp + m2) * 16) * ldc + col0;
#pragma unroll
                    for (int bj = 0; bj < 2; ++bj)
#pragma unroll
                        for (int n = 0; n < 2; ++n) res[m2][bj][n] = *(const PG8_GAS f32x4*)(rowp + bj * HALF + n * 16); }
#pragma unroll
                for (int m2 = 0; m2 < 2; ++m2) { PG8_GAS float* rowp = (PG8_GAS float*)H + (size_t)(row0 + ai * HALF + (2 * mp + m2) * 16) * ldc + col0;
#pragma unroll
                    for (int bj = 0; bj < 2; ++bj)
#pragma unroll
                        for (int n = 0; n < 2; ++n) *(PG8_GAS f32x4*)(rowp + bj * HALF + n * 16) = res[m2][bj][n] + acc[ai][bj][2 * mp + m2][n] * sc; }
                asm volatile("" ::: "memory");
            }
    }
};
template <int MODE, long long HB_OFF, long long RSQ_OFF> struct EpiResAddHB {
    static constexpr bool PERM = true, AFTER_DRAIN = false; static constexpr float hs = 4.f;
    float* H; int ldc; float sc;
    __device__ __forceinline__ void operator()(const f32x4 (&acc)[2][2][4][2], const Unit& u, int wr, int wc, int fr, int fq) const {
        const int row0 = u.pm * BM + wr * 64 + fr; const int col0 = u.pc * BM + wc * 32 + 8 * fq;
        PG8_GAS unsigned char* const HBo = (PG8_GAS unsigned char*)H + HB_OFF; PG8_GAS unsigned long long* const rsq = (PG8_GAS unsigned long long*)((PG8_GAS unsigned char*)H + RSQ_OFF);
#pragma unroll
        for (int ai = 0; ai < 2; ++ai)
#pragma unroll
            for (int m = 0; m < 4; ++m) { const int row = row0 + ai * HALF + m * 16; PG8_GAS float* rowp = (PG8_GAS float*)H + (size_t)row * ldc + col0;
                f32x4 r_[2][2];
#pragma unroll
                for (int bj = 0; bj < 2; ++bj)
#pragma unroll
                    for (int n = 0; n < 2; ++n) r_[bj][n] = *(const PG8_GAS f32x4*)(rowp + bj * HALF + n * 4);
                float ss = 0.f;
#pragma unroll
                for (int bj = 0; bj < 2; ++bj) { const f32x4 v0 = r_[bj][0] + acc[ai][bj][m][0] * sc, v1 = r_[bj][1] + acc[ai][bj][m][1] * sc;
                    *(PG8_GAS f32x4*)(rowp + bj * HALF) = v0; *(PG8_GAS f32x4*)(rowp + bj * HALF + 4) = v1;
                    ss += ((v0[0] * v0[0] + v0[1] * v0[1]) + (v0[2] * v0[2] + v0[3] * v0[3])) + ((v1[0] * v1[0] + v1[1] * v1[1]) + (v1[2] * v1[2] + v1[3] * v1[3]));
                    if constexpr (MODE == 1) { u32x4 w; w.x = cvt_pk_bf16(v0[0], v0[1]); w.y = cvt_pk_bf16(v0[2], v0[3]); w.z = cvt_pk_bf16(v1[0], v1[1]); w.w = cvt_pk_bf16(v1[2], v1[3]);
                        *(PG8_GAS u32x4*)((PG8_GAS bf16_t*)HBo + (size_t)row * ldc + col0 + bj * HALF) = w; }
                    else {
#define PG8_C8(x) __builtin_amdgcn_fmed3f((x) * hs, -448.f, 448.f)
                        unsigned lo = (unsigned)__builtin_amdgcn_cvt_pk_fp8_f32(PG8_C8(v0[0]), PG8_C8(v0[1]), 0, false); lo = (unsigned)__builtin_amdgcn_cvt_pk_fp8_f32(PG8_C8(v0[2]), PG8_C8(v0[3]), (int)lo, true);
                        unsigned hi = (unsigned)__builtin_amdgcn_cvt_pk_fp8_f32(PG8_C8(v1[0]), PG8_C8(v1[1]), 0, false); hi = (unsigned)__builtin_amdgcn_cvt_pk_fp8_f32(PG8_C8(v1[2]), PG8_C8(v1[3]), (int)hi, true);
#undef PG8_C8
                        *(PG8_GAS unsigned long long*)(HBo + (size_t)row * ldc + col0 + bj * HALF) = (unsigned long long)lo | ((unsigned long long)hi << 32); } }
                { auto p_ = __builtin_amdgcn_permlane16_swap(__float_as_uint(ss), __float_as_uint(ss), false, false); ss = __uint_as_float(p_[0]) + __uint_as_float(p_[1]); }
                { auto p_ = __builtin_amdgcn_permlane32_swap(__float_as_uint(ss), __float_as_uint(ss), false, false); ss = __uint_as_float(p_[0]) + __uint_as_float(p_[1]); }
                if (fq == 0) __hip_atomic_fetch_add(rsq + row, (unsigned long long)(ss * 16777216.f), __ATOMIC_RELAXED, __HIP_MEMORY_SCOPE_AGENT);
                asm volatile("" ::: "memory"); }
    }
};
template <bool OUT8> struct EpiSwigluT {
    static constexpr bool PERM = true, AFTER_DRAIN = false;
    bf16_t* O; int ldc; const float* rs; float sc; float o8; const unsigned long long* rsq;
    __device__ __forceinline__ void operator()(const f32x4 (&acc)[2][2][4][2], const Unit& u, int wr, int wc, int fr, int fq) const {
        const int row0 = u.pm * BM + wr * 64 + fr; const int col0 = u.pc * HALF + wc * 32 + 8 * fq;
        float sv[2][4];
#pragma unroll
        for (int ai = 0; ai < 2; ++ai)
#pragma unroll
            for (int m = 0; m < 4; ++m) sv[ai][m] = rsq ? sc * __builtin_amdgcn_rsqf((float)((const PG8_GAS unsigned long long*)rsq)[row0 + ai * HALF + m * 16] * (1.f / (16777216.f * 1024.f)) + 1e-6f) : (rs ? ((const PG8_GAS float*)rs)[row0 + ai * HALF + m * 16] : sc);
#pragma unroll
        for (int ai = 0; ai < 2; ++ai)
#pragma unroll
            for (int m = 0; m < 4; ++m) { const int row = row0 + ai * HALF + m * 16; const float s = sv[ai][m]; PG8_GAS bf16_t* rowp = (PG8_GAS bf16_t*)O + (size_t)row * ldc + col0;
                const float c1 = -1.4426950408889634f * s, c2 = OUT8 ? s * s * o8 : s * s;
                f32x2 q[4];
#pragma unroll
                for (int n = 0; n < 2; ++n)
#pragma unroll
                    for (int h = 0; h < 2; ++h) { const f32x4 av = acc[ai][0][m][n], bv = acc[ai][1][m][n];
                        const f32x2 a = h ? (f32x2){av[2], av[3]} : (f32x2){av[0], av[1]}, b = h ? (f32x2){bv[2], bv[3]} : (f32x2){bv[0], bv[1]};
                        const f32x2 t = a * c1; f32x2 e; e.x = __builtin_amdgcn_exp2f(t.x); e.y = __builtin_amdgcn_exp2f(t.y);
                        const f32x2 d = e + 1.f; f32x2 r; r.x = __builtin_amdgcn_rcpf(d.x); r.y = __builtin_amdgcn_rcpf(d.y);
                        q[2 * n + h] = ((a * b) * r) * c2; }
                if constexpr (OUT8) { PG8_GAS unsigned char* rp8 = (PG8_GAS unsigned char*)O + (size_t)row * ldc + col0;
#define PG8_C8(x) __builtin_amdgcn_fmed3f((x), -448.f, 448.f)
                    unsigned lo = (unsigned)__builtin_amdgcn_cvt_pk_fp8_f32(PG8_C8(q[0].x), PG8_C8(q[0].y), 0, false); lo = (unsigned)__builtin_amdgcn_cvt_pk_fp8_f32(PG8_C8(q[1].x), PG8_C8(q[1].y), (int)lo, true);
                    unsigned hi = (unsigned)__builtin_amdgcn_cvt_pk_fp8_f32(PG8_C8(q[2].x), PG8_C8(q[2].y), 0, false); hi = (unsigned)__builtin_amdgcn_cvt_pk_fp8_f32(PG8_C8(q[3].x), PG8_C8(q[3].y), (int)hi, true);
#undef PG8_C8
                    *(PG8_GAS unsigned long long*)rp8 = (unsigned long long)lo | ((unsigned long long)hi << 32); }
                else { u32x4 w; w.x = cvt_pk_bf16(q[0].x, q[0].y); w.y = cvt_pk_bf16(q[1].x, q[1].y); w.z = cvt_pk_bf16(q[2].x, q[2].y); w.w = cvt_pk_bf16(q[3].x, q[3].y);
                    *(PG8_GAS u32x4*)rowp = w; } }
    }
};
typedef EpiSwigluT<false> EpiSwiglu; typedef EpiSwigluT<true> EpiSwiglu8;

template <class Epi, class Sched, bool ALIGN_EPI = false, bool SP2 = false, bool FP8 = false>
__device__ __forceinline__ void gemm_phase(PG8_LAS unsigned char* lds, const Gemm g, const Sched& S, const Epi& E, int tid_in) {
    int tid_ = tid_in; asm volatile("" : "+v"(tid_));
    const int tid = tid_, wid = __builtin_amdgcn_readfirstlane(tid >> 6), lane = tid & 63, wr = wid >> 2, wc = wid & 3, fr = lane & 15, fq = lane >> 4;
    const int K = g.K, nt = K / BK;
    unsigned voffA[2], voffB[2];
#pragma unroll
    for (int i = 0; i < 2; ++i) { int R, C; stage_rc(tid * 16 + i * 8192, R, C); const int Rb = Epi::PERM ? ((R & ~31) + perm32(R & 31)) : R;
        voffA[i] = (unsigned)(R * K + C) * 2u; voffB[i] = (unsigned)(Rb * K + C) * 2u; }
    const size_t kstep = (size_t)(BK * 2);
    const size_t hstep = (size_t)HALF * K * 2;
    const size_t tstep = 2 * hstep;
    const unsigned ldsw = (unsigned)wid * 1024u;
    const int aoff = lds_byte(wr * 64 + fr, fq * 8), boff = lds_byte(wc * 32 + fr, fq * 8);
#define PG8_SA(b, h) (((b) * 2 + (h)) * HTB)
#define PG8_SB(b, h) ((4 + (b) * 2 + (h)) * HTB)
#define PG8_STAGE(bufoff, gbase, voff) do { _Pragma("unroll") for (int _i = 0; _i < 2; ++_i) \
        __builtin_amdgcn_global_load_lds((const unsigned*)((const char*)(gbase) + (voff)[_i]), (PG8_LAS unsigned*)(lds + (bufoff) + ldsw + _i * 8192), 16, 0, 0); } while (0)
#define PG8_LDA(dst, b, h) do { _Pragma("unroll") for (int m = 0; m < 4; ++m) _Pragma("unroll") for (int k = 0; k < 2; ++k) dst[m][k] = *(const PG8_LAS bf16x8*)(lds + PG8_SA(b, h) + aoff + m * 2048 + k * 1024); } while (0)
#define PG8_LDB(dst, b, h) do { _Pragma("unroll") for (int n = 0; n < 2; ++n) _Pragma("unroll") for (int k = 0; k < 2; ++k) dst[n][k] = *(const PG8_LAS bf16x8*)(lds + PG8_SB(b, h) + boff + n * 2048 + k * 1024); } while (0)
#define PG8_MMA(ai, bj, At, Bt) do { __builtin_amdgcn_s_setprio(1); \
        if constexpr (FP8) { typedef int v8i_ __attribute__((ext_vector_type(8))); typedef int v4i_ __attribute__((ext_vector_type(4))); const int sc8_ = 0x7f7f7f7f;     \
            _Pragma("unroll") for (int m = 0; m < 4; ++m) _Pragma("unroll") for (int n = 0; n < 2; ++n) { \
                const v4i_ b0_ = __builtin_bit_cast(v4i_, Bt[n][0]), b1_ = __builtin_bit_cast(v4i_, Bt[n][1]), a0_ = __builtin_bit_cast(v4i_, At[m][0]), a1_ = __builtin_bit_cast(v4i_, At[m][1]); \
                const v8i_ bb_ = (v8i_){b0_.x, b0_.y, b0_.z, b0_.w, b1_.x, b1_.y, b1_.z, b1_.w}, aa_ = (v8i_){a0_.x, a0_.y, a0_.z, a0_.w, a1_.x, a1_.y, a1_.z, a1_.w}; \
                asm volatile("v_mfma_scale_f32_16x16x128_f8f6f4 %0, %1, %2, %0, %3, %3 op_sel_hi:[0,0,0]" : "+v"(acc[ai][bj][m][n]) : "v"(bb_), "v"(aa_), "v"(sc8_)); } \
        } else { _Pragma("unroll") for (int m = 0; m < 4; ++m) _Pragma("unroll") for (int n = 0; n < 2; ++n) _Pragma("unroll") for (int k = 0; k < 2; ++k) \
            acc[ai][bj][m][n] = __builtin_amdgcn_mfma_f32_16x16x32_bf16(Bt[n][k], At[m][k], acc[ai][bj][m][n], 0, 0, 0); } \
        __builtin_amdgcn_s_setprio(0); } while (0)
#define PG8_WAIT_V(n) asm volatile("s_waitcnt vmcnt(" #n ")" ::: "memory")
#define PG8_WAIT_L(n) asm volatile("s_waitcnt lgkmcnt(" #n ")" ::: "memory")
#define PG8_BAR __builtin_amdgcn_s_barrier()
#define PG8_SCHED __builtin_amdgcn_sched_barrier(0)
    Unit cur, nxt; int ui = 0;
    if (!S.next(0, cur)) return;
    f32x4 acc[2][2][4][2];
    { float zf; asm volatile("v_mov_b32 %0, 0" : "=v"(zf));
#pragma unroll
    for (int a = 0; a < 2; ++a)
#pragma unroll
        for (int b = 0; b < 2; ++b)
#pragma unroll
            for (int m = 0; m < 4; ++m)
#pragma unroll
                for (int n = 0; n < 2; ++n) acc[a][b][m][n] = (f32x4){zf, zf, zf, zf}; }
    bf16x8 At[4][2], B0[2][2], B1[2][2];
    const char* cA = (const char*)g.A + (size_t)cur.pm * tstep; const char* cB = (const char*)g.Bt + (size_t)cur.pn * tstep;
    S.a_ready(cur);
    if constexpr (SP2) {
        PG8_STAGE(PG8_SB(0, 0), cB, voffB); PG8_STAGE(PG8_SB(0, 1), cB + hstep, voffB); PG8_STAGE(PG8_SA(0, 0), cA, voffA); PG8_STAGE(PG8_SA(0, 1), cA + hstep, voffA);
        if (wr == 1) PG8_BAR;
        PG8_WAIT_V(2); PG8_BAR;
        PG8_STAGE(PG8_SB(1, 0), cB + kstep, voffB); PG8_STAGE(PG8_SA(1, 0), cA + kstep, voffA); PG8_STAGE(PG8_SB(1, 1), cB + hstep + kstep, voffB);
        PG8_WAIT_V(6); PG8_BAR;
    } else {
        PG8_STAGE(PG8_SB(0, 0), cB, voffB); PG8_STAGE(PG8_SA(0, 0), cA, voffA); PG8_STAGE(PG8_SB(0, 1), cB + hstep, voffB); PG8_STAGE(PG8_SA(0, 1), cA + hstep, voffA);
        if (wr == 1) PG8_BAR;
        PG8_WAIT_V(4); PG8_BAR;
        PG8_STAGE(PG8_SB(1, 0), cB + kstep, voffB); PG8_STAGE(PG8_SA(1, 0), cA + kstep, voffA); PG8_STAGE(PG8_SB(1, 1), cB + hstep + kstep, voffB);
        PG8_WAIT_V(6); PG8_BAR;
    }
    for (;;) {
        const bool has_next = S.next(ui + 1, nxt);
        const char* nA = has_next ? (const char*)g.A + (size_t)nxt.pm * tstep : cA; const char* nB = has_next ? (const char*)g.Bt + (size_t)nxt.pn * tstep : cB;
        for (int t = 0; t < nt; t += 2) {
            const bool last = (t == nt - 2);
            const char* a1 = cA + (size_t)(t + 1) * kstep;
            const char* a2 = last ? nA : cA + (size_t)(t + 2) * kstep; const char* b2 = last ? nB : cB + (size_t)(t + 2) * kstep;
            const char* a3 = a2 + kstep; const char* b3 = b2 + kstep;
            if (last && has_next) S.a_ready(nxt);
            if constexpr (SP2) {
            PG8_LDB(B0, 0, 0); PG8_LDB(B1, 0, 1); PG8_SCHED; PG8_LDA(At, 0, 0); PG8_STAGE(PG8_SA(1, 1), a1 + hstep, voffA);
            PG8_WAIT_V(8); PG8_WAIT_L(0); PG8_BAR; PG8_MMA(0, 0, At, B0); PG8_MMA(0, 1, At, B1); PG8_BAR; PG8_SCHED;
            PG8_LDA(At, 0, 1); PG8_STAGE(PG8_SB(0, 0), b2, voffB); PG8_STAGE(PG8_SB(0, 1), b2 + hstep, voffB); PG8_STAGE(PG8_SA(0, 0), a2, voffA);
            PG8_WAIT_V(8); PG8_WAIT_L(0); PG8_BAR; PG8_MMA(1, 0, At, B0); PG8_MMA(1, 1, At, B1); PG8_BAR; PG8_SCHED;
            PG8_LDB(B0, 1, 0); PG8_LDB(B1, 1, 1); PG8_SCHED; PG8_LDA(At, 1, 0); PG8_STAGE(PG8_SA(0, 1), a2 + hstep, voffA);
            PG8_WAIT_V(8); PG8_WAIT_L(0); PG8_BAR; PG8_MMA(0, 0, At, B0); PG8_MMA(0, 1, At, B1); PG8_BAR; PG8_SCHED;
            PG8_LDA(At, 1, 1); PG8_STAGE(PG8_SB(1, 0), b3, voffB); PG8_STAGE(PG8_SB(1, 1), b3 + hstep, voffB); PG8_STAGE(PG8_SA(1, 0), a3, voffA);
            PG8_WAIT_V(8); PG8_WAIT_L(0); PG8_BAR; PG8_MMA(1, 0, At, B0); PG8_MMA(1, 1, At, B1); PG8_BAR; PG8_SCHED;
            } else {
            PG8_LDB(B0, 0, 0); PG8_SCHED; PG8_LDA(At, 0, 0); PG8_STAGE(PG8_SA(1, 1), a1 + hstep, voffA);
            PG8_WAIT_L(8); PG8_BAR; PG8_WAIT_L(0); PG8_MMA(0, 0, At, B0); PG8_BAR; PG8_SCHED;
            PG8_LDB(B1, 0, 1); PG8_STAGE(PG8_SB(0, 0), b2, voffB);
            PG8_BAR; PG8_WAIT_L(0); PG8_MMA(0, 1, At, B1); PG8_BAR;
            PG8_LDA(At, 0, 1); PG8_STAGE(PG8_SA(0, 0), a2, voffA);
            PG8_BAR; PG8_WAIT_L(0); PG8_MMA(1, 0, At, B0); PG8_BAR; PG8_SCHED;
            PG8_STAGE(PG8_SB(0, 1), b2 + hstep, voffB);
            PG8_WAIT_V(6); PG8_BAR; PG8_MMA(1, 1, At, B1); PG8_BAR;
            PG8_LDB(B0, 1, 0); PG8_SCHED; PG8_LDA(At, 1, 0); PG8_STAGE(PG8_SA(0, 1), a2 + hstep, voffA);
            PG8_WAIT_L(8); PG8_BAR; PG8_WAIT_L(0); PG8_MMA(0, 0, At, B0); PG8_BAR; PG8_SCHED;
            PG8_LDB(B1, 1, 1); PG8_STAGE(PG8_SB(1, 0), b3, voffB);
            PG8_BAR; PG8_WAIT_L(0); PG8_MMA(0, 1, At, B1); PG8_BAR;
            PG8_LDA(At, 1, 1); PG8_STAGE(PG8_SA(1, 0), a3, voffA);
            PG8_BAR; PG8_WAIT_L(0); PG8_MMA(1, 0, At, B0); PG8_BAR; PG8_SCHED;
            PG8_STAGE(PG8_SB(1, 1), b3 + hstep, voffB);
            PG8_WAIT_V(6); PG8_BAR; PG8_MMA(1, 1, At, B1); PG8_BAR;
            }
        }
        if constexpr (FP8) asm volatile("s_nop 15\n\ts_nop 15\n\ts_nop 15" ::: "memory");
        if constexpr (ALIGN_EPI) { if (wr == 0) PG8_BAR; }
        if constexpr (!Epi::AFTER_DRAIN) { E(acc, cur, wr, wc, fr, fq); S.done(cur); }
        if (!has_next) break;
        { float zf; asm volatile("v_mov_b32 %0, 0" : "=v"(zf));
#pragma unroll
        for (int a = 0; a < 2; ++a)
#pragma unroll
            for (int b = 0; b < 2; ++b)
#pragma unroll
                for (int m = 0; m < 4; ++m)
#pragma unroll
                    for (int n = 0; n < 2; ++n) acc[a][b][m][n] = (f32x4){zf, zf, zf, zf}; }
        cur = nxt; cA = nA; cB = nB; ++ui;
        if constexpr (ALIGN_EPI) { if (wr == 1) PG8_BAR; }
    }
    PG8_WAIT_V(0);
    if constexpr (!ALIGN_EPI) { if (wr == 0) PG8_BAR; }
    PG8_BAR;
    if constexpr (Epi::AFTER_DRAIN) { E.fused(acc, cur, wr, wc, fr, fq, lds, wid, lane); S.done(cur); }
#undef PG8_SA
#undef PG8_SB
#undef PG8_STAGE
#undef PG8_LDA
#undef PG8_LDB
#undef PG8_MMA
#undef PG8_WAIT_V
#undef PG8_WAIT_L
#undef PG8_BAR
#undef PG8_SCHED
}
}
#include <hip/hip_bf16.h>
#include <cmath>
namespace attn_body {
using bf16=__hip_bfloat16;
using bf16x8=__attribute__((ext_vector_type(8)))short;
using s16x4=__attribute__((ext_vector_type(4)))short;
using f32x16=__attribute__((ext_vector_type(16)))float;
using u32x4=__attribute__((ext_vector_type(4)))unsigned;
constexpr int BATCH=4,NHEAD=8,SEQ=4096,D=64,DM=512,DMO=1024,KVSEQ=4224;
constexpr int NW=8,QBLK=32,QB=QBLK*NW,KVBLK=64,NQB=SEQ/QB;
constexpr int ATTN_UNIT_ROWS=QB;
__device__ __forceinline__ int crow(int r,int hi){return (r&3)+8*(r>>2)+4*hi;}
#define SBAR() __builtin_amdgcn_sched_barrier(0)
__device__ __forceinline__ void cmask(f32x16&p0,f32x16&p1,int jb,int qrel,int hi){
  const float NEG=-INFINITY; int kb=64*jb+4*hi;
  #pragma unroll
  for(int r=0;r<16;++r){int kv=kb+(r&3)+8*(r>>2); if(kv>qrel)p0[r]=NEG; if(kv+32>qrel)p1[r]=NEG;}
}

constexpr int NSLOT=3, SLOTB=8192;
constexpr int LDS_K=0, LDS_V=NSLOT*SLOTB, LDS_V2=2*NSLOT*SLOTB, LDS_WS=3*NSLOT*SLOTB, LDS_OST=LDS_WS+NW*64*4, LDS_BYTES=LDS_OST+NW*4096;
constexpr float C2=0.125f*1.4426950408889634f;
__device__ __forceinline__ void glds16(const void*gsrc,unsigned lds_dst){unsigned keep;
  asm volatile("s_mov_b32 %0, m0\n\ts_mov_b32 m0, %2\n\ts_nop 0\n\tglobal_load_lds_dwordx4 %1, off\n\ts_mov_b32 m0, %0":"=&s"(keep):"v"(gsrc),"s"(lds_dst):"memory");}
__device__ __forceinline__ void glds16s(const void*sbase,unsigned voff,unsigned lds_dst){unsigned keep;
  asm volatile("s_mov_b32 %0, m0\n\ts_mov_b32 m0, %3\n\ts_nop 0\n\tglobal_load_lds_dwordx4 %1, %2\n\ts_mov_b32 m0, %0":"=&s"(keep):"v"(voff),"s"(sbase),"s"(lds_dst):"memory");}
__device__ __forceinline__ float max3f(float a,float b,float c){float r;asm("v_max3_f32 %0, %1, %2, %3":"=v"(r):"v"(a),"v"(b),"v"(c));return r;}
__device__ __forceinline__ float max2f(float a,float b){float r;asm("v_max_f32_e32 %0, %1, %2":"=v"(r):"v"(a),"v"(b));return r;}
__device__ __forceinline__ float fadd_s(float a,float b){float r;asm("v_add_f32_e32 %0, %1, %2":"=v"(r):"v"(a),"v"(b));return r;}
__device__ __forceinline__ float fsub_s(float a,float b){float r;asm("v_sub_f32_e32 %0, %1, %2":"=v"(r):"v"(a),"v"(b));return r;}
typedef float f32x2_t __attribute__((ext_vector_type(2))); typedef __bf16 bf16x2_t __attribute__((ext_vector_type(2)));
__device__ __forceinline__ unsigned cvtpk_s(float lo,float hi){f32x2_t v={lo,hi};bf16x2_t b=__builtin_convertvector(v,bf16x2_t);return __builtin_bit_cast(unsigned,b);}
#define WAIT_BAR(N) asm volatile("s_waitcnt vmcnt(" #N ") lgkmcnt(0)\n\ts_barrier":::"memory")

typedef __attribute__((address_space(3))) const char* lds_cptr;
__device__ __forceinline__ void qkt(f32x16&p0,f32x16&p1,lds_cptr Kslot,const bf16x8*qr,const f32x16&negm0,const f32x16&negm1,int r32,int hi){
  const lds_cptr kb=Kslot+hi*1024+r32*16;
  #pragma unroll
  for(int d0=0;d0<4;++d0){
    const bf16x8 b0=*(const __attribute__((address_space(3))) bf16x8*)(kb+d0*2048);
    const bf16x8 b1=*(const __attribute__((address_space(3))) bf16x8*)(kb+d0*2048+512);
    if(d0==0){p0=__builtin_amdgcn_mfma_f32_32x32x16_bf16(b0,qr[0],negm0,0,0,0);p1=__builtin_amdgcn_mfma_f32_32x32x16_bf16(b1,qr[0],negm1,0,0,0);}
    else{p0=__builtin_amdgcn_mfma_f32_32x32x16_bf16(b0,qr[d0],p0,0,0,0);p1=__builtin_amdgcn_mfma_f32_32x32x16_bf16(b1,qr[d0],p1,0,0,0);}}
}
typedef short v4i16_t __attribute__((ext_vector_type(4)));
__device__ __forceinline__ void kload8(bf16x8*kf,lds_cptr kp){
  kf[0]=*(const __attribute__((address_space(3))) bf16x8*)(kp);      kf[1]=*(const __attribute__((address_space(3))) bf16x8*)(kp+512);
  kf[2]=*(const __attribute__((address_space(3))) bf16x8*)(kp+2048); kf[3]=*(const __attribute__((address_space(3))) bf16x8*)(kp+2560);
  kf[4]=*(const __attribute__((address_space(3))) bf16x8*)(kp+4096); kf[5]=*(const __attribute__((address_space(3))) bf16x8*)(kp+4608);
  kf[6]=*(const __attribute__((address_space(3))) bf16x8*)(kp+6144); kf[7]=*(const __attribute__((address_space(3))) bf16x8*)(kp+6656);
}
__device__ __forceinline__ void kload2(bf16x8*kf,lds_cptr kp,int j){ kf[2*j]=*(const __attribute__((address_space(3))) bf16x8*)(kp+j*2048); kf[2*j+1]=*(const __attribute__((address_space(3))) bf16x8*)(kp+j*2048+512); }
__device__ __forceinline__ s16x4 vtr(lds_cptr p){ return __builtin_bit_cast(s16x4,__builtin_amdgcn_ds_read_tr16_b64_v4i16((__attribute__((address_space(3))) v4i16_t*)p)); }
__device__ __forceinline__ float rowmax(const f32x16&p0,const f32x16&p1){
  float a=max3f(p0[0],p0[1],p1[0]),b=max3f(p0[2],p0[3],p1[1]);a=max3f(a,p1[2],p1[3]);
  #pragma unroll
  for(int r=4;r<16;r+=4){a=max3f(a,p0[r],p0[r+1]);b=max3f(b,p0[r+2],p0[r+3]);a=max3f(a,p1[r],p1[r+1]);b=max3f(b,p1[r+2],p1[r+3]);}
  const float m=max2f(a,b);
  auto rr=__builtin_amdgcn_permlane32_swap(__float_as_uint(m),__float_as_uint(m),false,false);
  return max2f(__uint_as_float(rr[0]),__uint_as_float(rr[1]));
}
__device__ __forceinline__ void pv(f32x16*o,int vb,bf16x8 pa0,bf16x8 pa1,bf16x8 pa2,bf16x8 pa3){
  #pragma unroll
  for(int d0=0;d0<2;++d0){s16x4 lo[4],hi[4];
    #pragma unroll
    for(int ks=0;ks<4;++ks){
      asm volatile("ds_read_b64_tr_b16 %0,%1 offset:%c2":"=&v"(lo[ks]):"v"(vb),"i"(d0*4096+ks*1024):"memory");
      asm volatile("ds_read_b64_tr_b16 %0,%1 offset:%c2":"=&v"(hi[ks]):"v"(vb),"i"(d0*4096+ks*1024+512):"memory");}
    asm volatile("s_waitcnt lgkmcnt(0)":::"memory");SBAR();
    #define PK(k) (bf16x8){lo[k][0],lo[k][1],lo[k][2],lo[k][3],hi[k][0],hi[k][1],hi[k][2],hi[k][3]}
    o[d0]=__builtin_amdgcn_mfma_f32_32x32x16_bf16(pa0,PK(0),o[d0],0,0,0);
    o[d0]=__builtin_amdgcn_mfma_f32_32x32x16_bf16(pa1,PK(1),o[d0],0,0,0);
    o[d0]=__builtin_amdgcn_mfma_f32_32x32x16_bf16(pa2,PK(2),o[d0],0,0,0);
    o[d0]=__builtin_amdgcn_mfma_f32_32x32x16_bf16(pa3,PK(3),o[d0],0,0,0);
    #undef PK
  }
}

#ifndef ATTN_STORE16
#define ATTN_STORE16(p,v) (*(u32x4*)(p)=(v))
#endif
template<int THRL> __device__ __forceinline__ void attn_unit(int b,int hc,int qb,const bf16*Q,const bf16*__restrict__ K,const bf16*__restrict__ V,bf16*O,char*shm,int tid_in){
  int tid_=tid_in; asm volatile("":"+v"(tid_)); const int tid=tid_,lane=tid&63,r32=lane&31,hi=lane>>5; const int wid=__builtin_amdgcn_readfirstlane(tid>>6);
  const long rowbase=(long)b*SEQ, kvbase=(long)b*KVSEQ; const int q0=qb*QB;
  const bf16*Qw=Q+(rowbase+q0+wid*QBLK)*DM+hc*D;
  const bf16*Kh=K+kvbase*DM+hc*D,*Vh=V+kvbase*DM+(hc>>1)*128;
  const unsigned lds0=(unsigned)(uintptr_t)shm;
  typedef __attribute__((address_space(3))) float lds_f32; typedef __attribute__((address_space(3))) unsigned short lds_u16; typedef __attribute__((address_space(3))) char lds_char;
  lds_f32*wsf=(lds_f32*)((lds_char*)shm+LDS_WS)+wid*64;
  const bf16*ksb=Kh+wid*8; const unsigned kvo=(unsigned)lane*(DM*2);
  const bf16*vsb=Vh+(long)(16*(wid&3))*DM+(wid>>2)*32; const unsigned vvo=(unsigned)((lane>>2)*DM+(lane&3)*8)*2u;
  const unsigned kdst=lds0+LDS_K+wid*1024, vdst=lds0+LDS_V+wid*1024, vdst2=lds0+LDS_V2+wid*1024;
  #define DMA_K(t,slot) glds16s(ksb+(long)(t)*KVBLK*DM,kvo,(unsigned)__builtin_amdgcn_readfirstlane(kdst+(slot)))
  #define DMA_V(t,slot) do{ glds16s(vsb+(long)(t)*KVBLK*DM,vvo,(unsigned)__builtin_amdgcn_readfirstlane(vdst+(slot))); glds16s(vsb+(long)(t)*KVBLK*DM+64,vvo,(unsigned)__builtin_amdgcn_readfirstlane(vdst2+(slot))); }while(0)
  const int vb0=(int)(lds0+LDS_V)+((lane>>4)&1)*32+(lane&3)*8+(4*hi+((lane&15)>>2))*64;
  bf16x8 kf[8];
  const lds_cptr shm3=(lds_cptr)shm; const lds_cptr kp0=shm3+LDS_K+hi*1024+r32*16; const lds_cptr vp0=shm3+LDS_V+((lane>>4)&1)*32+(lane&3)*8+(4*hi+((lane&15)>>2))*64;
  const int NT=(q0+QB)/KVBLK+2;
  DMA_K(0,0);DMA_V(0,0);DMA_K(1,SLOTB);
  bf16x8 qr[4];
  #pragma unroll
  for(int d0=0;d0<4;++d0)qr[d0]=*reinterpret_cast<const bf16x8*>(&Qw[(long)r32*DM+d0*16+hi*8]);
  float mhat=0.f,l_reg=0.f;f32x16 o[4];o[0]=f32x16{};o[1]=f32x16{};o[2]=f32x16{};o[3]=f32x16{};f32x16 negm=f32x16{};asm volatile("":"+v"(negm));
  const int qrel=wid*QBLK+r32;
  #define CMASK(P0,P1,t) do{int jb_=(t)-(NT-4); if(jb_>=0)cmask(P0,P1,jb_,qrel,hi);}while(0)
  bool resc=false;
  #define START(P0,P1) do{ const float rm=rowmax(P0,P1); resc=false; \
    { const float dl=rm; mhat=fadd_s(mhat,dl); \
      _Pragma("unroll") for(int r=0;r<16;++r){P0[r]=fsub_s(P0[r],dl);P1[r]=fsub_s(P1[r],dl);} \
      _Pragma("unroll") for(int r=0;r<16;++r)negm[r]=-mhat; asm volatile("":"+v"(negm)); } \
    _Pragma("unroll") for(int r=0;r<16;++r)P0[r]=__builtin_amdgcn_exp2f(P0[r]); }while(0)
  #define RESC() do{ if(resc){ asm volatile("s_waitcnt lgkmcnt(0)":::"memory"); \
      _Pragma("unroll") for(int d_=0;d_<4;++d_) _Pragma("unroll") for(int r=0;r<16;++r)o[d_][r]*=wsf[crow(r,hi)]; } }while(0)
  f32x16 pA0,pA1,pB0,pB1;
  int sl_prev=0,sl_cur=0,sl_next=SLOTB;
  #define ROT() do{sl_prev=sl_cur;sl_cur=sl_next;sl_next=(sl_next==(NSLOT-1)*SLOTB)?0:sl_next+SLOTB;}while(0)
  DMA_K(2,2*SLOTB);
  WAIT_BAR(4);
  { f32x16 cm0,cm1; _Pragma("unroll") for(int r=0;r<16;++r){cm0[r]=-INFINITY;cm1[r]=(r<8)?-INFINITY:0.f;} asm volatile("":"+v"(cm0),"+v"(cm1));
    qkt(pA0,pA1,shm3+LDS_K,qr,cm0,cm1,r32,hi); }
  asm volatile("s_nop 15\n\ts_nop 7":"+v"(pA0),"+v"(pA1));CMASK(pA0,pA1,0);
  START(pA0,pA1);
  _Pragma("unroll") for(int r=0;r<16;++r)pA1[r]=__builtin_amdgcn_exp2f(pA1[r]);
  _Pragma("unroll") for(int r=0;r<16;++r)negm[r]=-INFINITY; asm volatile("":"+v"(negm));
  WAIT_BAR(0);
  DMA_K(3,0);DMA_V(1,SLOTB);
  ROT();
  kload8(kf,kp0+sl_cur);
  WAIT_BAR(3);
  s16x4 vlo[8],vhi[8],wlo[8],whi[8]; u32x4 pw0,pw1,pw2,pw3;
  #define PKW(P,B) cvtpk_s(P[B],P[B+1])
  #define PAF(k) __builtin_bit_cast(bf16x8,pw##k)
  #define VFR(i) (bf16x8){vlo[i][0],vlo[i][1],vlo[i][2],vlo[i][3],vhi[i][0],vhi[i][1],vhi[i][2],vhi[i][3]}
  #define WFR(i) (bf16x8){wlo[i][0],wlo[i][1],wlo[i][2],wlo[i][3],whi[i][0],whi[i][1],whi[i][2],whi[i][3]}
  #define PIN(x) asm volatile("":"+v"(x))
  #define MX3(a,b,c) __builtin_fmaxf(__builtin_fmaxf((a),(b)),(c))
  #define GAPA(MF,A0,A1,A2,A3,W0,W1,PW) do{ MF; sacc+=A0; sacc+=A1; sacc+=A2; sacc+=A3; PIN(sacc); W0; W1; PIN(PW); SBAR(); }while(0)
  #define EX(v) __builtin_amdgcn_exp2f(v)
  #define GAPB(MF,X,B) do{ MF; X[B]=EX(X[B]); X[B+1]=EX(X[B+1]); PIN(X); SBAR(); }while(0)
  #define VRD(i) do{ vlo[i]=vtr(vp_+(((i)>>2)*4096+((i)&3)*1024)); vhi[i]=vtr(vp_+(((i)>>2)*4096+((i)&3)*1024+512)); }while(0)
  #define WRD(i) do{ wlo[i]=vtr(vp_+((LDS_V2-LDS_V)+((i)>>2)*4096+((i)&3)*1024)); whi[i]=vtr(vp_+((LDS_V2-LDS_V)+((i)>>2)*4096+((i)&3)*1024+512)); SBAR(); }while(0)
  #define KRD(G,j) do{ if(G){ kload2(kf,kp0+sl_next,j); SBAR(); } }while(0)
  #define STEP(C0,C1,P0,P1,t,GK,GV,GL) do{ SBAR(); \
    const lds_cptr vp_=vp0+sl_prev; \
    float sacc=(P0[0]+P0[1]); \
    GAPA(C0=__builtin_amdgcn_mfma_f32_32x32x16_bf16(kf[0],qr[0],negm,0,0,0), P0[2],P0[3],P0[4],P0[5],     pw0[0]=PKW(P0,0), pw0[1]=PKW(P0,2), pw0); \
    GAPA(C1=__builtin_amdgcn_mfma_f32_32x32x16_bf16(kf[1],qr[0],negm,0,0,0), P0[6],P0[7],P0[8],P0[9],     pw0[2]=PKW(P0,4), pw0[3]=PKW(P0,6), pw0); \
    GAPA(C0=__builtin_amdgcn_mfma_f32_32x32x16_bf16(kf[2],qr[1],C0,0,0,0),   P0[10],P0[11],P0[12],P0[13], pw1[0]=PKW(P0,8), pw1[1]=PKW(P0,10), pw1); \
    GAPA(C1=__builtin_amdgcn_mfma_f32_32x32x16_bf16(kf[3],qr[1],C1,0,0,0),   P0[14],P0[15],P1[0],P1[1],   pw1[2]=PKW(P0,12),pw1[3]=PKW(P0,14), pw1); \
    GAPA(C0=__builtin_amdgcn_mfma_f32_32x32x16_bf16(kf[4],qr[2],C0,0,0,0),   P1[2],P1[3],P1[4],P1[5],     pw2[0]=PKW(P1,0), pw2[1]=PKW(P1,2), pw2); \
    GAPA(C1=__builtin_amdgcn_mfma_f32_32x32x16_bf16(kf[5],qr[2],C1,0,0,0),   P1[6],P1[7],P1[8],P1[9],     pw2[2]=PKW(P1,4), pw2[3]=PKW(P1,6), pw2); \
    GAPA(C0=__builtin_amdgcn_mfma_f32_32x32x16_bf16(kf[6],qr[3],C0,0,0,0),   P1[10],P1[11],P1[12],P1[13], pw3[0]=PKW(P1,8), pw3[1]=PKW(P1,10), pw3); \
    GAPA(C1=__builtin_amdgcn_mfma_f32_32x32x16_bf16(kf[7],qr[3],C1,0,0,0),   P1[14],P1[15],0.f,0.f,       pw3[2]=PKW(P1,12),pw3[3]=PKW(P1,14), pw3); \
    l_reg+=sacc; \
    VRD(0);VRD(4);VRD(1);VRD(5);VRD(2);VRD(6);VRD(3);VRD(7); SBAR();     \
    if(GK){DMA_K((t)+3,sl_cur);} if(GV){DMA_V((t)+1,sl_next);} \
    CMASK(C0,C1,t); \
    { float a=MX3(C0[0],C0[1],C1[0]),b=MX3(C0[2],C0[3],C1[1]); a=MX3(a,C1[2],C1[3]); \
      _Pragma("unroll") for(int r=4;r<16;r+=4){a=MX3(a,C0[r],C0[r+1]);b=MX3(b,C0[r+2],C0[r+3]);a=MX3(a,C1[r],C1[r+1]);b=MX3(b,C1[r+2],C1[r+3]);} \
      float rm=__builtin_fmaxf(a,b); { auto rr=__builtin_amdgcn_permlane32_swap(__float_as_uint(rm),__float_as_uint(rm),false,false); rm=__builtin_fmaxf(__uint_as_float(rr[0]),__uint_as_float(rr[1])); } \
      resc=false; \
      if(__builtin_expect(__any(rm>(float)THRL),0)){ const float dl=__builtin_fmaxf(rm,0.f); mhat+=dl; \
        _Pragma("unroll") for(int r=0;r<16;++r){C0[r]-=dl;C1[r]-=dl;} \
        _Pragma("unroll") for(int r=0;r<16;++r)negm[r]=-mhat; asm volatile("":"+v"(negm)); \
        const float f=__builtin_amdgcn_exp2f(-dl); l_reg*=f; if(hi==0)wsf[r32]=f; resc=true; } } \
    SBAR(); \
    GAPB(o[0]=__builtin_amdgcn_mfma_f32_32x32x16_bf16(PAF(0),VFR(0),o[0],0,0,0), C0,0);  WRD(0); \
    GAPB(o[1]=__builtin_amdgcn_mfma_f32_32x32x16_bf16(PAF(0),VFR(4),o[1],0,0,0), C0,2);  WRD(4); \
    KRD(GL,0); GAPB(o[0]=__builtin_amdgcn_mfma_f32_32x32x16_bf16(PAF(1),VFR(1),o[0],0,0,0), C0,4);  WRD(1); \
    KRD(GL,1); GAPB(o[1]=__builtin_amdgcn_mfma_f32_32x32x16_bf16(PAF(1),VFR(5),o[1],0,0,0), C0,6);  WRD(5); \
    KRD(GL,2); GAPB(o[0]=__builtin_amdgcn_mfma_f32_32x32x16_bf16(PAF(2),VFR(2),o[0],0,0,0), C0,8);  WRD(2); \
    KRD(GL,3); GAPB(o[1]=__builtin_amdgcn_mfma_f32_32x32x16_bf16(PAF(2),VFR(6),o[1],0,0,0), C0,10); WRD(6); \
    GAPB(o[0]=__builtin_amdgcn_mfma_f32_32x32x16_bf16(PAF(3),VFR(3),o[0],0,0,0), C0,12); WRD(3); \
    GAPB(o[1]=__builtin_amdgcn_mfma_f32_32x32x16_bf16(PAF(3),VFR(7),o[1],0,0,0), C0,14); WRD(7); \
    GAPB(o[2]=__builtin_amdgcn_mfma_f32_32x32x16_bf16(PAF(0),WFR(0),o[2],0,0,0), C1,0); \
    GAPB(o[3]=__builtin_amdgcn_mfma_f32_32x32x16_bf16(PAF(0),WFR(4),o[3],0,0,0), C1,2); \
    GAPB(o[2]=__builtin_amdgcn_mfma_f32_32x32x16_bf16(PAF(1),WFR(1),o[2],0,0,0), C1,4); \
    GAPB(o[3]=__builtin_amdgcn_mfma_f32_32x32x16_bf16(PAF(1),WFR(5),o[3],0,0,0), C1,6); \
    GAPB(o[2]=__builtin_amdgcn_mfma_f32_32x32x16_bf16(PAF(2),WFR(2),o[2],0,0,0), C1,8); \
    GAPB(o[3]=__builtin_amdgcn_mfma_f32_32x32x16_bf16(PAF(2),WFR(6),o[3],0,0,0), C1,10); \
    GAPB(o[2]=__builtin_amdgcn_mfma_f32_32x32x16_bf16(PAF(3),WFR(3),o[2],0,0,0), C1,12); \
    GAPB(o[3]=__builtin_amdgcn_mfma_f32_32x32x16_bf16(PAF(3),WFR(7),o[3],0,0,0), C1,14); \
    }while(0)
  int t=1;
  #define FIX1(tt) do{ if((tt)==1){ _Pragma("unroll") for(int r=0;r<16;++r)negm[r]=-mhat; asm volatile("":"+v"(negm)); } }while(0)
  #undef CMASK
  #define CMASK(P0,P1,t) do{}while(0)
  for(;t+5<NT;t+=2){
    STEP(pB0,pB1,pA0,pA1,t,true,true,true);     WAIT_BAR(3); RESC(); ROT(); FIX1(t);
    STEP(pA0,pA1,pB0,pB1,t+1,true,true,true);   WAIT_BAR(3); RESC(); ROT();
  }
  #undef CMASK
  #define CMASK(P0,P1,t) do{int jb_=(t)-(NT-4); if(jb_>=0)cmask(P0,P1,jb_,qrel,hi);}while(0)
  #define ENDW(tt) do{ if((tt)+3<NT){WAIT_BAR(3);} else if((tt)+2<NT){WAIT_BAR(2);} else {WAIT_BAR(0);} }while(0)
  for(;t+1<NT;t+=2){
    STEP(pB0,pB1,pA0,pA1,t,(t+3<NT),(t+1<NT),(t+1<NT));       ENDW(t);   RESC(); ROT(); FIX1(t);
    STEP(pA0,pA1,pB0,pB1,t+1,(t+4<NT),(t+2<NT),(t+2<NT));     ENDW(t+1); RESC(); ROT();
  }
  STEP(pB0,pB1,pA0,pA1,NT-1,false,false,false); RESC();
  { float sacc=pB0[0]+pB0[1]; _Pragma("unroll") for(int r=2;r<16;++r)sacc+=pB0[r]; _Pragma("unroll") for(int r=0;r<16;++r)sacc+=pB1[r]; l_reg+=sacc;
    pw0=(u32x4){PKW(pB0,0),PKW(pB0,2),PKW(pB0,4),PKW(pB0,6)};pw1=(u32x4){PKW(pB0,8),PKW(pB0,10),PKW(pB0,12),PKW(pB0,14)};pw2=(u32x4){PKW(pB1,0),PKW(pB1,2),PKW(pB1,4),PKW(pB1,6)};pw3=(u32x4){PKW(pB1,8),PKW(pB1,10),PKW(pB1,12),PKW(pB1,14)};
    SBAR(); pv(o,vb0+sl_cur,PAF(0),PAF(1),PAF(2),PAF(3)); pv(o+2,vb0+(LDS_V2-LDS_V)+sl_cur,PAF(0),PAF(1),PAF(2),PAF(3)); }
  #undef PKW
  #undef PAF
  #undef VFR
  #undef WFR
  #undef WRD
  #undef PIN
  #undef MX3
  #undef GAPA
  #undef GAPB
  #undef EX
  #undef VRD
  #undef KRD
  #undef STEP
  #undef ENDW
  {auto rr=__builtin_amdgcn_permlane32_swap(__float_as_uint(l_reg),__float_as_uint(l_reg),false,false);l_reg=__uint_as_float(rr[0])+__uint_as_float(rr[1]);}
  if(hi==0)wsf[32+r32]=l_reg;asm volatile("s_waitcnt lgkmcnt(0)":::"memory");
  float rli[16];
  #pragma unroll
  for(int r=0;r<16;++r)rli[r]=__builtin_amdgcn_rcpf(wsf[32+crow(r,hi)]);
  bf16*Ow=O+(rowbase+q0+wid*QBLK)*DMO+hc*128;
  { lds_u16*stg=(lds_u16*)((lds_char*)shm+LDS_OST)+wid*2048;
    #pragma unroll
    for(int half=0;half<2;++half){
      #pragma unroll
      for(int r=0;r<16;++r){const int orow=crow(r,hi);
        #pragma unroll
        for(int d0=0;d0<2;++d0)stg[orow*64+d0*32+r32]=(unsigned short)(cvtpk_s(o[2*half+d0][r]*rli[r],0.f)&0xffffu);}
      asm volatile("s_waitcnt lgkmcnt(0)":::"memory");
      #pragma unroll
      for(int i=0;i<4;++i){const int row=i*8+(lane>>3),ch=lane&7; const u32x4 v=*(const __attribute__((address_space(3))) u32x4*)(stg+row*64+ch*8); ATTN_STORE16(Ow+(long)row*DMO+half*64+ch*8,v);}
      asm volatile("s_waitcnt lgkmcnt(0)":::"memory"); } }
  asm volatile("s_waitcnt lgkmcnt(0)\n\ts_barrier":::"memory");
  #undef DMA_K
  #undef DMA_V
  #undef CMASK
  #undef START
  #undef RESC
  #undef ROT
}
constexpr int ATTN_LDS_BYTES=LDS_BYTES;
struct AttnTensors { const bf16* Q; const bf16* K; const bf16* V; bf16* O; };
struct AttnUnit { int bh; int qb; };
struct StaticOrder {
  int vcu;
  __device__ __forceinline__ explicit StaticOrder(int grid,int block):vcu((block%8)*(grid/8)+block/8){}
  __device__ __forceinline__ bool next(int i,AttnUnit&u)const{ if(i>=4||vcu>=256)return false; const int s=vcu&3; u.bh=vcu>>2; u.qb=(i==0)?s:(i==1)?7-s:(i==2)?8+s:15-s; return true; }
  __device__ __forceinline__ void a_ready(const AttnUnit&)const{}
  __device__ __forceinline__ void done(const AttnUnit&)const{}
};
struct QueueOrder {
  unsigned* ctr; __attribute__((address_space(3))) unsigned* slot; int x; int wv;
  __device__ __forceinline__ bool next(int,AttnUnit&u)const{
    int l0_; asm volatile("v_mbcnt_lo_u32_b32 %0, -1, 0\n\tv_mbcnt_hi_u32_b32 %0, -1, %0":"=v"(l0_));
    if(wv==0&&l0_==0){ const unsigned e=__hip_atomic_fetch_add(ctr,1u,__ATOMIC_RELAXED,__HIP_MEMORY_SCOPE_AGENT); *slot=e; }
    asm volatile("s_waitcnt vmcnt(0) lgkmcnt(0)\n\ts_barrier":::"memory");
    const unsigned e=*slot;
    asm volatile("s_waitcnt lgkmcnt(0)\n\ts_barrier":::"memory");
    if(e>=64u)return false; u.bh=(int)(e&3u)*8+x; u.qb=15-(int)(e>>2); return true; }
  __device__ __forceinline__ void a_ready(const AttnUnit&)const{}
  __device__ __forceinline__ void done(const AttnUnit&)const{}
};
template<class Sched,int THRL=8> __device__ __forceinline__ void attn_phase(char*lds,const AttnTensors&T,const Sched&S,int wv){
  AttnUnit u;
  for(int i=0;S.next(i,u);++i){ S.a_ready(u); int l_; asm volatile("v_mbcnt_lo_u32_b32 %0, -1, 0\n\tv_mbcnt_hi_u32_b32 %0, -1, %0":"=v"(l_));
    attn_unit<THRL>(u.bh/NHEAD,u.bh%NHEAD,u.qb,T.Q,T.K,T.V,T.O,lds,wv*64+l_); S.done(u); }
}
#undef SBAR
#undef WAIT_BAR
}
#define GAS __attribute__((address_space(1)))
#define LAS __attribute__((address_space(3)))
typedef unsigned short bf16;
typedef unsigned v4u __attribute__((ext_vector_type(4)));
typedef float f32x4 __attribute__((ext_vector_type(4)));
typedef short bf16x8 __attribute__((ext_vector_type(8)));
typedef GAS unsigned gu32;
typedef GAS unsigned long long gu64;
#define RLX_AGENT __ATOMIC_RELAXED, __HIP_MEMORY_SCOPE_AGENT
#define LDS_WAIT() asm volatile("s_waitcnt lgkmcnt(0)" ::: "memory")
#define VM_WAIT() asm volatile("s_waitcnt vmcnt(0)" ::: "memory")
__device__ __forceinline__ unsigned long long rt() { return __builtin_amdgcn_s_memrealtime(); }
__device__ __forceinline__ unsigned f2bf(float f) { unsigned u = __builtin_bit_cast(unsigned, f); return (u + 0x7fffu + ((u >> 16) & 1u)) >> 16; }
__device__ __forceinline__ unsigned pk2(float lo, float hi) { return f2bf(lo) | (f2bf(hi) << 16); }

#define XB_TMO      128
#define XB_XCNT(j)  (256  + 64 * (j))
#define XB_XSUB(j)  (1280 + 64 * (j))
#define XB_XGEN(j)  (2304 + 64 * (j))
#define XB_TOP      3328
#define XB_TOPGEN   3392
#define XCD_BAR_WORDS 3456
#define XB_SPIN_CAP (1u << 18)

__device__ __forceinline__ unsigned xb_ld(unsigned* p)              { return __hip_atomic_load(p, __ATOMIC_RELAXED, __HIP_MEMORY_SCOPE_AGENT); }
__device__ __forceinline__ unsigned xb_add(unsigned* p, unsigned v) { return __hip_atomic_fetch_add(p, v, __ATOMIC_RELAXED, __HIP_MEMORY_SCOPE_AGENT); }
__device__ __forceinline__ unsigned xb_xcc_id() { return (unsigned)__builtin_amdgcn_s_getreg((3 << 11) | 20) & 0xFu; }
#define XB_SPIN(cond, bar) do { unsigned _sp = 0; while (cond) { __builtin_amdgcn_s_sleep(1); \
    if ((++_sp & 255u) == 0u) { if (xb_ld(&(bar)[XB_TMO])) break; if (_sp > XB_SPIN_CAP) { atomicAdd(&(bar)[XB_TMO], 1u); break; } } } } while (0)

struct XcdBarrier {
    unsigned* bar; unsigned x; int wv;
    volatile LAS unsigned* st;
};

__device__ __forceinline__ XcdBarrier xcd_barrier_post(unsigned* bar, volatile LAS unsigned* st) {
    XcdBarrier b; b.bar = bar; b.x = xb_xcc_id(); b.st = st;
    if (threadIdx.x == 0) (void)xb_add(&bar[XB_XCNT(b.x)], 1u);
    return b;
}
__device__ __forceinline__ void xcd_barrier_complete(unsigned* bar, unsigned x, unsigned& nloc, unsigned& nx) {
    const unsigned G = gridDim.x * gridDim.y * gridDim.z;
    unsigned sum, cnt, mine, sp = 0u;
    for (;;) {
        sum = 0u; cnt = 0u; mine = 0u;
#pragma unroll
        for (unsigned j = 0; j < 16; ++j) { const unsigned c = xb_ld(&bar[XB_XCNT(j)]); sum += c; cnt += (c > 0u) ? 1u : 0u; mine = (j == x) ? c : mine; }
        if (sum == G) break;
        __builtin_amdgcn_s_sleep(1);
        if ((++sp & 255u) == 0u) { if (xb_ld(&bar[XB_TMO])) break; if (sp > XB_SPIN_CAP) { atomicAdd(&bar[XB_TMO], 1u); break; } }
    }
    nloc = mine > 0u ? mine : 1u; nx = cnt > 0u ? cnt : 1u;
}

__device__ __forceinline__ void xcd_barrier(const XcdBarrier& b) {
    asm volatile("s_waitcnt vmcnt(0)" ::: "memory");
    __syncthreads();
    unsigned ln_; asm volatile("v_mbcnt_lo_u32_b32 %0, -1, 0\n\tv_mbcnt_hi_u32_b32 %0, -1, %0" : "=v"(ln_));
    if (b.wv == 0 && ln_ == 0u) {
        unsigned* bar = b.bar;
        __builtin_amdgcn_s_waitcnt(0);
        unsigned nloc = b.st[0], nx = b.st[1];
        if (nloc == 0u) { xcd_barrier_complete(bar, b.x, nloc, nx); b.st[0] = nloc; b.st[1] = nx; }
        const unsigned old = xb_add(&bar[XB_XSUB(b.x)], 1u);
        const unsigned gen = old / nloc;
        if (old + 1u == (gen + 1u) * nloc) {
            __builtin_amdgcn_fence(__ATOMIC_RELEASE, "agent");
            asm volatile("s_waitcnt vmcnt(0)" ::: "memory");
            const unsigned og = xb_add(&bar[XB_TOP], 1u);
            const unsigned tg = og / nx;
            if (og + 1u == (tg + 1u) * nx) xb_add(&bar[XB_TOPGEN], 1u);
            else XB_SPIN(xb_ld(&bar[XB_TOPGEN]) == tg, bar);
            __builtin_amdgcn_fence(__ATOMIC_ACQUIRE, "agent");
            xb_add(&bar[XB_XGEN(b.x)], 1u);
            asm volatile("s_waitcnt vmcnt(0)" ::: "memory");
        } else {
            XB_SPIN(xb_ld(&bar[XB_XGEN(b.x)]) == gen, bar);
            __builtin_amdgcn_fence(__ATOMIC_ACQUIRE, "agent");
            asm volatile("s_waitcnt vmcnt(0)" ::: "memory");
        }
    }
    __syncthreads();
}

constexpr int NWAVES = 8;
constexpr int DM = 1024, NB = 4, SEQ = 4096, NMETA = 16, DEPTH = 4;
constexpr int NREAL = NB * SEQ;
constexpr int NTOK = NREAL + NMETA;
constexpr int MPAD = 16640;
constexpr int INC = 3200, INP = 3328;
constexpr int RCOLS = 896, QOFF = 896, KOFF = 896 + 512, VOFF = 896 + 1024, COFF = 2432;
constexpr int FF = 2816, FF2 = 5632, NE = 8;
constexpr int KVROWS = 128 + SEQ;
constexpr int MOEP = 35072;
constexpr float C2Q = 0.125f * 1.4426950408889634f;

constexpr size_t MiB = 1u << 20;
constexpr size_t WS_CTL = 0, CTL_ZERO_BYTES = 1 * MiB;
constexpr size_t WS_COS = 1 * MiB, WS_SIN = 1 * MiB + 192 * 1024;
constexpr size_t WS_RSTD = 1 * MiB + 512 * 1024;
constexpr size_t WS_RSQB = 1 * MiB + 512 * 1024 + 72 * 1024;
constexpr size_t WS_RSROW = 1 * MiB + 768 * 1024;
constexpr size_t WS_TOKE = 2 * MiB, WS_TOKS = 2 * MiB + 256 * 1024, WS_TOKG = 2 * MiB + 512 * 1024;
constexpr size_t WS_WIN = 4 * MiB;
constexpr size_t WS_WOUT = 30 * MiB;
constexpr size_t WS_WGU = 38 * MiB;
constexpr size_t WS_WD = 60 * MiB;
constexpr size_t WS_MWGU = 72 * MiB;
constexpr size_t WS_MWD = 160 * MiB;
constexpr size_t WS_H = 204 * MiB;
constexpr size_t WS_HB = 269 * MiB;
constexpr size_t WS_PH = 302 * MiB;
constexpr size_t WS_PROJ = WS_PH;
constexpr size_t WS_QN = 408 * MiB;
constexpr size_t WS_KP = 425 * MiB;
constexpr size_t WS_VP = 442 * MiB;
constexpr size_t WS_OC = 459 * MiB;
constexpr size_t WS_OMIX = 492 * MiB;
constexpr size_t WS_SC = 525 * MiB, SC_STRIDE = 17 * MiB;
constexpr size_t WS_MIX_END = WS_SC + 9 * SC_STRIDE;
constexpr size_t WS_G = WS_PH;
constexpr size_t WS_AROWS = 491 * MiB;
constexpr size_t WS_YM = 560 * MiB;
constexpr size_t WS_LORA = 680 * MiB;
constexpr size_t WS_END = 714 * MiB;
static_assert(WS_PROJ + (size_t)MPAD * INP * 2 <= WS_QN && WS_G + (size_t)MOEP * FF * 2 <= WS_AROWS && WS_AROWS + (size_t)MOEP * 1024 * 2 <= WS_YM && WS_YM + (size_t)MOEP * 1024 * 2 <= WS_END, "ws map");
static_assert((size_t)8 * FF2 * DM <= 44 * MiB && 44 * MiB + (size_t)4112 * 11008 + 1024 <= 88 * MiB && (size_t)4112 * 8192 <= (size_t)MPAD * 2048, "chunk buffers");
static_assert(WS_H + (size_t)MPAD * 1024 * 4 <= WS_HB && WS_HB + (size_t)MPAD * 1024 * 2 <= WS_PH && WS_MIX_END <= WS_END, "ws map 2");
static_assert((size_t)NTOK * 256 * 4 <= SC_STRIDE && WS_OC + (size_t)NTOK * 2048 <= WS_OMIX && WS_OMIX + (size_t)MPAD * 2048 <= WS_SC, "ws map 3");
constexpr int CW_MOECNT = 1024;
constexpr int CW_BAR = 4096;
constexpr int CW_ATTQ = 8192;

constexpr int LDS_BYTES = 147456;
constexpr int MISC_OFF = LDS_BYTES - 128;

#define MK_ONE_LAUNCH 1
struct Args { const float* in[32]; float* out; unsigned char* ws; int ph_lo, ph_hi; };

__device__ __forceinline__ v4u zero_v4u() { unsigned z; asm volatile("v_mov_b32 %0, 0" : "=v"(z)); return (v4u){z, z, z, z}; }
__device__ __forceinline__ unsigned pk4_fp8(float a, float b, float c, float d) {
    a = __builtin_amdgcn_fmed3f(a, -448.f, 448.f); b = __builtin_amdgcn_fmed3f(b, -448.f, 448.f); c = __builtin_amdgcn_fmed3f(c, -448.f, 448.f); d = __builtin_amdgcn_fmed3f(d, -448.f, 448.f);
    unsigned p = (unsigned)__builtin_amdgcn_cvt_pk_fp8_f32(a, b, 0, false); return (unsigned)__builtin_amdgcn_cvt_pk_fp8_f32(c, d, (int)p, true); }
#ifndef INP8_MASK
#define INP8_MASK 0xC
#endif
constexpr int INP8 = INP8_MASK;
constexpr float W8_SCALE = 64.f, A8_SCALE = 16.f, G8_SCALE = 4.f, H8_SCALE = 4.f;
__device__ __forceinline__ float bf2f(unsigned short b) { return __uint_as_float(((unsigned)b) << 16); }
#define DPP_F(x, ctrl) __int_as_float(__builtin_amdgcn_update_dpp(0, __float_as_int(x), ctrl, 0xF, 0xF, true))
__device__ __forceinline__ float lane_xor1(float v) { return DPP_F(v, 0xB1); }
__device__ __forceinline__ float sum8(float v) { v += DPP_F(v, 0xB1); v += DPP_F(v, 0x4E); v += DPP_F(v, 0x141); return v; }
__device__ __forceinline__ float sum16(float v) { v = sum8(v); v += DPP_F(v, 0x140); return v; }
__device__ __forceinline__ float wave_sum_dpp(float p) {
    p = sum16(p);
    asm volatile("s_nop 1\n\tv_add_f32_dpp %0, %0, %0 row_bcast:15 row_mask:0xa bank_mask:0xf\n\ts_nop 1\n\tv_add_f32_dpp %0, %0, %0 row_bcast:31 row_mask:0xc bank_mask:0xf\n\ts_nop 0" : "+v"(p));
    return __int_as_float(__builtin_amdgcn_readlane(__float_as_int(p), 63));
}
__device__ __forceinline__ float wave_sum(float v) { return wave_sum_dpp(v); }
__device__ __forceinline__ float wave_max(float v) {
    v = fmaxf(v, DPP_F(v, 0xB1)); v = fmaxf(v, DPP_F(v, 0x4E)); v = fmaxf(v, DPP_F(v, 0x141)); v = fmaxf(v, DPP_F(v, 0x140));
    asm volatile("s_nop 1\n\tv_max_f32_dpp %0, %0, %0 row_bcast:15 row_mask:0xa bank_mask:0xf\n\ts_nop 1\n\tv_max_f32_dpp %0, %0, %0 row_bcast:31 row_mask:0xc bank_mask:0xf\n\ts_nop 0" : "+v"(v));
    return __int_as_float(__builtin_amdgcn_readlane(__float_as_int(v), 63));
}
__device__ __forceinline__ float sigmoidf_(float x) { return 1.f / (1.f + __expf(-x)); }
__device__ __forceinline__ int prevrow(int row) { if (row < 0) return -1; if (row >= NREAL) return row == NREAL ? -1 : row - 1; return (row & (SEQ - 1)) == 0 ? NTOK - 1 : row - 1; }

__device__ __forceinline__ void tr_item(const float* W, int K, int N, bf16* WT, int rowmode, const float* gk, LAS float* scr, int item, int lane) {
    const int nblk = N / 32, kb = item / nblk, nb = item % nblk, k0 = 64 * kb, n0 = 32 * nb;
    const float* src = W + (size_t)(k0 + (lane >> 5)) * N + n0 + (lane & 31);
    float v[32];
#pragma unroll
    for (int i = 0; i < 32; ++i) v[i] = src[(size_t)(2 * i) * N];
#pragma unroll
    for (int i = 0; i < 32; ++i) scr[(2 * i + (lane >> 5)) * 33 + (lane & 31)] = v[i];
    LDS_WAIT(); asm volatile("" ::: "memory");
    const int c = lane & 7;
    f32x4 g0 = (f32x4){1.f, 1.f, 1.f, 1.f}, g1 = g0;
    if (gk) { g0 = *(const f32x4*)(gk + k0 + 8 * c); g1 = *(const f32x4*)(gk + k0 + 8 * c + 4); }
#pragma unroll
    for (int j = 0; j < 4; ++j) { const int n = (lane >> 3) + 8 * j; const LAS float* s = scr + (8 * c) * 33 + n;
        v4u o; o.x = pk2(s[0 * 33] * g0.x, s[1 * 33] * g0.y); o.y = pk2(s[2 * 33] * g0.z, s[3 * 33] * g0.w); o.z = pk2(s[4 * 33] * g1.x, s[5 * 33] * g1.y); o.w = pk2(s[6 * 33] * g1.z, s[7 * 33] * g1.w);
        const int nn = n0 + n; const int drow = rowmode == 0 ? nn : ((nn >> 7) * 256 + (nn & 127) + (rowmode == 2 ? 128 : 0));
        *(GAS v4u*)(WT + (size_t)drow * K + k0 + 8 * c) = o; }
    LDS_WAIT(); asm volatile("" ::: "memory");
}

__device__ __forceinline__ void tr_item2(const float* W0, int K0, int N0, bf16* WT0, int rm0, const float* gk0, int item0,
                                         const float* W1, int K1, int N1, bf16* WT1, int rm1, const float* gk1, int item1, LAS float* scr, int lane, bool f8_0 = false, bool f8_1 = false) {
    const int nb0_ = N0 / 32, nb1_ = N1 / 32;
    const int k00 = 64 * (item0 / nb0_), n00 = 32 * (item0 % nb0_), k01 = 64 * (item1 / nb1_), n01 = 32 * (item1 % nb1_);
    const float* s0 = W0 + (size_t)(k00 + (lane >> 5)) * N0 + n00 + (lane & 31); const float* s1 = W1 + (size_t)(k01 + (lane >> 5)) * N1 + n01 + (lane & 31);
    float v0[32], v1[32];
#pragma unroll
    for (int i = 0; i < 32; ++i) { v0[i] = s0[(size_t)(2 * i) * N0]; v1[i] = s1[(size_t)(2 * i) * N1]; }
    LAS float* t0 = scr; LAS float* t1 = scr + 64 * 33;
#pragma unroll
    for (int i = 0; i < 32; ++i) { t0[(2 * i + (lane >> 5)) * 33 + (lane & 31)] = v0[i]; t1[(2 * i + (lane >> 5)) * 33 + (lane & 31)] = v1[i]; }
    LDS_WAIT(); asm volatile("" ::: "memory");
    const int c = lane & 7;
#pragma unroll
    for (int q = 0; q < 2; ++q) { const float* gk = q ? gk1 : gk0; const int k0 = q ? k01 : k00, n0 = q ? n01 : n00, K = q ? K1 : K0, rowmode = q ? rm1 : rm0; bf16* WT = q ? WT1 : WT0; const LAS float* tt = q ? t1 : t0;
        f32x4 g0 = (f32x4){1.f, 1.f, 1.f, 1.f}, g1 = g0;
        if (gk) { g0 = *(const f32x4*)(gk + k0 + 8 * c); g1 = *(const f32x4*)(gk + k0 + 8 * c + 4); }
#pragma unroll
        for (int j = 0; j < 4; ++j) { const int n = (lane >> 3) + 8 * j; const LAS float* s = tt + (8 * c) * 33 + n;
            v4u o; o.x = pk2(s[0 * 33] * g0.x, s[1 * 33] * g0.y); o.y = pk2(s[2 * 33] * g0.z, s[3 * 33] * g0.w); o.z = pk2(s[4 * 33] * g1.x, s[5 * 33] * g1.y); o.w = pk2(s[6 * 33] * g1.z, s[7 * 33] * g1.w);
            const int nn = n0 + n; const int drow = rowmode == 0 ? nn : ((nn >> 7) * 256 + (nn & 127) + (rowmode == 2 ? 128 : 0));
            if (q ? f8_1 : f8_0) { const unsigned lo = pk4_fp8(s[0 * 33] * g0.x * W8_SCALE, s[1 * 33] * g0.y * W8_SCALE, s[2 * 33] * g0.z * W8_SCALE, s[3 * 33] * g0.w * W8_SCALE), hi8 = pk4_fp8(s[4 * 33] * g1.x * W8_SCALE, s[5 * 33] * g1.y * W8_SCALE, s[6 * 33] * g1.z * W8_SCALE, s[7 * 33] * g1.w * W8_SCALE);
                *(GAS unsigned long long*)((GAS unsigned char*)WT + (size_t)drow * K + k0 + 8 * c) = (unsigned long long)lo | ((unsigned long long)hi8 << 32); }
            else *(GAS v4u*)(WT + (size_t)drow * K + k0 + 8 * c) = o; } }
    LDS_WAIT(); asm volatile("" ::: "memory");
}

__device__ __forceinline__ void meta_gemm_res(const bf16* A, int K, const bf16* Bt, float* Hm, LAS unsigned char* lds, int bx, int wave, int lane, int hbmode = 0, bf16* HBm = nullptr, unsigned long long* rsqm = nullptr) {
    if (bx < 32) {
        typedef short bfx8 __attribute__((ext_vector_type(8)));
        const int ct = 2 * bx + (wave >> 2), ksp = wave & 3, n = lane & 15, kq = lane >> 4; const int kc = K >> 2, steps = kc >> 5;
        const bf16* ap = A + (size_t)n * K + ksp * kc + 8 * kq; const bf16* wp = Bt + (size_t)(16 * ct + n) * K + ksp * kc + 8 * kq;
        f32x4 acc = (f32x4){0.f, 0.f, 0.f, 0.f};
#pragma unroll 11
        for (int s = 0; s < steps; ++s) { const v4u a = *(const v4u*)(wp + 32 * s), b = *(const v4u*)(ap + 32 * s);
            acc = __builtin_amdgcn_mfma_f32_16x16x32_bf16(__builtin_bit_cast(bfx8, a), __builtin_bit_cast(bfx8, b), acc, 0, 0, 0); }
        LAS f32x4* red = (LAS f32x4*)lds;
        red[wave * 64 + lane] = acc;
        __syncthreads();
        if (ksp == 0) { const f32x4 s = (red[wave * 64 + lane] + red[(wave + 1) * 64 + lane]) + (red[(wave + 2) * 64 + lane] + red[(wave + 3) * 64 + lane]);
            f32x4* hp = (f32x4*)(Hm + (size_t)n * 1024 + 16 * ct + 4 * kq); const f32x4 hn = *hp + s; *hp = hn;
            if (hbmode) { const int cc = 16 * ct + 4 * kq;
                if (hbmode == 1) *(unsigned long long*)(HBm + (size_t)n * 1024 + cc) = (unsigned long long)pk2(hn.x, hn.y) | ((unsigned long long)pk2(hn.z, hn.w) << 32);
                else *(unsigned*)((unsigned char*)HBm + (size_t)n * 1024 + cc) = pk4_fp8(hn.x * H8_SCALE, hn.y * H8_SCALE, hn.z * H8_SCALE, hn.w * H8_SCALE);
                __hip_atomic_fetch_add(rsqm + n, (unsigned long long)(((hn.x * hn.x + hn.y * hn.y) + (hn.z * hn.z + hn.w * hn.w)) * 16777216.f), RLX_AGENT); } }
        __syncthreads();
    }
}

__device__ __forceinline__ void meta_gemm_res8(const unsigned char* A, int K, const unsigned char* Bt, float* Hm, float sc, LAS unsigned char* lds, int bx, int wave, int lane, int hbmode = 0, bf16* HBm = nullptr, unsigned long long* rsqm = nullptr) {
    if (bx < 32) {
        typedef int v8i_ __attribute__((ext_vector_type(8)));
        const int ct = 2 * bx + (wave >> 2), ksp = wave & 3, n = lane & 15, kq = lane >> 4; const int kc = K >> 2, steps = kc >> 7;
        const int s0 = ksp < 2 ? 6 * ksp : 12 + 5 * (ksp - 2), ns = ksp < 2 ? 6 : 5; (void)kc; (void)steps;
        const unsigned char* ap = A + (size_t)n * K + 32 * kq; const unsigned char* wp = Bt + (size_t)(16 * ct + n) * K + 32 * kq;
        f32x4 acc = (f32x4){0.f, 0.f, 0.f, 0.f};
#pragma unroll 6
        for (int s = s0; s < s0 + ns; ++s) { const v4u a0 = *(const v4u*)(wp + 128 * s), a1 = *(const v4u*)(wp + 128 * s + 16), b0 = *(const v4u*)(ap + 128 * s), b1 = *(const v4u*)(ap + 128 * s + 16);
            const v8i_ aa = (v8i_){(int)a0.x, (int)a0.y, (int)a0.z, (int)a0.w, (int)a1.x, (int)a1.y, (int)a1.z, (int)a1.w}, bb = (v8i_){(int)b0.x, (int)b0.y, (int)b0.z, (int)b0.w, (int)b1.x, (int)b1.y, (int)b1.z, (int)b1.w};
            acc = __builtin_amdgcn_mfma_scale_f32_16x16x128_f8f6f4(aa, bb, acc, 0, 0, 0, 0x7f7f7f7f, 0, 0x7f7f7f7f); }
        LAS f32x4* red = (LAS f32x4*)lds;
        red[wave * 64 + lane] = acc;
        __syncthreads();
        if (ksp == 0) { const f32x4 s = (red[wave * 64 + lane] + red[(wave + 1) * 64 + lane]) + (red[(wave + 2) * 64 + lane] + red[(wave + 3) * 64 + lane]);
            f32x4* hp = (f32x4*)(Hm + (size_t)n * 1024 + 16 * ct + 4 * kq); const f32x4 hn = *hp + s * sc; *hp = hn;
            if (hbmode) { const int cc = 16 * ct + 4 * kq;
                if (hbmode == 1) *(unsigned long long*)(HBm + (size_t)n * 1024 + cc) = (unsigned long long)pk2(hn.x, hn.y) | ((unsigned long long)pk2(hn.z, hn.w) << 32);
                else *(unsigned*)((unsigned char*)HBm + (size_t)n * 1024 + cc) = pk4_fp8(hn.x * H8_SCALE, hn.y * H8_SCALE, hn.z * H8_SCALE, hn.w * H8_SCALE);
                __hip_atomic_fetch_add(rsqm + n, (unsigned long long)(((hn.x * hn.x + hn.y * hn.y) + (hn.z * hn.z + hn.w * hn.w)) * 16777216.f), RLX_AGENT); } }
        __syncthreads();
    }
}

__global__ void __launch_bounds__(NWAVES * 64, 2) hymba_fwd(Args args) {
    extern __shared__ __attribute__((aligned(16))) unsigned char lds_raw[];
    LAS unsigned char* lds = (LAS unsigned char*)lds_raw;
    volatile LAS unsigned* MISC = (volatile LAS unsigned*)(lds + MISC_OFF);
    const int wave = __builtin_amdgcn_readfirstlane((int)threadIdx.x >> 6);
#define PH_TID int tid; asm volatile("v_mbcnt_lo_u32_b32 %0, -1, 0\n\tv_mbcnt_hi_u32_b32 %0, -1, %0" : "=v"(tid)); tid += wave * 64; const int lane = tid & 63; (void)lane; unsigned char* ws = ws0; asm volatile("" : "+s"(ws)); const char* ka = ka0; asm volatile("" : "+s"(ka)); (void)ka
    const int G = gridDim.x, bx = blockIdx.x;
    const int gw = bx * NWAVES + wave, NGW = G * NWAVES;
    unsigned char* const ws0 = args.ws;
    const char* const ka0 = (const char*)__builtin_amdgcn_kernarg_segment_ptr();
    { const int t0_ = (int)threadIdx.x; if (t0_ < 32) ((LAS unsigned*)(lds + MISC_OFF))[t0_] = 0u; }
    __syncthreads();
#if MK_ONE_LAUNCH
    constexpr int lo = 0, hi = 48; constexpr bool multi = true;
#else
    const int lo = args.ph_lo, hi = args.ph_hi;
    const bool multi = (hi - lo) > 1;
#endif
    XcdBarrier bar; bar.bar = (unsigned*)(ws0 + WS_CTL) + CW_BAR; bar.x = 0; bar.st = nullptr; bar.wv = wave;
    if (multi) { bar = xcd_barrier_post((unsigned*)(ws0 + WS_CTL) + CW_BAR, MISC + 8); bar.wv = wave; }
#ifndef ENMASK
#define ENMASK 0xFFFF
#endif
#define EN(k) (((ENMASK) >> (k)) & 1)
#ifndef REPMASK
#define REPMASK 0
#endif
#define NREP(k) ((((REPMASK) >> (k)) & 1) ? 2 : 1)
#define IN(k) (lo <= (k) && (k) < hi)
#define SEAM(k) do { if (hi > (k) + 1) xcd_barrier(bar); } while (0)

#define Hf ((float*)(ws + WS_H))
#define HB ((bf16*)(ws + WS_HB))
#define RSTD ((float*)(ws + WS_RSTD))
#define PROJ ((bf16*)(ws + WS_PROJ))
#define QN ((bf16*)(ws + WS_QN))
#define KP ((bf16*)(ws + WS_KP))
#define VP ((bf16*)(ws + WS_VP))
#define OC ((bf16*)(ws + WS_OC))
#define OMIX ((bf16*)(ws + WS_OMIX))
#define SP4 ((f32x4*)(ws + WS_SC + 0 * SC_STRIDE))
#define SR ((float*)(ws + WS_SC + 4 * SC_STRIDE))
#define SV ((float*)(ws + WS_SC + 5 * SC_STRIDE))
#define SG ((float*)(ws + WS_SC + 6 * SC_STRIDE))
#define SBON ((float*)(ws + WS_SC + 7 * SC_STRIDE))
#define SY ((float*)(ws + WS_SC + 8 * SC_STRIDE))
#define COS ((float*)(ws + WS_COS))
#define SIN ((float*)(ws + WS_SIN))
#define GB ((bf16*)(ws + WS_G))
#define AROWS ((bf16*)(ws + WS_AROWS))
#define YM ((bf16*)(ws + WS_YM))
#define RSQB ((unsigned long long*)(ws + WS_RSQB))
#define RSQA ((unsigned long long*)(ws + WS_RSROW))
#define TOKE ((int*)(ws + WS_TOKE))
#define TOKS ((int*)(ws + WS_TOKS))
#define TOKG ((float*)(ws + WS_TOKG))
#define ctl ((gu32*)(ws + WS_CTL))
#define INP(i) (*(const float* const*)(ka + 8 * (i)))
#define LORA_W ((float*)(ws + WS_LORA))
#define LORA_AG ((bf16*)(ws + WS_LORA + 17 * MiB))
#define CH_REC ((unsigned char*)(ws + WS_MWGU + 44 * MiB))
#define CH_RB 11008
#define CH_SPK ((unsigned char*)(ws + WS_HB))
#ifndef SCAN_CHUNKED
#define SCAN_CHUNKED 1
#endif

    for (int rep_ = 0; rep_ < NREP(15); ++rep_) if (EN(15) && IN(0)) { PH_TID;
        LAS float* scr = (LAS float*)(lds + wave * 17408);
        constexpr int I_IN = 16 * 100, I_OUT = 16 * 32, I_GU = 16 * 88, I_DN = 44 * 32;
        constexpr int NITEMS = DEPTH * (I_IN + I_OUT) + 2 * (2 * I_GU + I_DN);
        for (int it0 = 2 * gw; it0 < NITEMS; it0 += 2 * NGW) {
            const float* W_[2]; bf16* D_[2]; int K_[2], N_[2], rm_[2], r_[2]; const float* g_[2]; bool f8_[2] = {false, false};
#pragma unroll
            for (int q = 0; q < 2; ++q) { int r = it0 + q;
                if (r < DEPTH * I_IN) { const int l = r / I_IN; W_[q] = INP(3) + (size_t)l * DM * INC; K_[q] = DM; N_[q] = INC; D_[q] = (bf16*)(ws + WS_WIN) + (size_t)l * INP * DM; rm_[q] = 0; g_[q] = INP(2) + l * DM; r_[q] = r % I_IN; f8_[q] = ((INP8 >> l) & 1) != 0; continue; } r -= DEPTH * I_IN;
                if (r < DEPTH * I_OUT) { const int l = r / I_OUT; W_[q] = INP(23) + (size_t)l * DM * DM; K_[q] = DM; N_[q] = DM; D_[q] = (bf16*)(ws + WS_WOUT) + (size_t)l * DM * DM; rm_[q] = 0; g_[q] = nullptr; r_[q] = r % I_OUT; continue; } r -= DEPTH * I_OUT;
                if (r < 2 * I_GU) { const int j = r / I_GU; W_[q] = INP(25) + (size_t)j * DM * FF; K_[q] = DM; N_[q] = FF; D_[q] = (bf16*)(ws + WS_WGU) + (size_t)j * FF2 * DM; rm_[q] = 1; g_[q] = INP(24) + (2 * j) * DM; r_[q] = r % I_GU; f8_[q] = (j == 1); continue; } r -= 2 * I_GU;
                if (r < 2 * I_GU) { const int j = r / I_GU; W_[q] = INP(26) + (size_t)j * DM * FF; K_[q] = DM; N_[q] = FF; D_[q] = (bf16*)(ws + WS_WGU) + (size_t)j * FF2 * DM; rm_[q] = 2; g_[q] = INP(24) + (2 * j) * DM; r_[q] = r % I_GU; f8_[q] = (j == 1); continue; } r -= 2 * I_GU;
                { const int j = r / I_DN; W_[q] = INP(27) + (size_t)j * FF * DM; K_[q] = FF; N_[q] = DM; D_[q] = (bf16*)(ws + WS_WD) + (size_t)j * DM * FF; rm_[q] = 0; g_[q] = nullptr; r_[q] = r % I_DN; f8_[q] = (j == 1); } }
            tr_item2(W_[0], K_[0], N_[0], D_[0], rm_[0], g_[0], r_[0], W_[1], K_[1], N_[1], D_[1], rm_[1], g_[1], r_[1], scr, lane, f8_[0], f8_[1]);
        }
        const int gt = bx * (NWAVES * 64) + tid, NGT = G * NWAVES * 64;
        for (int i = gt; i < DEPTH * 128 * (DM / 8); i += NGT) { const int l = i / (128 * (DM / 8)), r = i % (128 * (DM / 8));
            if ((INP8 >> l) & 1) { if (r < 128 * (DM / 16)) ((v4u*)((unsigned char*)(ws + WS_WIN) + (size_t)l * INP * DM * 2 + (size_t)INC * DM))[r] = zero_v4u(); }
            else ((v4u*)((bf16*)(ws + WS_WIN) + ((size_t)l * INP + INC) * DM))[r] = zero_v4u(); }
        for (int row = gw; row < MPAD; row += NGW) {
            f32x4 v[4]; float s = 0.f;
#pragma unroll
            for (int j = 0; j < 4; ++j) { const int c4 = lane + 64 * j; v[j] = __builtin_bit_cast(f32x4, zero_v4u());
                if (row < NREAL) v[j] = ((const f32x4*)INP(0))[(size_t)row * (DM / 4) + c4]; else if (row < NTOK) v[j] = ((const f32x4*)INP(1))[(row - NREAL) * (DM / 4) + c4];
                ((f32x4*)Hf)[(size_t)row * (DM / 4) + c4] = v[j]; s += (v[j].x * v[j].x + v[j].y * v[j].y) + (v[j].z * v[j].z + v[j].w * v[j].w); }
            if (row < NTOK) { s = wave_sum(s); const float rstd = 1.f / sqrtf(s * (1.f / DM) + 1e-6f);
                if (INP8 & 1) { const float sn = rstd * A8_SCALE;
#pragma unroll
                    for (int j = 0; j < 4; ++j) ((unsigned*)((unsigned char*)HB + (size_t)row * DM))[lane + 64 * j] = pk4_fp8(v[j].x * sn, v[j].y * sn, v[j].z * sn, v[j].w * sn); }
                else {
#pragma unroll
                    for (int j = 0; j < 4; ++j) ((unsigned long long*)(HB + (size_t)row * DM))[lane + 64 * j] = (unsigned long long)pk2(v[j].x, v[j].y) | ((unsigned long long)pk2(v[j].z, v[j].w) << 32); }
                if (lane == 0) RSTD[row] = rstd; }
        }
        if (INP8 & 1) { for (int i = gt; i < (MPAD - NTOK) * (DM / 16); i += NGT) ((v4u*)((unsigned char*)HB + (size_t)NTOK * DM))[i] = zero_v4u(); }
        else
        for (int i = gt; i < (MPAD - NTOK) * (DM / 8); i += NGT) ((v4u*)(HB + (size_t)NTOK * DM))[i] = zero_v4u();
        for (int i = gt; i < MPAD - NTOK; i += NGT) RSTD[NTOK + i] = 0.f;
        for (int i = gt; i < (SEQ + NMETA) * 8; i += NGT) { const int pos = i >> 3, j = i & 7;
            const float invf = j == 0 ? 1.000000000e+00f : j == 1 ? 1.939227432e-01f : j == 2 ? 3.760603070e-02f : j == 3 ? 7.292664610e-03f : j == 4 ? 1.414213562e-03f : j == 5 ? 2.742481884e-04f : j == 6 ? 5.318296098e-05f : 1.031338616e-05f;
            const float angf = (float)pos * invf; const double a = (double)angf; const double n = __builtin_rint(a * 0.15915494309189535);
            const double rr = (a - n * 6.283185307179586) - n * 2.4492935982947064e-16; const float rev = (float)(rr * 0.15915494309189535);
            COS[i] = __builtin_amdgcn_cosf(rev); SIN[i] = __builtin_amdgcn_sinf(rev); }
        SEAM(0);
    }

constexpr int CONV_I_GU = 16 * 88, CONV_I_DN = 44 * 32, CONV_PER_E = 2 * CONV_I_GU + CONV_I_DN;
#define MOE_CONVERT(TL_, LO_, HI_, WI_, NW_) do { LAS float* scr = (LAS float*)(lds + wave * 17408); const int tl_ = (TL_), tj_ = tl_ >> 1; const float* gff = INP(24) + tl_ * DM; \
        for (int it0 = (LO_) + 2 * (WI_); it0 < (HI_); it0 += 2 * (NW_)) { \
            const float* W_[2]; bf16* D_[2]; int K_[2], N_[2], rm_[2], r_[2]; const float* g_[2]; \
            _Pragma("unroll") for (int q = 0; q < 2; ++q) { const int it = it0 + q; const int e = it / CONV_PER_E; int r = it % CONV_PER_E; const size_t eo = (size_t)(tj_ * NE + e) * DM * FF; \
                if (r < CONV_I_GU) { W_[q] = INP(29) + eo; K_[q] = DM; N_[q] = FF; D_[q] = (bf16*)(ws + WS_MWGU) + (size_t)e * FF2 * DM / 2; rm_[q] = 1; g_[q] = gff; } \
                else if (r < 2 * CONV_I_GU) { r -= CONV_I_GU; W_[q] = INP(30) + eo; K_[q] = DM; N_[q] = FF; D_[q] = (bf16*)(ws + WS_MWGU) + (size_t)e * FF2 * DM / 2; rm_[q] = 2; g_[q] = gff; } \
                else { r -= 2 * CONV_I_GU; W_[q] = INP(31) + eo; K_[q] = FF; N_[q] = DM; D_[q] = (bf16*)(ws + WS_MWD) + (size_t)e * DM * FF / 2; rm_[q] = 0; g_[q] = nullptr; } \
                r_[q] = r; } \
            tr_item2(W_[0], K_[0], N_[0], D_[0], rm_[0], g_[0], r_[0], W_[1], K_[1], N_[1], D_[1], rm_[1], g_[1], r_[1], scr, lane, true, true); } } while (0)
#pragma nounroll
    for (int layer = 0; layer < DEPTH; ++layer) {
        const int pb = 1 + 12 * layer; const bool moe = (layer & 1) != 0; const int jj = layer >> 1;
        if (hi <= pb || lo >= pb + 12) continue;
        const float lam_init = 0.8f - 0.6f * __expf(-0.3f * (float)layer);

        for (int rep_ = 0; rep_ < NREP(1); ++rep_) if (EN(1) && IN(pb + 1)) { PH_TID;
            int cbx_ = bx; asm volatile("" : "+s"(cbx_));
            pg8::StaticOrder S; S.init(MPAD, INP, G, cbx_);
            if ((INP8 >> layer) & 1) { pg8::Gemm g{HB, (const bf16*)(ws + WS_WIN) + (size_t)layer * INP * DM, MPAD, INP, DM / 2};
                pg8::EpiBf16Rs E{PROJ, INP, nullptr, moe ? 1.f / (W8_SCALE * H8_SCALE) : 1.f / (W8_SCALE * A8_SCALE), moe ? RSQB : nullptr};
                pg8::gemm_phase<pg8::EpiBf16Rs, pg8::StaticOrder, true, true, true>(lds, g, S, E, tid); }
            else { pg8::Gemm g{HB, (const bf16*)(ws + WS_WIN) + (size_t)layer * INP * DM, MPAD, INP, DM}; pg8::EpiBf16Rs E{PROJ, INP, moe ? nullptr : RSTD, 1.f, moe ? RSQB : nullptr};
                pg8::gemm_phase<pg8::EpiBf16Rs, pg8::StaticOrder, true, true>(lds, g, S, E, tid); }
            SEAM(pb + 1);
        }
        for (int rep_ = 0; rep_ < NREP(2); ++rep_) if (EN(2) && IN(pb + 2)) { PH_TID;
            const int gt = bx * (NWAVES * 64) + tid, NGT = G * NWAVES * 64;
            if (tid < 65) { const v4u z_ = zero_v4u(); RSQA[bx * 65 + tid] = (unsigned long long)z_.x | ((unsigned long long)z_.y << 32); if (!moe) RSQB[bx * 65 + tid] = (unsigned long long)z_.x | ((unsigned long long)z_.y << 32); }
            for (int i = gt; i < NB * 112 * 64; i += NGT) { const int b = i / (112 * 64), r = (i / 64) % 112, c = i % 64; const int row = b * KVROWS + (r < 48 ? r : r + 16);
                ((v4u*)(KP + (size_t)row * 512))[c] = zero_v4u(); ((v4u*)(VP + (size_t)row * 512))[c] = zero_v4u(); }
            const int ngrp = (1025 - bx + 255) / 256, nrows = 16 * ngrp;
#define MP_ROW(idx) (16 * (bx + 256 * ((idx) >> 4)) + ((idx) & 15))
            LAS unsigned char* WT = lds;
            { const int nn = tid & 255, hf = tid >> 8;
              const float* sd = INP(6) + layer * 32 * 256 + (hf * 16) * 256 + nn; const float* sa = INP(8) + layer * 32 * 256 + (hf * 16) * 256 + nn; const float* sg = INP(9) + layer * 64 * 256 + (hf * 32) * 256 + nn;
              v4u wv[2];
#pragma unroll
              for (int i = 0; i < 2; ++i) { wv[i].x = pk2(sd[(8 * i) * 256], sd[(8 * i + 1) * 256]); wv[i].y = pk2(sd[(8 * i + 2) * 256], sd[(8 * i + 3) * 256]); wv[i].z = pk2(sd[(8 * i + 4) * 256], sd[(8 * i + 5) * 256]); wv[i].w = pk2(sd[(8 * i + 6) * 256], sd[(8 * i + 7) * 256]); }
              *(LAS v4u*)(WT + nn * 64 + hf * 32) = wv[0]; *(LAS v4u*)(WT + nn * 64 + hf * 32 + 16) = wv[1];
#pragma unroll
              for (int i = 0; i < 2; ++i) { wv[i].x = pk2(sa[(8 * i) * 256], sa[(8 * i + 1) * 256]); wv[i].y = pk2(sa[(8 * i + 2) * 256], sa[(8 * i + 3) * 256]); wv[i].z = pk2(sa[(8 * i + 4) * 256], sa[(8 * i + 5) * 256]); wv[i].w = pk2(sa[(8 * i + 6) * 256], sa[(8 * i + 7) * 256]); }
              *(LAS v4u*)(WT + 16384 + nn * 64 + hf * 32) = wv[0]; *(LAS v4u*)(WT + 16384 + nn * 64 + hf * 32 + 16) = wv[1];
#pragma unroll
              for (int i = 0; i < 4; ++i) { v4u t; t.x = pk2(sg[(8 * i) * 256], sg[(8 * i + 1) * 256]); t.y = pk2(sg[(8 * i + 2) * 256], sg[(8 * i + 3) * 256]); t.z = pk2(sg[(8 * i + 4) * 256], sg[(8 * i + 5) * 256]); t.w = pk2(sg[(8 * i + 6) * 256], sg[(8 * i + 7) * 256]);
                  *(LAS v4u*)(WT + 32768 + nn * 128 + hf * 64 + 16 * i) = t; } }
            __syncthreads();
            const float* mu = INP(4) + layer * RCOLS; const float* w0 = INP(5) + layer * 256; const float* a0 = INP(7) + layer * 256;
            const float* k_k = INP(10) + layer * 256; const float* k_a = INP(11) + layer * 256; const float* r_k = INP(12) + layer * 256;
            const float* qg = INP(15) + layer * 64; const float* kg = INP(16) + layer * 64; const float* cw = INP(22) + layer * 3 * 256;
            for (int rep3_ = 0; rep3_ < NREP(5); ++rep3_)
            if (wave < ngrp) {
                typedef attn_body::bf16x8 bfx8;
                const int rowbase = 16 * (bx + 256 * wave);
                LAS unsigned char* XT = lds + 65536 + wave * 4096;
                { const float mu0 = mu[768 + 2 * lane], mu1 = mu[768 + 2 * lane + 1]; const int p0 = prevrow(rowbase);
                  unsigned cur = p0 < 0 ? 0u : *(const unsigned*)(PROJ + (size_t)p0 * INP + 768 + 2 * lane); float pl = __uint_as_float(cur << 16), ph = __uint_as_float(cur & 0xffff0000u);
#pragma unroll
                  for (int r = 0; r < 16; ++r) { cur = *(const unsigned*)(PROJ + (size_t)(rowbase + r) * INP + 768 + 2 * lane); const float xl = __uint_as_float(cur << 16), xh = __uint_as_float(cur & 0xffff0000u);
                      float h0 = xl + (pl - xl) * mu0, h1 = xh + (ph - xh) * mu1; pl = xl; ph = xh;
                      if (lane < 16) { h0 = 1.f - 2.f / (1.f + __expf(2.f * h0)); h1 = 1.f - 2.f / (1.f + __expf(2.f * h1)); } else if (lane >= 32) { h0 = sigmoidf_(h0); h1 = sigmoidf_(h1); }
                      *(LAS unsigned*)(XT + r * 256 + 4 * lane) = pk2(h0, h1); } }
                LDS_WAIT();
                const int n = lane & 15, kq = lane >> 4;
                const v4u xd = *(const LAS v4u*)(XT + n * 256 + (8 * kq) * 2), xa = *(const LAS v4u*)(XT + n * 256 + (32 + 8 * kq) * 2);
                const v4u xg0 = *(const LAS v4u*)(XT + n * 256 + (64 + 8 * kq) * 2), xg1 = *(const LAS v4u*)(XT + n * 256 + (96 + 8 * kq) * 2);
                float* lw = LORA_W + (size_t)(rowbase + n) * 256 + 4 * kq; bf16* lag = LORA_AG + (size_t)(rowbase + n) * 512 + 4 * kq;
#pragma unroll 4
                for (int ct = 0; ct < 16; ++ct) {
                    const v4u ad = *(const LAS v4u*)(WT + (16 * ct + n) * 64 + (8 * kq) * 2), aa = *(const LAS v4u*)(WT + 16384 + (16 * ct + n) * 64 + (8 * kq) * 2);
                    const v4u ag0 = *(const LAS v4u*)(WT + 32768 + (16 * ct + n) * 128 + (8 * kq) * 2), ag1 = *(const LAS v4u*)(WT + 32768 + (16 * ct + n) * 128 + (32 + 8 * kq) * 2);
                    f32x4 dd = __builtin_amdgcn_mfma_f32_16x16x32_bf16(__builtin_bit_cast(bfx8, ad), __builtin_bit_cast(bfx8, xd), (f32x4){0.f, 0.f, 0.f, 0.f}, 0, 0, 0);
                    f32x4 da = __builtin_amdgcn_mfma_f32_16x16x32_bf16(__builtin_bit_cast(bfx8, aa), __builtin_bit_cast(bfx8, xa), (f32x4){0.f, 0.f, 0.f, 0.f}, 0, 0, 0);
                    f32x4 dg = __builtin_amdgcn_mfma_f32_16x16x32_bf16(__builtin_bit_cast(bfx8, ag0), __builtin_bit_cast(bfx8, xg0), (f32x4){0.f, 0.f, 0.f, 0.f}, 0, 0, 0);
                    dg = __builtin_amdgcn_mfma_f32_16x16x32_bf16(__builtin_bit_cast(bfx8, ag1), __builtin_bit_cast(bfx8, xg1), dg, 0, 0, 0);
                    *(f32x4*)(lw + 16 * ct) = dd;
                    *(unsigned long long*)(lag + 16 * ct) = (unsigned long long)pk2(da.x, da.y) | ((unsigned long long)pk2(da.z, da.w) << 32);
                    *(unsigned long long*)(lag + 256 + 16 * ct) = (unsigned long long)pk2(dg.x, dg.y) | ((unsigned long long)pk2(dg.z, dg.w) << 32);
                }
            }
            asm volatile("s_waitcnt vmcnt(0)" ::: "memory");
            __syncthreads();
#pragma nounroll
            for (int rep3_ = 0; rep3_ < NREP(10); ++rep3_)
            {
                typedef unsigned u32x2_ __attribute__((ext_vector_type(2)));
                const int sub = lane & 7; const int c4 = 4 * lane;
                const f32x4 qg0 = *(const f32x4*)(qg + 8 * sub), qg1 = *(const f32x4*)(qg + 8 * sub + 4), kg0 = *(const f32x4*)(kg + 8 * sub), kg1 = *(const f32x4*)(kg + 8 * sub + 4);
                const f32x4 cw0 = *(const f32x4*)(cw + c4), cw1 = *(const f32x4*)(cw + 256 + c4), cw2 = *(const f32x4*)(cw + 512 + c4);
                v4u rq, rk, rv; u32x2_ b0, g0_, u0, g1_, u1, g2_, u2;
#define AP_LOAD(rw) do { const int p1_ = prevrow(rw), p2_ = prevrow(p1_); const bf16* q_ = PROJ + (size_t)(rw) * INP; const bf16* q1_ = PROJ + (size_t)(p1_ < 0 ? (rw) : p1_) * INP; const bf16* q2_ = PROJ + (size_t)(p2_ < 0 ? (rw) : p2_) * INP; \
                    rq = *(const v4u*)(q_ + QOFF + 8 * lane); rk = *(const v4u*)(q_ + KOFF + 8 * lane); rv = *(const v4u*)(q_ + VOFF + 8 * lane); (void)q1_; (void)q2_; } while (0)
#define CV_LOAD(rw) do { const int p1_ = prevrow(rw), p2_ = prevrow(p1_); const bf16* q_ = PROJ + (size_t)(rw) * INP; const bf16* q1_ = PROJ + (size_t)(p1_ < 0 ? (rw) : p1_) * INP; const bf16* q2_ = PROJ + (size_t)(p2_ < 0 ? (rw) : p2_) * INP; \
                    b0 = *(const u32x2_*)(q_ + COFF + c4); g0_ = *(const u32x2_*)(q_ + COFF + 256 + c4); u0 = *(const u32x2_*)(q_ + COFF + 512 + c4); \
                    g1_ = *(const u32x2_*)(q1_ + COFF + 256 + c4); u1 = *(const u32x2_*)(q1_ + COFF + 512 + c4); g2_ = *(const u32x2_*)(q2_ + COFF + 256 + c4); u2 = *(const u32x2_*)(q2_ + COFF + 512 + c4); } while (0)
#define U2F4(t_) ((f32x4){__uint_as_float((t_).x << 16), __uint_as_float((t_).x & 0xffff0000u), __uint_as_float((t_).y << 16), __uint_as_float((t_).y & 0xffff0000u)})
                int idx = wave; AP_LOAD(MP_ROW(idx));
                for (; idx < nrows; idx += 8) { const int row = MP_ROW(idx);
                    const int p1 = prevrow(row), p2 = prevrow(p1); const float m1 = p1 < 0 ? 0.f : 1.f, m2 = p2 < 0 ? 0.f : 1.f;
                    const v4u cq = rq, ck = rk, cv = rv;
                    CV_LOAD(row);
                    if (idx + 8 < nrows) AP_LOAD(MP_ROW(idx + 8));
                    const int pos = row >= NREAL ? row - NREAL : NMETA + (row & (SEQ - 1));
                    const f32x4 c0 = *(const f32x4*)(COS + pos * 8), c1 = *(const f32x4*)(COS + pos * 8 + 4), n0 = *(const f32x4*)(SIN + pos * 8), n1 = *(const f32x4*)(SIN + pos * 8 + 4);
                    const float cs[8] = {c0.x, c0.y, c0.z, c0.w, c1.x, c1.y, c1.z, c1.w}; const float sn[8] = {n0.x, n0.y, n0.z, n0.w, n1.x, n1.y, n1.z, n1.w};
#pragma unroll
                    for (int which = 0; which < 2; ++which) {
                        const v4u raw = which ? ck : cq;
                        float x[8] = {__uint_as_float(raw.x << 16), __uint_as_float(raw.x & 0xffff0000u), __uint_as_float(raw.y << 16), __uint_as_float(raw.y & 0xffff0000u),
                                      __uint_as_float(raw.z << 16), __uint_as_float(raw.z & 0xffff0000u), __uint_as_float(raw.w << 16), __uint_as_float(raw.w & 0xffff0000u)};
                        float s2 = 0.f;
#pragma unroll
                        for (int i = 0; i < 8; ++i) s2 += x[i] * x[i];
                        s2 = sum8(s2);
                        const float rs = 1.f / sqrtf(s2 * (1.f / 64.f) + 1e-6f);
                        const f32x4 ga = which ? kg0 : qg0, gb = which ? kg1 : qg1;
                        const float gg[8] = {ga.x, ga.y, ga.z, ga.w, gb.x, gb.y, gb.z, gb.w};
                        float o[8];
#pragma unroll
                        for (int i = 0; i < 8; ++i) { const float xn = x[i] * rs * gg[i]; const float xp = lane_xor1(xn);
                            o[i] = sub == 0 ? xn * cs[i] - xp * sn[i] : (sub == 1 ? xn * cs[i] + xp * sn[i] : xn); if (!which) o[i] *= C2Q; }
                        v4u w; w.x = pk2(o[0], o[1]); w.y = pk2(o[2], o[3]); w.z = pk2(o[4], o[5]); w.w = pk2(o[6], o[7]);
                        if (!which) *(v4u*)(QN + (size_t)row * 512 + 8 * lane) = w;
                        else {
                            if (row < NREAL) { const size_t kr = (size_t)((row >> 12) * KVROWS + 128 + (row & (SEQ - 1))) * 512 + 8 * lane; *(v4u*)(KP + kr) = w; *(v4u*)(VP + kr) = cv; }
                            else {
#pragma unroll
                                for (int b = 0; b < NB; ++b) { const size_t kr = (size_t)(b * KVROWS + 48 + (row - NREAL)) * 512 + 8 * lane; *(v4u*)(KP + kr) = w; *(v4u*)(VP + kr) = cv; } } }
                    }
                    { const f32x4 fb0 = U2F4(b0), z0 = U2F4(g0_) * U2F4(u0), z1 = U2F4(g1_) * U2F4(u1) * m1, z2 = U2F4(g2_) * U2F4(u2) * m2;
                      const f32x4 y = cw0 * z2 + cw1 * z1 + cw2 * z0; const f32x4 o = fb0 * y;
                      *(unsigned long long*)(OMIX + (size_t)row * DM + 768 + c4) = (unsigned long long)pk2(o.x, o.y) | ((unsigned long long)pk2(o.z, o.w) << 32); }
                }
#undef AP_LOAD
#undef CV_LOAD
#undef U2F4
            }
            {
                LAS float* XL = (LAS float*)(lds + wave * 17408);
                LAS float* YL = XL + 32 * 65;
                const int nreal_g = ngrp - (bx == 0 ? 1 : 0);
                for (int lt = wave; lt < 4 * nreal_g + (bx == 0 ? 4 : 0); lt += NWAVES) {
                    int bh, ch; if (lt < 4 * nreal_g) { const int g = bx + 256 * (lt >> 2); bh = (g >> 8) * 4 + (lt & 3); ch = (g & 255) + 1; } else { bh = lt - 4 * nreal_g; ch = 0; }
                    const int task = bh * 257 + ch, b = bh >> 2, cb = (bh & 3) * 64; const int rowbase = ch == 0 ? NREAL : b * SEQ + 16 * (ch - 1);
                    float at[16], rt[16], bt[16], kt[16], vsv[16]; float gam = 1.f;
                    { const int c = cb + lane;
                      const float mu_r = mu[c], mu_k = mu[256 + c], mu_v = mu[512 + c], w0c = w0[c], a0c = a0[c], kkc = k_k[c], kac = k_a[c], rkc = r_k[c];
                      const int p0 = prevrow(rowbase); const bf16* q0 = PROJ + (size_t)(p0 < 0 ? rowbase : p0) * INP + c; const float pm = p0 < 0 ? 0.f : 1.f;
                      float pr_ = pm * bf2f(q0[0]), pk_ = pm * bf2f(q0[256]), pv_ = pm * bf2f(q0[512]);
                      unsigned short xr[16], xk[16], xv[16], la[16], lg[16]; float lw[16];
#pragma unroll
                      for (int t = 0; t < 16; ++t) { const bf16* q_ = PROJ + (size_t)(rowbase + t) * INP + c; xr[t] = q_[0]; xk[t] = q_[256]; xv[t] = q_[512];
                          lw[t] = LORA_W[(size_t)(rowbase + t) * 256 + c]; la[t] = LORA_AG[(size_t)(rowbase + t) * 512 + c]; lg[t] = LORA_AG[(size_t)(rowbase + t) * 512 + 256 + c]; }
#pragma unroll
                      for (int t = 0; t < 16; ++t) {
                          const float fr = bf2f(xr[t]), fk = bf2f(xk[t]), fv = bf2f(xv[t]);
                          const float r = fr + (pr_ - fr) * mu_r, k = fk + (pk_ - fk) * mu_k, v = fv + (pv_ - fv) * mu_v; pr_ = fr; pk_ = fk; pv_ = fv;
                          const float wacc = w0c + lw[t], aacc = a0c + bf2f(la[t]), gacc = bf2f(lg[t]);
                          const float nx = -wacc; const float sp = fmaxf(nx, 0.f) + __logf(1.f + __expf(-fabsf(nx)));
                          const float wlog = -sp - 0.5f; const float decay = __expf(-__expf(wlog));
                          const float a = sigmoidf_(aacc);
                          const float kkr = k * kkc; const float ss = wave_sum_dpp(kkr * kkr); const float kk = kkr / fmaxf(sqrtf(ss), 1e-12f);
                          const float k2 = k * (1.f + (a - 1.f) * kac);
                          const float bs = wave_sum_dpp(r * k2 * rkc);
                          const size_t si = (size_t)(rowbase + t) * 256 + c;
                          SG[si] = gacc; SBON[si] = bs * v;
                          at[t] = -kk * gam; gam *= decay; rt[t] = r * gam; const float ig = 1.f / gam; bt[t] = kk * a * ig; kt[t] = k2 * ig; vsv[t] = v; } }
#pragma unroll
                    for (int t = 0; t < 16; ++t) { XL[t * 65 + lane] = bt[t]; XL[(16 + t) * 65 + lane] = kt[t]; YL[t * 65 + lane] = at[t]; YL[(16 + t) * 65 + lane] = rt[t]; }
                    attn_body::f32x16 gm = attn_body::f32x16{};
#pragma unroll 8
                    for (int kk = 0; kk < 32; ++kk) gm = __builtin_amdgcn_mfma_f32_32x32x2f32(XL[(lane & 31) * 65 + 2 * kk + (lane >> 5)], YL[(lane & 31) * 65 + 2 * kk + (lane >> 5)], gm, 0, 0, 0);
                    LDS_WAIT();
                    LAS float* GL = YL; LAS float* TL = YL + 1056; LAS float* XM = YL + 1328;
#pragma unroll
                    for (int r = 0; r < 16; ++r) GL[((r & 3) + 8 * (r >> 2) + 4 * (lane >> 5)) * 33 + (lane & 31)] = gm[r];
                    float tr[16];
#pragma unroll
                    for (int t = 0; t < 16; ++t) tr[t] = ((lane & 15) == t) ? 1.f : 0.f;
#pragma unroll
                    for (int s = 0; s < 15; ++s)
#pragma unroll
                        for (int t = s + 1; t < 16; ++t) tr[t] = fmaf(tr[s], GL[s * 33 + t], tr[t]);
                    if (lane < 16) {
#pragma unroll
                        for (int t = 0; t < 16; ++t) TL[lane * 17 + t] = tr[t]; }
                    { const int s = lane & 15, q = lane >> 4; float x0 = 0.f, x1 = 0.f, x2 = 0.f, x3 = 0.f;
#pragma unroll
                      for (int u = 1; u < 16; ++u) { const float l = (u > s) ? GL[(16 + s) * 33 + u] : 0.f; x0 = fmaf(l, TL[u * 17 + 4 * q], x0); x1 = fmaf(l, TL[u * 17 + 4 * q + 1], x1); x2 = fmaf(l, TL[u * 17 + 4 * q + 2], x2); x3 = fmaf(l, TL[u * 17 + 4 * q + 3], x3); }
                      XM[s * 17 + 4 * q] = x0; XM[s * 17 + 4 * q + 1] = x1; XM[s * 17 + 4 * q + 2] = x2; XM[s * 17 + 4 * q + 3] = x3; }
                    float atT[16];
#pragma unroll
                    for (int sp = 0; sp < 16; ++sp) { float acc = 0.f;
#pragma unroll
                        for (int s = 0; s <= sp; ++s) acc = fmaf(at[s], TL[s * 17 + sp], acc);
                        atT[sp] = acc; }
                    unsigned char* rec = CH_REC + (size_t)task * CH_RB;
                    ((float*)rec)[lane] = gam;
                    LAS unsigned short* ST = (LAS unsigned short*)XL;
                    const int kpos = (lane & ~15) + 8 * ((lane >> 2) & 1) + (lane & 3) + 4 * ((lane >> 3) & 1);
                    float zz[16];
#pragma unroll
                    for (int s = 0; s < 16; ++s) { float acc = kt[s] * gam;
#pragma unroll
                        for (int sp = s + 1; sp < 16; ++sp) acc = fmaf(XM[s * 17 + sp], bt[sp] * gam, acc);
                        zz[s] = acc; }
#pragma unroll
                    for (int t = 0; t < 16; ++t) { float acc = rt[t];
#pragma unroll
                        for (int s = 0; s <= t; ++s) acc = fmaf(atT[s], GL[s * 33 + 16 + t], acc);
                        ST[t * 64 + kpos] = (unsigned short)f2bf(atT[t]); ST[(16 + t) * 64 + kpos] = (unsigned short)f2bf(acc); }
                    { v4u w0, w1;
                      w0.x = pk2(bt[0] * gam, bt[1] * gam); w0.y = pk2(bt[2] * gam, bt[3] * gam); w0.z = pk2(bt[8] * gam, bt[9] * gam); w0.w = pk2(bt[10] * gam, bt[11] * gam);
                      w1.x = pk2(bt[4] * gam, bt[5] * gam); w1.y = pk2(bt[6] * gam, bt[7] * gam); w1.z = pk2(bt[12] * gam, bt[13] * gam); w1.w = pk2(bt[14] * gam, bt[15] * gam);
                      v4u* d = (v4u*)(rec + 4352 + lane * 32); d[0] = w0; d[1] = w1;
                      v4u z0, z1; z0.x = pk2(zz[0], zz[1]); z0.y = pk2(zz[2], zz[3]); z0.z = pk2(zz[4], zz[5]); z0.w = pk2(zz[6], zz[7]);
                      z1.x = pk2(zz[8], zz[9]); z1.y = pk2(zz[10], zz[11]); z1.z = pk2(zz[12], zz[13]); z1.w = pk2(zz[14], zz[15]);
                      v4u* dz = (v4u*)(rec + 6400 + lane * 32); dz[0] = z0; dz[1] = z1; }
                    { float vs[16];
#pragma unroll
                      for (int s = 0; s < 16; ++s) vs[s] = vsv[s];
                      v4u a0, a1; a0.x = pk2(vs[0], vs[1]); a0.y = pk2(vs[2], vs[3]); a0.z = pk2(vs[4], vs[5]); a0.w = pk2(vs[6], vs[7]);
                      a1.x = pk2(vs[8], vs[9]); a1.y = pk2(vs[10], vs[11]); a1.z = pk2(vs[12], vs[13]); a1.w = pk2(vs[14], vs[15]);
                      v4u* dv = (v4u*)(rec + 8448 + lane * 32); dv[0] = a0; dv[1] = a1; }
                    { const int s = lane & 15, q = lane >> 4;
#pragma unroll
                      for (int e = 0; e < 4; ++e) { const int t = 4 * q + e; float acc = (t >= s) ? GL[(16 + s) * 33 + 16 + t] : 0.f;
#pragma unroll
                          for (int sp = 1; sp < 16; ++sp) { const float m = (sp <= t) ? GL[sp * 33 + 16 + t] : 0.f; acc = fmaf(XM[s * 17 + sp], m, acc); }
                          ((unsigned short*)(rec + 10496))[t * 16 + s] = (unsigned short)f2bf(acc); } }
                    LDS_WAIT();
                    { const LAS v4u* sv = (const LAS v4u*)ST + lane; v4u* d = (v4u*)(rec + 256) + lane;
#pragma unroll
                      for (int i = 0; i < 4; ++i) d[64 * i] = sv[64 * i]; }
                    LDS_WAIT();
                    if (ch == 0) {
                        asm volatile("s_waitcnt vmcnt(0)" ::: "memory");
                        const v4u* src = (const v4u*)rec;
#pragma unroll 1
                        for (int i = lane; i < CH_RB / 16; i += 64) { const v4u w = src[i];
#pragma unroll
                            for (int cp = 1; cp < 4; ++cp) ((v4u*)(CH_REC + (size_t)((bh + 4 * cp) * 257) * CH_RB))[i] = w; }
                    }
                }
            }
            SEAM(pb + 2);
        }
        for (int rep_ = 0; rep_ < NREP(3); ++rep_) if (EN(3) && IN(pb + 3)) { PH_TID;
#define PK8(T, o) ((v4u){attn_body::cvtpk_s(T[o], T[o + 1]), attn_body::cvtpk_s(T[o + 2], T[o + 3]), attn_body::cvtpk_s(T[o + 4], T[o + 5]), attn_body::cvtpk_s(T[o + 6], T[o + 7])})
            for (int rep2_ = 0; rep2_ < NREP(13); ++rep2_)
            if (bx < 32) {
                typedef attn_body::bf16x8 bfx8; typedef attn_body::f32x16 fx16;
                const int bh = bx >> 1, vh = bx & 1, n = lane & 31, hh = lane >> 5;
                const unsigned char* rec0 = CH_REC + (size_t)(bh * 257) * CH_RB;
                const unsigned lds0 = (unsigned)(uintptr_t)lds_raw;
                constexpr int RBUF = 6 * CH_RB;
#define S2_ISSUE(rnd) do { if (wave >= 1 && wave <= 6) { const int c_ = 6 * (rnd) + wave - 1; if (c_ < 257) { const unsigned dst_ = lds0 + ((rnd) & 1) * RBUF + (wave - 1) * CH_RB; \
                    for (int p_ = 0; p_ < 11; ++p_) attn_body::glds16s(rec0 + (size_t)c_ * CH_RB + p_ * 1024, (unsigned)lane * 16u, (unsigned)__builtin_amdgcn_readfirstlane(dst_ + p_ * 1024)); } } } while (0)
                S2_ISSUE(0);
                asm volatile("s_waitcnt vmcnt(0)\n\ts_barrier" ::: "memory");
                v4u* spk = (v4u*)(CH_SPK + (size_t)(bh * 257) * 8192 + vh * 4096) + lane;
                fx16 st0 = fx16{}, st1 = fx16{};
                for (int rnd = 0; rnd < 43; ++rnd) {
                    S2_ISSUE(rnd + 1);
                    if (wave == 0) {
                        v4u atf[4], bhf[2], ztf[2], vtf; f32x4 gq[8];
#define S2_FRAGS(j_) do { const LAS unsigned char* r_ = lds + (rnd & 1) * RBUF + (j_) * CH_RB; \
                            _Pragma("unroll") for (int ks = 0; ks < 4; ++ks) atf[ks] = *(const LAS v4u*)(r_ + 256 + ((lane & 15) * 64 + 16 * ks + 8 * hh) * 2); \
                            _Pragma("unroll") for (int i = 0; i < 2; ++i) { bhf[i] = *(const LAS v4u*)(r_ + 4352 + ((32 * i + n) * 16 + 8 * hh) * 2); ztf[i] = *(const LAS v4u*)(r_ + 6400 + ((32 * i + n) * 16 + 8 * hh) * 2); } \
                            vtf = *(const LAS v4u*)(r_ + 8448 + ((32 * vh + n) * 16 + 8 * hh) * 2); \
                            _Pragma("unroll") for (int i = 0; i < 2; ++i) _Pragma("unroll") for (int q = 0; q < 4; ++q) gq[4 * i + q] = *(const LAS f32x4*)(r_ + (32 * i + 8 * q + 4 * hh) * 4); } while (0)
                        S2_FRAGS(0);
                        for (int j = 0; j < 6; ++j) { const int ch = 6 * rnd + j; if (ch >= 257) break;
                            const v4u a0 = atf[0], a1 = atf[1], a2 = atf[2], a3 = atf[3], b0 = bhf[0], b1 = bhf[1], z0 = ztf[0], z1 = ztf[1], vt = vtf;
                            f32x4 g_[8];
#pragma unroll
                            for (int i = 0; i < 8; ++i) g_[i] = gq[i];
                            if (j < 5) S2_FRAGS(j + 1);
                            const v4u s0 = PK8(st0, 0), s1 = PK8(st0, 8), s2 = PK8(st1, 0), s3 = PK8(st1, 8);
                            spk[(size_t)ch * 512 + 0] = s0; spk[(size_t)ch * 512 + 64] = s1; spk[(size_t)ch * 512 + 128] = s2; spk[(size_t)ch * 512 + 192] = s3;
                            fx16 pt = fx16{};
                            pt = __builtin_amdgcn_mfma_f32_32x32x16_bf16(__builtin_bit_cast(bfx8, a0), __builtin_bit_cast(bfx8, s0), pt, 0, 0, 0);
                            pt = __builtin_amdgcn_mfma_f32_32x32x16_bf16(__builtin_bit_cast(bfx8, a1), __builtin_bit_cast(bfx8, s1), pt, 0, 0, 0);
                            pt = __builtin_amdgcn_mfma_f32_32x32x16_bf16(__builtin_bit_cast(bfx8, a2), __builtin_bit_cast(bfx8, s2), pt, 0, 0, 0);
                            pt = __builtin_amdgcn_mfma_f32_32x32x16_bf16(__builtin_bit_cast(bfx8, a3), __builtin_bit_cast(bfx8, s3), pt, 0, 0, 0);
#pragma unroll
                            for (int q = 0; q < 4; ++q) { st0[4 * q] *= g_[q].x; st0[4 * q + 1] *= g_[q].y; st0[4 * q + 2] *= g_[q].z; st0[4 * q + 3] *= g_[q].w;
                                                          st1[4 * q] *= g_[4 + q].x; st1[4 * q + 1] *= g_[4 + q].y; st1[4 * q + 2] *= g_[4 + q].z; st1[4 * q + 3] *= g_[4 + q].w; }
                            st0 = __builtin_amdgcn_mfma_f32_32x32x16_bf16(__builtin_bit_cast(bfx8, z0), __builtin_bit_cast(bfx8, vt), st0, 0, 0, 0);
                            st1 = __builtin_amdgcn_mfma_f32_32x32x16_bf16(__builtin_bit_cast(bfx8, z1), __builtin_bit_cast(bfx8, vt), st1, 0, 0, 0);
                            const v4u pp = PK8(pt, 0);
                            st0 = __builtin_amdgcn_mfma_f32_32x32x16_bf16(__builtin_bit_cast(bfx8, b0), __builtin_bit_cast(bfx8, pp), st0, 0, 0, 0);
                            st1 = __builtin_amdgcn_mfma_f32_32x32x16_bf16(__builtin_bit_cast(bfx8, b1), __builtin_bit_cast(bfx8, pp), st1, 0, 0, 0);
                        }
#undef S2_FRAGS
                        asm volatile("s_waitcnt lgkmcnt(0)\n\ts_barrier" ::: "memory");
                    } else asm volatile("s_waitcnt vmcnt(0) lgkmcnt(0)\n\ts_barrier" ::: "memory");
                }
#undef S2_ISSUE
            }
            __syncthreads();
            for (int rep2_ = 0; rep2_ < NREP(12); ++rep2_)
            { const attn_body::AttnTensors AT{(const attn_body::bf16*)QN, (const attn_body::bf16*)KP, (const attn_body::bf16*)VP, (attn_body::bf16*)OC};
              const attn_body::QueueOrder SO{(unsigned*)(ctl + CW_ATTQ + (layer * 8 + (bx & 7)) * 64), (LAS unsigned*)(lds + MISC_OFF + 64), bx & 7, wave};
              attn_body::attn_phase<attn_body::QueueOrder>((char*)lds_raw, AT, SO, wave); }
            __syncthreads();
#ifndef NO_META
            { int lane; asm volatile("v_mbcnt_lo_u32_b32 %0, -1, 0\n\tv_mbcnt_hi_u32_b32 %0, -1, %0" : "=v"(lane));
                LAS float* sc = (LAS float*)(lds + wave * 1024); LAS float* qs = sc + 64;
                for (int task = gw; task < NMETA * 8; task += NGW) {
                    const int row = NREAL + (task >> 3), hc = task & 7, h = hc >> 1; const int n = row - NREAL + 1;
                    qs[lane] = bf2f(QN[(size_t)row * 512 + hc * 64 + lane]);
                    float m = -INFINITY;
                    { const int idx = lane;
                        if (idx < n) { const size_t kr = 48 + idx; const v4u* kp = (const v4u*)(KP + kr * 512 + hc * 64); float dot = 0.f;
#pragma unroll
                            for (int c8 = 0; c8 < 8; ++c8) { const v4u kv = kp[c8];
                                dot += qs[c8 * 8 + 0] * __uint_as_float(kv.x << 16) + qs[c8 * 8 + 1] * __uint_as_float(kv.x & 0xffff0000u) + qs[c8 * 8 + 2] * __uint_as_float(kv.y << 16) + qs[c8 * 8 + 3] * __uint_as_float(kv.y & 0xffff0000u)
                                     + qs[c8 * 8 + 4] * __uint_as_float(kv.z << 16) + qs[c8 * 8 + 5] * __uint_as_float(kv.z & 0xffff0000u) + qs[c8 * 8 + 6] * __uint_as_float(kv.w << 16) + qs[c8 * 8 + 7] * __uint_as_float(kv.w & 0xffff0000u); }
                            sc[idx] = dot; m = dot; } }
                    m = wave_max(m);
                    float l = 0.f;
                    if (lane < n) { const float p = __builtin_amdgcn_exp2f(sc[lane] - m); sc[lane] = p; l = p; }
                    l = wave_sum(l);
                    float o0 = 0.f, o1 = 0.f;
                    for (int idx = 0; idx < n; ++idx) { const float p = sc[idx]; const size_t vr = 48 + idx;
                        const unsigned v2 = *(const unsigned*)(VP + vr * 512 + h * 128 + 2 * lane); o0 += p * __uint_as_float(v2 << 16); o1 += p * __uint_as_float(v2 & 0xffff0000u); }
                    const float inv = 1.f / l;
                    *(unsigned*)(OC + (size_t)row * 1024 + hc * 128 + 2 * lane) = pk2(o0 * inv, o1 * inv);
                    LDS_WAIT();
                }
            }
#endif
            SEAM(pb + 3);
        }
        for (int rep_ = 0; rep_ < NREP(4); ++rep_) if (EN(4) && IN(pb + 4)) { PH_TID;
            const float* gn_g = INP(13) + layer * 256; const float* gn_b = INP(14) + layer * 256; const float* subg = INP(21) + layer * 128;
            const float s1 = wave_sum(INP(17)[layer * 64 + lane] * INP(18)[layer * 64 + lane]); const float s2 = wave_sum(INP(19)[layer * 64 + lane] * INP(20)[layer * 64 + lane]);
            const float lam = __expf(s1) - __expf(s2) + lam_init;
            const int ngrp = (1025 - bx + 255) / 256, nrows = 16 * ngrp;
            {
                typedef attn_body::bf16x8 bfx8; typedef attn_body::f32x16 fx16;
                const int n = lane & 31, hh = lane >> 5;
                for (int lt = wave; lt < 8 * ngrp; lt += NWAVES) {
                    const int g = bx + 256 * (lt >> 3), hd = (lt >> 1) & 3, vh = lt & 1; const int bh = g < 1024 ? (g >> 8) * 4 + hd : hd, ch = g < 1024 ? (g & 255) + 1 : 0;
                    const int ct = bh * 257 + ch, b = bh >> 2, cb = (bh & 3) * 64; const int rowbase = ch == 0 ? NREAL : b * SEQ + 16 * (ch - 1);
                    const unsigned char* r_ = CH_REC + (size_t)ct * CH_RB; const v4u* spk = (const v4u*)(CH_SPK + (size_t)ct * 8192 + vh * 4096) + lane;
                    fx16 y = fx16{};
#pragma unroll
                    for (int ks = 0; ks < 4; ++ks) { const v4u a = *(const v4u*)(r_ + 2304 + ((lane & 15) * 64 + 16 * ks + 8 * hh) * 2); const v4u s = spk[64 * ks];
                        y = __builtin_amdgcn_mfma_f32_32x32x16_bf16(__builtin_bit_cast(bfx8, a), __builtin_bit_cast(bfx8, s), y, 0, 0, 0); }
                    { const v4u a = *(const v4u*)(r_ + 10496 + ((lane & 15) * 16 + 8 * hh) * 2); const v4u vt = *(const v4u*)(r_ + 8448 + ((32 * vh + n) * 16 + 8 * hh) * 2);
                      y = __builtin_amdgcn_mfma_f32_32x32x16_bf16(__builtin_bit_cast(bfx8, a), __builtin_bit_cast(bfx8, vt), y, 0, 0, 0); }
                    {
#pragma unroll
                        for (int r = 0; r < 8; ++r) SY[(size_t)(rowbase + (r & 3) + 8 * (r >> 2) + 4 * hh) * 256 + cb + 32 * vh + n] = y[r]; }
                }
            }
#undef PK8
            asm volatile("s_waitcnt vmcnt(0)" ::: "memory");
            __syncthreads();
            for (int idx = wave; idx < nrows; idx += NWAVES) { const int row = MP_ROW(idx);
                { const f32x4 y = *(const f32x4*)(SY + (size_t)row * 256 + 4 * lane); const float mean = sum16((y.x + y.y) + (y.z + y.w)) * (1.f / 64.f);
                  const f32x4 dlt = y - mean; const float var = sum16((dlt.x * dlt.x + dlt.y * dlt.y) + (dlt.z * dlt.z + dlt.w * dlt.w)) * (1.f / 64.f); const float rs = 1.f / sqrtf(var + 64e-5f);
                  const f32x4 gg = *(const f32x4*)(gn_g + 4 * lane), gb = *(const f32x4*)(gn_b + 4 * lane), bon = *(const f32x4*)(SBON + (size_t)row * 256 + 4 * lane), gt = *(const f32x4*)(SG + (size_t)row * 256 + 4 * lane);
                  const f32x4 o = (dlt * rs * gg + gb + bon) * gt;
                  *(unsigned long long*)(OMIX + (size_t)row * DM + 4 * lane) = (unsigned long long)pk2(o.x, o.y) | ((unsigned long long)pk2(o.z, o.w) << 32); }
                { const int h = lane >> 4, j8 = (lane & 15) * 8; const v4u a0 = *(const v4u*)(OC + (size_t)row * 1024 + (h * 2 + 0) * 128 + j8), a1 = *(const v4u*)(OC + (size_t)row * 1024 + (h * 2 + 1) * 128 + j8);
                  float dv[8];
                  dv[0] = __uint_as_float(a0.x << 16) - lam * __uint_as_float(a1.x << 16); dv[1] = __uint_as_float(a0.x & 0xffff0000u) - lam * __uint_as_float(a1.x & 0xffff0000u);
                  dv[2] = __uint_as_float(a0.y << 16) - lam * __uint_as_float(a1.y << 16); dv[3] = __uint_as_float(a0.y & 0xffff0000u) - lam * __uint_as_float(a1.y & 0xffff0000u);
                  dv[4] = __uint_as_float(a0.z << 16) - lam * __uint_as_float(a1.z << 16); dv[5] = __uint_as_float(a0.z & 0xffff0000u) - lam * __uint_as_float(a1.z & 0xffff0000u);
                  dv[6] = __uint_as_float(a0.w << 16) - lam * __uint_as_float(a1.w << 16); dv[7] = __uint_as_float(a0.w & 0xffff0000u) - lam * __uint_as_float(a1.w & 0xffff0000u);
                  float ss = 0.f;
#pragma unroll
                  for (int i = 0; i < 8; ++i) ss += dv[i] * dv[i];
                  ss = sum16(ss); const float sc_ = (1.f / sqrtf(ss * (1.f / 128.f) + 1e-5f)) * (1.f - lam_init);
                  const f32x4 g0 = *(const f32x4*)(subg + j8), g1 = *(const f32x4*)(subg + j8 + 4);
                  v4u o; o.x = pk2(dv[0] * sc_ * g0.x, dv[1] * sc_ * g0.y); o.y = pk2(dv[2] * sc_ * g0.z, dv[3] * sc_ * g0.w); o.z = pk2(dv[4] * sc_ * g1.x, dv[5] * sc_ * g1.y); o.w = pk2(dv[6] * sc_ * g1.z, dv[7] * sc_ * g1.w);
                  *(v4u*)(OMIX + (size_t)row * DM + 256 + h * 128 + j8) = o; }
            }
            { const int gt = bx * (NWAVES * 64) + tid, NGT = G * NWAVES * 64;
              for (int i = gt; i < (MPAD - NTOK) * (DM / 8); i += NGT) ((v4u*)(OMIX + (size_t)NTOK * DM))[i] = zero_v4u(); }
            SEAM(pb + 4);
        }
        if (EN(5) && IN(pb + 5)) { PH_TID;
            pg8::Gemm g{OMIX, (const bf16*)(ws + WS_WOUT) + (size_t)layer * DM * DM, NREAL, DM, DM}; pg8::StaticOrder S; S.init(NREAL, DM, G, bx);
            if (!moe) {
                if (layer == 2) {
                    meta_gemm_res(OMIX + (size_t)NREAL * DM, DM, (const bf16*)(ws + WS_WOUT) + (size_t)layer * DM * DM, Hf + (size_t)NREAL * DM, lds, bx, wave, lane, 2, (bf16*)((unsigned char*)HB + (size_t)NREAL * DM), RSQA + NREAL);
                    typedef pg8::EpiResAddHB<2, (long long)WS_HB - (long long)WS_H, (long long)WS_RSROW - (long long)WS_H> EpiHB2; EpiHB2 E{Hf, DM, 1.f};
                    pg8::gemm_phase<EpiHB2, pg8::StaticOrder, true, true>(lds, g, S, E, tid);
                } else {
                    meta_gemm_res(OMIX + (size_t)NREAL * DM, DM, (const bf16*)(ws + WS_WOUT) + (size_t)layer * DM * DM, Hf + (size_t)NREAL * DM, lds, bx, wave, lane, 1, HB + (size_t)NREAL * DM, RSQA + NREAL);
                    typedef pg8::EpiResAddHB<1, (long long)WS_HB - (long long)WS_H, (long long)WS_RSROW - (long long)WS_H> EpiHB1; EpiHB1 E{Hf, DM, 1.f};
                    pg8::gemm_phase<EpiHB1, pg8::StaticOrder, true, true>(lds, g, S, E, tid);
                }
            } else {
                meta_gemm_res(OMIX + (size_t)NREAL * DM, DM, (const bf16*)(ws + WS_WOUT) + (size_t)layer * DM * DM, Hf + (size_t)NREAL * DM, lds, bx, wave, lane);
                pg8::EpiResAdd E{Hf, DM, 1.f};
                pg8::gemm_phase<pg8::EpiResAdd, pg8::StaticOrder, true, true>(lds, g, S, E, tid);
            }
            SEAM(pb + 5);
        }
        if (EN(6) && IN(pb + 6) && moe) { PH_TID;
            LAS int* lcnt = (LAS int*)lds; LAS int* lbase = lcnt + 8; LAS int* lrow = lcnt + 16;
            if (tid < 16) lcnt[tid] = 0;
            __syncthreads();
            const float* gff = INP(24) + layer * DM; const float* Wr = INP(28) + (size_t)jj * DM * NE;
            for (int i = wave; i < 72; i += NWAVES) { const int row = bx + G * i;
                if (row < NTOK) {
                    const GAS f32x4* xr = (const GAS f32x4*)(Hf + (size_t)row * DM) + lane; f32x4 v[4]; float s = 0.f;
#pragma unroll
                    for (int j = 0; j < 4; ++j) { v[j] = xr[64 * j]; s += (v[j].x * v[j].x + v[j].y * v[j].y) + (v[j].z * v[j].z + v[j].w * v[j].w); }
                    s = wave_sum(s); const float rstd = 1.f / sqrtf(s * (1.f / DM) + 1e-6f);
                    if (moe) { LAS unsigned* o4 = (LAS unsigned*)(lds + 4096 + i * 1024) + lane; const float sn = rstd * A8_SCALE;
#pragma unroll
                      for (int j = 0; j < 4; ++j) o4[64 * j] = pk4_fp8(v[j].x * sn, v[j].y * sn, v[j].z * sn, v[j].w * sn); }
                    else if (layer == 2) { GAS unsigned* o4 = (GAS unsigned*)((GAS unsigned char*)HB + (size_t)row * DM) + lane; const float sn = rstd * A8_SCALE;
#pragma unroll
                      for (int j = 0; j < 4; ++j) o4[64 * j] = pk4_fp8(v[j].x * sn, v[j].y * sn, v[j].z * sn, v[j].w * sn); }
                    else { GAS unsigned long long* o8 = (GAS unsigned long long*)(HB + (size_t)row * DM) + lane;
#pragma unroll
                      for (int j = 0; j < 4; ++j) o8[64 * j] = (unsigned long long)pk2(v[j].x, v[j].y) | ((unsigned long long)pk2(v[j].z, v[j].w) << 32); }
                    if (lane == 0) RSTD[row] = rstd;
                    if (moe) {
                        float lg[8];
#pragma unroll
                        for (int e = 0; e < 8; ++e) lg[e] = 0.f;
#pragma unroll
                        for (int j = 0; j < 4; ++j) { const int k0 = 4 * lane + 256 * j; const f32x4 gv = *(const f32x4*)(gff + k0);
#pragma unroll
                            for (int q = 0; q < 4; ++q) { const float hv = v[j][q] * gv[q]; const f32x4 wa = *(const f32x4*)(Wr + (size_t)(k0 + q) * 8), wb = *(const f32x4*)(Wr + (size_t)(k0 + q) * 8 + 4);
                                lg[0] += hv * wa.x; lg[1] += hv * wa.y; lg[2] += hv * wa.z; lg[3] += hv * wa.w; lg[4] += hv * wb.x; lg[5] += hv * wb.y; lg[6] += hv * wb.z; lg[7] += hv * wb.w; } }
#pragma unroll
                        for (int e = 0; e < 8; ++e) lg[e] = wave_sum(lg[e]) * rstd;
                        int e1 = 0; float l1 = lg[0];
#pragma unroll
                        for (int e = 1; e < 8; ++e) if (lg[e] > l1) { l1 = lg[e]; e1 = e; }
                        int e2 = -1; float l2 = -INFINITY;
#pragma unroll
                        for (int e = 0; e < 8; ++e) if (e != e1 && lg[e] > l2) { l2 = lg[e]; e2 = e; }
                        if (lane == 0) { const float g2 = 1.f / (1.f + __expf(l1 - l2)); const float g1 = 1.f - g2;
                            const int sl1 = atomicAdd((int*)&lcnt[e1], 1), sl2 = atomicAdd((int*)&lcnt[e2], 1);
                            lrow[i * 4 + 0] = e1; lrow[i * 4 + 1] = sl1; lrow[i * 4 + 2] = e2; lrow[i * 4 + 3] = sl2;
                            TOKG[row * 2 + 0] = g1; TOKG[row * 2 + 1] = g2; }
                    }
                }
            }
            if (moe) {
                __syncthreads();
                if (tid < 8) lbase[tid] = (int)__hip_atomic_fetch_add((unsigned*)(ctl + CW_MOECNT + 64 * jj + tid), (unsigned)lcnt[tid], RLX_AGENT);
                __syncthreads();
                if (tid < 72) { const int row = bx + G * tid; if (row < NTOK) { const int e1 = lrow[tid * 4 + 0], e2 = lrow[tid * 4 + 2];
                    TOKE[row * 2 + 0] = e1; TOKE[row * 2 + 1] = e2; TOKS[row * 2 + 0] = lbase[e1] + lrow[tid * 4 + 1]; TOKS[row * 2 + 1] = lbase[e2] + lrow[tid * 4 + 3]; } }
                __syncthreads();
            }
            SEAM(pb + 6);
        }
        if (!moe) {
            for (int rep_ = 0; rep_ < NREP(7); ++rep_) if (EN(7) && IN(pb + 7)) { PH_TID;
                pg8::StaticOrder S; S.init(MPAD, FF2, G, bx);
                if (layer == 2) { pg8::Gemm g{HB, (const bf16*)(ws + WS_WGU) + (size_t)jj * FF2 * DM, MPAD, FF2, DM / 2}; pg8::EpiSwiglu8 E{GB, FF, nullptr, 1.f / (W8_SCALE * H8_SCALE), G8_SCALE, RSQA};
                    pg8::gemm_phase<pg8::EpiSwiglu8, pg8::StaticOrder, true, true, true>(lds, g, S, E, tid); }
                else { pg8::Gemm g{HB, (const bf16*)(ws + WS_WGU) + (size_t)jj * FF2 * DM, MPAD, FF2, DM}; pg8::EpiSwiglu E{GB, FF, nullptr, 1.f, 0.f, RSQA};
                    pg8::gemm_phase<pg8::EpiSwiglu, pg8::StaticOrder, true, true>(lds, g, S, E, tid); }
                SEAM(pb + 7);
            }
            if (EN(8) && IN(pb + 8)) { PH_TID;
                pg8::StaticOrder S; S.init(NREAL, DM, G, bx);
                static_assert(INP8 == 0xC, "the down-GEMM epilogues below leave layer 1's in-projection operand as bf16 and layer 3's as fp8");
                if (layer == 2) {
                    meta_gemm_res8((const unsigned char*)GB + (size_t)NREAL * FF, FF, (const unsigned char*)((const bf16*)(ws + WS_WD) + (size_t)jj * DM * FF), Hf + (size_t)NREAL * DM, 1.f / (W8_SCALE * G8_SCALE), lds, bx, wave, lane,
                                   2, (bf16*)((unsigned char*)HB + (size_t)NREAL * DM), RSQB + NREAL);
                    pg8::Gemm g{GB, (const bf16*)(ws + WS_WD) + (size_t)jj * DM * FF, NREAL, DM, FF / 2};
                    typedef pg8::EpiResAddHB<2, (long long)WS_HB - (long long)WS_H, (long long)WS_RSQB - (long long)WS_H> EpiDn2; EpiDn2 E{Hf, DM, 1.f / (W8_SCALE * G8_SCALE)};
                    pg8::gemm_phase<EpiDn2, pg8::StaticOrder, true, true, true>(lds, g, S, E, tid);
                } else {
                    meta_gemm_res(GB + (size_t)NREAL * FF, FF, (const bf16*)(ws + WS_WD) + (size_t)jj * DM * FF, Hf + (size_t)NREAL * DM, lds, bx, wave, lane, 1, HB + (size_t)NREAL * DM, RSQB + NREAL);
                    pg8::Gemm g{GB, (const bf16*)(ws + WS_WD) + (size_t)jj * DM * FF, NREAL, DM, FF};
                    typedef pg8::EpiResAddHB<1, (long long)WS_HB - (long long)WS_H, (long long)WS_RSQB - (long long)WS_H> EpiDn1; EpiDn1 E{Hf, DM, 1.f};
                    pg8::gemm_phase<EpiDn1, pg8::StaticOrder, true, true>(lds, g, S, E, tid);
                }
                __syncthreads();
                MOE_CONVERT(layer + 1, 0, NE * CONV_PER_E, gw, NGW);
                SEAM(pb + 8);
            }
        } else {
#define cnt ((const int*)(ctl + CW_MOECNT + 64 * jj))
            for (int rep_ = 0; rep_ < NREP(7); ++rep_) if (EN(7) && IN(pb + 7)) { PH_TID;
                int ts[8]; { int a = 0;
#pragma unroll
                    for (int e = 0; e < 8; ++e) { ts[e] = a; a += (__hip_atomic_load(cnt + e, RLX_AGENT) + 255) >> 8; } }
                { LAS const int* lbase = (LAS const int*)lds + 8; LAS const int* lrow = (LAS const int*)lds + 16;
                  for (int i = wave; i < 72; i += NWAVES) { const int row = bx + G * i;
                      if (row < NTOK) { const v4u d = *(const LAS v4u*)(lds + 4096 + i * 1024 + lane * 16);
#pragma unroll
                          for (int c = 0; c < 2; ++c) { const int e = lrow[i * 4 + 2 * c]; int tse = 0, lb = 0;
#pragma unroll
                              for (int x = 0; x < 8; ++x) { tse = (e == x) ? ts[x] : tse; lb = (e == x) ? lbase[x] : lb; }
                              const size_t p = (size_t)tse * 256 + lb + lrow[i * 4 + 2 * c + 1];
                              ((v4u*)((unsigned char*)AROWS + p * DM))[lane] = d; } } } }
                SEAM(pb + 7);
            }
            for (int rep_ = 0; rep_ < NREP(8); ++rep_) if (EN(8) && IN(pb + 8)) { PH_TID;
                pg8::Gemm g{AROWS, (const bf16*)(ws + WS_MWGU), MOEP, FF2, DM / 2}; pg8::MoeOrder S; S.init(cnt, FF2 / 256, G, bx);
                pg8::EpiSwiglu8 E{GB, FF, nullptr, 1.f / (W8_SCALE * A8_SCALE), G8_SCALE};
                pg8::gemm_phase<pg8::EpiSwiglu8, pg8::MoeOrder, true, true, true>(lds, g, S, E, tid);
                SEAM(pb + 8);
            }
            for (int rep_ = 0; rep_ < NREP(9); ++rep_) if (EN(9) && IN(pb + 9)) { PH_TID;
                pg8::Gemm g{GB, (const bf16*)(ws + WS_MWD), MOEP, DM, FF / 2}; pg8::MoeOrder S; S.init(cnt, DM / 256, G, bx);
                pg8::EpiBf16Rs E{YM, DM, nullptr, 1.f / (W8_SCALE * G8_SCALE)};
                pg8::gemm_phase<pg8::EpiBf16Rs, pg8::MoeOrder, true, true, true>(lds, g, S, E, tid);
                SEAM(pb + 9);
            }
            if (EN(10) && IN(pb + 10)) { PH_TID;
                int ts[8]; { int a = 0;
#pragma unroll
                    for (int e = 0; e < 8; ++e) { ts[e] = a; a += (__hip_atomic_load(cnt + e, RLX_AGENT) + 255) >> 8; } }
                for (int row = gw; row < NTOK; row += NGW) {
                    const int e1 = TOKE[row * 2], e2 = TOKE[row * 2 + 1]; int t1 = 0, t2 = 0;
#pragma unroll
                    for (int q = 0; q < 8; ++q) { t1 = (e1 == q) ? ts[q] : t1; t2 = (e2 == q) ? ts[q] : t2; }
                    const size_t p1 = (size_t)t1 * 256 + TOKS[row * 2], p2 = (size_t)t2 * 256 + TOKS[row * 2 + 1]; const float g1 = TOKG[row * 2], g2 = TOKG[row * 2 + 1];
                    float* hr = Hf + (size_t)row * DM; f32x4 hv[2][2]; float ssq = 0.f;
#pragma unroll
                    for (int j = 0; j < 2; ++j) { const int c8 = (lane + 64 * j) * 8; const v4u y1 = *(const v4u*)(YM + p1 * DM + c8), y2 = *(const v4u*)(YM + p2 * DM + c8);
                        f32x4 ha = *(f32x4*)(hr + c8), hb2 = *(f32x4*)(hr + c8 + 4);
                        ha.x += g1 * __uint_as_float(y1.x << 16) + g2 * __uint_as_float(y2.x << 16); ha.y += g1 * __uint_as_float(y1.x & 0xffff0000u) + g2 * __uint_as_float(y2.x & 0xffff0000u);
                        ha.z += g1 * __uint_as_float(y1.y << 16) + g2 * __uint_as_float(y2.y << 16); ha.w += g1 * __uint_as_float(y1.y & 0xffff0000u) + g2 * __uint_as_float(y2.y & 0xffff0000u);
                        hb2.x += g1 * __uint_as_float(y1.z << 16) + g2 * __uint_as_float(y2.z << 16); hb2.y += g1 * __uint_as_float(y1.z & 0xffff0000u) + g2 * __uint_as_float(y2.z & 0xffff0000u);
                        hb2.z += g1 * __uint_as_float(y1.w << 16) + g2 * __uint_as_float(y2.w << 16); hb2.w += g1 * __uint_as_float(y1.w & 0xffff0000u) + g2 * __uint_as_float(y2.w & 0xffff0000u);
                        hv[j][0] = ha; hv[j][1] = hb2; ssq += (ha.x * ha.x + ha.y * ha.y) + (ha.z * ha.z + ha.w * ha.w) + (hb2.x * hb2.x + hb2.y * hb2.y) + (hb2.z * hb2.z + hb2.w * hb2.w); }
                    if (layer == DEPTH - 1) {
                        if (row < NREAL) { float* orow = (*(float* const*)(ka + 256)) + (size_t)row * DM;
#pragma unroll
                            for (int j = 0; j < 2; ++j) { const int c8 = (lane + 64 * j) * 8; *(f32x4*)(orow + c8) = hv[j][0]; *(f32x4*)(orow + c8 + 4) = hv[j][1]; } }
                    } else {
                        ssq = wave_sum(ssq); const float rstd = 1.f / sqrtf(ssq * (1.f / DM) + 1e-6f), sn = rstd * A8_SCALE;
#pragma unroll
                        for (int j = 0; j < 2; ++j) { const int c8 = (lane + 64 * j) * 8; *(f32x4*)(hr + c8) = hv[j][0]; *(f32x4*)(hr + c8 + 4) = hv[j][1];
                            if ((INP8 >> (layer + 1)) & 1) { const unsigned lo = pk4_fp8(hv[j][0].x * sn, hv[j][0].y * sn, hv[j][0].z * sn, hv[j][0].w * sn), hi8 = pk4_fp8(hv[j][1].x * sn, hv[j][1].y * sn, hv[j][1].z * sn, hv[j][1].w * sn);
                                *(unsigned long long*)((unsigned char*)HB + (size_t)row * DM + c8) = (unsigned long long)lo | ((unsigned long long)hi8 << 32); }
                            else { v4u w; w.x = pk2(hv[j][0].x, hv[j][0].y); w.y = pk2(hv[j][0].z, hv[j][0].w); w.z = pk2(hv[j][1].x, hv[j][1].y); w.w = pk2(hv[j][1].z, hv[j][1].w);
                                *(v4u*)(HB + (size_t)row * DM + c8) = w; } }
                        if (lane == 0) RSTD[row] = rstd;
                    }
                }
                SEAM(pb + 10);
            }
        }
    }
#ifdef UBENCH
    if (hi >= 48 && bx == 255) { PH_TID;
        float x = (float)lane * 1e-3f, y = 1.0001f; float acc = 0.f;
        for (int it = 0; it < UBENCH_ITERS; ++it) {
#if UBENCH == 1
#pragma unroll
            for (int k = 0; k < 64; ++k) { asm volatile("v_fma_f32 %0, %0, %1, %0" : "+v"(x) : "v"(y)); }
#elif UBENCH == 2
#pragma unroll
            for (int k = 0; k < 64; ++k) { asm volatile("s_nop 1\n\tv_add_f32_dpp %0, %0, %0 row_mirror row_mask:0xf bank_mask:0xf bound_ctrl:1" : "+v"(x)); }
#elif UBENCH == 3
#pragma unroll
            for (int k = 0; k < 32; ++k) { asm volatile("s_nop 0\n\tv_readlane_b32 s20, %0, 63\n\tv_fmac_f32 %0, s20, %1" : "+v"(x) : "v"(y) : "s20"); }
#elif UBENCH == 5
            { float y2 = x + 1.f;
#pragma unroll
            for (int k = 0; k < 64; ++k) { asm volatile("s_nop 1\n\tv_add_f32_dpp %0, %0, %0 row_mirror row_mask:0xf bank_mask:0xf bound_ctrl:1\n\tv_add_f32_dpp %1, %1, %1 row_mirror row_mask:0xf bank_mask:0xf bound_ctrl:1" : "+v"(x), "+v"(y2)); }
            x += y2; }
#elif UBENCH == 6
            if (wave < 4) {
#pragma unroll
            for (int k = 0; k < 64; ++k) { asm volatile("s_nop 1\n\tv_add_f32_dpp %0, %0, %0 row_mirror row_mask:0xf bank_mask:0xf bound_ctrl:1" : "+v"(x)); } }
#elif UBENCH == 7
            if (wave < 4) {
#pragma unroll
            for (int k = 0; k < 64; ++k) { asm volatile("v_fma_f32 %0, %0, %1, %0" : "+v"(x) : "v"(y)); } }
#elif UBENCH == 8
            { float y2 = x + 1.f, y3 = x + 2.f, y4 = x + 3.f;
#pragma unroll
            for (int k = 0; k < 64; ++k) { asm volatile("s_nop 1\n\tv_add_f32_dpp %0, %0, %0 row_mirror row_mask:0xf bank_mask:0xf bound_ctrl:1\n\tv_add_f32_dpp %1, %1, %1 row_mirror row_mask:0xf bank_mask:0xf bound_ctrl:1\n\tv_add_f32_dpp %2, %2, %2 row_mirror row_mask:0xf bank_mask:0xf bound_ctrl:1\n\tv_add_f32_dpp %3, %3, %3 row_mirror row_mask:0xf bank_mask:0xf bound_ctrl:1" : "+v"(x), "+v"(y2), "+v"(y3), "+v"(y4)); }
            x += y2 + y3 + y4; }
#elif UBENCH == 4
#pragma unroll
            for (int k = 0; k < 64; ++k) { asm volatile("s_nop 1\n\tv_add_f32_dpp %0, %0, %0 row_bcast:15 row_mask:0xa bank_mask:0xf" : "+v"(x)); }
#endif
        }
        acc += x;
        if (acc == 123.456f) ((float*)(ws + WS_CTL))[2000 + tid] = acc;
    }
#endif
#undef IN
#undef SEAM
}

#ifndef MK_ONE_LAUNCH
#endif
extern "C" void kernel_launch(void* const* d_in, const int* in_sizes, int n_in, void* d_out, int out_size, void* d_ws, size_t ws_size, hipStream_t stream) {
    static int grid = 0;
    if (grid == 0) {
        if (n_in != 32 || out_size != NREAL * DM || ws_size < WS_END) { fprintf(stderr, "kernel_launch: unexpected shapes (n_in %d out %d ws %zu need %zu); nothing launched\n", n_in, out_size, ws_size, (size_t)WS_END); grid = -1; return; }
        int dev = 0, cus = 0, per_cu = 0;
        if (hipGetDevice(&dev) != hipSuccess || hipDeviceGetAttribute(&cus, hipDeviceAttributeMultiprocessorCount, dev) != hipSuccess) { grid = -1; return; }
        if (hipFuncSetAttribute((const void*)hymba_fwd, hipFuncAttributeMaxDynamicSharedMemorySize, LDS_BYTES) != hipSuccess) { fprintf(stderr, "kernel_launch: hipFuncSetAttribute failed\n"); grid = -1; return; }
        if (hipOccupancyMaxActiveBlocksPerMultiprocessor(&per_cu, (const void*)hymba_fwd, NWAVES * 64, LDS_BYTES) != hipSuccess || per_cu < 1) fprintf(stderr, "kernel_launch: occupancy query says %d\n", per_cu);
        (void)hipGetLastError();
        grid = cus;
        if (grid != 256) { fprintf(stderr, "kernel_launch: built for 256 CUs, device has %d; nothing launched\n", cus); grid = -1; return; }
    }
    if (grid < 0) return;
    if (hipMemsetAsync((char*)d_ws + WS_CTL, 0, CTL_ZERO_BYTES, stream) != hipSuccess) return;
    Args a{};
    for (int i = 0; i < 32; ++i) a.in[i] = (const float*)d_in[i];
    a.out = (float*)d_out; a.ws = (unsigned char*)d_ws;
#if MK_ONE_LAUNCH
    a.ph_lo = 0; a.ph_hi = 48;
    hipLaunchKernelGGL(hymba_fwd, dim3(grid), dim3(NWAVES * 64), LDS_BYTES, stream, a);
#else
    for (int ph = 0; ph < 50; ++ph) {
        if (ph >= 1 && ph <= 48) { const int l = (ph - 1) / 12, k = (ph - 1) % 12; const bool moe = l & 1; if (k == 11 || (!moe && k >= 9)) continue; }
        a.ph_lo = ph; a.ph_hi = ph + 1;
        hipLaunchKernelGGL(hymba_fwd, dim3(grid), dim3(NWAVES * 64), LDS_BYTES, stream, a);
    }
#endif
}
```

```cpp
#include <hip/hip_runtime.h>
#include <hip/hip_bf16.h>
#include <cmath>
#include <cstdio>
#include <cstdint>
namespace pg8 {
#define PG8_LAS __attribute__((address_space(3)))
typedef unsigned short bf16_t;
typedef short bf16x8 __attribute__((ext_vector_type(8)));
typedef float f32x4 __attribute__((ext_vector_type(4)));
typedef float f32x2 __attribute__((ext_vector_type(2)));
typedef unsigned u32x4 __attribute__((ext_vector_type(4)));
constexpr int BM = 256, BK = 64, HALF = 128, HTB = HALF * BK * 2  , STAGE_BYTES = 8 * HTB, NXCD = 8, WGM = 8;

__host__ __device__ __forceinline__ int lds_byte(int r, int c) { const int st = (r >> 4) * 2 + (c >> 5), rr = r & 15, cc = c & 31, ob = rr * 64 + cc * 2; return st * 1024 + (ob ^ (((ob >> 9) & 1) << 5)); }
__host__ __device__ __forceinline__ void stage_rc(int b, int& R, int& C) { const int st = b / 1024, sb = b % 1024, swz = sb ^ (((sb >> 9) & 1) << 5); R = (st >> 1) * 16 + swz / 64; C = (st & 1) * 32 + (swz % 64) / 2; }
__host__ __device__ __forceinline__ int perm32(int rho) { const int n = rho >> 4, i = rho & 15; return 8 * (i >> 2) + 4 * n + (i & 3); }

struct Unit { int pm, pn, pc; };
struct Gemm { const bf16_t* A; const bf16_t* Bt; int M, N, K; };

struct StaticOrder {
    int nM, nN, nwg, G, c;
    __host__ __device__ void init(int M, int N, int G_, int c_) { nM = M / BM; nN = N / BM; nwg = nM * nN; G = G_; c = c_; }
    __host__ __device__ bool next(int i, Unit& u) const {
        const long L = (long)i * G + c; if (L >= nwg) return false;
        int wgid = (int)L; { const int q = nwg / NXCD, r = nwg % NXCD, xcd = wgid % NXCD, off = wgid / NXCD; wgid = (xcd < r ? xcd * (q + 1) : r * (q + 1) + (xcd - r) * q) + off; }
        const int nig = WGM * nN, gid = wgid / nig, fm = gid * WGM, gsz = (nM - fm) < WGM ? (nM - fm) : WGM;
        u.pm = fm + ((wgid % nig) % gsz); u.pn = (wgid % nig) / gsz; u.pc = u.pn; return true;
    }
    __device__ __forceinline__ void a_ready(const Unit&) const {}
    __device__ __forceinline__ void done(const Unit&) const {}
};
struct MoeOrder {
    int G, c, nN, total; int t1, t2, t3, t4, t5, t6, t7;
    __device__ __forceinline__ void init(const int* cnt, int nN_, int G_, int c_) {
        G = G_; c = c_; nN = nN_; int a = 0;
        a += (__builtin_amdgcn_readfirstlane(__hip_atomic_load(cnt + 0, __ATOMIC_RELAXED, __HIP_MEMORY_SCOPE_AGENT)) + 255) >> 8; t1 = a;
        a += (__builtin_amdgcn_readfirstlane(__hip_atomic_load(cnt + 1, __ATOMIC_RELAXED, __HIP_MEMORY_SCOPE_AGENT)) + 255) >> 8; t2 = a;
        a += (__builtin_amdgcn_readfirstlane(__hip_atomic_load(cnt + 2, __ATOMIC_RELAXED, __HIP_MEMORY_SCOPE_AGENT)) + 255) >> 8; t3 = a;
        a += (__builtin_amdgcn_readfirstlane(__hip_atomic_load(cnt + 3, __ATOMIC_RELAXED, __HIP_MEMORY_SCOPE_AGENT)) + 255) >> 8; t4 = a;
        a += (__builtin_amdgcn_readfirstlane(__hip_atomic_load(cnt + 4, __ATOMIC_RELAXED, __HIP_MEMORY_SCOPE_AGENT)) + 255) >> 8; t5 = a;
        a += (__builtin_amdgcn_readfirstlane(__hip_atomic_load(cnt + 5, __ATOMIC_RELAXED, __HIP_MEMORY_SCOPE_AGENT)) + 255) >> 8; t6 = a;
        a += (__builtin_amdgcn_readfirstlane(__hip_atomic_load(cnt + 6, __ATOMIC_RELAXED, __HIP_MEMORY_SCOPE_AGENT)) + 255) >> 8; t7 = a;
        a += (__builtin_amdgcn_readfirstlane(__hip_atomic_load(cnt + 7, __ATOMIC_RELAXED, __HIP_MEMORY_SCOPE_AGENT)) + 255) >> 8;
        total = a * nN;
    }
    __device__ __forceinline__ bool next(int i, Unit& u) const {
        const int x = c & 7, per = G >> 3; const int e_ = i * per + (c >> 3);
        const int ntile = total / nN; const int mine = (ntile - x + 7) >> 3;
        if (e_ >= mine * nN) return false;
        const int rt = x + 8 * (e_ / nN), j = e_ % nN;
        const int e = (rt >= t1) + (rt >= t2) + (rt >= t3) + (rt >= t4) + (rt >= t5) + (rt >= t6) + (rt >= t7);
        u.pm = rt; u.pn = e * nN + j; u.pc = j; return true;
    }
    __device__ __forceinline__ void a_ready(const Unit&) const {}
    __device__ __forceinline__ void done(const Unit&) const {}
};

__device__ __forceinline__ unsigned cvt_pk_bf16(float lo, float hi) { unsigned r; asm volatile("v_cvt_pk_bf16_f32 %0, %1, %2" : "=v"(r) : "v"(lo), "v"(hi)); return r; }

#define PG8_GAS __attribute__((address_space(1)))
struct EpiBf16Rs {
    static constexpr bool PERM = true, AFTER_DRAIN = false;
    bf16_t* O; int ldc; const float* rs; float sc;
    __device__ __forceinline__ void operator()(const f32x4 (&acc)[2][2][4][2], const Unit& u, int wr, int wc, int fr, int fq) const {
        const int row0 = u.pm * BM + wr * 64 + fr; const int col0 = u.pc * BM + wc * 32 + 8 * fq;
        float sv[2][4];
#pragma unroll
        for (int ai = 0; ai < 2; ++ai)
#pragma unroll
            for (int m = 0; m < 4; ++m) sv[ai][m] = rs ? ((const PG8_GAS float*)rs)[row0 + ai * HALF + m * 16] : sc;
#pragma unroll
        for (int ai = 0; ai < 2; ++ai)
#pragma unroll
            for (int m = 0; m < 4; ++m) { const int row = row0 + ai * HALF + m * 16; const float s = sv[ai][m]; PG8_GAS bf16_t* rowp = (PG8_GAS bf16_t*)O + (size_t)row * ldc + col0;
#pragma unroll
                for (int bj = 0; bj < 2; ++bj) { const f32x4 v0 = acc[ai][bj][m][0] * s, v1 = acc[ai][bj][m][1] * s;
                    u32x4 w; w.x = cvt_pk_bf16(v0[0], v0[1]); w.y = cvt_pk_bf16(v0[2], v0[3]); w.z = cvt_pk_bf16(v1[0], v1[1]); w.w = cvt_pk_bf16(v1[2], v1[3]);
                    *(PG8_GAS u32x4*)(rowp + bj * HALF) = w; } }
    }
};
struct EpiResAdd {
    static constexpr bool PERM = false, AFTER_DRAIN = false;
    float* H; int ldc; float sc;
    __device__ __forceinline__ void operator()(const f32x4 (&acc)[2][2][4][2], const Unit& u, int wr, int wc, int fr, int fq) const {
        const int row0 = u.pm * BM + wr * 64 + fr; const int col0 = u.pc * BM + wc * 32 + 4 * fq;
#pragma unroll
        for (int ai = 0; ai < 2; ++ai)
#pragma unroll
            for (int mp = 0; mp < 2; ++mp) {
                f32x4 res[2][2][2];
#pragma unroll
                for (int m2 = 0; m2 < 2; ++m2) { const PG8_GAS float* rowp = (const PG8_GAS float*)H + (size_t)(row0 + ai * HALF + (2 * mp + m2) * 16) * ldc + col0;
#pragma unroll
                    for (int bj = 0; bj < 2; ++bj)
#pragma unroll
                        for (int n = 0; n < 2; ++n) res[m2][bj][n] = *(const PG8_GAS f32x4*)(rowp + bj * HALF + n * 16); }
#pragma unroll
                for (int m2 = 0; m2 < 2; ++m2) { PG8_GAS float* rowp = (PG8_GAS float*)H + (size_t)(row0 + ai * HALF + (2 * mp + m2) * 16) * ldc + col0;
#pragma unroll
                    for (int bj = 0; bj < 2; ++bj)
#pragma unroll
                        for (int n = 0; n < 2; ++n) *(PG8_GAS f32x4*)(rowp + bj * HALF + n * 16) = res[m2][bj][n] + acc[ai][bj][2 * mp + m2][n] * sc; }
                asm volatile("" ::: "memory");
            }
    }
};
template <int MODE, long long HB_OFF, long long RSQ_OFF> struct EpiResAddHB {
    static constexpr bool PERM = true, AFTER_DRAIN = false; static constexpr float hs = 4.f;
    float* H; int ldc; float sc;
    __device__ __forceinline__ void operator()(const f32x4 (&acc)[2][2][4][2], const Unit& u, int wr, int wc, int fr, int fq) const {
        const int row0 = u.pm * BM + wr * 64 + fr; const int col0 = u.pc * BM + wc * 32 + 8 * fq;
        PG8_GAS unsigned char* const HBo = (PG8_GAS unsigned char*)H + HB_OFF; PG8_GAS unsigned long long* const rsq = (PG8_GAS unsigned long long*)((PG8_GAS unsigned char*)H + RSQ_OFF);
#pragma unroll
        for (int ai = 0; ai < 2; ++ai)
#pragma unroll
            for (int m = 0; m < 4; ++m) { const int row = row0 + ai * HALF + m * 16; PG8_GAS float* rowp = (PG8_GAS float*)H + (size_t)row * ldc + col0;
                f32x4 r_[2][2];
#pragma unroll
                for (int bj = 0; bj < 2; ++bj)
#pragma unroll
                    for (int n = 0; n < 2; ++n) r_[bj][n] = *(const PG8_GAS f32x4*)(rowp + bj * HALF + n * 4);
                float ss = 0.f;
#pragma unroll
                for (int bj = 0; bj < 2; ++bj) { const f32x4 v0 = r_[bj][0] + acc[ai][bj][m][0] * sc, v1 = r_[bj][1] + acc[ai][bj][m][1] * sc;
                    *(PG8_GAS f32x4*)(rowp + bj * HALF) = v0; *(PG8_GAS f32x4*)(rowp + bj * HALF + 4) = v1;
                    ss += ((v0[0] * v0[0] + v0[1] * v0[1]) + (v0[2] * v0[2] + v0[3] * v0[3])) + ((v1[0] * v1[0] + v1[1] * v1[1]) + (v1[2] * v1[2] + v1[3] * v1[3]));
                    if constexpr (MODE == 1) { u32x4 w; w.x = cvt_pk_bf16(v0[0], v0[1]); w.y = cvt_pk_bf16(v0[2], v0[3]); w.z = cvt_pk_bf16(v1[0], v1[1]); w.w = cvt_pk_bf16(v1[2], v1[3]);
                        *(PG8_GAS u32x4*)((PG8_GAS bf16_t*)HBo + (size_t)row * ldc + col0 + bj * HALF) = w; }
                    else {
#define PG8_C8(x) __builtin_amdgcn_fmed3f((x) * hs, -448.f, 448.f)
                        unsigned lo = (unsigned)__builtin_amdgcn_cvt_pk_fp8_f32(PG8_C8(v0[0]), PG8_C8(v0[1]), 0, false); lo = (unsigned)__builtin_amdgcn_cvt_pk_fp8_f32(PG8_C8(v0[2]), PG8_C8(v0[3]), (int)lo, true);
                        unsigned hi = (unsigned)__builtin_amdgcn_cvt_pk_fp8_f32(PG8_C8(v1[0]), PG8_C8(v1[1]), 0, false); hi = (unsigned)__builtin_amdgcn_cvt_pk_fp8_f32(PG8_C8(v1[2]), PG8_C8(v1[3]), (int)hi, true);
#undef PG8_C8
                        *(PG8_GAS unsigned long long*)(HBo + (size_t)row * ldc + col0 + bj * HALF) = (unsigned long long)lo | ((unsigned long long)hi << 32); } }
                { auto p_ = __builtin_amdgcn_permlane16_swap(__float_as_uint(ss), __float_as_uint(ss), false, false); ss = __uint_as_float(p_[0]) + __uint_as_float(p_[1]); }
                { auto p_ = __builtin_amdgcn_permlane32_swap(__float_as_uint(ss), __float_as_uint(ss), false, false); ss = __uint_as_float(p_[0]) + __uint_as_float(p_[1]); }
                if (fq == 0) __hip_atomic_fetch_add(rsq + row, (unsigned long long)(ss * 16777216.f), __ATOMIC_RELAXED, __HIP_MEMORY_SCOPE_AGENT);
                asm volatile("" ::: "memory"); }
    }
};
template <bool OUT8> struct EpiSwigluT {
    static constexpr bool PERM = true, AFTER_DRAIN = false;
    bf16_t* O; int ldc; const float* rs; float sc; float o8; const unsigned long long* rsq;
    __device__ __forceinline__ void operator()(const f32x4 (&acc)[2][2][4][2], const Unit& u, int wr, int wc, int fr, int fq) const {
        const int row0 = u.pm * BM + wr * 64 + fr; const int col0 = u.pc * HALF + wc * 32 + 8 * fq;
        float sv[2][4];
#pragma unroll
        for (int ai = 0; ai < 2; ++ai)
#pragma unroll
            for (int m = 0; m < 4; ++m) sv[ai][m] = rsq ? sc * __builtin_amdgcn_rsqf((float)((const PG8_GAS unsigned long long*)rsq)[row0 + ai * HALF + m * 16] * (1.f / (16777216.f * 1024.f)) + 1e-6f) : (rs ? ((const PG8_GAS float*)rs)[row0 + ai * HALF + m * 16] : sc);
#pragma unroll
        for (int ai = 0; ai < 2; ++ai)
#pragma unroll
            for (int m = 0; m < 4; ++m) { const int row = row0 + ai * HALF + m * 16; const float s = sv[ai][m]; PG8_GAS bf16_t* rowp = (PG8_GAS bf16_t*)O + (size_t)row * ldc + col0;
                const float c1 = -1.4426950408889634f * s, c2 = OUT8 ? s * s * o8 : s * s;
                f32x2 q[4];
#pragma unroll
                for (int n = 0; n < 2; ++n)
#pragma unroll
                    for (int h = 0; h < 2; ++h) { const f32x4 av = acc[ai][0][m][n], bv = acc[ai][1][m][n];
                        const f32x2 a = h ? (f32x2){av[2], av[3]} : (f32x2){av[0], av[1]}, b = h ? (f32x2){bv[2], bv[3]} : (f32x2){bv[0], bv[1]};
                        const f32x2 t = a * c1; f32x2 e; e.x = __builtin_amdgcn_exp2f(t.x); e.y = __builtin_amdgcn_exp2f(t.y);
                        const f32x2 d = e + 1.f; f32x2 r; r.x = __builtin_amdgcn_rcpf(d.x); r.y = __builtin_amdgcn_rcpf(d.y);
                        q[2 * n + h] = ((a * b) * r) * c2; }
                if constexpr (OUT8) { PG8_GAS unsigned char* rp8 = (PG8_GAS unsigned char*)O + (size_t)row * ldc + col0;
#define PG8_C8(x) __builtin_amdgcn_fmed3f((x), -448.f, 448.f)
                    unsigned lo = (unsigned)__builtin_amdgcn_cvt_pk_fp8_f32(PG8_C8(q[0].x), PG8_C8(q[0].y), 0, false); lo = (unsigned)__builtin_amdgcn_cvt_pk_fp8_f32(PG8_C8(q[1].x), PG8_C8(q[1].y), (int)lo, true);
                    unsigned hi = (unsigned)__builtin_amdgcn_cvt_pk_fp8_f32(PG8_C8(q[2].x), PG8_C8(q[2].y), 0, false); hi = (unsigned)__builtin_amdgcn_cvt_pk_fp8_f32(PG8_C8(q[3].x), PG8_C8(q[3].y), (int)hi, true);
#undef PG8_C8
                    *(PG8_GAS unsigned long long*)rp8 = (unsigned long long)lo | ((unsigned long long)hi << 32); }
                else { u32x4 w; w.x = cvt_pk_bf16(q[0].x, q[0].y); w.y = cvt_pk_bf16(q[1].x, q[1].y); w.z = cvt_pk_bf16(q[2].x, q[2].y); w.w = cvt_pk_bf16(q[3].x, q[3].y);
                    *(PG8_GAS u32x4*)rowp = w; } }
    }
};
typedef EpiSwigluT<false> EpiSwiglu; typedef EpiSwigluT<true> EpiSwiglu8;

template <class Epi, class Sched, bool ALIGN_EPI = false, bool SP2 = false, bool FP8 = false>
__device__ __forceinline__ void gemm_phase(PG8_LAS unsigned char* lds, const Gemm g, const Sched& S, const Epi& E, int tid_in) {
    int tid_ = tid_in; asm volatile("" : "+v"(tid_));
    const int tid = tid_, wid = __builtin_amdgcn_readfirstlane(tid >> 6), lane = tid & 63, wr = wid >> 2, wc = wid & 3, fr = lane & 15, fq = lane >> 4;
    const int K = g.K, nt = K / BK;
    unsigned voffA[2], voffB[2];
#pragma unroll
    for (int i = 0; i < 2; ++i) { int R, C; stage_rc(tid * 16 + i * 8192, R, C); const int Rb = Epi::PERM ? ((R & ~31) + perm32(R & 31)) : R;
        voffA[i] = (unsigned)(R * K + C) * 2u; voffB[i] = (unsigned)(Rb * K + C) * 2u; }
    const size_t kstep = (size_t)(BK * 2);
    const size_t hstep = (size_t)HALF * K * 2;
    const size_t tstep = 2 * hstep;
    const unsigned ldsw = (unsigned)wid * 1024u;
    const int aoff = lds_byte(wr * 64 + fr, fq * 8), boff = lds_byte(wc * 32 + fr, fq * 8);
#define PG8_SA(b, h) (((b) * 2 + (h)) * HTB)
#define PG8_SB(b, h) ((4 + (b) * 2 + (h)) * HTB)
#define PG8_STAGE(bufoff, gbase, voff) do { _Pragma("unroll") for (int _i = 0; _i < 2; ++_i) \
        __builtin_amdgcn_global_load_lds((const unsigned*)((const char*)(gbase) + (voff)[_i]), (PG8_LAS unsigned*)(lds + (bufoff) + ldsw + _i * 8192), 16, 0, 0); } while (0)
#define PG8_LDA(dst, b, h) do { _Pragma("unroll") for (int m = 0; m < 4; ++m) _Pragma("unroll") for (int k = 0; k < 2; ++k) dst[m][k] = *(const PG8_LAS bf16x8*)(lds + PG8_SA(b, h) + aoff + m * 2048 + k * 1024); } while (0)
#define PG8_LDB(dst, b, h) do { _Pragma("unroll") for (int n = 0; n < 2; ++n) _Pragma("unroll") for (int k = 0; k < 2; ++k) dst[n][k] = *(const PG8_LAS bf16x8*)(lds + PG8_SB(b, h) + boff + n * 2048 + k * 1024); } while (0)
#define PG8_MMA(ai, bj, At, Bt) do { __builtin_amdgcn_s_setprio(1); \
        if constexpr (FP8) { typedef int v8i_ __attribute__((ext_vector_type(8))); typedef int v4i_ __attribute__((ext_vector_type(4))); const int sc8_ = 0x7f7f7f7f;     \
            _Pragma("unroll") for (int m = 0; m < 4; ++m) _Pragma("unroll") for (int n = 0; n < 2; ++n) { \
                const v4i_ b0_ = __builtin_bit_cast(v4i_, Bt[n][0]), b1_ = __builtin_bit_cast(v4i_, Bt[n][1]), a0_ = __builtin_bit_cast(v4i_, At[m][0]), a1_ = __builtin_bit_cast(v4i_, At[m][1]); \
                const v8i_ bb_ = (v8i_){b0_.x, b0_.y, b0_.z, b0_.w, b1_.x, b1_.y, b1_.z, b1_.w}, aa_ = (v8i_){a0_.x, a0_.y, a0_.z, a0_.w, a1_.x, a1_.y, a1_.z, a1_.w}; \
                asm volatile("v_mfma_scale_f32_16x16x128_f8f6f4 %0, %1, %2, %0, %3, %3 op_sel_hi:[0,0,0]" : "+v"(acc[ai][bj][m][n]) : "v"(bb_), "v"(aa_), "v"(sc8_)); } \
        } else { _Pragma("unroll") for (int m = 0; m < 4; ++m) _Pragma("unroll") for (int n = 0; n < 2; ++n) _Pragma("unroll") for (int k = 0; k < 2; ++k) \
            acc[ai][bj][m][n] = __builtin_amdgcn_mfma_f32_16x16x32_bf16(Bt[n][k], At[m][k], acc[ai][bj][m][n], 0, 0, 0); } \
        __builtin_amdgcn_s_setprio(0); } while (0)
#define PG8_WAIT_V(n) asm volatile("s_waitcnt vmcnt(" #n ")" ::: "memory")
#define PG8_WAIT_L(n) asm volatile("s_waitcnt lgkmcnt(" #n ")" ::: "memory")
#define PG8_BAR __builtin_amdgcn_s_barrier()
#define PG8_SCHED __builtin_amdgcn_sched_barrier(0)
    Unit cur, nxt; int ui = 0;
    if (!S.next(0, cur)) return;
    f32x4 acc[2][2][4][2];
    { float zf; asm volatile("v_mov_b32 %0, 0" : "=v"(zf));
#pragma unroll
    for (int a = 0; a < 2; ++a)
#pragma unroll
        for (int b = 0; b < 2; ++b)
#pragma unroll
            for (int m = 0; m < 4; ++m)
#pragma unroll
                for (int n = 0; n < 2; ++n) acc[a][b][m][n] = (f32x4){zf, zf, zf, zf}; }
    bf16x8 At[4][2], B0[2][2], B1[2][2];
    const char* cA = (const char*)g.A + (size_t)cur.pm * tstep; const char* cB = (const char*)g.Bt + (size_t)cur.pn * tstep;
    S.a_ready(cur);
    if constexpr (SP2) {
        PG8_STAGE(PG8_SB(0, 0), cB, voffB); PG8_STAGE(PG8_SB(0, 1), cB + hstep, voffB); PG8_STAGE(PG8_SA(0, 0), cA, voffA); PG8_STAGE(PG8_SA(0, 1), cA + hstep, voffA);
        if (wr == 1) PG8_BAR;
        PG8_WAIT_V(2); PG8_BAR;
        PG8_STAGE(PG8_SB(1, 0), cB + kstep, voffB); PG8_STAGE(PG8_SA(1, 0), cA + kstep, voffA); PG8_STAGE(PG8_SB(1, 1), cB + hstep + kstep, voffB);
        PG8_WAIT_V(6); PG8_BAR;
    } else {
        PG8_STAGE(PG8_SB(0, 0), cB, voffB); PG8_STAGE(PG8_SA(0, 0), cA, voffA); PG8_STAGE(PG8_SB(0, 1), cB + hstep, voffB); PG8_STAGE(PG8_SA(0, 1), cA + hstep, voffA);
        if (wr == 1) PG8_BAR;
        PG8_WAIT_V(4); PG8_BAR;
        PG8_STAGE(PG8_SB(1, 0), cB + kstep, voffB); PG8_STAGE(PG8_SA(1, 0), cA + kstep, voffA); PG8_STAGE(PG8_SB(1, 1), cB + hstep + kstep, voffB);
        PG8_WAIT_V(6); PG8_BAR;
    }
    for (;;) {
        const bool has_next = S.next(ui + 1, nxt);
        const char* nA = has_next ? (const char*)g.A + (size_t)nxt.pm * tstep : cA; const char* nB = has_next ? (const char*)g.Bt + (size_t)nxt.pn * tstep : cB;
        for (int t = 0; t < nt; t += 2) {
            const bool last = (t == nt - 2);
            const char* a1 = cA + (size_t)(t + 1) * kstep;
            const char* a2 = last ? nA : cA + (size_t)(t + 2) * kstep; const char* b2 = last ? nB : cB + (size_t)(t + 2) * kstep;
            const char* a3 = a2 + kstep; const char* b3 = b2 + kstep;
            if (last && has_next) S.a_ready(nxt);
            if constexpr (SP2) {
            PG8_LDB(B0, 0, 0); PG8_LDB(B1, 0, 1); PG8_SCHED; PG8_LDA(At, 0, 0); PG8_STAGE(PG8_SA(1, 1), a1 + hstep, voffA);
            PG8_WAIT_V(8); PG8_WAIT_L(0); PG8_BAR; PG8_MMA(0, 0, At, B0); PG8_MMA(0, 1, At, B1); PG8_BAR; PG8_SCHED;
            PG8_LDA(At, 0, 1); PG8_STAGE(PG8_SB(0, 0), b2, voffB); PG8_STAGE(PG8_SB(0, 1), b2 + hstep, voffB); PG8_STAGE(PG8_SA(0, 0), a2, voffA);
            PG8_WAIT_V(8); PG8_WAIT_L(0); PG8_BAR; PG8_MMA(1, 0, At, B0); PG8_MMA(1, 1, At, B1); PG8_BAR; PG8_SCHED;
            PG8_LDB(B0, 1, 0); PG8_LDB(B1, 1, 1); PG8_SCHED; PG8_LDA(At, 1, 0); PG8_STAGE(PG8_SA(0, 1), a2 + hstep, voffA);
            PG8_WAIT_V(8); PG8_WAIT_L(0); PG8_BAR; PG8_MMA(0, 0, At, B0); PG8_MMA(0, 1, At, B1); PG8_BAR; PG8_SCHED;
            PG8_LDA(At, 1, 1); PG8_STAGE(PG8_SB(1, 0), b3, voffB); PG8_STAGE(PG8_SB(1, 1), b3 + hstep, voffB); PG8_STAGE(PG8_SA(1, 0), a3, voffA);
            PG8_WAIT_V(8); PG8_WAIT_L(0); PG8_BAR; PG8_MMA(1, 0, At, B0); PG8_MMA(1, 1, At, B1); PG8_BAR; PG8_SCHED;
            } else {
            PG8_LDB(B0, 0, 0); PG8_SCHED; PG8_LDA(At, 0, 0); PG8_STAGE(PG8_SA(1, 1), a1 + hstep, voffA);
            PG8_WAIT_L(8); PG8_BAR; PG8_WAIT_L(0); PG8_MMA(0, 0, At, B0); PG8_BAR; PG8_SCHED;
            PG8_LDB(B1, 0, 1); PG8_STAGE(PG8_SB(0, 0), b2, voffB);
            PG8_BAR; PG8_WAIT_L(0); PG8_MMA(0, 1, At, B1); PG8_BAR;
            PG8_LDA(At, 0, 1); PG8_STAGE(PG8_SA(0, 0), a2, voffA);
            PG8_BAR; PG8_WAIT_L(0); PG8_MMA(1, 0, At, B0); PG8_BAR; PG8_SCHED;
            PG8_STAGE(PG8_SB(0, 1), b2 + hstep, voffB);
            PG8_WAIT_V(6); PG8_BAR; PG8_MMA(1, 1, At, B1); PG8_BAR;
            PG8_LDB(B0, 1, 0); PG8_SCHED; PG8_LDA(At, 1, 0); PG8_STAGE(PG8_SA(0, 1), a2 + hstep, voffA);
            PG8_WAIT_L(8); PG8_BAR; PG8_WAIT_L(0); PG8_MMA(0, 0, At, B0); PG8_BAR; PG8_SCHED;
            PG8_LDB(B1, 1, 1); PG8_STAGE(PG8_SB(1, 0), b3, voffB);
            PG8_BAR; PG8_WAIT_L(0); PG8_MMA(0, 1, At, B1); PG8_BAR;
            PG8_LDA(At, 1, 1); PG8_STAGE(PG8_SA(1, 0), a3, voffA);
            PG8_BAR; PG8_WAIT_L(0); PG8_MMA(1, 0, At, B0); PG8_BAR; PG8_SCHED;
            PG8_STAGE(PG8_SB(1, 1), b3 + hstep, voffB);
            PG8_WAIT_V(6); PG8_BAR; PG8_MMA(1, 1, At, B1); PG8_BAR;
            }
        }
        if constexpr (FP8) asm volatile("s_nop 15\n\ts_nop 15\n\ts_nop 15" ::: "memory");
        if constexpr (ALIGN_EPI) { if (wr == 0) PG8_BAR; }
        if constexpr (!Epi::AFTER_DRAIN) { E(acc, cur, wr, wc, fr, fq); S.done(cur); }
        if (!has_next) break;
        { float zf; asm volatile("v_mov_b32 %0, 0" : "=v"(zf));
#pragma unroll
        for (int a = 0; a < 2; ++a)
#pragma unroll
            for (int b = 0; b < 2; ++b)
#pragma unroll
                for (int m = 0; m < 4; ++m)
#pragma unroll
                    for (int n = 0; n < 2; ++n) acc[a][b][m][n] = (f32x4){zf, zf, zf, zf}; }
        cur = nxt; cA = nA; cB = nB; ++ui;
        if constexpr (ALIGN_EPI) { if (wr == 1) PG8_BAR; }
    }
    PG8_WAIT_V(0);
    if constexpr (!ALIGN_EPI) { if (wr == 0) PG8_BAR; }
    PG8_BAR;
    if constexpr (Epi::AFTER_DRAIN) { E.fused(acc, cur, wr, wc, fr, fq, lds, wid, lane); S.done(cur); }
#undef PG8_SA
#undef PG8_SB
#undef PG8_STAGE
#undef PG8_LDA
#undef PG8_LDB
#undef PG8_MMA
#undef PG8_WAIT_V
#undef PG8_WAIT_L
#undef PG8_BAR
#undef PG8_SCHED
}
}
#include <hip/hip_bf16.h>
#include <cmath>
namespace attn_body {
using bf16=__hip_bfloat16;
using bf16x8=__attribute__((ext_vector_type(8)))short;
using s16x4=__attribute__((ext_vector_type(4)))short;
using f32x16=__attribute__((ext_vector_type(16)))float;
using u32x4=__attribute__((ext_vector_type(4)))unsigned;
constexpr int BATCH=4,NHEAD=8,SEQ=4096,D=64,DM=512,DMO=1024,KVSEQ=4224;
constexpr int NW=8,QBLK=32,QB=QBLK*NW,KVBLK=64,NQB=SEQ/QB;
constexpr int ATTN_UNIT_ROWS=QB;
__device__ __forceinline__ int crow(int r,int hi){return (r&3)+8*(r>>2)+4*hi;}
#define SBAR() __builtin_amdgcn_sched_barrier(0)
__device__ __forceinline__ void cmask(f32x16&p0,f32x16&p1,int jb,int qrel,int hi){
  const float NEG=-INFINITY; int kb=64*jb+4*hi;
  #pragma unroll
  for(int r=0;r<16;++r){int kv=kb+(r&3)+8*(r>>2); if(kv>qrel)p0[r]=NEG; if(kv+32>qrel)p1[r]=NEG;}
}

constexpr int NSLOT=3, SLOTB=8192;
constexpr int LDS_K=0, LDS_V=NSLOT*SLOTB, LDS_V2=2*NSLOT*SLOTB, LDS_WS=3*NSLOT*SLOTB, LDS_OST=LDS_WS+NW*64*4, LDS_BYTES=LDS_OST+NW*4096;
constexpr float C2=0.125f*1.4426950408889634f;
__device__ __forceinline__ void glds16(const void*gsrc,unsigned lds_dst){unsigned keep;
  asm volatile("s_mov_b32 %0, m0\n\ts_mov_b32 m0, %2\n\ts_nop 0\n\tglobal_load_lds_dwordx4 %1, off\n\ts_mov_b32 m0, %0":"=&s"(keep):"v"(gsrc),"s"(lds_dst):"memory");}
__device__ __forceinline__ void glds16s(const void*sbase,unsigned voff,unsigned lds_dst){unsigned keep;
  asm volatile("s_mov_b32 %0, m0\n\ts_mov_b32 m0, %3\n\ts_nop 0\n\tglobal_load_lds_dwordx4 %1, %2\n\ts_mov_b32 m0, %0":"=&s"(keep):"v"(voff),"s"(sbase),"s"(lds_dst):"memory");}
__device__ __forceinline__ float max3f(float a,float b,float c){float r;asm("v_max3_f32 %0, %1, %2, %3":"=v"(r):"v"(a),"v"(b),"v"(c));return r;}
__device__ __forceinline__ float max2f(float a,float b){float r;asm("v_max_f32_e32 %0, %1, %2":"=v"(r):"v"(a),"v"(b));return r;}
__device__ __forceinline__ float fadd_s(float a,float b){float r;asm("v_add_f32_e32 %0, %1, %2":"=v"(r):"v"(a),"v"(b));return r;}
__device__ __forceinline__ float fsub_s(float a,float b){float r;asm("v_sub_f32_e32 %0, %1, %2":"=v"(r):"v"(a),"v"(b));return r;}
typedef float f32x2_t __attribute__((ext_vector_type(2))); typedef __bf16 bf16x2_t __attribute__((ext_vector_type(2)));
__device__ __forceinline__ unsigned cvtpk_s(float lo,float hi){f32x2_t v={lo,hi};bf16x2_t b=__builtin_convertvector(v,bf16x2_t);return __builtin_bit_cast(unsigned,b);}
#define WAIT_BAR(N) asm volatile("s_waitcnt vmcnt(" #N ") lgkmcnt(0)\n\ts_barrier":::"memory")

typedef __attribute__((address_space(3))) const char* lds_cptr;
__device__ __forceinline__ void qkt(f32x16&p0,f32x16&p1,lds_cptr Kslot,const bf16x8*qr,const f32x16&negm0,const f32x16&negm1,int r32,int hi){
  const lds_cptr kb=Kslot+hi*1024+r32*16;
  #pragma unroll
  for(int d0=0;d0<4;++d0){
    const bf16x8 b0=*(const __attribute__((address_space(3))) bf16x8*)(kb+d0*2048);
    const bf16x8 b1=*(const __attribute__((address_space(3))) bf16x8*)(kb+d0*2048+512);
    if(d0==0){p0=__builtin_amdgcn_mfma_f32_32x32x16_bf16(b0,qr[0],negm0,0,0,0);p1=__builtin_amdgcn_mfma_f32_32x32x16_bf16(b1,qr[0],negm1,0,0,0);}
    else{p0=__builtin_amdgcn_mfma_f32_32x32x16_bf16(b0,qr[d0],p0,0,0,0);p1=__builtin_amdgcn_mfma_f32_32x32x16_bf16(b1,qr[d0],p1,0,0,0);}}
}
typedef short v4i16_t __attribute__((ext_vector_type(4)));
__device__ __forceinline__ void kload8(bf16x8*kf,lds_cptr kp){
  kf[0]=*(const __attribute__((address_space(3))) bf16x8*)(kp);      kf[1]=*(const __attribute__((address_space(3))) bf16x8*)(kp+512);
  kf[2]=*(const __attribute__((address_space(3))) bf16x8*)(kp+2048); kf[3]=*(const __attribute__((address_space(3))) bf16x8*)(kp+2560);
  kf[4]=*(const __attribute__((address_space(3))) bf16x8*)(kp+4096); kf[5]=*(const __attribute__((address_space(3))) bf16x8*)(kp+4608);
  kf[6]=*(const __attribute__((address_space(3))) bf16x8*)(kp+6144); kf[7]=*(const __attribute__((address_space(3))) bf16x8*)(kp+6656);
}
__device__ __forceinline__ void kload2(bf16x8*kf,lds_cptr kp,int j){ kf[2*j]=*(const __attribute__((address_space(3))) bf16x8*)(kp+j*2048); kf[2*j+1]=*(const __attribute__((address_space(3))) bf16x8*)(kp+j*2048+512); }
__device__ __forceinline__ s16x4 vtr(lds_cptr p){ return __builtin_bit_cast(s16x4,__builtin_amdgcn_ds_read_tr16_b64_v4i16((__attribute__((address_space(3))) v4i16_t*)p)); }
__device__ __forceinline__ float rowmax(const f32x16&p0,const f32x16&p1){
  float a=max3f(p0[0],p0[1],p1[0]),b=max3f(p0[2],p0[3],p1[1]);a=max3f(a,p1[2],p1[3]);
  #pragma unroll
  for(int r=4;r<16;r+=4){a=max3f(a,p0[r],p0[r+1]);b=max3f(b,p0[r+2],p0[r+3]);a=max3f(a,p1[r],p1[r+1]);b=max3f(b,p1[r+2],p1[r+3]);}
  const float m=max2f(a,b);
  auto rr=__builtin_amdgcn_permlane32_swap(__float_as_uint(m),__float_as_uint(m),false,false);
  return max2f(__uint_as_float(rr[0]),__uint_as_float(rr[1]));
}
__device__ __forceinline__ void pv(f32x16*o,int vb,bf16x8 pa0,bf16x8 pa1,bf16x8 pa2,bf16x8 pa3){
  #pragma unroll
  for(int d0=0;d0<2;++d0){s16x4 lo[4],hi[4];
    #pragma unroll
    for(int ks=0;ks<4;++ks){
      asm volatile("ds_read_b64_tr_b16 %0,%1 offset:%c2":"=&v"(lo[ks]):"v"(vb),"i"(d0*4096+ks*1024):"memory");
      asm volatile("ds_read_b64_tr_b16 %0,%1 offset:%c2":"=&v"(hi[ks]):"v"(vb),"i"(d0*4096+ks*1024+512):"memory");}
    asm volatile("s_waitcnt lgkmcnt(0)":::"memory");SBAR();
    #define PK(k) (bf16x8){lo[k][0],lo[k][1],lo[k][2],lo[k][3],hi[k][0],hi[k][1],hi[k][2],hi[k][3]}
    o[d0]=__builtin_amdgcn_mfma_f32_32x32x16_bf16(pa0,PK(0),o[d0],0,0,0);
    o[d0]=__builtin_amdgcn_mfma_f32_32x32x16_bf16(pa1,PK(1),o[d0],0,0,0);
    o[d0]=__builtin_amdgcn_mfma_f32_32x32x16_bf16(pa2,PK(2),o[d0],0,0,0);
    o[d0]=__builtin_amdgcn_mfma_f32_32x32x16_bf16(pa3,PK(3),o[d0],0,0,0);
    #undef PK
  }
}

#ifndef ATTN_STORE16
#define ATTN_STORE16(p,v) (*(u32x4*)(p)=(v))
#endif
template<int THRL> __device__ __forceinline__ void attn_unit(int b,int hc,int qb,const bf16*Q,const bf16*__restrict__ K,const bf16*__restrict__ V,bf16*O,char*shm,int tid_in){
  int tid_=tid_in; asm volatile("":"+v"(tid_)); const int tid=tid_,lane=tid&63,r32=lane&31,hi=lane>>5; const int wid=__builtin_amdgcn_readfirstlane(tid>>6);
  const long rowbase=(long)b*SEQ, kvbase=(long)b*KVSEQ; const int q0=qb*QB;
  const bf16*Qw=Q+(rowbase+q0+wid*QBLK)*DM+hc*D;
  const bf16*Kh=K+kvbase*DM+hc*D,*Vh=V+kvbase*DM+(hc>>1)*128;
  const unsigned lds0=(unsigned)(uintptr_t)shm;
  typedef __attribute__((address_space(3))) float lds_f32; typedef __attribute__((address_space(3))) unsigned short lds_u16; typedef __attribute__((address_space(3))) char lds_char;
  lds_f32*wsf=(lds_f32*)((lds_char*)shm+LDS_WS)+wid*64;
  const bf16*ksb=Kh+wid*8; const unsigned kvo=(unsigned)lane*(DM*2);
  const bf16*vsb=Vh+(long)(16*(wid&3))*DM+(wid>>2)*32; const unsigned vvo=(unsigned)((lane>>2)*DM+(lane&3)*8)*2u;
  const unsigned kdst=lds0+LDS_K+wid*1024, vdst=lds0+LDS_V+wid*1024, vdst2=lds0+LDS_V2+wid*1024;
  #define DMA_K(t,slot) glds16s(ksb+(long)(t)*KVBLK*DM,kvo,(unsigned)__builtin_amdgcn_readfirstlane(kdst+(slot)))
  #define DMA_V(t,slot) do{ glds16s(vsb+(long)(t)*KVBLK*DM,vvo,(unsigned)__builtin_amdgcn_readfirstlane(vdst+(slot))); glds16s(vsb+(long)(t)*KVBLK*DM+64,vvo,(unsigned)__builtin_amdgcn_readfirstlane(vdst2+(slot))); }while(0)
  const int vb0=(int)(lds0+LDS_V)+((lane>>4)&1)*32+(lane&3)*8+(4*hi+((lane&15)>>2))*64;
  bf16x8 kf[8];
  const lds_cptr shm3=(lds_cptr)shm; const lds_cptr kp0=shm3+LDS_K+hi*1024+r32*16; const lds_cptr vp0=shm3+LDS_V+((lane>>4)&1)*32+(lane&3)*8+(4*hi+((lane&15)>>2))*64;
  const int NT=(q0+QB)/KVBLK+2;
  DMA_K(0,0);DMA_V(0,0);DMA_K(1,SLOTB);
  bf16x8 qr[4];
  #pragma unroll
  for(int d0=0;d0<4;++d0)qr[d0]=*reinterpret_cast<const bf16x8*>(&Qw[(long)r32*DM+d0*16+hi*8]);
  float mhat=0.f,l_reg=0.f;f32x16 o[4];o[0]=f32x16{};o[1]=f32x16{};o[2]=f32x16{};o[3]=f32x16{};f32x16 negm=f32x16{};asm volatile("":"+v"(negm));
  const int qrel=wid*QBLK+r32;
  #define CMASK(P0,P1,t) do{int jb_=(t)-(NT-4); if(jb_>=0)cmask(P0,P1,jb_,qrel,hi);}while(0)
  bool resc=false;
  #define START(P0,P1) do{ const float rm=rowmax(P0,P1); resc=false; \
    { const float dl=rm; mhat=fadd_s(mhat,dl); \
      _Pragma("unroll") for(int r=0;r<16;++r){P0[r]=fsub_s(P0[r],dl);P1[r]=fsub_s(P1[r],dl);} \
      _Pragma("unroll") for(int r=0;r<16;++r)negm[r]=-mhat; asm volatile("":"+v"(negm)); } \
    _Pragma("unroll") for(int r=0;r<16;++r)P0[r]=__builtin_amdgcn_exp2f(P0[r]); }while(0)
  #define RESC() do{ if(resc){ asm volatile("s_waitcnt lgkmcnt(0)":::"memory"); \
      _Pragma("unroll") for(int d_=0;d_<4;++d_) _Pragma("unroll") for(int r=0;r<16;++r)o[d_][r]*=wsf[crow(r,hi)]; } }while(0)
  f32x16 pA0,pA1,pB0,pB1;
  int sl_prev=0,sl_cur=0,sl_next=SLOTB;
  #define ROT() do{sl_prev=sl_cur;sl_cur=sl_next;sl_next=(sl_next==(NSLOT-1)*SLOTB)?0:sl_next+SLOTB;}while(0)
  DMA_K(2,2*SLOTB);
  WAIT_BAR(4);
  { f32x16 cm0,cm1; _Pragma("unroll") for(int r=0;r<16;++r){cm0[r]=-INFINITY;cm1[r]=(r<8)?-INFINITY:0.f;} asm volatile("":"+v"(cm0),"+v"(cm1));
    qkt(pA0,pA1,shm3+LDS_K,qr,cm0,cm1,r32,hi); }
  asm volatile("s_nop 15\n\ts_nop 7":"+v"(pA0),"+v"(pA1));CMASK(pA0,pA1,0);
  START(pA0,pA1);
  _Pragma("unroll") for(int r=0;r<16;++r)pA1[r]=__builtin_amdgcn_exp2f(pA1[r]);
  _Pragma("unroll") for(int r=0;r<16;++r)negm[r]=-INFINITY; asm volatile("":"+v"(negm));
  WAIT_BAR(0);
  DMA_K(3,0);DMA_V(1,SLOTB);
  ROT();
  kload8(kf,kp0+sl_cur);
  WAIT_BAR(3);
  s16x4 vlo[8],vhi[8],wlo[8],whi[8]; u32x4 pw0,pw1,pw2,pw3;
  #define PKW(P,B) cvtpk_s(P[B],P[B+1])
  #define PAF(k) __builtin_bit_cast(bf16x8,pw##k)
  #define VFR(i) (bf16x8){vlo[i][0],vlo[i][1],vlo[i][2],vlo[i][3],vhi[i][0],vhi[i][1],vhi[i][2],vhi[i][3]}
  #define WFR(i) (bf16x8){wlo[i][0],wlo[i][1],wlo[i][2],wlo[i][3],whi[i][0],whi[i][1],whi[i][2],whi[i][3]}
  #define PIN(x) asm volatile("":"+v"(x))
  #define MX3(a,b,c) __builtin_fmaxf(__builtin_fmaxf((a),(b)),(c))
  #define GAPA(MF,A0,A1,A2,A3,W0,W1,PW) do{ MF; sacc+=A0; sacc+=A1; sacc+=A2; sacc+=A3; PIN(sacc); W0; W1; PIN(PW); SBAR(); }while(0)
  #define EX(v) __builtin_amdgcn_exp2f(v)
  #define GAPB(MF,X,B) do{ MF; X[B]=EX(X[B]); X[B+1]=EX(X[B+1]); PIN(X); SBAR(); }while(0)
  #define VRD(i) do{ vlo[i]=vtr(vp_+(((i)>>2)*4096+((i)&3)*1024)); vhi[i]=vtr(vp_+(((i)>>2)*4096+((i)&3)*1024+512)); }while(0)
  #define WRD(i) do{ wlo[i]=vtr(vp_+((LDS_V2-LDS_V)+((i)>>2)*4096+((i)&3)*1024)); whi[i]=vtr(vp_+((LDS_V2-LDS_V)+((i)>>2)*4096+((i)&3)*1024+512)); SBAR(); }while(0)
  #define KRD(G,j) do{ if(G){ kload2(kf,kp0+sl_next,j); SBAR(); } }while(0)
  #define STEP(C0,C1,P0,P1,t,GK,GV,GL) do{ SBAR(); \
    const lds_cptr vp_=vp0+sl_prev; \
    float sacc=(P0[0]+P0[1]); \
    GAPA(C0=__builtin_amdgcn_mfma_f32_32x32x16_bf16(kf[0],qr[0],negm,0,0,0), P0[2],P0[3],P0[4],P0[5],     pw0[0]=PKW(P0,0), pw0[1]=PKW(P0,2), pw0); \
    GAPA(C1=__builtin_amdgcn_mfma_f32_32x32x16_bf16(kf[1],qr[0],negm,0,0,0), P0[6],P0[7],P0[8],P0[9],     pw0[2]=PKW(P0,4), pw0[3]=PKW(P0,6), pw0); \
    GAPA(C0=__builtin_amdgcn_mfma_f32_32x32x16_bf16(kf[2],qr[1],C0,0,0,0),   P0[10],P0[11],P0[12],P0[13], pw1[0]=PKW(P0,8), pw1[1]=PKW(P0,10), pw1); \
    GAPA(C1=__builtin_amdgcn_mfma_f32_32x32x16_bf16(kf[3],qr[1],C1,0,0,0),   P0[14],P0[15],P1[0],P1[1],   pw1[2]=PKW(P0,12),pw1[3]=PKW(P0,14), pw1); \
    GAPA(C0=__builtin_amdgcn_mfma_f32_32x32x16_bf16(kf[4],qr[2],C0,0,0,0),   P1[2],P1[3],P1[4],P1[5],     pw2[0]=PKW(P1,0), pw2[1]=PKW(P1,2), pw2); \
    GAPA(C1=__builtin_amdgcn_mfma_f32_32x32x16_bf16(kf[5],qr[2],C1,0,0,0),   P1[6],P1[7],P1[8],P1[9],     pw2[2]=PKW(P1,4), pw2[3]=PKW(P1,6), pw2); \
    GAPA(C0=__builtin_amdgcn_mfma_f32_32x32x16_bf16(kf[6],qr[3],C0,0,0,0),   P1[10],P1[11],P1[12],P1[13], pw3[0]=PKW(P1,8), pw3[1]=PKW(P1,10), pw3); \
    GAPA(C1=__builtin_amdgcn_mfma_f32_32x32x16_bf16(kf[7],qr[3],C1,0,0,0),   P1[14],P1[15],0.f,0.f,       pw3[2]=PKW(P1,12),pw3[3]=PKW(P1,14), pw3); \
    l_reg+=sacc; \
    VRD(0);VRD(4);VRD(1);VRD(5);VRD(2);VRD(6);VRD(3);VRD(7); SBAR();     \
    if(GK){DMA_K((t)+3,sl_cur);} if(GV){DMA_V((t)+1,sl_next);} \
    CMASK(C0,C1,t); \
    { float a=MX3(C0[0],C0[1],C1[0]),b=MX3(C0[2],C0[3],C1[1]); a=MX3(a,C1[2],C1[3]); \
      _Pragma("unroll") for(int r=4;r<16;r+=4){a=MX3(a,C0[r],C0[r+1]);b=MX3(b,C0[r+2],C0[r+3]);a=MX3(a,C1[r],C1[r+1]);b=MX3(b,C1[r+2],C1[r+3]);} \
      float rm=__builtin_fmaxf(a,b); { auto rr=__builtin_amdgcn_permlane32_swap(__float_as_uint(rm),__float_as_uint(rm),false,false); rm=__builtin_fmaxf(__uint_as_float(rr[0]),__uint_as_float(rr[1])); } \
      resc=false; \
      if(__builtin_expect(__any(rm>(float)THRL),0)){ const float dl=__builtin_fmaxf(rm,0.f); mhat+=dl; \
        _Pragma("unroll") for(int r=0;r<16;++r){C0[r]-=dl;C1[r]-=dl;} \
        _Pragma("unroll") for(int r=0;r<16;++r)negm[r]=-mhat; asm volatile("":"+v"(negm)); \
        const float f=__builtin_amdgcn_exp2f(-dl); l_reg*=f; if(hi==0)wsf[r32]=f; resc=true; } } \
    SBAR(); __builtin_amdgcn_s_setprio(1); \
    GAPB(o[0]=__builtin_amdgcn_mfma_f32_32x32x16_bf16(PAF(0),VFR(0),o[0],0,0,0), C0,0);  WRD(0); \
    GAPB(o[1]=__builtin_amdgcn_mfma_f32_32x32x16_bf16(PAF(0),VFR(4),o[1],0,0,0), C0,2);  WRD(4); \
    KRD(GL,0); GAPB(o[0]=__builtin_amdgcn_mfma_f32_32x32x16_bf16(PAF(1),VFR(1),o[0],0,0,0), C0,4);  WRD(1); \
    KRD(GL,1); GAPB(o[1]=__builtin_amdgcn_mfma_f32_32x32x16_bf16(PAF(1),VFR(5),o[1],0,0,0), C0,6);  WRD(5); \
    KRD(GL,2); GAPB(o[0]=__builtin_amdgcn_mfma_f32_32x32x16_bf16(PAF(2),VFR(2),o[0],0,0,0), C0,8);  WRD(2); \
    KRD(GL,3); GAPB(o[1]=__builtin_amdgcn_mfma_f32_32x32x16_bf16(PAF(2),VFR(6),o[1],0,0,0), C0,10); WRD(6); \
    GAPB(o[0]=__builtin_amdgcn_mfma_f32_32x32x16_bf16(PAF(3),VFR(3),o[0],0,0,0), C0,12); WRD(3); \
    GAPB(o[1]=__builtin_amdgcn_mfma_f32_32x32x16_bf16(PAF(3),VFR(7),o[1],0,0,0), C0,14); WRD(7); \
    GAPB(o[2]=__builtin_amdgcn_mfma_f32_32x32x16_bf16(PAF(0),WFR(0),o[2],0,0,0), C1,0); \
    GAPB(o[3]=__builtin_amdgcn_mfma_f32_32x32x16_bf16(PAF(0),WFR(4),o[3],0,0,0), C1,2); \
    GAPB(o[2]=__builtin_amdgcn_mfma_f32_32x32x16_bf16(PAF(1),WFR(1),o[2],0,0,0), C1,4); \
    GAPB(o[3]=__builtin_amdgcn_mfma_f32_32x32x16_bf16(PAF(1),WFR(5),o[3],0,0,0), C1,6); \
    GAPB(o[2]=__builtin_amdgcn_mfma_f32_32x32x16_bf16(PAF(2),WFR(2),o[2],0,0,0), C1,8); \
    GAPB(o[3]=__builtin_amdgcn_mfma_f32_32x32x16_bf16(PAF(2),WFR(6),o[3],0,0,0), C1,10); \
    GAPB(o[2]=__builtin_amdgcn_mfma_f32_32x32x16_bf16(PAF(3),WFR(3),o[2],0,0,0), C1,12); \
    GAPB(o[3]=__builtin_amdgcn_mfma_f32_32x32x16_bf16(PAF(3),WFR(7),o[3],0,0,0), C1,14); __builtin_amdgcn_s_setprio(0); \
    }while(0)
  int t=1;
  #define FIX1(tt) do{ if((tt)==1){ _Pragma("unroll") for(int r=0;r<16;++r)negm[r]=-mhat; asm volatile("":"+v"(negm)); } }while(0)
  #undef CMASK
  #define CMASK(P0,P1,t) do{}while(0)
  for(;t+5<NT;t+=2){
    STEP(pB0,pB1,pA0,pA1,t,true,true,true);     WAIT_BAR(3); RESC(); ROT(); FIX1(t);
    STEP(pA0,pA1,pB0,pB1,t+1,true,true,true);   WAIT_BAR(3); RESC(); ROT();
  }
  #undef CMASK
  #define CMASK(P0,P1,t) do{int jb_=(t)-(NT-4); if(jb_>=0)cmask(P0,P1,jb_,qrel,hi);}while(0)
  #define ENDW(tt) do{ if((tt)+3<NT){WAIT_BAR(3);} else if((tt)+2<NT){WAIT_BAR(2);} else {WAIT_BAR(0);} }while(0)
  for(;t+1<NT;t+=2){
    STEP(pB0,pB1,pA0,pA1,t,(t+3<NT),(t+1<NT),(t+1<NT));       ENDW(t);   RESC(); ROT(); FIX1(t);
    STEP(pA0,pA1,pB0,pB1,t+1,(t+4<NT),(t+2<NT),(t+2<NT));     ENDW(t+1); RESC(); ROT();
  }
  STEP(pB0,pB1,pA0,pA1,NT-1,false,false,false); RESC();
  { float sacc=pB0[0]+pB0[1]; _Pragma("unroll") for(int r=2;r<16;++r)sacc+=pB0[r]; _Pragma("unroll") for(int r=0;r<16;++r)sacc+=pB1[r]; l_reg+=sacc;
    pw0=(u32x4){PKW(pB0,0),PKW(pB0,2),PKW(pB0,4),PKW(pB0,6)};pw1=(u32x4){PKW(pB0,8),PKW(pB0,10),PKW(pB0,12),PKW(pB0,14)};pw2=(u32x4){PKW(pB1,0),PKW(pB1,2),PKW(pB1,4),PKW(pB1,6)};pw3=(u32x4){PKW(pB1,8),PKW(pB1,10),PKW(pB1,12),PKW(pB1,14)};
    SBAR(); pv(o,vb0+sl_cur,PAF(0),PAF(1),PAF(2),PAF(3)); pv(o+2,vb0+(LDS_V2-LDS_V)+sl_cur,PAF(0),PAF(1),PAF(2),PAF(3)); }
  #undef PKW
  #undef PAF
  #undef VFR
  #undef WFR
  #undef WRD
  #undef PIN
  #undef MX3
  #undef GAPA
  #undef GAPB
  #undef EX
  #undef VRD
  #undef KRD
  #undef STEP
  #undef ENDW
  {auto rr=__builtin_amdgcn_permlane32_swap(__float_as_uint(l_reg),__float_as_uint(l_reg),false,false);l_reg=__uint_as_float(rr[0])+__uint_as_float(rr[1]);}
  if(hi==0)wsf[32+r32]=l_reg;asm volatile("s_waitcnt lgkmcnt(0)":::"memory");
  float rli[16];
  #pragma unroll
  for(int r=0;r<16;++r)rli[r]=__builtin_amdgcn_rcpf(wsf[32+crow(r,hi)]);
  bf16*Ow=O+(rowbase+q0+wid*QBLK)*DMO+hc*128;
  { lds_u16*stg=(lds_u16*)((lds_char*)shm+LDS_OST)+wid*2048;
    #pragma unroll
    for(int half=0;half<2;++half){
      #pragma unroll
      for(int r=0;r<16;++r){const int orow=crow(r,hi);
        #pragma unroll
        for(int d0=0;d0<2;++d0)stg[orow*64+d0*32+r32]=(unsigned short)(cvtpk_s(o[2*half+d0][r]*rli[r],0.f)&0xffffu);}
      asm volatile("s_waitcnt lgkmcnt(0)":::"memory");
      #pragma unroll
      for(int i=0;i<4;++i){const int row=i*8+(lane>>3),ch=lane&7; const u32x4 v=*(const __attribute__((address_space(3))) u32x4*)(stg+row*64+ch*8); ATTN_STORE16(Ow+(long)row*DMO+half*64+ch*8,v);}
      asm volatile("s_waitcnt lgkmcnt(0)":::"memory"); } }
  asm volatile("s_waitcnt lgkmcnt(0)\n\ts_barrier":::"memory");
  #undef DMA_K
  #undef DMA_V
  #undef CMASK
  #undef START
  #undef RESC
  #undef ROT
}
constexpr int ATTN_LDS_BYTES=LDS_BYTES;
struct AttnTensors { const bf16* Q; const bf16* K; const bf16* V; bf16* O; };
struct AttnUnit { int bh; int qb; };
struct StaticOrder {
  int vcu;
  __device__ __forceinline__ explicit StaticOrder(int grid,int block):vcu((block%8)*(grid/8)+block/8){}
  __device__ __forceinline__ bool next(int i,AttnUnit&u)const{ if(i>=4||vcu>=256)return false; const int s=vcu&3; u.bh=vcu>>2; u.qb=(i==0)?s:(i==1)?7-s:(i==2)?8+s:15-s; return true; }
  __device__ __forceinline__ void a_ready(const AttnUnit&)const{}
  __device__ __forceinline__ void done(const AttnUnit&)const{}
};
struct QueueOrder {
  unsigned* ctr; __attribute__((address_space(3))) unsigned* slot; int x; int tid0;
  __device__ __forceinline__ bool next(int,AttnUnit&u)const{
    if(tid0==0){ const unsigned e=__hip_atomic_fetch_add(ctr,1u,__ATOMIC_RELAXED,__HIP_MEMORY_SCOPE_AGENT); *slot=e; }
    asm volatile("s_waitcnt vmcnt(0) lgkmcnt(0)\n\ts_barrier":::"memory");
    const unsigned e=*slot;
    asm volatile("s_waitcnt lgkmcnt(0)\n\ts_barrier":::"memory");
    if(e>=64u)return false; u.bh=(int)(e&3u)*8+x; u.qb=15-(int)(e>>2); return true; }
  __device__ __forceinline__ void a_ready(const AttnUnit&)const{}
  __device__ __forceinline__ void done(const AttnUnit&)const{}
};
template<class Sched,int THRL=8> __device__ __forceinline__ void attn_phase(char*lds,const AttnTensors&T,const Sched&S,int tid_in){
  AttnUnit u;
  for(int i=0;S.next(i,u);++i){ S.a_ready(u); attn_unit<THRL>(u.bh/NHEAD,u.bh%NHEAD,u.qb,T.Q,T.K,T.V,T.O,lds,tid_in); S.done(u); }
}
#undef SBAR
#undef WAIT_BAR
}
#define GAS __attribute__((address_space(1)))
#define LAS __attribute__((address_space(3)))
typedef unsigned short bf16;
typedef unsigned v4u __attribute__((ext_vector_type(4)));
typedef float f32x4 __attribute__((ext_vector_type(4)));
typedef short bf16x8 __attribute__((ext_vector_type(8)));
typedef GAS unsigned gu32;
typedef GAS unsigned long long gu64;
#define RLX_AGENT __ATOMIC_RELAXED, __HIP_MEMORY_SCOPE_AGENT
#define LDS_WAIT() asm volatile("s_waitcnt lgkmcnt(0)" ::: "memory")
#define VM_WAIT() asm volatile("s_waitcnt vmcnt(0)" ::: "memory")
__device__ __forceinline__ unsigned long long rt() { return __builtin_amdgcn_s_memrealtime(); }
__device__ __forceinline__ unsigned f2bf(float f) { unsigned u = __builtin_bit_cast(unsigned, f); return (u + 0x7fffu + ((u >> 16) & 1u)) >> 16; }
__device__ __forceinline__ unsigned pk2(float lo, float hi) { return f2bf(lo) | (f2bf(hi) << 16); }

#define XB_TMO      128
#define XB_XCNT(j)  (256  + 64 * (j))
#define XB_XSUB(j)  (1280 + 64 * (j))
#define XB_XGEN(j)  (2304 + 64 * (j))
#define XB_TOP      3328
#define XB_TOPGEN   3392
#define XCD_BAR_WORDS 3456
#define XB_SPIN_CAP (1u << 18)

__device__ __forceinline__ unsigned xb_ld(unsigned* p)              { return __hip_atomic_load(p, __ATOMIC_RELAXED, __HIP_MEMORY_SCOPE_AGENT); }
__device__ __forceinline__ unsigned xb_add(unsigned* p, unsigned v) { return __hip_atomic_fetch_add(p, v, __ATOMIC_RELAXED, __HIP_MEMORY_SCOPE_AGENT); }
__device__ __forceinline__ unsigned xb_xcc_id() { return (unsigned)__builtin_amdgcn_s_getreg((3 << 11) | 20) & 0xFu; }
#define XB_SPIN(cond, bar) do { unsigned _sp = 0; while (cond) { __builtin_amdgcn_s_sleep(1); \
    if ((++_sp & 255u) == 0u) { if (xb_ld(&(bar)[XB_TMO])) break; if (_sp > XB_SPIN_CAP) { atomicAdd(&(bar)[XB_TMO], 1u); break; } } } } while (0)

struct XcdBarrier {
    unsigned* bar; unsigned x; int wv;
    volatile LAS unsigned* st;
};

__device__ __forceinline__ XcdBarrier xcd_barrier_post(unsigned* bar, volatile LAS unsigned* st) {
    XcdBarrier b; b.bar = bar; b.x = xb_xcc_id(); b.st = st;
    if (threadIdx.x == 0) (void)xb_add(&bar[XB_XCNT(b.x)], 1u);
    return b;
}
__device__ __forceinline__ void xcd_barrier_complete(unsigned* bar, unsigned x, unsigned& nloc, unsigned& nx) {
    const unsigned G = gridDim.x * gridDim.y * gridDim.z;
    unsigned sum, cnt, mine, sp = 0u;
    for (;;) {
        sum = 0u; cnt = 0u; mine = 0u;
#pragma unroll
        for (unsigned j = 0; j < 16; ++j) { const unsigned c = xb_ld(&bar[XB_XCNT(j)]); sum += c; cnt += (c > 0u) ? 1u : 0u; mine = (j == x) ? c : mine; }
        if (sum == G) break;
        __builtin_amdgcn_s_sleep(1);
        if ((++sp & 255u) == 0u) { if (xb_ld(&bar[XB_TMO])) break; if (sp > XB_SPIN_CAP) { atomicAdd(&bar[XB_TMO], 1u); break; } }
    }
    nloc = mine > 0u ? mine : 1u; nx = cnt > 0u ? cnt : 1u;
}

__device__ __forceinline__ void xcd_barrier(const XcdBarrier& b) {
    asm volatile("s_waitcnt vmcnt(0)" ::: "memory");
    __syncthreads();
    unsigned ln_; asm volatile("v_mbcnt_lo_u32_b32 %0, -1, 0\n\tv_mbcnt_hi_u32_b32 %0, -1, %0" : "=v"(ln_));
    if (b.wv == 0 && ln_ == 0u) {
        unsigned* bar = b.bar;
        __builtin_amdgcn_s_waitcnt(0);
        unsigned nloc = b.st[0], nx = b.st[1];
        if (nloc == 0u) { xcd_barrier_complete(bar, b.x, nloc, nx); b.st[0] = nloc; b.st[1] = nx; }
        const unsigned old = xb_add(&bar[XB_XSUB(b.x)], 1u);
        const unsigned gen = old / nloc;
        if (old + 1u == (gen + 1u) * nloc) {
            __builtin_amdgcn_fence(__ATOMIC_RELEASE, "agent");
            asm volatile("s_waitcnt vmcnt(0)" ::: "memory");
            const unsigned og = xb_add(&bar[XB_TOP], 1u);
            const unsigned tg = og / nx;
            if (og + 1u == (tg + 1u) * nx) xb_add(&bar[XB_TOPGEN], 1u);
            else XB_SPIN(xb_ld(&bar[XB_TOPGEN]) == tg, bar);
            __builtin_amdgcn_fence(__ATOMIC_ACQUIRE, "agent");
            xb_add(&bar[XB_XGEN(b.x)], 1u);
            asm volatile("s_waitcnt vmcnt(0)" ::: "memory");
        } else {
            XB_SPIN(xb_ld(&bar[XB_XGEN(b.x)]) == gen, bar);
            __builtin_amdgcn_fence(__ATOMIC_ACQUIRE, "agent");
            asm volatile("s_waitcnt vmcnt(0)" ::: "memory");
        }
    }
    __syncthreads();
}

constexpr int NWAVES = 8;
constexpr int DM = 1024, NB = 4, SEQ = 4096, NMETA = 16, DEPTH = 4;
constexpr int NREAL = NB * SEQ;
constexpr int NTOK = NREAL + NMETA;
constexpr int MPAD = 16640;
constexpr int INC = 3200, INP = 3328;
constexpr int RCOLS = 896, QOFF = 896, KOFF = 896 + 512, VOFF = 896 + 1024, COFF = 2432;
constexpr int FF = 2816, FF2 = 5632, NE = 8;
constexpr int KVROWS = 128 + SEQ;
constexpr int MOEP = 35072;
constexpr float C2Q = 0.125f * 1.4426950408889634f;

constexpr size_t MiB = 1u << 20;
constexpr size_t WS_CTL = 0, CTL_ZERO_BYTES = 1 * MiB;
constexpr size_t WS_COS = 1 * MiB, WS_SIN = 1 * MiB + 192 * 1024;
constexpr size_t WS_RSTD = 1 * MiB + 512 * 1024;
constexpr size_t WS_RSROW = 1 * MiB + 768 * 1024;
constexpr size_t WS_TOKE = 2 * MiB, WS_TOKS = 2 * MiB + 256 * 1024, WS_TOKG = 2 * MiB + 512 * 1024;
constexpr size_t WS_WIN = 4 * MiB;
constexpr size_t WS_WOUT = 30 * MiB;
constexpr size_t WS_WGU = 38 * MiB;
constexpr size_t WS_WD = 60 * MiB;
constexpr size_t WS_MWGU = 72 * MiB;
constexpr size_t WS_MWD = 160 * MiB;
constexpr size_t WS_H = 204 * MiB;
constexpr size_t WS_HB = 269 * MiB;
constexpr size_t WS_PH = 302 * MiB;
constexpr size_t WS_PROJ = WS_PH;
constexpr size_t WS_QN = 408 * MiB;
constexpr size_t WS_KP = 425 * MiB;
constexpr size_t WS_VP = 442 * MiB;
constexpr size_t WS_OC = 459 * MiB;
constexpr size_t WS_OMIX = 492 * MiB;
constexpr size_t WS_SC = 525 * MiB, SC_STRIDE = 17 * MiB;
constexpr size_t WS_MIX_END = WS_SC + 9 * SC_STRIDE;
constexpr size_t WS_G = WS_PH;
constexpr size_t WS_AROWS = 491 * MiB;
constexpr size_t WS_YM = 560 * MiB;
constexpr size_t WS_LORA = 680 * MiB;
constexpr size_t WS_END = 714 * MiB;
static_assert(WS_PROJ + (size_t)MPAD * INP * 2 <= WS_QN && WS_G + (size_t)MOEP * FF * 2 <= WS_AROWS && WS_AROWS + (size_t)MOEP * 1024 * 2 <= WS_YM && WS_YM + (size_t)MOEP * 1024 * 2 <= WS_END, "ws map");
static_assert((size_t)8 * FF2 * DM <= 44 * MiB && 44 * MiB + (size_t)4112 * 11008 + 1024 <= 88 * MiB && (size_t)4112 * 8192 <= (size_t)MPAD * 2048, "chunk buffers");
static_assert(WS_H + (size_t)MPAD * 1024 * 4 <= WS_HB && WS_HB + (size_t)MPAD * 1024 * 2 <= WS_PH && WS_MIX_END <= WS_END, "ws map 2");
static_assert((size_t)NTOK * 256 * 4 <= SC_STRIDE && WS_OC + (size_t)NTOK * 2048 <= WS_OMIX && WS_OMIX + (size_t)MPAD * 2048 <= WS_SC, "ws map 3");
constexpr int CW_MOECNT = 1024;
constexpr int CW_BAR = 4096;
constexpr int CW_ATTQ = 8192;

constexpr int LDS_BYTES = 147456;
constexpr int MISC_OFF = LDS_BYTES - 128;

struct Args { const float* in[32]; float* out; unsigned char* ws; int ph_lo, ph_hi; };

__device__ __forceinline__ v4u zero_v4u() { unsigned z; asm volatile("v_mov_b32 %0, 0" : "=v"(z)); return (v4u){z, z, z, z}; }
__device__ __forceinline__ unsigned pk4_fp8(float a, float b, float c, float d) {
    a = __builtin_amdgcn_fmed3f(a, -448.f, 448.f); b = __builtin_amdgcn_fmed3f(b, -448.f, 448.f); c = __builtin_amdgcn_fmed3f(c, -448.f, 448.f); d = __builtin_amdgcn_fmed3f(d, -448.f, 448.f);
    unsigned p = (unsigned)__builtin_amdgcn_cvt_pk_fp8_f32(a, b, 0, false); return (unsigned)__builtin_amdgcn_cvt_pk_fp8_f32(c, d, (int)p, true); }
#ifndef INP8_MASK
#define INP8_MASK 0xC
#endif
constexpr int INP8 = INP8_MASK;
constexpr float W8_SCALE = 64.f, A8_SCALE = 16.f, G8_SCALE = 4.f, H8_SCALE = 4.f;
__device__ __forceinline__ float bf2f(unsigned short b) { return __uint_as_float(((unsigned)b) << 16); }
#define DPP_F(x, ctrl) __int_as_float(__builtin_amdgcn_update_dpp(0, __float_as_int(x), ctrl, 0xF, 0xF, true))
__device__ __forceinline__ float lane_xor1(float v) { return DPP_F(v, 0xB1); }
__device__ __forceinline__ float sum8(float v) { v += DPP_F(v, 0xB1); v += DPP_F(v, 0x4E); v += DPP_F(v, 0x141); return v; }
__device__ __forceinline__ float sum16(float v) { v = sum8(v); v += DPP_F(v, 0x140); return v; }
__device__ __forceinline__ float wave_sum_dpp(float p) {
    p = sum16(p);
    asm volatile("s_nop 1\n\tv_add_f32_dpp %0, %0, %0 row_bcast:15 row_mask:0xa bank_mask:0xf\n\ts_nop 1\n\tv_add_f32_dpp %0, %0, %0 row_bcast:31 row_mask:0xc bank_mask:0xf\n\ts_nop 0" : "+v"(p));
    return __int_as_float(__builtin_amdgcn_readlane(__float_as_int(p), 63));
}
__device__ __forceinline__ float wave_sum(float v) { return wave_sum_dpp(v); }
__device__ __forceinline__ float wave_max(float v) {
    v = fmaxf(v, DPP_F(v, 0xB1)); v = fmaxf(v, DPP_F(v, 0x4E)); v = fmaxf(v, DPP_F(v, 0x141)); v = fmaxf(v, DPP_F(v, 0x140));
    asm volatile("s_nop 1\n\tv_max_f32_dpp %0, %0, %0 row_bcast:15 row_mask:0xa bank_mask:0xf\n\ts_nop 1\n\tv_max_f32_dpp %0, %0, %0 row_bcast:31 row_mask:0xc bank_mask:0xf\n\ts_nop 0" : "+v"(v));
    return __int_as_float(__builtin_amdgcn_readlane(__float_as_int(v), 63));
}
__device__ __forceinline__ float sigmoidf_(float x) { return 1.f / (1.f + __expf(-x)); }
__device__ __forceinline__ int prevrow(int row) { if (row < 0) return -1; if (row >= NREAL) return row == NREAL ? -1 : row - 1; return (row & (SEQ - 1)) == 0 ? NTOK - 1 : row - 1; }

__device__ __forceinline__ void tr_item(const float* W, int K, int N, bf16* WT, int rowmode, const float* gk, LAS float* scr, int item, int lane) {
    const int nblk = N / 32, kb = item / nblk, nb = item % nblk, k0 = 64 * kb, n0 = 32 * nb;
    const float* src = W + (size_t)(k0 + (lane >> 5)) * N + n0 + (lane & 31);
    float v[32];
#pragma unroll
    for (int i = 0; i < 32; ++i) v[i] = src[(size_t)(2 * i) * N];
#pragma unroll
    for (int i = 0; i < 32; ++i) scr[(2 * i + (lane >> 5)) * 33 + (lane & 31)] = v[i];
    LDS_WAIT(); asm volatile("" ::: "memory");
    const int c = lane & 7;
    f32x4 g0 = (f32x4){1.f, 1.f, 1.f, 1.f}, g1 = g0;
    if (gk) { g0 = *(const f32x4*)(gk + k0 + 8 * c); g1 = *(const f32x4*)(gk + k0 + 8 * c + 4); }
#pragma unroll
    for (int j = 0; j < 4; ++j) { const int n = (lane >> 3) + 8 * j; const LAS float* s = scr + (8 * c) * 33 + n;
        v4u o; o.x = pk2(s[0 * 33] * g0.x, s[1 * 33] * g0.y); o.y = pk2(s[2 * 33] * g0.z, s[3 * 33] * g0.w); o.z = pk2(s[4 * 33] * g1.x, s[5 * 33] * g1.y); o.w = pk2(s[6 * 33] * g1.z, s[7 * 33] * g1.w);
        const int nn = n0 + n; const int drow = rowmode == 0 ? nn : ((nn >> 7) * 256 + (nn & 127) + (rowmode == 2 ? 128 : 0));
        *(GAS v4u*)(WT + (size_t)drow * K + k0 + 8 * c) = o; }
    LDS_WAIT(); asm volatile("" ::: "memory");
}

__device__ __forceinline__ void tr_item2(const float* W0, int K0, int N0, bf16* WT0, int rm0, const float* gk0, int item0,
                                         const float* W1, int K1, int N1, bf16* WT1, int rm1, const float* gk1, int item1, LAS float* scr, int lane, bool f8_0 = false, bool f8_1 = false) {
    const int nb0_ = N0 / 32, nb1_ = N1 / 32;
    const int k00 = 64 * (item0 / nb0_), n00 = 32 * (item0 % nb0_), k01 = 64 * (item1 / nb1_), n01 = 32 * (item1 % nb1_);
    const float* s0 = W0 + (size_t)(k00 + (lane >> 5)) * N0 + n00 + (lane & 31); const float* s1 = W1 + (size_t)(k01 + (lane >> 5)) * N1 + n01 + (lane & 31);
    float v0[32], v1[32];
#pragma unroll
    for (int i = 0; i < 32; ++i) { v0[i] = s0[(size_t)(2 * i) * N0]; v1[i] = s1[(size_t)(2 * i) * N1]; }
    LAS float* t0 = scr; LAS float* t1 = scr + 64 * 33;
#pragma unroll
    for (int i = 0; i < 32; ++i) { t0[(2 * i + (lane >> 5)) * 33 + (lane & 31)] = v0[i]; t1[(2 * i + (lane >> 5)) * 33 + (lane & 31)] = v1[i]; }
    LDS_WAIT(); asm volatile("" ::: "memory");
    const int c = lane & 7;
#pragma unroll
    for (int q = 0; q < 2; ++q) { const float* gk = q ? gk1 : gk0; const int k0 = q ? k01 : k00, n0 = q ? n01 : n00, K = q ? K1 : K0, rowmode = q ? rm1 : rm0; bf16* WT = q ? WT1 : WT0; const LAS float* tt = q ? t1 : t0;
        f32x4 g0 = (f32x4){1.f, 1.f, 1.f, 1.f}, g1 = g0;
        if (gk) { g0 = *(const f32x4*)(gk + k0 + 8 * c); g1 = *(const f32x4*)(gk + k0 + 8 * c + 4); }
#pragma unroll
        for (int j = 0; j < 4; ++j) { const int n = (lane >> 3) + 8 * j; const LAS float* s = tt + (8 * c) * 33 + n;
            v4u o; o.x = pk2(s[0 * 33] * g0.x, s[1 * 33] * g0.y); o.y = pk2(s[2 * 33] * g0.z, s[3 * 33] * g0.w); o.z = pk2(s[4 * 33] * g1.x, s[5 * 33] * g1.y); o.w = pk2(s[6 * 33] * g1.z, s[7 * 33] * g1.w);
            const int nn = n0 + n; const int drow = rowmode == 0 ? nn : ((nn >> 7) * 256 + (nn & 127) + (rowmode == 2 ? 128 : 0));
            if (q ? f8_1 : f8_0) { const unsigned lo = pk4_fp8(s[0 * 33] * g0.x * W8_SCALE, s[1 * 33] * g0.y * W8_SCALE, s[2 * 33] * g0.z * W8_SCALE, s[3 * 33] * g0.w * W8_SCALE), hi8 = pk4_fp8(s[4 * 33] * g1.x * W8_SCALE, s[5 * 33] * g1.y * W8_SCALE, s[6 * 33] * g1.z * W8_SCALE, s[7 * 33] * g1.w * W8_SCALE);
                *(GAS unsigned long long*)((GAS unsigned char*)WT + (size_t)drow * K + k0 + 8 * c) = (unsigned long long)lo | ((unsigned long long)hi8 << 32); }
            else *(GAS v4u*)(WT + (size_t)drow * K + k0 + 8 * c) = o; } }
    LDS_WAIT(); asm volatile("" ::: "memory");
}

__device__ __forceinline__ void meta_gemm_res(const bf16* A, int K, const bf16* Bt, float* Hm, LAS unsigned char* lds, int bx, int wave, int lane, int hbmode = 0, bf16* HBm = nullptr, unsigned long long* rsqm = nullptr) {
    if (bx < 32) {
        typedef short bfx8 __attribute__((ext_vector_type(8)));
        const int ct = 2 * bx + (wave >> 2), ksp = wave & 3, n = lane & 15, kq = lane >> 4; const int kc = K >> 2, steps = kc >> 5;
        const bf16* ap = A + (size_t)n * K + ksp * kc + 8 * kq; const bf16* wp = Bt + (size_t)(16 * ct + n) * K + ksp * kc + 8 * kq;
        f32x4 acc = (f32x4){0.f, 0.f, 0.f, 0.f};
#pragma unroll 11
        for (int s = 0; s < steps; ++s) { const v4u a = *(const v4u*)(wp + 32 * s), b = *(const v4u*)(ap + 32 * s);
            acc = __builtin_amdgcn_mfma_f32_16x16x32_bf16(__builtin_bit_cast(bfx8, a), __builtin_bit_cast(bfx8, b), acc, 0, 0, 0); }
        LAS f32x4* red = (LAS f32x4*)lds;
        red[wave * 64 + lane] = acc;
        __syncthreads();
        if (ksp == 0) { const f32x4 s = (red[wave * 64 + lane] + red[(wave + 1) * 64 + lane]) + (red[(wave + 2) * 64 + lane] + red[(wave + 3) * 64 + lane]);
            f32x4* hp = (f32x4*)(Hm + (size_t)n * 1024 + 16 * ct + 4 * kq); const f32x4 hn = *hp + s; *hp = hn;
            if (hbmode) { const int cc = 16 * ct + 4 * kq;
                if (hbmode == 1) *(unsigned long long*)(HBm + (size_t)n * 1024 + cc) = (unsigned long long)pk2(hn.x, hn.y) | ((unsigned long long)pk2(hn.z, hn.w) << 32);
                else *(unsigned*)((unsigned char*)HBm + (size_t)n * 1024 + cc) = pk4_fp8(hn.x * H8_SCALE, hn.y * H8_SCALE, hn.z * H8_SCALE, hn.w * H8_SCALE);
                __hip_atomic_fetch_add(rsqm + n, (unsigned long long)(((hn.x * hn.x + hn.y * hn.y) + (hn.z * hn.z + hn.w * hn.w)) * 16777216.f), RLX_AGENT); } }
        __syncthreads();
    }
}

__device__ __forceinline__ void meta_gemm_res8(const unsigned char* A, int K, const unsigned char* Bt, float* Hm, float sc, LAS unsigned char* lds, int bx, int wave, int lane) {
    if (bx < 32) {
        typedef int v8i_ __attribute__((ext_vector_type(8)));
        const int ct = 2 * bx + (wave >> 2), ksp = wave & 3, n = lane & 15, kq = lane >> 4; const int kc = K >> 2, steps = kc >> 7;
        const int s0 = ksp < 2 ? 6 * ksp : 12 + 5 * (ksp - 2), ns = ksp < 2 ? 6 : 5; (void)kc; (void)steps;
        const unsigned char* ap = A + (size_t)n * K + 32 * kq; const unsigned char* wp = Bt + (size_t)(16 * ct + n) * K + 32 * kq;
        f32x4 acc = (f32x4){0.f, 0.f, 0.f, 0.f};
#pragma unroll 6
        for (int s = s0; s < s0 + ns; ++s) { const v4u a0 = *(const v4u*)(wp + 128 * s), a1 = *(const v4u*)(wp + 128 * s + 16), b0 = *(const v4u*)(ap + 128 * s), b1 = *(const v4u*)(ap + 128 * s + 16);
            const v8i_ aa = (v8i_){(int)a0.x, (int)a0.y, (int)a0.z, (int)a0.w, (int)a1.x, (int)a1.y, (int)a1.z, (int)a1.w}, bb = (v8i_){(int)b0.x, (int)b0.y, (int)b0.z, (int)b0.w, (int)b1.x, (int)b1.y, (int)b1.z, (int)b1.w};
            acc = __builtin_amdgcn_mfma_scale_f32_16x16x128_f8f6f4(aa, bb, acc, 0, 0, 0, 0x7f7f7f7f, 0, 0x7f7f7f7f); }
        LAS f32x4* red = (LAS f32x4*)lds;
        red[wave * 64 + lane] = acc;
        __syncthreads();
        if (ksp == 0) { const f32x4 s = (red[wave * 64 + lane] + red[(wave + 1) * 64 + lane]) + (red[(wave + 2) * 64 + lane] + red[(wave + 3) * 64 + lane]);
            f32x4* hp = (f32x4*)(Hm + (size_t)n * 1024 + 16 * ct + 4 * kq); *hp = *hp + s * sc; }
        __syncthreads();
    }
}

__global__ void __launch_bounds__(NWAVES * 64, 2) hymba_fwd(Args args) {
    extern __shared__ __attribute__((aligned(16))) unsigned char lds_raw[];
    LAS unsigned char* lds = (LAS unsigned char*)lds_raw;
    volatile LAS unsigned* MISC = (volatile LAS unsigned*)(lds + MISC_OFF);
    const int wave = __builtin_amdgcn_readfirstlane((int)threadIdx.x >> 6);
#define PH_TID int tid; asm volatile("v_mbcnt_lo_u32_b32 %0, -1, 0\n\tv_mbcnt_hi_u32_b32 %0, -1, %0" : "=v"(tid)); tid += wave * 64; const int lane = tid & 63; (void)lane; unsigned char* ws = ws0; asm volatile("" : "+s"(ws)); const char* ka = ka0; asm volatile("" : "+s"(ka)); (void)ka
    const int G = gridDim.x, bx = blockIdx.x;
    const int gw = bx * NWAVES + wave, NGW = G * NWAVES;
    unsigned char* const ws0 = args.ws;
    const char* const ka0 = (const char*)__builtin_amdgcn_kernarg_segment_ptr();
    { const int t0_ = (int)threadIdx.x; if (t0_ < 32) ((LAS unsigned*)(lds + MISC_OFF))[t0_] = 0u; }
    __syncthreads();
    const int lo = args.ph_lo, hi = args.ph_hi;
    const bool multi = (hi - lo) > 1;
    XcdBarrier bar; bar.bar = (unsigned*)(ws0 + WS_CTL) + CW_BAR; bar.x = 0; bar.st = nullptr; bar.wv = wave;
    if (multi) { bar = xcd_barrier_post((unsigned*)(ws0 + WS_CTL) + CW_BAR, MISC + 8); bar.wv = wave; }
#ifndef ENMASK
#define ENMASK 0xFFFF
#endif
#define EN(k) (((ENMASK) >> (k)) & 1)
#ifndef REPMASK
#define REPMASK 0
#endif
#define NREP(k) ((((REPMASK) >> (k)) & 1) ? 2 : 1)
#define IN(k) (lo <= (k) && (k) < hi)
#define SEAM(k) do { if (hi > (k) + 1) xcd_barrier(bar); } while (0)

#define Hf ((float*)(ws + WS_H))
#define HB ((bf16*)(ws + WS_HB))
#define RSTD ((float*)(ws + WS_RSTD))
#define PROJ ((bf16*)(ws + WS_PROJ))
#define QN ((bf16*)(ws + WS_QN))
#define KP ((bf16*)(ws + WS_KP))
#define VP ((bf16*)(ws + WS_VP))
#define OC ((bf16*)(ws + WS_OC))
#define OMIX ((bf16*)(ws + WS_OMIX))
#define SP4 ((f32x4*)(ws + WS_SC + 0 * SC_STRIDE))
#define SR ((float*)(ws + WS_SC + 4 * SC_STRIDE))
#define SV ((float*)(ws + WS_SC + 5 * SC_STRIDE))
#define SG ((float*)(ws + WS_SC + 6 * SC_STRIDE))
#define SBON ((float*)(ws + WS_SC + 7 * SC_STRIDE))
#define SY ((float*)(ws + WS_SC + 8 * SC_STRIDE))
#define COS ((float*)(ws + WS_COS))
#define SIN ((float*)(ws + WS_SIN))
#define GB ((bf16*)(ws + WS_G))
#define AROWS ((bf16*)(ws + WS_AROWS))
#define YM ((bf16*)(ws + WS_YM))
#define RSQA ((unsigned long long*)(ws + WS_RSROW))
#define TOKE ((int*)(ws + WS_TOKE))
#define TOKS ((int*)(ws + WS_TOKS))
#define TOKG ((float*)(ws + WS_TOKG))
#define ctl ((gu32*)(ws + WS_CTL))
#define INP(i) (*(const float* const*)(ka + 8 * (i)))
#define LORA_W ((float*)(ws + WS_LORA))
#define LORA_AG ((bf16*)(ws + WS_LORA + 17 * MiB))
#define CH_REC ((unsigned char*)(ws + WS_MWGU + 44 * MiB))
#define CH_RB 11008
#define CH_SPK ((unsigned char*)(ws + WS_HB))
#ifndef SCAN_CHUNKED
#define SCAN_CHUNKED 1
#endif

    for (int rep_ = 0; rep_ < NREP(15); ++rep_) if (EN(15) && IN(0)) { PH_TID;
        LAS float* scr = (LAS float*)(lds + wave * 17408);
        constexpr int I_IN = 16 * 100, I_OUT = 16 * 32, I_GU = 16 * 88, I_DN = 44 * 32;
        constexpr int NITEMS = DEPTH * (I_IN + I_OUT) + 2 * (2 * I_GU + I_DN);
        for (int it0 = 2 * gw; it0 < NITEMS; it0 += 2 * NGW) {
            const float* W_[2]; bf16* D_[2]; int K_[2], N_[2], rm_[2], r_[2]; const float* g_[2]; bool f8_[2] = {false, false};
#pragma unroll
            for (int q = 0; q < 2; ++q) { int r = it0 + q;
                if (r < DEPTH * I_IN) { const int l = r / I_IN; W_[q] = INP(3) + (size_t)l * DM * INC; K_[q] = DM; N_[q] = INC; D_[q] = (bf16*)(ws + WS_WIN) + (size_t)l * INP * DM; rm_[q] = 0; g_[q] = INP(2) + l * DM; r_[q] = r % I_IN; f8_[q] = ((INP8 >> l) & 1) != 0; continue; } r -= DEPTH * I_IN;
                if (r < DEPTH * I_OUT) { const int l = r / I_OUT; W_[q] = INP(23) + (size_t)l * DM * DM; K_[q] = DM; N_[q] = DM; D_[q] = (bf16*)(ws + WS_WOUT) + (size_t)l * DM * DM; rm_[q] = 0; g_[q] = nullptr; r_[q] = r % I_OUT; continue; } r -= DEPTH * I_OUT;
                if (r < 2 * I_GU) { const int j = r / I_GU; W_[q] = INP(25) + (size_t)j * DM * FF; K_[q] = DM; N_[q] = FF; D_[q] = (bf16*)(ws + WS_WGU) + (size_t)j * FF2 * DM; rm_[q] = 1; g_[q] = INP(24) + (2 * j) * DM; r_[q] = r % I_GU; f8_[q] = (j == 1); continue; } r -= 2 * I_GU;
                if (r < 2 * I_GU) { const int j = r / I_GU; W_[q] = INP(26) + (size_t)j * DM * FF; K_[q] = DM; N_[q] = FF; D_[q] = (bf16*)(ws + WS_WGU) + (size_t)j * FF2 * DM; rm_[q] = 2; g_[q] = INP(24) + (2 * j) * DM; r_[q] = r % I_GU; f8_[q] = (j == 1); continue; } r -= 2 * I_GU;
                { const int j = r / I_DN; W_[q] = INP(27) + (size_t)j * FF * DM; K_[q] = FF; N_[q] = DM; D_[q] = (bf16*)(ws + WS_WD) + (size_t)j * DM * FF; rm_[q] = 0; g_[q] = nullptr; r_[q] = r % I_DN; f8_[q] = (j == 1); } }
            tr_item2(W_[0], K_[0], N_[0], D_[0], rm_[0], g_[0], r_[0], W_[1], K_[1], N_[1], D_[1], rm_[1], g_[1], r_[1], scr, lane, f8_[0], f8_[1]);
        }
        const int gt = bx * (NWAVES * 64) + tid, NGT = G * NWAVES * 64;
        for (int i = gt; i < DEPTH * 128 * (DM / 8); i += NGT) { const int l = i / (128 * (DM / 8)), r = i % (128 * (DM / 8));
            if ((INP8 >> l) & 1) { if (r < 128 * (DM / 16)) ((v4u*)((unsigned char*)(ws + WS_WIN) + (size_t)l * INP * DM * 2 + (size_t)INC * DM))[r] = zero_v4u(); }
            else ((v4u*)((bf16*)(ws + WS_WIN) + ((size_t)l * INP + INC) * DM))[r] = zero_v4u(); }
        for (int row = gw; row < MPAD; row += NGW) {
            f32x4 v[4]; float s = 0.f;
#pragma unroll
            for (int j = 0; j < 4; ++j) { const int c4 = lane + 64 * j; v[j] = __builtin_bit_cast(f32x4, zero_v4u());
                if (row < NREAL) v[j] = ((const f32x4*)INP(0))[(size_t)row * (DM / 4) + c4]; else if (row < NTOK) v[j] = ((const f32x4*)INP(1))[(row - NREAL) * (DM / 4) + c4];
                ((f32x4*)Hf)[(size_t)row * (DM / 4) + c4] = v[j]; s += (v[j].x * v[j].x + v[j].y * v[j].y) + (v[j].z * v[j].z + v[j].w * v[j].w); }
            if (row < NTOK) { s = wave_sum(s); const float rstd = 1.f / sqrtf(s * (1.f / DM) + 1e-6f);
                if (INP8 & 1) { const float sn = rstd * A8_SCALE;
#pragma unroll
                    for (int j = 0; j < 4; ++j) ((unsigned*)((unsigned char*)HB + (size_t)row * DM))[lane + 64 * j] = pk4_fp8(v[j].x * sn, v[j].y * sn, v[j].z * sn, v[j].w * sn); }
                else {
#pragma unroll
                    for (int j = 0; j < 4; ++j) ((unsigned long long*)(HB + (size_t)row * DM))[lane + 64 * j] = (unsigned long long)pk2(v[j].x, v[j].y) | ((unsigned long long)pk2(v[j].z, v[j].w) << 32); }
                if (lane == 0) RSTD[row] = rstd; }
        }
        if (INP8 & 1) { for (int i = gt; i < (MPAD - NTOK) * (DM / 16); i += NGT) ((v4u*)((unsigned char*)HB + (size_t)NTOK * DM))[i] = zero_v4u(); }
        else
        for (int i = gt; i < (MPAD - NTOK) * (DM / 8); i += NGT) ((v4u*)(HB + (size_t)NTOK * DM))[i] = zero_v4u();
        for (int i = gt; i < MPAD - NTOK; i += NGT) RSTD[NTOK + i] = 0.f;
        for (int i = gt; i < (SEQ + NMETA) * 8; i += NGT) { const int pos = i >> 3, j = i & 7;
            const float invf = j == 0 ? 1.000000000e+00f : j == 1 ? 1.939227432e-01f : j == 2 ? 3.760603070e-02f : j == 3 ? 7.292664610e-03f : j == 4 ? 1.414213562e-03f : j == 5 ? 2.742481884e-04f : j == 6 ? 5.318296098e-05f : 1.031338616e-05f;
            const float angf = (float)pos * invf; const double a = (double)angf; const double n = __builtin_rint(a * 0.15915494309189535);
            const double rr = (a - n * 6.283185307179586) - n * 2.4492935982947064e-16; const float rev = (float)(rr * 0.15915494309189535);
            COS[i] = __builtin_amdgcn_cosf(rev); SIN[i] = __builtin_amdgcn_sinf(rev); }
        SEAM(0);
    }

#pragma nounroll
    for (int layer = 0; layer < DEPTH; ++layer) {
        const int pb = 1 + 12 * layer; const bool moe = (layer & 1) != 0; const int jj = layer >> 1;
        if (hi <= pb || lo >= pb + 12) continue;
        const float lam_init = 0.8f - 0.6f * __expf(-0.3f * (float)layer);

        for (int rep_ = 0; rep_ < NREP(0); ++rep_) if (EN(0) && IN(pb + 0) && moe) { PH_TID;
            for (int row = gw; row < NTOK; row += NGW) {
                const GAS f32x4* xr = (const GAS f32x4*)(Hf + (size_t)row * DM) + lane; f32x4 v[4]; float s = 0.f;
#pragma unroll
                for (int j = 0; j < 4; ++j) { v[j] = xr[64 * j]; s += (v[j].x * v[j].x + v[j].y * v[j].y) + (v[j].z * v[j].z + v[j].w * v[j].w); }
                s = wave_sum(s); const float rstd = 1.f / sqrtf(s * (1.f / DM) + 1e-6f);
                if ((INP8 >> layer) & 1) { GAS unsigned* o4 = (GAS unsigned*)((GAS unsigned char*)HB + (size_t)row * DM) + lane; const float sn = rstd * A8_SCALE;
#pragma unroll
                    for (int j = 0; j < 4; ++j) o4[64 * j] = pk4_fp8(v[j].x * sn, v[j].y * sn, v[j].z * sn, v[j].w * sn); }
                else { GAS unsigned long long* o8 = (GAS unsigned long long*)(HB + (size_t)row * DM) + lane;
#pragma unroll
                    for (int j = 0; j < 4; ++j) o8[64 * j] = (unsigned long long)pk2(v[j].x, v[j].y) | ((unsigned long long)pk2(v[j].z, v[j].w) << 32); }
                if (lane == 0) RSTD[row] = rstd;
            }
            if ((INP8 >> layer) & 1) { const int gt = bx * (NWAVES * 64) + tid, NGT = G * NWAVES * 64;
                for (int i = gt; i < (MPAD - NTOK) * (DM / 16); i += NGT) ((v4u*)((unsigned char*)HB + (size_t)NTOK * DM))[i] = zero_v4u(); }
            if (moe) {
                LAS float* scr = (LAS float*)(lds + wave * 17408);
                constexpr int I_GU = 16 * 88, I_DN = 44 * 32, PER_E = 2 * I_GU + I_DN;
                const float* gff = INP(24) + layer * DM;
                for (int it0 = 2 * gw; it0 < NE * PER_E; it0 += 2 * NGW) {
                    const float* W_[2]; bf16* D_[2]; int K_[2], N_[2], rm_[2], r_[2]; const float* g_[2];
#pragma unroll
                    for (int q = 0; q < 2; ++q) { const int it = it0 + q; const int e = it / PER_E; int r = it % PER_E; const size_t eo = (size_t)(jj * NE + e) * DM * FF;
                        if (r < I_GU) { W_[q] = INP(29) + eo; K_[q] = DM; N_[q] = FF; D_[q] = (bf16*)(ws + WS_MWGU) + (size_t)e * FF2 * DM / 2; rm_[q] = 1; g_[q] = gff; }
                        else if (r < 2 * I_GU) { r -= I_GU; W_[q] = INP(30) + eo; K_[q] = DM; N_[q] = FF; D_[q] = (bf16*)(ws + WS_MWGU) + (size_t)e * FF2 * DM / 2; rm_[q] = 2; g_[q] = gff; }
                        else { r -= 2 * I_GU; W_[q] = INP(31) + eo; K_[q] = FF; N_[q] = DM; D_[q] = (bf16*)(ws + WS_MWD) + (size_t)e * DM * FF / 2; rm_[q] = 0; g_[q] = nullptr; }
                        r_[q] = r; }
                    tr_item2(W_[0], K_[0], N_[0], D_[0], rm_[0], g_[0], r_[0], W_[1], K_[1], N_[1], D_[1], rm_[1], g_[1], r_[1], scr, lane, true, true);
                }
            }
            SEAM(pb + 0);
        }
        for (int rep_ = 0; rep_ < NREP(1); ++rep_) if (EN(1) && IN(pb + 1)) { PH_TID;
            pg8::StaticOrder S; S.init(MPAD, INP, G, bx);
            if ((INP8 >> layer) & 1) { pg8::Gemm g{HB, (const bf16*)(ws + WS_WIN) + (size_t)layer * INP * DM, MPAD, INP, DM / 2}; pg8::EpiBf16Rs E{PROJ, INP, nullptr, 1.f / (W8_SCALE * A8_SCALE)};
                pg8::gemm_phase<pg8::EpiBf16Rs, pg8::StaticOrder, true, true, true>(lds, g, S, E, tid); }
            else { pg8::Gemm g{HB, (const bf16*)(ws + WS_WIN) + (size_t)layer * INP * DM, MPAD, INP, DM}; pg8::EpiBf16Rs E{PROJ, INP, RSTD, 1.f};
                pg8::gemm_phase<pg8::EpiBf16Rs, pg8::StaticOrder, true, true>(lds, g, S, E, tid); }
            SEAM(pb + 1);
        }
        for (int rep_ = 0; rep_ < NREP(2); ++rep_) if (EN(2) && IN(pb + 2)) { PH_TID;
            const int gt = bx * (NWAVES * 64) + tid, NGT = G * NWAVES * 64;
            if (tid < 65) { const v4u z_ = zero_v4u(); RSQA[bx * 65 + tid] = (unsigned long long)z_.x | ((unsigned long long)z_.y << 32); }
            for (int i = gt; i < NB * 112 * 64; i += NGT) { const int b = i / (112 * 64), r = (i / 64) % 112, c = i % 64; const int row = b * KVROWS + (r < 48 ? r : r + 16);
                ((v4u*)(KP + (size_t)row * 512))[c] = zero_v4u(); ((v4u*)(VP + (size_t)row * 512))[c] = zero_v4u(); }
            const int ngrp = (1025 - bx + 255) / 256, nrows = 16 * ngrp;
#define MP_ROW(idx) (16 * (bx + 256 * ((idx) >> 4)) + ((idx) & 15))
            LAS unsigned char* WT = lds;
            { const int nn = tid & 255, hf = tid >> 8;
              const float* sd = INP(6) + layer * 32 * 256 + (hf * 16) * 256 + nn; const float* sa = INP(8) + layer * 32 * 256 + (hf * 16) * 256 + nn; const float* sg = INP(9) + layer * 64 * 256 + (hf * 32) * 256 + nn;
              v4u wv[2];
#pragma unroll
              for (int i = 0; i < 2; ++i) { wv[i].x = pk2(sd[(8 * i) * 256], sd[(8 * i + 1) * 256]); wv[i].y = pk2(sd[(8 * i + 2) * 256], sd[(8 * i + 3) * 256]); wv[i].z = pk2(sd[(8 * i + 4) * 256], sd[(8 * i + 5) * 256]); wv[i].w = pk2(sd[(8 * i + 6) * 256], sd[(8 * i + 7) * 256]); }
              *(LAS v4u*)(WT + nn * 64 + hf * 32) = wv[0]; *(LAS v4u*)(WT + nn * 64 + hf * 32 + 16) = wv[1];
#pragma unroll
              for (int i = 0; i < 2; ++i) { wv[i].x = pk2(sa[(8 * i) * 256], sa[(8 * i + 1) * 256]); wv[i].y = pk2(sa[(8 * i + 2) * 256], sa[(8 * i + 3) * 256]); wv[i].z = pk2(sa[(8 * i + 4) * 256], sa[(8 * i + 5) * 256]); wv[i].w = pk2(sa[(8 * i + 6) * 256], sa[(8 * i + 7) * 256]); }
              *(LAS v4u*)(WT + 16384 + nn * 64 + hf * 32) = wv[0]; *(LAS v4u*)(WT + 16384 + nn * 64 + hf * 32 + 16) = wv[1];
#pragma unroll
              for (int i = 0; i < 4; ++i) { v4u t; t.x = pk2(sg[(8 * i) * 256], sg[(8 * i + 1) * 256]); t.y = pk2(sg[(8 * i + 2) * 256], sg[(8 * i + 3) * 256]); t.z = pk2(sg[(8 * i + 4) * 256], sg[(8 * i + 5) * 256]); t.w = pk2(sg[(8 * i + 6) * 256], sg[(8 * i + 7) * 256]);
                  *(LAS v4u*)(WT + 32768 + nn * 128 + hf * 64 + 16 * i) = t; } }
            __syncthreads();
            const float* mu = INP(4) + layer * RCOLS; const float* w0 = INP(5) + layer * 256; const float* a0 = INP(7) + layer * 256;
            const float* k_k = INP(10) + layer * 256; const float* k_a = INP(11) + layer * 256; const float* r_k = INP(12) + layer * 256;
            const float* qg = INP(15) + layer * 64; const float* kg = INP(16) + layer * 64; const float* cw = INP(22) + layer * 3 * 256;
            for (int rep3_ = 0; rep3_ < NREP(5); ++rep3_)
            if (wave < ngrp) {
                typedef attn_body::bf16x8 bfx8;
                const int rowbase = 16 * (bx + 256 * wave);
                LAS unsigned char* XT = lds + 65536 + wave * 4096;
                { const float mu0 = mu[768 + 2 * lane], mu1 = mu[768 + 2 * lane + 1]; const int p0 = prevrow(rowbase);
                  unsigned cur = p0 < 0 ? 0u : *(const unsigned*)(PROJ + (size_t)p0 * INP + 768 + 2 * lane); float pl = __uint_as_float(cur << 16), ph = __uint_as_float(cur & 0xffff0000u);
#pragma unroll
                  for (int r = 0; r < 16; ++r) { cur = *(const unsigned*)(PROJ + (size_t)(rowbase + r) * INP + 768 + 2 * lane); const float xl = __uint_as_float(cur << 16), xh = __uint_as_float(cur & 0xffff0000u);
                      float h0 = xl + (pl - xl) * mu0, h1 = xh + (ph - xh) * mu1; pl = xl; ph = xh;
                      if (lane < 16) { h0 = 1.f - 2.f / (1.f + __expf(2.f * h0)); h1 = 1.f - 2.f / (1.f + __expf(2.f * h1)); } else if (lane >= 32) { h0 = sigmoidf_(h0); h1 = sigmoidf_(h1); }
                      *(LAS unsigned*)(XT + r * 256 + 4 * lane) = pk2(h0, h1); } }
                LDS_WAIT();
                const int n = lane & 15, kq = lane >> 4;
                const v4u xd = *(const LAS v4u*)(XT + n * 256 + (8 * kq) * 2), xa = *(const LAS v4u*)(XT + n * 256 + (32 + 8 * kq) * 2);
                const v4u xg0 = *(const LAS v4u*)(XT + n * 256 + (64 + 8 * kq) * 2), xg1 = *(const LAS v4u*)(XT + n * 256 + (96 + 8 * kq) * 2);
                float* lw = LORA_W + (size_t)(rowbase + n) * 256 + 4 * kq; bf16* lag = LORA_AG + (size_t)(rowbase + n) * 512 + 4 * kq;
#pragma unroll 4
                for (int ct = 0; ct < 16; ++ct) {
                    const v4u ad = *(const LAS v4u*)(WT + (16 * ct + n) * 64 + (8 * kq) * 2), aa = *(const LAS v4u*)(WT + 16384 + (16 * ct + n) * 64 + (8 * kq) * 2);
                    const v4u ag0 = *(const LAS v4u*)(WT + 32768 + (16 * ct + n) * 128 + (8 * kq) * 2), ag1 = *(const LAS v4u*)(WT + 32768 + (16 * ct + n) * 128 + (32 + 8 * kq) * 2);
                    f32x4 dd = __builtin_amdgcn_mfma_f32_16x16x32_bf16(__builtin_bit_cast(bfx8, ad), __builtin_bit_cast(bfx8, xd), (f32x4){0.f, 0.f, 0.f, 0.f}, 0, 0, 0);
                    f32x4 da = __builtin_amdgcn_mfma_f32_16x16x32_bf16(__builtin_bit_cast(bfx8, aa), __builtin_bit_cast(bfx8, xa), (f32x4){0.f, 0.f, 0.f, 0.f}, 0, 0, 0);
                    f32x4 dg = __builtin_amdgcn_mfma_f32_16x16x32_bf16(__builtin_bit_cast(bfx8, ag0), __builtin_bit_cast(bfx8, xg0), (f32x4){0.f, 0.f, 0.f, 0.f}, 0, 0, 0);
                    dg = __builtin_amdgcn_mfma_f32_16x16x32_bf16(__builtin_bit_cast(bfx8, ag1), __builtin_bit_cast(bfx8, xg1), dg, 0, 0, 0);
                    *(f32x4*)(lw + 16 * ct) = dd;
                    *(unsigned long long*)(lag + 16 * ct) = (unsigned long long)pk2(da.x, da.y) | ((unsigned long long)pk2(da.z, da.w) << 32);
                    *(unsigned long long*)(lag + 256 + 16 * ct) = (unsigned long long)pk2(dg.x, dg.y) | ((unsigned long long)pk2(dg.z, dg.w) << 32);
                }
            }
            asm volatile("s_waitcnt vmcnt(0)" ::: "memory");
            __syncthreads();
#pragma nounroll
            for (int rep3_ = 0; rep3_ < NREP(10); ++rep3_)
            {
                typedef unsigned u32x2_ __attribute__((ext_vector_type(2)));
                const int sub = lane & 7; const int c4 = 4 * lane;
                const f32x4 qg0 = *(const f32x4*)(qg + 8 * sub), qg1 = *(const f32x4*)(qg + 8 * sub + 4), kg0 = *(const f32x4*)(kg + 8 * sub), kg1 = *(const f32x4*)(kg + 8 * sub + 4);
                const f32x4 cw0 = *(const f32x4*)(cw + c4), cw1 = *(const f32x4*)(cw + 256 + c4), cw2 = *(const f32x4*)(cw + 512 + c4);
                v4u rq, rk, rv; u32x2_ b0, g0_, u0, g1_, u1, g2_, u2;
#define AP_LOAD(rw) do { const int p1_ = prevrow(rw), p2_ = prevrow(p1_); const bf16* q_ = PROJ + (size_t)(rw) * INP; const bf16* q1_ = PROJ + (size_t)(p1_ < 0 ? (rw) : p1_) * INP; const bf16* q2_ = PROJ + (size_t)(p2_ < 0 ? (rw) : p2_) * INP; \
                    rq = *(const v4u*)(q_ + QOFF + 8 * lane); rk = *(const v4u*)(q_ + KOFF + 8 * lane); rv = *(const v4u*)(q_ + VOFF + 8 * lane); (void)q1_; (void)q2_; } while (0)
#define CV_LOAD(rw) do { const int p1_ = prevrow(rw), p2_ = prevrow(p1_); const bf16* q_ = PROJ + (size_t)(rw) * INP; const bf16* q1_ = PROJ + (size_t)(p1_ < 0 ? (rw) : p1_) * INP; const bf16* q2_ = PROJ + (size_t)(p2_ < 0 ? (rw) : p2_) * INP; \
                    b0 = *(const u32x2_*)(q_ + COFF + c4); g0_ = *(const u32x2_*)(q_ + COFF + 256 + c4); u0 = *(const u32x2_*)(q_ + COFF + 512 + c4); \
                    g1_ = *(const u32x2_*)(q1_ + COFF + 256 + c4); u1 = *(const u32x2_*)(q1_ + COFF + 512 + c4); g2_ = *(const u32x2_*)(q2_ + COFF + 256 + c4); u2 = *(const u32x2_*)(q2_ + COFF + 512 + c4); } while (0)
#define U2F4(t_) ((f32x4){__uint_as_float((t_).x << 16), __uint_as_float((t_).x & 0xffff0000u), __uint_as_float((t_).y << 16), __uint_as_float((t_).y & 0xffff0000u)})
                int idx = wave; AP_LOAD(MP_ROW(idx));
                for (; idx < nrows; idx += 8) { const int row = MP_ROW(idx);
                    const int p1 = prevrow(row), p2 = prevrow(p1); const float m1 = p1 < 0 ? 0.f : 1.f, m2 = p2 < 0 ? 0.f : 1.f;
                    const v4u cq = rq, ck = rk, cv = rv;
                    CV_LOAD(row);
                    if (idx + 8 < nrows) AP_LOAD(MP_ROW(idx + 8));
                    const int pos = row >= NREAL ? row - NREAL : NMETA + (row & (SEQ - 1));
                    const f32x4 c0 = *(const f32x4*)(COS + pos * 8), c1 = *(const f32x4*)(COS + pos * 8 + 4), n0 = *(const f32x4*)(SIN + pos * 8), n1 = *(const f32x4*)(SIN + pos * 8 + 4);
                    const float cs[8] = {c0.x, c0.y, c0.z, c0.w, c1.x, c1.y, c1.z, c1.w}; const float sn[8] = {n0.x, n0.y, n0.z, n0.w, n1.x, n1.y, n1.z, n1.w};
#pragma unroll
                    for (int which = 0; which < 2; ++which) {
                        const v4u raw = which ? ck : cq;
                        float x[8] = {__uint_as_float(raw.x << 16), __uint_as_float(raw.x & 0xffff0000u), __uint_as_float(raw.y << 16), __uint_as_float(raw.y & 0xffff0000u),
                                      __uint_as_float(raw.z << 16), __uint_as_float(raw.z & 0xffff0000u), __uint_as_float(raw.w << 16), __uint_as_float(raw.w & 0xffff0000u)};
                        float s2 = 0.f;
#pragma unroll
                        for (int i = 0; i < 8; ++i) s2 += x[i] * x[i];
                        s2 = sum8(s2);
                        const float rs = 1.f / sqrtf(s2 * (1.f / 64.f) + 1e-6f);
                        const f32x4 ga = which ? kg0 : qg0, gb = which ? kg1 : qg1;
                        const float gg[8] = {ga.x, ga.y, ga.z, ga.w, gb.x, gb.y, gb.z, gb.w};
                        float o[8];
#pragma unroll
                        for (int i = 0; i < 8; ++i) { const float xn = x[i] * rs * gg[i]; const float xp = lane_xor1(xn);
                            o[i] = sub == 0 ? xn * cs[i] - xp * sn[i] : (sub == 1 ? xn * cs[i] + xp * sn[i] : xn); if (!which) o[i] *= C2Q; }
                        v4u w; w.x = pk2(o[0], o[1]); w.y = pk2(o[2], o[3]); w.z = pk2(o[4], o[5]); w.w = pk2(o[6], o[7]);
                        if (!which) *(v4u*)(QN + (size_t)row * 512 + 8 * lane) = w;
                        else {
                            if (row < NREAL) { const size_t kr = (size_t)((row >> 12) * KVROWS + 128 + (row & (SEQ - 1))) * 512 + 8 * lane; *(v4u*)(KP + kr) = w; *(v4u*)(VP + kr) = cv; }
                            else {
#pragma unroll
                                for (int b = 0; b < NB; ++b) { const size_t kr = (size_t)(b * KVROWS + 48 + (row - NREAL)) * 512 + 8 * lane; *(v4u*)(KP + kr) = w; *(v4u*)(VP + kr) = cv; } } }
                    }
                    { const f32x4 fb0 = U2F4(b0), z0 = U2F4(g0_) * U2F4(u0), z1 = U2F4(g1_) * U2F4(u1) * m1, z2 = U2F4(g2_) * U2F4(u2) * m2;
                      const f32x4 y = cw0 * z2 + cw1 * z1 + cw2 * z0; const f32x4 o = fb0 * y;
                      *(unsigned long long*)(OMIX + (size_t)row * DM + 768 + c4) = (unsigned long long)pk2(o.x, o.y) | ((unsigned long long)pk2(o.z, o.w) << 32); }
                }
#undef AP_LOAD
#undef CV_LOAD
#undef U2F4
            }
            {
                LAS float* XL = (LAS float*)(lds + wave * 17408);
                LAS float* YL = XL + 32 * 65;
                const int nreal_g = ngrp - (bx == 0 ? 1 : 0);
                for (int lt = wave; lt < 4 * nreal_g + (bx == 0 ? 4 : 0); lt += NWAVES) {
                    int bh, ch; if (lt < 4 * nreal_g) { const int g = bx + 256 * (lt >> 2); bh = (g >> 8) * 4 + (lt & 3); ch = (g & 255) + 1; } else { bh = lt - 4 * nreal_g; ch = 0; }
                    const int task = bh * 257 + ch, b = bh >> 2, cb = (bh & 3) * 64; const int rowbase = ch == 0 ? NREAL : b * SEQ + 16 * (ch - 1);
                    float at[16], rt[16], bt[16], kt[16], vsv[16]; float gam = 1.f;
                    { const int c = cb + lane;
                      const float mu_r = mu[c], mu_k = mu[256 + c], mu_v = mu[512 + c], w0c = w0[c], a0c = a0[c], kkc = k_k[c], kac = k_a[c], rkc = r_k[c];
                      const int p0 = prevrow(rowbase); const bf16* q0 = PROJ + (size_t)(p0 < 0 ? rowbase : p0) * INP + c; const float pm = p0 < 0 ? 0.f : 1.f;
                      float pr_ = pm * bf2f(q0[0]), pk_ = pm * bf2f(q0[256]), pv_ = pm * bf2f(q0[512]);
                      unsigned short xr[16], xk[16], xv[16], la[16], lg[16]; float lw[16];
#pragma unroll
                      for (int t = 0; t < 16; ++t) { const bf16* q_ = PROJ + (size_t)(rowbase + t) * INP + c; xr[t] = q_[0]; xk[t] = q_[256]; xv[t] = q_[512];
                          lw[t] = LORA_W[(size_t)(rowbase + t) * 256 + c]; la[t] = LORA_AG[(size_t)(rowbase + t) * 512 + c]; lg[t] = LORA_AG[(size_t)(rowbase + t) * 512 + 256 + c]; }
#pragma unroll
                      for (int t = 0; t < 16; ++t) {
                          const float fr = bf2f(xr[t]), fk = bf2f(xk[t]), fv = bf2f(xv[t]);
                          const float r = fr + (pr_ - fr) * mu_r, k = fk + (pk_ - fk) * mu_k, v = fv + (pv_ - fv) * mu_v; pr_ = fr; pk_ = fk; pv_ = fv;
                          const float wacc = w0c + lw[t], aacc = a0c + bf2f(la[t]), gacc = bf2f(lg[t]);
                          const float nx = -wacc; const float sp = fmaxf(nx, 0.f) + __logf(1.f + __expf(-fabsf(nx)));
                          const float wlog = -sp - 0.5f; const float decay = __expf(-__expf(wlog));
                          const float a = sigmoidf_(aacc);
                          const float kkr = k * kkc; const float ss = wave_sum_dpp(kkr * kkr); const float kk = kkr / fmaxf(sqrtf(ss), 1e-12f);
                          const float k2 = k * (1.f + (a - 1.f) * kac);
                          const float bs = wave_sum_dpp(r * k2 * rkc);
                          const size_t si = (size_t)(rowbase + t) * 256 + c;
                          SG[si] = gacc; SBON[si] = bs * v;
                          at[t] = -kk * gam; gam *= decay; rt[t] = r * gam; const float ig = 1.f / gam; bt[t] = kk * a * ig; kt[t] = k2 * ig; vsv[t] = v; } }
#pragma unroll
                    for (int t = 0; t < 16; ++t) { XL[t * 65 + lane] = bt[t]; XL[(16 + t) * 65 + lane] = kt[t]; YL[t * 65 + lane] = at[t]; YL[(16 + t) * 65 + lane] = rt[t]; }
                    attn_body::f32x16 gm = attn_body::f32x16{};
#pragma unroll 8
                    for (int kk = 0; kk < 32; ++kk) gm = __builtin_amdgcn_mfma_f32_32x32x2f32(XL[(lane & 31) * 65 + 2 * kk + (lane >> 5)], YL[(lane & 31) * 65 + 2 * kk + (lane >> 5)], gm, 0, 0, 0);
                    LDS_WAIT();
                    LAS float* GL = YL; LAS float* TL = YL + 1056; LAS float* XM = YL + 1328;
#pragma unroll
                    for (int r = 0; r < 16; ++r) GL[((r & 3) + 8 * (r >> 2) + 4 * (lane >> 5)) * 33 + (lane & 31)] = gm[r];
                    float tr[16];
#pragma unroll
                    for (int t = 0; t < 16; ++t) tr[t] = ((lane & 15) == t) ? 1.f : 0.f;
#pragma unroll
                    for (int s = 0; s < 15; ++s)
#pragma unroll
                        for (int t = s + 1; t < 16; ++t) tr[t] = fmaf(tr[s], GL[s * 33 + t], tr[t]);
                    if (lane < 16) {
#pragma unroll
                        for (int t = 0; t < 16; ++t) TL[lane * 17 + t] = tr[t]; }
                    { const int s = lane & 15, q = lane >> 4; float x0 = 0.f, x1 = 0.f, x2 = 0.f, x3 = 0.f;
#pragma unroll
                      for (int u = 1; u < 16; ++u) { const float l = (u > s) ? GL[(16 + s) * 33 + u] : 0.f; x0 = fmaf(l, TL[u * 17 + 4 * q], x0); x1 = fmaf(l, TL[u * 17 + 4 * q + 1], x1); x2 = fmaf(l, TL[u * 17 + 4 * q + 2], x2); x3 = fmaf(l, TL[u * 17 + 4 * q + 3], x3); }
                      XM[s * 17 + 4 * q] = x0; XM[s * 17 + 4 * q + 1] = x1; XM[s * 17 + 4 * q + 2] = x2; XM[s * 17 + 4 * q + 3] = x3; }
                    float atT[16];
#pragma unroll
                    for (int sp = 0; sp < 16; ++sp) { float acc = 0.f;
#pragma unroll
                        for (int s = 0; s <= sp; ++s) acc = fmaf(at[s], TL[s * 17 + sp], acc);
                        atT[sp] = acc; }
                    unsigned char* rec = CH_REC + (size_t)task * CH_RB;
                    ((float*)rec)[lane] = gam;
                    LAS unsigned short* ST = (LAS unsigned short*)XL;
                    const int kpos = (lane & ~15) + 8 * ((lane >> 2) & 1) + (lane & 3) + 4 * ((lane >> 3) & 1);
                    float zz[16];
#pragma unroll
                    for (int s = 0; s < 16; ++s) { float acc = kt[s] * gam;
#pragma unroll
                        for (int sp = s + 1; sp < 16; ++sp) acc = fmaf(XM[s * 17 + sp], bt[sp] * gam, acc);
                        zz[s] = acc; }
#pragma unroll
                    for (int t = 0; t < 16; ++t) { float acc = rt[t];
#pragma unroll
                        for (int s = 0; s <= t; ++s) acc = fmaf(atT[s], GL[s * 33 + 16 + t], acc);
                        ST[t * 64 + kpos] = (unsigned short)f2bf(atT[t]); ST[(16 + t) * 64 + kpos] = (unsigned short)f2bf(acc); }
                    { v4u w0, w1;
                      w0.x = pk2(bt[0] * gam, bt[1] * gam); w0.y = pk2(bt[2] * gam, bt[3] * gam); w0.z = pk2(bt[8] * gam, bt[9] * gam); w0.w = pk2(bt[10] * gam, bt[11] * gam);
                      w1.x = pk2(bt[4] * gam, bt[5] * gam); w1.y = pk2(bt[6] * gam, bt[7] * gam); w1.z = pk2(bt[12] * gam, bt[13] * gam); w1.w = pk2(bt[14] * gam, bt[15] * gam);
                      v4u* d = (v4u*)(rec + 4352 + lane * 32); d[0] = w0; d[1] = w1;
                      v4u z0, z1; z0.x = pk2(zz[0], zz[1]); z0.y = pk2(zz[2], zz[3]); z0.z = pk2(zz[4], zz[5]); z0.w = pk2(zz[6], zz[7]);
                      z1.x = pk2(zz[8], zz[9]); z1.y = pk2(zz[10], zz[11]); z1.z = pk2(zz[12], zz[13]); z1.w = pk2(zz[14], zz[15]);
                      v4u* dz = (v4u*)(rec + 6400 + lane * 32); dz[0] = z0; dz[1] = z1; }
                    { float vs[16];
#pragma unroll
                      for (int s = 0; s < 16; ++s) vs[s] = vsv[s];
                      v4u a0, a1; a0.x = pk2(vs[0], vs[1]); a0.y = pk2(vs[2], vs[3]); a0.z = pk2(vs[4], vs[5]); a0.w = pk2(vs[6], vs[7]);
                      a1.x = pk2(vs[8], vs[9]); a1.y = pk2(vs[10], vs[11]); a1.z = pk2(vs[12], vs[13]); a1.w = pk2(vs[14], vs[15]);
                      v4u* dv = (v4u*)(rec + 8448 + lane * 32); dv[0] = a0; dv[1] = a1; }
                    { const int s = lane & 15, q = lane >> 4;
#pragma unroll
                      for (int e = 0; e < 4; ++e) { const int t = 4 * q + e; float acc = (t >= s) ? GL[(16 + s) * 33 + 16 + t] : 0.f;
#pragma unroll
                          for (int sp = 1; sp < 16; ++sp) { const float m = (sp <= t) ? GL[sp * 33 + 16 + t] : 0.f; acc = fmaf(XM[s * 17 + sp], m, acc); }
                          ((unsigned short*)(rec + 10496))[t * 16 + s] = (unsigned short)f2bf(acc); } }
                    LDS_WAIT();
                    { const LAS v4u* sv = (const LAS v4u*)ST + lane; v4u* d = (v4u*)(rec + 256) + lane;
#pragma unroll
                      for (int i = 0; i < 4; ++i) d[64 * i] = sv[64 * i]; }
                    LDS_WAIT();
                    if (ch == 0) {
                        asm volatile("s_waitcnt vmcnt(0)" ::: "memory");
                        const v4u* src = (const v4u*)rec;
#pragma unroll 1
                        for (int i = lane; i < CH_RB / 16; i += 64) { const v4u w = src[i];
#pragma unroll
                            for (int cp = 1; cp < 4; ++cp) ((v4u*)(CH_REC + (size_t)((bh + 4 * cp) * 257) * CH_RB))[i] = w; }
                    }
                }
            }
            SEAM(pb + 2);
        }
        for (int rep_ = 0; rep_ < NREP(3); ++rep_) if (EN(3) && IN(pb + 3)) { PH_TID;
#define PK8(T, o) ((v4u){attn_body::cvtpk_s(T[o], T[o + 1]), attn_body::cvtpk_s(T[o + 2], T[o + 3]), attn_body::cvtpk_s(T[o + 4], T[o + 5]), attn_body::cvtpk_s(T[o + 6], T[o + 7])})
            for (int rep2_ = 0; rep2_ < NREP(13); ++rep2_)
            if (bx < 32) {
                typedef attn_body::bf16x8 bfx8; typedef attn_body::f32x16 fx16;
                const int bh = bx >> 1, vh = bx & 1, n = lane & 31, hh = lane >> 5;
                const unsigned char* rec0 = CH_REC + (size_t)(bh * 257) * CH_RB;
                const unsigned lds0 = (unsigned)(uintptr_t)lds_raw;
                constexpr int RBUF = 6 * CH_RB;
#define S2_ISSUE(rnd) do { if (wave >= 1 && wave <= 6) { const int c_ = 6 * (rnd) + wave - 1; if (c_ < 257) { const unsigned dst_ = lds0 + ((rnd) & 1) * RBUF + (wave - 1) * CH_RB; \
                    for (int p_ = 0; p_ < 11; ++p_) attn_body::glds16s(rec0 + (size_t)c_ * CH_RB + p_ * 1024, (unsigned)lane * 16u, (unsigned)__builtin_amdgcn_readfirstlane(dst_ + p_ * 1024)); } } } while (0)
                S2_ISSUE(0);
                asm volatile("s_waitcnt vmcnt(0)\n\ts_barrier" ::: "memory");
                v4u* spk = (v4u*)(CH_SPK + (size_t)(bh * 257) * 8192 + vh * 4096) + lane;
                fx16 st0 = fx16{}, st1 = fx16{};
                for (int rnd = 0; rnd < 43; ++rnd) {
                    S2_ISSUE(rnd + 1);
                    if (wave == 0) {
                        v4u atf[4], bhf[2], ztf[2], vtf; f32x4 gq[8];
#define S2_FRAGS(j_) do { const LAS unsigned char* r_ = lds + (rnd & 1) * RBUF + (j_) * CH_RB; \
                            _Pragma("unroll") for (int ks = 0; ks < 4; ++ks) atf[ks] = *(const LAS v4u*)(r_ + 256 + ((lane & 15) * 64 + 16 * ks + 8 * hh) * 2); \
                            _Pragma("unroll") for (int i = 0; i < 2; ++i) { bhf[i] = *(const LAS v4u*)(r_ + 4352 + ((32 * i + n) * 16 + 8 * hh) * 2); ztf[i] = *(const LAS v4u*)(r_ + 6400 + ((32 * i + n) * 16 + 8 * hh) * 2); } \
                            vtf = *(const LAS v4u*)(r_ + 8448 + ((32 * vh + n) * 16 + 8 * hh) * 2); \
                            _Pragma("unroll") for (int i = 0; i < 2; ++i) _Pragma("unroll") for (int q = 0; q < 4; ++q) gq[4 * i + q] = *(const LAS f32x4*)(r_ + (32 * i + 8 * q + 4 * hh) * 4); } while (0)
                        S2_FRAGS(0);
                        for (int j = 0; j < 6; ++j) { const int ch = 6 * rnd + j; if (ch >= 257) break;
                            const v4u a0 = atf[0], a1 = atf[1], a2 = atf[2], a3 = atf[3], b0 = bhf[0], b1 = bhf[1], z0 = ztf[0], z1 = ztf[1], vt = vtf;
                            f32x4 g_[8];
#pragma unroll
                            for (int i = 0; i < 8; ++i) g_[i] = gq[i];
                            if (j < 5) S2_FRAGS(j + 1);
                            const v4u s0 = PK8(st0, 0), s1 = PK8(st0, 8), s2 = PK8(st1, 0), s3 = PK8(st1, 8);
                            spk[(size_t)ch * 512 + 0] = s0; spk[(size_t)ch * 512 + 64] = s1; spk[(size_t)ch * 512 + 128] = s2; spk[(size_t)ch * 512 + 192] = s3;
                            fx16 pt = fx16{};
                            pt = __builtin_amdgcn_mfma_f32_32x32x16_bf16(__builtin_bit_cast(bfx8, a0), __builtin_bit_cast(bfx8, s0), pt, 0, 0, 0);
                            pt = __builtin_amdgcn_mfma_f32_32x32x16_bf16(__builtin_bit_cast(bfx8, a1), __builtin_bit_cast(bfx8, s1), pt, 0, 0, 0);
                            pt = __builtin_amdgcn_mfma_f32_32x32x16_bf16(__builtin_bit_cast(bfx8, a2), __builtin_bit_cast(bfx8, s2), pt, 0, 0, 0);
                            pt = __builtin_amdgcn_mfma_f32_32x32x16_bf16(__builtin_bit_cast(bfx8, a3), __builtin_bit_cast(bfx8, s3), pt, 0, 0, 0);
#pragma unroll
                            for (int q = 0; q < 4; ++q) { st0[4 * q] *= g_[q].x; st0[4 * q + 1] *= g_[q].y; st0[4 * q + 2] *= g_[q].z; st0[4 * q + 3] *= g_[q].w;
                                                          st1[4 * q] *= g_[4 + q].x; st1[4 * q + 1] *= g_[4 + q].y; st1[4 * q + 2] *= g_[4 + q].z; st1[4 * q + 3] *= g_[4 + q].w; }
                            st0 = __builtin_amdgcn_mfma_f32_32x32x16_bf16(__builtin_bit_cast(bfx8, z0), __builtin_bit_cast(bfx8, vt), st0, 0, 0, 0);
                            st1 = __builtin_amdgcn_mfma_f32_32x32x16_bf16(__builtin_bit_cast(bfx8, z1), __builtin_bit_cast(bfx8, vt), st1, 0, 0, 0);
                            const v4u pp = PK8(pt, 0);
                            st0 = __builtin_amdgcn_mfma_f32_32x32x16_bf16(__builtin_bit_cast(bfx8, b0), __builtin_bit_cast(bfx8, pp), st0, 0, 0, 0);
                            st1 = __builtin_amdgcn_mfma_f32_32x32x16_bf16(__builtin_bit_cast(bfx8, b1), __builtin_bit_cast(bfx8, pp), st1, 0, 0, 0);
                        }
#undef S2_FRAGS
                        asm volatile("s_waitcnt lgkmcnt(0)\n\ts_barrier" ::: "memory");
                    } else asm volatile("s_waitcnt vmcnt(0) lgkmcnt(0)\n\ts_barrier" ::: "memory");
                }
#undef S2_ISSUE
            }
            __syncthreads();
            for (int rep2_ = 0; rep2_ < NREP(12); ++rep2_)
            { const attn_body::AttnTensors AT{(const attn_body::bf16*)QN, (const attn_body::bf16*)KP, (const attn_body::bf16*)VP, (attn_body::bf16*)OC};
              const attn_body::QueueOrder SO{(unsigned*)(ctl + CW_ATTQ + (layer * 8 + (bx & 7)) * 64), (LAS unsigned*)(lds + MISC_OFF + 64), bx & 7, tid};
              attn_body::attn_phase<attn_body::QueueOrder>((char*)lds_raw, AT, SO, tid); }
            __syncthreads();
#ifndef NO_META
            {
                LAS float* sc = (LAS float*)(lds + wave * 1024); LAS float* qs = sc + 64;
                for (int task = gw; task < NMETA * 8; task += NGW) {
                    const int row = NREAL + (task >> 3), hc = task & 7, h = hc >> 1; const int n = row - NREAL + 1;
                    qs[lane] = bf2f(QN[(size_t)row * 512 + hc * 64 + lane]);
                    float m = -INFINITY;
                    { const int idx = lane;
                        if (idx < n) { const size_t kr = 48 + idx; const v4u* kp = (const v4u*)(KP + kr * 512 + hc * 64); float dot = 0.f;
#pragma unroll
                            for (int c8 = 0; c8 < 8; ++c8) { const v4u kv = kp[c8];
                                dot += qs[c8 * 8 + 0] * __uint_as_float(kv.x << 16) + qs[c8 * 8 + 1] * __uint_as_float(kv.x & 0xffff0000u) + qs[c8 * 8 + 2] * __uint_as_float(kv.y << 16) + qs[c8 * 8 + 3] * __uint_as_float(kv.y & 0xffff0000u)
                                     + qs[c8 * 8 + 4] * __uint_as_float(kv.z << 16) + qs[c8 * 8 + 5] * __uint_as_float(kv.z & 0xffff0000u) + qs[c8 * 8 + 6] * __uint_as_float(kv.w << 16) + qs[c8 * 8 + 7] * __uint_as_float(kv.w & 0xffff0000u); }
                            sc[idx] = dot; m = dot; } }
                    m = wave_max(m);
                    float l = 0.f;
                    if (lane < n) { const float p = __builtin_amdgcn_exp2f(sc[lane] - m); sc[lane] = p; l = p; }
                    l = wave_sum(l);
                    float o0 = 0.f, o1 = 0.f;
                    for (int idx = 0; idx < n; ++idx) { const float p = sc[idx]; const size_t vr = 48 + idx;
                        const unsigned v2 = *(const unsigned*)(VP + vr * 512 + h * 128 + 2 * lane); o0 += p * __uint_as_float(v2 << 16); o1 += p * __uint_as_float(v2 & 0xffff0000u); }
                    const float inv = 1.f / l;
                    *(unsigned*)(OC + (size_t)row * 1024 + hc * 128 + 2 * lane) = pk2(o0 * inv, o1 * inv);
                    LDS_WAIT();
                }
            }
#endif
            SEAM(pb + 3);
        }
        for (int rep_ = 0; rep_ < NREP(4); ++rep_) if (EN(4) && IN(pb + 4)) { PH_TID;
            const float* gn_g = INP(13) + layer * 256; const float* gn_b = INP(14) + layer * 256; const float* subg = INP(21) + layer * 128;
            const float s1 = wave_sum(INP(17)[layer * 64 + lane] * INP(18)[layer * 64 + lane]); const float s2 = wave_sum(INP(19)[layer * 64 + lane] * INP(20)[layer * 64 + lane]);
            const float lam = __expf(s1) - __expf(s2) + lam_init;
            const int ngrp = (1025 - bx + 255) / 256, nrows = 16 * ngrp;
            {
                typedef attn_body::bf16x8 bfx8; typedef attn_body::f32x16 fx16;
                const int n = lane & 31, hh = lane >> 5;
                for (int lt = wave; lt < 8 * ngrp; lt += NWAVES) {
                    const int g = bx + 256 * (lt >> 3), hd = (lt >> 1) & 3, vh = lt & 1; const int bh = g < 1024 ? (g >> 8) * 4 + hd : hd, ch = g < 1024 ? (g & 255) + 1 : 0;
                    const int ct = bh * 257 + ch, b = bh >> 2, cb = (bh & 3) * 64; const int rowbase = ch == 0 ? NREAL : b * SEQ + 16 * (ch - 1);
                    const unsigned char* r_ = CH_REC + (size_t)ct * CH_RB; const v4u* spk = (const v4u*)(CH_SPK + (size_t)ct * 8192 + vh * 4096) + lane;
                    fx16 y = fx16{};
#pragma unroll
                    for (int ks = 0; ks < 4; ++ks) { const v4u a = *(const v4u*)(r_ + 2304 + ((lane & 15) * 64 + 16 * ks + 8 * hh) * 2); const v4u s = spk[64 * ks];
                        y = __builtin_amdgcn_mfma_f32_32x32x16_bf16(__builtin_bit_cast(bfx8, a), __builtin_bit_cast(bfx8, s), y, 0, 0, 0); }
                    { const v4u a = *(const v4u*)(r_ + 10496 + ((lane & 15) * 16 + 8 * hh) * 2); const v4u vt = *(const v4u*)(r_ + 8448 + ((32 * vh + n) * 16 + 8 * hh) * 2);
                      y = __builtin_amdgcn_mfma_f32_32x32x16_bf16(__builtin_bit_cast(bfx8, a), __builtin_bit_cast(bfx8, vt), y, 0, 0, 0); }
                    {
#pragma unroll
                        for (int r = 0; r < 8; ++r) SY[(size_t)(rowbase + (r & 3) + 8 * (r >> 2) + 4 * hh) * 256 + cb + 32 * vh + n] = y[r]; }
                }
            }
#undef PK8
            asm volatile("s_waitcnt vmcnt(0)" ::: "memory");
            __syncthreads();
            for (int idx = wave; idx < nrows; idx += NWAVES) { const int row = MP_ROW(idx);
                { const f32x4 y = *(const f32x4*)(SY + (size_t)row * 256 + 4 * lane); const float mean = sum16((y.x + y.y) + (y.z + y.w)) * (1.f / 64.f);
                  const f32x4 dlt = y - mean; const float var = sum16((dlt.x * dlt.x + dlt.y * dlt.y) + (dlt.z * dlt.z + dlt.w * dlt.w)) * (1.f / 64.f); const float rs = 1.f / sqrtf(var + 64e-5f);
                  const f32x4 gg = *(const f32x4*)(gn_g + 4 * lane), gb = *(const f32x4*)(gn_b + 4 * lane), bon = *(const f32x4*)(SBON + (size_t)row * 256 + 4 * lane), gt = *(const f32x4*)(SG + (size_t)row * 256 + 4 * lane);
                  const f32x4 o = (dlt * rs * gg + gb + bon) * gt;
                  *(unsigned long long*)(OMIX + (size_t)row * DM + 4 * lane) = (unsigned long long)pk2(o.x, o.y) | ((unsigned long long)pk2(o.z, o.w) << 32); }
                { const int h = lane >> 4, j8 = (lane & 15) * 8; const v4u a0 = *(const v4u*)(OC + (size_t)row * 1024 + (h * 2 + 0) * 128 + j8), a1 = *(const v4u*)(OC + (size_t)row * 1024 + (h * 2 + 1) * 128 + j8);
                  float dv[8];
                  dv[0] = __uint_as_float(a0.x << 16) - lam * __uint_as_float(a1.x << 16); dv[1] = __uint_as_float(a0.x & 0xffff0000u) - lam * __uint_as_float(a1.x & 0xffff0000u);
                  dv[2] = __uint_as_float(a0.y << 16) - lam * __uint_as_float(a1.y << 16); dv[3] = __uint_as_float(a0.y & 0xffff0000u) - lam * __uint_as_float(a1.y & 0xffff0000u);
                  dv[4] = __uint_as_float(a0.z << 16) - lam * __uint_as_float(a1.z << 16); dv[5] = __uint_as_float(a0.z & 0xffff0000u) - lam * __uint_as_float(a1.z & 0xffff0000u);
                  dv[6] = __uint_as_float(a0.w << 16) - lam * __uint_as_float(a1.w << 16); dv[7] = __uint_as_float(a0.w & 0xffff0000u) - lam * __uint_as_float(a1.w & 0xffff0000u);
                  float ss = 0.f;
#pragma unroll
                  for (int i = 0; i < 8; ++i) ss += dv[i] * dv[i];
                  ss = sum16(ss); const float sc_ = (1.f / sqrtf(ss * (1.f / 128.f) + 1e-5f)) * (1.f - lam_init);
                  const f32x4 g0 = *(const f32x4*)(subg + j8), g1 = *(const f32x4*)(subg + j8 + 4);
                  v4u o; o.x = pk2(dv[0] * sc_ * g0.x, dv[1] * sc_ * g0.y); o.y = pk2(dv[2] * sc_ * g0.z, dv[3] * sc_ * g0.w); o.z = pk2(dv[4] * sc_ * g1.x, dv[5] * sc_ * g1.y); o.w = pk2(dv[6] * sc_ * g1.z, dv[7] * sc_ * g1.w);
                  *(v4u*)(OMIX + (size_t)row * DM + 256 + h * 128 + j8) = o; }
            }
            { const int gt = bx * (NWAVES * 64) + tid, NGT = G * NWAVES * 64;
              for (int i = gt; i < (MPAD - NTOK) * (DM / 8); i += NGT) ((v4u*)(OMIX + (size_t)NTOK * DM))[i] = zero_v4u(); }
            SEAM(pb + 4);
        }
        if (EN(5) && IN(pb + 5)) { PH_TID;
            pg8::Gemm g{OMIX, (const bf16*)(ws + WS_WOUT) + (size_t)layer * DM * DM, NREAL, DM, DM}; pg8::StaticOrder S; S.init(NREAL, DM, G, bx);
            if (!moe) {
                if (layer == 2) {
                    meta_gemm_res(OMIX + (size_t)NREAL * DM, DM, (const bf16*)(ws + WS_WOUT) + (size_t)layer * DM * DM, Hf + (size_t)NREAL * DM, lds, bx, wave, lane, 2, (bf16*)((unsigned char*)HB + (size_t)NREAL * DM), RSQA + NREAL);
                    typedef pg8::EpiResAddHB<2, (long long)WS_HB - (long long)WS_H, (long long)WS_RSROW - (long long)WS_H> EpiHB2; EpiHB2 E{Hf, DM, 1.f};
                    pg8::gemm_phase<EpiHB2, pg8::StaticOrder, true, true>(lds, g, S, E, tid);
                } else {
                    meta_gemm_res(OMIX + (size_t)NREAL * DM, DM, (const bf16*)(ws + WS_WOUT) + (size_t)layer * DM * DM, Hf + (size_t)NREAL * DM, lds, bx, wave, lane, 1, HB + (size_t)NREAL * DM, RSQA + NREAL);
                    typedef pg8::EpiResAddHB<1, (long long)WS_HB - (long long)WS_H, (long long)WS_RSROW - (long long)WS_H> EpiHB1; EpiHB1 E{Hf, DM, 1.f};
                    pg8::gemm_phase<EpiHB1, pg8::StaticOrder, true, true>(lds, g, S, E, tid);
                }
            } else {
                meta_gemm_res(OMIX + (size_t)NREAL * DM, DM, (const bf16*)(ws + WS_WOUT) + (size_t)layer * DM * DM, Hf + (size_t)NREAL * DM, lds, bx, wave, lane);
                pg8::EpiResAdd E{Hf, DM, 1.f};
                pg8::gemm_phase<pg8::EpiResAdd, pg8::StaticOrder, true, true>(lds, g, S, E, tid);
            }
            SEAM(pb + 5);
        }
        if (EN(6) && IN(pb + 6) && moe) { PH_TID;
            LAS int* lcnt = (LAS int*)lds; LAS int* lbase = lcnt + 8; LAS int* lrow = lcnt + 16;
            if (tid < 16) lcnt[tid] = 0;
            __syncthreads();
            const float* gff = INP(24) + layer * DM; const float* Wr = INP(28) + (size_t)jj * DM * NE;
            for (int i = wave; i < 72; i += NWAVES) { const int row = bx + G * i;
                if (row < NTOK) {
                    const GAS f32x4* xr = (const GAS f32x4*)(Hf + (size_t)row * DM) + lane; f32x4 v[4]; float s = 0.f;
#pragma unroll
                    for (int j = 0; j < 4; ++j) { v[j] = xr[64 * j]; s += (v[j].x * v[j].x + v[j].y * v[j].y) + (v[j].z * v[j].z + v[j].w * v[j].w); }
                    s = wave_sum(s); const float rstd = 1.f / sqrtf(s * (1.f / DM) + 1e-6f);
                    if (moe) { LAS unsigned* o4 = (LAS unsigned*)(lds + 4096 + i * 1024) + lane; const float sn = rstd * A8_SCALE;
#pragma unroll
                      for (int j = 0; j < 4; ++j) o4[64 * j] = pk4_fp8(v[j].x * sn, v[j].y * sn, v[j].z * sn, v[j].w * sn); }
                    else if (layer == 2) { GAS unsigned* o4 = (GAS unsigned*)((GAS unsigned char*)HB + (size_t)row * DM) + lane; const float sn = rstd * A8_SCALE;
#pragma unroll
                      for (int j = 0; j < 4; ++j) o4[64 * j] = pk4_fp8(v[j].x * sn, v[j].y * sn, v[j].z * sn, v[j].w * sn); }
                    else { GAS unsigned long long* o8 = (GAS unsigned long long*)(HB + (size_t)row * DM) + lane;
#pragma unroll
                      for (int j = 0; j < 4; ++j) o8[64 * j] = (unsigned long long)pk2(v[j].x, v[j].y) | ((unsigned long long)pk2(v[j].z, v[j].w) << 32); }
                    if (lane == 0) RSTD[row] = rstd;
                    if (moe) {
                        float lg[8];
#pragma unroll
                        for (int e = 0; e < 8; ++e) lg[e] = 0.f;
#pragma unroll
                        for (int j = 0; j < 4; ++j) { const int k0 = 4 * lane + 256 * j; const f32x4 gv = *(const f32x4*)(gff + k0);
#pragma unroll
                            for (int q = 0; q < 4; ++q) { const float hv = v[j][q] * gv[q]; const f32x4 wa = *(const f32x4*)(Wr + (size_t)(k0 + q) * 8), wb = *(const f32x4*)(Wr + (size_t)(k0 + q) * 8 + 4);
                                lg[0] += hv * wa.x; lg[1] += hv * wa.y; lg[2] += hv * wa.z; lg[3] += hv * wa.w; lg[4] += hv * wb.x; lg[5] += hv * wb.y; lg[6] += hv * wb.z; lg[7] += hv * wb.w; } }
#pragma unroll
                        for (int e = 0; e < 8; ++e) lg[e] = wave_sum(lg[e]) * rstd;
                        int e1 = 0; float l1 = lg[0];
#pragma unroll
                        for (int e = 1; e < 8; ++e) if (lg[e] > l1) { l1 = lg[e]; e1 = e; }
                        int e2 = -1; float l2 = -INFINITY;
#pragma unroll
                        for (int e = 0; e < 8; ++e) if (e != e1 && lg[e] > l2) { l2 = lg[e]; e2 = e; }
                        if (lane == 0) { const float g2 = 1.f / (1.f + __expf(l1 - l2)); const float g1 = 1.f - g2;
                            const int sl1 = atomicAdd((int*)&lcnt[e1], 1), sl2 = atomicAdd((int*)&lcnt[e2], 1);
                            lrow[i * 4 + 0] = e1; lrow[i * 4 + 1] = sl1; lrow[i * 4 + 2] = e2; lrow[i * 4 + 3] = sl2;
                            TOKG[row * 2 + 0] = g1; TOKG[row * 2 + 1] = g2; }
                    }
                }
            }
            if (moe) {
                __syncthreads();
                if (tid < 8) lbase[tid] = (int)__hip_atomic_fetch_add((unsigned*)(ctl + CW_MOECNT + 64 * jj + tid), (unsigned)lcnt[tid], RLX_AGENT);
                __syncthreads();
                if (tid < 72) { const int row = bx + G * tid; if (row < NTOK) { const int e1 = lrow[tid * 4 + 0], e2 = lrow[tid * 4 + 2];
                    TOKE[row * 2 + 0] = e1; TOKE[row * 2 + 1] = e2; TOKS[row * 2 + 0] = lbase[e1] + lrow[tid * 4 + 1]; TOKS[row * 2 + 1] = lbase[e2] + lrow[tid * 4 + 3]; } }
                __syncthreads();
            }
            SEAM(pb + 6);
        }
        if (!moe) {
            for (int rep_ = 0; rep_ < NREP(7); ++rep_) if (EN(7) && IN(pb + 7)) { PH_TID;
                pg8::StaticOrder S; S.init(MPAD, FF2, G, bx);
                if (layer == 2) { pg8::Gemm g{HB, (const bf16*)(ws + WS_WGU) + (size_t)jj * FF2 * DM, MPAD, FF2, DM / 2}; pg8::EpiSwiglu8 E{GB, FF, nullptr, 1.f / (W8_SCALE * H8_SCALE), G8_SCALE, RSQA};
                    pg8::gemm_phase<pg8::EpiSwiglu8, pg8::StaticOrder, true, true, true>(lds, g, S, E, tid); }
                else { pg8::Gemm g{HB, (const bf16*)(ws + WS_WGU) + (size_t)jj * FF2 * DM, MPAD, FF2, DM}; pg8::EpiSwiglu E{GB, FF, nullptr, 1.f, 0.f, RSQA};
                    pg8::gemm_phase<pg8::EpiSwiglu, pg8::StaticOrder, true, true>(lds, g, S, E, tid); }
                SEAM(pb + 7);
            }
            if (EN(8) && IN(pb + 8)) { PH_TID;
                pg8::StaticOrder S; S.init(NREAL, DM, G, bx);
                if (layer == 2) {
                    meta_gemm_res8((const unsigned char*)GB + (size_t)NREAL * FF, FF, (const unsigned char*)((const bf16*)(ws + WS_WD) + (size_t)jj * DM * FF), Hf + (size_t)NREAL * DM, 1.f / (W8_SCALE * G8_SCALE), lds, bx, wave, lane);
                    pg8::Gemm g{GB, (const bf16*)(ws + WS_WD) + (size_t)jj * DM * FF, NREAL, DM, FF / 2}; pg8::EpiResAdd E{Hf, DM, 1.f / (W8_SCALE * G8_SCALE)};
                    pg8::gemm_phase<pg8::EpiResAdd, pg8::StaticOrder, true, true, true>(lds, g, S, E, tid);
                } else {
                    meta_gemm_res(GB + (size_t)NREAL * FF, FF, (const bf16*)(ws + WS_WD) + (size_t)jj * DM * FF, Hf + (size_t)NREAL * DM, lds, bx, wave, lane);
                    pg8::Gemm g{GB, (const bf16*)(ws + WS_WD) + (size_t)jj * DM * FF, NREAL, DM, FF}; pg8::EpiResAdd E{Hf, DM, 1.f};
                    pg8::gemm_phase<pg8::EpiResAdd, pg8::StaticOrder, true, true>(lds, g, S, E, tid);
                }
                SEAM(pb + 8);
            }
        } else {
#define cnt ((const int*)(ctl + CW_MOECNT + 64 * jj))
            for (int rep_ = 0; rep_ < NREP(7); ++rep_) if (EN(7) && IN(pb + 7)) { PH_TID;
                int ts[8]; { int a = 0;
#pragma unroll
                    for (int e = 0; e < 8; ++e) { ts[e] = a; a += (__hip_atomic_load(cnt + e, RLX_AGENT) + 255) >> 8; } }
                { LAS const int* lbase = (LAS const int*)lds + 8; LAS const int* lrow = (LAS const int*)lds + 16;
                  for (int i = wave; i < 72; i += NWAVES) { const int row = bx + G * i;
                      if (row < NTOK) { const v4u d = *(const LAS v4u*)(lds + 4096 + i * 1024 + lane * 16);
#pragma unroll
                          for (int c = 0; c < 2; ++c) { const int e = lrow[i * 4 + 2 * c]; int tse = 0, lb = 0;
#pragma unroll
                              for (int x = 0; x < 8; ++x) { tse = (e == x) ? ts[x] : tse; lb = (e == x) ? lbase[x] : lb; }
                              const size_t p = (size_t)tse * 256 + lb + lrow[i * 4 + 2 * c + 1];
                              ((v4u*)((unsigned char*)AROWS + p * DM))[lane] = d; } } } }
                SEAM(pb + 7);
            }
            for (int rep_ = 0; rep_ < NREP(8); ++rep_) if (EN(8) && IN(pb + 8)) { PH_TID;
                pg8::Gemm g{AROWS, (const bf16*)(ws + WS_MWGU), MOEP, FF2, DM / 2}; pg8::MoeOrder S; S.init(cnt, FF2 / 256, G, bx);
                pg8::EpiSwiglu8 E{GB, FF, nullptr, 1.f / (W8_SCALE * A8_SCALE), G8_SCALE};
                pg8::gemm_phase<pg8::EpiSwiglu8, pg8::MoeOrder, true, true, true>(lds, g, S, E, tid);
                SEAM(pb + 8);
            }
            for (int rep_ = 0; rep_ < NREP(9); ++rep_) if (EN(9) && IN(pb + 9)) { PH_TID;
                pg8::Gemm g{GB, (const bf16*)(ws + WS_MWD), MOEP, DM, FF / 2}; pg8::MoeOrder S; S.init(cnt, DM / 256, G, bx);
                pg8::EpiBf16Rs E{YM, DM, nullptr, 1.f / (W8_SCALE * G8_SCALE)};
                pg8::gemm_phase<pg8::EpiBf16Rs, pg8::MoeOrder, true, true, true>(lds, g, S, E, tid);
                SEAM(pb + 9);
            }
            if (EN(10) && IN(pb + 10)) { PH_TID;
                int ts[8]; { int a = 0;
#pragma unroll
                    for (int e = 0; e < 8; ++e) { ts[e] = a; a += (__hip_atomic_load(cnt + e, RLX_AGENT) + 255) >> 8; } }
                for (int row = gw; row < NTOK; row += NGW) {
                    const int e1 = TOKE[row * 2], e2 = TOKE[row * 2 + 1]; int t1 = 0, t2 = 0;
#pragma unroll
                    for (int q = 0; q < 8; ++q) { t1 = (e1 == q) ? ts[q] : t1; t2 = (e2 == q) ? ts[q] : t2; }
                    const size_t p1 = (size_t)t1 * 256 + TOKS[row * 2], p2 = (size_t)t2 * 256 + TOKS[row * 2 + 1]; const float g1 = TOKG[row * 2], g2 = TOKG[row * 2 + 1];
                    float* hr = Hf + (size_t)row * DM; f32x4 hv[2][2]; float ssq = 0.f;
#pragma unroll
                    for (int j = 0; j < 2; ++j) { const int c8 = (lane + 64 * j) * 8; const v4u y1 = *(const v4u*)(YM + p1 * DM + c8), y2 = *(const v4u*)(YM + p2 * DM + c8);
                        f32x4 ha = *(f32x4*)(hr + c8), hb2 = *(f32x4*)(hr + c8 + 4);
                        ha.x += g1 * __uint_as_float(y1.x << 16) + g2 * __uint_as_float(y2.x << 16); ha.y += g1 * __uint_as_float(y1.x & 0xffff0000u) + g2 * __uint_as_float(y2.x & 0xffff0000u);
                        ha.z += g1 * __uint_as_float(y1.y << 16) + g2 * __uint_as_float(y2.y << 16); ha.w += g1 * __uint_as_float(y1.y & 0xffff0000u) + g2 * __uint_as_float(y2.y & 0xffff0000u);
                        hb2.x += g1 * __uint_as_float(y1.z << 16) + g2 * __uint_as_float(y2.z << 16); hb2.y += g1 * __uint_as_float(y1.z & 0xffff0000u) + g2 * __uint_as_float(y2.z & 0xffff0000u);
                        hb2.z += g1 * __uint_as_float(y1.w << 16) + g2 * __uint_as_float(y2.w << 16); hb2.w += g1 * __uint_as_float(y1.w & 0xffff0000u) + g2 * __uint_as_float(y2.w & 0xffff0000u);
                        hv[j][0] = ha; hv[j][1] = hb2; ssq += (ha.x * ha.x + ha.y * ha.y) + (ha.z * ha.z + ha.w * ha.w) + (hb2.x * hb2.x + hb2.y * hb2.y) + (hb2.z * hb2.z + hb2.w * hb2.w); }
                    if (layer == DEPTH - 1) {
                        if (row < NREAL) { float* orow = (*(float* const*)(ka + 256)) + (size_t)row * DM;
#pragma unroll
                            for (int j = 0; j < 2; ++j) { const int c8 = (lane + 64 * j) * 8; *(f32x4*)(orow + c8) = hv[j][0]; *(f32x4*)(orow + c8 + 4) = hv[j][1]; } }
                    } else {
                        ssq = wave_sum(ssq); const float rstd = 1.f / sqrtf(ssq * (1.f / DM) + 1e-6f), sn = rstd * A8_SCALE;
#pragma unroll
                        for (int j = 0; j < 2; ++j) { const int c8 = (lane + 64 * j) * 8; *(f32x4*)(hr + c8) = hv[j][0]; *(f32x4*)(hr + c8 + 4) = hv[j][1];
                            if ((INP8 >> (layer + 1)) & 1) { const unsigned lo = pk4_fp8(hv[j][0].x * sn, hv[j][0].y * sn, hv[j][0].z * sn, hv[j][0].w * sn), hi8 = pk4_fp8(hv[j][1].x * sn, hv[j][1].y * sn, hv[j][1].z * sn, hv[j][1].w * sn);
                                *(unsigned long long*)((unsigned char*)HB + (size_t)row * DM + c8) = (unsigned long long)lo | ((unsigned long long)hi8 << 32); }
                            else { v4u w; w.x = pk2(hv[j][0].x, hv[j][0].y); w.y = pk2(hv[j][0].z, hv[j][0].w); w.z = pk2(hv[j][1].x, hv[j][1].y); w.w = pk2(hv[j][1].z, hv[j][1].w);
                                *(v4u*)(HB + (size_t)row * DM + c8) = w; } }
                        if (lane == 0) RSTD[row] = rstd;
                    }
                }
                SEAM(pb + 10);
            }
        }
    }
#ifdef UBENCH
    if (hi >= 48 && bx == 255) { PH_TID;
        float x = (float)lane * 1e-3f, y = 1.0001f; float acc = 0.f;
        for (int it = 0; it < UBENCH_ITERS; ++it) {
#if UBENCH == 1
#pragma unroll
            for (int k = 0; k < 64; ++k) { asm volatile("v_fma_f32 %0, %0, %1, %0" : "+v"(x) : "v"(y)); }
#elif UBENCH == 2
#pragma unroll
            for (int k = 0; k < 64; ++k) { asm volatile("s_nop 1\n\tv_add_f32_dpp %0, %0, %0 row_mirror row_mask:0xf bank_mask:0xf bound_ctrl:1" : "+v"(x)); }
#elif UBENCH == 3
#pragma unroll
            for (int k = 0; k < 32; ++k) { asm volatile("s_nop 0\n\tv_readlane_b32 s20, %0, 63\n\tv_fmac_f32 %0, s20, %1" : "+v"(x) : "v"(y) : "s20"); }
#elif UBENCH == 5
            { float y2 = x + 1.f;
#pragma unroll
            for (int k = 0; k < 64; ++k) { asm volatile("s_nop 1\n\tv_add_f32_dpp %0, %0, %0 row_mirror row_mask:0xf bank_mask:0xf bound_ctrl:1\n\tv_add_f32_dpp %1, %1, %1 row_mirror row_mask:0xf bank_mask:0xf bound_ctrl:1" : "+v"(x), "+v"(y2)); }
            x += y2; }
#elif UBENCH == 6
            if (wave < 4) {
#pragma unroll
            for (int k = 0; k < 64; ++k) { asm volatile("s_nop 1\n\tv_add_f32_dpp %0, %0, %0 row_mirror row_mask:0xf bank_mask:0xf bound_ctrl:1" : "+v"(x)); } }
#elif UBENCH == 7
            if (wave < 4) {
#pragma unroll
            for (int k = 0; k < 64; ++k) { asm volatile("v_fma_f32 %0, %0, %1, %0" : "+v"(x) : "v"(y)); } }
#elif UBENCH == 8
            { float y2 = x + 1.f, y3 = x + 2.f, y4 = x + 3.f;
#pragma unroll
            for (int k = 0; k < 64; ++k) { asm volatile("s_nop 1\n\tv_add_f32_dpp %0, %0, %0 row_mirror row_mask:0xf bank_mask:0xf bound_ctrl:1\n\tv_add_f32_dpp %1, %1, %1 row_mirror row_mask:0xf bank_mask:0xf bound_ctrl:1\n\tv_add_f32_dpp %2, %2, %2 row_mirror row_mask:0xf bank_mask:0xf bound_ctrl:1\n\tv_add_f32_dpp %3, %3, %3 row_mirror row_mask:0xf bank_mask:0xf bound_ctrl:1" : "+v"(x), "+v"(y2), "+v"(y3), "+v"(y4)); }
            x += y2 + y3 + y4; }
#elif UBENCH == 4
#pragma unroll
            for (int k = 0; k < 64; ++k) { asm volatile("s_nop 1\n\tv_add_f32_dpp %0, %0, %0 row_bcast:15 row_mask:0xa bank_mask:0xf" : "+v"(x)); }
#endif
        }
        acc += x;
        if (acc == 123.456f) ((float*)(ws + WS_CTL))[2000 + tid] = acc;
    }
#endif
#undef IN
#undef SEAM
}

#ifndef MK_ONE_LAUNCH
#define MK_ONE_LAUNCH 1
#endif
extern "C" void kernel_launch(void* const* d_in, const int* in_sizes, int n_in, void* d_out, int out_size, void* d_ws, size_t ws_size, hipStream_t stream) {
    static int grid = 0;
    if (grid == 0) {
        if (n_in != 32 || out_size != NREAL * DM || ws_size < WS_END) { fprintf(stderr, "kernel_launch: unexpected shapes (n_in %d out %d ws %zu need %zu); nothing launched\n", n_in, out_size, ws_size, (size_t)WS_END); grid = -1; return; }
        int dev = 0, cus = 0, per_cu = 0;
        if (hipGetDevice(&dev) != hipSuccess || hipDeviceGetAttribute(&cus, hipDeviceAttributeMultiprocessorCount, dev) != hipSuccess) { grid = -1; return; }
        if (hipFuncSetAttribute((const void*)hymba_fwd, hipFuncAttributeMaxDynamicSharedMemorySize, LDS_BYTES) != hipSuccess) { fprintf(stderr, "kernel_launch: hipFuncSetAttribute failed\n"); grid = -1; return; }
        if (hipOccupancyMaxActiveBlocksPerMultiprocessor(&per_cu, (const void*)hymba_fwd, NWAVES * 64, LDS_BYTES) != hipSuccess || per_cu < 1) fprintf(stderr, "kernel_launch: occupancy query says %d\n", per_cu);
        (void)hipGetLastError();
        grid = cus;
        if (grid != 256) { fprintf(stderr, "kernel_launch: built for 256 CUs, device has %d; nothing launched\n", cus); grid = -1; return; }
    }
    if (grid < 0) return;
    if (hipMemsetAsync((char*)d_ws + WS_CTL, 0, CTL_ZERO_BYTES, stream) != hipSuccess) return;
    Args a{};
    for (int i = 0; i < 32; ++i) a.in[i] = (const float*)d_in[i];
    a.out = (float*)d_out; a.ws = (unsigned char*)d_ws;
#if MK_ONE_LAUNCH
    a.ph_lo = 0; a.ph_hi = 48;
    hipLaunchKernelGGL(hymba_fwd, dim3(grid), dim3(NWAVES * 64), LDS_BYTES, stream, a);
#else
    for (int ph = 0; ph < 50; ++ph) {
        if (ph >= 1 && ph <= 48) { const int l = (ph - 1) / 12, k = (ph - 1) % 12; const bool moe = l & 1; if (k == 11 || (!moe && k >= 9)) continue; }
        a.ph_lo = ph; a.ph_hi = ph + 1;
        hipLaunchKernelGGL(hymba_fwd, dim3(grid), dim3(NWAVES * 64), LDS_BYTES, stream, a);
    }
#endif
}
```

```cpp
#include <hip/hip_runtime.h>
#include <hip/hip_bf16.h>
#include <cmath>
#include <cstdio>
#include <cstdint>
namespace pg8 {
#define PG8_LAS __attribute__((address_space(3)))
typedef unsigned short bf16_t;
typedef short bf16x8 __attribute__((ext_vector_type(8)));
typedef float f32x4 __attribute__((ext_vector_type(4)));
typedef float f32x2 __attribute__((ext_vector_type(2)));
typedef unsigned u32x4 __attribute__((ext_vector_type(4)));
constexpr int BM = 256, BK = 64, HALF = 128, HTB = HALF * BK * 2  , STAGE_BYTES = 8 * HTB, NXCD = 8, WGM = 8;

__host__ __device__ __forceinline__ int lds_byte(int r, int c) { const int st = (r >> 4) * 2 + (c >> 5), rr = r & 15, cc = c & 31, ob = rr * 64 + cc * 2; return st * 1024 + (ob ^ (((ob >> 9) & 1) << 5)); }
__host__ __device__ __forceinline__ void stage_rc(int b, int& R, int& C) { const int st = b / 1024, sb = b % 1024, swz = sb ^ (((sb >> 9) & 1) << 5); R = (st >> 1) * 16 + swz / 64; C = (st & 1) * 32 + (swz % 64) / 2; }
__host__ __device__ __forceinline__ int perm32(int rho) { const int n = rho >> 4, i = rho & 15; return 8 * (i >> 2) + 4 * n + (i & 3); }

struct Unit { int pm, pn, pc; };
struct Gemm { const bf16_t* A; const bf16_t* Bt; int M, N, K; };

struct StaticOrder {
    int nM, nN, nwg, G, c;
    __host__ __device__ void init(int M, int N, int G_, int c_) { nM = M / BM; nN = N / BM; nwg = nM * nN; G = G_; c = c_; }
    __host__ __device__ bool next(int i, Unit& u) const {
        const long L = (long)i * G + c; if (L >= nwg) return false;
        int wgid = (int)L; { const int q = nwg / NXCD, r = nwg % NXCD, xcd = wgid % NXCD, off = wgid / NXCD; wgid = (xcd < r ? xcd * (q + 1) : r * (q + 1) + (xcd - r) * q) + off; }
        const int nig = WGM * nN, gid = wgid / nig, fm = gid * WGM, gsz = (nM - fm) < WGM ? (nM - fm) : WGM;
        u.pm = fm + ((wgid % nig) % gsz); u.pn = (wgid % nig) / gsz; u.pc = u.pn; return true;
    }
    __device__ __forceinline__ void a_ready(const Unit&) const {}
    __device__ __forceinline__ void done(const Unit&) const {}
};
struct MoeOrder {
    int G, c, nN, total; int t1, t2, t3, t4, t5, t6, t7;
    __device__ __forceinline__ void init(const int* cnt, int nN_, int G_, int c_) {
        G = G_; c = c_; nN = nN_; int a = 0;
        a += (__builtin_amdgcn_readfirstlane(__hip_atomic_load(cnt + 0, __ATOMIC_RELAXED, __HIP_MEMORY_SCOPE_AGENT)) + 255) >> 8; t1 = a;
        a += (__builtin_amdgcn_readfirstlane(__hip_atomic_load(cnt + 1, __ATOMIC_RELAXED, __HIP_MEMORY_SCOPE_AGENT)) + 255) >> 8; t2 = a;
        a += (__builtin_amdgcn_readfirstlane(__hip_atomic_load(cnt + 2, __ATOMIC_RELAXED, __HIP_MEMORY_SCOPE_AGENT)) + 255) >> 8; t3 = a;
        a += (__builtin_amdgcn_readfirstlane(__hip_atomic_load(cnt + 3, __ATOMIC_RELAXED, __HIP_MEMORY_SCOPE_AGENT)) + 255) >> 8; t4 = a;
        a += (__builtin_amdgcn_readfirstlane(__hip_atomic_load(cnt + 4, __ATOMIC_RELAXED, __HIP_MEMORY_SCOPE_AGENT)) + 255) >> 8; t5 = a;
        a += (__builtin_amdgcn_readfirstlane(__hip_atomic_load(cnt + 5, __ATOMIC_RELAXED, __HIP_MEMORY_SCOPE_AGENT)) + 255) >> 8; t6 = a;
        a += (__builtin_amdgcn_readfirstlane(__hip_atomic_load(cnt + 6, __ATOMIC_RELAXED, __HIP_MEMORY_SCOPE_AGENT)) + 255) >> 8; t7 = a;
        a += (__builtin_amdgcn_readfirstlane(__hip_atomic_load(cnt + 7, __ATOMIC_RELAXED, __HIP_MEMORY_SCOPE_AGENT)) + 255) >> 8;
        total = a * nN;
    }
    __device__ __forceinline__ bool next(int i, Unit& u) const {
        const int x = c & 7, per = G >> 3; const int e_ = i * per + (c >> 3);
        const int ntile = total / nN; const int mine = (ntile - x + 7) >> 3;
        if (e_ >= mine * nN) return false;
        const int rt = x + 8 * (e_ / nN), j = e_ % nN;
        const int e = (rt >= t1) + (rt >= t2) + (rt >= t3) + (rt >= t4) + (rt >= t5) + (rt >= t6) + (rt >= t7);
        u.pm = rt; u.pn = e * nN + j; u.pc = j; return true;
    }
    __device__ __forceinline__ void a_ready(const Unit&) const {}
    __device__ __forceinline__ void done(const Unit&) const {}
};

__device__ __forceinline__ unsigned cvt_pk_bf16(float lo, float hi) { unsigned r; asm volatile("v_cvt_pk_bf16_f32 %0, %1, %2" : "=v"(r) : "v"(lo), "v"(hi)); return r; }

#define PG8_GAS __attribute__((address_space(1)))
struct EpiBf16Rs {
    static constexpr bool PERM = true, AFTER_DRAIN = false;
    bf16_t* O; int ldc; const float* rs; float sc;
    __device__ __forceinline__ void operator()(const f32x4 (&acc)[2][2][4][2], const Unit& u, int wr, int wc, int fr, int fq) const {
        const int row0 = u.pm * BM + wr * 64 + fr; const int col0 = u.pc * BM + wc * 32 + 8 * fq;
        float sv[2][4];
#pragma unroll
        for (int ai = 0; ai < 2; ++ai)
#pragma unroll
            for (int m = 0; m < 4; ++m) sv[ai][m] = rs ? ((const PG8_GAS float*)rs)[row0 + ai * HALF + m * 16] : sc;
#pragma unroll
        for (int ai = 0; ai < 2; ++ai)
#pragma unroll
            for (int m = 0; m < 4; ++m) { const int row = row0 + ai * HALF + m * 16; const float s = sv[ai][m]; PG8_GAS bf16_t* rowp = (PG8_GAS bf16_t*)O + (size_t)row * ldc + col0;
#pragma unroll
                for (int bj = 0; bj < 2; ++bj) { const f32x4 v0 = acc[ai][bj][m][0] * s, v1 = acc[ai][bj][m][1] * s;
                    u32x4 w; w.x = cvt_pk_bf16(v0[0], v0[1]); w.y = cvt_pk_bf16(v0[2], v0[3]); w.z = cvt_pk_bf16(v1[0], v1[1]); w.w = cvt_pk_bf16(v1[2], v1[3]);
                    *(PG8_GAS u32x4*)(rowp + bj * HALF) = w; } }
    }
};
struct EpiResAdd {
    static constexpr bool PERM = false, AFTER_DRAIN = false;
    float* H; int ldc; float sc;
    __device__ __forceinline__ void operator()(const f32x4 (&acc)[2][2][4][2], const Unit& u, int wr, int wc, int fr, int fq) const {
        const int row0 = u.pm * BM + wr * 64 + fr; const int col0 = u.pc * BM + wc * 32 + 4 * fq;
#pragma unroll
        for (int ai = 0; ai < 2; ++ai)
#pragma unroll
            for (int mp = 0; mp < 2; ++mp) {
                f32x4 res[2][2][2];
#pragma unroll
                for (int m2 = 0; m2 < 2; ++m2) { const PG8_GAS float* rowp = (const PG8_GAS float*)H + (size_t)(row0 + ai * HALF + (2 * mp + m2) * 16) * ldc + col0;
#pragma unroll
                    for (int bj = 0; bj < 2; ++bj)
#pragma unroll
                        for (int n = 0; n < 2; ++n) res[m2][bj][n] = *(const PG8_GAS f32x4*)(rowp + bj * HALF + n * 16); }
#pragma unroll
                for (int m2 = 0; m2 < 2; ++m2) { PG8_GAS float* rowp = (PG8_GAS float*)H + (size_t)(row0 + ai * HALF + (2 * mp + m2) * 16) * ldc + col0;
#pragma unroll
                    for (int bj = 0; bj < 2; ++bj)
#pragma unroll
                        for (int n = 0; n < 2; ++n) *(PG8_GAS f32x4*)(rowp + bj * HALF + n * 16) = res[m2][bj][n] + acc[ai][bj][2 * mp + m2][n] * sc; }
                asm volatile("" ::: "memory");
            }
    }
};
template <int MODE, long long HB_OFF, long long RSQ_OFF> struct EpiResAddHB {
    static constexpr bool PERM = true, AFTER_DRAIN = false; static constexpr float hs = 4.f;
    float* H; int ldc; float sc;
    __device__ __forceinline__ void operator()(const f32x4 (&acc)[2][2][4][2], const Unit& u, int wr, int wc, int fr, int fq) const {
        const int row0 = u.pm * BM + wr * 64 + fr; const int col0 = u.pc * BM + wc * 32 + 8 * fq;
        PG8_GAS unsigned char* const HBo = (PG8_GAS unsigned char*)H + HB_OFF; PG8_GAS unsigned long long* const rsq = (PG8_GAS unsigned long long*)((PG8_GAS unsigned char*)H + RSQ_OFF);
#pragma unroll
        for (int ai = 0; ai < 2; ++ai)
#pragma unroll
            for (int m = 0; m < 4; ++m) { const int row = row0 + ai * HALF + m * 16; PG8_GAS float* rowp = (PG8_GAS float*)H + (size_t)row * ldc + col0;
                f32x4 r_[2][2];
#pragma unroll
                for (int bj = 0; bj < 2; ++bj)
#pragma unroll
                    for (int n = 0; n < 2; ++n) r_[bj][n] = *(const PG8_GAS f32x4*)(rowp + bj * HALF + n * 4);
                float ss = 0.f;
#pragma unroll
                for (int bj = 0; bj < 2; ++bj) { const f32x4 v0 = r_[bj][0] + acc[ai][bj][m][0] * sc, v1 = r_[bj][1] + acc[ai][bj][m][1] * sc;
                    *(PG8_GAS f32x4*)(rowp + bj * HALF) = v0; *(PG8_GAS f32x4*)(rowp + bj * HALF + 4) = v1;
                    ss += ((v0[0] * v0[0] + v0[1] * v0[1]) + (v0[2] * v0[2] + v0[3] * v0[3])) + ((v1[0] * v1[0] + v1[1] * v1[1]) + (v1[2] * v1[2] + v1[3] * v1[3]));
                    if constexpr (MODE == 1) { u32x4 w; w.x = cvt_pk_bf16(v0[0], v0[1]); w.y = cvt_pk_bf16(v0[2], v0[3]); w.z = cvt_pk_bf16(v1[0], v1[1]); w.w = cvt_pk_bf16(v1[2], v1[3]);
                        *(PG8_GAS u32x4*)((PG8_GAS bf16_t*)HBo + (size_t)row * ldc + col0 + bj * HALF) = w; }
                    else {
#define PG8_C8(x) __builtin_amdgcn_fmed3f((x) * hs, -448.f, 448.f)
                        unsigned lo = (unsigned)__builtin_amdgcn_cvt_pk_fp8_f32(PG8_C8(v0[0]), PG8_C8(v0[1]), 0, false); lo = (unsigned)__builtin_amdgcn_cvt_pk_fp8_f32(PG8_C8(v0[2]), PG8_C8(v0[3]), (int)lo, true);
                        unsigned hi = (unsigned)__builtin_amdgcn_cvt_pk_fp8_f32(PG8_C8(v1[0]), PG8_C8(v1[1]), 0, false); hi = (unsigned)__builtin_amdgcn_cvt_pk_fp8_f32(PG8_C8(v1[2]), PG8_C8(v1[3]), (int)hi, true);
#undef PG8_C8
                        *(PG8_GAS unsigned long long*)(HBo + (size_t)row * ldc + col0 + bj * HALF) = (unsigned long long)lo | ((unsigned long long)hi << 32); } }
                { auto p_ = __builtin_amdgcn_permlane16_swap(__float_as_uint(ss), __float_as_uint(ss), false, false); ss = __uint_as_float(p_[0]) + __uint_as_float(p_[1]); }
                { auto p_ = __builtin_amdgcn_permlane32_swap(__float_as_uint(ss), __float_as_uint(ss), false, false); ss = __uint_as_float(p_[0]) + __uint_as_float(p_[1]); }
                if (fq == 0) __hip_atomic_fetch_add(rsq + row, (unsigned long long)(ss * 16777216.f), __ATOMIC_RELAXED, __HIP_MEMORY_SCOPE_AGENT);
                asm volatile("" ::: "memory"); }
    }
};
template <bool OUT8> struct EpiSwigluT {
    static constexpr bool PERM = true, AFTER_DRAIN = false;
    bf16_t* O; int ldc; const float* rs; float sc; float o8; const unsigned long long* rsq;
    __device__ __forceinline__ void operator()(const f32x4 (&acc)[2][2][4][2], const Unit& u, int wr, int wc, int fr, int fq) const {
        const int row0 = u.pm * BM + wr * 64 + fr; const int col0 = u.pc * HALF + wc * 32 + 8 * fq;
        float sv[2][4];
#pragma unroll
        for (int ai = 0; ai < 2; ++ai)
#pragma unroll
            for (int m = 0; m < 4; ++m) sv[ai][m] = rsq ? sc * __builtin_amdgcn_rsqf((float)((const PG8_GAS unsigned long long*)rsq)[row0 + ai * HALF + m * 16] * (1.f / (16777216.f * 1024.f)) + 1e-6f) : (rs ? ((const PG8_GAS float*)rs)[row0 + ai * HALF + m * 16] : sc);
#pragma unroll
        for (int ai = 0; ai < 2; ++ai)
#pragma unroll
            for (int m = 0; m < 4; ++m) { const int row = row0 + ai * HALF + m * 16; const float s = sv[ai][m]; PG8_GAS bf16_t* rowp = (PG8_GAS bf16_t*)O + (size_t)row * ldc + col0;
                const float c1 = -1.4426950408889634f * s, c2 = OUT8 ? s * s * o8 : s * s;
                f32x2 q[4];
#pragma unroll
                for (int n = 0; n < 2; ++n)
#pragma unroll
                    for (int h = 0; h < 2; ++h) { const f32x4 av = acc[ai][0][m][n], bv = acc[ai][1][m][n];
                        const f32x2 a = h ? (f32x2){av[2], av[3]} : (f32x2){av[0], av[1]}, b = h ? (f32x2){bv[2], bv[3]} : (f32x2){bv[0], bv[1]};
                        const f32x2 t = a * c1; f32x2 e; e.x = __builtin_amdgcn_exp2f(t.x); e.y = __builtin_amdgcn_exp2f(t.y);
                        const f32x2 d = e + 1.f; f32x2 r; r.x = __builtin_amdgcn_rcpf(d.x); r.y = __builtin_amdgcn_rcpf(d.y);
                        q[2 * n + h] = ((a * b) * r) * c2; }
                if constexpr (OUT8) { PG8_GAS unsigned char* rp8 = (PG8_GAS unsigned char*)O + (size_t)row * ldc + col0;
#define PG8_C8(x) __builtin_amdgcn_fmed3f((x), -448.f, 448.f)
                    unsigned lo = (unsigned)__builtin_amdgcn_cvt_pk_fp8_f32(PG8_C8(q[0].x), PG8_C8(q[0].y), 0, false); lo = (unsigned)__builtin_amdgcn_cvt_pk_fp8_f32(PG8_C8(q[1].x), PG8_C8(q[1].y), (int)lo, true);
                    unsigned hi = (unsigned)__builtin_amdgcn_cvt_pk_fp8_f32(PG8_C8(q[2].x), PG8_C8(q[2].y), 0, false); hi = (unsigned)__builtin_amdgcn_cvt_pk_fp8_f32(PG8_C8(q[3].x), PG8_C8(q[3].y), (int)hi, true);
#undef PG8_C8
                    *(PG8_GAS unsigned long long*)rp8 = (unsigned long long)lo | ((unsigned long long)hi << 32); }
                else { u32x4 w; w.x = cvt_pk_bf16(q[0].x, q[0].y); w.y = cvt_pk_bf16(q[1].x, q[1].y); w.z = cvt_pk_bf16(q[2].x, q[2].y); w.w = cvt_pk_bf16(q[3].x, q[3].y);
                    *(PG8_GAS u32x4*)rowp = w; } }
    }
};
typedef EpiSwigluT<false> EpiSwiglu; typedef EpiSwigluT<true> EpiSwiglu8;

template <class Epi, class Sched, bool ALIGN_EPI = false, bool SP2 = false, bool FP8 = false>
__device__ __forceinline__ void gemm_phase(PG8_LAS unsigned char* lds, const Gemm g, const Sched& S, const Epi& E, int tid_in) {
    int tid_ = tid_in; asm volatile("" : "+v"(tid_));
    const int tid = tid_, wid = __builtin_amdgcn_readfirstlane(tid >> 6), lane = tid & 63, wr = wid >> 2, wc = wid & 3, fr = lane & 15, fq = lane >> 4;
    const int K = g.K, nt = K / BK;
    unsigned voffA[2], voffB[2];
#pragma unroll
    for (int i = 0; i < 2; ++i) { int R, C; stage_rc(tid * 16 + i * 8192, R, C); const int Rb = Epi::PERM ? ((R & ~31) + perm32(R & 31)) : R;
        voffA[i] = (unsigned)(R * K + C) * 2u; voffB[i] = (unsigned)(Rb * K + C) * 2u; }
    const size_t kstep = (size_t)(BK * 2);
    const size_t hstep = (size_t)HALF * K * 2;
    const size_t tstep = 2 * hstep;
    const unsigned ldsw = (unsigned)wid * 1024u;
    const int aoff = lds_byte(wr * 64 + fr, fq * 8), boff = lds_byte(wc * 32 + fr, fq * 8);
#define PG8_SA(b, h) (((b) * 2 + (h)) * HTB)
#define PG8_SB(b, h) ((4 + (b) * 2 + (h)) * HTB)
#define PG8_STAGE(bufoff, gbase, voff) do { _Pragma("unroll") for (int _i = 0; _i < 2; ++_i) \
        __builtin_amdgcn_global_load_lds((const unsigned*)((const char*)(gbase) + (voff)[_i]), (PG8_LAS unsigned*)(lds + (bufoff) + ldsw + _i * 8192), 16, 0, 0); } while (0)
#define PG8_LDA(dst, b, h) do { _Pragma("unroll") for (int m = 0; m < 4; ++m) _Pragma("unroll") for (int k = 0; k < 2; ++k) dst[m][k] = *(const PG8_LAS bf16x8*)(lds + PG8_SA(b, h) + aoff + m * 2048 + k * 1024); } while (0)
#define PG8_LDB(dst, b, h) do { _Pragma("unroll") for (int n = 0; n < 2; ++n) _Pragma("unroll") for (int k = 0; k < 2; ++k) dst[n][k] = *(const PG8_LAS bf16x8*)(lds + PG8_SB(b, h) + boff + n * 2048 + k * 1024); } while (0)
#define PG8_MMA(ai, bj, At, Bt) do { __builtin_amdgcn_s_setprio(1); \
        if constexpr (FP8) { typedef int v8i_ __attribute__((ext_vector_type(8))); typedef int v4i_ __attribute__((ext_vector_type(4))); const int sc8_ = 0x7f7f7f7f;     \
            _Pragma("unroll") for (int m = 0; m < 4; ++m) _Pragma("unroll") for (int n = 0; n < 2; ++n) { \
                const v4i_ b0_ = __builtin_bit_cast(v4i_, Bt[n][0]), b1_ = __builtin_bit_cast(v4i_, Bt[n][1]), a0_ = __builtin_bit_cast(v4i_, At[m][0]), a1_ = __builtin_bit_cast(v4i_, At[m][1]); \
                const v8i_ bb_ = (v8i_){b0_.x, b0_.y, b0_.z, b0_.w, b1_.x, b1_.y, b1_.z, b1_.w}, aa_ = (v8i_){a0_.x, a0_.y, a0_.z, a0_.w, a1_.x, a1_.y, a1_.z, a1_.w}; \
                asm volatile("v_mfma_scale_f32_16x16x128_f8f6f4 %0, %1, %2, %0, %3, %3 op_sel_hi:[0,0,0]" : "+v"(acc[ai][bj][m][n]) : "v"(bb_), "v"(aa_), "v"(sc8_)); } \
        } else { _Pragma("unroll") for (int m = 0; m < 4; ++m) _Pragma("unroll") for (int n = 0; n < 2; ++n) _Pragma("unroll") for (int k = 0; k < 2; ++k) \
            acc[ai][bj][m][n] = __builtin_amdgcn_mfma_f32_16x16x32_bf16(Bt[n][k], At[m][k], acc[ai][bj][m][n], 0, 0, 0); } \
        __builtin_amdgcn_s_setprio(0); } while (0)
#define PG8_WAIT_V(n) asm volatile("s_waitcnt vmcnt(" #n ")" ::: "memory")
#define PG8_WAIT_L(n) asm volatile("s_waitcnt lgkmcnt(" #n ")" ::: "memory")
#define PG8_BAR __builtin_amdgcn_s_barrier()
#define PG8_SCHED __builtin_amdgcn_sched_barrier(0)
    Unit cur, nxt; int ui = 0;
    if (!S.next(0, cur)) return;
    f32x4 acc[2][2][4][2];
    { float zf; asm volatile("v_mov_b32 %0, 0" : "=v"(zf));
#pragma unroll
    for (int a = 0; a < 2; ++a)
#pragma unroll
        for (int b = 0; b < 2; ++b)
#pragma unroll
            for (int m = 0; m < 4; ++m)
#pragma unroll
                for (int n = 0; n < 2; ++n) acc[a][b][m][n] = (f32x4){zf, zf, zf, zf}; }
    bf16x8 At[4][2], B0[2][2], B1[2][2];
    const char* cA = (const char*)g.A + (size_t)cur.pm * tstep; const char* cB = (const char*)g.Bt + (size_t)cur.pn * tstep;
    S.a_ready(cur);
    if constexpr (SP2) {
        PG8_STAGE(PG8_SB(0, 0), cB, voffB); PG8_STAGE(PG8_SB(0, 1), cB + hstep, voffB); PG8_STAGE(PG8_SA(0, 0), cA, voffA); PG8_STAGE(PG8_SA(0, 1), cA + hstep, voffA);
        if (wr == 1) PG8_BAR;
        PG8_WAIT_V(2); PG8_BAR;
        PG8_STAGE(PG8_SB(1, 0), cB + kstep, voffB); PG8_STAGE(PG8_SA(1, 0), cA + kstep, voffA); PG8_STAGE(PG8_SB(1, 1), cB + hstep + kstep, voffB);
        PG8_WAIT_V(6); PG8_BAR;
    } else {
        PG8_STAGE(PG8_SB(0, 0), cB, voffB); PG8_STAGE(PG8_SA(0, 0), cA, voffA); PG8_STAGE(PG8_SB(0, 1), cB + hstep, voffB); PG8_STAGE(PG8_SA(0, 1), cA + hstep, voffA);
        if (wr == 1) PG8_BAR;
        PG8_WAIT_V(4); PG8_BAR;
        PG8_STAGE(PG8_SB(1, 0), cB + kstep, voffB); PG8_STAGE(PG8_SA(1, 0), cA + kstep, voffA); PG8_STAGE(PG8_SB(1, 1), cB + hstep + kstep, voffB);
        PG8_WAIT_V(6); PG8_BAR;
    }
    for (;;) {
        const bool has_next = S.next(ui + 1, nxt);
        const char* nA = has_next ? (const char*)g.A + (size_t)nxt.pm * tstep : cA; const char* nB = has_next ? (const char*)g.Bt + (size_t)nxt.pn * tstep : cB;
        for (int t = 0; t < nt; t += 2) {
            const bool last = (t == nt - 2);
            const char* a1 = cA + (size_t)(t + 1) * kstep;
            const char* a2 = last ? nA : cA + (size_t)(t + 2) * kstep; const char* b2 = last ? nB : cB + (size_t)(t + 2) * kstep;
            const char* a3 = a2 + kstep; const char* b3 = b2 + kstep;
            if (last && has_next) S.a_ready(nxt);
            if constexpr (SP2) {
            PG8_LDB(B0, 0, 0); PG8_LDB(B1, 0, 1); PG8_SCHED; PG8_LDA(At, 0, 0); PG8_STAGE(PG8_SA(1, 1), a1 + hstep, voffA);
            PG8_WAIT_V(8); PG8_WAIT_L(0); PG8_BAR; PG8_MMA(0, 0, At, B0); PG8_MMA(0, 1, At, B1); PG8_BAR; PG8_SCHED;
            PG8_LDA(At, 0, 1); PG8_STAGE(PG8_SB(0, 0), b2, voffB); PG8_STAGE(PG8_SB(0, 1), b2 + hstep, voffB); PG8_STAGE(PG8_SA(0, 0), a2, voffA);
            PG8_WAIT_V(8); PG8_WAIT_L(0); PG8_BAR; PG8_MMA(1, 0, At, B0); PG8_MMA(1, 1, At, B1); PG8_BAR; PG8_SCHED;
            PG8_LDB(B0, 1, 0); PG8_LDB(B1, 1, 1); PG8_SCHED; PG8_LDA(At, 1, 0); PG8_STAGE(PG8_SA(0, 1), a2 + hstep, voffA);
            PG8_WAIT_V(8); PG8_WAIT_L(0); PG8_BAR; PG8_MMA(0, 0, At, B0); PG8_MMA(0, 1, At, B1); PG8_BAR; PG8_SCHED;
            PG8_LDA(At, 1, 1); PG8_STAGE(PG8_SB(1, 0), b3, voffB); PG8_STAGE(PG8_SB(1, 1), b3 + hstep, voffB); PG8_STAGE(PG8_SA(1, 0), a3, voffA);
            PG8_WAIT_V(8); PG8_WAIT_L(0); PG8_BAR; PG8_MMA(1, 0, At, B0); PG8_MMA(1, 1, At, B1); PG8_BAR; PG8_SCHED;
            } else {
            PG8_LDB(B0, 0, 0); PG8_SCHED; PG8_LDA(At, 0, 0); PG8_STAGE(PG8_SA(1, 1), a1 + hstep, voffA);
            PG8_WAIT_L(8); PG8_BAR; PG8_WAIT_L(0); PG8_MMA(0, 0, At, B0); PG8_BAR; PG8_SCHED;
            PG8_LDB(B1, 0, 1); PG8_STAGE(PG8_SB(0, 0), b2, voffB);
            PG8_BAR; PG8_WAIT_L(0); PG8_MMA(0, 1, At, B1); PG8_BAR;
            PG8_LDA(At, 0, 1); PG8_STAGE(PG8_SA(0, 0), a2, voffA);
            PG8_BAR; PG8_WAIT_L(0); PG8_MMA(1, 0, At, B0); PG8_BAR; PG8_SCHED;
            PG8_STAGE(PG8_SB(0, 1), b2 + hstep, voffB);
            PG8_WAIT_V(6); PG8_BAR; PG8_MMA(1, 1, At, B1); PG8_BAR;
            PG8_LDB(B0, 1, 0); PG8_SCHED; PG8_LDA(At, 1, 0); PG8_STAGE(PG8_SA(0, 1), a2 + hstep, voffA);
            PG8_WAIT_L(8); PG8_BAR; PG8_WAIT_L(0); PG8_MMA(0, 0, At, B0); PG8_BAR; PG8_SCHED;
            PG8_LDB(B1, 1, 1); PG8_STAGE(PG8_SB(1, 0), b3, voffB);
            PG8_BAR; PG8_WAIT_L(0); PG8_MMA(0, 1, At, B1); PG8_BAR;
            PG8_LDA(At, 1, 1); PG8_STAGE(PG8_SA(1, 0), a3, voffA);
            PG8_BAR; PG8_WAIT_L(0); PG8_MMA(1, 0, At, B0); PG8_BAR; PG8_SCHED;
            PG8_STAGE(PG8_SB(1, 1), b3 + hstep, voffB);
            PG8_WAIT_V(6); PG8_BAR; PG8_MMA(1, 1, At, B1); PG8_BAR;
            }
        }
        if constexpr (FP8) asm volatile("s_nop 15\n\ts_nop 15\n\ts_nop 15" ::: "memory");
        if constexpr (ALIGN_EPI) { if (wr == 0) PG8_BAR; }
        if constexpr (!Epi::AFTER_DRAIN) { E(acc, cur, wr, wc, fr, fq); S.done(cur); }
        if (!has_next) break;
        { float zf; asm volatile("v_mov_b32 %0, 0" : "=v"(zf));
#pragma unroll
        for (int a = 0; a < 2; ++a)
#pragma unroll
            for (int b = 0; b < 2; ++b)
#pragma unroll
                for (int m = 0; m < 4; ++m)
#pragma unroll
                    for (int n = 0; n < 2; ++n) acc[a][b][m][n] = (f32x4){zf, zf, zf, zf}; }
        cur = nxt; cA = nA; cB = nB; ++ui;
        if constexpr (ALIGN_EPI) { if (wr == 1) PG8_BAR; }
    }
    PG8_WAIT_V(0);
    if constexpr (!ALIGN_EPI) { if (wr == 0) PG8_BAR; }
    PG8_BAR;
    if constexpr (Epi::AFTER_DRAIN) { E.fused(acc, cur, wr, wc, fr, fq, lds, wid, lane); S.done(cur); }
#undef PG8_SA
#undef PG8_SB
#undef PG8_STAGE
#undef PG8_LDA
#undef PG8_LDB
#undef PG8_MMA
#undef PG8_WAIT_V
#undef PG8_WAIT_L
#undef PG8_BAR
#undef PG8_SCHED
}
}
#include <hip/hip_bf16.h>
#include <cmath>
namespace attn_body {
using bf16=__hip_bfloat16;
using bf16x8=__attribute__((ext_vector_type(8)))short;
using s16x4=__attribute__((ext_vector_type(4)))short;
using f32x16=__attribute__((ext_vector_type(16)))float;
using u32x4=__attribute__((ext_vector_type(4)))unsigned;
constexpr int BATCH=4,NHEAD=8,SEQ=4096,D=64,DM=512,DMO=1024,KVSEQ=4224;
constexpr int NW=8,QBLK=32,QB=QBLK*NW,KVBLK=64,NQB=SEQ/QB;
constexpr int ATTN_UNIT_ROWS=QB;
__device__ __forceinline__ int crow(int r,int hi){return (r&3)+8*(r>>2)+4*hi;}
#define SBAR() __builtin_amdgcn_sched_barrier(0)
__device__ __forceinline__ void cmask(f32x16&p0,f32x16&p1,int jb,int qrel,int hi){
  const float NEG=-INFINITY; int kb=64*jb+4*hi;
  #pragma unroll
  for(int r=0;r<16;++r){int kv=kb+(r&3)+8*(r>>2); if(kv>qrel)p0[r]=NEG; if(kv+32>qrel)p1[r]=NEG;}
}

constexpr int NSLOT=3, SLOTB=8192;
constexpr int LDS_K=0, LDS_V=NSLOT*SLOTB, LDS_V2=2*NSLOT*SLOTB, LDS_WS=3*NSLOT*SLOTB, LDS_OST=LDS_WS+NW*64*4, LDS_BYTES=LDS_OST+NW*4096;
constexpr float C2=0.125f*1.4426950408889634f;
__device__ __forceinline__ void glds16(const void*gsrc,unsigned lds_dst){unsigned keep;
  asm volatile("s_mov_b32 %0, m0\n\ts_mov_b32 m0, %2\n\ts_nop 0\n\tglobal_load_lds_dwordx4 %1, off\n\ts_mov_b32 m0, %0":"=&s"(keep):"v"(gsrc),"s"(lds_dst):"memory");}
__device__ __forceinline__ void glds16s(const void*sbase,unsigned voff,unsigned lds_dst){unsigned keep;
  asm volatile("s_mov_b32 %0, m0\n\ts_mov_b32 m0, %3\n\ts_nop 0\n\tglobal_load_lds_dwordx4 %1, %2\n\ts_mov_b32 m0, %0":"=&s"(keep):"v"(voff),"s"(sbase),"s"(lds_dst):"memory");}
__device__ __forceinline__ float max3f(float a,float b,float c){float r;asm("v_max3_f32 %0, %1, %2, %3":"=v"(r):"v"(a),"v"(b),"v"(c));return r;}
__device__ __forceinline__ float max2f(float a,float b){float r;asm("v_max_f32_e32 %0, %1, %2":"=v"(r):"v"(a),"v"(b));return r;}
__device__ __forceinline__ float fadd_s(float a,float b){float r;asm("v_add_f32_e32 %0, %1, %2":"=v"(r):"v"(a),"v"(b));return r;}
__device__ __forceinline__ float fsub_s(float a,float b){float r;asm("v_sub_f32_e32 %0, %1, %2":"=v"(r):"v"(a),"v"(b));return r;}
typedef float f32x2_t __attribute__((ext_vector_type(2))); typedef __bf16 bf16x2_t __attribute__((ext_vector_type(2)));
__device__ __forceinline__ unsigned cvtpk_s(float lo,float hi){f32x2_t v={lo,hi};bf16x2_t b=__builtin_convertvector(v,bf16x2_t);return __builtin_bit_cast(unsigned,b);}
#define WAIT_BAR(N) asm volatile("s_waitcnt vmcnt(" #N ") lgkmcnt(0)\n\ts_barrier":::"memory")

typedef __attribute__((address_space(3))) const char* lds_cptr;
__device__ __forceinline__ void qkt(f32x16&p0,f32x16&p1,lds_cptr Kslot,const bf16x8*qr,const f32x16&negm0,const f32x16&negm1,int r32,int hi){
  const lds_cptr kb=Kslot+hi*1024+r32*16;
  #pragma unroll
  for(int d0=0;d0<4;++d0){
    const bf16x8 b0=*(const __attribute__((address_space(3))) bf16x8*)(kb+d0*2048);
    const bf16x8 b1=*(const __attribute__((address_space(3))) bf16x8*)(kb+d0*2048+512);
    if(d0==0){p0=__builtin_amdgcn_mfma_f32_32x32x16_bf16(b0,qr[0],negm0,0,0,0);p1=__builtin_amdgcn_mfma_f32_32x32x16_bf16(b1,qr[0],negm1,0,0,0);}
    else{p0=__builtin_amdgcn_mfma_f32_32x32x16_bf16(b0,qr[d0],p0,0,0,0);p1=__builtin_amdgcn_mfma_f32_32x32x16_bf16(b1,qr[d0],p1,0,0,0);}}
}
typedef short v4i16_t __attribute__((ext_vector_type(4)));
__device__ __forceinline__ void kload8(bf16x8*kf,lds_cptr kp){
  kf[0]=*(const __attribute__((address_space(3))) bf16x8*)(kp);      kf[1]=*(const __attribute__((address_space(3))) bf16x8*)(kp+512);
  kf[2]=*(const __attribute__((address_space(3))) bf16x8*)(kp+2048); kf[3]=*(const __attribute__((address_space(3))) bf16x8*)(kp+2560);
  kf[4]=*(const __attribute__((address_space(3))) bf16x8*)(kp+4096); kf[5]=*(const __attribute__((address_space(3))) bf16x8*)(kp+4608);
  kf[6]=*(const __attribute__((address_space(3))) bf16x8*)(kp+6144); kf[7]=*(const __attribute__((address_space(3))) bf16x8*)(kp+6656);
}
__device__ __forceinline__ void kload2(bf16x8*kf,lds_cptr kp,int j){ kf[2*j]=*(const __attribute__((address_space(3))) bf16x8*)(kp+j*2048); kf[2*j+1]=*(const __attribute__((address_space(3))) bf16x8*)(kp+j*2048+512); }
__device__ __forceinline__ s16x4 vtr(lds_cptr p){ return __builtin_bit_cast(s16x4,__builtin_amdgcn_ds_read_tr16_b64_v4i16((__attribute__((address_space(3))) v4i16_t*)p)); }
__device__ __forceinline__ float rowmax(const f32x16&p0,const f32x16&p1){
  float a=max3f(p0[0],p0[1],p1[0]),b=max3f(p0[2],p0[3],p1[1]);a=max3f(a,p1[2],p1[3]);
  #pragma unroll
  for(int r=4;r<16;r+=4){a=max3f(a,p0[r],p0[r+1]);b=max3f(b,p0[r+2],p0[r+3]);a=max3f(a,p1[r],p1[r+1]);b=max3f(b,p1[r+2],p1[r+3]);}
  const float m=max2f(a,b);
  auto rr=__builtin_amdgcn_permlane32_swap(__float_as_uint(m),__float_as_uint(m),false,false);
  return max2f(__uint_as_float(rr[0]),__uint_as_float(rr[1]));
}
__device__ __forceinline__ void pv(f32x16*o,int vb,bf16x8 pa0,bf16x8 pa1,bf16x8 pa2,bf16x8 pa3){
  #pragma unroll
  for(int d0=0;d0<2;++d0){s16x4 lo[4],hi[4];
    #pragma unroll
    for(int ks=0;ks<4;++ks){
      asm volatile("ds_read_b64_tr_b16 %0,%1 offset:%c2":"=&v"(lo[ks]):"v"(vb),"i"(d0*4096+ks*1024):"memory");
      asm volatile("ds_read_b64_tr_b16 %0,%1 offset:%c2":"=&v"(hi[ks]):"v"(vb),"i"(d0*4096+ks*1024+512):"memory");}
    asm volatile("s_waitcnt lgkmcnt(0)":::"memory");SBAR();
    #define PK(k) (bf16x8){lo[k][0],lo[k][1],lo[k][2],lo[k][3],hi[k][0],hi[k][1],hi[k][2],hi[k][3]}
    o[d0]=__builtin_amdgcn_mfma_f32_32x32x16_bf16(pa0,PK(0),o[d0],0,0,0);
    o[d0]=__builtin_amdgcn_mfma_f32_32x32x16_bf16(pa1,PK(1),o[d0],0,0,0);
    o[d0]=__builtin_amdgcn_mfma_f32_32x32x16_bf16(pa2,PK(2),o[d0],0,0,0);
    o[d0]=__builtin_amdgcn_mfma_f32_32x32x16_bf16(pa3,PK(3),o[d0],0,0,0);
    #undef PK
  }
}

#ifndef ATTN_STORE16
#define ATTN_STORE16(p,v) (*(u32x4*)(p)=(v))
#endif
template<int THRL> __device__ __forceinline__ void attn_unit(int b,int hc,int qb,const bf16*Q,const bf16*__restrict__ K,const bf16*__restrict__ V,bf16*O,char*shm,int tid_in){
  int tid_=tid_in; asm volatile("":"+v"(tid_)); const int tid=tid_,lane=tid&63,r32=lane&31,hi=lane>>5; const int wid=__builtin_amdgcn_readfirstlane(tid>>6);
  const long rowbase=(long)b*SEQ, kvbase=(long)b*KVSEQ; const int q0=qb*QB;
  const bf16*Qw=Q+(rowbase+q0+wid*QBLK)*DM+hc*D;
  const bf16*Kh=K+kvbase*DM+hc*D,*Vh=V+kvbase*DM+(hc>>1)*128;
  const unsigned lds0=(unsigned)(uintptr_t)shm;
  typedef __attribute__((address_space(3))) float lds_f32; typedef __attribute__((address_space(3))) unsigned short lds_u16; typedef __attribute__((address_space(3))) char lds_char;
  lds_f32*wsf=(lds_f32*)((lds_char*)shm+LDS_WS)+wid*64;
  const bf16*ksb=Kh+wid*8; const unsigned kvo=(unsigned)lane*(DM*2);
  const bf16*vsb=Vh+(long)(16*(wid&3))*DM+(wid>>2)*32; const unsigned vvo=(unsigned)((lane>>2)*DM+(lane&3)*8)*2u;
  const unsigned kdst=lds0+LDS_K+wid*1024, vdst=lds0+LDS_V+wid*1024, vdst2=lds0+LDS_V2+wid*1024;
  #define DMA_K(t,slot) glds16s(ksb+(long)(t)*KVBLK*DM,kvo,(unsigned)__builtin_amdgcn_readfirstlane(kdst+(slot)))
  #define DMA_V(t,slot) do{ glds16s(vsb+(long)(t)*KVBLK*DM,vvo,(unsigned)__builtin_amdgcn_readfirstlane(vdst+(slot))); glds16s(vsb+(long)(t)*KVBLK*DM+64,vvo,(unsigned)__builtin_amdgcn_readfirstlane(vdst2+(slot))); }while(0)
  const int vb0=(int)(lds0+LDS_V)+((lane>>4)&1)*32+(lane&3)*8+(4*hi+((lane&15)>>2))*64;
  bf16x8 kf[8];
  const lds_cptr shm3=(lds_cptr)shm; const lds_cptr kp0=shm3+LDS_K+hi*1024+r32*16; const lds_cptr vp0=shm3+LDS_V+((lane>>4)&1)*32+(lane&3)*8+(4*hi+((lane&15)>>2))*64;
  const int NT=(q0+QB)/KVBLK+2;
  DMA_K(0,0);DMA_V(0,0);DMA_K(1,SLOTB);
  bf16x8 qr[4];
  #pragma unroll
  for(int d0=0;d0<4;++d0)qr[d0]=*reinterpret_cast<const bf16x8*>(&Qw[(long)r32*DM+d0*16+hi*8]);
  float mhat=0.f,l_reg=0.f;f32x16 o[4];o[0]=f32x16{};o[1]=f32x16{};o[2]=f32x16{};o[3]=f32x16{};f32x16 negm=f32x16{};asm volatile("":"+v"(negm));
  const int qrel=wid*QBLK+r32;
  #define CMASK(P0,P1,t) do{int jb_=(t)-(NT-4); if(jb_>=0)cmask(P0,P1,jb_,qrel,hi);}while(0)
  bool resc=false;
  #define START(P0,P1) do{ const float rm=rowmax(P0,P1); resc=false; \
    { const float dl=rm; mhat=fadd_s(mhat,dl); \
      _Pragma("unroll") for(int r=0;r<16;++r){P0[r]=fsub_s(P0[r],dl);P1[r]=fsub_s(P1[r],dl);} \
      _Pragma("unroll") for(int r=0;r<16;++r)negm[r]=-mhat; asm volatile("":"+v"(negm)); } \
    _Pragma("unroll") for(int r=0;r<16;++r)P0[r]=__builtin_amdgcn_exp2f(P0[r]); }while(0)
  #define RESC() do{ if(resc){ asm volatile("s_waitcnt lgkmcnt(0)":::"memory"); \
      _Pragma("unroll") for(int d_=0;d_<4;++d_) _Pragma("unroll") for(int r=0;r<16;++r)o[d_][r]*=wsf[crow(r,hi)]; } }while(0)
  f32x16 pA0,pA1,pB0,pB1;
  int sl_prev=0,sl_cur=0,sl_next=SLOTB;
  #define ROT() do{sl_prev=sl_cur;sl_cur=sl_next;sl_next=(sl_next==(NSLOT-1)*SLOTB)?0:sl_next+SLOTB;}while(0)
  DMA_K(2,2*SLOTB);
  WAIT_BAR(4);
  { f32x16 cm0,cm1; _Pragma("unroll") for(int r=0;r<16;++r){cm0[r]=-INFINITY;cm1[r]=(r<8)?-INFINITY:0.f;} asm volatile("":"+v"(cm0),"+v"(cm1));
    qkt(pA0,pA1,shm3+LDS_K,qr,cm0,cm1,r32,hi); }
  asm volatile("s_nop 15\n\ts_nop 7":"+v"(pA0),"+v"(pA1));CMASK(pA0,pA1,0);
  START(pA0,pA1);
  _Pragma("unroll") for(int r=0;r<16;++r)pA1[r]=__builtin_amdgcn_exp2f(pA1[r]);
  _Pragma("unroll") for(int r=0;r<16;++r)negm[r]=-INFINITY; asm volatile("":"+v"(negm));
  WAIT_BAR(0);
  DMA_K(3,0);DMA_V(1,SLOTB);
  ROT();
  kload8(kf,kp0+sl_cur);
  WAIT_BAR(3);
  s16x4 vlo[8],vhi[8],wlo[8],whi[8]; u32x4 pw0,pw1,pw2,pw3;
  #define PKW(P,B) cvtpk_s(P[B],P[B+1])
  #define PAF(k) __builtin_bit_cast(bf16x8,pw##k)
  #define VFR(i) (bf16x8){vlo[i][0],vlo[i][1],vlo[i][2],vlo[i][3],vhi[i][0],vhi[i][1],vhi[i][2],vhi[i][3]}
  #define WFR(i) (bf16x8){wlo[i][0],wlo[i][1],wlo[i][2],wlo[i][3],whi[i][0],whi[i][1],whi[i][2],whi[i][3]}
  #define PIN(x) asm volatile("":"+v"(x))
  #define MX3(a,b,c) __builtin_fmaxf(__builtin_fmaxf((a),(b)),(c))
  #define GAPA(MF,A0,A1,A2,A3,W0,W1,PW) do{ MF; sacc+=A0; sacc+=A1; sacc+=A2; sacc+=A3; PIN(sacc); W0; W1; PIN(PW); SBAR(); }while(0)
  #define EX(v) __builtin_amdgcn_exp2f(v)
  #define GAPB(MF,X,B) do{ MF; X[B]=EX(X[B]); X[B+1]=EX(X[B+1]); PIN(X); SBAR(); }while(0)
  #define VRD(i) do{ vlo[i]=vtr(vp_+(((i)>>2)*4096+((i)&3)*1024)); vhi[i]=vtr(vp_+(((i)>>2)*4096+((i)&3)*1024+512)); }while(0)
  #define WRD(i) do{ wlo[i]=vtr(vp_+((LDS_V2-LDS_V)+((i)>>2)*4096+((i)&3)*1024)); whi[i]=vtr(vp_+((LDS_V2-LDS_V)+((i)>>2)*4096+((i)&3)*1024+512)); SBAR(); }while(0)
  #define KRD(G,j) do{ if(G){ kload2(kf,kp0+sl_next,j); SBAR(); } }while(0)
  #define STEP(C0,C1,P0,P1,t,GK,GV,GL) do{ SBAR(); \
    const lds_cptr vp_=vp0+sl_prev; \
    float sacc=(P0[0]+P0[1]); \
    GAPA(C0=__builtin_amdgcn_mfma_f32_32x32x16_bf16(kf[0],qr[0],negm,0,0,0), P0[2],P0[3],P0[4],P0[5],     pw0[0]=PKW(P0,0), pw0[1]=PKW(P0,2), pw0); \
    GAPA(C1=__builtin_amdgcn_mfma_f32_32x32x16_bf16(kf[1],qr[0],negm,0,0,0), P0[6],P0[7],P0[8],P0[9],     pw0[2]=PKW(P0,4), pw0[3]=PKW(P0,6), pw0); \
    GAPA(C0=__builtin_amdgcn_mfma_f32_32x32x16_bf16(kf[2],qr[1],C0,0,0,0),   P0[10],P0[11],P0[12],P0[13], pw1[0]=PKW(P0,8), pw1[1]=PKW(P0,10), pw1); \
    GAPA(C1=__builtin_amdgcn_mfma_f32_32x32x16_bf16(kf[3],qr[1],C1,0,0,0),   P0[14],P0[15],P1[0],P1[1],   pw1[2]=PKW(P0,12),pw1[3]=PKW(P0,14), pw1); \
    GAPA(C0=__builtin_amdgcn_mfma_f32_32x32x16_bf16(kf[4],qr[2],C0,0,0,0),   P1[2],P1[3],P1[4],P1[5],     pw2[0]=PKW(P1,0), pw2[1]=PKW(P1,2), pw2); \
    GAPA(C1=__builtin_amdgcn_mfma_f32_32x32x16_bf16(kf[5],qr[2],C1,0,0,0),   P1[6],P1[7],P1[8],P1[9],     pw2[2]=PKW(P1,4), pw2[3]=PKW(P1,6), pw2); \
    GAPA(C0=__builtin_amdgcn_mfma_f32_32x32x16_bf16(kf[6],qr[3],C0,0,0,0),   P1[10],P1[11],P1[12],P1[13], pw3[0]=PKW(P1,8), pw3[1]=PKW(P1,10), pw3); \
    GAPA(C1=__builtin_amdgcn_mfma_f32_32x32x16_bf16(kf[7],qr[3],C1,0,0,0),   P1[14],P1[15],0.f,0.f,       pw3[2]=PKW(P1,12),pw3[3]=PKW(P1,14), pw3); \
    l_reg+=sacc; \
    VRD(0);VRD(4);VRD(1);VRD(5);VRD(2);VRD(6);VRD(3);VRD(7); SBAR();     \
    if(GK){DMA_K((t)+3,sl_cur);} if(GV){DMA_V((t)+1,sl_next);} \
    CMASK(C0,C1,t); \
    { float a=MX3(C0[0],C0[1],C1[0]),b=MX3(C0[2],C0[3],C1[1]); a=MX3(a,C1[2],C1[3]); \
      _Pragma("unroll") for(int r=4;r<16;r+=4){a=MX3(a,C0[r],C0[r+1]);b=MX3(b,C0[r+2],C0[r+3]);a=MX3(a,C1[r],C1[r+1]);b=MX3(b,C1[r+2],C1[r+3]);} \
      float rm=__builtin_fmaxf(a,b); { auto rr=__builtin_amdgcn_permlane32_swap(__float_as_uint(rm),__float_as_uint(rm),false,false); rm=__builtin_fmaxf(__uint_as_float(rr[0]),__uint_as_float(rr[1])); } \
      resc=false; \
      if(__builtin_expect(__any(rm>(float)THRL),0)){ const float dl=__builtin_fmaxf(rm,0.f); mhat+=dl; \
        _Pragma("unroll") for(int r=0;r<16;++r){C0[r]-=dl;C1[r]-=dl;} \
        _Pragma("unroll") for(int r=0;r<16;++r)negm[r]=-mhat; asm volatile("":"+v"(negm)); \
        const float f=__builtin_amdgcn_exp2f(-dl); l_reg*=f; if(hi==0)wsf[r32]=f; resc=true; } } \
    SBAR(); \
    GAPB(o[0]=__builtin_amdgcn_mfma_f32_32x32x16_bf16(PAF(0),VFR(0),o[0],0,0,0), C0,0);  WRD(0); \
    GAPB(o[1]=__builtin_amdgcn_mfma_f32_32x32x16_bf16(PAF(0),VFR(4),o[1],0,0,0), C0,2);  WRD(4); \
    KRD(GL,0); GAPB(o[0]=__builtin_amdgcn_mfma_f32_32x32x16_bf16(PAF(1),VFR(1),o[0],0,0,0), C0,4);  WRD(1); \
    KRD(GL,1); GAPB(o[1]=__builtin_amdgcn_mfma_f32_32x32x16_bf16(PAF(1),VFR(5),o[1],0,0,0), C0,6);  WRD(5); \
    KRD(GL,2); GAPB(o[0]=__builtin_amdgcn_mfma_f32_32x32x16_bf16(PAF(2),VFR(2),o[0],0,0,0), C0,8);  WRD(2); \
    KRD(GL,3); GAPB(o[1]=__builtin_amdgcn_mfma_f32_32x32x16_bf16(PAF(2),VFR(6),o[1],0,0,0), C0,10); WRD(6); \
    GAPB(o[0]=__builtin_amdgcn_mfma_f32_32x32x16_bf16(PAF(3),VFR(3),o[0],0,0,0), C0,12); WRD(3); \
    GAPB(o[1]=__builtin_amdgcn_mfma_f32_32x32x16_bf16(PAF(3),VFR(7),o[1],0,0,0), C0,14); WRD(7); \
    GAPB(o[2]=__builtin_amdgcn_mfma_f32_32x32x16_bf16(PAF(0),WFR(0),o[2],0,0,0), C1,0); \
    GAPB(o[3]=__builtin_amdgcn_mfma_f32_32x32x16_bf16(PAF(0),WFR(4),o[3],0,0,0), C1,2); \
    GAPB(o[2]=__builtin_amdgcn_mfma_f32_32x32x16_bf16(PAF(1),WFR(1),o[2],0,0,0), C1,4); \
    GAPB(o[3]=__builtin_amdgcn_mfma_f32_32x32x16_bf16(PAF(1),WFR(5),o[3],0,0,0), C1,6); \
    GAPB(o[2]=__builtin_amdgcn_mfma_f32_32x32x16_bf16(PAF(2),WFR(2),o[2],0,0,0), C1,8); \
    GAPB(o[3]=__builtin_amdgcn_mfma_f32_32x32x16_bf16(PAF(2),WFR(6),o[3],0,0,0), C1,10); \
    GAPB(o[2]=__builtin_amdgcn_mfma_f32_32x32x16_bf16(PAF(3),WFR(3),o[2],0,0,0), C1,12); \
    GAPB(o[3]=__builtin_amdgcn_mfma_f32_32x32x16_bf16(PAF(3),WFR(7),o[3],0,0,0), C1,14); \
    }while(0)
  int t=1;
  #define FIX1(tt) do{ if((tt)==1){ _Pragma("unroll") for(int r=0;r<16;++r)negm[r]=-mhat; asm volatile("":"+v"(negm)); } }while(0)
  #undef CMASK
  #define CMASK(P0,P1,t) do{}while(0)
  for(;t+5<NT;t+=2){
    STEP(pB0,pB1,pA0,pA1,t,true,true,true);     WAIT_BAR(3); RESC(); ROT(); FIX1(t);
    STEP(pA0,pA1,pB0,pB1,t+1,true,true,true);   WAIT_BAR(3); RESC(); ROT();
  }
  #undef CMASK
  #define CMASK(P0,P1,t) do{int jb_=(t)-(NT-4); if(jb_>=0)cmask(P0,P1,jb_,qrel,hi);}while(0)
  #define ENDW(tt) do{ if((tt)+3<NT){WAIT_BAR(3);} else if((tt)+2<NT){WAIT_BAR(2);} else {WAIT_BAR(0);} }while(0)
  for(;t+1<NT;t+=2){
    STEP(pB0,pB1,pA0,pA1,t,(t+3<NT),(t+1<NT),(t+1<NT));       ENDW(t);   RESC(); ROT(); FIX1(t);
    STEP(pA0,pA1,pB0,pB1,t+1,(t+4<NT),(t+2<NT),(t+2<NT));     ENDW(t+1); RESC(); ROT();
  }
  STEP(pB0,pB1,pA0,pA1,NT-1,false,false,false); RESC();
  { float sacc=pB0[0]+pB0[1]; _Pragma("unroll") for(int r=2;r<16;++r)sacc+=pB0[r]; _Pragma("unroll") for(int r=0;r<16;++r)sacc+=pB1[r]; l_reg+=sacc;
    pw0=(u32x4){PKW(pB0,0),PKW(pB0,2),PKW(pB0,4),PKW(pB0,6)};pw1=(u32x4){PKW(pB0,8),PKW(pB0,10),PKW(pB0,12),PKW(pB0,14)};pw2=(u32x4){PKW(pB1,0),PKW(pB1,2),PKW(pB1,4),PKW(pB1,6)};pw3=(u32x4){PKW(pB1,8),PKW(pB1,10),PKW(pB1,12),PKW(pB1,14)};
    SBAR(); pv(o,vb0+sl_cur,PAF(0),PAF(1),PAF(2),PAF(3)); pv(o+2,vb0+(LDS_V2-LDS_V)+sl_cur,PAF(0),PAF(1),PAF(2),PAF(3)); }
  #undef PKW
  #undef PAF
  #undef VFR
  #undef WFR
  #undef WRD
  #undef PIN
  #undef MX3
  #undef GAPA
  #undef GAPB
  #undef EX
  #undef VRD
  #undef KRD
  #undef STEP
  #undef ENDW
  {auto rr=__builtin_amdgcn_permlane32_swap(__float_as_uint(l_reg),__float_as_uint(l_reg),false,false);l_reg=__uint_as_float(rr[0])+__uint_as_float(rr[1]);}
  if(hi==0)wsf[32+r32]=l_reg;asm volatile("s_waitcnt lgkmcnt(0)":::"memory");
  float rli[16];
  #pragma unroll
  for(int r=0;r<16;++r)rli[r]=__builtin_amdgcn_rcpf(wsf[32+crow(r,hi)]);
  bf16*Ow=O+(rowbase+q0+wid*QBLK)*DMO+hc*128;
  { lds_u16*stg=(lds_u16*)((lds_char*)shm+LDS_OST)+wid*2048;
    #pragma unroll
    for(int half=0;half<2;++half){
      #pragma unroll
      for(int r=0;r<16;++r){const int orow=crow(r,hi);
        #pragma unroll
        for(int d0=0;d0<2;++d0)stg[orow*64+d0*32+r32]=(unsigned short)(cvtpk_s(o[2*half+d0][r]*rli[r],0.f)&0xffffu);}
      asm volatile("s_waitcnt lgkmcnt(0)":::"memory");
      #pragma unroll
      for(int i=0;i<4;++i){const int row=i*8+(lane>>3),ch=lane&7; const u32x4 v=*(const __attribute__((address_space(3))) u32x4*)(stg+row*64+ch*8); ATTN_STORE16(Ow+(long)row*DMO+half*64+ch*8,v);}
      asm volatile("s_waitcnt lgkmcnt(0)":::"memory"); } }
  asm volatile("s_waitcnt lgkmcnt(0)\n\ts_barrier":::"memory");
  #undef DMA_K
  #undef DMA_V
  #undef CMASK
  #undef START
  #undef RESC
  #undef ROT
}
constexpr int ATTN_LDS_BYTES=LDS_BYTES;
struct AttnTensors { const bf16* Q; const bf16* K; const bf16* V; bf16* O; };
struct AttnUnit { int bh; int qb; };
struct StaticOrder {
  int vcu;
  __device__ __forceinline__ explicit StaticOrder(int grid,int block):vcu((block%8)*(grid/8)+block/8){}
  __device__ __forceinline__ bool next(int i,AttnUnit&u)const{ if(i>=4||vcu>=256)return false; const int s=vcu&3; u.bh=vcu>>2; u.qb=(i==0)?s:(i==1)?7-s:(i==2)?8+s:15-s; return true; }
  __device__ __forceinline__ void a_ready(const AttnUnit&)const{}
  __device__ __forceinline__ void done(const AttnUnit&)const{}
};
struct QueueOrder {
  unsigned* ctr; __attribute__((address_space(3))) unsigned* slot; int x; int tid0;
  __device__ __forceinline__ bool next(int,AttnUnit&u)const{
    if(tid0==0){ const unsigned e=__hip_atomic_fetch_add(ctr,1u,__ATOMIC_RELAXED,__HIP_MEMORY_SCOPE_AGENT); *slot=e; }
    asm volatile("s_waitcnt vmcnt(0) lgkmcnt(0)\n\ts_barrier":::"memory");
    const unsigned e=*slot;
    asm volatile("s_waitcnt lgkmcnt(0)\n\ts_barrier":::"memory");
    if(e>=64u)return false; u.bh=(int)(e&3u)*8+x; u.qb=15-(int)(e>>2); return true; }
  __device__ __forceinline__ void a_ready(const AttnUnit&)const{}
  __device__ __forceinline__ void done(const AttnUnit&)const{}
};
template<class Sched,int THRL=8> __device__ __forceinline__ void attn_phase(char*lds,const AttnTensors&T,const Sched&S,int tid_in){
  AttnUnit u;
  for(int i=0;S.next(i,u);++i){ S.a_ready(u); attn_unit<THRL>(u.bh/NHEAD,u.bh%NHEAD,u.qb,T.Q,T.K,T.V,T.O,lds,tid_in); S.done(u); }
}
#undef SBAR
#undef WAIT_BAR
}
#define GAS __attribute__((address_space(1)))
#define LAS __attribute__((address_space(3)))
typedef unsigned short bf16;
typedef unsigned v4u __attribute__((ext_vector_type(4)));
typedef float f32x4 __attribute__((ext_vector_type(4)));
typedef short bf16x8 __attribute__((ext_vector_type(8)));
typedef GAS unsigned gu32;
typedef GAS unsigned long long gu64;
#define RLX_AGENT __ATOMIC_RELAXED, __HIP_MEMORY_SCOPE_AGENT
#define LDS_WAIT() asm volatile("s_waitcnt lgkmcnt(0)" ::: "memory")
#define VM_WAIT() asm volatile("s_waitcnt vmcnt(0)" ::: "memory")
__device__ __forceinline__ unsigned long long rt() { return __builtin_amdgcn_s_memrealtime(); }
__device__ __forceinline__ unsigned f2bf(float f) { unsigned u = __builtin_bit_cast(unsigned, f); return (u + 0x7fffu + ((u >> 16) & 1u)) >> 16; }
__device__ __forceinline__ unsigned pk2(float lo, float hi) { return f2bf(lo) | (f2bf(hi) << 16); }

#define XB_TMO      128
#define XB_XCNT(j)  (256  + 64 * (j))
#define XB_XSUB(j)  (1280 + 64 * (j))
#define XB_XGEN(j)  (2304 + 64 * (j))
#define XB_TOP      3328
#define XB_TOPGEN   3392
#define XCD_BAR_WORDS 3456
#define XB_SPIN_CAP (1u << 18)

__device__ __forceinline__ unsigned xb_ld(unsigned* p)              { return __hip_atomic_load(p, __ATOMIC_RELAXED, __HIP_MEMORY_SCOPE_AGENT); }
__device__ __forceinline__ unsigned xb_add(unsigned* p, unsigned v) { return __hip_atomic_fetch_add(p, v, __ATOMIC_RELAXED, __HIP_MEMORY_SCOPE_AGENT); }
__device__ __forceinline__ unsigned xb_xcc_id() { return (unsigned)__builtin_amdgcn_s_getreg((3 << 11) | 20) & 0xFu; }
#define XB_SPIN(cond, bar) do { unsigned _sp = 0; while (cond) { __builtin_amdgcn_s_sleep(1); \
    if ((++_sp & 255u) == 0u) { if (xb_ld(&(bar)[XB_TMO])) break; if (_sp > XB_SPIN_CAP) { atomicAdd(&(bar)[XB_TMO], 1u); break; } } } } while (0)

struct XcdBarrier {
    unsigned* bar; unsigned x; int wv;
    volatile LAS unsigned* st;
};

__device__ __forceinline__ XcdBarrier xcd_barrier_post(unsigned* bar, volatile LAS unsigned* st) {
    XcdBarrier b; b.bar = bar; b.x = xb_xcc_id(); b.st = st;
    if (threadIdx.x == 0) (void)xb_add(&bar[XB_XCNT(b.x)], 1u);
    return b;
}
__device__ __forceinline__ void xcd_barrier_complete(unsigned* bar, unsigned x, unsigned& nloc, unsigned& nx) {
    const unsigned G = gridDim.x * gridDim.y * gridDim.z;
    unsigned sum, cnt, mine, sp = 0u;
    for (;;) {
        sum = 0u; cnt = 0u; mine = 0u;
#pragma unroll
        for (unsigned j = 0; j < 16; ++j) { const unsigned c = xb_ld(&bar[XB_XCNT(j)]); sum += c; cnt += (c > 0u) ? 1u : 0u; mine = (j == x) ? c : mine; }
        if (sum == G) break;
        __builtin_amdgcn_s_sleep(1);
        if ((++sp & 255u) == 0u) { if (xb_ld(&bar[XB_TMO])) break; if (sp > XB_SPIN_CAP) { atomicAdd(&bar[XB_TMO], 1u); break; } }
    }
    nloc = mine > 0u ? mine : 1u; nx = cnt > 0u ? cnt : 1u;
}

__device__ __forceinline__ void xcd_barrier(const XcdBarrier& b) {
    asm volatile("s_waitcnt vmcnt(0)" ::: "memory");
    __syncthreads();
    unsigned ln_; asm volatile("v_mbcnt_lo_u32_b32 %0, -1, 0\n\tv_mbcnt_hi_u32_b32 %0, -1, %0" : "=v"(ln_));
    if (b.wv == 0 && ln_ == 0u) {
        unsigned* bar = b.bar;
        __builtin_amdgcn_s_waitcnt(0);
        unsigned nloc = b.st[0], nx = b.st[1];
        if (nloc == 0u) { xcd_barrier_complete(bar, b.x, nloc, nx); b.st[0] = nloc; b.st[1] = nx; }
        const unsigned old = xb_add(&bar[XB_XSUB(b.x)], 1u);
        const unsigned gen = old / nloc;
        if (old + 1u == (gen + 1u) * nloc) {
            __builtin_amdgcn_fence(__ATOMIC_RELEASE, "agent");
            asm volatile("s_waitcnt vmcnt(0)" ::: "memory");
            const unsigned og = xb_add(&bar[XB_TOP], 1u);
            const unsigned tg = og / nx;
            if (og + 1u == (tg + 1u) * nx) xb_add(&bar[XB_TOPGEN], 1u);
            else XB_SPIN(xb_ld(&bar[XB_TOPGEN]) == tg, bar);
            __builtin_amdgcn_fence(__ATOMIC_ACQUIRE, "agent");
            xb_add(&bar[XB_XGEN(b.x)], 1u);
            asm volatile("s_waitcnt vmcnt(0)" ::: "memory");
        } else {
            XB_SPIN(xb_ld(&bar[XB_XGEN(b.x)]) == gen, bar);
            __builtin_amdgcn_fence(__ATOMIC_ACQUIRE, "agent");
            asm volatile("s_waitcnt vmcnt(0)" ::: "memory");
        }
    }
    __syncthreads();
}

constexpr int NWAVES = 8;
constexpr int DM = 1024, NB = 4, SEQ = 4096, NMETA = 16, DEPTH = 4;
constexpr int NREAL = NB * SEQ;
constexpr int NTOK = NREAL + NMETA;
constexpr int MPAD = 16640;
constexpr int INC = 3200, INP = 3328;
constexpr int RCOLS = 896, QOFF = 896, KOFF = 896 + 512, VOFF = 896 + 1024, COFF = 2432;
constexpr int FF = 2816, FF2 = 5632, NE = 8;
constexpr int KVROWS = 128 + SEQ;
constexpr int MOEP = 35072;
constexpr float C2Q = 0.125f * 1.4426950408889634f;

constexpr size_t MiB = 1u << 20;
constexpr size_t WS_CTL = 0, CTL_ZERO_BYTES = 1 * MiB;
constexpr size_t WS_COS = 1 * MiB, WS_SIN = 1 * MiB + 192 * 1024;
constexpr size_t WS_RSTD = 1 * MiB + 512 * 1024;
constexpr size_t WS_RSROW = 1 * MiB + 768 * 1024;
constexpr size_t WS_TOKE = 2 * MiB, WS_TOKS = 2 * MiB + 256 * 1024, WS_TOKG = 2 * MiB + 512 * 1024;
constexpr size_t WS_WIN = 4 * MiB;
constexpr size_t WS_WOUT = 30 * MiB;
constexpr size_t WS_WGU = 38 * MiB;
constexpr size_t WS_WD = 60 * MiB;
constexpr size_t WS_MWGU = 72 * MiB;
constexpr size_t WS_MWD = 160 * MiB;
constexpr size_t WS_H = 204 * MiB;
constexpr size_t WS_HB = 269 * MiB;
constexpr size_t WS_PH = 302 * MiB;
constexpr size_t WS_PROJ = WS_PH;
constexpr size_t WS_QN = 408 * MiB;
constexpr size_t WS_KP = 425 * MiB;
constexpr size_t WS_VP = 442 * MiB;
constexpr size_t WS_OC = 459 * MiB;
constexpr size_t WS_OMIX = 492 * MiB;
constexpr size_t WS_SC = 525 * MiB, SC_STRIDE = 17 * MiB;
constexpr size_t WS_MIX_END = WS_SC + 9 * SC_STRIDE;
constexpr size_t WS_G = WS_PH;
constexpr size_t WS_AROWS = 491 * MiB;
constexpr size_t WS_YM = 560 * MiB;
constexpr size_t WS_LORA = 680 * MiB;
constexpr size_t WS_END = 714 * MiB;
static_assert(WS_PROJ + (size_t)MPAD * INP * 2 <= WS_QN && WS_G + (size_t)MOEP * FF * 2 <= WS_AROWS && WS_AROWS + (size_t)MOEP * 1024 * 2 <= WS_YM && WS_YM + (size_t)MOEP * 1024 * 2 <= WS_END, "ws map");
static_assert((size_t)8 * FF2 * DM <= 44 * MiB && 44 * MiB + (size_t)4112 * 11008 + 1024 <= 88 * MiB && (size_t)4112 * 8192 <= (size_t)MPAD * 2048, "chunk buffers");
static_assert(WS_H + (size_t)MPAD * 1024 * 4 <= WS_HB && WS_HB + (size_t)MPAD * 1024 * 2 <= WS_PH && WS_MIX_END <= WS_END, "ws map 2");
static_assert((size_t)NTOK * 256 * 4 <= SC_STRIDE && WS_OC + (size_t)NTOK * 2048 <= WS_OMIX && WS_OMIX + (size_t)MPAD * 2048 <= WS_SC, "ws map 3");
constexpr int CW_MOECNT = 1024;
constexpr int CW_BAR = 4096;
constexpr int CW_ATTQ = 8192;

constexpr int LDS_BYTES = 147456;
constexpr int MISC_OFF = LDS_BYTES - 128;

struct Args { const float* in[32]; float* out; unsigned char* ws; int ph_lo, ph_hi; };

__device__ __forceinline__ v4u zero_v4u() { unsigned z; asm volatile("v_mov_b32 %0, 0" : "=v"(z)); return (v4u){z, z, z, z}; }
__device__ __forceinline__ unsigned pk4_fp8(float a, float b, float c, float d) {
    a = __builtin_amdgcn_fmed3f(a, -448.f, 448.f); b = __builtin_amdgcn_fmed3f(b, -448.f, 448.f); c = __builtin_amdgcn_fmed3f(c, -448.f, 448.f); d = __builtin_amdgcn_fmed3f(d, -448.f, 448.f);
    unsigned p = (unsigned)__builtin_amdgcn_cvt_pk_fp8_f32(a, b, 0, false); return (unsigned)__builtin_amdgcn_cvt_pk_fp8_f32(c, d, (int)p, true); }
#ifndef INP8_MASK
#define INP8_MASK 0xC
#endif
constexpr int INP8 = INP8_MASK;
constexpr float W8_SCALE = 64.f, A8_SCALE = 16.f, G8_SCALE = 4.f, H8_SCALE = 4.f;
__device__ __forceinline__ float bf2f(unsigned short b) { return __uint_as_float(((unsigned)b) << 16); }
#define DPP_F(x, ctrl) __int_as_float(__builtin_amdgcn_update_dpp(0, __float_as_int(x), ctrl, 0xF, 0xF, true))
__device__ __forceinline__ float lane_xor1(float v) { return DPP_F(v, 0xB1); }
__device__ __forceinline__ float sum8(float v) { v += DPP_F(v, 0xB1); v += DPP_F(v, 0x4E); v += DPP_F(v, 0x141); return v; }
__device__ __forceinline__ float sum16(float v) { v = sum8(v); v += DPP_F(v, 0x140); return v; }
__device__ __forceinline__ float wave_sum_dpp(float p) {
    p = sum16(p);
    asm volatile("s_nop 1\n\tv_add_f32_dpp %0, %0, %0 row_bcast:15 row_mask:0xa bank_mask:0xf\n\ts_nop 1\n\tv_add_f32_dpp %0, %0, %0 row_bcast:31 row_mask:0xc bank_mask:0xf\n\ts_nop 0" : "+v"(p));
    return __int_as_float(__builtin_amdgcn_readlane(__float_as_int(p), 63));
}
__device__ __forceinline__ float wave_sum(float v) { return wave_sum_dpp(v); }
__device__ __forceinline__ float wave_max(float v) {
    v = fmaxf(v, DPP_F(v, 0xB1)); v = fmaxf(v, DPP_F(v, 0x4E)); v = fmaxf(v, DPP_F(v, 0x141)); v = fmaxf(v, DPP_F(v, 0x140));
    asm volatile("s_nop 1\n\tv_max_f32_dpp %0, %0, %0 row_bcast:15 row_mask:0xa bank_mask:0xf\n\ts_nop 1\n\tv_max_f32_dpp %0, %0, %0 row_bcast:31 row_mask:0xc bank_mask:0xf\n\ts_nop 0" : "+v"(v));
    return __int_as_float(__builtin_amdgcn_readlane(__float_as_int(v), 63));
}
__device__ __forceinline__ float sigmoidf_(float x) { return 1.f / (1.f + __expf(-x)); }
__device__ __forceinline__ int prevrow(int row) { if (row < 0) return -1; if (row >= NREAL) return row == NREAL ? -1 : row - 1; return (row & (SEQ - 1)) == 0 ? NTOK - 1 : row - 1; }

__device__ __forceinline__ void tr_item(const float* W, int K, int N, bf16* WT, int rowmode, const float* gk, LAS float* scr, int item, int lane) {
    const int nblk = N / 32, kb = item / nblk, nb = item % nblk, k0 = 64 * kb, n0 = 32 * nb;
    const float* src = W + (size_t)(k0 + (lane >> 5)) * N + n0 + (lane & 31);
    float v[32];
#pragma unroll
    for (int i = 0; i < 32; ++i) v[i] = src[(size_t)(2 * i) * N];
#pragma unroll
    for (int i = 0; i < 32; ++i) scr[(2 * i + (lane >> 5)) * 33 + (lane & 31)] = v[i];
    LDS_WAIT(); asm volatile("" ::: "memory");
    const int c = lane & 7;
    f32x4 g0 = (f32x4){1.f, 1.f, 1.f, 1.f}, g1 = g0;
    if (gk) { g0 = *(const f32x4*)(gk + k0 + 8 * c); g1 = *(const f32x4*)(gk + k0 + 8 * c + 4); }
#pragma unroll
    for (int j = 0; j < 4; ++j) { const int n = (lane >> 3) + 8 * j; const LAS float* s = scr + (8 * c) * 33 + n;
        v4u o; o.x = pk2(s[0 * 33] * g0.x, s[1 * 33] * g0.y); o.y = pk2(s[2 * 33] * g0.z, s[3 * 33] * g0.w); o.z = pk2(s[4 * 33] * g1.x, s[5 * 33] * g1.y); o.w = pk2(s[6 * 33] * g1.z, s[7 * 33] * g1.w);
        const int nn = n0 + n; const int drow = rowmode == 0 ? nn : ((nn >> 7) * 256 + (nn & 127) + (rowmode == 2 ? 128 : 0));
        *(GAS v4u*)(WT + (size_t)drow * K + k0 + 8 * c) = o; }
    LDS_WAIT(); asm volatile("" ::: "memory");
}

__device__ __forceinline__ void tr_item2(const float* W0, int K0, int N0, bf16* WT0, int rm0, const float* gk0, int item0,
                                         const float* W1, int K1, int N1, bf16* WT1, int rm1, const float* gk1, int item1, LAS float* scr, int lane, bool f8_0 = false, bool f8_1 = false) {
    const int nb0_ = N0 / 32, nb1_ = N1 / 32;
    const int k00 = 64 * (item0 / nb0_), n00 = 32 * (item0 % nb0_), k01 = 64 * (item1 / nb1_), n01 = 32 * (item1 % nb1_);
    const float* s0 = W0 + (size_t)(k00 + (lane >> 5)) * N0 + n00 + (lane & 31); const float* s1 = W1 + (size_t)(k01 + (lane >> 5)) * N1 + n01 + (lane & 31);
    float v0[32], v1[32];
#pragma unroll
    for (int i = 0; i < 32; ++i) { v0[i] = s0[(size_t)(2 * i) * N0]; v1[i] = s1[(size_t)(2 * i) * N1]; }
    LAS float* t0 = scr; LAS float* t1 = scr + 64 * 33;
#pragma unroll
    for (int i = 0; i < 32; ++i) { t0[(2 * i + (lane >> 5)) * 33 + (lane & 31)] = v0[i]; t1[(2 * i + (lane >> 5)) * 33 + (lane & 31)] = v1[i]; }
    LDS_WAIT(); asm volatile("" ::: "memory");
    const int c = lane & 7;
#pragma unroll
    for (int q = 0; q < 2; ++q) { const float* gk = q ? gk1 : gk0; const int k0 = q ? k01 : k00, n0 = q ? n01 : n00, K = q ? K1 : K0, rowmode = q ? rm1 : rm0; bf16* WT = q ? WT1 : WT0; const LAS float* tt = q ? t1 : t0;
        f32x4 g0 = (f32x4){1.f, 1.f, 1.f, 1.f}, g1 = g0;
        if (gk) { g0 = *(const f32x4*)(gk + k0 + 8 * c); g1 = *(const f32x4*)(gk + k0 + 8 * c + 4); }
#pragma unroll
        for (int j = 0; j < 4; ++j) { const int n = (lane >> 3) + 8 * j; const LAS float* s = tt + (8 * c) * 33 + n;
            v4u o; o.x = pk2(s[0 * 33] * g0.x, s[1 * 33] * g0.y); o.y = pk2(s[2 * 33] * g0.z, s[3 * 33] * g0.w); o.z = pk2(s[4 * 33] * g1.x, s[5 * 33] * g1.y); o.w = pk2(s[6 * 33] * g1.z, s[7 * 33] * g1.w);
            const int nn = n0 + n; const int drow = rowmode == 0 ? nn : ((nn >> 7) * 256 + (nn & 127) + (rowmode == 2 ? 128 : 0));
            if (q ? f8_1 : f8_0) { const unsigned lo = pk4_fp8(s[0 * 33] * g0.x * W8_SCALE, s[1 * 33] * g0.y * W8_SCALE, s[2 * 33] * g0.z * W8_SCALE, s[3 * 33] * g0.w * W8_SCALE), hi8 = pk4_fp8(s[4 * 33] * g1.x * W8_SCALE, s[5 * 33] * g1.y * W8_SCALE, s[6 * 33] * g1.z * W8_SCALE, s[7 * 33] * g1.w * W8_SCALE);
                *(GAS unsigned long long*)((GAS unsigned char*)WT + (size_t)drow * K + k0 + 8 * c) = (unsigned long long)lo | ((unsigned long long)hi8 << 32); }
            else *(GAS v4u*)(WT + (size_t)drow * K + k0 + 8 * c) = o; } }
    LDS_WAIT(); asm volatile("" ::: "memory");
}

__device__ __forceinline__ void meta_gemm_res(const bf16* A, int K, const bf16* Bt, float* Hm, LAS unsigned char* lds, int bx, int wave, int lane, int hbmode = 0, bf16* HBm = nullptr, unsigned long long* rsqm = nullptr) {
    if (bx < 32) {
        typedef short bfx8 __attribute__((ext_vector_type(8)));
        const int ct = 2 * bx + (wave >> 2), ksp = wave & 3, n = lane & 15, kq = lane >> 4; const int kc = K >> 2, steps = kc >> 5;
        const bf16* ap = A + (size_t)n * K + ksp * kc + 8 * kq; const bf16* wp = Bt + (size_t)(16 * ct + n) * K + ksp * kc + 8 * kq;
        f32x4 acc = (f32x4){0.f, 0.f, 0.f, 0.f};
#pragma unroll 11
        for (int s = 0; s < steps; ++s) { const v4u a = *(const v4u*)(wp + 32 * s), b = *(const v4u*)(ap + 32 * s);
            acc = __builtin_amdgcn_mfma_f32_16x16x32_bf16(__builtin_bit_cast(bfx8, a), __builtin_bit_cast(bfx8, b), acc, 0, 0, 0); }
        LAS f32x4* red = (LAS f32x4*)lds;
        red[wave * 64 + lane] = acc;
        __syncthreads();
        if (ksp == 0) { const f32x4 s = (red[wave * 64 + lane] + red[(wave + 1) * 64 + lane]) + (red[(wave + 2) * 64 + lane] + red[(wave + 3) * 64 + lane]);
            f32x4* hp = (f32x4*)(Hm + (size_t)n * 1024 + 16 * ct + 4 * kq); const f32x4 hn = *hp + s; *hp = hn;
            if (hbmode) { const int cc = 16 * ct + 4 * kq;
                if (hbmode == 1) *(unsigned long long*)(HBm + (size_t)n * 1024 + cc) = (unsigned long long)pk2(hn.x, hn.y) | ((unsigned long long)pk2(hn.z, hn.w) << 32);
                else *(unsigned*)((unsigned char*)HBm + (size_t)n * 1024 + cc) = pk4_fp8(hn.x * H8_SCALE, hn.y * H8_SCALE, hn.z * H8_SCALE, hn.w * H8_SCALE);
                __hip_atomic_fetch_add(rsqm + n, (unsigned long long)(((hn.x * hn.x + hn.y * hn.y) + (hn.z * hn.z + hn.w * hn.w)) * 16777216.f), RLX_AGENT); } }
        __syncthreads();
    }
}

__device__ __forceinline__ void meta_gemm_res8(const unsigned char* A, int K, const unsigned char* Bt, float* Hm, float sc, LAS unsigned char* lds, int bx, int wave, int lane) {
    if (bx < 32) {
        typedef int v8i_ __attribute__((ext_vector_type(8)));
        const int ct = 2 * bx + (wave >> 2), ksp = wave & 3, n = lane & 15, kq = lane >> 4; const int kc = K >> 2, steps = kc >> 7;
        const int s0 = ksp < 2 ? 6 * ksp : 12 + 5 * (ksp - 2), ns = ksp < 2 ? 6 : 5; (void)kc; (void)steps;
        const unsigned char* ap = A + (size_t)n * K + 32 * kq; const unsigned char* wp = Bt + (size_t)(16 * ct + n) * K + 32 * kq;
        f32x4 acc = (f32x4){0.f, 0.f, 0.f, 0.f};
#pragma unroll 6
        for (int s = s0; s < s0 + ns; ++s) { const v4u a0 = *(const v4u*)(wp + 128 * s), a1 = *(const v4u*)(wp + 128 * s + 16), b0 = *(const v4u*)(ap + 128 * s), b1 = *(const v4u*)(ap + 128 * s + 16);
            const v8i_ aa = (v8i_){(int)a0.x, (int)a0.y, (int)a0.z, (int)a0.w, (int)a1.x, (int)a1.y, (int)a1.z, (int)a1.w}, bb = (v8i_){(int)b0.x, (int)b0.y, (int)b0.z, (int)b0.w, (int)b1.x, (int)b1.y, (int)b1.z, (int)b1.w};
            acc = __builtin_amdgcn_mfma_scale_f32_16x16x128_f8f6f4(aa, bb, acc, 0, 0, 0, 0x7f7f7f7f, 0, 0x7f7f7f7f); }
        LAS f32x4* red = (LAS f32x4*)lds;
        red[wave * 64 + lane] = acc;
        __syncthreads();
        if (ksp == 0) { const f32x4 s = (red[wave * 64 + lane] + red[(wave + 1) * 64 + lane]) + (red[(wave + 2) * 64 + lane] + red[(wave + 3) * 64 + lane]);
            f32x4* hp = (f32x4*)(Hm + (size_t)n * 1024 + 16 * ct + 4 * kq); *hp = *hp + s * sc; }
        __syncthreads();
    }
}

__global__ void __launch_bounds__(NWAVES * 64, 2) hymba_fwd(Args args) {
    extern __shared__ __attribute__((aligned(16))) unsigned char lds_raw[];
    LAS unsigned char* lds = (LAS unsigned char*)lds_raw;
    volatile LAS unsigned* MISC = (volatile LAS unsigned*)(lds + MISC_OFF);
    const int wave = __builtin_amdgcn_readfirstlane((int)threadIdx.x >> 6);
#define PH_TID int tid; asm volatile("v_mbcnt_lo_u32_b32 %0, -1, 0\n\tv_mbcnt_hi_u32_b32 %0, -1, %0" : "=v"(tid)); tid += wave * 64; const int lane = tid & 63; (void)lane; unsigned char* ws = ws0; asm volatile("" : "+s"(ws)); const char* ka = ka0; asm volatile("" : "+s"(ka)); (void)ka
    const int G = gridDim.x, bx = blockIdx.x;
    const int gw = bx * NWAVES + wave, NGW = G * NWAVES;
    unsigned char* const ws0 = args.ws;
    const char* const ka0 = (const char*)__builtin_amdgcn_kernarg_segment_ptr();
    { const int t0_ = (int)threadIdx.x; if (t0_ < 32) ((LAS unsigned*)(lds + MISC_OFF))[t0_] = 0u; }
    __syncthreads();
    const int lo = args.ph_lo, hi = args.ph_hi;
    const bool multi = (hi - lo) > 1;
    XcdBarrier bar; bar.bar = (unsigned*)(ws0 + WS_CTL) + CW_BAR; bar.x = 0; bar.st = nullptr; bar.wv = wave;
    if (multi) { bar = xcd_barrier_post((unsigned*)(ws0 + WS_CTL) + CW_BAR, MISC + 8); bar.wv = wave; }
#ifndef ENMASK
#define ENMASK 0xFFFF
#endif
#define EN(k) (((ENMASK) >> (k)) & 1)
#ifndef REPMASK
#define REPMASK 0
#endif
#define NREP(k) ((((REPMASK) >> (k)) & 1) ? 2 : 1)
#define IN(k) (lo <= (k) && (k) < hi)
#define SEAM(k) do { if (hi > (k) + 1) xcd_barrier(bar); } while (0)

#define Hf ((float*)(ws + WS_H))
#define HB ((bf16*)(ws + WS_HB))
#define RSTD ((float*)(ws + WS_RSTD))
#define PROJ ((bf16*)(ws + WS_PROJ))
#define QN ((bf16*)(ws + WS_QN))
#define KP ((bf16*)(ws + WS_KP))
#define VP ((bf16*)(ws + WS_VP))
#define OC ((bf16*)(ws + WS_OC))
#define OMIX ((bf16*)(ws + WS_OMIX))
#define SP4 ((f32x4*)(ws + WS_SC + 0 * SC_STRIDE))
#define SR ((float*)(ws + WS_SC + 4 * SC_STRIDE))
#define SV ((float*)(ws + WS_SC + 5 * SC_STRIDE))
#define SG ((float*)(ws + WS_SC + 6 * SC_STRIDE))
#define SBON ((float*)(ws + WS_SC + 7 * SC_STRIDE))
#define SY ((float*)(ws + WS_SC + 8 * SC_STRIDE))
#define COS ((float*)(ws + WS_COS))
#define SIN ((float*)(ws + WS_SIN))
#define GB ((bf16*)(ws + WS_G))
#define AROWS ((bf16*)(ws + WS_AROWS))
#define YM ((bf16*)(ws + WS_YM))
#define RSQA ((unsigned long long*)(ws + WS_RSROW))
#define TOKE ((int*)(ws + WS_TOKE))
#define TOKS ((int*)(ws + WS_TOKS))
#define TOKG ((float*)(ws + WS_TOKG))
#define ctl ((gu32*)(ws + WS_CTL))
#define INP(i) (*(const float* const*)(ka + 8 * (i)))
#define LORA_W ((float*)(ws + WS_LORA))
#define LORA_AG ((bf16*)(ws + WS_LORA + 17 * MiB))
#define CH_REC ((unsigned char*)(ws + WS_MWGU + 44 * MiB))
#define CH_RB 11008
#define CH_SPK ((unsigned char*)(ws + WS_HB))
#ifndef SCAN_CHUNKED
#define SCAN_CHUNKED 1
#endif

    for (int rep_ = 0; rep_ < NREP(15); ++rep_) if (EN(15) && IN(0)) { PH_TID;
        LAS float* scr = (LAS float*)(lds + wave * 17408);
        constexpr int I_IN = 16 * 100, I_OUT = 16 * 32, I_GU = 16 * 88, I_DN = 44 * 32;
        constexpr int NITEMS = DEPTH * (I_IN + I_OUT) + 2 * (2 * I_GU + I_DN);
        for (int it0 = 2 * gw; it0 < NITEMS; it0 += 2 * NGW) {
            const float* W_[2]; bf16* D_[2]; int K_[2], N_[2], rm_[2], r_[2]; const float* g_[2]; bool f8_[2] = {false, false};
#pragma unroll
            for (int q = 0; q < 2; ++q) { int r = it0 + q;
                if (r < DEPTH * I_IN) { const int l = r / I_IN; W_[q] = INP(3) + (size_t)l * DM * INC; K_[q] = DM; N_[q] = INC; D_[q] = (bf16*)(ws + WS_WIN) + (size_t)l * INP * DM; rm_[q] = 0; g_[q] = INP(2) + l * DM; r_[q] = r % I_IN; f8_[q] = ((INP8 >> l) & 1) != 0; continue; } r -= DEPTH * I_IN;
                if (r < DEPTH * I_OUT) { const int l = r / I_OUT; W_[q] = INP(23) + (size_t)l * DM * DM; K_[q] = DM; N_[q] = DM; D_[q] = (bf16*)(ws + WS_WOUT) + (size_t)l * DM * DM; rm_[q] = 0; g_[q] = nullptr; r_[q] = r % I_OUT; continue; } r -= DEPTH * I_OUT;
                if (r < 2 * I_GU) { const int j = r / I_GU; W_[q] = INP(25) + (size_t)j * DM * FF; K_[q] = DM; N_[q] = FF; D_[q] = (bf16*)(ws + WS_WGU) + (size_t)j * FF2 * DM; rm_[q] = 1; g_[q] = INP(24) + (2 * j) * DM; r_[q] = r % I_GU; f8_[q] = (j == 1); continue; } r -= 2 * I_GU;
                if (r < 2 * I_GU) { const int j = r / I_GU; W_[q] = INP(26) + (size_t)j * DM * FF; K_[q] = DM; N_[q] = FF; D_[q] = (bf16*)(ws + WS_WGU) + (size_t)j * FF2 * DM; rm_[q] = 2; g_[q] = INP(24) + (2 * j) * DM; r_[q] = r % I_GU; f8_[q] = (j == 1); continue; } r -= 2 * I_GU;
                { const int j = r / I_DN; W_[q] = INP(27) + (size_t)j * FF * DM; K_[q] = FF; N_[q] = DM; D_[q] = (bf16*)(ws + WS_WD) + (size_t)j * DM * FF; rm_[q] = 0; g_[q] = nullptr; r_[q] = r % I_DN; f8_[q] = (j == 1); } }
            tr_item2(W_[0], K_[0], N_[0], D_[0], rm_[0], g_[0], r_[0], W_[1], K_[1], N_[1], D_[1], rm_[1], g_[1], r_[1], scr, lane, f8_[0], f8_[1]);
        }
        const int gt = bx * (NWAVES * 64) + tid, NGT = G * NWAVES * 64;
        for (int i = gt; i < DEPTH * 128 * (DM / 8); i += NGT) { const int l = i / (128 * (DM / 8)), r = i % (128 * (DM / 8));
            if ((INP8 >> l) & 1) { if (r < 128 * (DM / 16)) ((v4u*)((unsigned char*)(ws + WS_WIN) + (size_t)l * INP * DM * 2 + (size_t)INC * DM))[r] = zero_v4u(); }
            else ((v4u*)((bf16*)(ws + WS_WIN) + ((size_t)l * INP + INC) * DM))[r] = zero_v4u(); }
        for (int row = gw; row < MPAD; row += NGW) {
            f32x4 v[4]; float s = 0.f;
#pragma unroll
            for (int j = 0; j < 4; ++j) { const int c4 = lane + 64 * j; v[j] = __builtin_bit_cast(f32x4, zero_v4u());
                if (row < NREAL) v[j] = ((const f32x4*)INP(0))[(size_t)row * (DM / 4) + c4]; else if (row < NTOK) v[j] = ((const f32x4*)INP(1))[(row - NREAL) * (DM / 4) + c4];
                ((f32x4*)Hf)[(size_t)row * (DM / 4) + c4] = v[j]; s += (v[j].x * v[j].x + v[j].y * v[j].y) + (v[j].z * v[j].z + v[j].w * v[j].w); }
            if (row < NTOK) { s = wave_sum(s); const float rstd = 1.f / sqrtf(s * (1.f / DM) + 1e-6f);
                if (INP8 & 1) { const float sn = rstd * A8_SCALE;
#pragma unroll
                    for (int j = 0; j < 4; ++j) ((unsigned*)((unsigned char*)HB + (size_t)row * DM))[lane + 64 * j] = pk4_fp8(v[j].x * sn, v[j].y * sn, v[j].z * sn, v[j].w * sn); }
                else {
#pragma unroll
                    for (int j = 0; j < 4; ++j) ((unsigned long long*)(HB + (size_t)row * DM))[lane + 64 * j] = (unsigned long long)pk2(v[j].x, v[j].y) | ((unsigned long long)pk2(v[j].z, v[j].w) << 32); }
                if (lane == 0) RSTD[row] = rstd; }
        }
        if (INP8 & 1) { for (int i = gt; i < (MPAD - NTOK) * (DM / 16); i += NGT) ((v4u*)((unsigned char*)HB + (size_t)NTOK * DM))[i] = zero_v4u(); }
        else
        for (int i = gt; i < (MPAD - NTOK) * (DM / 8); i += NGT) ((v4u*)(HB + (size_t)NTOK * DM))[i] = zero_v4u();
        for (int i = gt; i < MPAD - NTOK; i += NGT) RSTD[NTOK + i] = 0.f;
        for (int i = gt; i < (SEQ + NMETA) * 8; i += NGT) { const int pos = i >> 3, j = i & 7;
            const float invf = j == 0 ? 1.000000000e+00f : j == 1 ? 1.939227432e-01f : j == 2 ? 3.760603070e-02f : j == 3 ? 7.292664610e-03f : j == 4 ? 1.414213562e-03f : j == 5 ? 2.742481884e-04f : j == 6 ? 5.318296098e-05f : 1.031338616e-05f;
            const float angf = (float)pos * invf; const double a = (double)angf; const double n = __builtin_rint(a * 0.15915494309189535);
            const double rr = (a - n * 6.283185307179586) - n * 2.4492935982947064e-16; const float rev = (float)(rr * 0.15915494309189535);
            COS[i] = __builtin_amdgcn_cosf(rev); SIN[i] = __builtin_amdgcn_sinf(rev); }
        SEAM(0);
    }

#pragma nounroll
    for (int layer = 0; layer < DEPTH; ++layer) {
        const int pb = 1 + 12 * layer; const bool moe = (layer & 1) != 0; const int jj = layer >> 1;
        if (hi <= pb || lo >= pb + 12) continue;
        const float lam_init = 0.8f - 0.6f * __expf(-0.3f * (float)layer);

        for (int rep_ = 0; rep_ < NREP(0); ++rep_) if (EN(0) && IN(pb + 0) && moe) { PH_TID;
            for (int row = gw; row < NTOK; row += NGW) {
                const GAS f32x4* xr = (const GAS f32x4*)(Hf + (size_t)row * DM) + lane; f32x4 v[4]; float s = 0.f;
#pragma unroll
                for (int j = 0; j < 4; ++j) { v[j] = xr[64 * j]; s += (v[j].x * v[j].x + v[j].y * v[j].y) + (v[j].z * v[j].z + v[j].w * v[j].w); }
                s = wave_sum(s); const float rstd = 1.f / sqrtf(s * (1.f / DM) + 1e-6f);
                if ((INP8 >> layer) & 1) { GAS unsigned* o4 = (GAS unsigned*)((GAS unsigned char*)HB + (size_t)row * DM) + lane; const float sn = rstd * A8_SCALE;
#pragma unroll
                    for (int j = 0; j < 4; ++j) o4[64 * j] = pk4_fp8(v[j].x * sn, v[j].y * sn, v[j].z * sn, v[j].w * sn); }
                else { GAS unsigned long long* o8 = (GAS unsigned long long*)(HB + (size_t)row * DM) + lane;
#pragma unroll
                    for (int j = 0; j < 4; ++j) o8[64 * j] = (unsigned long long)pk2(v[j].x, v[j].y) | ((unsigned long long)pk2(v[j].z, v[j].w) << 32); }
                if (lane == 0) RSTD[row] = rstd;
            }
            if ((INP8 >> layer) & 1) { const int gt = bx * (NWAVES * 64) + tid, NGT = G * NWAVES * 64;
                for (int i = gt; i < (MPAD - NTOK) * (DM / 16); i += NGT) ((v4u*)((unsigned char*)HB + (size_t)NTOK * DM))[i] = zero_v4u(); }
            if (moe) {
                LAS float* scr = (LAS float*)(lds + wave * 17408);
                constexpr int I_GU = 16 * 88, I_DN = 44 * 32, PER_E = 2 * I_GU + I_DN;
                const float* gff = INP(24) + layer * DM;
                for (int it0 = 2 * gw; it0 < NE * PER_E; it0 += 2 * NGW) {
                    const float* W_[2]; bf16* D_[2]; int K_[2], N_[2], rm_[2], r_[2]; const float* g_[2];
#pragma unroll
                    for (int q = 0; q < 2; ++q) { const int it = it0 + q; const int e = it / PER_E; int r = it % PER_E; const size_t eo = (size_t)(jj * NE + e) * DM * FF;
                        if (r < I_GU) { W_[q] = INP(29) + eo; K_[q] = DM; N_[q] = FF; D_[q] = (bf16*)(ws + WS_MWGU) + (size_t)e * FF2 * DM / 2; rm_[q] = 1; g_[q] = gff; }
                        else if (r < 2 * I_GU) { r -= I_GU; W_[q] = INP(30) + eo; K_[q] = DM; N_[q] = FF; D_[q] = (bf16*)(ws + WS_MWGU) + (size_t)e * FF2 * DM / 2; rm_[q] = 2; g_[q] = gff; }
                        else { r -= 2 * I_GU; W_[q] = INP(31) + eo; K_[q] = FF; N_[q] = DM; D_[q] = (bf16*)(ws + WS_MWD) + (size_t)e * DM * FF / 2; rm_[q] = 0; g_[q] = nullptr; }
                        r_[q] = r; }
                    tr_item2(W_[0], K_[0], N_[0], D_[0], rm_[0], g_[0], r_[0], W_[1], K_[1], N_[1], D_[1], rm_[1], g_[1], r_[1], scr, lane, true, true);
                }
            }
            SEAM(pb + 0);
        }
        for (int rep_ = 0; rep_ < NREP(1); ++rep_) if (EN(1) && IN(pb + 1)) { PH_TID;
            pg8::StaticOrder S; S.init(MPAD, INP, G, bx);
            if ((INP8 >> layer) & 1) { pg8::Gemm g{HB, (const bf16*)(ws + WS_WIN) + (size_t)layer * INP * DM, MPAD, INP, DM / 2}; pg8::EpiBf16Rs E{PROJ, INP, nullptr, 1.f / (W8_SCALE * A8_SCALE)};
                pg8::gemm_phase<pg8::EpiBf16Rs, pg8::StaticOrder, true, true, true>(lds, g, S, E, tid); }
            else { pg8::Gemm g{HB, (const bf16*)(ws + WS_WIN) + (size_t)layer * INP * DM, MPAD, INP, DM}; pg8::EpiBf16Rs E{PROJ, INP, RSTD, 1.f};
                pg8::gemm_phase<pg8::EpiBf16Rs, pg8::StaticOrder, true, true>(lds, g, S, E, tid); }
            SEAM(pb + 1);
        }
        for (int rep_ = 0; rep_ < NREP(2); ++rep_) if (EN(2) && IN(pb + 2)) { PH_TID;
            const int gt = bx * (NWAVES * 64) + tid, NGT = G * NWAVES * 64;
            if (tid < 65) { const v4u z_ = zero_v4u(); RSQA[bx * 65 + tid] = (unsigned long long)z_.x | ((unsigned long long)z_.y << 32); }
            for (int i = gt; i < NB * 112 * 64; i += NGT) { const int b = i / (112 * 64), r = (i / 64) % 112, c = i % 64; const int row = b * KVROWS + (r < 48 ? r : r + 16);
                ((v4u*)(KP + (size_t)row * 512))[c] = zero_v4u(); ((v4u*)(VP + (size_t)row * 512))[c] = zero_v4u(); }
            const int ngrp = (1025 - bx + 255) / 256, nrows = 16 * ngrp;
#define MP_ROW(idx) (16 * (bx + 256 * ((idx) >> 4)) + ((idx) & 15))
            LAS unsigned char* WT = lds;
            { const int nn = tid & 255, hf = tid >> 8;
              const float* sd = INP(6) + layer * 32 * 256 + (hf * 16) * 256 + nn; const float* sa = INP(8) + layer * 32 * 256 + (hf * 16) * 256 + nn; const float* sg = INP(9) + layer * 64 * 256 + (hf * 32) * 256 + nn;
              v4u wv[2];
#pragma unroll
              for (int i = 0; i < 2; ++i) { wv[i].x = pk2(sd[(8 * i) * 256], sd[(8 * i + 1) * 256]); wv[i].y = pk2(sd[(8 * i + 2) * 256], sd[(8 * i + 3) * 256]); wv[i].z = pk2(sd[(8 * i + 4) * 256], sd[(8 * i + 5) * 256]); wv[i].w = pk2(sd[(8 * i + 6) * 256], sd[(8 * i + 7) * 256]); }
              *(LAS v4u*)(WT + nn * 64 + hf * 32) = wv[0]; *(LAS v4u*)(WT + nn * 64 + hf * 32 + 16) = wv[1];
#pragma unroll
              for (int i = 0; i < 2; ++i) { wv[i].x = pk2(sa[(8 * i) * 256], sa[(8 * i + 1) * 256]); wv[i].y = pk2(sa[(8 * i + 2) * 256], sa[(8 * i + 3) * 256]); wv[i].z = pk2(sa[(8 * i + 4) * 256], sa[(8 * i + 5) * 256]); wv[i].w = pk2(sa[(8 * i + 6) * 256], sa[(8 * i + 7) * 256]); }
              *(LAS v4u*)(WT + 16384 + nn * 64 + hf * 32) = wv[0]; *(LAS v4u*)(WT + 16384 + nn * 64 + hf * 32 + 16) = wv[1];
#pragma unroll
              for (int i = 0; i < 4; ++i) { v4u t; t.x = pk2(sg[(8 * i) * 256], sg[(8 * i + 1) * 256]); t.y = pk2(sg[(8 * i + 2) * 256], sg[(8 * i + 3) * 256]); t.z = pk2(sg[(8 * i + 4) * 256], sg[(8 * i + 5) * 256]); t.w = pk2(sg[(8 * i + 6) * 256], sg[(8 * i + 7) * 256]);
                  *(LAS v4u*)(WT + 32768 + nn * 128 + hf * 64 + 16 * i) = t; } }
            __syncthreads();
            const float* mu = INP(4) + layer * RCOLS; const float* w0 = INP(5) + layer * 256; const float* a0 = INP(7) + layer * 256;
            const float* k_k = INP(10) + layer * 256; const float* k_a = INP(11) + layer * 256; const float* r_k = INP(12) + layer * 256;
            const float* qg = INP(15) + layer * 64; const float* kg = INP(16) + layer * 64; const float* cw = INP(22) + layer * 3 * 256;
            for (int rep3_ = 0; rep3_ < NREP(5); ++rep3_)
            if (wave < ngrp) {
                typedef attn_body::bf16x8 bfx8;
                const int rowbase = 16 * (bx + 256 * wave);
                LAS unsigned char* XT = lds + 65536 + wave * 4096;
                { const float mu0 = mu[768 + 2 * lane], mu1 = mu[768 + 2 * lane + 1]; const int p0 = prevrow(rowbase);
                  unsigned cur = p0 < 0 ? 0u : *(const unsigned*)(PROJ + (size_t)p0 * INP + 768 + 2 * lane); float pl = __uint_as_float(cur << 16), ph = __uint_as_float(cur & 0xffff0000u);
#pragma unroll
                  for (int r = 0; r < 16; ++r) { cur = *(const unsigned*)(PROJ + (size_t)(rowbase + r) * INP + 768 + 2 * lane); const float xl = __uint_as_float(cur << 16), xh = __uint_as_float(cur & 0xffff0000u);
                      float h0 = xl + (pl - xl) * mu0, h1 = xh + (ph - xh) * mu1; pl = xl; ph = xh;
                      if (lane < 16) { h0 = 1.f - 2.f / (1.f + __expf(2.f * h0)); h1 = 1.f - 2.f / (1.f + __expf(2.f * h1)); } else if (lane >= 32) { h0 = sigmoidf_(h0); h1 = sigmoidf_(h1); }
                      *(LAS unsigned*)(XT + r * 256 + 4 * lane) = pk2(h0, h1); } }
                LDS_WAIT();
                const int n = lane & 15, kq = lane >> 4;
                const v4u xd = *(const LAS v4u*)(XT + n * 256 + (8 * kq) * 2), xa = *(const LAS v4u*)(XT + n * 256 + (32 + 8 * kq) * 2);
                const v4u xg0 = *(const LAS v4u*)(XT + n * 256 + (64 + 8 * kq) * 2), xg1 = *(const LAS v4u*)(XT + n * 256 + (96 + 8 * kq) * 2);
                float* lw = LORA_W + (size_t)(rowbase + n) * 256 + 4 * kq; bf16* lag = LORA_AG + (size_t)(rowbase + n) * 512 + 4 * kq;
#pragma unroll 4
                for (int ct = 0; ct < 16; ++ct) {
                    const v4u ad = *(const LAS v4u*)(WT + (16 * ct + n) * 64 + (8 * kq) * 2), aa = *(const LAS v4u*)(WT + 16384 + (16 * ct + n) * 64 + (8 * kq) * 2);
                    const v4u ag0 = *(const LAS v4u*)(WT + 32768 + (16 * ct + n) * 128 + (8 * kq) * 2), ag1 = *(const LAS v4u*)(WT + 32768 + (16 * ct + n) * 128 + (32 + 8 * kq) * 2);
                    f32x4 dd = __builtin_amdgcn_mfma_f32_16x16x32_bf16(__builtin_bit_cast(bfx8, ad), __builtin_bit_cast(bfx8, xd), (f32x4){0.f, 0.f, 0.f, 0.f}, 0, 0, 0);
                    f32x4 da = __builtin_amdgcn_mfma_f32_16x16x32_bf16(__builtin_bit_cast(bfx8, aa), __builtin_bit_cast(bfx8, xa), (f32x4){0.f, 0.f, 0.f, 0.f}, 0, 0, 0);
                    f32x4 dg = __builtin_amdgcn_mfma_f32_16x16x32_bf16(__builtin_bit_cast(bfx8, ag0), __builtin_bit_cast(bfx8, xg0), (f32x4){0.f, 0.f, 0.f, 0.f}, 0, 0, 0);
                    dg = __builtin_amdgcn_mfma_f32_16x16x32_bf16(__builtin_bit_cast(bfx8, ag1), __builtin_bit_cast(bfx8, xg1), dg, 0, 0, 0);
                    *(f32x4*)(lw + 16 * ct) = dd;
                    *(unsigned long long*)(lag + 16 * ct) = (unsigned long long)pk2(da.x, da.y) | ((unsigned long long)pk2(da.z, da.w) << 32);
                    *(unsigned long long*)(lag + 256 + 16 * ct) = (unsigned long long)pk2(dg.x, dg.y) | ((unsigned long long)pk2(dg.z, dg.w) << 32);
                }
            }
            asm volatile("s_waitcnt vmcnt(0)" ::: "memory");
            __syncthreads();
#pragma nounroll
            for (int rep3_ = 0; rep3_ < NREP(10); ++rep3_)
            {
                typedef unsigned u32x2_ __attribute__((ext_vector_type(2)));
                const int sub = lane & 7; const int c4 = 4 * lane;
                const f32x4 qg0 = *(const f32x4*)(qg + 8 * sub), qg1 = *(const f32x4*)(qg + 8 * sub + 4), kg0 = *(const f32x4*)(kg + 8 * sub), kg1 = *(const f32x4*)(kg + 8 * sub + 4);
                const f32x4 cw0 = *(const f32x4*)(cw + c4), cw1 = *(const f32x4*)(cw + 256 + c4), cw2 = *(const f32x4*)(cw + 512 + c4);
                v4u rq, rk, rv; u32x2_ b0, g0_, u0, g1_, u1, g2_, u2;
#define AP_LOAD(rw) do { const int p1_ = prevrow(rw), p2_ = prevrow(p1_); const bf16* q_ = PROJ + (size_t)(rw) * INP; const bf16* q1_ = PROJ + (size_t)(p1_ < 0 ? (rw) : p1_) * INP; const bf16* q2_ = PROJ + (size_t)(p2_ < 0 ? (rw) : p2_) * INP; \
                    rq = *(const v4u*)(q_ + QOFF + 8 * lane); rk = *(const v4u*)(q_ + KOFF + 8 * lane); rv = *(const v4u*)(q_ + VOFF + 8 * lane); (void)q1_; (void)q2_; } while (0)
#define CV_LOAD(rw) do { const int p1_ = prevrow(rw), p2_ = prevrow(p1_); const bf16* q_ = PROJ + (size_t)(rw) * INP; const bf16* q1_ = PROJ + (size_t)(p1_ < 0 ? (rw) : p1_) * INP; const bf16* q2_ = PROJ + (size_t)(p2_ < 0 ? (rw) : p2_) * INP; \
                    b0 = *(const u32x2_*)(q_ + COFF + c4); g0_ = *(const u32x2_*)(q_ + COFF + 256 + c4); u0 = *(const u32x2_*)(q_ + COFF + 512 + c4); \
                    g1_ = *(const u32x2_*)(q1_ + COFF + 256 + c4); u1 = *(const u32x2_*)(q1_ + COFF + 512 + c4); g2_ = *(const u32x2_*)(q2_ + COFF + 256 + c4); u2 = *(const u32x2_*)(q2_ + COFF + 512 + c4); } while (0)
#define U2F4(t_) ((f32x4){__uint_as_float((t_).x << 16), __uint_as_float((t_).x & 0xffff0000u), __uint_as_float((t_).y << 16), __uint_as_float((t_).y & 0xffff0000u)})
                int idx = wave; AP_LOAD(MP_ROW(idx));
                for (; idx < nrows; idx += 8) { const int row = MP_ROW(idx);
                    const int p1 = prevrow(row), p2 = prevrow(p1); const float m1 = p1 < 0 ? 0.f : 1.f, m2 = p2 < 0 ? 0.f : 1.f;
                    const v4u cq = rq, ck = rk, cv = rv;
                    CV_LOAD(row);
                    if (idx + 8 < nrows) AP_LOAD(MP_ROW(idx + 8));
                    const int pos = row >= NREAL ? row - NREAL : NMETA + (row & (SEQ - 1));
                    const f32x4 c0 = *(const f32x4*)(COS + pos * 8), c1 = *(const f32x4*)(COS + pos * 8 + 4), n0 = *(const f32x4*)(SIN + pos * 8), n1 = *(const f32x4*)(SIN + pos * 8 + 4);
                    const float cs[8] = {c0.x, c0.y, c0.z, c0.w, c1.x, c1.y, c1.z, c1.w}; const float sn[8] = {n0.x, n0.y, n0.z, n0.w, n1.x, n1.y, n1.z, n1.w};
#pragma unroll
                    for (int which = 0; which < 2; ++which) {
                        const v4u raw = which ? ck : cq;
                        float x[8] = {__uint_as_float(raw.x << 16), __uint_as_float(raw.x & 0xffff0000u), __uint_as_float(raw.y << 16), __uint_as_float(raw.y & 0xffff0000u),
                                      __uint_as_float(raw.z << 16), __uint_as_float(raw.z & 0xffff0000u), __uint_as_float(raw.w << 16), __uint_as_float(raw.w & 0xffff0000u)};
                        float s2 = 0.f;
#pragma unroll
                        for (int i = 0; i < 8; ++i) s2 += x[i] * x[i];
                        s2 = sum8(s2);
                        const float rs = 1.f / sqrtf(s2 * (1.f / 64.f) + 1e-6f);
                        const f32x4 ga = which ? kg0 : qg0, gb = which ? kg1 : qg1;
                        const float gg[8] = {ga.x, ga.y, ga.z, ga.w, gb.x, gb.y, gb.z, gb.w};
                        float o[8];
#pragma unroll
                        for (int i = 0; i < 8; ++i) { const float xn = x[i] * rs * gg[i]; const float xp = lane_xor1(xn);
                            o[i] = sub == 0 ? xn * cs[i] - xp * sn[i] : (sub == 1 ? xn * cs[i] + xp * sn[i] : xn); if (!which) o[i] *= C2Q; }
                        v4u w; w.x = pk2(o[0], o[1]); w.y = pk2(o[2], o[3]); w.z = pk2(o[4], o[5]); w.w = pk2(o[6], o[7]);
                        if (!which) *(v4u*)(QN + (size_t)row * 512 + 8 * lane) = w;
                        else {
                            if (row < NREAL) { const size_t kr = (size_t)((row >> 12) * KVROWS + 128 + (row & (SEQ - 1))) * 512 + 8 * lane; *(v4u*)(KP + kr) = w; *(v4u*)(VP + kr) = cv; }
                            else {
#pragma unroll
                                for (int b = 0; b < NB; ++b) { const size_t kr = (size_t)(b * KVROWS + 48 + (row - NREAL)) * 512 + 8 * lane; *(v4u*)(KP + kr) = w; *(v4u*)(VP + kr) = cv; } } }
                    }
                    { const f32x4 fb0 = U2F4(b0), z0 = U2F4(g0_) * U2F4(u0), z1 = U2F4(g1_) * U2F4(u1) * m1, z2 = U2F4(g2_) * U2F4(u2) * m2;
                      const f32x4 y = cw0 * z2 + cw1 * z1 + cw2 * z0; const f32x4 o = fb0 * y;
                      *(unsigned long long*)(OMIX + (size_t)row * DM + 768 + c4) = (unsigned long long)pk2(o.x, o.y) | ((unsigned long long)pk2(o.z, o.w) << 32); }
                }
#undef AP_LOAD
#undef CV_LOAD
#undef U2F4
            }
            {
                LAS float* XL = (LAS float*)(lds + wave * 17408);
                LAS float* YL = XL + 32 * 65;
                const int nreal_g = ngrp - (bx == 0 ? 1 : 0);
                for (int lt = wave; lt < 4 * nreal_g + (bx == 0 ? 4 : 0); lt += NWAVES) {
                    int bh, ch; if (lt < 4 * nreal_g) { const int g = bx + 256 * (lt >> 2); bh = (g >> 8) * 4 + (lt & 3); ch = (g & 255) + 1; } else { bh = lt - 4 * nreal_g; ch = 0; }
                    const int task = bh * 257 + ch, b = bh >> 2, cb = (bh & 3) * 64; const int rowbase = ch == 0 ? NREAL : b * SEQ + 16 * (ch - 1);
                    float at[16], rt[16], bt[16], kt[16], vsv[16]; float gam = 1.f;
                    { const int c = cb + lane;
                      const float mu_r = mu[c], mu_k = mu[256 + c], mu_v = mu[512 + c], w0c = w0[c], a0c = a0[c], kkc = k_k[c], kac = k_a[c], rkc = r_k[c];
                      const int p0 = prevrow(rowbase); const bf16* q0 = PROJ + (size_t)(p0 < 0 ? rowbase : p0) * INP + c; const float pm = p0 < 0 ? 0.f : 1.f;
                      float pr_ = pm * bf2f(q0[0]), pk_ = pm * bf2f(q0[256]), pv_ = pm * bf2f(q0[512]);
                      unsigned short xr[16], xk[16], xv[16], la[16], lg[16]; float lw[16];
#pragma unroll
                      for (int t = 0; t < 16; ++t) { const bf16* q_ = PROJ + (size_t)(rowbase + t) * INP + c; xr[t] = q_[0]; xk[t] = q_[256]; xv[t] = q_[512];
                          lw[t] = LORA_W[(size_t)(rowbase + t) * 256 + c]; la[t] = LORA_AG[(size_t)(rowbase + t) * 512 + c]; lg[t] = LORA_AG[(size_t)(rowbase + t) * 512 + 256 + c]; }
#pragma unroll
                      for (int t = 0; t < 16; ++t) {
                          const float fr = bf2f(xr[t]), fk = bf2f(xk[t]), fv = bf2f(xv[t]);
                          const float r = fr + (pr_ - fr) * mu_r, k = fk + (pk_ - fk) * mu_k, v = fv + (pv_ - fv) * mu_v; pr_ = fr; pk_ = fk; pv_ = fv;
                          const float wacc = w0c + lw[t], aacc = a0c + bf2f(la[t]), gacc = bf2f(lg[t]);
                          const float nx = -wacc; const float sp = fmaxf(nx, 0.f) + __logf(1.f + __expf(-fabsf(nx)));
                          const float wlog = -sp - 0.5f; const float decay = __expf(-__expf(wlog));
                          const float a = sigmoidf_(aacc);
                          const float kkr = k * kkc; const float ss = wave_sum_dpp(kkr * kkr); const float kk = kkr / fmaxf(sqrtf(ss), 1e-12f);
                          const float k2 = k * (1.f + (a - 1.f) * kac);
                          const float bs = wave_sum_dpp(r * k2 * rkc);
                          const size_t si = (size_t)(rowbase + t) * 256 + c;
                          SG[si] = gacc; SBON[si] = bs * v;
                          at[t] = -kk * gam; gam *= decay; rt[t] = r * gam; const float ig = 1.f / gam; bt[t] = kk * a * ig; kt[t] = k2 * ig; vsv[t] = v; } }
#pragma unroll
                    for (int t = 0; t < 16; ++t) { XL[t * 65 + lane] = bt[t]; XL[(16 + t) * 65 + lane] = kt[t]; YL[t * 65 + lane] = at[t]; YL[(16 + t) * 65 + lane] = rt[t]; }
                    attn_body::f32x16 gm = attn_body::f32x16{};
#pragma unroll 8
                    for (int kk = 0; kk < 32; ++kk) gm = __builtin_amdgcn_mfma_f32_32x32x2f32(XL[(lane & 31) * 65 + 2 * kk + (lane >> 5)], YL[(lane & 31) * 65 + 2 * kk + (lane >> 5)], gm, 0, 0, 0);
                    LDS_WAIT();
                    LAS float* GL = YL; LAS float* TL = YL + 1056; LAS float* XM = YL + 1328;
#pragma unroll
                    for (int r = 0; r < 16; ++r) GL[((r & 3) + 8 * (r >> 2) + 4 * (lane >> 5)) * 33 + (lane & 31)] = gm[r];
                    float tr[16];
#pragma unroll
                    for (int t = 0; t < 16; ++t) tr[t] = ((lane & 15) == t) ? 1.f : 0.f;
#pragma unroll
                    for (int s = 0; s < 15; ++s)
#pragma unroll
                        for (int t = s + 1; t < 16; ++t) tr[t] = fmaf(tr[s], GL[s * 33 + t], tr[t]);
                    if (lane < 16) {
#pragma unroll
                        for (int t = 0; t < 16; ++t) TL[lane * 17 + t] = tr[t]; }
                    { const int s = lane & 15, q = lane >> 4; float x0 = 0.f, x1 = 0.f, x2 = 0.f, x3 = 0.f;
#pragma unroll
                      for (int u = 1; u < 16; ++u) { const float l = (u > s) ? GL[(16 + s) * 33 + u] : 0.f; x0 = fmaf(l, TL[u * 17 + 4 * q], x0); x1 = fmaf(l, TL[u * 17 + 4 * q + 1], x1); x2 = fmaf(l, TL[u * 17 + 4 * q + 2], x2); x3 = fmaf(l, TL[u * 17 + 4 * q + 3], x3); }
                      XM[s * 17 + 4 * q] = x0; XM[s * 17 + 4 * q + 1] = x1; XM[s * 17 + 4 * q + 2] = x2; XM[s * 17 + 4 * q + 3] = x3; }
                    float atT[16];
#pragma unroll
                    for (int sp = 0; sp < 16; ++sp) { float acc = 0.f;
#pragma unroll
                        for (int s = 0; s <= sp; ++s) acc = fmaf(at[s], TL[s * 17 + sp], acc);
                        atT[sp] = acc; }
                    unsigned char* rec = CH_REC + (size_t)task * CH_RB;
                    ((float*)rec)[lane] = gam;
                    LAS unsigned short* ST = (LAS unsigned short*)XL;
                    const int kpos = (lane & ~15) + 8 * ((lane >> 2) & 1) + (lane & 3) + 4 * ((lane >> 3) & 1);
                    float zz[16];
#pragma unroll
                    for (int s = 0; s < 16; ++s) { float acc = kt[s] * gam;
#pragma unroll
                        for (int sp = s + 1; sp < 16; ++sp) acc = fmaf(XM[s * 17 + sp], bt[sp] * gam, acc);
                        zz[s] = acc; }
#pragma unroll
                    for (int t = 0; t < 16; ++t) { float acc = rt[t];
#pragma unroll
                        for (int s = 0; s <= t; ++s) acc = fmaf(atT[s], GL[s * 33 + 16 + t], acc);
                        ST[t * 64 + kpos] = (unsigned short)f2bf(atT[t]); ST[(16 + t) * 64 + kpos] = (unsigned short)f2bf(acc); }
                    { v4u w0, w1;
                      w0.x = pk2(bt[0] * gam, bt[1] * gam); w0.y = pk2(bt[2] * gam, bt[3] * gam); w0.z = pk2(bt[8] * gam, bt[9] * gam); w0.w = pk2(bt[10] * gam, bt[11] * gam);
                      w1.x = pk2(bt[4] * gam, bt[5] * gam); w1.y = pk2(bt[6] * gam, bt[7] * gam); w1.z = pk2(bt[12] * gam, bt[13] * gam); w1.w = pk2(bt[14] * gam, bt[15] * gam);
                      v4u* d = (v4u*)(rec + 4352 + lane * 32); d[0] = w0; d[1] = w1;
                      v4u z0, z1; z0.x = pk2(zz[0], zz[1]); z0.y = pk2(zz[2], zz[3]); z0.z = pk2(zz[4], zz[5]); z0.w = pk2(zz[6], zz[7]);
                      z1.x = pk2(zz[8], zz[9]); z1.y = pk2(zz[10], zz[11]); z1.z = pk2(zz[12], zz[13]); z1.w = pk2(zz[14], zz[15]);
                      v4u* dz = (v4u*)(rec + 6400 + lane * 32); dz[0] = z0; dz[1] = z1; }
                    { float vs[16];
#pragma unroll
                      for (int s = 0; s < 16; ++s) vs[s] = vsv[s];
                      v4u a0, a1; a0.x = pk2(vs[0], vs[1]); a0.y = pk2(vs[2], vs[3]); a0.z = pk2(vs[4], vs[5]); a0.w = pk2(vs[6], vs[7]);
                      a1.x = pk2(vs[8], vs[9]); a1.y = pk2(vs[10], vs[11]); a1.z = pk2(vs[12], vs[13]); a1.w = pk2(vs[14], vs[15]);
                      v4u* dv = (v4u*)(rec + 8448 + lane * 32); dv[0] = a0; dv[1] = a1; }
                    { const int s = lane & 15, q = lane >> 4;
#pragma unroll
                      for (int e = 0; e < 4; ++e) { const int t = 4 * q + e; float acc = (t >= s) ? GL[(16 + s) * 33 + 16 + t] : 0.f;
#pragma unroll
                          for (int sp = 1; sp < 16; ++sp) { const float m = (sp <= t) ? GL[sp * 33 + 16 + t] : 0.f; acc = fmaf(XM[s * 17 + sp], m, acc); }
                          ((unsigned short*)(rec + 10496))[t * 16 + s] = (unsigned short)f2bf(acc); } }
                    LDS_WAIT();
                    { const LAS v4u* sv = (const LAS v4u*)ST + lane; v4u* d = (v4u*)(rec + 256) + lane;
#pragma unroll
                      for (int i = 0; i < 4; ++i) d[64 * i] = sv[64 * i]; }
                    LDS_WAIT();
                    if (ch == 0) {
                        asm volatile("s_waitcnt vmcnt(0)" ::: "memory");
                        const v4u* src = (const v4u*)rec;
#pragma unroll 1
                        for (int i = lane; i < CH_RB / 16; i += 64) { const v4u w = src[i];
#pragma unroll
                            for (int cp = 1; cp < 4; ++cp) ((v4u*)(CH_REC + (size_t)((bh + 4 * cp) * 257) * CH_RB))[i] = w; }
                    }
                }
            }
            SEAM(pb + 2);
        }
        for (int rep_ = 0; rep_ < NREP(3); ++rep_) if (EN(3) && IN(pb + 3)) { PH_TID;
#define PK8(T, o) ((v4u){attn_body::cvtpk_s(T[o], T[o + 1]), attn_body::cvtpk_s(T[o + 2], T[o + 3]), attn_body::cvtpk_s(T[o + 4], T[o + 5]), attn_body::cvtpk_s(T[o + 6], T[o + 7])})
            for (int rep2_ = 0; rep2_ < NREP(13); ++rep2_)
            if (bx < 32) {
                typedef attn_body::bf16x8 bfx8; typedef attn_body::f32x16 fx16;
                const int bh = bx >> 1, vh = bx & 1, n = lane & 31, hh = lane >> 5;
                const unsigned char* rec0 = CH_REC + (size_t)(bh * 257) * CH_RB;
                const unsigned lds0 = (unsigned)(uintptr_t)lds_raw;
                constexpr int RBUF = 6 * CH_RB;
#define S2_ISSUE(rnd) do { if (wave >= 1 && wave <= 6) { const int c_ = 6 * (rnd) + wave - 1; if (c_ < 257) { const unsigned dst_ = lds0 + ((rnd) & 1) * RBUF + (wave - 1) * CH_RB; \
                    for (int p_ = 0; p_ < 11; ++p_) attn_body::glds16s(rec0 + (size_t)c_ * CH_RB + p_ * 1024, (unsigned)lane * 16u, (unsigned)__builtin_amdgcn_readfirstlane(dst_ + p_ * 1024)); } } } while (0)
                S2_ISSUE(0);
                asm volatile("s_waitcnt vmcnt(0)\n\ts_barrier" ::: "memory");
                v4u* spk = (v4u*)(CH_SPK + (size_t)(bh * 257) * 8192 + vh * 4096) + lane;
                fx16 st0 = fx16{}, st1 = fx16{};
                for (int rnd = 0; rnd < 43; ++rnd) {
                    S2_ISSUE(rnd + 1);
                    if (wave == 0) {
                        v4u atf[4], bhf[2], ztf[2], vtf; f32x4 gq[8];
#define S2_FRAGS(j_) do { const LAS unsigned char* r_ = lds + (rnd & 1) * RBUF + (j_) * CH_RB; \
                            _Pragma("unroll") for (int ks = 0; ks < 4; ++ks) atf[ks] = *(const LAS v4u*)(r_ + 256 + ((lane & 15) * 64 + 16 * ks + 8 * hh) * 2); \
                            _Pragma("unroll") for (int i = 0; i < 2; ++i) { bhf[i] = *(const LAS v4u*)(r_ + 4352 + ((32 * i + n) * 16 + 8 * hh) * 2); ztf[i] = *(const LAS v4u*)(r_ + 6400 + ((32 * i + n) * 16 + 8 * hh) * 2); } \
                            vtf = *(const LAS v4u*)(r_ + 8448 + ((32 * vh + n) * 16 + 8 * hh) * 2); \
                            _Pragma("unroll") for (int i = 0; i < 2; ++i) _Pragma("unroll") for (int q = 0; q < 4; ++q) gq[4 * i + q] = *(const LAS f32x4*)(r_ + (32 * i + 8 * q + 4 * hh) * 4); } while (0)
                        S2_FRAGS(0);
                        for (int j = 0; j < 6; ++j) { const int ch = 6 * rnd + j; if (ch >= 257) break;
                            const v4u a0 = atf[0], a1 = atf[1], a2 = atf[2], a3 = atf[3], b0 = bhf[0], b1 = bhf[1], z0 = ztf[0], z1 = ztf[1], vt = vtf;
                            f32x4 g_[8];
#pragma unroll
                            for (int i = 0; i < 8; ++i) g_[i] = gq[i];
                            if (j < 5) S2_FRAGS(j + 1);
                            const v4u s0 = PK8(st0, 0), s1 = PK8(st0, 8), s2 = PK8(st1, 0), s3 = PK8(st1, 8);
                            spk[(size_t)ch * 512 + 0] = s0; spk[(size_t)ch * 512 + 64] = s1; spk[(size_t)ch * 512 + 128] = s2; spk[(size_t)ch * 512 + 192] = s3;
                            fx16 pt = fx16{};
                            pt = __builtin_amdgcn_mfma_f32_32x32x16_bf16(__builtin_bit_cast(bfx8, a0), __builtin_bit_cast(bfx8, s0), pt, 0, 0, 0);
                            pt = __builtin_amdgcn_mfma_f32_32x32x16_bf16(__builtin_bit_cast(bfx8, a1), __builtin_bit_cast(bfx8, s1), pt, 0, 0, 0);
                            pt = __builtin_amdgcn_mfma_f32_32x32x16_bf16(__builtin_bit_cast(bfx8, a2), __builtin_bit_cast(bfx8, s2), pt, 0, 0, 0);
                            pt = __builtin_amdgcn_mfma_f32_32x32x16_bf16(__builtin_bit_cast(bfx8, a3), __builtin_bit_cast(bfx8, s3), pt, 0, 0, 0);
#pragma unroll
                            for (int q = 0; q < 4; ++q) { st0[4 * q] *= g_[q].x; st0[4 * q + 1] *= g_[q].y; st0[4 * q + 2] *= g_[q].z; st0[4 * q + 3] *= g_[q].w;
                                                          st1[4 * q] *= g_[4 + q].x; st1[4 * q + 1] *= g_[4 + q].y; st1[4 * q + 2] *= g_[4 + q].z; st1[4 * q + 3] *= g_[4 + q].w; }
                            st0 = __builtin_amdgcn_mfma_f32_32x32x16_bf16(__builtin_bit_cast(bfx8, z0), __builtin_bit_cast(bfx8, vt), st0, 0, 0, 0);
                            st1 = __builtin_amdgcn_mfma_f32_32x32x16_bf16(__builtin_bit_cast(bfx8, z1), __builtin_bit_cast(bfx8, vt), st1, 0, 0, 0);
                            const v4u pp = PK8(pt, 0);
                            st0 = __builtin_amdgcn_mfma_f32_32x32x16_bf16(__builtin_bit_cast(bfx8, b0), __builtin_bit_cast(bfx8, pp), st0, 0, 0, 0);
                            st1 = __builtin_amdgcn_mfma_f32_32x32x16_bf16(__builtin_bit_cast(bfx8, b1), __builtin_bit_cast(bfx8, pp), st1, 0, 0, 0);
                        }
#undef S2_FRAGS
                        asm volatile("s_waitcnt lgkmcnt(0)\n\ts_barrier" ::: "memory");
                    } else asm volatile("s_waitcnt vmcnt(0) lgkmcnt(0)\n\ts_barrier" ::: "memory");
                }
#undef S2_ISSUE
            }
            __syncthreads();
            for (int rep2_ = 0; rep2_ < NREP(12); ++rep2_)
            { const attn_body::AttnTensors AT{(const attn_body::bf16*)QN, (const attn_body::bf16*)KP, (const attn_body::bf16*)VP, (attn_body::bf16*)OC};
              const attn_body::QueueOrder SO{(unsigned*)(ctl + CW_ATTQ + (layer * 8 + (bx & 7)) * 64), (LAS unsigned*)(lds + MISC_OFF + 64), bx & 7, tid};
              attn_body::attn_phase<attn_body::QueueOrder>((char*)lds_raw, AT, SO, tid); }
            __syncthreads();
#ifndef NO_META
            {
                LAS float* sc = (LAS float*)(lds + wave * 1024); LAS float* qs = sc + 64;
                for (int task = gw; task < NMETA * 8; task += NGW) {
                    const int row = NREAL + (task >> 3), hc = task & 7, h = hc >> 1; const int n = row - NREAL + 1;
                    qs[lane] = bf2f(QN[(size_t)row * 512 + hc * 64 + lane]);
                    float m = -INFINITY;
                    { const int idx = lane;
                        if (idx < n) { const size_t kr = 48 + idx; const v4u* kp = (const v4u*)(KP + kr * 512 + hc * 64); float dot = 0.f;
#pragma unroll
                            for (int c8 = 0; c8 < 8; ++c8) { const v4u kv = kp[c8];
                                dot += qs[c8 * 8 + 0] * __uint_as_float(kv.x << 16) + qs[c8 * 8 + 1] * __uint_as_float(kv.x & 0xffff0000u) + qs[c8 * 8 + 2] * __uint_as_float(kv.y << 16) + qs[c8 * 8 + 3] * __uint_as_float(kv.y & 0xffff0000u)
                                     + qs[c8 * 8 + 4] * __uint_as_float(kv.z << 16) + qs[c8 * 8 + 5] * __uint_as_float(kv.z & 0xffff0000u) + qs[c8 * 8 + 6] * __uint_as_float(kv.w << 16) + qs[c8 * 8 + 7] * __uint_as_float(kv.w & 0xffff0000u); }
                            sc[idx] = dot; m = dot; } }
                    m = wave_max(m);
                    float l = 0.f;
                    if (lane < n) { const float p = __builtin_amdgcn_exp2f(sc[lane] - m); sc[lane] = p; l = p; }
                    l = wave_sum(l);
                    float o0 = 0.f, o1 = 0.f;
                    for (int idx = 0; idx < n; ++idx) { const float p = sc[idx]; const size_t vr = 48 + idx;
                        const unsigned v2 = *(const unsigned*)(VP + vr * 512 + h * 128 + 2 * lane); o0 += p * __uint_as_float(v2 << 16); o1 += p * __uint_as_float(v2 & 0xffff0000u); }
                    const float inv = 1.f / l;
                    *(unsigned*)(OC + (size_t)row * 1024 + hc * 128 + 2 * lane) = pk2(o0 * inv, o1 * inv);
                    LDS_WAIT();
                }
            }
#endif
            SEAM(pb + 3);
        }
        for (int rep_ = 0; rep_ < NREP(4); ++rep_) if (EN(4) && IN(pb + 4)) { PH_TID;
            const float* gn_g = INP(13) + layer * 256; const float* gn_b = INP(14) + layer * 256; const float* subg = INP(21) + layer * 128;
            const float s1 = wave_sum(INP(17)[layer * 64 + lane] * INP(18)[layer * 64 + lane]); const float s2 = wave_sum(INP(19)[layer * 64 + lane] * INP(20)[layer * 64 + lane]);
            const float lam = __expf(s1) - __expf(s2) + lam_init;
            const int ngrp = (1025 - bx + 255) / 256, nrows = 16 * ngrp;
            {
                typedef attn_body::bf16x8 bfx8; typedef attn_body::f32x16 fx16;
                const int n = lane & 31, hh = lane >> 5;
                for (int lt = wave; lt < 8 * ngrp; lt += NWAVES) {
                    const int g = bx + 256 * (lt >> 3), hd = (lt >> 1) & 3, vh = lt & 1; const int bh = g < 1024 ? (g >> 8) * 4 + hd : hd, ch = g < 1024 ? (g & 255) + 1 : 0;
                    const int ct = bh * 257 + ch, b = bh >> 2, cb = (bh & 3) * 64; const int rowbase = ch == 0 ? NREAL : b * SEQ + 16 * (ch - 1);
                    const unsigned char* r_ = CH_REC + (size_t)ct * CH_RB; const v4u* spk = (const v4u*)(CH_SPK + (size_t)ct * 8192 + vh * 4096) + lane;
                    fx16 y = fx16{};
#pragma unroll
                    for (int ks = 0; ks < 4; ++ks) { const v4u a = *(const v4u*)(r_ + 2304 + ((lane & 15) * 64 + 16 * ks + 8 * hh) * 2); const v4u s = spk[64 * ks];
                        y = __builtin_amdgcn_mfma_f32_32x32x16_bf16(__builtin_bit_cast(bfx8, a), __builtin_bit_cast(bfx8, s), y, 0, 0, 0); }
                    { const v4u a = *(const v4u*)(r_ + 10496 + ((lane & 15) * 16 + 8 * hh) * 2); const v4u vt = *(const v4u*)(r_ + 8448 + ((32 * vh + n) * 16 + 8 * hh) * 2);
                      y = __builtin_amdgcn_mfma_f32_32x32x16_bf16(__builtin_bit_cast(bfx8, a), __builtin_bit_cast(bfx8, vt), y, 0, 0, 0); }
                    {
#pragma unroll
                        for (int r = 0; r < 8; ++r) SY[(size_t)(rowbase + (r & 3) + 8 * (r >> 2) + 4 * hh) * 256 + cb + 32 * vh + n] = y[r]; }
                }
            }
#undef PK8
            asm volatile("s_waitcnt vmcnt(0)" ::: "memory");
            __syncthreads();
            for (int idx = wave; idx < nrows; idx += NWAVES) { const int row = MP_ROW(idx);
                { const f32x4 y = *(const f32x4*)(SY + (size_t)row * 256 + 4 * lane); const float mean = sum16((y.x + y.y) + (y.z + y.w)) * (1.f / 64.f);
                  const f32x4 dlt = y - mean; const float var = sum16((dlt.x * dlt.x + dlt.y * dlt.y) + (dlt.z * dlt.z + dlt.w * dlt.w)) * (1.f / 64.f); const float rs = 1.f / sqrtf(var + 64e-5f);
                  const f32x4 gg = *(const f32x4*)(gn_g + 4 * lane), gb = *(const f32x4*)(gn_b + 4 * lane), bon = *(const f32x4*)(SBON + (size_t)row * 256 + 4 * lane), gt = *(const f32x4*)(SG + (size_t)row * 256 + 4 * lane);
                  const f32x4 o = (dlt * rs * gg + gb + bon) * gt;
                  *(unsigned long long*)(OMIX + (size_t)row * DM + 4 * lane) = (unsigned long long)pk2(o.x, o.y) | ((unsigned long long)pk2(o.z, o.w) << 32); }
                { const int h = lane >> 4, j8 = (lane & 15) * 8; const v4u a0 = *(const v4u*)(OC + (size_t)row * 1024 + (h * 2 + 0) * 128 + j8), a1 = *(const v4u*)(OC + (size_t)row * 1024 + (h * 2 + 1) * 128 + j8);
                  float dv[8];
                  dv[0] = __uint_as_float(a0.x << 16) - lam * __uint_as_float(a1.x << 16); dv[1] = __uint_as_float(a0.x & 0xffff0000u) - lam * __uint_as_float(a1.x & 0xffff0000u);
                  dv[2] = __uint_as_float(a0.y << 16) - lam * __uint_as_float(a1.y << 16); dv[3] = __uint_as_float(a0.y & 0xffff0000u) - lam * __uint_as_float(a1.y & 0xffff0000u);
                  dv[4] = __uint_as_float(a0.z << 16) - lam * __uint_as_float(a1.z << 16); dv[5] = __uint_as_float(a0.z & 0xffff0000u) - lam * __uint_as_float(a1.z & 0xffff0000u);
                  dv[6] = __uint_as_float(a0.w << 16) - lam * __uint_as_float(a1.w << 16); dv[7] = __uint_as_float(a0.w & 0xffff0000u) - lam * __uint_as_float(a1.w & 0xffff0000u);
                  float ss = 0.f;
#pragma unroll
                  for (int i = 0; i < 8; ++i) ss += dv[i] * dv[i];
                  ss = sum16(ss); const float sc_ = (1.f / sqrtf(ss * (1.f / 128.f) + 1e-5f)) * (1.f - lam_init);
                  const f32x4 g0 = *(const f32x4*)(subg + j8), g1 = *(const f32x4*)(subg + j8 + 4);
                  v4u o; o.x = pk2(dv[0] * sc_ * g0.x, dv[1] * sc_ * g0.y); o.y = pk2(dv[2] * sc_ * g0.z, dv[3] * sc_ * g0.w); o.z = pk2(dv[4] * sc_ * g1.x, dv[5] * sc_ * g1.y); o.w = pk2(dv[6] * sc_ * g1.z, dv[7] * sc_ * g1.w);
                  *(v4u*)(OMIX + (size_t)row * DM + 256 + h * 128 + j8) = o; }
            }
            { const int gt = bx * (NWAVES * 64) + tid, NGT = G * NWAVES * 64;
              for (int i = gt; i < (MPAD - NTOK) * (DM / 8); i += NGT) ((v4u*)(OMIX + (size_t)NTOK * DM))[i] = zero_v4u(); }
            SEAM(pb + 4);
        }
        if (EN(5) && IN(pb + 5)) { PH_TID;
            pg8::Gemm g{OMIX, (const bf16*)(ws + WS_WOUT) + (size_t)layer * DM * DM, NREAL, DM, DM}; pg8::StaticOrder S; S.init(NREAL, DM, G, bx);
            if (!moe) {
                if (layer == 2) {
                    meta_gemm_res(OMIX + (size_t)NREAL * DM, DM, (const bf16*)(ws + WS_WOUT) + (size_t)layer * DM * DM, Hf + (size_t)NREAL * DM, lds, bx, wave, lane, 2, (bf16*)((unsigned char*)HB + (size_t)NREAL * DM), RSQA + NREAL);
                    typedef pg8::EpiResAddHB<2, (long long)WS_HB - (long long)WS_H, (long long)WS_RSROW - (long long)WS_H> EpiHB2; EpiHB2 E{Hf, DM, 1.f};
                    pg8::gemm_phase<EpiHB2, pg8::StaticOrder, true, true>(lds, g, S, E, tid);
                } else {
                    meta_gemm_res(OMIX + (size_t)NREAL * DM, DM, (const bf16*)(ws + WS_WOUT) + (size_t)layer * DM * DM, Hf + (size_t)NREAL * DM, lds, bx, wave, lane, 1, HB + (size_t)NREAL * DM, RSQA + NREAL);
                    typedef pg8::EpiResAddHB<1, (long long)WS_HB - (long long)WS_H, (long long)WS_RSROW - (long long)WS_H> EpiHB1; EpiHB1 E{Hf, DM, 1.f};
                    pg8::gemm_phase<EpiHB1, pg8::StaticOrder, true, true>(lds, g, S, E, tid);
                }
            } else {
                meta_gemm_res(OMIX + (size_t)NREAL * DM, DM, (const bf16*)(ws + WS_WOUT) + (size_t)layer * DM * DM, Hf + (size_t)NREAL * DM, lds, bx, wave, lane);
                pg8::EpiResAdd E{Hf, DM, 1.f};
                pg8::gemm_phase<pg8::EpiResAdd, pg8::StaticOrder, true, true>(lds, g, S, E, tid);
            }
            SEAM(pb + 5);
        }
        if (EN(6) && IN(pb + 6) && moe) { PH_TID;
            LAS int* lcnt = (LAS int*)lds; LAS int* lbase = lcnt + 8; LAS int* lrow = lcnt + 16;
            if (tid < 16) lcnt[tid] = 0;
            __syncthreads();
            const float* gff = INP(24) + layer * DM; const float* Wr = INP(28) + (size_t)jj * DM * NE;
            for (int i = wave; i < 72; i += NWAVES) { const int row = bx + G * i;
                if (row < NTOK) {
                    const GAS f32x4* xr = (const GAS f32x4*)(Hf + (size_t)row * DM) + lane; f32x4 v[4]; float s = 0.f;
#pragma unroll
                    for (int j = 0; j < 4; ++j) { v[j] = xr[64 * j]; s += (v[j].x * v[j].x + v[j].y * v[j].y) + (v[j].z * v[j].z + v[j].w * v[j].w); }
                    s = wave_sum(s); const float rstd = 1.f / sqrtf(s * (1.f / DM) + 1e-6f);
                    if (moe) { LAS unsigned* o4 = (LAS unsigned*)(lds + 4096 + i * 1024) + lane; const float sn = rstd * A8_SCALE;
#pragma unroll
                      for (int j = 0; j < 4; ++j) o4[64 * j] = pk4_fp8(v[j].x * sn, v[j].y * sn, v[j].z * sn, v[j].w * sn); }
                    else if (layer == 2) { GAS unsigned* o4 = (GAS unsigned*)((GAS unsigned char*)HB + (size_t)row * DM) + lane; const float sn = rstd * A8_SCALE;
#pragma unroll
                      for (int j = 0; j < 4; ++j) o4[64 * j] = pk4_fp8(v[j].x * sn, v[j].y * sn, v[j].z * sn, v[j].w * sn); }
                    else { GAS unsigned long long* o8 = (GAS unsigned long long*)(HB + (size_t)row * DM) + lane;
#pragma unroll
                      for (int j = 0; j < 4; ++j) o8[64 * j] = (unsigned long long)pk2(v[j].x, v[j].y) | ((unsigned long long)pk2(v[j].z, v[j].w) << 32); }
                    if (lane == 0) RSTD[row] = rstd;
                    if (moe) {
                        float lg[8];
#pragma unroll
                        for (int e = 0; e < 8; ++e) lg[e] = 0.f;
#pragma unroll
                        for (int j = 0; j < 4; ++j) { const int k0 = 4 * lane + 256 * j; const f32x4 gv = *(const f32x4*)(gff + k0);
#pragma unroll
                            for (int q = 0; q < 4; ++q) { const float hv = v[j][q] * gv[q]; const f32x4 wa = *(const f32x4*)(Wr + (size_t)(k0 + q) * 8), wb = *(const f32x4*)(Wr + (size_t)(k0 + q) * 8 + 4);
                                lg[0] += hv * wa.x; lg[1] += hv * wa.y; lg[2] += hv * wa.z; lg[3] += hv * wa.w; lg[4] += hv * wb.x; lg[5] += hv * wb.y; lg[6] += hv * wb.z; lg[7] += hv * wb.w; } }
#pragma unroll
                        for (int e = 0; e < 8; ++e) lg[e] = wave_sum(lg[e]) * rstd;
                        int e1 = 0; float l1 = lg[0];
#pragma unroll
                        for (int e = 1; e < 8; ++e) if (lg[e] > l1) { l1 = lg[e]; e1 = e; }
                        int e2 = -1; float l2 = -INFINITY;
#pragma unroll
                        for (int e = 0; e < 8; ++e) if (e != e1 && lg[e] > l2) { l2 = lg[e]; e2 = e; }
                        if (lane == 0) { const float g2 = 1.f / (1.f + __expf(l1 - l2)); const float g1 = 1.f - g2;
                            const int sl1 = atomicAdd((int*)&lcnt[e1], 1), sl2 = atomicAdd((int*)&lcnt[e2], 1);
                            lrow[i * 4 + 0] = e1; lrow[i * 4 + 1] = sl1; lrow[i * 4 + 2] = e2; lrow[i * 4 + 3] = sl2;
                            TOKG[row * 2 + 0] = g1; TOKG[row * 2 + 1] = g2; }
                    }
                }
            }
            if (moe) {
                __syncthreads();
                if (tid < 8) lbase[tid] = (int)__hip_atomic_fetch_add((unsigned*)(ctl + CW_MOECNT + 64 * jj + tid), (unsigned)lcnt[tid], RLX_AGENT);
                __syncthreads();
                if (tid < 72) { const int row = bx + G * tid; if (row < NTOK) { const int e1 = lrow[tid * 4 + 0], e2 = lrow[tid * 4 + 2];
                    TOKE[row * 2 + 0] = e1; TOKE[row * 2 + 1] = e2; TOKS[row * 2 + 0] = lbase[e1] + lrow[tid * 4 + 1]; TOKS[row * 2 + 1] = lbase[e2] + lrow[tid * 4 + 3]; } }
                __syncthreads();
            }
            SEAM(pb + 6);
        }
        if (!moe) {
            for (int rep_ = 0; rep_ < NREP(7); ++rep_) if (EN(7) && IN(pb + 7)) { PH_TID;
                pg8::StaticOrder S; S.init(MPAD, FF2, G, bx);
                if (layer == 2) { pg8::Gemm g{HB, (const bf16*)(ws + WS_WGU) + (size_t)jj * FF2 * DM, MPAD, FF2, DM / 2}; pg8::EpiSwiglu8 E{GB, FF, nullptr, 1.f / (W8_SCALE * H8_SCALE), G8_SCALE, RSQA};
                    pg8::gemm_phase<pg8::EpiSwiglu8, pg8::StaticOrder, true, true, true>(lds, g, S, E, tid); }
                else { pg8::Gemm g{HB, (const bf16*)(ws + WS_WGU) + (size_t)jj * FF2 * DM, MPAD, FF2, DM}; pg8::EpiSwiglu E{GB, FF, nullptr, 1.f, 0.f, RSQA};
                    pg8::gemm_phase<pg8::EpiSwiglu, pg8::StaticOrder, true, true>(lds, g, S, E, tid); }
                SEAM(pb + 7);
            }
            if (EN(8) && IN(pb + 8)) { PH_TID;
                pg8::StaticOrder S; S.init(NREAL, DM, G, bx);
                if (layer == 2) {
                    meta_gemm_res8((const unsigned char*)GB + (size_t)NREAL * FF, FF, (const unsigned char*)((const bf16*)(ws + WS_WD) + (size_t)jj * DM * FF), Hf + (size_t)NREAL * DM, 1.f / (W8_SCALE * G8_SCALE), lds, bx, wave, lane);
                    pg8::Gemm g{GB, (const bf16*)(ws + WS_WD) + (size_t)jj * DM * FF, NREAL, DM, FF / 2}; pg8::EpiResAdd E{Hf, DM, 1.f / (W8_SCALE * G8_SCALE)};
                    pg8::gemm_phase<pg8::EpiResAdd, pg8::StaticOrder, true, true, true>(lds, g, S, E, tid);
                } else {
                    meta_gemm_res(GB + (size_t)NREAL * FF, FF, (const bf16*)(ws + WS_WD) + (size_t)jj * DM * FF, Hf + (size_t)NREAL * DM, lds, bx, wave, lane);
                    pg8::Gemm g{GB, (const bf16*)(ws + WS_WD) + (size_t)jj * DM * FF, NREAL, DM, FF}; pg8::EpiResAdd E{Hf, DM, 1.f};
                    pg8::gemm_phase<pg8::EpiResAdd, pg8::StaticOrder, true, true>(lds, g, S, E, tid);
                }
                SEAM(pb + 8);
            }
        } else {
#define cnt ((const int*)(ctl + CW_MOECNT + 64 * jj))
            for (int rep_ = 0; rep_ < NREP(7); ++rep_) if (EN(7) && IN(pb + 7)) { PH_TID;
                int ts[8]; { int a = 0;
#pragma unroll
                    for (int e = 0; e < 8; ++e) { ts[e] = a; a += (__hip_atomic_load(cnt + e, RLX_AGENT) + 255) >> 8; } }
                { LAS const int* lbase = (LAS const int*)lds + 8; LAS const int* lrow = (LAS const int*)lds + 16;
                  for (int i = wave; i < 72; i += NWAVES) { const int row = bx + G * i;
                      if (row < NTOK) { const v4u d = *(const LAS v4u*)(lds + 4096 + i * 1024 + lane * 16);
#pragma unroll
                          for (int c = 0; c < 2; ++c) { const int e = lrow[i * 4 + 2 * c]; int tse = 0, lb = 0;
#pragma unroll
                              for (int x = 0; x < 8; ++x) { tse = (e == x) ? ts[x] : tse; lb = (e == x) ? lbase[x] : lb; }
                              const size_t p = (size_t)tse * 256 + lb + lrow[i * 4 + 2 * c + 1];
                              ((v4u*)((unsigned char*)AROWS + p * DM))[lane] = d; } } } }
                SEAM(pb + 7);
            }
            for (int rep_ = 0; rep_ < NREP(8); ++rep_) if (EN(8) && IN(pb + 8)) { PH_TID;
                pg8::Gemm g{AROWS, (const bf16*)(ws + WS_MWGU), MOEP, FF2, DM / 2}; pg8::MoeOrder S; S.init(cnt, FF2 / 256, G, bx);
                pg8::EpiSwiglu8 E{GB, FF, nullptr, 1.f / (W8_SCALE * A8_SCALE), G8_SCALE};
                pg8::gemm_phase<pg8::EpiSwiglu8, pg8::MoeOrder, true, true, true>(lds, g, S, E, tid);
                SEAM(pb + 8);
            }
            for (int rep_ = 0; rep_ < NREP(9); ++rep_) if (EN(9) && IN(pb + 9)) { PH_TID;
                pg8::Gemm g{GB, (const bf16*)(ws + WS_MWD), MOEP, DM, FF / 2}; pg8::MoeOrder S; S.init(cnt, DM / 256, G, bx);
                pg8::EpiBf16Rs E{YM, DM, nullptr, 1.f / (W8_SCALE * G8_SCALE)};
                pg8::gemm_phase<pg8::EpiBf16Rs, pg8::MoeOrder, true, true, true>(lds, g, S, E, tid);
                SEAM(pb + 9);
            }
            if (EN(10) && IN(pb + 10)) { PH_TID;
                int ts[8]; { int a = 0;
#pragma unroll
                    for (int e = 0; e < 8; ++e) { ts[e] = a; a += (__hip_atomic_load(cnt + e, RLX_AGENT) + 255) >> 8; } }
                for (int row = gw; row < NTOK; row += NGW) {
                    const int e1 = TOKE[row * 2], e2 = TOKE[row * 2 + 1]; int t1 = 0, t2 = 0;
#pragma unroll
                    for (int q = 0; q < 8; ++q) { t1 = (e1 == q) ? ts[q] : t1; t2 = (e2 == q) ? ts[q] : t2; }
                    const size_t p1 = (size_t)t1 * 256 + TOKS[row * 2], p2 = (size_t)t2 * 256 + TOKS[row * 2 + 1]; const float g1 = TOKG[row * 2], g2 = TOKG[row * 2 + 1];
                    float* hr = Hf + (size_t)row * DM; f32x4 hv[2][2]; float ssq = 0.f;
#pragma unroll
                    for (int j = 0; j < 2; ++j) { const int c8 = (lane + 64 * j) * 8; const v4u y1 = *(const v4u*)(YM + p1 * DM + c8), y2 = *(const v4u*)(YM + p2 * DM + c8);
                        f32x4 ha = *(f32x4*)(hr + c8), hb2 = *(f32x4*)(hr + c8 + 4);
                        ha.x += g1 * __uint_as_float(y1.x << 16) + g2 * __uint_as_float(y2.x << 16); ha.y += g1 * __uint_as_float(y1.x & 0xffff0000u) + g2 * __uint_as_float(y2.x & 0xffff0000u);
                        ha.z += g1 * __uint_as_float(y1.y << 16) + g2 * __uint_as_float(y2.y << 16); ha.w += g1 * __uint_as_float(y1.y & 0xffff0000u) + g2 * __uint_as_float(y2.y & 0xffff0000u);
                        hb2.x += g1 * __uint_as_float(y1.z << 16) + g2 * __uint_as_float(y2.z << 16); hb2.y += g1 * __uint_as_float(y1.z & 0xffff0000u) + g2 * __uint_as_float(y2.z & 0xffff0000u);
                        hb2.z += g1 * __uint_as_float(y1.w << 16) + g2 * __uint_as_float(y2.w << 16); hb2.w += g1 * __uint_as_float(y1.w & 0xffff0000u) + g2 * __uint_as_float(y2.w & 0xffff0000u);
                        hv[j][0] = ha; hv[j][1] = hb2; ssq += (ha.x * ha.x + ha.y * ha.y) + (ha.z * ha.z + ha.w * ha.w) + (hb2.x * hb2.x + hb2.y * hb2.y) + (hb2.z * hb2.z + hb2.w * hb2.w); }
                    if (layer == DEPTH - 1) {
                        if (row < NREAL) { float* orow = (*(float* const*)(ka + 256)) + (size_t)row * DM;
#pragma unroll
                            for (int j = 0; j < 2; ++j) { const int c8 = (lane + 64 * j) * 8; *(f32x4*)(orow + c8) = hv[j][0]; *(f32x4*)(orow + c8 + 4) = hv[j][1]; } }
                    } else {
                        ssq = wave_sum(ssq); const float rstd = 1.f / sqrtf(ssq * (1.f / DM) + 1e-6f), sn = rstd * A8_SCALE;
#pragma unroll
                        for (int j = 0; j < 2; ++j) { const int c8 = (lane + 64 * j) * 8; *(f32x4*)(hr + c8) = hv[j][0]; *(f32x4*)(hr + c8 + 4) = hv[j][1];
                            if ((INP8 >> (layer + 1)) & 1) { const unsigned lo = pk4_fp8(hv[j][0].x * sn, hv[j][0].y * sn, hv[j][0].z * sn, hv[j][0].w * sn), hi8 = pk4_fp8(hv[j][1].x * sn, hv[j][1].y * sn, hv[j][1].z * sn, hv[j][1].w * sn);
                                *(unsigned long long*)((unsigned char*)HB + (size_t)row * DM + c8) = (unsigned long long)lo | ((unsigned long long)hi8 << 32); }
                            else { v4u w; w.x = pk2(hv[j][0].x, hv[j][0].y); w.y = pk2(hv[j][0].z, hv[j][0].w); w.z = pk2(hv[j][1].x, hv[j][1].y); w.w = pk2(hv[j][1].z, hv[j][1].w);
                                *(v4u*)(HB + (size_t)row * DM + c8) = w; } }
                        if (lane == 0) RSTD[row] = rstd;
                    }
                }
                SEAM(pb + 10);
            }
        }
    }
#ifdef UBENCH
    if (hi >= 48 && bx == 255) { PH_TID;
        float x = (float)lane * 1e-3f, y = 1.0001f; float acc = 0.f;
        for (int it = 0; it < UBENCH_ITERS; ++it) {
#if UBENCH == 1
#pragma unroll
            for (int k = 0; k < 64; ++k) { asm volatile("v_fma_f32 %0, %0, %1, %0" : "+v"(x) : "v"(y)); }
#elif UBENCH == 2
#pragma unroll
            for (int k = 0; k < 64; ++k) { asm volatile("s_nop 1\n\tv_add_f32_dpp %0, %0, %0 row_mirror row_mask:0xf bank_mask:0xf bound_ctrl:1" : "+v"(x)); }
#elif UBENCH == 3
#pragma unroll
            for (int k = 0; k < 32; ++k) { asm volatile("s_nop 0\n\tv_readlane_b32 s20, %0, 63\n\tv_fmac_f32 %0, s20, %1" : "+v"(x) : "v"(y) : "s20"); }
#elif UBENCH == 5
            { float y2 = x + 1.f;
#pragma unroll
            for (int k = 0; k < 64; ++k) { asm volatile("s_nop 1\n\tv_add_f32_dpp %0, %0, %0 row_mirror row_mask:0xf bank_mask:0xf bound_ctrl:1\n\tv_add_f32_dpp %1, %1, %1 row_mirror row_mask:0xf bank_mask:0xf bound_ctrl:1" : "+v"(x), "+v"(y2)); }
            x += y2; }
#elif UBENCH == 6
            if (wave < 4) {
#pragma unroll
            for (int k = 0; k < 64; ++k) { asm volatile("s_nop 1\n\tv_add_f32_dpp %0, %0, %0 row_mirror row_mask:0xf bank_mask:0xf bound_ctrl:1" : "+v"(x)); } }
#elif UBENCH == 7
            if (wave < 4) {
#pragma unroll
            for (int k = 0; k < 64; ++k) { asm volatile("v_fma_f32 %0, %0, %1, %0" : "+v"(x) : "v"(y)); } }
#elif UBENCH == 8
            { float y2 = x + 1.f, y3 = x + 2.f, y4 = x + 3.f;
#pragma unroll
            for (int k = 0; k < 64; ++k) { asm volatile("s_nop 1\n\tv_add_f32_dpp %0, %0, %0 row_mirror row_mask:0xf bank_mask:0xf bound_ctrl:1\n\tv_add_f32_dpp %1, %1, %1 row_mirror row_mask:0xf bank_mask:0xf bound_ctrl:1\n\tv_add_f32_dpp %2, %2, %2 row_mirror row_mask:0xf bank_mask:0xf bound_ctrl:1\n\tv_add_f32_dpp %3, %3, %3 row_mirror row_mask:0xf bank_mask:0xf bound_ctrl:1" : "+v"(x), "+v"(y2), "+v"(y3), "+v"(y4)); }
            x += y2 + y3 + y4; }
#elif UBENCH == 4
#pragma unroll
            for (int k = 0; k < 64; ++k) { asm volatile("s_nop 1\n\tv_add_f32_dpp %0, %0, %0 row_bcast:15 row_mask:0xa bank_mask:0xf" : "+v"(x)); }
#endif
        }
        acc += x;
        if (acc == 123.456f) ((float*)(ws + WS_CTL))[2000 + tid] = acc;
    }
#endif
#undef IN
#undef SEAM
}

#ifndef MK_ONE_LAUNCH
#define MK_ONE_LAUNCH 1
#endif
extern "C" void kernel_launch(void* const* d_in, const int* in_sizes, int n_in, void* d_out, int out_size, void* d_ws, size_t ws_size, hipStream_t stream) {
    static int grid = 0;
    if (grid == 0) {
        if (n_in != 32 || out_size != NREAL * DM || ws_size < WS_END) { fprintf(stderr, "kernel_launch: unexpected shapes (n_in %d out %d ws %zu need %zu); nothing launched\n", n_in, out_size, ws_size, (size_t)WS_END); grid = -1; return; }
        int dev = 0, cus = 0, per_cu = 0;
        if (hipGetDevice(&dev) != hipSuccess || hipDeviceGetAttribute(&cus, hipDeviceAttributeMultiprocessorCount, dev) != hipSuccess) { grid = -1; return; }
        if (hipFuncSetAttribute((const void*)hymba_fwd, hipFuncAttributeMaxDynamicSharedMemorySize, LDS_BYTES) != hipSuccess) { fprintf(stderr, "kernel_launch: hipFuncSetAttribute failed\n"); grid = -1; return; }
        if (hipOccupancyMaxActiveBlocksPerMultiprocessor(&per_cu, (const void*)hymba_fwd, NWAVES * 64, LDS_BYTES) != hipSuccess || per_cu < 1) fprintf(stderr, "kernel_launch: occupancy query says %d\n", per_cu);
        (void)hipGetLastError();
        grid = cus;
        if (grid != 256) { fprintf(stderr, "kernel_launch: built for 256 CUs, device has %d; nothing launched\n", cus); grid = -1; return; }
    }
    if (grid < 0) return;
    if (hipMemsetAsync((char*)d_ws + WS_CTL, 0, CTL_ZERO_BYTES, stream) != hipSuccess) return;
    Args a{};
    for (int i = 0; i < 32; ++i) a.in[i] = (const float*)d_in[i];
    a.out = (float*)d_out; a.ws = (unsigned char*)d_ws;
#if MK_ONE_LAUNCH
    a.ph_lo = 0; a.ph_hi = 48;
    hipLaunchKernelGGL(hymba_fwd, dim3(grid), dim3(NWAVES * 64), LDS_BYTES, stream, a);
#else
    for (int ph = 0; ph < 50; ++ph) {
        if (ph >= 1 && ph <= 48) { const int l = (ph - 1) / 12, k = (ph - 1) % 12; const bool moe = l & 1; if (k == 11 || (!moe && k >= 9)) continue; }
        a.ph_lo = ph; a.ph_hi = ph + 1;
        hipLaunchKernelGGL(hymba_fwd, dim3(grid), dim3(NWAVES * 64), LDS_BYTES, stream, a);
    }
#endif
}
```

```cpp
#include <hip/hip_runtime.h>
#include <hip/hip_bf16.h>
#include <cmath>
#include <cstdio>
#include <cstdint>
namespace pg8 {
#define PG8_LAS __attribute__((address_space(3)))
typedef unsigned short bf16_t;
typedef short bf16x8 __attribute__((ext_vector_type(8)));
typedef float f32x4 __attribute__((ext_vector_type(4)));
typedef float f32x2 __attribute__((ext_vector_type(2)));
typedef unsigned u32x4 __attribute__((ext_vector_type(4)));
constexpr int BM = 256, BK = 64, HALF = 128, HTB = HALF * BK * 2  , STAGE_BYTES = 8 * HTB, NXCD = 8, WGM = 8;

__host__ __device__ __forceinline__ int lds_byte(int r, int c) { const int st = (r >> 4) * 2 + (c >> 5), rr = r & 15, cc = c & 31, ob = rr * 64 + cc * 2; return st * 1024 + (ob ^ (((ob >> 9) & 1) << 5)); }
__host__ __device__ __forceinline__ void stage_rc(int b, int& R, int& C) { const int st = b / 1024, sb = b % 1024, swz = sb ^ (((sb >> 9) & 1) << 5); R = (st >> 1) * 16 + swz / 64; C = (st & 1) * 32 + (swz % 64) / 2; }
__host__ __device__ __forceinline__ int perm32(int rho) { const int n = rho >> 4, i = rho & 15; return 8 * (i >> 2) + 4 * n + (i & 3); }

struct Unit { int pm, pn, pc; };
struct Gemm { const bf16_t* A; const bf16_t* Bt; int M, N, K; };

struct StaticOrder {
    int nM, nN, nwg, G, c;
    __host__ __device__ void init(int M, int N, int G_, int c_) { nM = M / BM; nN = N / BM; nwg = nM * nN; G = G_; c = c_; }
    __host__ __device__ bool next(int i, Unit& u) const {
        const long L = (long)i * G + c; if (L >= nwg) return false;
        int wgid = (int)L; { const int q = nwg / NXCD, r = nwg % NXCD, xcd = wgid % NXCD, off = wgid / NXCD; wgid = (xcd < r ? xcd * (q + 1) : r * (q + 1) + (xcd - r) * q) + off; }
        const int nig = WGM * nN, gid = wgid / nig, fm = gid * WGM, gsz = (nM - fm) < WGM ? (nM - fm) : WGM;
        u.pm = fm + ((wgid % nig) % gsz); u.pn = (wgid % nig) / gsz; u.pc = u.pn; return true;
    }
    __device__ __forceinline__ void a_ready(const Unit&) const {}
    __device__ __forceinline__ void done(const Unit&) const {}
};
struct MoeOrder {
    int G, c, nN, total; int t1, t2, t3, t4, t5, t6, t7;
    __device__ __forceinline__ void init(const int* cnt, int nN_, int G_, int c_) {
        G = G_; c = c_; nN = nN_; int a = 0;
        a += (__builtin_amdgcn_readfirstlane(__hip_atomic_load(cnt + 0, __ATOMIC_RELAXED, __HIP_MEMORY_SCOPE_AGENT)) + 255) >> 8; t1 = a;
        a += (__builtin_amdgcn_readfirstlane(__hip_atomic_load(cnt + 1, __ATOMIC_RELAXED, __HIP_MEMORY_SCOPE_AGENT)) + 255) >> 8; t2 = a;
        a += (__builtin_amdgcn_readfirstlane(__hip_atomic_load(cnt + 2, __ATOMIC_RELAXED, __HIP_MEMORY_SCOPE_AGENT)) + 255) >> 8; t3 = a;
        a += (__builtin_amdgcn_readfirstlane(__hip_atomic_load(cnt + 3, __ATOMIC_RELAXED, __HIP_MEMORY_SCOPE_AGENT)) + 255) >> 8; t4 = a;
        a += (__builtin_amdgcn_readfirstlane(__hip_atomic_load(cnt + 4, __ATOMIC_RELAXED, __HIP_MEMORY_SCOPE_AGENT)) + 255) >> 8; t5 = a;
        a += (__builtin_amdgcn_readfirstlane(__hip_atomic_load(cnt + 5, __ATOMIC_RELAXED, __HIP_MEMORY_SCOPE_AGENT)) + 255) >> 8; t6 = a;
        a += (__builtin_amdgcn_readfirstlane(__hip_atomic_load(cnt + 6, __ATOMIC_RELAXED, __HIP_MEMORY_SCOPE_AGENT)) + 255) >> 8; t7 = a;
        a += (__builtin_amdgcn_readfirstlane(__hip_atomic_load(cnt + 7, __ATOMIC_RELAXED, __HIP_MEMORY_SCOPE_AGENT)) + 255) >> 8;
        total = a * nN;
    }
    __device__ __forceinline__ bool next(int i, Unit& u) const {
        const int x = c & 7, per = G >> 3; const int e_ = i * per + (c >> 3);
        const int ntile = total / nN; const int mine = (ntile - x + 7) >> 3;
        if (e_ >= mine * nN) return false;
        const int rt = x + 8 * (e_ / nN), j = e_ % nN;
        const int e = (rt >= t1) + (rt >= t2) + (rt >= t3) + (rt >= t4) + (rt >= t5) + (rt >= t6) + (rt >= t7);
        u.pm = rt; u.pn = e * nN + j; u.pc = j; return true;
    }
    __device__ __forceinline__ void a_ready(const Unit&) const {}
    __device__ __forceinline__ void done(const Unit&) const {}
};

__device__ __forceinline__ unsigned cvt_pk_bf16(float lo, float hi) { unsigned r; asm volatile("v_cvt_pk_bf16_f32 %0, %1, %2" : "=v"(r) : "v"(lo), "v"(hi)); return r; }

#define PG8_GAS __attribute__((address_space(1)))
struct EpiBf16Rs {
    static constexpr bool PERM = true, AFTER_DRAIN = false;
    bf16_t* O; int ldc; const float* rs; float sc;
    __device__ __forceinline__ void operator()(const f32x4 (&acc)[2][2][4][2], const Unit& u, int wr, int wc, int fr, int fq) const {
        const int row0 = u.pm * BM + wr * 64 + fr; const int col0 = u.pc * BM + wc * 32 + 8 * fq;
        float sv[2][4];
#pragma unroll
        for (int ai = 0; ai < 2; ++ai)
#pragma unroll
            for (int m = 0; m < 4; ++m) sv[ai][m] = rs ? ((const PG8_GAS float*)rs)[row0 + ai * HALF + m * 16] : sc;
#pragma unroll
        for (int ai = 0; ai < 2; ++ai)
#pragma unroll
            for (int m = 0; m < 4; ++m) { const int row = row0 + ai * HALF + m * 16; const float s = sv[ai][m]; PG8_GAS bf16_t* rowp = (PG8_GAS bf16_t*)O + (size_t)row * ldc + col0;
#pragma unroll
                for (int bj = 0; bj < 2; ++bj) { const f32x4 v0 = acc[ai][bj][m][0] * s, v1 = acc[ai][bj][m][1] * s;
                    u32x4 w; w.x = cvt_pk_bf16(v0[0], v0[1]); w.y = cvt_pk_bf16(v0[2], v0[3]); w.z = cvt_pk_bf16(v1[0], v1[1]); w.w = cvt_pk_bf16(v1[2], v1[3]);
                    *(PG8_GAS u32x4*)(rowp + bj * HALF) = w; } }
    }
};
struct EpiResAdd {
    static constexpr bool PERM = false, AFTER_DRAIN = false;
    float* H; int ldc; float sc;
    __device__ __forceinline__ void operator()(const f32x4 (&acc)[2][2][4][2], const Unit& u, int wr, int wc, int fr, int fq) const {
        const int row0 = u.pm * BM + wr * 64 + fr; const int col0 = u.pc * BM + wc * 32 + 4 * fq;
#pragma unroll
        for (int ai = 0; ai < 2; ++ai)
#pragma unroll
            for (int mp = 0; mp < 2; ++mp) {
                f32x4 res[2][2][2];
#pragma unroll
                for (int m2 = 0; m2 < 2; ++m2) { const PG8_GAS float* rowp = (const PG8_GAS float*)H + (size_t)(row0 + ai * HALF + (2 * mp + m2) * 16) * ldc + col0;
#pragma unroll
                    for (int bj = 0; bj < 2; ++bj)
#pragma unroll
                        for (int n = 0; n < 2; ++n) res[m2][bj][n] = *(const PG8_GAS f32x4*)(rowp + bj * HALF + n * 16); }
#pragma unroll
                for (int m2 = 0; m2 < 2; ++m2) { PG8_GAS float* rowp = (PG8_GAS float*)H + (size_t)(row0 + ai * HALF + (2 * mp + m2) * 16) * ldc + col0;
#pragma unroll
                    for (int bj = 0; bj < 2; ++bj)
#pragma unroll
                        for (int n = 0; n < 2; ++n) *(PG8_GAS f32x4*)(rowp + bj * HALF + n * 16) = res[m2][bj][n] + acc[ai][bj][2 * mp + m2][n] * sc; }
                asm volatile("" ::: "memory");
            }
    }
};
template <int MODE, long long HB_OFF, long long RSQ_OFF> struct EpiResAddHB {
    static constexpr bool PERM = true, AFTER_DRAIN = false; static constexpr float hs = 4.f;
    float* H; int ldc; float sc;
    __device__ __forceinline__ void operator()(const f32x4 (&acc)[2][2][4][2], const Unit& u, int wr, int wc, int fr, int fq) const {
        const int row0 = u.pm * BM + wr * 64 + fr; const int col0 = u.pc * BM + wc * 32 + 8 * fq;
        PG8_GAS unsigned char* const HBo = (PG8_GAS unsigned char*)H + HB_OFF; PG8_GAS unsigned long long* const rsq = (PG8_GAS unsigned long long*)((PG8_GAS unsigned char*)H + RSQ_OFF);
#pragma unroll
        for (int ai = 0; ai < 2; ++ai)
#pragma unroll
            for (int m = 0; m < 4; ++m) { const int row = row0 + ai * HALF + m * 16; PG8_GAS float* rowp = (PG8_GAS float*)H + (size_t)row * ldc + col0;
                f32x4 r_[2][2];
#pragma unroll
                for (int bj = 0; bj < 2; ++bj)
#pragma unroll
                    for (int n = 0; n < 2; ++n) r_[bj][n] = *(const PG8_GAS f32x4*)(rowp + bj * HALF + n * 4);
                float ss = 0.f;
#pragma unroll
                for (int bj = 0; bj < 2; ++bj) { const f32x4 v0 = r_[bj][0] + acc[ai][bj][m][0] * sc, v1 = r_[bj][1] + acc[ai][bj][m][1] * sc;
                    *(PG8_GAS f32x4*)(rowp + bj * HALF) = v0; *(PG8_GAS f32x4*)(rowp + bj * HALF + 4) = v1;
                    ss += ((v0[0] * v0[0] + v0[1] * v0[1]) + (v0[2] * v0[2] + v0[3] * v0[3])) + ((v1[0] * v1[0] + v1[1] * v1[1]) + (v1[2] * v1[2] + v1[3] * v1[3]));
                    if constexpr (MODE == 1) { u32x4 w; w.x = cvt_pk_bf16(v0[0], v0[1]); w.y = cvt_pk_bf16(v0[2], v0[3]); w.z = cvt_pk_bf16(v1[0], v1[1]); w.w = cvt_pk_bf16(v1[2], v1[3]);
                        *(PG8_GAS u32x4*)((PG8_GAS bf16_t*)HBo + (size_t)row * ldc + col0 + bj * HALF) = w; }
                    else {
#define PG8_C8(x) __builtin_amdgcn_fmed3f((x) * hs, -448.f, 448.f)
                        unsigned lo = (unsigned)__builtin_amdgcn_cvt_pk_fp8_f32(PG8_C8(v0[0]), PG8_C8(v0[1]), 0, false); lo = (unsigned)__builtin_amdgcn_cvt_pk_fp8_f32(PG8_C8(v0[2]), PG8_C8(v0[3]), (int)lo, true);
                        unsigned hi = (unsigned)__builtin_amdgcn_cvt_pk_fp8_f32(PG8_C8(v1[0]), PG8_C8(v1[1]), 0, false); hi = (unsigned)__builtin_amdgcn_cvt_pk_fp8_f32(PG8_C8(v1[2]), PG8_C8(v1[3]), (int)hi, true);
#undef PG8_C8
                        *(PG8_GAS unsigned long long*)(HBo + (size_t)row * ldc + col0 + bj * HALF) = (unsigned long long)lo | ((unsigned long long)hi << 32); } }
                { auto p_ = __builtin_amdgcn_permlane16_swap(__float_as_uint(ss), __float_as_uint(ss), false, false); ss = __uint_as_float(p_[0]) + __uint_as_float(p_[1]); }
                { auto p_ = __builtin_amdgcn_permlane32_swap(__float_as_uint(ss), __float_as_uint(ss), false, false); ss = __uint_as_float(p_[0]) + __uint_as_float(p_[1]); }
                if (fq == 0) __hip_atomic_fetch_add(rsq + row, (unsigned long long)(ss * 16777216.f), __ATOMIC_RELAXED, __HIP_MEMORY_SCOPE_AGENT);
                asm volatile("" ::: "memory"); }
    }
};
template <bool OUT8> struct EpiSwigluT {
    static constexpr bool PERM = true, AFTER_DRAIN = false;
    bf16_t* O; int ldc; const float* rs; float sc; float o8; const unsigned long long* rsq;
    __device__ __forceinline__ void operator()(const f32x4 (&acc)[2][2][4][2], const Unit& u, int wr, int wc, int fr, int fq) const {
        const int row0 = u.pm * BM + wr * 64 + fr; const int col0 = u.pc * HALF + wc * 32 + 8 * fq;
        float sv[2][4];
#pragma unroll
        for (int ai = 0; ai < 2; ++ai)
#pragma unroll
            for (int m = 0; m < 4; ++m) sv[ai][m] = rsq ? sc * __builtin_amdgcn_rsqf((float)((const PG8_GAS unsigned long long*)rsq)[row0 + ai * HALF + m * 16] * (1.f / (16777216.f * 1024.f)) + 1e-6f) : (rs ? ((const PG8_GAS float*)rs)[row0 + ai * HALF + m * 16] : sc);
#pragma unroll
        for (int ai = 0; ai < 2; ++ai)
#pragma unroll
            for (int m = 0; m < 4; ++m) { const int row = row0 + ai * HALF + m * 16; const float s = sv[ai][m]; PG8_GAS bf16_t* rowp = (PG8_GAS bf16_t*)O + (size_t)row * ldc + col0;
                const float c1 = -1.4426950408889634f * s, c2 = OUT8 ? s * s * o8 : s * s;
                f32x2 q[4];
#pragma unroll
                for (int n = 0; n < 2; ++n)
#pragma unroll
                    for (int h = 0; h < 2; ++h) { const f32x4 av = acc[ai][0][m][n], bv = acc[ai][1][m][n];
                        const f32x2 a = h ? (f32x2){av[2], av[3]} : (f32x2){av[0], av[1]}, b = h ? (f32x2){bv[2], bv[3]} : (f32x2){bv[0], bv[1]};
                        const f32x2 t = a * c1; f32x2 e; e.x = __builtin_amdgcn_exp2f(t.x); e.y = __builtin_amdgcn_exp2f(t.y);
                        const f32x2 d = e + 1.f; f32x2 r; r.x = __builtin_amdgcn_rcpf(d.x); r.y = __builtin_amdgcn_rcpf(d.y);
                        q[2 * n + h] = ((a * b) * r) * c2; }
                if constexpr (OUT8) { PG8_GAS unsigned char* rp8 = (PG8_GAS unsigned char*)O + (size_t)row * ldc + col0;
#define PG8_C8(x) __builtin_amdgcn_fmed3f((x), -448.f, 448.f)
                    unsigned lo = (unsigned)__builtin_amdgcn_cvt_pk_fp8_f32(PG8_C8(q[0].x), PG8_C8(q[0].y), 0, false); lo = (unsigned)__builtin_amdgcn_cvt_pk_fp8_f32(PG8_C8(q[1].x), PG8_C8(q[1].y), (int)lo, true);
                    unsigned hi = (unsigned)__builtin_amdgcn_cvt_pk_fp8_f32(PG8_C8(q[2].x), PG8_C8(q[2].y), 0, false); hi = (unsigned)__builtin_amdgcn_cvt_pk_fp8_f32(PG8_C8(q[3].x), PG8_C8(q[3].y), (int)hi, true);
#undef PG8_C8
                    *(PG8_GAS unsigned long long*)rp8 = (unsigned long long)lo | ((unsigned long long)hi << 32); }
                else { u32x4 w; w.x = cvt_pk_bf16(q[0].x, q[0].y); w.y = cvt_pk_bf16(q[1].x, q[1].y); w.z = cvt_pk_bf16(q[2].x, q[2].y); w.w = cvt_pk_bf16(q[3].x, q[3].y);
                    *(PG8_GAS u32x4*)rowp = w; } }
    }
};
typedef EpiSwigluT<false> EpiSwiglu; typedef EpiSwigluT<true> EpiSwiglu8;

template <class Epi, class Sched, bool ALIGN_EPI = false, bool SP2 = false, bool FP8 = false>
__device__ __forceinline__ void gemm_phase(PG8_LAS unsigned char* lds, const Gemm g, const Sched& S, const Epi& E, int tid_in) {
    int tid_ = tid_in; asm volatile("" : "+v"(tid_));
    const int tid = tid_, wid = __builtin_amdgcn_readfirstlane(tid >> 6), lane = tid & 63, wr = wid >> 2, wc = wid & 3, fr = lane & 15, fq = lane >> 4;
    const int K = g.K, nt = K / BK;
    unsigned voffA[2], voffB[2];
#pragma unroll
    for (int i = 0; i < 2; ++i) { int R, C; stage_rc(tid * 16 + i * 8192, R, C); const int Rb = Epi::PERM ? ((R & ~31) + perm32(R & 31)) : R;
        voffA[i] = (unsigned)(R * K + C) * 2u; voffB[i] = (unsigned)(Rb * K + C) * 2u; }
    const size_t kstep = (size_t)(BK * 2);
    const size_t hstep = (size_t)HALF * K * 2;
    const size_t tstep = 2 * hstep;
    const unsigned ldsw = (unsigned)wid * 1024u;
    const int aoff = lds_byte(wr * 64 + fr, fq * 8), boff = lds_byte(wc * 32 + fr, fq * 8);
#define PG8_SA(b, h) (((b) * 2 + (h)) * HTB)
#define PG8_SB(b, h) ((4 + (b) * 2 + (h)) * HTB)
#define PG8_STAGE(bufoff, gbase, voff) do { _Pragma("unroll") for (int _i = 0; _i < 2; ++_i) \
        __builtin_amdgcn_global_load_lds((const unsigned*)((const char*)(gbase) + (voff)[_i]), (PG8_LAS unsigned*)(lds + (bufoff) + ldsw + _i * 8192), 16, 0, 0); } while (0)
#define PG8_LDA(dst, b, h) do { _Pragma("unroll") for (int m = 0; m < 4; ++m) _Pragma("unroll") for (int k = 0; k < 2; ++k) dst[m][k] = *(const PG8_LAS bf16x8*)(lds + PG8_SA(b, h) + aoff + m * 2048 + k * 1024); } while (0)
#define PG8_LDB(dst, b, h) do { _Pragma("unroll") for (int n = 0; n < 2; ++n) _Pragma("unroll") for (int k = 0; k < 2; ++k) dst[n][k] = *(const PG8_LAS bf16x8*)(lds + PG8_SB(b, h) + boff + n * 2048 + k * 1024); } while (0)
#define PG8_MMA(ai, bj, At, Bt) do { __builtin_amdgcn_s_setprio(1); \
        if constexpr (FP8) { typedef int v8i_ __attribute__((ext_vector_type(8))); typedef int v4i_ __attribute__((ext_vector_type(4))); const int sc8_ = 0x7f7f7f7f;     \
            _Pragma("unroll") for (int m = 0; m < 4; ++m) _Pragma("unroll") for (int n = 0; n < 2; ++n) { \
                const v4i_ b0_ = __builtin_bit_cast(v4i_, Bt[n][0]), b1_ = __builtin_bit_cast(v4i_, Bt[n][1]), a0_ = __builtin_bit_cast(v4i_, At[m][0]), a1_ = __builtin_bit_cast(v4i_, At[m][1]); \
                const v8i_ bb_ = (v8i_){b0_.x, b0_.y, b0_.z, b0_.w, b1_.x, b1_.y, b1_.z, b1_.w}, aa_ = (v8i_){a0_.x, a0_.y, a0_.z, a0_.w, a1_.x, a1_.y, a1_.z, a1_.w}; \
                asm volatile("v_mfma_scale_f32_16x16x128_f8f6f4 %0, %1, %2, %0, %3, %3 op_sel_hi:[0,0,0]" : "+v"(acc[ai][bj][m][n]) : "v"(bb_), "v"(aa_), "v"(sc8_)); } \
        } else { _Pragma("unroll") for (int m = 0; m < 4; ++m) _Pragma("unroll") for (int n = 0; n < 2; ++n) _Pragma("unroll") for (int k = 0; k < 2; ++k) \
            acc[ai][bj][m][n] = __builtin_amdgcn_mfma_f32_16x16x32_bf16(Bt[n][k], At[m][k], acc[ai][bj][m][n], 0, 0, 0); } \
        __builtin_amdgcn_s_setprio(0); } while (0)
#define PG8_WAIT_V(n) asm volatile("s_waitcnt vmcnt(" #n ")" ::: "memory")
#define PG8_WAIT_L(n) asm volatile("s_waitcnt lgkmcnt(" #n ")" ::: "memory")
#define PG8_BAR __builtin_amdgcn_s_barrier()
#define PG8_SCHED __builtin_amdgcn_sched_barrier(0)
    Unit cur, nxt; int ui = 0;
    if (!S.next(0, cur)) return;
    f32x4 acc[2][2][4][2];
    { float zf; asm volatile("v_mov_b32 %0, 0" : "=v"(zf));
#pragma unroll
    for (int a = 0; a < 2; ++a)
#pragma unroll
        for (int b = 0; b < 2; ++b)
#pragma unroll
            for (int m = 0; m < 4; ++m)
#pragma unroll
                for (int n = 0; n < 2; ++n) acc[a][b][m][n] = (f32x4){zf, zf, zf, zf}; }
    bf16x8 At[4][2], B0[2][2], B1[2][2];
    const char* cA = (const char*)g.A + (size_t)cur.pm * tstep; const char* cB = (const char*)g.Bt + (size_t)cur.pn * tstep;
    S.a_ready(cur);
    if constexpr (SP2) {
        PG8_STAGE(PG8_SB(0, 0), cB, voffB); PG8_STAGE(PG8_SB(0, 1), cB + hstep, voffB); PG8_STAGE(PG8_SA(0, 0), cA, voffA); PG8_STAGE(PG8_SA(0, 1), cA + hstep, voffA);
        if (wr == 1) PG8_BAR;
        PG8_WAIT_V(2); PG8_BAR;
        PG8_STAGE(PG8_SB(1, 0), cB + kstep, voffB); PG8_STAGE(PG8_SA(1, 0), cA + kstep, voffA); PG8_STAGE(PG8_SB(1, 1), cB + hstep + kstep, voffB);
        PG8_WAIT_V(6); PG8_BAR;
    } else {
        PG8_STAGE(PG8_SB(0, 0), cB, voffB); PG8_STAGE(PG8_SA(0, 0), cA, voffA); PG8_STAGE(PG8_SB(0, 1), cB + hstep, voffB); PG8_STAGE(PG8_SA(0, 1), cA + hstep, voffA);
        if (wr == 1) PG8_BAR;
        PG8_WAIT_V(4); PG8_BAR;
        PG8_STAGE(PG8_SB(1, 0), cB + kstep, voffB); PG8_STAGE(PG8_SA(1, 0), cA + kstep, voffA); PG8_STAGE(PG8_SB(1, 1), cB + hstep + kstep, voffB);
        PG8_WAIT_V(6); PG8_BAR;
    }
    for (;;) {
        const bool has_next = S.next(ui + 1, nxt);
        const char* nA = has_next ? (const char*)g.A + (size_t)nxt.pm * tstep : cA; const char* nB = has_next ? (const char*)g.Bt + (size_t)nxt.pn * tstep : cB;
        for (int t = 0; t < nt; t += 2) {
            const bool last = (t == nt - 2);
            const char* a1 = cA + (size_t)(t + 1) * kstep;
            const char* a2 = last ? nA : cA + (size_t)(t + 2) * kstep; const char* b2 = last ? nB : cB + (size_t)(t + 2) * kstep;
            const char* a3 = a2 + kstep; const char* b3 = b2 + kstep;
            if (last && has_next) S.a_ready(nxt);
            if constexpr (SP2) {
            PG8_LDB(B0, 0, 0); PG8_LDB(B1, 0, 1); PG8_SCHED; PG8_LDA(At, 0, 0); PG8_STAGE(PG8_SA(1, 1), a1 + hstep, voffA);
            PG8_WAIT_V(8); PG8_WAIT_L(0); PG8_BAR; PG8_MMA(0, 0, At, B0); PG8_MMA(0, 1, At, B1); PG8_BAR; PG8_SCHED;
            PG8_LDA(At, 0, 1); PG8_STAGE(PG8_SB(0, 0), b2, voffB); PG8_STAGE(PG8_SB(0, 1), b2 + hstep, voffB); PG8_STAGE(PG8_SA(0, 0), a2, voffA);
            PG8_WAIT_V(8); PG8_WAIT_L(0); PG8_BAR; PG8_MMA(1, 0, At, B0); PG8_MMA(1, 1, At, B1); PG8_BAR; PG8_SCHED;
            PG8_LDB(B0, 1, 0); PG8_LDB(B1, 1, 1); PG8_SCHED; PG8_LDA(At, 1, 0); PG8_STAGE(PG8_SA(0, 1), a2 + hstep, voffA);
            PG8_WAIT_V(8); PG8_WAIT_L(0); PG8_BAR; PG8_MMA(0, 0, At, B0); PG8_MMA(0, 1, At, B1); PG8_BAR; PG8_SCHED;
            PG8_LDA(At, 1, 1); PG8_STAGE(PG8_SB(1, 0), b3, voffB); PG8_STAGE(PG8_SB(1, 1), b3 + hstep, voffB); PG8_STAGE(PG8_SA(1, 0), a3, voffA);
            PG8_WAIT_V(8); PG8_WAIT_L(0); PG8_BAR; PG8_MMA(1, 0, At, B0); PG8_MMA(1, 1, At, B1); PG8_BAR; PG8_SCHED;
            } else {
            PG8_LDB(B0, 0, 0); PG8_SCHED; PG8_LDA(At, 0, 0); PG8_STAGE(PG8_SA(1, 1), a1 + hstep, voffA);
            PG8_WAIT_L(8); PG8_BAR; PG8_WAIT_L(0); PG8_MMA(0, 0, At, B0); PG8_BAR; PG8_SCHED;
            PG8_LDB(B1, 0, 1); PG8_STAGE(PG8_SB(0, 0), b2, voffB);
            PG8_BAR; PG8_WAIT_L(0); PG8_MMA(0, 1, At, B1); PG8_BAR;
            PG8_LDA(At, 0, 1); PG8_STAGE(PG8_SA(0, 0), a2, voffA);
            PG8_BAR; PG8_WAIT_L(0); PG8_MMA(1, 0, At, B0); PG8_BAR; PG8_SCHED;
            PG8_STAGE(PG8_SB(0, 1), b2 + hstep, voffB);
            PG8_WAIT_V(6); PG8_BAR; PG8_MMA(1, 1, At, B1); PG8_BAR;
            PG8_LDB(B0, 1, 0); PG8_SCHED; PG8_LDA(At, 1, 0); PG8_STAGE(PG8_SA(0, 1), a2 + hstep, voffA);
            PG8_WAIT_L(8); PG8_BAR; PG8_WAIT_L(0); PG8_MMA(0, 0, At, B0); PG8_BAR; PG8_SCHED;
            PG8_LDB(B1, 1, 1); PG8_STAGE(PG8_SB(1, 0), b3, voffB);
            PG8_BAR; PG8_WAIT_L(0); PG8_MMA(0, 1, At, B1); PG8_BAR;
            PG8_LDA(At, 1, 1); PG8_STAGE(PG8_SA(1, 0), a3, voffA);
            PG8_BAR; PG8_WAIT_L(0); PG8_MMA(1, 0, At, B0); PG8_BAR; PG8_SCHED;
            PG8_STAGE(PG8_SB(1, 1), b3 + hstep, voffB);
            PG8_WAIT_V(6); PG8_BAR; PG8_MMA(1, 1, At, B1); PG8_BAR;
            }
        }
        if constexpr (FP8) asm volatile("s_nop 15\n\ts_nop 15\n\ts_nop 15" ::: "memory");
        if constexpr (ALIGN_EPI) { if (wr == 0) PG8_BAR; }
        if constexpr (!Epi::AFTER_DRAIN) { E(acc, cur, wr, wc, fr, fq); S.done(cur); }
        if (!has_next) break;
        { float zf; asm volatile("v_mov_b32 %0, 0" : "=v"(zf));
#pragma unroll
        for (int a = 0; a < 2; ++a)
#pragma unroll
            for (int b = 0; b < 2; ++b)
#pragma unroll
                for (int m = 0; m < 4; ++m)
#pragma unroll
                    for (int n = 0; n < 2; ++n) acc[a][b][m][n] = (f32x4){zf, zf, zf, zf}; }
        cur = nxt; cA = nA; cB = nB; ++ui;
        if constexpr (ALIGN_EPI) { if (wr == 1) PG8_BAR; }
    }
    PG8_WAIT_V(0);
    if constexpr (!ALIGN_EPI) { if (wr == 0) PG8_BAR; }
    PG8_BAR;
    if constexpr (Epi::AFTER_DRAIN) { E.fused(acc, cur, wr, wc, fr, fq, lds, wid, lane); S.done(cur); }
#undef PG8_SA
#undef PG8_SB
#undef PG8_STAGE
#undef PG8_LDA
#undef PG8_LDB
#undef PG8_MMA
#undef PG8_WAIT_V
#undef PG8_WAIT_L
#undef PG8_BAR
#undef PG8_SCHED
}
}
#include <hip/hip_bf16.h>
#include <cmath>
namespace attn_body {
using bf16=__hip_bfloat16;
using bf16x8=__attribute__((ext_vector_type(8)))short;
using s16x4=__attribute__((ext_vector_type(4)))short;
using f32x16=__attribute__((ext_vector_type(16)))float;
using u32x4=__attribute__((ext_vector_type(4)))unsigned;
constexpr int BATCH=4,NHEAD=8,SEQ=4096,D=64,DM=512,DMO=1024,KVSEQ=4224;
constexpr int NW=8,QBLK=32,QB=QBLK*NW,KVBLK=64,NQB=SEQ/QB;
constexpr int ATTN_UNIT_ROWS=QB;
__device__ __forceinline__ int crow(int r,int hi){return (r&3)+8*(r>>2)+4*hi;}
#define SBAR() __builtin_amdgcn_sched_barrier(0)
__device__ __forceinline__ void cmask(f32x16&p0,f32x16&p1,int jb,int qrel,int hi){
  const float NEG=-INFINITY; int kb=64*jb+4*hi;
  #pragma unroll
  for(int r=0;r<16;++r){int kv=kb+(r&3)+8*(r>>2); if(kv>qrel)p0[r]=NEG; if(kv+32>qrel)p1[r]=NEG;}
}

constexpr int NSLOT=3, SLOTB=8192;
constexpr int LDS_K=0, LDS_V=NSLOT*SLOTB, LDS_V2=2*NSLOT*SLOTB, LDS_WS=3*NSLOT*SLOTB, LDS_OST=LDS_WS+NW*64*4, LDS_BYTES=LDS_OST+NW*4096;
constexpr float C2=0.125f*1.4426950408889634f;
__device__ __forceinline__ void glds16(const void*gsrc,unsigned lds_dst){unsigned keep;
  asm volatile("s_mov_b32 %0, m0\n\ts_mov_b32 m0, %2\n\ts_nop 0\n\tglobal_load_lds_dwordx4 %1, off\n\ts_mov_b32 m0, %0":"=&s"(keep):"v"(gsrc),"s"(lds_dst):"memory");}
__device__ __forceinline__ void glds16s(const void*sbase,unsigned voff,unsigned lds_dst){unsigned keep;
  asm volatile("s_mov_b32 %0, m0\n\ts_mov_b32 m0, %3\n\ts_nop 0\n\tglobal_load_lds_dwordx4 %1, %2\n\ts_mov_b32 m0, %0":"=&s"(keep):"v"(voff),"s"(sbase),"s"(lds_dst):"memory");}
__device__ __forceinline__ float max3f(float a,float b,float c){float r;asm("v_max3_f32 %0, %1, %2, %3":"=v"(r):"v"(a),"v"(b),"v"(c));return r;}
__device__ __forceinline__ float max2f(float a,float b){float r;asm("v_max_f32_e32 %0, %1, %2":"=v"(r):"v"(a),"v"(b));return r;}
__device__ __forceinline__ float fadd_s(float a,float b){float r;asm("v_add_f32_e32 %0, %1, %2":"=v"(r):"v"(a),"v"(b));return r;}
__device__ __forceinline__ float fsub_s(float a,float b){float r;asm("v_sub_f32_e32 %0, %1, %2":"=v"(r):"v"(a),"v"(b));return r;}
typedef float f32x2_t __attribute__((ext_vector_type(2))); typedef __bf16 bf16x2_t __attribute__((ext_vector_type(2)));
__device__ __forceinline__ unsigned cvtpk_s(float lo,float hi){f32x2_t v={lo,hi};bf16x2_t b=__builtin_convertvector(v,bf16x2_t);return __builtin_bit_cast(unsigned,b);}
#define WAIT_BAR(N) asm volatile("s_waitcnt vmcnt(" #N ") lgkmcnt(0)\n\ts_barrier":::"memory")

typedef __attribute__((address_space(3))) const char* lds_cptr;
__device__ __forceinline__ void qkt(f32x16&p0,f32x16&p1,lds_cptr Kslot,const bf16x8*qr,const f32x16&negm0,const f32x16&negm1,int r32,int hi){
  const lds_cptr kb=Kslot+hi*1024+r32*16;
  #pragma unroll
  for(int d0=0;d0<4;++d0){
    const bf16x8 b0=*(const __attribute__((address_space(3))) bf16x8*)(kb+d0*2048);
    const bf16x8 b1=*(const __attribute__((address_space(3))) bf16x8*)(kb+d0*2048+512);
    if(d0==0){p0=__builtin_amdgcn_mfma_f32_32x32x16_bf16(b0,qr[0],negm0,0,0,0);p1=__builtin_amdgcn_mfma_f32_32x32x16_bf16(b1,qr[0],negm1,0,0,0);}
    else{p0=__builtin_amdgcn_mfma_f32_32x32x16_bf16(b0,qr[d0],p0,0,0,0);p1=__builtin_amdgcn_mfma_f32_32x32x16_bf16(b1,qr[d0],p1,0,0,0);}}
}
typedef short v4i16_t __attribute__((ext_vector_type(4)));
__device__ __forceinline__ void kload8(bf16x8*kf,lds_cptr kp){
  kf[0]=*(const __attribute__((address_space(3))) bf16x8*)(kp);      kf[1]=*(const __attribute__((address_space(3))) bf16x8*)(kp+512);
  kf[2]=*(const __attribute__((address_space(3))) bf16x8*)(kp+2048); kf[3]=*(const __attribute__((address_space(3))) bf16x8*)(kp+2560);
  kf[4]=*(const __attribute__((address_space(3))) bf16x8*)(kp+4096); kf[5]=*(const __attribute__((address_space(3))) bf16x8*)(kp+4608);
  kf[6]=*(const __attribute__((address_space(3))) bf16x8*)(kp+6144); kf[7]=*(const __attribute__((address_space(3))) bf16x8*)(kp+6656);
}
__device__ __forceinline__ void kload2(bf16x8*kf,lds_cptr kp,int j){ kf[2*j]=*(const __attribute__((address_space(3))) bf16x8*)(kp+j*2048); kf[2*j+1]=*(const __attribute__((address_space(3))) bf16x8*)(kp+j*2048+512); }
__device__ __forceinline__ s16x4 vtr(lds_cptr p){ return __builtin_bit_cast(s16x4,__builtin_amdgcn_ds_read_tr16_b64_v4i16((__attribute__((address_space(3))) v4i16_t*)p)); }
__device__ __forceinline__ float rowmax(const f32x16&p0,const f32x16&p1){
  float a=max3f(p0[0],p0[1],p1[0]),b=max3f(p0[2],p0[3],p1[1]);a=max3f(a,p1[2],p1[3]);
  #pragma unroll
  for(int r=4;r<16;r+=4){a=max3f(a,p0[r],p0[r+1]);b=max3f(b,p0[r+2],p0[r+3]);a=max3f(a,p1[r],p1[r+1]);b=max3f(b,p1[r+2],p1[r+3]);}
  const float m=max2f(a,b);
  auto rr=__builtin_amdgcn_permlane32_swap(__float_as_uint(m),__float_as_uint(m),false,false);
  return max2f(__uint_as_float(rr[0]),__uint_as_float(rr[1]));
}
__device__ __forceinline__ void pv(f32x16*o,int vb,bf16x8 pa0,bf16x8 pa1,bf16x8 pa2,bf16x8 pa3){
  #pragma unroll
  for(int d0=0;d0<2;++d0){s16x4 lo[4],hi[4];
    #pragma unroll
    for(int ks=0;ks<4;++ks){
      asm volatile("ds_read_b64_tr_b16 %0,%1 offset:%c2":"=&v"(lo[ks]):"v"(vb),"i"(d0*4096+ks*1024):"memory");
      asm volatile("ds_read_b64_tr_b16 %0,%1 offset:%c2":"=&v"(hi[ks]):"v"(vb),"i"(d0*4096+ks*1024+512):"memory");}
    asm volatile("s_waitcnt lgkmcnt(0)":::"memory");SBAR();
    #define PK(k) (bf16x8){lo[k][0],lo[k][1],lo[k][2],lo[k][3],hi[k][0],hi[k][1],hi[k][2],hi[k][3]}
    o[d0]=__builtin_amdgcn_mfma_f32_32x32x16_bf16(pa0,PK(0),o[d0],0,0,0);
    o[d0]=__builtin_amdgcn_mfma_f32_32x32x16_bf16(pa1,PK(1),o[d0],0,0,0);
    o[d0]=__builtin_amdgcn_mfma_f32_32x32x16_bf16(pa2,PK(2),o[d0],0,0,0);
    o[d0]=__builtin_amdgcn_mfma_f32_32x32x16_bf16(pa3,PK(3),o[d0],0,0,0);
    #undef PK
  }
}

#ifndef ATTN_STORE16
#define ATTN_STORE16(p,v) (*(u32x4*)(p)=(v))
#endif
template<int THRL> __device__ __forceinline__ void attn_unit(int b,int hc,int qb,const bf16*Q,const bf16*__restrict__ K,const bf16*__restrict__ V,bf16*O,char*shm,int tid_in){
  int tid_=tid_in; asm volatile("":"+v"(tid_)); const int tid=tid_,lane=tid&63,r32=lane&31,hi=lane>>5; const int wid=__builtin_amdgcn_readfirstlane(tid>>6);
  const long rowbase=(long)b*SEQ, kvbase=(long)b*KVSEQ; const int q0=qb*QB;
  const bf16*Qw=Q+(rowbase+q0+wid*QBLK)*DM+hc*D;
  const bf16*Kh=K+kvbase*DM+hc*D,*Vh=V+kvbase*DM+(hc>>1)*128;
  const unsigned lds0=(unsigned)(uintptr_t)shm;
  typedef __attribute__((address_space(3))) float lds_f32; typedef __attribute__((address_space(3))) unsigned short lds_u16; typedef __attribute__((address_space(3))) char lds_char;
  lds_f32*wsf=(lds_f32*)((lds_char*)shm+LDS_WS)+wid*64;
  const bf16*ksb=Kh+wid*8; const unsigned kvo=(unsigned)lane*(DM*2);
  const bf16*vsb=Vh+(long)(16*(wid&3))*DM+(wid>>2)*32; const unsigned vvo=(unsigned)((lane>>2)*DM+(lane&3)*8)*2u;
  const unsigned kdst=lds0+LDS_K+wid*1024, vdst=lds0+LDS_V+wid*1024, vdst2=lds0+LDS_V2+wid*1024;
  #define DMA_K(t,slot) glds16s(ksb+(long)(t)*KVBLK*DM,kvo,(unsigned)__builtin_amdgcn_readfirstlane(kdst+(slot)))
  #define DMA_V(t,slot) do{ glds16s(vsb+(long)(t)*KVBLK*DM,vvo,(unsigned)__builtin_amdgcn_readfirstlane(vdst+(slot))); glds16s(vsb+(long)(t)*KVBLK*DM+64,vvo,(unsigned)__builtin_amdgcn_readfirstlane(vdst2+(slot))); }while(0)
  const int vb0=(int)(lds0+LDS_V)+((lane>>4)&1)*32+(lane&3)*8+(4*hi+((lane&15)>>2))*64;
  bf16x8 kf[8];
  const lds_cptr shm3=(lds_cptr)shm; const lds_cptr kp0=shm3+LDS_K+hi*1024+r32*16; const lds_cptr vp0=shm3+LDS_V+((lane>>4)&1)*32+(lane&3)*8+(4*hi+((lane&15)>>2))*64;
  const int NT=(q0+QB)/KVBLK+2;
  DMA_K(0,0);DMA_V(0,0);DMA_K(1,SLOTB);
  bf16x8 qr[4];
  #pragma unroll
  for(int d0=0;d0<4;++d0)qr[d0]=*reinterpret_cast<const bf16x8*>(&Qw[(long)r32*DM+d0*16+hi*8]);
  float mhat=0.f,l_reg=0.f;f32x16 o[4];o[0]=f32x16{};o[1]=f32x16{};o[2]=f32x16{};o[3]=f32x16{};f32x16 negm=f32x16{};asm volatile("":"+v"(negm));
  const int qrel=wid*QBLK+r32;
  #define CMASK(P0,P1,t) do{int jb_=(t)-(NT-4); if(jb_>=0)cmask(P0,P1,jb_,qrel,hi);}while(0)
  bool resc=false;
  #define START(P0,P1) do{ const float rm=rowmax(P0,P1); resc=false; \
    { const float dl=rm; mhat=fadd_s(mhat,dl); \
      _Pragma("unroll") for(int r=0;r<16;++r){P0[r]=fsub_s(P0[r],dl);P1[r]=fsub_s(P1[r],dl);} \
      _Pragma("unroll") for(int r=0;r<16;++r)negm[r]=-mhat; asm volatile("":"+v"(negm)); } \
    _Pragma("unroll") for(int r=0;r<16;++r)P0[r]=__builtin_amdgcn_exp2f(P0[r]); }while(0)
  #define RESC() do{ if(resc){ asm volatile("s_waitcnt lgkmcnt(0)":::"memory"); \
      _Pragma("unroll") for(int d_=0;d_<4;++d_) _Pragma("unroll") for(int r=0;r<16;++r)o[d_][r]*=wsf[crow(r,hi)]; } }while(0)
  f32x16 pA0,pA1,pB0,pB1;
  int sl_prev=0,sl_cur=0,sl_next=SLOTB;
  #define ROT() do{sl_prev=sl_cur;sl_cur=sl_next;sl_next=(sl_next==(NSLOT-1)*SLOTB)?0:sl_next+SLOTB;}while(0)
  DMA_K(2,2*SLOTB);
  WAIT_BAR(4);
  { f32x16 cm0,cm1; _Pragma("unroll") for(int r=0;r<16;++r){cm0[r]=-INFINITY;cm1[r]=(r<8)?-INFINITY:0.f;} asm volatile("":"+v"(cm0),"+v"(cm1));
    qkt(pA0,pA1,shm3+LDS_K,qr,cm0,cm1,r32,hi); }
  asm volatile("s_nop 15\n\ts_nop 7":"+v"(pA0),"+v"(pA1));CMASK(pA0,pA1,0);
  START(pA0,pA1);
  _Pragma("unroll") for(int r=0;r<16;++r)pA1[r]=__builtin_amdgcn_exp2f(pA1[r]);
  _Pragma("unroll") for(int r=0;r<16;++r)negm[r]=-INFINITY; asm volatile("":"+v"(negm));
  WAIT_BAR(0);
  DMA_K(3,0);DMA_V(1,SLOTB);
  ROT();
  kload8(kf,kp0+sl_cur);
  WAIT_BAR(3);
  s16x4 vlo[8],vhi[8],wlo[8],whi[8]; u32x4 pw0,pw1,pw2,pw3;
  #define PKW(P,B) cvtpk_s(P[B],P[B+1])
  #define PAF(k) __builtin_bit_cast(bf16x8,pw##k)
  #define VFR(i) (bf16x8){vlo[i][0],vlo[i][1],vlo[i][2],vlo[i][3],vhi[i][0],vhi[i][1],vhi[i][2],vhi[i][3]}
  #define WFR(i) (bf16x8){wlo[i][0],wlo[i][1],wlo[i][2],wlo[i][3],whi[i][0],whi[i][1],whi[i][2],whi[i][3]}
  #define PIN(x) asm volatile("":"+v"(x))
  #define MX3(a,b,c) __builtin_fmaxf(__builtin_fmaxf((a),(b)),(c))
  #define GAPA(MF,A0,A1,A2,A3,W0,W1,PW) do{ MF; sacc+=A0; sacc+=A1; sacc+=A2; sacc+=A3; PIN(sacc); W0; W1; PIN(PW); SBAR(); }while(0)
  #define EX(v) __builtin_amdgcn_exp2f(v)
  #define GAPB(MF,X,B) do{ MF; X[B]=EX(X[B]); X[B+1]=EX(X[B+1]); PIN(X); SBAR(); }while(0)
  #define VRD(i) do{ vlo[i]=vtr(vp_+(((i)>>2)*4096+((i)&3)*1024)); vhi[i]=vtr(vp_+(((i)>>2)*4096+((i)&3)*1024+512)); }while(0)
  #define WRD(i) do{ wlo[i]=vtr(vp_+((LDS_V2-LDS_V)+((i)>>2)*4096+((i)&3)*1024)); whi[i]=vtr(vp_+((LDS_V2-LDS_V)+((i)>>2)*4096+((i)&3)*1024+512)); SBAR(); }while(0)
  #define KRD(G,j) do{ if(G){ kload2(kf,kp0+sl_next,j); SBAR(); } }while(0)
  #define STEP(C0,C1,P0,P1,t,GK,GV,GL) do{ SBAR(); \
    const lds_cptr vp_=vp0+sl_prev; \
    float sacc=(P0[0]+P0[1]); \
    GAPA(C0=__builtin_amdgcn_mfma_f32_32x32x16_bf16(kf[0],qr[0],negm,0,0,0), P0[2],P0[3],P0[4],P0[5],     pw0[0]=PKW(P0,0), pw0[1]=PKW(P0,2), pw0); \
    GAPA(C1=__builtin_amdgcn_mfma_f32_32x32x16_bf16(kf[1],qr[0],negm,0,0,0), P0[6],P0[7],P0[8],P0[9],     pw0[2]=PKW(P0,4), pw0[3]=PKW(P0,6), pw0); \
    GAPA(C0=__builtin_amdgcn_mfma_f32_32x32x16_bf16(kf[2],qr[1],C0,0,0,0),   P0[10],P0[11],P0[12],P0[13], pw1[0]=PKW(P0,8), pw1[1]=PKW(P0,10), pw1); \
    GAPA(C1=__builtin_amdgcn_mfma_f32_32x32x16_bf16(kf[3],qr[1],C1,0,0,0),   P0[14],P0[15],P1[0],P1[1],   pw1[2]=PKW(P0,12),pw1[3]=PKW(P0,14), pw1); \
    GAPA(C0=__builtin_amdgcn_mfma_f32_32x32x16_bf16(kf[4],qr[2],C0,0,0,0),   P1[2],P1[3],P1[4],P1[5],     pw2[0]=PKW(P1,0), pw2[1]=PKW(P1,2), pw2); \
    GAPA(C1=__builtin_amdgcn_mfma_f32_32x32x16_bf16(kf[5],qr[2],C1,0,0,0),   P1[6],P1[7],P1[8],P1[9],     pw2[2]=PKW(P1,4), pw2[3]=PKW(P1,6), pw2); \
    GAPA(C0=__builtin_amdgcn_mfma_f32_32x32x16_bf16(kf[6],qr[3],C0,0,0,0),   P1[10],P1[11],P1[12],P1[13], pw3[0]=PKW(P1,8), pw3[1]=PKW(P1,10), pw3); \
    GAPA(C1=__builtin_amdgcn_mfma_f32_32x32x16_bf16(kf[7],qr[3],C1,0,0,0),   P1[14],P1[15],0.f,0.f,       pw3[2]=PKW(P1,12),pw3[3]=PKW(P1,14), pw3); \
    l_reg+=sacc; \
    VRD(0);VRD(4);VRD(1);VRD(5);VRD(2);VRD(6);VRD(3);VRD(7); SBAR();     \
    if(GK){DMA_K((t)+3,sl_cur);} if(GV){DMA_V((t)+1,sl_next);} \
    CMASK(C0,C1,t); \
    { float a=MX3(C0[0],C0[1],C1[0]),b=MX3(C0[2],C0[3],C1[1]); a=MX3(a,C1[2],C1[3]); \
      _Pragma("unroll") for(int r=4;r<16;r+=4){a=MX3(a,C0[r],C0[r+1]);b=MX3(b,C0[r+2],C0[r+3]);a=MX3(a,C1[r],C1[r+1]);b=MX3(b,C1[r+2],C1[r+3]);} \
      float rm=__builtin_fmaxf(a,b); { auto rr=__builtin_amdgcn_permlane32_swap(__float_as_uint(rm),__float_as_uint(rm),false,false); rm=__builtin_fmaxf(__uint_as_float(rr[0]),__uint_as_float(rr[1])); } \
      resc=false; \
      if(__builtin_expect(__any(rm>(float)THRL),0)){ const float dl=__builtin_fmaxf(rm,0.f); mhat+=dl; \
        _Pragma("unroll") for(int r=0;r<16;++r){C0[r]-=dl;C1[r]-=dl;} \
        _Pragma("unroll") for(int r=0;r<16;++r)negm[r]=-mhat; asm volatile("":"+v"(negm)); \
        const float f=__builtin_amdgcn_exp2f(-dl); l_reg*=f; if(hi==0)wsf[r32]=f; resc=true; } } \
    SBAR(); \
    GAPB(o[0]=__builtin_amdgcn_mfma_f32_32x32x16_bf16(PAF(0),VFR(0),o[0],0,0,0), C0,0);  WRD(0); \
    GAPB(o[1]=__builtin_amdgcn_mfma_f32_32x32x16_bf16(PAF(0),VFR(4),o[1],0,0,0), C0,2);  WRD(4); \
    KRD(GL,0); GAPB(o[0]=__builtin_amdgcn_mfma_f32_32x32x16_bf16(PAF(1),VFR(1),o[0],0,0,0), C0,4);  WRD(1); \
    KRD(GL,1); GAPB(o[1]=__builtin_amdgcn_mfma_f32_32x32x16_bf16(PAF(1),VFR(5),o[1],0,0,0), C0,6);  WRD(5); \
    KRD(GL,2); GAPB(o[0]=__builtin_amdgcn_mfma_f32_32x32x16_bf16(PAF(2),VFR(2),o[0],0,0,0), C0,8);  WRD(2); \
    KRD(GL,3); GAPB(o[1]=__builtin_amdgcn_mfma_f32_32x32x16_bf16(PAF(2),VFR(6),o[1],0,0,0), C0,10); WRD(6); \
    GAPB(o[0]=__builtin_amdgcn_mfma_f32_32x32x16_bf16(PAF(3),VFR(3),o[0],0,0,0), C0,12); WRD(3); \
    GAPB(o[1]=__builtin_amdgcn_mfma_f32_32x32x16_bf16(PAF(3),VFR(7),o[1],0,0,0), C0,14); WRD(7); \
    GAPB(o[2]=__builtin_amdgcn_mfma_f32_32x32x16_bf16(PAF(0),WFR(0),o[2],0,0,0), C1,0); \
    GAPB(o[3]=__builtin_amdgcn_mfma_f32_32x32x16_bf16(PAF(0),WFR(4),o[3],0,0,0), C1,2); \
    GAPB(o[2]=__builtin_amdgcn_mfma_f32_32x32x16_bf16(PAF(1),WFR(1),o[2],0,0,0), C1,4); \
    GAPB(o[3]=__builtin_amdgcn_mfma_f32_32x32x16_bf16(PAF(1),WFR(5),o[3],0,0,0), C1,6); \
    GAPB(o[2]=__builtin_amdgcn_mfma_f32_32x32x16_bf16(PAF(2),WFR(2),o[2],0,0,0), C1,8); \
    GAPB(o[3]=__builtin_amdgcn_mfma_f32_32x32x16_bf16(PAF(2),WFR(6),o[3],0,0,0), C1,10); \
    GAPB(o[2]=__builtin_amdgcn_mfma_f32_32x32x16_bf16(PAF(3),WFR(3),o[2],0,0,0), C1,12); \
    GAPB(o[3]=__builtin_amdgcn_mfma_f32_32x32x16_bf16(PAF(3),WFR(7),o[3],0,0,0), C1,14); \
    }while(0)
  int t=1;
  #define FIX1(tt) do{ if((tt)==1){ _Pragma("unroll") for(int r=0;r<16;++r)negm[r]=-mhat; asm volatile("":"+v"(negm)); } }while(0)
  #undef CMASK
  #define CMASK(P0,P1,t) do{}while(0)
  for(;t+5<NT;t+=2){
    STEP(pB0,pB1,pA0,pA1,t,true,true,true);     WAIT_BAR(3); RESC(); ROT(); FIX1(t);
    STEP(pA0,pA1,pB0,pB1,t+1,true,true,true);   WAIT_BAR(3); RESC(); ROT();
  }
  #undef CMASK
  #define CMASK(P0,P1,t) do{int jb_=(t)-(NT-4); if(jb_>=0)cmask(P0,P1,jb_,qrel,hi);}while(0)
  #define ENDW(tt) do{ if((tt)+3<NT){WAIT_BAR(3);} else if((tt)+2<NT){WAIT_BAR(2);} else {WAIT_BAR(0);} }while(0)
  for(;t+1<NT;t+=2){
    STEP(pB0,pB1,pA0,pA1,t,(t+3<NT),(t+1<NT),(t+1<NT));       ENDW(t);   RESC(); ROT(); FIX1(t);
    STEP(pA0,pA1,pB0,pB1,t+1,(t+4<NT),(t+2<NT),(t+2<NT));     ENDW(t+1); RESC(); ROT();
  }
  STEP(pB0,pB1,pA0,pA1,NT-1,false,false,false); RESC();
  { float sacc=pB0[0]+pB0[1]; _Pragma("unroll") for(int r=2;r<16;++r)sacc+=pB0[r]; _Pragma("unroll") for(int r=0;r<16;++r)sacc+=pB1[r]; l_reg+=sacc;
    pw0=(u32x4){PKW(pB0,0),PKW(pB0,2),PKW(pB0,4),PKW(pB0,6)};pw1=(u32x4){PKW(pB0,8),PKW(pB0,10),PKW(pB0,12),PKW(pB0,14)};pw2=(u32x4){PKW(pB1,0),PKW(pB1,2),PKW(pB1,4),PKW(pB1,6)};pw3=(u32x4){PKW(pB1,8),PKW(pB1,10),PKW(pB1,12),PKW(pB1,14)};
    SBAR(); pv(o,vb0+sl_cur,PAF(0),PAF(1),PAF(2),PAF(3)); pv(o+2,vb0+(LDS_V2-LDS_V)+sl_cur,PAF(0),PAF(1),PAF(2),PAF(3)); }
  #undef PKW
  #undef PAF
  #undef VFR
  #undef WFR
  #undef WRD
  #undef PIN
  #undef MX3
  #undef GAPA
  #undef GAPB
  #undef EX
  #undef VRD
  #undef KRD
  #undef STEP
  #undef ENDW
  {auto rr=__builtin_amdgcn_permlane32_swap(__float_as_uint(l_reg),__float_as_uint(l_reg),false,false);l_reg=__uint_as_float(rr[0])+__uint_as_float(rr[1]);}
  if(hi==0)wsf[32+r32]=l_reg;asm volatile("s_waitcnt lgkmcnt(0)":::"memory");
  float rli[16];
  #pragma unroll
  for(int r=0;r<16;++r)rli[r]=__builtin_amdgcn_rcpf(wsf[32+crow(r,hi)]);
  bf16*Ow=O+(rowbase+q0+wid*QBLK)*DMO+hc*128;
  { lds_u16*stg=(lds_u16*)((lds_char*)shm+LDS_OST)+wid*2048;
    #pragma unroll
    for(int half=0;half<2;++half){
      #pragma unroll
      for(int r=0;r<16;++r){const int orow=crow(r,hi);
        #pragma unroll
        for(int d0=0;d0<2;++d0)stg[orow*64+d0*32+r32]=(unsigned short)(cvtpk_s(o[2*half+d0][r]*rli[r],0.f)&0xffffu);}
      asm volatile("s_waitcnt lgkmcnt(0)":::"memory");
      #pragma unroll
      for(int i=0;i<4;++i){const int row=i*8+(lane>>3),ch=lane&7; const u32x4 v=*(const __attribute__((address_space(3))) u32x4*)(stg+row*64+ch*8); ATTN_STORE16(Ow+(long)row*DMO+half*64+ch*8,v);}
      asm volatile("s_waitcnt lgkmcnt(0)":::"memory"); } }
  asm volatile("s_waitcnt lgkmcnt(0)\n\ts_barrier":::"memory");
  #undef DMA_K
  #undef DMA_V
  #undef CMASK
  #undef START
  #undef RESC
  #undef ROT
}
constexpr int ATTN_LDS_BYTES=LDS_BYTES;
struct AttnTensors { const bf16* Q; const bf16* K; const bf16* V; bf16* O; };
struct AttnUnit { int bh; int qb; };
struct StaticOrder {
  int vcu;
  __device__ __forceinline__ explicit StaticOrder(int grid,int block):vcu((block%8)*(grid/8)+block/8){}
  __device__ __forceinline__ bool next(int i,AttnUnit&u)const{ if(i>=4||vcu>=256)return false; const int s=vcu&3; u.bh=vcu>>2; u.qb=(i==0)?s:(i==1)?7-s:(i==2)?8+s:15-s; return true; }
  __device__ __forceinline__ void a_ready(const AttnUnit&)const{}
  __device__ __forceinline__ void done(const AttnUnit&)const{}
};
struct QueueOrder {
  unsigned* ctr; __attribute__((address_space(3))) unsigned* slot; int x; int tid0;
  __device__ __forceinline__ bool next(int,AttnUnit&u)const{
    if(tid0==0){ const unsigned e=__hip_atomic_fetch_add(ctr,1u,__ATOMIC_RELAXED,__HIP_MEMORY_SCOPE_AGENT); *slot=e; }
    asm volatile("s_waitcnt vmcnt(0) lgkmcnt(0)\n\ts_barrier":::"memory");
    const unsigned e=*slot;
    asm volatile("s_waitcnt lgkmcnt(0)\n\ts_barrier":::"memory");
    if(e>=64u)return false; u.bh=(int)(e&3u)*8+x; u.qb=15-(int)(e>>2); return true; }
  __device__ __forceinline__ void a_ready(const AttnUnit&)const{}
  __device__ __forceinline__ void done(const AttnUnit&)const{}
};
template<class Sched,int THRL=8> __device__ __forceinline__ void attn_phase(char*lds,const AttnTensors&T,const Sched&S,int tid_in){
  AttnUnit u;
  for(int i=0;S.next(i,u);++i){ S.a_ready(u); attn_unit<THRL>(u.bh/NHEAD,u.bh%NHEAD,u.qb,T.Q,T.K,T.V,T.O,lds,tid_in); S.done(u); }
}
#undef SBAR
#undef WAIT_BAR
}
#define GAS __attribute__((address_space(1)))
#define LAS __attribute__((address_space(3)))
typedef unsigned short bf16;
typedef unsigned v4u __attribute__((ext_vector_type(4)));
typedef float f32x4 __attribute__((ext_vector_type(4)));
typedef short bf16x8 __attribute__((ext_vector_type(8)));
typedef GAS unsigned gu32;
typedef GAS unsigned long long gu64;
#define RLX_AGENT __ATOMIC_RELAXED, __HIP_MEMORY_SCOPE_AGENT
#define LDS_WAIT() asm volatile("s_waitcnt lgkmcnt(0)" ::: "memory")
#define VM_WAIT() asm volatile("s_waitcnt vmcnt(0)" ::: "memory")
__device__ __forceinline__ unsigned long long rt() { return __builtin_amdgcn_s_memrealtime(); }
__device__ __forceinline__ unsigned f2bf(float f) { unsigned u = __builtin_bit_cast(unsigned, f); return (u + 0x7fffu + ((u >> 16) & 1u)) >> 16; }
__device__ __forceinline__ unsigned pk2(float lo, float hi) { return f2bf(lo) | (f2bf(hi) << 16); }

#define XB_TMO      128
#define XB_XCNT(j)  (256  + 64 * (j))
#define XB_XSUB(j)  (1280 + 64 * (j))
#define XB_XGEN(j)  (2304 + 64 * (j))
#define XB_TOP      3328
#define XB_TOPGEN   3392
#define XCD_BAR_WORDS 3456
#define XB_SPIN_CAP (1u << 18)

__device__ __forceinline__ unsigned xb_ld(unsigned* p)              { return __hip_atomic_load(p, __ATOMIC_RELAXED, __HIP_MEMORY_SCOPE_AGENT); }
__device__ __forceinline__ unsigned xb_add(unsigned* p, unsigned v) { return __hip_atomic_fetch_add(p, v, __ATOMIC_RELAXED, __HIP_MEMORY_SCOPE_AGENT); }
__device__ __forceinline__ unsigned xb_xcc_id() { return (unsigned)__builtin_amdgcn_s_getreg((3 << 11) | 20) & 0xFu; }
#define XB_SPIN(cond, bar) do { unsigned _sp = 0; while (cond) { __builtin_amdgcn_s_sleep(1); \
    if ((++_sp & 255u) == 0u) { if (xb_ld(&(bar)[XB_TMO])) break; if (_sp > XB_SPIN_CAP) { atomicAdd(&(bar)[XB_TMO], 1u); break; } } } } while (0)

struct XcdBarrier {
    unsigned* bar; unsigned x; int wv;
    volatile LAS unsigned* st;
};

__device__ __forceinline__ XcdBarrier xcd_barrier_post(unsigned* bar, volatile LAS unsigned* st) {
    XcdBarrier b; b.bar = bar; b.x = xb_xcc_id(); b.st = st;
    if (threadIdx.x == 0) (void)xb_add(&bar[XB_XCNT(b.x)], 1u);
    return b;
}
__device__ __forceinline__ void xcd_barrier_complete(unsigned* bar, unsigned x, unsigned& nloc, unsigned& nx) {
    const unsigned G = gridDim.x * gridDim.y * gridDim.z;
    unsigned sum, cnt, mine, sp = 0u;
    for (;;) {
        sum = 0u; cnt = 0u; mine = 0u;
#pragma unroll
        for (unsigned j = 0; j < 16; ++j) { const unsigned c = xb_ld(&bar[XB_XCNT(j)]); sum += c; cnt += (c > 0u) ? 1u : 0u; mine = (j == x) ? c : mine; }
        if (sum == G) break;
        __builtin_amdgcn_s_sleep(1);
        if ((++sp & 255u) == 0u) { if (xb_ld(&bar[XB_TMO])) break; if (sp > XB_SPIN_CAP) { atomicAdd(&bar[XB_TMO], 1u); break; } }
    }
    nloc = mine > 0u ? mine : 1u; nx = cnt > 0u ? cnt : 1u;
}

__device__ __forceinline__ void xcd_barrier(const XcdBarrier& b) {
    asm volatile("s_waitcnt vmcnt(0)" ::: "memory");
    __syncthreads();
    unsigned ln_; asm volatile("v_mbcnt_lo_u32_b32 %0, -1, 0\n\tv_mbcnt_hi_u32_b32 %0, -1, %0" : "=v"(ln_));
    if (b.wv == 0 && ln_ == 0u) {
        unsigned* bar = b.bar;
        __builtin_amdgcn_s_waitcnt(0);
        unsigned nloc = b.st[0], nx = b.st[1];
        if (nloc == 0u) { xcd_barrier_complete(bar, b.x, nloc, nx); b.st[0] = nloc; b.st[1] = nx; }
        const unsigned old = xb_add(&bar[XB_XSUB(b.x)], 1u);
        const unsigned gen = old / nloc;
        if (old + 1u == (gen + 1u) * nloc) {
            __builtin_amdgcn_fence(__ATOMIC_RELEASE, "agent");
            asm volatile("s_waitcnt vmcnt(0)" ::: "memory");
            const unsigned og = xb_add(&bar[XB_TOP], 1u);
            const unsigned tg = og / nx;
            if (og + 1u == (tg + 1u) * nx) xb_add(&bar[XB_TOPGEN], 1u);
            else XB_SPIN(xb_ld(&bar[XB_TOPGEN]) == tg, bar);
            __builtin_amdgcn_fence(__ATOMIC_ACQUIRE, "agent");
            xb_add(&bar[XB_XGEN(b.x)], 1u);
            asm volatile("s_waitcnt vmcnt(0)" ::: "memory");
        } else {
            XB_SPIN(xb_ld(&bar[XB_XGEN(b.x)]) == gen, bar);
            __builtin_amdgcn_fence(__ATOMIC_ACQUIRE, "agent");
            asm volatile("s_waitcnt vmcnt(0)" ::: "memory");
        }
    }
    __syncthreads();
}

constexpr int NWAVES = 8;
constexpr int DM = 1024, NB = 4, SEQ = 4096, NMETA = 16, DEPTH = 4;
constexpr int NREAL = NB * SEQ;
constexpr int NTOK = NREAL + NMETA;
constexpr int MPAD = 16640;
constexpr int INC = 3200, INP = 3328;
constexpr int RCOLS = 896, QOFF = 896, KOFF = 896 + 512, VOFF = 896 + 1024, COFF = 2432;
constexpr int FF = 2816, FF2 = 5632, NE = 8;
constexpr int KVROWS = 128 + SEQ;
constexpr int MOEP = 35072;
constexpr float C2Q = 0.125f * 1.4426950408889634f;

constexpr size_t MiB = 1u << 20;
constexpr size_t WS_CTL = 0, CTL_ZERO_BYTES = 1 * MiB;
constexpr size_t WS_COS = 1 * MiB, WS_SIN = 1 * MiB + 192 * 1024;
constexpr size_t WS_RSTD = 1 * MiB + 512 * 1024;
constexpr size_t WS_RSROW = 1 * MiB + 768 * 1024;
constexpr size_t WS_TOKE = 2 * MiB, WS_TOKS = 2 * MiB + 256 * 1024, WS_TOKG = 2 * MiB + 512 * 1024;
constexpr size_t WS_WIN = 4 * MiB;
constexpr size_t WS_WOUT = 30 * MiB;
constexpr size_t WS_WGU = 38 * MiB;
constexpr size_t WS_WD = 60 * MiB;
constexpr size_t WS_MWGU = 72 * MiB;
constexpr size_t WS_MWD = 160 * MiB;
constexpr size_t WS_H = 204 * MiB;
constexpr size_t WS_HB = 269 * MiB;
constexpr size_t WS_PH = 302 * MiB;
constexpr size_t WS_PROJ = WS_PH;
constexpr size_t WS_QN = 408 * MiB;
constexpr size_t WS_KP = 425 * MiB;
constexpr size_t WS_VP = 442 * MiB;
constexpr size_t WS_OC = 459 * MiB;
constexpr size_t WS_OMIX = 492 * MiB;
constexpr size_t WS_SC = 525 * MiB, SC_STRIDE = 17 * MiB;
constexpr size_t WS_MIX_END = WS_SC + 9 * SC_STRIDE;
constexpr size_t WS_G = WS_PH;
constexpr size_t WS_AROWS = 491 * MiB;
constexpr size_t WS_YM = 560 * MiB;
constexpr size_t WS_LORA = 680 * MiB;
constexpr size_t WS_END = 714 * MiB;
static_assert(WS_PROJ + (size_t)MPAD * INP * 2 <= WS_QN && WS_G + (size_t)MOEP * FF * 2 <= WS_AROWS && WS_AROWS + (size_t)MOEP * 1024 * 2 <= WS_YM && WS_YM + (size_t)MOEP * 1024 * 2 <= WS_END, "ws map");
static_assert((size_t)8 * FF2 * DM <= 44 * MiB && 44 * MiB + (size_t)4112 * 11008 + 1024 <= 88 * MiB && (size_t)4112 * 8192 <= (size_t)MPAD * 2048, "chunk buffers");
static_assert(WS_H + (size_t)MPAD * 1024 * 4 <= WS_HB && WS_HB + (size_t)MPAD * 1024 * 2 <= WS_PH && WS_MIX_END <= WS_END, "ws map 2");
static_assert((size_t)NTOK * 256 * 4 <= SC_STRIDE && WS_OC + (size_t)NTOK * 2048 <= WS_OMIX && WS_OMIX + (size_t)MPAD * 2048 <= WS_SC, "ws map 3");
constexpr int CW_MOECNT = 1024;
constexpr int CW_BAR = 4096;
constexpr int CW_ATTQ = 8192;

constexpr int LDS_BYTES = 147456;
constexpr int MISC_OFF = LDS_BYTES - 128;

struct Args { const float* in[32]; float* out; unsigned char* ws; int ph_lo, ph_hi; };

__device__ __forceinline__ v4u zero_v4u() { unsigned z; asm volatile("v_mov_b32 %0, 0" : "=v"(z)); return (v4u){z, z, z, z}; }
__device__ __forceinline__ unsigned pk4_fp8(float a, float b, float c, float d) {
    a = __builtin_amdgcn_fmed3f(a, -448.f, 448.f); b = __builtin_amdgcn_fmed3f(b, -448.f, 448.f); c = __builtin_amdgcn_fmed3f(c, -448.f, 448.f); d = __builtin_amdgcn_fmed3f(d, -448.f, 448.f);
    unsigned p = (unsigned)__builtin_amdgcn_cvt_pk_fp8_f32(a, b, 0, false); return (unsigned)__builtin_amdgcn_cvt_pk_fp8_f32(c, d, (int)p, true); }
#ifndef INP8_MASK
#define INP8_MASK 0xC
#endif
constexpr int INP8 = INP8_MASK;
constexpr float W8_SCALE = 64.f, A8_SCALE = 16.f, G8_SCALE = 4.f, H8_SCALE = 4.f;
__device__ __forceinline__ float bf2f(unsigned short b) { return __uint_as_float(((unsigned)b) << 16); }
#define DPP_F(x, ctrl) __int_as_float(__builtin_amdgcn_update_dpp(0, __float_as_int(x), ctrl, 0xF, 0xF, true))
__device__ __forceinline__ float lane_xor1(float v) { return DPP_F(v, 0xB1); }
__device__ __forceinline__ float sum8(float v) { v += DPP_F(v, 0xB1); v += DPP_F(v, 0x4E); v += DPP_F(v, 0x141); return v; }
__device__ __forceinline__ float sum16(float v) { v = sum8(v); v += DPP_F(v, 0x140); return v; }
__device__ __forceinline__ float wave_sum_dpp(float p) {
    p = sum16(p);
    asm volatile("s_nop 1\n\tv_add_f32_dpp %0, %0, %0 row_bcast:15 row_mask:0xa bank_mask:0xf\n\ts_nop 1\n\tv_add_f32_dpp %0, %0, %0 row_bcast:31 row_mask:0xc bank_mask:0xf\n\ts_nop 0" : "+v"(p));
    return __int_as_float(__builtin_amdgcn_readlane(__float_as_int(p), 63));
}
__device__ __forceinline__ float wave_sum(float v) { return wave_sum_dpp(v); }
__device__ __forceinline__ float wave_max(float v) {
    v = fmaxf(v, DPP_F(v, 0xB1)); v = fmaxf(v, DPP_F(v, 0x4E)); v = fmaxf(v, DPP_F(v, 0x141)); v = fmaxf(v, DPP_F(v, 0x140));
    asm volatile("s_nop 1\n\tv_max_f32_dpp %0, %0, %0 row_bcast:15 row_mask:0xa bank_mask:0xf\n\ts_nop 1\n\tv_max_f32_dpp %0, %0, %0 row_bcast:31 row_mask:0xc bank_mask:0xf\n\ts_nop 0" : "+v"(v));
    return __int_as_float(__builtin_amdgcn_readlane(__float_as_int(v), 63));
}
__device__ __forceinline__ float sigmoidf_(float x) { return 1.f / (1.f + __expf(-x)); }
__device__ __forceinline__ int prevrow(int row) { if (row < 0) return -1; if (row >= NREAL) return row == NREAL ? -1 : row - 1; return (row & (SEQ - 1)) == 0 ? NTOK - 1 : row - 1; }

__device__ __forceinline__ void tr_item(const float* W, int K, int N, bf16* WT, int rowmode, const float* gk, LAS float* scr, int item, int lane) {
    const int nblk = N / 32, kb = item / nblk, nb = item % nblk, k0 = 64 * kb, n0 = 32 * nb;
    const float* src = W + (size_t)(k0 + (lane >> 5)) * N + n0 + (lane & 31);
    float v[32];
#pragma unroll
    for (int i = 0; i < 32; ++i) v[i] = src[(size_t)(2 * i) * N];
#pragma unroll
    for (int i = 0; i < 32; ++i) scr[(2 * i + (lane >> 5)) * 33 + (lane & 31)] = v[i];
    LDS_WAIT(); asm volatile("" ::: "memory");
    const int c = lane & 7;
    f32x4 g0 = (f32x4){1.f, 1.f, 1.f, 1.f}, g1 = g0;
    if (gk) { g0 = *(const f32x4*)(gk + k0 + 8 * c); g1 = *(const f32x4*)(gk + k0 + 8 * c + 4); }
#pragma unroll
    for (int j = 0; j < 4; ++j) { const int n = (lane >> 3) + 8 * j; const LAS float* s = scr + (8 * c) * 33 + n;
        v4u o; o.x = pk2(s[0 * 33] * g0.x, s[1 * 33] * g0.y); o.y = pk2(s[2 * 33] * g0.z, s[3 * 33] * g0.w); o.z = pk2(s[4 * 33] * g1.x, s[5 * 33] * g1.y); o.w = pk2(s[6 * 33] * g1.z, s[7 * 33] * g1.w);
        const int nn = n0 + n; const int drow = rowmode == 0 ? nn : ((nn >> 7) * 256 + (nn & 127) + (rowmode == 2 ? 128 : 0));
        *(GAS v4u*)(WT + (size_t)drow * K + k0 + 8 * c) = o; }
    LDS_WAIT(); asm volatile("" ::: "memory");
}

__device__ __forceinline__ void tr_item2(const float* W0, int K0, int N0, bf16* WT0, int rm0, const float* gk0, int item0,
                                         const float* W1, int K1, int N1, bf16* WT1, int rm1, const float* gk1, int item1, LAS float* scr, int lane, bool f8_0 = false, bool f8_1 = false) {
    const int nb0_ = N0 / 32, nb1_ = N1 / 32;
    const int k00 = 64 * (item0 / nb0_), n00 = 32 * (item0 % nb0_), k01 = 64 * (item1 / nb1_), n01 = 32 * (item1 % nb1_);
    const float* s0 = W0 + (size_t)(k00 + (lane >> 5)) * N0 + n00 + (lane & 31); const float* s1 = W1 + (size_t)(k01 + (lane >> 5)) * N1 + n01 + (lane & 31);
    float v0[32], v1[32];
#pragma unroll
    for (int i = 0; i < 32; ++i) { v0[i] = s0[(size_t)(2 * i) * N0]; v1[i] = s1[(size_t)(2 * i) * N1]; }
    LAS float* t0 = scr; LAS float* t1 = scr + 64 * 33;
#pragma unroll
    for (int i = 0; i < 32; ++i) { t0[(2 * i + (lane >> 5)) * 33 + (lane & 31)] = v0[i]; t1[(2 * i + (lane >> 5)) * 33 + (lane & 31)] = v1[i]; }
    LDS_WAIT(); asm volatile("" ::: "memory");
    const int c = lane & 7;
#pragma unroll
    for (int q = 0; q < 2; ++q) { const float* gk = q ? gk1 : gk0; const int k0 = q ? k01 : k00, n0 = q ? n01 : n00, K = q ? K1 : K0, rowmode = q ? rm1 : rm0; bf16* WT = q ? WT1 : WT0; const LAS float* tt = q ? t1 : t0;
        f32x4 g0 = (f32x4){1.f, 1.f, 1.f, 1.f}, g1 = g0;
        if (gk) { g0 = *(const f32x4*)(gk + k0 + 8 * c); g1 = *(const f32x4*)(gk + k0 + 8 * c + 4); }
#pragma unroll
        for (int j = 0; j < 4; ++j) { const int n = (lane >> 3) + 8 * j; const LAS float* s = tt + (8 * c) * 33 + n;
            v4u o; o.x = pk2(s[0 * 33] * g0.x, s[1 * 33] * g0.y); o.y = pk2(s[2 * 33] * g0.z, s[3 * 33] * g0.w); o.z = pk2(s[4 * 33] * g1.x, s[5 * 33] * g1.y); o.w = pk2(s[6 * 33] * g1.z, s[7 * 33] * g1.w);
            const int nn = n0 + n; const int drow = rowmode == 0 ? nn : ((nn >> 7) * 256 + (nn & 127) + (rowmode == 2 ? 128 : 0));
            if (q ? f8_1 : f8_0) { const unsigned lo = pk4_fp8(s[0 * 33] * g0.x * W8_SCALE, s[1 * 33] * g0.y * W8_SCALE, s[2 * 33] * g0.z * W8_SCALE, s[3 * 33] * g0.w * W8_SCALE), hi8 = pk4_fp8(s[4 * 33] * g1.x * W8_SCALE, s[5 * 33] * g1.y * W8_SCALE, s[6 * 33] * g1.z * W8_SCALE, s[7 * 33] * g1.w * W8_SCALE);
                *(GAS unsigned long long*)((GAS unsigned char*)WT + (size_t)drow * K + k0 + 8 * c) = (unsigned long long)lo | ((unsigned long long)hi8 << 32); }
            else *(GAS v4u*)(WT + (size_t)drow * K + k0 + 8 * c) = o; } }
    LDS_WAIT(); asm volatile("" ::: "memory");
}

__device__ __forceinline__ void meta_gemm_res(const bf16* A, int K, const bf16* Bt, float* Hm, LAS unsigned char* lds, int bx, int wave, int lane, int hbmode = 0, bf16* HBm = nullptr, unsigned long long* rsqm = nullptr) {
    if (bx < 32) {
        typedef short bfx8 __attribute__((ext_vector_type(8)));
        const int ct = 2 * bx + (wave >> 2), ksp = wave & 3, n = lane & 15, kq = lane >> 4; const int kc = K >> 2, steps = kc >> 5;
        const bf16* ap = A + (size_t)n * K + ksp * kc + 8 * kq; const bf16* wp = Bt + (size_t)(16 * ct + n) * K + ksp * kc + 8 * kq;
        f32x4 acc = (f32x4){0.f, 0.f, 0.f, 0.f};
#pragma unroll 11
        for (int s = 0; s < steps; ++s) { const v4u a = *(const v4u*)(wp + 32 * s), b = *(const v4u*)(ap + 32 * s);
            acc = __builtin_amdgcn_mfma_f32_16x16x32_bf16(__builtin_bit_cast(bfx8, a), __builtin_bit_cast(bfx8, b), acc, 0, 0, 0); }
        LAS f32x4* red = (LAS f32x4*)lds;
        red[wave * 64 + lane] = acc;
        __syncthreads();
        if (ksp == 0) { const f32x4 s = (red[wave * 64 + lane] + red[(wave + 1) * 64 + lane]) + (red[(wave + 2) * 64 + lane] + red[(wave + 3) * 64 + lane]);
            f32x4* hp = (f32x4*)(Hm + (size_t)n * 1024 + 16 * ct + 4 * kq); const f32x4 hn = *hp + s; *hp = hn;
            if (hbmode) { const int cc = 16 * ct + 4 * kq;
                if (hbmode == 1) *(unsigned long long*)(HBm + (size_t)n * 1024 + cc) = (unsigned long long)pk2(hn.x, hn.y) | ((unsigned long long)pk2(hn.z, hn.w) << 32);
                else *(unsigned*)((unsigned char*)HBm + (size_t)n * 1024 + cc) = pk4_fp8(hn.x * H8_SCALE, hn.y * H8_SCALE, hn.z * H8_SCALE, hn.w * H8_SCALE);
                __hip_atomic_fetch_add(rsqm + n, (unsigned long long)(((hn.x * hn.x + hn.y * hn.y) + (hn.z * hn.z + hn.w * hn.w)) * 16777216.f), RLX_AGENT); } }
        __syncthreads();
    }
}

__device__ __forceinline__ void meta_gemm_res8(const unsigned char* A, int K, const unsigned char* Bt, float* Hm, float sc, LAS unsigned char* lds, int bx, int wave, int lane) {
    if (bx < 32) {
        typedef int v8i_ __attribute__((ext_vector_type(8)));
        const int ct = 2 * bx + (wave >> 2), ksp = wave & 3, n = lane & 15, kq = lane >> 4; const int kc = K >> 2, steps = kc >> 7;
        const int s0 = ksp < 2 ? 6 * ksp : 12 + 5 * (ksp - 2), ns = ksp < 2 ? 6 : 5; (void)kc; (void)steps;
        const unsigned char* ap = A + (size_t)n * K + 32 * kq; const unsigned char* wp = Bt + (size_t)(16 * ct + n) * K + 32 * kq;
        f32x4 acc = (f32x4){0.f, 0.f, 0.f, 0.f};
#pragma unroll 6
        for (int s = s0; s < s0 + ns; ++s) { const v4u a0 = *(const v4u*)(wp + 128 * s), a1 = *(const v4u*)(wp + 128 * s + 16), b0 = *(const v4u*)(ap + 128 * s), b1 = *(const v4u*)(ap + 128 * s + 16);
            const v8i_ aa = (v8i_){(int)a0.x, (int)a0.y, (int)a0.z, (int)a0.w, (int)a1.x, (int)a1.y, (int)a1.z, (int)a1.w}, bb = (v8i_){(int)b0.x, (int)b0.y, (int)b0.z, (int)b0.w, (int)b1.x, (int)b1.y, (int)b1.z, (int)b1.w};
            acc = __builtin_amdgcn_mfma_scale_f32_16x16x128_f8f6f4(aa, bb, acc, 0, 0, 0, 0x7f7f7f7f, 0, 0x7f7f7f7f); }
        LAS f32x4* red = (LAS f32x4*)lds;
        red[wave * 64 + lane] = acc;
        __syncthreads();
        if (ksp == 0) { const f32x4 s = (red[wave * 64 + lane] + red[(wave + 1) * 64 + lane]) + (red[(wave + 2) * 64 + lane] + red[(wave + 3) * 64 + lane]);
            f32x4* hp = (f32x4*)(Hm + (size_t)n * 1024 + 16 * ct + 4 * kq); *hp = *hp + s * sc; }
        __syncthreads();
    }
}

__global__ void __launch_bounds__(NWAVES * 64, 2) hymba_fwd(Args args) {
    extern __shared__ __attribute__((aligned(16))) unsigned char lds_raw[];
    LAS unsigned char* lds = (LAS unsigned char*)lds_raw;
    volatile LAS unsigned* MISC = (volatile LAS unsigned*)(lds + MISC_OFF);
    const int wave = __builtin_amdgcn_readfirstlane((int)threadIdx.x >> 6);
#define PH_TID int tid; asm volatile("v_mbcnt_lo_u32_b32 %0, -1, 0\n\tv_mbcnt_hi_u32_b32 %0, -1, %0" : "=v"(tid)); tid += wave * 64; const int lane = tid & 63; (void)lane; unsigned char* ws = ws0; asm volatile("" : "+s"(ws)); const char* ka = ka0; asm volatile("" : "+s"(ka)); (void)ka
    const int G = gridDim.x, bx = blockIdx.x;
    const int gw = bx * NWAVES + wave, NGW = G * NWAVES;
    unsigned char* const ws0 = args.ws;
    const char* const ka0 = (const char*)__builtin_amdgcn_kernarg_segment_ptr();
    { const int t0_ = (int)threadIdx.x; if (t0_ < 32) ((LAS unsigned*)(lds + MISC_OFF))[t0_] = 0u; }
    __syncthreads();
    const int lo = args.ph_lo, hi = args.ph_hi;
    const bool multi = (hi - lo) > 1;
    XcdBarrier bar; bar.bar = (unsigned*)(ws0 + WS_CTL) + CW_BAR; bar.x = 0; bar.st = nullptr; bar.wv = wave;
    if (multi) { bar = xcd_barrier_post((unsigned*)(ws0 + WS_CTL) + CW_BAR, MISC + 8); bar.wv = wave; }
#ifndef ENMASK
#define ENMASK 0xFFFF
#endif
#define EN(k) (((ENMASK) >> (k)) & 1)
#ifndef REPMASK
#define REPMASK 0
#endif
#define NREP(k) ((((REPMASK) >> (k)) & 1) ? 2 : 1)
#define IN(k) (lo <= (k) && (k) < hi)
#define SEAM(k) do { if (hi > (k) + 1) xcd_barrier(bar); } while (0)

#define Hf ((float*)(ws + WS_H))
#define HB ((bf16*)(ws + WS_HB))
#define RSTD ((float*)(ws + WS_RSTD))
#define PROJ ((bf16*)(ws + WS_PROJ))
#define QN ((bf16*)(ws + WS_QN))
#define KP ((bf16*)(ws + WS_KP))
#define VP ((bf16*)(ws + WS_VP))
#define OC ((bf16*)(ws + WS_OC))
#define OMIX ((bf16*)(ws + WS_OMIX))
#define SP4 ((f32x4*)(ws + WS_SC + 0 * SC_STRIDE))
#define SR ((float*)(ws + WS_SC + 4 * SC_STRIDE))
#define SV ((float*)(ws + WS_SC + 5 * SC_STRIDE))
#define SG ((float*)(ws + WS_SC + 6 * SC_STRIDE))
#define SBON ((float*)(ws + WS_SC + 7 * SC_STRIDE))
#define SY ((float*)(ws + WS_SC + 8 * SC_STRIDE))
#define COS ((float*)(ws + WS_COS))
#define SIN ((float*)(ws + WS_SIN))
#define GB ((bf16*)(ws + WS_G))
#define AROWS ((bf16*)(ws + WS_AROWS))
#define YM ((bf16*)(ws + WS_YM))
#define RSQA ((unsigned long long*)(ws + WS_RSROW))
#define TOKE ((int*)(ws + WS_TOKE))
#define TOKS ((int*)(ws + WS_TOKS))
#define TOKG ((float*)(ws + WS_TOKG))
#define ctl ((gu32*)(ws + WS_CTL))
#define INP(i) (*(const float* const*)(ka + 8 * (i)))
#define LORA_W ((float*)(ws + WS_LORA))
#define LORA_AG ((bf16*)(ws + WS_LORA + 17 * MiB))
#define CH_REC ((unsigned char*)(ws + WS_MWGU + 44 * MiB))
#define CH_RB 11008
#define CH_SPK ((unsigned char*)(ws + WS_HB))
#ifndef SCAN_CHUNKED
#define SCAN_CHUNKED 1
#endif

    for (int rep_ = 0; rep_ < NREP(15); ++rep_) if (EN(15) && IN(0)) { PH_TID;
        LAS float* scr = (LAS float*)(lds + wave * 17408);
        constexpr int I_IN = 16 * 100, I_OUT = 16 * 32, I_GU = 16 * 88, I_DN = 44 * 32;
        constexpr int NITEMS = DEPTH * (I_IN + I_OUT) + 2 * (2 * I_GU + I_DN);
        for (int it0 = 2 * gw; it0 < NITEMS; it0 += 2 * NGW) {
            const float* W_[2]; bf16* D_[2]; int K_[2], N_[2], rm_[2], r_[2]; const float* g_[2]; bool f8_[2] = {false, false};
#pragma unroll
            for (int q = 0; q < 2; ++q) { int r = it0 + q;
                if (r < DEPTH * I_IN) { const int l = r / I_IN; W_[q] = INP(3) + (size_t)l * DM * INC; K_[q] = DM; N_[q] = INC; D_[q] = (bf16*)(ws + WS_WIN) + (size_t)l * INP * DM; rm_[q] = 0; g_[q] = INP(2) + l * DM; r_[q] = r % I_IN; f8_[q] = ((INP8 >> l) & 1) != 0; continue; } r -= DEPTH * I_IN;
                if (r < DEPTH * I_OUT) { const int l = r / I_OUT; W_[q] = INP(23) + (size_t)l * DM * DM; K_[q] = DM; N_[q] = DM; D_[q] = (bf16*)(ws + WS_WOUT) + (size_t)l * DM * DM; rm_[q] = 0; g_[q] = nullptr; r_[q] = r % I_OUT; continue; } r -= DEPTH * I_OUT;
                if (r < 2 * I_GU) { const int j = r / I_GU; W_[q] = INP(25) + (size_t)j * DM * FF; K_[q] = DM; N_[q] = FF; D_[q] = (bf16*)(ws + WS_WGU) + (size_t)j * FF2 * DM; rm_[q] = 1; g_[q] = INP(24) + (2 * j) * DM; r_[q] = r % I_GU; f8_[q] = (j == 1); continue; } r -= 2 * I_GU;
                if (r < 2 * I_GU) { const int j = r / I_GU; W_[q] = INP(26) + (size_t)j * DM * FF; K_[q] = DM; N_[q] = FF; D_[q] = (bf16*)(ws + WS_WGU) + (size_t)j * FF2 * DM; rm_[q] = 2; g_[q] = INP(24) + (2 * j) * DM; r_[q] = r % I_GU; f8_[q] = (j == 1); continue; } r -= 2 * I_GU;
                { const int j = r / I_DN; W_[q] = INP(27) + (size_t)j * FF * DM; K_[q] = FF; N_[q] = DM; D_[q] = (bf16*)(ws + WS_WD) + (size_t)j * DM * FF; rm_[q] = 0; g_[q] = nullptr; r_[q] = r % I_DN; f8_[q] = (j == 1); } }
            tr_item2(W_[0], K_[0], N_[0], D_[0], rm_[0], g_[0], r_[0], W_[1], K_[1], N_[1], D_[1], rm_[1], g_[1], r_[1], scr, lane, f8_[0], f8_[1]);
        }
        const int gt = bx * (NWAVES * 64) + tid, NGT = G * NWAVES * 64;
        for (int i = gt; i < DEPTH * 128 * (DM / 8); i += NGT) { const int l = i / (128 * (DM / 8)), r = i % (128 * (DM / 8));
            if ((INP8 >> l) & 1) { if (r < 128 * (DM / 16)) ((v4u*)((unsigned char*)(ws + WS_WIN) + (size_t)l * INP * DM * 2 + (size_t)INC * DM))[r] = zero_v4u(); }
            else ((v4u*)((bf16*)(ws + WS_WIN) + ((size_t)l * INP + INC) * DM))[r] = zero_v4u(); }
        for (int row = gw; row < MPAD; row += NGW) {
            f32x4 v[4]; float s = 0.f;
#pragma unroll
            for (int j = 0; j < 4; ++j) { const int c4 = lane + 64 * j; v[j] = __builtin_bit_cast(f32x4, zero_v4u());
                if (row < NREAL) v[j] = ((const f32x4*)INP(0))[(size_t)row * (DM / 4) + c4]; else if (row < NTOK) v[j] = ((const f32x4*)INP(1))[(row - NREAL) * (DM / 4) + c4];
                ((f32x4*)Hf)[(size_t)row * (DM / 4) + c4] = v[j]; s += (v[j].x * v[j].x + v[j].y * v[j].y) + (v[j].z * v[j].z + v[j].w * v[j].w); }
            if (row < NTOK) { s = wave_sum(s); const float rstd = 1.f / sqrtf(s * (1.f / DM) + 1e-6f);
                if (INP8 & 1) { const float sn = rstd * A8_SCALE;
#pragma unroll
                    for (int j = 0; j < 4; ++j) ((unsigned*)((unsigned char*)HB + (size_t)row * DM))[lane + 64 * j] = pk4_fp8(v[j].x * sn, v[j].y * sn, v[j].z * sn, v[j].w * sn); }
                else {
#pragma unroll
                    for (int j = 0; j < 4; ++j) ((unsigned long long*)(HB + (size_t)row * DM))[lane + 64 * j] = (unsigned long long)pk2(v[j].x, v[j].y) | ((unsigned long long)pk2(v[j].z, v[j].w) << 32); }
                if (lane == 0) RSTD[row] = rstd; }
        }
        if (INP8 & 1) { for (int i = gt; i < (MPAD - NTOK) * (DM / 16); i += NGT) ((v4u*)((unsigned char*)HB + (size_t)NTOK * DM))[i] = zero_v4u(); }
        else
        for (int i = gt; i < (MPAD - NTOK) * (DM / 8); i += NGT) ((v4u*)(HB + (size_t)NTOK * DM))[i] = zero_v4u();
        for (int i = gt; i < MPAD - NTOK; i += NGT) RSTD[NTOK + i] = 0.f;
        for (int i = gt; i < (SEQ + NMETA) * 8; i += NGT) { const int pos = i >> 3, j = i & 7;
            const float invf = j == 0 ? 1.000000000e+00f : j == 1 ? 1.939227432e-01f : j == 2 ? 3.760603070e-02f : j == 3 ? 7.292664610e-03f : j == 4 ? 1.414213562e-03f : j == 5 ? 2.742481884e-04f : j == 6 ? 5.318296098e-05f : 1.031338616e-05f;
            const float angf = (float)pos * invf; const double a = (double)angf; const double n = __builtin_rint(a * 0.15915494309189535);
            const double rr = (a - n * 6.283185307179586) - n * 2.4492935982947064e-16; const float rev = (float)(rr * 0.15915494309189535);
            COS[i] = __builtin_amdgcn_cosf(rev); SIN[i] = __builtin_amdgcn_sinf(rev); }
        SEAM(0);
    }

#pragma nounroll
    for (int layer = 0; layer < DEPTH; ++layer) {
        const int pb = 1 + 12 * layer; const bool moe = (layer & 1) != 0; const int jj = layer >> 1;
        if (hi <= pb || lo >= pb + 12) continue;
        const float lam_init = 0.8f - 0.6f * __expf(-0.3f * (float)layer);

        for (int rep_ = 0; rep_ < NREP(0); ++rep_) if (EN(0) && IN(pb + 0) && moe) { PH_TID;
            for (int row = gw; row < NTOK; row += NGW) {
                const GAS f32x4* xr = (const GAS f32x4*)(Hf + (size_t)row * DM) + lane; f32x4 v[4]; float s = 0.f;
#pragma unroll
                for (int j = 0; j < 4; ++j) { v[j] = xr[64 * j]; s += (v[j].x * v[j].x + v[j].y * v[j].y) + (v[j].z * v[j].z + v[j].w * v[j].w); }
                s = wave_sum(s); const float rstd = 1.f / sqrtf(s * (1.f / DM) + 1e-6f);
                if ((INP8 >> layer) & 1) { GAS unsigned* o4 = (GAS unsigned*)((GAS unsigned char*)HB + (size_t)row * DM) + lane; const float sn = rstd * A8_SCALE;
#pragma unroll
                    for (int j = 0; j < 4; ++j) o4[64 * j] = pk4_fp8(v[j].x * sn, v[j].y * sn, v[j].z * sn, v[j].w * sn); }
                else { GAS unsigned long long* o8 = (GAS unsigned long long*)(HB + (size_t)row * DM) + lane;
#pragma unroll
                    for (int j = 0; j < 4; ++j) o8[64 * j] = (unsigned long long)pk2(v[j].x, v[j].y) | ((unsigned long long)pk2(v[j].z, v[j].w) << 32); }
                if (lane == 0) RSTD[row] = rstd;
            }
            if ((INP8 >> layer) & 1) { const int gt = bx * (NWAVES * 64) + tid, NGT = G * NWAVES * 64;
                for (int i = gt; i < (MPAD - NTOK) * (DM / 16); i += NGT) ((v4u*)((unsigned char*)HB + (size_t)NTOK * DM))[i] = zero_v4u(); }
            if (moe) {
                LAS float* scr = (LAS float*)(lds + wave * 17408);
                constexpr int I_GU = 16 * 88, I_DN = 44 * 32, PER_E = 2 * I_GU + I_DN;
                const float* gff = INP(24) + layer * DM;
                for (int it0 = 2 * gw; it0 < NE * PER_E; it0 += 2 * NGW) {
                    const float* W_[2]; bf16* D_[2]; int K_[2], N_[2], rm_[2], r_[2]; const float* g_[2];
#pragma unroll
                    for (int q = 0; q < 2; ++q) { const int it = it0 + q; const int e = it / PER_E; int r = it % PER_E; const size_t eo = (size_t)(jj * NE + e) * DM * FF;
                        if (r < I_GU) { W_[q] = INP(29) + eo; K_[q] = DM; N_[q] = FF; D_[q] = (bf16*)(ws + WS_MWGU) + (size_t)e * FF2 * DM / 2; rm_[q] = 1; g_[q] = gff; }
                        else if (r < 2 * I_GU) { r -= I_GU; W_[q] = INP(30) + eo; K_[q] = DM; N_[q] = FF; D_[q] = (bf16*)(ws + WS_MWGU) + (size_t)e * FF2 * DM / 2; rm_[q] = 2; g_[q] = gff; }
                        else { r -= 2 * I_GU; W_[q] = INP(31) + eo; K_[q] = FF; N_[q] = DM; D_[q] = (bf16*)(ws + WS_MWD) + (size_t)e * DM * FF / 2; rm_[q] = 0; g_[q] = nullptr; }
                        r_[q] = r; }
                    tr_item2(W_[0], K_[0], N_[0], D_[0], rm_[0], g_[0], r_[0], W_[1], K_[1], N_[1], D_[1], rm_[1], g_[1], r_[1], scr, lane, true, true);
                }
            }
            SEAM(pb + 0);
        }
        for (int rep_ = 0; rep_ < NREP(1); ++rep_) if (EN(1) && IN(pb + 1)) { PH_TID;
            pg8::StaticOrder S; S.init(MPAD, INP, G, bx);
            if ((INP8 >> layer) & 1) { pg8::Gemm g{HB, (const bf16*)(ws + WS_WIN) + (size_t)layer * INP * DM, MPAD, INP, DM / 2}; pg8::EpiBf16Rs E{PROJ, INP, nullptr, 1.f / (W8_SCALE * A8_SCALE)};
                pg8::gemm_phase<pg8::EpiBf16Rs, pg8::StaticOrder, true, true, true>(lds, g, S, E, tid); }
            else { pg8::Gemm g{HB, (const bf16*)(ws + WS_WIN) + (size_t)layer * INP * DM, MPAD, INP, DM}; pg8::EpiBf16Rs E{PROJ, INP, RSTD, 1.f};
                pg8::gemm_phase<pg8::EpiBf16Rs, pg8::StaticOrder, true, true>(lds, g, S, E, tid); }
            SEAM(pb + 1);
        }
        for (int rep_ = 0; rep_ < NREP(2); ++rep_) if (EN(2) && IN(pb + 2)) { PH_TID;
            const int gt = bx * (NWAVES * 64) + tid, NGT = G * NWAVES * 64;
            if (tid < 65) { const v4u z_ = zero_v4u(); RSQA[bx * 65 + tid] = (unsigned long long)z_.x | ((unsigned long long)z_.y << 32); }
            for (int i = gt; i < NB * 112 * 64; i += NGT) { const int b = i / (112 * 64), r = (i / 64) % 112, c = i % 64; const int row = b * KVROWS + (r < 48 ? r : r + 16);
                ((v4u*)(KP + (size_t)row * 512))[c] = zero_v4u(); ((v4u*)(VP + (size_t)row * 512))[c] = zero_v4u(); }
            const int ngrp = (1025 - bx + 255) / 256, nrows = 16 * ngrp;
#define MP_ROW(idx) (16 * (bx + 256 * ((idx) >> 4)) + ((idx) & 15))
            LAS unsigned char* WT = lds;
            { const int nn = tid & 255, hf = tid >> 8;
              const float* sd = INP(6) + layer * 32 * 256 + (hf * 16) * 256 + nn; const float* sa = INP(8) + layer * 32 * 256 + (hf * 16) * 256 + nn; const float* sg = INP(9) + layer * 64 * 256 + (hf * 32) * 256 + nn;
              v4u wv[2];
#pragma unroll
              for (int i = 0; i < 2; ++i) { wv[i].x = pk2(sd[(8 * i) * 256], sd[(8 * i + 1) * 256]); wv[i].y = pk2(sd[(8 * i + 2) * 256], sd[(8 * i + 3) * 256]); wv[i].z = pk2(sd[(8 * i + 4) * 256], sd[(8 * i + 5) * 256]); wv[i].w = pk2(sd[(8 * i + 6) * 256], sd[(8 * i + 7) * 256]); }
              *(LAS v4u*)(WT + nn * 64 + hf * 32) = wv[0]; *(LAS v4u*)(WT + nn * 64 + hf * 32 + 16) = wv[1];
#pragma unroll
              for (int i = 0; i < 2; ++i) { wv[i].x = pk2(sa[(8 * i) * 256], sa[(8 * i + 1) * 256]); wv[i].y = pk2(sa[(8 * i + 2) * 256], sa[(8 * i + 3) * 256]); wv[i].z = pk2(sa[(8 * i + 4) * 256], sa[(8 * i + 5) * 256]); wv[i].w = pk2(sa[(8 * i + 6) * 256], sa[(8 * i + 7) * 256]); }
              *(LAS v4u*)(WT + 16384 + nn * 64 + hf * 32) = wv[0]; *(LAS v4u*)(WT + 16384 + nn * 64 + hf * 32 + 16) = wv[1];
#pragma unroll
              for (int i = 0; i < 4; ++i) { v4u t; t.x = pk2(sg[(8 * i) * 256], sg[(8 * i + 1) * 256]); t.y = pk2(sg[(8 * i + 2) * 256], sg[(8 * i + 3) * 256]); t.z = pk2(sg[(8 * i + 4) * 256], sg[(8 * i + 5) * 256]); t.w = pk2(sg[(8 * i + 6) * 256], sg[(8 * i + 7) * 256]);
                  *(LAS v4u*)(WT + 32768 + nn * 128 + hf * 64 + 16 * i) = t; } }
            __syncthreads();
            const float* mu = INP(4) + layer * RCOLS; const float* w0 = INP(5) + layer * 256; const float* a0 = INP(7) + layer * 256;
            const float* k_k = INP(10) + layer * 256; const float* k_a = INP(11) + layer * 256; const float* r_k = INP(12) + layer * 256;
            const float* qg = INP(15) + layer * 64; const float* kg = INP(16) + layer * 64; const float* cw = INP(22) + layer * 3 * 256;
            for (int rep3_ = 0; rep3_ < NREP(5); ++rep3_)
            if (wave < ngrp) {
                typedef attn_body::bf16x8 bfx8;
                const int rowbase = 16 * (bx + 256 * wave);
                LAS unsigned char* XT = lds + 65536 + wave * 4096;
                { const float mu0 = mu[768 + 2 * lane], mu1 = mu[768 + 2 * lane + 1]; const int p0 = prevrow(rowbase);
                  unsigned cur = p0 < 0 ? 0u : *(const unsigned*)(PROJ + (size_t)p0 * INP + 768 + 2 * lane); float pl = __uint_as_float(cur << 16), ph = __uint_as_float(cur & 0xffff0000u);
#pragma unroll
                  for (int r = 0; r < 16; ++r) { cur = *(const unsigned*)(PROJ + (size_t)(rowbase + r) * INP + 768 + 2 * lane); const float xl = __uint_as_float(cur << 16), xh = __uint_as_float(cur & 0xffff0000u);
                      float h0 = xl + (pl - xl) * mu0, h1 = xh + (ph - xh) * mu1; pl = xl; ph = xh;
                      if (lane < 16) { h0 = 1.f - 2.f / (1.f + __expf(2.f * h0)); h1 = 1.f - 2.f / (1.f + __expf(2.f * h1)); } else if (lane >= 32) { h0 = sigmoidf_(h0); h1 = sigmoidf_(h1); }
                      *(LAS unsigned*)(XT + r * 256 + 4 * lane) = pk2(h0, h1); } }
                LDS_WAIT();
                const int n = lane & 15, kq = lane >> 4;
                const v4u xd = *(const LAS v4u*)(XT + n * 256 + (8 * kq) * 2), xa = *(const LAS v4u*)(XT + n * 256 + (32 + 8 * kq) * 2);
                const v4u xg0 = *(const LAS v4u*)(XT + n * 256 + (64 + 8 * kq) * 2), xg1 = *(const LAS v4u*)(XT + n * 256 + (96 + 8 * kq) * 2);
                float* lw = LORA_W + (size_t)(rowbase + n) * 256 + 4 * kq; bf16* lag = LORA_AG + (size_t)(rowbase + n) * 512 + 4 * kq;
#pragma unroll 4
                for (int ct = 0; ct < 16; ++ct) {
                    const v4u ad = *(const LAS v4u*)(WT + (16 * ct + n) * 64 + (8 * kq) * 2), aa = *(const LAS v4u*)(WT + 16384 + (16 * ct + n) * 64 + (8 * kq) * 2);
                    const v4u ag0 = *(const LAS v4u*)(WT + 32768 + (16 * ct + n) * 128 + (8 * kq) * 2), ag1 = *(const LAS v4u*)(WT + 32768 + (16 * ct + n) * 128 + (32 + 8 * kq) * 2);
                    f32x4 dd = __builtin_amdgcn_mfma_f32_16x16x32_bf16(__builtin_bit_cast(bfx8, ad), __builtin_bit_cast(bfx8, xd), (f32x4){0.f, 0.f, 0.f, 0.f}, 0, 0, 0);
                    f32x4 da = __builtin_amdgcn_mfma_f32_16x16x32_bf16(__builtin_bit_cast(bfx8, aa), __builtin_bit_cast(bfx8, xa), (f32x4){0.f, 0.f, 0.f, 0.f}, 0, 0, 0);
                    f32x4 dg = __builtin_amdgcn_mfma_f32_16x16x32_bf16(__builtin_bit_cast(bfx8, ag0), __builtin_bit_cast(bfx8, xg0), (f32x4){0.f, 0.f, 0.f, 0.f}, 0, 0, 0);
                    dg = __builtin_amdgcn_mfma_f32_16x16x32_bf16(__builtin_bit_cast(bfx8, ag1), __builtin_bit_cast(bfx8, xg1), dg, 0, 0, 0);
                    *(f32x4*)(lw + 16 * ct) = dd;
                    *(unsigned long long*)(lag + 16 * ct) = (unsigned long long)pk2(da.x, da.y) | ((unsigned long long)pk2(da.z, da.w) << 32);
                    *(unsigned long long*)(lag + 256 + 16 * ct) = (unsigned long long)pk2(dg.x, dg.y) | ((unsigned long long)pk2(dg.z, dg.w) << 32);
                }
            }
            asm volatile("s_waitcnt vmcnt(0)" ::: "memory");
            __syncthreads();
#pragma nounroll
            for (int rep3_ = 0; rep3_ < NREP(10); ++rep3_)
            {
                typedef unsigned u32x2_ __attribute__((ext_vector_type(2)));
                const int sub = lane & 7; const int c4 = 4 * lane;
                const f32x4 qg0 = *(const f32x4*)(qg + 8 * sub), qg1 = *(const f32x4*)(qg + 8 * sub + 4), kg0 = *(const f32x4*)(kg + 8 * sub), kg1 = *(const f32x4*)(kg + 8 * sub + 4);
                const f32x4 cw0 = *(const f32x4*)(cw + c4), cw1 = *(const f32x4*)(cw + 256 + c4), cw2 = *(const f32x4*)(cw + 512 + c4);
                v4u rq, rk, rv; u32x2_ b0, g0_, u0, g1_, u1, g2_, u2;
#define AP_LOAD(rw) do { const int p1_ = prevrow(rw), p2_ = prevrow(p1_); const bf16* q_ = PROJ + (size_t)(rw) * INP; const bf16* q1_ = PROJ + (size_t)(p1_ < 0 ? (rw) : p1_) * INP; const bf16* q2_ = PROJ + (size_t)(p2_ < 0 ? (rw) : p2_) * INP; \
                    rq = *(const v4u*)(q_ + QOFF + 8 * lane); rk = *(const v4u*)(q_ + KOFF + 8 * lane); rv = *(const v4u*)(q_ + VOFF + 8 * lane); (void)q1_; (void)q2_; } while (0)
#define CV_LOAD(rw) do { const int p1_ = prevrow(rw), p2_ = prevrow(p1_); const bf16* q_ = PROJ + (size_t)(rw) * INP; const bf16* q1_ = PROJ + (size_t)(p1_ < 0 ? (rw) : p1_) * INP; const bf16* q2_ = PROJ + (size_t)(p2_ < 0 ? (rw) : p2_) * INP; \
                    b0 = *(const u32x2_*)(q_ + COFF + c4); g0_ = *(const u32x2_*)(q_ + COFF + 256 + c4); u0 = *(const u32x2_*)(q_ + COFF + 512 + c4); \
                    g1_ = *(const u32x2_*)(q1_ + COFF + 256 + c4); u1 = *(const u32x2_*)(q1_ + COFF + 512 + c4); g2_ = *(const u32x2_*)(q2_ + COFF + 256 + c4); u2 = *(const u32x2_*)(q2_ + COFF + 512 + c4); } while (0)
#define U2F4(t_) ((f32x4){__uint_as_float((t_).x << 16), __uint_as_float((t_).x & 0xffff0000u), __uint_as_float((t_).y << 16), __uint_as_float((t_).y & 0xffff0000u)})
                int idx = wave; AP_LOAD(MP_ROW(idx));
                for (; idx < nrows; idx += 8) { const int row = MP_ROW(idx);
                    const int p1 = prevrow(row), p2 = prevrow(p1); const float m1 = p1 < 0 ? 0.f : 1.f, m2 = p2 < 0 ? 0.f : 1.f;
                    const v4u cq = rq, ck = rk, cv = rv;
                    CV_LOAD(row);
                    if (idx + 8 < nrows) AP_LOAD(MP_ROW(idx + 8));
                    const int pos = row >= NREAL ? row - NREAL : NMETA + (row & (SEQ - 1));
                    const f32x4 c0 = *(const f32x4*)(COS + pos * 8), c1 = *(const f32x4*)(COS + pos * 8 + 4), n0 = *(const f32x4*)(SIN + pos * 8), n1 = *(const f32x4*)(SIN + pos * 8 + 4);
                    const float cs[8] = {c0.x, c0.y, c0.z, c0.w, c1.x, c1.y, c1.z, c1.w}; const float sn[8] = {n0.x, n0.y, n0.z, n0.w, n1.x, n1.y, n1.z, n1.w};
#pragma unroll
                    for (int which = 0; which < 2; ++which) {
                        const v4u raw = which ? ck : cq;
                        float x[8] = {__uint_as_float(raw.x << 16), __uint_as_float(raw.x & 0xffff0000u), __uint_as_float(raw.y << 16), __uint_as_float(raw.y & 0xffff0000u),
                                      __uint_as_float(raw.z << 16), __uint_as_float(raw.z & 0xffff0000u), __uint_as_float(raw.w << 16), __uint_as_float(raw.w & 0xffff0000u)};
                        float s2 = 0.f;
#pragma unroll
                        for (int i = 0; i < 8; ++i) s2 += x[i] * x[i];
                        s2 = sum8(s2);
                        const float rs = 1.f / sqrtf(s2 * (1.f / 64.f) + 1e-6f);
                        const f32x4 ga = which ? kg0 : qg0, gb = which ? kg1 : qg1;
                        const float gg[8] = {ga.x, ga.y, ga.z, ga.w, gb.x, gb.y, gb.z, gb.w};
                        float o[8];
#pragma unroll
                        for (int i = 0; i < 8; ++i) { const float xn = x[i] * rs * gg[i]; const float xp = lane_xor1(xn);
                            o[i] = sub == 0 ? xn * cs[i] - xp * sn[i] : (sub == 1 ? xn * cs[i] + xp * sn[i] : xn); if (!which) o[i] *= C2Q; }
                        v4u w; w.x = pk2(o[0], o[1]); w.y = pk2(o[2], o[3]); w.z = pk2(o[4], o[5]); w.w = pk2(o[6], o[7]);
                        if (!which) *(v4u*)(QN + (size_t)row * 512 + 8 * lane) = w;
                        else {
                            if (row < NREAL) { const size_t kr = (size_t)((row >> 12) * KVROWS + 128 + (row & (SEQ - 1))) * 512 + 8 * lane; *(v4u*)(KP + kr) = w; *(v4u*)(VP + kr) = cv; }
                            else {
#pragma unroll
                                for (int b = 0; b < NB; ++b) { const size_t kr = (size_t)(b * KVROWS + 48 + (row - NREAL)) * 512 + 8 * lane; *(v4u*)(KP + kr) = w; *(v4u*)(VP + kr) = cv; } } }
                    }
                    { const f32x4 fb0 = U2F4(b0), z0 = U2F4(g0_) * U2F4(u0), z1 = U2F4(g1_) * U2F4(u1) * m1, z2 = U2F4(g2_) * U2F4(u2) * m2;
                      const f32x4 y = cw0 * z2 + cw1 * z1 + cw2 * z0; const f32x4 o = fb0 * y;
                      *(unsigned long long*)(OMIX + (size_t)row * DM + 768 + c4) = (unsigned long long)pk2(o.x, o.y) | ((unsigned long long)pk2(o.z, o.w) << 32); }
                }
#undef AP_LOAD
#undef CV_LOAD
#undef U2F4
            }
            {
                LAS float* XL = (LAS float*)(lds + wave * 17408);
                LAS float* YL = XL + 32 * 65;
                const int nreal_g = ngrp - (bx == 0 ? 1 : 0);
                for (int lt = wave; lt < 4 * nreal_g + (bx == 0 ? 4 : 0); lt += NWAVES) {
                    int bh, ch; if (lt < 4 * nreal_g) { const int g = bx + 256 * (lt >> 2); bh = (g >> 8) * 4 + (lt & 3); ch = (g & 255) + 1; } else { bh = lt - 4 * nreal_g; ch = 0; }
                    const int task = bh * 257 + ch, b = bh >> 2, cb = (bh & 3) * 64; const int rowbase = ch == 0 ? NREAL : b * SEQ + 16 * (ch - 1);
                    float at[16], rt[16], bt[16], kt[16], vsv[16]; float gam = 1.f;
                    { const int c = cb + lane;
                      const float mu_r = mu[c], mu_k = mu[256 + c], mu_v = mu[512 + c], w0c = w0[c], a0c = a0[c], kkc = k_k[c], kac = k_a[c], rkc = r_k[c];
                      const int p0 = prevrow(rowbase); const bf16* q0 = PROJ + (size_t)(p0 < 0 ? rowbase : p0) * INP + c; const float pm = p0 < 0 ? 0.f : 1.f;
                      float pr_ = pm * bf2f(q0[0]), pk_ = pm * bf2f(q0[256]), pv_ = pm * bf2f(q0[512]);
                      unsigned short xr[16], xk[16], xv[16], la[16], lg[16]; float lw[16];
#pragma unroll
                      for (int t = 0; t < 16; ++t) { const bf16* q_ = PROJ + (size_t)(rowbase + t) * INP + c; xr[t] = q_[0]; xk[t] = q_[256]; xv[t] = q_[512];
                          lw[t] = LORA_W[(size_t)(rowbase + t) * 256 + c]; la[t] = LORA_AG[(size_t)(rowbase + t) * 512 + c]; lg[t] = LORA_AG[(size_t)(rowbase + t) * 512 + 256 + c]; }
#pragma unroll
                      for (int t = 0; t < 16; ++t) {
                          const float fr = bf2f(xr[t]), fk = bf2f(xk[t]), fv = bf2f(xv[t]);
                          const float r = fr + (pr_ - fr) * mu_r, k = fk + (pk_ - fk) * mu_k, v = fv + (pv_ - fv) * mu_v; pr_ = fr; pk_ = fk; pv_ = fv;
                          const float wacc = w0c + lw[t], aacc = a0c + bf2f(la[t]), gacc = bf2f(lg[t]);
                          const float nx = -wacc; const float sp = fmaxf(nx, 0.f) + __logf(1.f + __expf(-fabsf(nx)));
                          const float wlog = -sp - 0.5f; const float decay = __expf(-__expf(wlog));
                          const float a = sigmoidf_(aacc);
                          const float kkr = k * kkc; const float ss = wave_sum_dpp(kkr * kkr); const float kk = kkr / fmaxf(sqrtf(ss), 1e-12f);
                          const float k2 = k * (1.f + (a - 1.f) * kac);
                          const float bs = wave_sum_dpp(r * k2 * rkc);
                          const size_t si = (size_t)(rowbase + t) * 256 + c;
                          SG[si] = gacc; SBON[si] = bs * v;
                          at[t] = -kk * gam; gam *= decay; rt[t] = r * gam; const float ig = 1.f / gam; bt[t] = kk * a * ig; kt[t] = k2 * ig; vsv[t] = v; } }
#pragma unroll
                    for (int t = 0; t < 16; ++t) { XL[t * 65 + lane] = bt[t]; XL[(16 + t) * 65 + lane] = kt[t]; YL[t * 65 + lane] = at[t]; YL[(16 + t) * 65 + lane] = rt[t]; }
                    attn_body::f32x16 gm = attn_body::f32x16{};
#pragma unroll 8
                    for (int kk = 0; kk < 32; ++kk) gm = __builtin_amdgcn_mfma_f32_32x32x2f32(XL[(lane & 31) * 65 + 2 * kk + (lane >> 5)], YL[(lane & 31) * 65 + 2 * kk + (lane >> 5)], gm, 0, 0, 0);
                    LDS_WAIT();
                    LAS float* GL = YL; LAS float* TL = YL + 1056; LAS float* XM = YL + 1328;
#pragma unroll
                    for (int r = 0; r < 16; ++r) GL[((r & 3) + 8 * (r >> 2) + 4 * (lane >> 5)) * 33 + (lane & 31)] = gm[r];
                    float tr[16];
#pragma unroll
                    for (int t = 0; t < 16; ++t) tr[t] = ((lane & 15) == t) ? 1.f : 0.f;
#pragma unroll
                    for (int s = 0; s < 15; ++s)
#pragma unroll
                        for (int t = s + 1; t < 16; ++t) tr[t] = fmaf(tr[s], GL[s * 33 + t], tr[t]);
                    if (lane < 16) {
#pragma unroll
                        for (int t = 0; t < 16; ++t) TL[lane * 17 + t] = tr[t]; }
                    { const int s = lane & 15, q = lane >> 4; float x0 = 0.f, x1 = 0.f, x2 = 0.f, x3 = 0.f;
#pragma unroll
                      for (int u = 1; u < 16; ++u) { const float l = (u > s) ? GL[(16 + s) * 33 + u] : 0.f; x0 = fmaf(l, TL[u * 17 + 4 * q], x0); x1 = fmaf(l, TL[u * 17 + 4 * q + 1], x1); x2 = fmaf(l, TL[u * 17 + 4 * q + 2], x2); x3 = fmaf(l, TL[u * 17 + 4 * q + 3], x3); }
                      XM[s * 17 + 4 * q] = x0; XM[s * 17 + 4 * q + 1] = x1; XM[s * 17 + 4 * q + 2] = x2; XM[s * 17 + 4 * q + 3] = x3; }
                    float atT[16];
#pragma unroll
                    for (int sp = 0; sp < 16; ++sp) { float acc = 0.f;
#pragma unroll
                        for (int s = 0; s <= sp; ++s) acc = fmaf(at[s], TL[s * 17 + sp], acc);
                        atT[sp] = acc; }
                    unsigned char* rec = CH_REC + (size_t)task * CH_RB;
                    ((float*)rec)[lane] = gam;
                    LAS unsigned short* ST = (LAS unsigned short*)XL;
                    const int kpos = (lane & ~15) + 8 * ((lane >> 2) & 1) + (lane & 3) + 4 * ((lane >> 3) & 1);
                    float zz[16];
#pragma unroll
                    for (int s = 0; s < 16; ++s) { float acc = kt[s] * gam;
#pragma unroll
                        for (int sp = s + 1; sp < 16; ++sp) acc = fmaf(XM[s * 17 + sp], bt[sp] * gam, acc);
                        zz[s] = acc; }
#pragma unroll
                    for (int t = 0; t < 16; ++t) { float acc = rt[t];
#pragma unroll
                        for (int s = 0; s <= t; ++s) acc = fmaf(atT[s], GL[s * 33 + 16 + t], acc);
                        ST[t * 64 + kpos] = (unsigned short)f2bf(atT[t]); ST[(16 + t) * 64 + kpos] = (unsigned short)f2bf(acc); }
                    { v4u w0, w1;
                      w0.x = pk2(bt[0] * gam, bt[1] * gam); w0.y = pk2(bt[2] * gam, bt[3] * gam); w0.z = pk2(bt[8] * gam, bt[9] * gam); w0.w = pk2(bt[10] * gam, bt[11] * gam);
                      w1.x = pk2(bt[4] * gam, bt[5] * gam); w1.y = pk2(bt[6] * gam, bt[7] * gam); w1.z = pk2(bt[12] * gam, bt[13] * gam); w1.w = pk2(bt[14] * gam, bt[15] * gam);
                      v4u* d = (v4u*)(rec + 4352 + lane * 32); d[0] = w0; d[1] = w1;
                      v4u z0, z1; z0.x = pk2(zz[0], zz[1]); z0.y = pk2(zz[2], zz[3]); z0.z = pk2(zz[4], zz[5]); z0.w = pk2(zz[6], zz[7]);
                      z1.x = pk2(zz[8], zz[9]); z1.y = pk2(zz[10], zz[11]); z1.z = pk2(zz[12], zz[13]); z1.w = pk2(zz[14], zz[15]);
                      v4u* dz = (v4u*)(rec + 6400 + lane * 32); dz[0] = z0; dz[1] = z1; }
                    { float vs[16];
#pragma unroll
                      for (int s = 0; s < 16; ++s) vs[s] = vsv[s];
                      v4u a0, a1; a0.x = pk2(vs[0], vs[1]); a0.y = pk2(vs[2], vs[3]); a0.z = pk2(vs[4], vs[5]); a0.w = pk2(vs[6], vs[7]);
                      a1.x = pk2(vs[8], vs[9]); a1.y = pk2(vs[10], vs[11]); a1.z = pk2(vs[12], vs[13]); a1.w = pk2(vs[14], vs[15]);
                      v4u* dv = (v4u*)(rec + 8448 + lane * 32); dv[0] = a0; dv[1] = a1; }
                    { const int s = lane & 15, q = lane >> 4;
#pragma unroll
                      for (int e = 0; e < 4; ++e) { const int t = 4 * q + e; float acc = (t >= s) ? GL[(16 + s) * 33 + 16 + t] : 0.f;
#pragma unroll
                          for (int sp = 1; sp < 16; ++sp) { const float m = (sp <= t) ? GL[sp * 33 + 16 + t] : 0.f; acc = fmaf(XM[s * 17 + sp], m, acc); }
                          ((unsigned short*)(rec + 10496))[t * 16 + s] = (unsigned short)f2bf(acc); } }
                    LDS_WAIT();
                    { const LAS v4u* sv = (const LAS v4u*)ST + lane; v4u* d = (v4u*)(rec + 256) + lane;
#pragma unroll
                      for (int i = 0; i < 4; ++i) d[64 * i] = sv[64 * i]; }
                    LDS_WAIT();
                    if (ch == 0) {
                        asm volatile("s_waitcnt vmcnt(0)" ::: "memory");
                        const v4u* src = (const v4u*)rec;
#pragma unroll 1
                        for (int i = lane; i < CH_RB / 16; i += 64) { const v4u w = src[i];
#pragma unroll
                            for (int cp = 1; cp < 4; ++cp) ((v4u*)(CH_REC + (size_t)((bh + 4 * cp) * 257) * CH_RB))[i] = w; }
                    }
                }
            }
            SEAM(pb + 2);
        }
        for (int rep_ = 0; rep_ < NREP(3); ++rep_) if (EN(3) && IN(pb + 3)) { PH_TID;
#define PK8(T, o) ((v4u){attn_body::cvtpk_s(T[o], T[o + 1]), attn_body::cvtpk_s(T[o + 2], T[o + 3]), attn_body::cvtpk_s(T[o + 4], T[o + 5]), attn_body::cvtpk_s(T[o + 6], T[o + 7])})
            for (int rep2_ = 0; rep2_ < NREP(13); ++rep2_)
            if (bx < 32) {
                typedef attn_body::bf16x8 bfx8; typedef attn_body::f32x16 fx16;
                const int bh = bx >> 1, vh = bx & 1, n = lane & 31, hh = lane >> 5;
                const unsigned char* rec0 = CH_REC + (size_t)(bh * 257) * CH_RB;
                const unsigned lds0 = (unsigned)(uintptr_t)lds_raw;
                constexpr int RBUF = 6 * CH_RB;
#define S2_ISSUE(rnd) do { if (wave >= 1 && wave <= 6) { const int c_ = 6 * (rnd) + wave - 1; if (c_ < 257) { const unsigned dst_ = lds0 + ((rnd) & 1) * RBUF + (wave - 1) * CH_RB; \
                    for (int p_ = 0; p_ < 11; ++p_) attn_body::glds16s(rec0 + (size_t)c_ * CH_RB + p_ * 1024, (unsigned)lane * 16u, (unsigned)__builtin_amdgcn_readfirstlane(dst_ + p_ * 1024)); } } } while (0)
                S2_ISSUE(0);
                asm volatile("s_waitcnt vmcnt(0)\n\ts_barrier" ::: "memory");
                v4u* spk = (v4u*)(CH_SPK + (size_t)(bh * 257) * 8192 + vh * 4096) + lane;
                fx16 st0 = fx16{}, st1 = fx16{};
                for (int rnd = 0; rnd < 43; ++rnd) {
                    S2_ISSUE(rnd + 1);
                    if (wave == 0) {
                        v4u atf[4], bhf[2], ztf[2], vtf; f32x4 gq[8];
#define S2_FRAGS(j_) do { const LAS unsigned char* r_ = lds + (rnd & 1) * RBUF + (j_) * CH_RB; \
                            _Pragma("unroll") for (int ks = 0; ks < 4; ++ks) atf[ks] = *(const LAS v4u*)(r_ + 256 + ((lane & 15) * 64 + 16 * ks + 8 * hh) * 2); \
                            _Pragma("unroll") for (int i = 0; i < 2; ++i) { bhf[i] = *(const LAS v4u*)(r_ + 4352 + ((32 * i + n) * 16 + 8 * hh) * 2); ztf[i] = *(const LAS v4u*)(r_ + 6400 + ((32 * i + n) * 16 + 8 * hh) * 2); } \
                            vtf = *(const LAS v4u*)(r_ + 8448 + ((32 * vh + n) * 16 + 8 * hh) * 2); \
                            _Pragma("unroll") for (int i = 0; i < 2; ++i) _Pragma("unroll") for (int q = 0; q < 4; ++q) gq[4 * i + q] = *(const LAS f32x4*)(r_ + (32 * i + 8 * q + 4 * hh) * 4); } while (0)
                        S2_FRAGS(0);
                        for (int j = 0; j < 6; ++j) { const int ch = 6 * rnd + j; if (ch >= 257) break;
                            const v4u a0 = atf[0], a1 = atf[1], a2 = atf[2], a3 = atf[3], b0 = bhf[0], b1 = bhf[1], z0 = ztf[0], z1 = ztf[1], vt = vtf;
                            f32x4 g_[8];
#pragma unroll
                            for (int i = 0; i < 8; ++i) g_[i] = gq[i];
                            if (j < 5) S2_FRAGS(j + 1);
                            const v4u s0 = PK8(st0, 0), s1 = PK8(st0, 8), s2 = PK8(st1, 0), s3 = PK8(st1, 8);
                            spk[(size_t)ch * 512 + 0] = s0; spk[(size_t)ch * 512 + 64] = s1; spk[(size_t)ch * 512 + 128] = s2; spk[(size_t)ch * 512 + 192] = s3;
                            fx16 pt = fx16{};
                            pt = __builtin_amdgcn_mfma_f32_32x32x16_bf16(__builtin_bit_cast(bfx8, a0), __builtin_bit_cast(bfx8, s0), pt, 0, 0, 0);
                            pt = __builtin_amdgcn_mfma_f32_32x32x16_bf16(__builtin_bit_cast(bfx8, a1), __builtin_bit_cast(bfx8, s1), pt, 0, 0, 0);
                            pt = __builtin_amdgcn_mfma_f32_32x32x16_bf16(__builtin_bit_cast(bfx8, a2), __builtin_bit_cast(bfx8, s2), pt, 0, 0, 0);
                            pt = __builtin_amdgcn_mfma_f32_32x32x16_bf16(__builtin_bit_cast(bfx8, a3), __builtin_bit_cast(bfx8, s3), pt, 0, 0, 0);
#pragma unroll
                            for (int q = 0; q < 4; ++q) { st0[4 * q] *= g_[q].x; st0[4 * q + 1] *= g_[q].y; st0[4 * q + 2] *= g_[q].z; st0[4 * q + 3] *= g_[q].w;
                                                          st1[4 * q] *= g_[4 + q].x; st1[4 * q + 1] *= g_[4 + q].y; st1[4 * q + 2] *= g_[4 + q].z; st1[4 * q + 3] *= g_[4 + q].w; }
                            st0 = __builtin_amdgcn_mfma_f32_32x32x16_bf16(__builtin_bit_cast(bfx8, z0), __builtin_bit_cast(bfx8, vt), st0, 0, 0, 0);
                            st1 = __builtin_amdgcn_mfma_f32_32x32x16_bf16(__builtin_bit_cast(bfx8, z1), __builtin_bit_cast(bfx8, vt), st1, 0, 0, 0);
                            const v4u pp = PK8(pt, 0);
                            st0 = __builtin_amdgcn_mfma_f32_32x32x16_bf16(__builtin_bit_cast(bfx8, b0), __builtin_bit_cast(bfx8, pp), st0, 0, 0, 0);
                            st1 = __builtin_amdgcn_mfma_f32_32x32x16_bf16(__builtin_bit_cast(bfx8, b1), __builtin_bit_cast(bfx8, pp), st1, 0, 0, 0);
                        }
#undef S2_FRAGS
                        asm volatile("s_waitcnt lgkmcnt(0)\n\ts_barrier" ::: "memory");
                    } else asm volatile("s_waitcnt vmcnt(0) lgkmcnt(0)\n\ts_barrier" ::: "memory");
                }
#undef S2_ISSUE
            }
            __syncthreads();
            for (int rep2_ = 0; rep2_ < NREP(12); ++rep2_)
            { const attn_body::AttnTensors AT{(const attn_body::bf16*)QN, (const attn_body::bf16*)KP, (const attn_body::bf16*)VP, (attn_body::bf16*)OC};
              const attn_body::QueueOrder SO{(unsigned*)(ctl + CW_ATTQ + (layer * 8 + (bx & 7)) * 64), (LAS unsigned*)(lds + MISC_OFF + 64), bx & 7, tid};
              attn_body::attn_phase<attn_body::QueueOrder>((char*)lds_raw, AT, SO, tid); }
            __syncthreads();
#ifndef NO_META
            {
                LAS float* sc = (LAS float*)(lds + wave * 1024); LAS float* qs = sc + 64;
                for (int task = gw; task < NMETA * 8; task += NGW) {
                    const int row = NREAL + (task >> 3), hc = task & 7, h = hc >> 1; const int n = row - NREAL + 1;
                    qs[lane] = bf2f(QN[(size_t)row * 512 + hc * 64 + lane]);
                    float m = -INFINITY;
                    { const int idx = lane;
                        if (idx < n) { const size_t kr = 48 + idx; const v4u* kp = (const v4u*)(KP + kr * 512 + hc * 64); float dot = 0.f;
#pragma unroll
                            for (int c8 = 0; c8 < 8; ++c8) { const v4u kv = kp[c8];
                                dot += qs[c8 * 8 + 0] * __uint_as_float(kv.x << 16) + qs[c8 * 8 + 1] * __uint_as_float(kv.x & 0xffff0000u) + qs[c8 * 8 + 2] * __uint_as_float(kv.y << 16) + qs[c8 * 8 + 3] * __uint_as_float(kv.y & 0xffff0000u)
                                     + qs[c8 * 8 + 4] * __uint_as_float(kv.z << 16) + qs[c8 * 8 + 5] * __uint_as_float(kv.z & 0xffff0000u) + qs[c8 * 8 + 6] * __uint_as_float(kv.w << 16) + qs[c8 * 8 + 7] * __uint_as_float(kv.w & 0xffff0000u); }
                            sc[idx] = dot; m = dot; } }
                    m = wave_max(m);
                    float l = 0.f;
                    if (lane < n) { const float p = __builtin_amdgcn_exp2f(sc[lane] - m); sc[lane] = p; l = p; }
                    l = wave_sum(l);
                    float o0 = 0.f, o1 = 0.f;
                    for (int idx = 0; idx < n; ++idx) { const float p = sc[idx]; const size_t vr = 48 + idx;
                        const unsigned v2 = *(const unsigned*)(VP + vr * 512 + h * 128 + 2 * lane); o0 += p * __uint_as_float(v2 << 16); o1 += p * __uint_as_float(v2 & 0xffff0000u); }
                    const float inv = 1.f / l;
                    *(unsigned*)(OC + (size_t)row * 1024 + hc * 128 + 2 * lane) = pk2(o0 * inv, o1 * inv);
                    LDS_WAIT();
                }
            }
#endif
            SEAM(pb + 3);
        }
        for (int rep_ = 0; rep_ < NREP(4); ++rep_) if (EN(4) && IN(pb + 4)) { PH_TID;
            const float* gn_g = INP(13) + layer * 256; const float* gn_b = INP(14) + layer * 256; const float* subg = INP(21) + layer * 128;
            const float s1 = wave_sum(INP(17)[layer * 64 + lane] * INP(18)[layer * 64 + lane]); const float s2 = wave_sum(INP(19)[layer * 64 + lane] * INP(20)[layer * 64 + lane]);
            const float lam = __expf(s1) - __expf(s2) + lam_init;
            const int ngrp = (1025 - bx + 255) / 256, nrows = 16 * ngrp;
            {
                typedef attn_body::bf16x8 bfx8; typedef attn_body::f32x16 fx16;
                const int n = lane & 31, hh = lane >> 5;
                for (int lt = wave; lt < 8 * ngrp; lt += NWAVES) {
                    const int g = bx + 256 * (lt >> 3), hd = (lt >> 1) & 3, vh = lt & 1; const int bh = g < 1024 ? (g >> 8) * 4 + hd : hd, ch = g < 1024 ? (g & 255) + 1 : 0;
                    const int ct = bh * 257 + ch, b = bh >> 2, cb = (bh & 3) * 64; const int rowbase = ch == 0 ? NREAL : b * SEQ + 16 * (ch - 1);
                    const unsigned char* r_ = CH_REC + (size_t)ct * CH_RB; const v4u* spk = (const v4u*)(CH_SPK + (size_t)ct * 8192 + vh * 4096) + lane;
                    fx16 y = fx16{};
#pragma unroll
                    for (int ks = 0; ks < 4; ++ks) { const v4u a = *(const v4u*)(r_ + 2304 + ((lane & 15) * 64 + 16 * ks + 8 * hh) * 2); const v4u s = spk[64 * ks];
                        y = __builtin_amdgcn_mfma_f32_32x32x16_bf16(__builtin_bit_cast(bfx8, a), __builtin_bit_cast(bfx8, s), y, 0, 0, 0); }
                    { const v4u a = *(const v4u*)(r_ + 10496 + ((lane & 15) * 16 + 8 * hh) * 2); const v4u vt = *(const v4u*)(r_ + 8448 + ((32 * vh + n) * 16 + 8 * hh) * 2);
                      y = __builtin_amdgcn_mfma_f32_32x32x16_bf16(__builtin_bit_cast(bfx8, a), __builtin_bit_cast(bfx8, vt), y, 0, 0, 0); }
                    {
#pragma unroll
                        for (int r = 0; r < 8; ++r) SY[(size_t)(rowbase + (r & 3) + 8 * (r >> 2) + 4 * hh) * 256 + cb + 32 * vh + n] = y[r]; }
                }
            }
#undef PK8
            asm volatile("s_waitcnt vmcnt(0)" ::: "memory");
            __syncthreads();
            {
                const int h = lane >> 4, j8 = (lane & 15) * 8;
                f32x4 ny, nbon, ngt; v4u na0, na1;
#define POST_LOAD(rw) do { const int r_ = (rw); ny = *(const f32x4*)(SY + (size_t)r_ * 256 + 4 * lane); nbon = *(const f32x4*)(SBON + (size_t)r_ * 256 + 4 * lane); ngt = *(const f32x4*)(SG + (size_t)r_ * 256 + 4 * lane); \
                    na0 = *(const v4u*)(OC + (size_t)r_ * 1024 + (h * 2 + 0) * 128 + j8); na1 = *(const v4u*)(OC + (size_t)r_ * 1024 + (h * 2 + 1) * 128 + j8); } while (0)
                const f32x4 gg = *(const f32x4*)(gn_g + 4 * lane), gb = *(const f32x4*)(gn_b + 4 * lane), g0 = *(const f32x4*)(subg + j8), g1 = *(const f32x4*)(subg + j8 + 4);
                int idx = wave; POST_LOAD(MP_ROW(idx));
                for (; idx < nrows; idx += NWAVES) { const int row = MP_ROW(idx);
                    const f32x4 y = ny, bon = nbon, gt = ngt; const v4u a0 = na0, a1 = na1;
                    if (idx + NWAVES < nrows) POST_LOAD(MP_ROW(idx + NWAVES));
                    { const float mean = sum16((y.x + y.y) + (y.z + y.w)) * (1.f / 64.f);
                      const f32x4 dlt = y - mean; const float var = sum16((dlt.x * dlt.x + dlt.y * dlt.y) + (dlt.z * dlt.z + dlt.w * dlt.w)) * (1.f / 64.f); const float rs = 1.f / sqrtf(var + 64e-5f);
                      const f32x4 o = (dlt * rs * gg + gb + bon) * gt;
                      *(unsigned long long*)(OMIX + (size_t)row * DM + 4 * lane) = (unsigned long long)pk2(o.x, o.y) | ((unsigned long long)pk2(o.z, o.w) << 32); }
                    { float dv[8];
                      dv[0] = __uint_as_float(a0.x << 16) - lam * __uint_as_float(a1.x << 16); dv[1] = __uint_as_float(a0.x & 0xffff0000u) - lam * __uint_as_float(a1.x & 0xffff0000u);
                      dv[2] = __uint_as_float(a0.y << 16) - lam * __uint_as_float(a1.y << 16); dv[3] = __uint_as_float(a0.y & 0xffff0000u) - lam * __uint_as_float(a1.y & 0xffff0000u);
                      dv[4] = __uint_as_float(a0.z << 16) - lam * __uint_as_float(a1.z << 16); dv[5] = __uint_as_float(a0.z & 0xffff0000u) - lam * __uint_as_float(a1.z & 0xffff0000u);
                      dv[6] = __uint_as_float(a0.w << 16) - lam * __uint_as_float(a1.w << 16); dv[7] = __uint_as_float(a0.w & 0xffff0000u) - lam * __uint_as_float(a1.w & 0xffff0000u);
                      float ss = 0.f;
#pragma unroll
                      for (int i = 0; i < 8; ++i) ss += dv[i] * dv[i];
                      ss = sum16(ss); const float sc_ = (1.f / sqrtf(ss * (1.f / 128.f) + 1e-5f)) * (1.f - lam_init);
                      v4u o; o.x = pk2(dv[0] * sc_ * g0.x, dv[1] * sc_ * g0.y); o.y = pk2(dv[2] * sc_ * g0.z, dv[3] * sc_ * g0.w); o.z = pk2(dv[4] * sc_ * g1.x, dv[5] * sc_ * g1.y); o.w = pk2(dv[6] * sc_ * g1.z, dv[7] * sc_ * g1.w);
                      *(v4u*)(OMIX + (size_t)row * DM + 256 + h * 128 + j8) = o; }
                }
#undef POST_LOAD
            }
            { const int gt = bx * (NWAVES * 64) + tid, NGT = G * NWAVES * 64;
              for (int i = gt; i < (MPAD - NTOK) * (DM / 8); i += NGT) ((v4u*)(OMIX + (size_t)NTOK * DM))[i] = zero_v4u(); }
            SEAM(pb + 4);
        }
        if (EN(5) && IN(pb + 5)) { PH_TID;
            pg8::Gemm g{OMIX, (const bf16*)(ws + WS_WOUT) + (size_t)layer * DM * DM, NREAL, DM, DM}; pg8::StaticOrder S; S.init(NREAL, DM, G, bx);
            if (!moe) {
                if (layer == 2) {
                    meta_gemm_res(OMIX + (size_t)NREAL * DM, DM, (const bf16*)(ws + WS_WOUT) + (size_t)layer * DM * DM, Hf + (size_t)NREAL * DM, lds, bx, wave, lane, 2, (bf16*)((unsigned char*)HB + (size_t)NREAL * DM), RSQA + NREAL);
                    typedef pg8::EpiResAddHB<2, (long long)WS_HB - (long long)WS_H, (long long)WS_RSROW - (long long)WS_H> EpiHB2; EpiHB2 E{Hf, DM, 1.f};
                    pg8::gemm_phase<EpiHB2, pg8::StaticOrder, true, true>(lds, g, S, E, tid);
                } else {
                    meta_gemm_res(OMIX + (size_t)NREAL * DM, DM, (const bf16*)(ws + WS_WOUT) + (size_t)layer * DM * DM, Hf + (size_t)NREAL * DM, lds, bx, wave, lane, 1, HB + (size_t)NREAL * DM, RSQA + NREAL);
                    typedef pg8::EpiResAddHB<1, (long long)WS_HB - (long long)WS_H, (long long)WS_RSROW - (long long)WS_H> EpiHB1; EpiHB1 E{Hf, DM, 1.f};
                    pg8::gemm_phase<EpiHB1, pg8::StaticOrder, true, true>(lds, g, S, E, tid);
                }
            } else {
                meta_gemm_res(OMIX + (size_t)NREAL * DM, DM, (const bf16*)(ws + WS_WOUT) + (size_t)layer * DM * DM, Hf + (size_t)NREAL * DM, lds, bx, wave, lane);
                pg8::EpiResAdd E{Hf, DM, 1.f};
                pg8::gemm_phase<pg8::EpiResAdd, pg8::StaticOrder, true, true>(lds, g, S, E, tid);
            }
            SEAM(pb + 5);
        }
        if (EN(6) && IN(pb + 6) && moe) { PH_TID;
            LAS int* lcnt = (LAS int*)lds; LAS int* lbase = lcnt + 8; LAS int* lrow = lcnt + 16;
            if (tid < 16) lcnt[tid] = 0;
            __syncthreads();
            const float* gff = INP(24) + layer * DM; const float* Wr = INP(28) + (size_t)jj * DM * NE;
            for (int i = wave; i < 72; i += NWAVES) { const int row = bx + G * i;
                if (row < NTOK) {
                    const GAS f32x4* xr = (const GAS f32x4*)(Hf + (size_t)row * DM) + lane; f32x4 v[4]; float s = 0.f;
#pragma unroll
                    for (int j = 0; j < 4; ++j) { v[j] = xr[64 * j]; s += (v[j].x * v[j].x + v[j].y * v[j].y) + (v[j].z * v[j].z + v[j].w * v[j].w); }
                    s = wave_sum(s); const float rstd = 1.f / sqrtf(s * (1.f / DM) + 1e-6f);
                    if (moe) { LAS unsigned* o4 = (LAS unsigned*)(lds + 4096 + i * 1024) + lane; const float sn = rstd * A8_SCALE;
#pragma unroll
                      for (int j = 0; j < 4; ++j) o4[64 * j] = pk4_fp8(v[j].x * sn, v[j].y * sn, v[j].z * sn, v[j].w * sn); }
                    else if (layer == 2) { GAS unsigned* o4 = (GAS unsigned*)((GAS unsigned char*)HB + (size_t)row * DM) + lane; const float sn = rstd * A8_SCALE;
#pragma unroll
                      for (int j = 0; j < 4; ++j) o4[64 * j] = pk4_fp8(v[j].x * sn, v[j].y * sn, v[j].z * sn, v[j].w * sn); }
                    else { GAS unsigned long long* o8 = (GAS unsigned long long*)(HB + (size_t)row * DM) + lane;
#pragma unroll
                      for (int j = 0; j < 4; ++j) o8[64 * j] = (unsigned long long)pk2(v[j].x, v[j].y) | ((unsigned long long)pk2(v[j].z, v[j].w) << 32); }
                    if (lane == 0) RSTD[row] = rstd;
                    if (moe) {
                        float lg[8];
#pragma unroll
                        for (int e = 0; e < 8; ++e) lg[e] = 0.f;
#pragma unroll
                        for (int j = 0; j < 4; ++j) { const int k0 = 4 * lane + 256 * j; const f32x4 gv = *(const f32x4*)(gff + k0);
#pragma unroll
                            for (int q = 0; q < 4; ++q) { const float hv = v[j][q] * gv[q]; const f32x4 wa = *(const f32x4*)(Wr + (size_t)(k0 + q) * 8), wb = *(const f32x4*)(Wr + (size_t)(k0 + q) * 8 + 4);
                                lg[0] += hv * wa.x; lg[1] += hv * wa.y; lg[2] += hv * wa.z; lg[3] += hv * wa.w; lg[4] += hv * wb.x; lg[5] += hv * wb.y; lg[6] += hv * wb.z; lg[7] += hv * wb.w; } }
#pragma unroll
                        for (int e = 0; e < 8; ++e) lg[e] = wave_sum(lg[e]) * rstd;
                        int e1 = 0; float l1 = lg[0];
#pragma unroll
                        for (int e = 1; e < 8; ++e) if (lg[e] > l1) { l1 = lg[e]; e1 = e; }
                        int e2 = -1; float l2 = -INFINITY;
#pragma unroll
                        for (int e = 0; e < 8; ++e) if (e != e1 && lg[e] > l2) { l2 = lg[e]; e2 = e; }
                        if (lane == 0) { const float g2 = 1.f / (1.f + __expf(l1 - l2)); const float g1 = 1.f - g2;
                            const int sl1 = atomicAdd((int*)&lcnt[e1], 1), sl2 = atomicAdd((int*)&lcnt[e2], 1);
                            lrow[i * 4 + 0] = e1; lrow[i * 4 + 1] = sl1; lrow[i * 4 + 2] = e2; lrow[i * 4 + 3] = sl2;
                            TOKG[row * 2 + 0] = g1; TOKG[row * 2 + 1] = g2; }
                    }
                }
            }
            if (moe) {
                __syncthreads();
                if (tid < 8) lbase[tid] = (int)__hip_atomic_fetch_add((unsigned*)(ctl + CW_MOECNT + 64 * jj + tid), (unsigned)lcnt[tid], RLX_AGENT);
                __syncthreads();
                if (tid < 72) { const int row = bx + G * tid; if (row < NTOK) { const int e1 = lrow[tid * 4 + 0], e2 = lrow[tid * 4 + 2];
                    TOKE[row * 2 + 0] = e1; TOKE[row * 2 + 1] = e2; TOKS[row * 2 + 0] = lbase[e1] + lrow[tid * 4 + 1]; TOKS[row * 2 + 1] = lbase[e2] + lrow[tid * 4 + 3]; } }
                __syncthreads();
            }
            SEAM(pb + 6);
        }
        if (!moe) {
            for (int rep_ = 0; rep_ < NREP(7); ++rep_) if (EN(7) && IN(pb + 7)) { PH_TID;
                pg8::StaticOrder S; S.init(MPAD, FF2, G, bx);
                if (layer == 2) { pg8::Gemm g{HB, (const bf16*)(ws + WS_WGU) + (size_t)jj * FF2 * DM, MPAD, FF2, DM / 2}; pg8::EpiSwiglu8 E{GB, FF, nullptr, 1.f / (W8_SCALE * H8_SCALE), G8_SCALE, RSQA};
                    pg8::gemm_phase<pg8::EpiSwiglu8, pg8::StaticOrder, true, true, true>(lds, g, S, E, tid); }
                else { pg8::Gemm g{HB, (const bf16*)(ws + WS_WGU) + (size_t)jj * FF2 * DM, MPAD, FF2, DM}; pg8::EpiSwiglu E{GB, FF, nullptr, 1.f, 0.f, RSQA};
                    pg8::gemm_phase<pg8::EpiSwiglu, pg8::StaticOrder, true, true>(lds, g, S, E, tid); }
                SEAM(pb + 7);
            }
            if (EN(8) && IN(pb + 8)) { PH_TID;
                pg8::StaticOrder S; S.init(NREAL, DM, G, bx);
                if (layer == 2) {
                    meta_gemm_res8((const unsigned char*)GB + (size_t)NREAL * FF, FF, (const unsigned char*)((const bf16*)(ws + WS_WD) + (size_t)jj * DM * FF), Hf + (size_t)NREAL * DM, 1.f / (W8_SCALE * G8_SCALE), lds, bx, wave, lane);
                    pg8::Gemm g{GB, (const bf16*)(ws + WS_WD) + (size_t)jj * DM * FF, NREAL, DM, FF / 2}; pg8::EpiResAdd E{Hf, DM, 1.f / (W8_SCALE * G8_SCALE)};
                    pg8::gemm_phase<pg8::EpiResAdd, pg8::StaticOrder, true, true, true>(lds, g, S, E, tid);
                } else {
                    meta_gemm_res(GB + (size_t)NREAL * FF, FF, (const bf16*)(ws + WS_WD) + (size_t)jj * DM * FF, Hf + (size_t)NREAL * DM, lds, bx, wave, lane);
                    pg8::Gemm g{GB, (const bf16*)(ws + WS_WD) + (size_t)jj * DM * FF, NREAL, DM, FF}; pg8::EpiResAdd E{Hf, DM, 1.f};
                    pg8::gemm_phase<pg8::EpiResAdd, pg8::StaticOrder, true, true>(lds, g, S, E, tid);
                }
                SEAM(pb + 8);
            }
        } else {
#define cnt ((const int*)(ctl + CW_MOECNT + 64 * jj))
            for (int rep_ = 0; rep_ < NREP(7); ++rep_) if (EN(7) && IN(pb + 7)) { PH_TID;
                int ts[8]; { int a = 0;
#pragma unroll
                    for (int e = 0; e < 8; ++e) { ts[e] = a; a += (__hip_atomic_load(cnt + e, RLX_AGENT) + 255) >> 8; } }
                { LAS const int* lbase = (LAS const int*)lds + 8; LAS const int* lrow = (LAS const int*)lds + 16;
                  for (int i = wave; i < 72; i += NWAVES) { const int row = bx + G * i;
                      if (row < NTOK) { const v4u d = *(const LAS v4u*)(lds + 4096 + i * 1024 + lane * 16);
#pragma unroll
                          for (int c = 0; c < 2; ++c) { const int e = lrow[i * 4 + 2 * c]; int tse = 0, lb = 0;
#pragma unroll
                              for (int x = 0; x < 8; ++x) { tse = (e == x) ? ts[x] : tse; lb = (e == x) ? lbase[x] : lb; }
                              const size_t p = (size_t)tse * 256 + lb + lrow[i * 4 + 2 * c + 1];
                              ((v4u*)((unsigned char*)AROWS + p * DM))[lane] = d; } } } }
                SEAM(pb + 7);
            }
            for (int rep_ = 0; rep_ < NREP(8); ++rep_) if (EN(8) && IN(pb + 8)) { PH_TID;
                pg8::Gemm g{AROWS, (const bf16*)(ws + WS_MWGU), MOEP, FF2, DM / 2}; pg8::MoeOrder S; S.init(cnt, FF2 / 256, G, bx);
                pg8::EpiSwiglu8 E{GB, FF, nullptr, 1.f / (W8_SCALE * A8_SCALE), G8_SCALE};
                pg8::gemm_phase<pg8::EpiSwiglu8, pg8::MoeOrder, true, true, true>(lds, g, S, E, tid);
                SEAM(pb + 8);
            }
            for (int rep_ = 0; rep_ < NREP(9); ++rep_) if (EN(9) && IN(pb + 9)) { PH_TID;
                pg8::Gemm g{GB, (const bf16*)(ws + WS_MWD), MOEP, DM, FF / 2}; pg8::MoeOrder S; S.init(cnt, DM / 256, G, bx);
                pg8::EpiBf16Rs E{YM, DM, nullptr, 1.f / (W8_SCALE * G8_SCALE)};
                pg8::gemm_phase<pg8::EpiBf16Rs, pg8::MoeOrder, true, true, true>(lds, g, S, E, tid);
                SEAM(pb + 9);
            }
            if (EN(10) && IN(pb + 10)) { PH_TID;
                int ts[8]; { int a = 0;
#pragma unroll
                    for (int e = 0; e < 8; ++e) { ts[e] = a; a += (__hip_atomic_load(cnt + e, RLX_AGENT) + 255) >> 8; } }
                for (int row = gw; row < NTOK; row += NGW) {
                    const int e1 = TOKE[row * 2], e2 = TOKE[row * 2 + 1]; int t1 = 0, t2 = 0;
#pragma unroll
                    for (int q = 0; q < 8; ++q) { t1 = (e1 == q) ? ts[q] : t1; t2 = (e2 == q) ? ts[q] : t2; }
                    const size_t p1 = (size_t)t1 * 256 + TOKS[row * 2], p2 = (size_t)t2 * 256 + TOKS[row * 2 + 1]; const float g1 = TOKG[row * 2], g2 = TOKG[row * 2 + 1];
                    float* hr = Hf + (size_t)row * DM; f32x4 hv[2][2]; float ssq = 0.f;
#pragma unroll
                    for (int j = 0; j < 2; ++j) { const int c8 = (lane + 64 * j) * 8; const v4u y1 = *(const v4u*)(YM + p1 * DM + c8), y2 = *(const v4u*)(YM + p2 * DM + c8);
                        f32x4 ha = *(f32x4*)(hr + c8), hb2 = *(f32x4*)(hr + c8 + 4);
                        ha.x += g1 * __uint_as_float(y1.x << 16) + g2 * __uint_as_float(y2.x << 16); ha.y += g1 * __uint_as_float(y1.x & 0xffff0000u) + g2 * __uint_as_float(y2.x & 0xffff0000u);
                        ha.z += g1 * __uint_as_float(y1.y << 16) + g2 * __uint_as_float(y2.y << 16); ha.w += g1 * __uint_as_float(y1.y & 0xffff0000u) + g2 * __uint_as_float(y2.y & 0xffff0000u);
                        hb2.x += g1 * __uint_as_float(y1.z << 16) + g2 * __uint_as_float(y2.z << 16); hb2.y += g1 * __uint_as_float(y1.z & 0xffff0000u) + g2 * __uint_as_float(y2.z & 0xffff0000u);
                        hb2.z += g1 * __uint_as_float(y1.w << 16) + g2 * __uint_as_float(y2.w << 16); hb2.w += g1 * __uint_as_float(y1.w & 0xffff0000u) + g2 * __uint_as_float(y2.w & 0xffff0000u);
                        hv[j][0] = ha; hv[j][1] = hb2; ssq += (ha.x * ha.x + ha.y * ha.y) + (ha.z * ha.z + ha.w * ha.w) + (hb2.x * hb2.x + hb2.y * hb2.y) + (hb2.z * hb2.z + hb2.w * hb2.w); }
                    if (layer == DEPTH - 1) {
                        if (row < NREAL) { float* orow = (*(float* const*)(ka + 256)) + (size_t)row * DM;
#pragma unroll
                            for (int j = 0; j < 2; ++j) { const int c8 = (lane + 64 * j) * 8; *(f32x4*)(orow + c8) = hv[j][0]; *(f32x4*)(orow + c8 + 4) = hv[j][1]; } }
                    } else {
                        ssq = wave_sum(ssq); const float rstd = 1.f / sqrtf(ssq * (1.f / DM) + 1e-6f), sn = rstd * A8_SCALE;
#pragma unroll
                        for (int j = 0; j < 2; ++j) { const int c8 = (lane + 64 * j) * 8; *(f32x4*)(hr + c8) = hv[j][0]; *(f32x4*)(hr + c8 + 4) = hv[j][1];
                            if ((INP8 >> (layer + 1)) & 1) { const unsigned lo = pk4_fp8(hv[j][0].x * sn, hv[j][0].y * sn, hv[j][0].z * sn, hv[j][0].w * sn), hi8 = pk4_fp8(hv[j][1].x * sn, hv[j][1].y * sn, hv[j][1].z * sn, hv[j][1].w * sn);
                                *(unsigned long long*)((unsigned char*)HB + (size_t)row * DM + c8) = (unsigned long long)lo | ((unsigned long long)hi8 << 32); }
                            else { v4u w; w.x = pk2(hv[j][0].x, hv[j][0].y); w.y = pk2(hv[j][0].z, hv[j][0].w); w.z = pk2(hv[j][1].x, hv[j][1].y); w.w = pk2(hv[j][1].z, hv[j][1].w);
                                *(v4u*)(HB + (size_t)row * DM + c8) = w; } }
                        if (lane == 0) RSTD[row] = rstd;
                    }
                }
                SEAM(pb + 10);
            }
        }
    }
#ifdef UBENCH
    if (hi >= 48 && bx == 255) { PH_TID;
        float x = (float)lane * 1e-3f, y = 1.0001f; float acc = 0.f;
        for (int it = 0; it < UBENCH_ITERS; ++it) {
#if UBENCH == 1
#pragma unroll
            for (int k = 0; k < 64; ++k) { asm volatile("v_fma_f32 %0, %0, %1, %0" : "+v"(x) : "v"(y)); }
#elif UBENCH == 2
#pragma unroll
            for (int k = 0; k < 64; ++k) { asm volatile("s_nop 1\n\tv_add_f32_dpp %0, %0, %0 row_mirror row_mask:0xf bank_mask:0xf bound_ctrl:1" : "+v"(x)); }
#elif UBENCH == 3
#pragma unroll
            for (int k = 0; k < 32; ++k) { asm volatile("s_nop 0\n\tv_readlane_b32 s20, %0, 63\n\tv_fmac_f32 %0, s20, %1" : "+v"(x) : "v"(y) : "s20"); }
#elif UBENCH == 5
            { float y2 = x + 1.f;
#pragma unroll
            for (int k = 0; k < 64; ++k) { asm volatile("s_nop 1\n\tv_add_f32_dpp %0, %0, %0 row_mirror row_mask:0xf bank_mask:0xf bound_ctrl:1\n\tv_add_f32_dpp %1, %1, %1 row_mirror row_mask:0xf bank_mask:0xf bound_ctrl:1" : "+v"(x), "+v"(y2)); }
            x += y2; }
#elif UBENCH == 6
            if (wave < 4) {
#pragma unroll
            for (int k = 0; k < 64; ++k) { asm volatile("s_nop 1\n\tv_add_f32_dpp %0, %0, %0 row_mirror row_mask:0xf bank_mask:0xf bound_ctrl:1" : "+v"(x)); } }
#elif UBENCH == 7
            if (wave < 4) {
#pragma unroll
            for (int k = 0; k < 64; ++k) { asm volatile("v_fma_f32 %0, %0, %1, %0" : "+v"(x) : "v"(y)); } }
#elif UBENCH == 8
            { float y2 = x + 1.f, y3 = x + 2.f, y4 = x + 3.f;
#pragma unroll
            for (int k = 0; k < 64; ++k) { asm volatile("s_nop 1\n\tv_add_f32_dpp %0, %0, %0 row_mirror row_mask:0xf bank_mask:0xf bound_ctrl:1\n\tv_add_f32_dpp %1, %1, %1 row_mirror row_mask:0xf bank_mask:0xf bound_ctrl:1\n\tv_add_f32_dpp %2, %2, %2 row_mirror row_mask:0xf bank_mask:0xf bound_ctrl:1\n\tv_add_f32_dpp %3, %3, %3 row_mirror row_mask:0xf bank_mask:0xf bound_ctrl:1" : "+v"(x), "+v"(y2), "+v"(y3), "+v"(y4)); }
            x += y2 + y3 + y4; }
#elif UBENCH == 4
#pragma unroll
            for (int k = 0; k < 64; ++k) { asm volatile("s_nop 1\n\tv_add_f32_dpp %0, %0, %0 row_bcast:15 row_mask:0xa bank_mask:0xf" : "+v"(x)); }
#endif
        }
        acc += x;
        if (acc == 123.456f) ((float*)(ws + WS_CTL))[2000 + tid] = acc;
    }
#endif
#undef IN
#undef SEAM
}

#ifndef MK_ONE_LAUNCH
#define MK_ONE_LAUNCH 1
#endif
extern "C" void kernel_launch(void* const* d_in, const int* in_sizes, int n_in, void* d_out, int out_size, void* d_ws, size_t ws_size, hipStream_t stream) {
    static int grid = 0;
    if (grid == 0) {
        if (n_in != 32 || out_size != NREAL * DM || ws_size < WS_END) { fprintf(stderr, "kernel_launch: unexpected shapes (n_in %d out %d ws %zu need %zu); nothing launched\n", n_in, out_size, ws_size, (size_t)WS_END); grid = -1; return; }
        int dev = 0, cus = 0, per_cu = 0;
        if (hipGetDevice(&dev) != hipSuccess || hipDeviceGetAttribute(&cus, hipDeviceAttributeMultiprocessorCount, dev) != hipSuccess) { grid = -1; return; }
        if (hipFuncSetAttribute((const void*)hymba_fwd, hipFuncAttributeMaxDynamicSharedMemorySize, LDS_BYTES) != hipSuccess) { fprintf(stderr, "kernel_launch: hipFuncSetAttribute failed\n"); grid = -1; return; }
        if (hipOccupancyMaxActiveBlocksPerMultiprocessor(&per_cu, (const void*)hymba_fwd, NWAVES * 64, LDS_BYTES) != hipSuccess || per_cu < 1) fprintf(stderr, "kernel_launch: occupancy query says %d\n", per_cu);
        (void)hipGetLastError();
        grid = cus;
        if (grid != 256) { fprintf(stderr, "kernel_launch: built for 256 CUs, device has %d; nothing launched\n", cus); grid = -1; return; }
    }
    if (grid < 0) return;
    if (hipMemsetAsync((char*)d_ws + WS_CTL, 0, CTL_ZERO_BYTES, stream) != hipSuccess) return;
    Args a{};
    for (int i = 0; i < 32; ++i) a.in[i] = (const float*)d_in[i];
    a.out = (float*)d_out; a.ws = (unsigned char*)d_ws;
#if MK_ONE_LAUNCH
    a.ph_lo = 0; a.ph_hi = 48;
    hipLaunchKernelGGL(hymba_fwd, dim3(grid), dim3(NWAVES * 64), LDS_BYTES, stream, a);
#else
    for (int ph = 0; ph < 50; ++ph) {
        if (ph >= 1 && ph <= 48) { const int l = (ph - 1) / 12, k = (ph - 1) % 12; const bool moe = l & 1; if (k == 11 || (!moe && k >= 9)) continue; }
        a.ph_lo = ph; a.ph_hi = ph + 1;
        hipLaunchKernelGGL(hymba_fwd, dim3(grid), dim3(NWAVES * 64), LDS_BYTES, stream, a);
    }
#endif
}
```

```cpp
#include <hip/hip_runtime.h>
#include <hip/hip_bf16.h>
#include <cmath>
#include <cstdio>
#include <cstdint>
namespace pg8 {
#define PG8_LAS __attribute__((address_space(3)))
typedef unsigned short bf16_t;
typedef short bf16x8 __attribute__((ext_vector_type(8)));
typedef float f32x4 __attribute__((ext_vector_type(4)));
typedef float f32x2 __attribute__((ext_vector_type(2)));
typedef unsigned u32x4 __attribute__((ext_vector_type(4)));
constexpr int BM = 256, BK = 64, HALF = 128, HTB = HALF * BK * 2  , STAGE_BYTES = 8 * HTB, NXCD = 8, WGM = 8;

__host__ __device__ __forceinline__ int lds_byte(int r, int c) { const int st = (r >> 4) * 2 + (c >> 5), rr = r & 15, cc = c & 31, ob = rr * 64 + cc * 2; return st * 1024 + (ob ^ (((ob >> 9) & 1) << 5)); }
__host__ __device__ __forceinline__ void stage_rc(int b, int& R, int& C) { const int st = b / 1024, sb = b % 1024, swz = sb ^ (((sb >> 9) & 1) << 5); R = (st >> 1) * 16 + swz / 64; C = (st & 1) * 32 + (swz % 64) / 2; }
__host__ __device__ __forceinline__ int perm32(int rho) { const int n = rho >> 4, i = rho & 15; return 8 * (i >> 2) + 4 * n + (i & 3); }

struct Unit { int pm, pn, pc; };
struct Gemm { const bf16_t* A; const bf16_t* Bt; int M, N, K; };

struct StaticOrder {
    int nM, nN, nwg, G, c;
    __host__ __device__ void init(int M, int N, int G_, int c_) { nM = M / BM; nN = N / BM; nwg = nM * nN; G = G_; c = c_; }
    __host__ __device__ bool next(int i, Unit& u) const {
        const long L = (long)i * G + c; if (L >= nwg) return false;
        int wgid = (int)L; { const int q = nwg / NXCD, r = nwg % NXCD, xcd = wgid % NXCD, off = wgid / NXCD; wgid = (xcd < r ? xcd * (q + 1) : r * (q + 1) + (xcd - r) * q) + off; }
        const int nig = WGM * nN, gid = wgid / nig, fm = gid * WGM, gsz = (nM - fm) < WGM ? (nM - fm) : WGM;
        u.pm = fm + ((wgid % nig) % gsz); u.pn = (wgid % nig) / gsz; u.pc = u.pn; return true;
    }
    __device__ __forceinline__ void a_ready(const Unit&) const {}
    __device__ __forceinline__ void done(const Unit&) const {}
};
struct MoeOrder {
    int G, c, nN, total; int t1, t2, t3, t4, t5, t6, t7;
    __device__ __forceinline__ void init(const int* cnt, int nN_, int G_, int c_) {
        G = G_; c = c_; nN = nN_; int a = 0;
        a += (__builtin_amdgcn_readfirstlane(__hip_atomic_load(cnt + 0, __ATOMIC_RELAXED, __HIP_MEMORY_SCOPE_AGENT)) + 255) >> 8; t1 = a;
        a += (__builtin_amdgcn_readfirstlane(__hip_atomic_load(cnt + 1, __ATOMIC_RELAXED, __HIP_MEMORY_SCOPE_AGENT)) + 255) >> 8; t2 = a;
        a += (__builtin_amdgcn_readfirstlane(__hip_atomic_load(cnt + 2, __ATOMIC_RELAXED, __HIP_MEMORY_SCOPE_AGENT)) + 255) >> 8; t3 = a;
        a += (__builtin_amdgcn_readfirstlane(__hip_atomic_load(cnt + 3, __ATOMIC_RELAXED, __HIP_MEMORY_SCOPE_AGENT)) + 255) >> 8; t4 = a;
        a += (__builtin_amdgcn_readfirstlane(__hip_atomic_load(cnt + 4, __ATOMIC_RELAXED, __HIP_MEMORY_SCOPE_AGENT)) + 255) >> 8; t5 = a;
        a += (__builtin_amdgcn_readfirstlane(__hip_atomic_load(cnt + 5, __ATOMIC_RELAXED, __HIP_MEMORY_SCOPE_AGENT)) + 255) >> 8; t6 = a;
        a += (__builtin_amdgcn_readfirstlane(__hip_atomic_load(cnt + 6, __ATOMIC_RELAXED, __HIP_MEMORY_SCOPE_AGENT)) + 255) >> 8; t7 = a;
        a += (__builtin_amdgcn_readfirstlane(__hip_atomic_load(cnt + 7, __ATOMIC_RELAXED, __HIP_MEMORY_SCOPE_AGENT)) + 255) >> 8;
        total = a * nN;
    }
    __device__ __forceinline__ bool next(int i, Unit& u) const {
        const int x = c & 7, per = G >> 3; const int e_ = i * per + (c >> 3);
        const int ntile = total / nN; const int mine = (ntile - x + 7) >> 3;
        if (e_ >= mine * nN) return false;
        const int rt = x + 8 * (e_ / nN), j = e_ % nN;
        const int e = (rt >= t1) + (rt >= t2) + (rt >= t3) + (rt >= t4) + (rt >= t5) + (rt >= t6) + (rt >= t7);
        u.pm = rt; u.pn = e * nN + j; u.pc = j; return true;
    }
    __device__ __forceinline__ void a_ready(const Unit&) const {}
    __device__ __forceinline__ void done(const Unit&) const {}
};

__device__ __forceinline__ unsigned cvt_pk_bf16(float lo, float hi) { unsigned r; asm volatile("v_cvt_pk_bf16_f32 %0, %1, %2" : "=v"(r) : "v"(lo), "v"(hi)); return r; }

#define PG8_GAS __attribute__((address_space(1)))
struct EpiBf16Rs {
    static constexpr bool PERM = true, AFTER_DRAIN = false;
    bf16_t* O; int ldc; const float* rs; float sc;
    __device__ __forceinline__ void operator()(const f32x4 (&acc)[2][2][4][2], const Unit& u, int wr, int wc, int fr, int fq) const {
        const int row0 = u.pm * BM + wr * 64 + fr; const int col0 = u.pc * BM + wc * 32 + 8 * fq;
        float sv[2][4];
#pragma unroll
        for (int ai = 0; ai < 2; ++ai)
#pragma unroll
            for (int m = 0; m < 4; ++m) sv[ai][m] = rs ? ((const PG8_GAS float*)rs)[row0 + ai * HALF + m * 16] : sc;
#pragma unroll
        for (int ai = 0; ai < 2; ++ai)
#pragma unroll
            for (int m = 0; m < 4; ++m) { const int row = row0 + ai * HALF + m * 16; const float s = sv[ai][m]; PG8_GAS bf16_t* rowp = (PG8_GAS bf16_t*)O + (size_t)row * ldc + col0;
#pragma unroll
                for (int bj = 0; bj < 2; ++bj) { const f32x4 v0 = acc[ai][bj][m][0] * s, v1 = acc[ai][bj][m][1] * s;
                    u32x4 w; w.x = cvt_pk_bf16(v0[0], v0[1]); w.y = cvt_pk_bf16(v0[2], v0[3]); w.z = cvt_pk_bf16(v1[0], v1[1]); w.w = cvt_pk_bf16(v1[2], v1[3]);
                    *(PG8_GAS u32x4*)(rowp + bj * HALF) = w; } }
    }
};
struct EpiResAdd {
    static constexpr bool PERM = false, AFTER_DRAIN = false;
    float* H; int ldc; float sc;
    __device__ __forceinline__ void operator()(const f32x4 (&acc)[2][2][4][2], const Unit& u, int wr, int wc, int fr, int fq) const {
        const int row0 = u.pm * BM + wr * 64 + fr; const int col0 = u.pc * BM + wc * 32 + 4 * fq;
#pragma unroll
        for (int ai = 0; ai < 2; ++ai)
#pragma unroll
            for (int mp = 0; mp < 2; ++mp) {
                f32x4 res[2][2][2];
#pragma unroll
                for (int m2 = 0; m2 < 2; ++m2) { const PG8_GAS float* rowp = (const PG8_GAS float*)H + (size_t)(row0 + ai * HALF + (2 * mp + m2) * 16) * ldc + col0;
#pragma unroll
                    for (int bj = 0; bj < 2; ++bj)
#pragma unroll
                        for (int n = 0; n < 2; ++n) res[m2][bj][n] = *(const PG8_GAS f32x4*)(rowp + bj * HALF + n * 16); }
#pragma unroll
                for (int m2 = 0; m2 < 2; ++m2) { PG8_GAS float* rowp = (PG8_GAS float*)H + (size_t)(row0 + ai * HALF + (2 * mp + m2) * 16) * ldc + col0;
#pragma unroll
                    for (int bj = 0; bj < 2; ++bj)
#pragma unroll
                        for (int n = 0; n < 2; ++n) *(PG8_GAS f32x4*)(rowp + bj * HALF + n * 16) = res[m2][bj][n] + acc[ai][bj][2 * mp + m2][n] * sc; }
                asm volatile("" ::: "memory");
            }
    }
};
template <int MODE, long long HB_OFF, long long RSQ_OFF> struct EpiResAddHB {
    static constexpr bool PERM = true, AFTER_DRAIN = false; static constexpr float hs = 4.f;
    float* H; int ldc; float sc;
    __device__ __forceinline__ void operator()(const f32x4 (&acc)[2][2][4][2], const Unit& u, int wr, int wc, int fr, int fq) const {
        const int row0 = u.pm * BM + wr * 64 + fr; const int col0 = u.pc * BM + wc * 32 + 8 * fq;
        PG8_GAS unsigned char* const HBo = (PG8_GAS unsigned char*)H + HB_OFF; PG8_GAS unsigned long long* const rsq = (PG8_GAS unsigned long long*)((PG8_GAS unsigned char*)H + RSQ_OFF);
#pragma unroll
        for (int ai = 0; ai < 2; ++ai)
#pragma unroll
            for (int m = 0; m < 4; ++m) { const int row = row0 + ai * HALF + m * 16; PG8_GAS float* rowp = (PG8_GAS float*)H + (size_t)row * ldc + col0;
                f32x4 r_[2][2];
#pragma unroll
                for (int bj = 0; bj < 2; ++bj)
#pragma unroll
                    for (int n = 0; n < 2; ++n) r_[bj][n] = *(const PG8_GAS f32x4*)(rowp + bj * HALF + n * 4);
                float ss = 0.f;
#pragma unroll
                for (int bj = 0; bj < 2; ++bj) { const f32x4 v0 = r_[bj][0] + acc[ai][bj][m][0] * sc, v1 = r_[bj][1] + acc[ai][bj][m][1] * sc;
                    *(PG8_GAS f32x4*)(rowp + bj * HALF) = v0; *(PG8_GAS f32x4*)(rowp + bj * HALF + 4) = v1;
                    ss += ((v0[0] * v0[0] + v0[1] * v0[1]) + (v0[2] * v0[2] + v0[3] * v0[3])) + ((v1[0] * v1[0] + v1[1] * v1[1]) + (v1[2] * v1[2] + v1[3] * v1[3]));
                    if constexpr (MODE == 1) { u32x4 w; w.x = cvt_pk_bf16(v0[0], v0[1]); w.y = cvt_pk_bf16(v0[2], v0[3]); w.z = cvt_pk_bf16(v1[0], v1[1]); w.w = cvt_pk_bf16(v1[2], v1[3]);
                        *(PG8_GAS u32x4*)((PG8_GAS bf16_t*)HBo + (size_t)row * ldc + col0 + bj * HALF) = w; }
                    else {
#define PG8_C8(x) __builtin_amdgcn_fmed3f((x) * hs, -448.f, 448.f)
                        unsigned lo = (unsigned)__builtin_amdgcn_cvt_pk_fp8_f32(PG8_C8(v0[0]), PG8_C8(v0[1]), 0, false); lo = (unsigned)__builtin_amdgcn_cvt_pk_fp8_f32(PG8_C8(v0[2]), PG8_C8(v0[3]), (int)lo, true);
                        unsigned hi = (unsigned)__builtin_amdgcn_cvt_pk_fp8_f32(PG8_C8(v1[0]), PG8_C8(v1[1]), 0, false); hi = (unsigned)__builtin_amdgcn_cvt_pk_fp8_f32(PG8_C8(v1[2]), PG8_C8(v1[3]), (int)hi, true);
#undef PG8_C8
                        *(PG8_GAS unsigned long long*)(HBo + (size_t)row * ldc + col0 + bj * HALF) = (unsigned long long)lo | ((unsigned long long)hi << 32); } }
                { auto p_ = __builtin_amdgcn_permlane16_swap(__float_as_uint(ss), __float_as_uint(ss), false, false); ss = __uint_as_float(p_[0]) + __uint_as_float(p_[1]); }
                { auto p_ = __builtin_amdgcn_permlane32_swap(__float_as_uint(ss), __float_as_uint(ss), false, false); ss = __uint_as_float(p_[0]) + __uint_as_float(p_[1]); }
                if (fq == 0) __hip_atomic_fetch_add(rsq + row, (unsigned long long)(ss * 16777216.f), __ATOMIC_RELAXED, __HIP_MEMORY_SCOPE_AGENT);
                asm volatile("" ::: "memory"); }
    }
};
template <bool OUT8> struct EpiSwigluT {
    static constexpr bool PERM = true, AFTER_DRAIN = false;
    bf16_t* O; int ldc; const float* rs; float sc; float o8; const unsigned long long* rsq;
    __device__ __forceinline__ void operator()(const f32x4 (&acc)[2][2][4][2], const Unit& u, int wr, int wc, int fr, int fq) const {
        const int row0 = u.pm * BM + wr * 64 + fr; const int col0 = u.pc * HALF + wc * 32 + 8 * fq;
        float sv[2][4];
#pragma unroll
        for (int ai = 0; ai < 2; ++ai)
#pragma unroll
            for (int m = 0; m < 4; ++m) sv[ai][m] = rsq ? sc * __builtin_amdgcn_rsqf((float)((const PG8_GAS unsigned long long*)rsq)[row0 + ai * HALF + m * 16] * (1.f / (16777216.f * 1024.f)) + 1e-6f) : (rs ? ((const PG8_GAS float*)rs)[row0 + ai * HALF + m * 16] : sc);
#pragma unroll
        for (int ai = 0; ai < 2; ++ai)
#pragma unroll
            for (int m = 0; m < 4; ++m) { const int row = row0 + ai * HALF + m * 16; const float s = sv[ai][m]; PG8_GAS bf16_t* rowp = (PG8_GAS bf16_t*)O + (size_t)row * ldc + col0;
                const float c1 = -1.4426950408889634f * s, c2 = OUT8 ? s * s * o8 : s * s;
                f32x2 q[4];
#pragma unroll
                for (int n = 0; n < 2; ++n)
#pragma unroll
                    for (int h = 0; h < 2; ++h) { const f32x4 av = acc[ai][0][m][n], bv = acc[ai][1][m][n];
                        const f32x2 a = h ? (f32x2){av[2], av[3]} : (f32x2){av[0], av[1]}, b = h ? (f32x2){bv[2], bv[3]} : (f32x2){bv[0], bv[1]};
                        const f32x2 t = a * c1; f32x2 e; e.x = __builtin_amdgcn_exp2f(t.x); e.y = __builtin_amdgcn_exp2f(t.y);
                        const f32x2 d = e + 1.f; f32x2 r; r.x = __builtin_amdgcn_rcpf(d.x); r.y = __builtin_amdgcn_rcpf(d.y);
                        q[2 * n + h] = ((a * b) * r) * c2; }
                if constexpr (OUT8) { PG8_GAS unsigned char* rp8 = (PG8_GAS unsigned char*)O + (size_t)row * ldc + col0;
#define PG8_C8(x) __builtin_amdgcn_fmed3f((x), -448.f, 448.f)
                    unsigned lo = (unsigned)__builtin_amdgcn_cvt_pk_fp8_f32(PG8_C8(q[0].x), PG8_C8(q[0].y), 0, false); lo = (unsigned)__builtin_amdgcn_cvt_pk_fp8_f32(PG8_C8(q[1].x), PG8_C8(q[1].y), (int)lo, true);
                    unsigned hi = (unsigned)__builtin_amdgcn_cvt_pk_fp8_f32(PG8_C8(q[2].x), PG8_C8(q[2].y), 0, false); hi = (unsigned)__builtin_amdgcn_cvt_pk_fp8_f32(PG8_C8(q[3].x), PG8_C8(q[3].y), (int)hi, true);
#undef PG8_C8
                    *(PG8_GAS unsigned long long*)rp8 = (unsigned long long)lo | ((unsigned long long)hi << 32); }
                else { u32x4 w; w.x = cvt_pk_bf16(q[0].x, q[0].y); w.y = cvt_pk_bf16(q[1].x, q[1].y); w.z = cvt_pk_bf16(q[2].x, q[2].y); w.w = cvt_pk_bf16(q[3].x, q[3].y);
                    *(PG8_GAS u32x4*)rowp = w; } }
    }
};
typedef EpiSwigluT<false> EpiSwiglu; typedef EpiSwigluT<true> EpiSwiglu8;

template <class Epi, class Sched, bool ALIGN_EPI = false, bool SP2 = false, bool FP8 = false>
__device__ __forceinline__ void gemm_phase(PG8_LAS unsigned char* lds, const Gemm g, const Sched& S, const Epi& E, int tid_in) {
    int tid_ = tid_in; asm volatile("" : "+v"(tid_));
    const int tid = tid_, wid = __builtin_amdgcn_readfirstlane(tid >> 6), lane = tid & 63, wr = wid >> 2, wc = wid & 3, fr = lane & 15, fq = lane >> 4;
    const int K = g.K, nt = K / BK;
    unsigned voffA[2], voffB[2];
#pragma unroll
    for (int i = 0; i < 2; ++i) { int R, C; stage_rc(tid * 16 + i * 8192, R, C); const int Rb = Epi::PERM ? ((R & ~31) + perm32(R & 31)) : R;
        voffA[i] = (unsigned)(R * K + C) * 2u; voffB[i] = (unsigned)(Rb * K + C) * 2u; }
    const size_t kstep = (size_t)(BK * 2);
    const size_t hstep = (size_t)HALF * K * 2;
    const size_t tstep = 2 * hstep;
    const unsigned ldsw = (unsigned)wid * 1024u;
    const int aoff = lds_byte(wr * 64 + fr, fq * 8), boff = lds_byte(wc * 32 + fr, fq * 8);
#define PG8_SA(b, h) (((b) * 2 + (h)) * HTB)
#define PG8_SB(b, h) ((4 + (b) * 2 + (h)) * HTB)
#define PG8_STAGE(bufoff, gbase, voff) do { _Pragma("unroll") for (int _i = 0; _i < 2; ++_i) \
        __builtin_amdgcn_global_load_lds((const unsigned*)((const char*)(gbase) + (voff)[_i]), (PG8_LAS unsigned*)(lds + (bufoff) + ldsw + _i * 8192), 16, 0, 0); } while (0)
#define PG8_LDA(dst, b, h) do { _Pragma("unroll") for (int m = 0; m < 4; ++m) _Pragma("unroll") for (int k = 0; k < 2; ++k) dst[m][k] = *(const PG8_LAS bf16x8*)(lds + PG8_SA(b, h) + aoff + m * 2048 + k * 1024); } while (0)
#define PG8_LDB(dst, b, h) do { _Pragma("unroll") for (int n = 0; n < 2; ++n) _Pragma("unroll") for (int k = 0; k < 2; ++k) dst[n][k] = *(const PG8_LAS bf16x8*)(lds + PG8_SB(b, h) + boff + n * 2048 + k * 1024); } while (0)
#define PG8_MMA(ai, bj, At, Bt) do { __builtin_amdgcn_s_setprio(1); \
        if constexpr (FP8) { typedef int v8i_ __attribute__((ext_vector_type(8))); typedef int v4i_ __attribute__((ext_vector_type(4))); const int sc8_ = 0x7f7f7f7f;     \
            _Pragma("unroll") for (int m = 0; m < 4; ++m) _Pragma("unroll") for (int n = 0; n < 2; ++n) { \
                const v4i_ b0_ = __builtin_bit_cast(v4i_, Bt[n][0]), b1_ = __builtin_bit_cast(v4i_, Bt[n][1]), a0_ = __builtin_bit_cast(v4i_, At[m][0]), a1_ = __builtin_bit_cast(v4i_, At[m][1]); \
                const v8i_ bb_ = (v8i_){b0_.x, b0_.y, b0_.z, b0_.w, b1_.x, b1_.y, b1_.z, b1_.w}, aa_ = (v8i_){a0_.x, a0_.y, a0_.z, a0_.w, a1_.x, a1_.y, a1_.z, a1_.w}; \
                asm volatile("v_mfma_scale_f32_16x16x128_f8f6f4 %0, %1, %2, %0, %3, %3 op_sel_hi:[0,0,0]" : "+v"(acc[ai][bj][m][n]) : "v"(bb_), "v"(aa_), "v"(sc8_)); } \
        } else { _Pragma("unroll") for (int m = 0; m < 4; ++m) _Pragma("unroll") for (int n = 0; n < 2; ++n) _Pragma("unroll") for (int k = 0; k < 2; ++k) \
            acc[ai][bj][m][n] = __builtin_amdgcn_mfma_f32_16x16x32_bf16(Bt[n][k], At[m][k], acc[ai][bj][m][n], 0, 0, 0); } \
        __builtin_amdgcn_s_setprio(0); } while (0)
#define PG8_WAIT_V(n) asm volatile("s_waitcnt vmcnt(" #n ")" ::: "memory")
#define PG8_WAIT_L(n) asm volatile("s_waitcnt lgkmcnt(" #n ")" ::: "memory")
#define PG8_BAR __builtin_amdgcn_s_barrier()
#define PG8_SCHED __builtin_amdgcn_sched_barrier(0)
    Unit cur, nxt; int ui = 0;
    if (!S.next(0, cur)) return;
    f32x4 acc[2][2][4][2];
    { float zf; asm volatile("v_mov_b32 %0, 0" : "=v"(zf));
#pragma unroll
    for (int a = 0; a < 2; ++a)
#pragma unroll
        for (int b = 0; b < 2; ++b)
#pragma unroll
            for (int m = 0; m < 4; ++m)
#pragma unroll
                for (int n = 0; n < 2; ++n) acc[a][b][m][n] = (f32x4){zf, zf, zf, zf}; }
    bf16x8 At[4][2], B0[2][2], B1[2][2];
    const char* cA = (const char*)g.A + (size_t)cur.pm * tstep; const char* cB = (const char*)g.Bt + (size_t)cur.pn * tstep;
    S.a_ready(cur);
    if constexpr (SP2) {
        PG8_STAGE(PG8_SB(0, 0), cB, voffB); PG8_STAGE(PG8_SB(0, 1), cB + hstep, voffB); PG8_STAGE(PG8_SA(0, 0), cA, voffA); PG8_STAGE(PG8_SA(0, 1), cA + hstep, voffA);
        if (wr == 1) PG8_BAR;
        PG8_WAIT_V(2); PG8_BAR;
        PG8_STAGE(PG8_SB(1, 0), cB + kstep, voffB); PG8_STAGE(PG8_SA(1, 0), cA + kstep, voffA); PG8_STAGE(PG8_SB(1, 1), cB + hstep + kstep, voffB);
        PG8_WAIT_V(6); PG8_BAR;
    } else {
        PG8_STAGE(PG8_SB(0, 0), cB, voffB); PG8_STAGE(PG8_SA(0, 0), cA, voffA); PG8_STAGE(PG8_SB(0, 1), cB + hstep, voffB); PG8_STAGE(PG8_SA(0, 1), cA + hstep, voffA);
        if (wr == 1) PG8_BAR;
        PG8_WAIT_V(4); PG8_BAR;
        PG8_STAGE(PG8_SB(1, 0), cB + kstep, voffB); PG8_STAGE(PG8_SA(1, 0), cA + kstep, voffA); PG8_STAGE(PG8_SB(1, 1), cB + hstep + kstep, voffB);
        PG8_WAIT_V(6); PG8_BAR;
    }
    for (;;) {
        const bool has_next = S.next(ui + 1, nxt);
        const char* nA = has_next ? (const char*)g.A + (size_t)nxt.pm * tstep : cA; const char* nB = has_next ? (const char*)g.Bt + (size_t)nxt.pn * tstep : cB;
        for (int t = 0; t < nt; t += 2) {
            const bool last = (t == nt - 2);
            const char* a1 = cA + (size_t)(t + 1) * kstep;
            const char* a2 = last ? nA : cA + (size_t)(t + 2) * kstep; const char* b2 = last ? nB : cB + (size_t)(t + 2) * kstep;
            const char* a3 = a2 + kstep; const char* b3 = b2 + kstep;
            if (last && has_next) S.a_ready(nxt);
            if constexpr (SP2) {
            PG8_LDB(B0, 0, 0); PG8_LDB(B1, 0, 1); PG8_SCHED; PG8_LDA(At, 0, 0); PG8_STAGE(PG8_SA(1, 1), a1 + hstep, voffA);
            PG8_WAIT_V(8); PG8_WAIT_L(0); PG8_BAR; PG8_MMA(0, 0, At, B0); PG8_MMA(0, 1, At, B1); PG8_BAR; PG8_SCHED;
            PG8_LDA(At, 0, 1); PG8_STAGE(PG8_SB(0, 0), b2, voffB); PG8_STAGE(PG8_SB(0, 1), b2 + hstep, voffB); PG8_STAGE(PG8_SA(0, 0), a2, voffA);
            PG8_WAIT_V(8); PG8_WAIT_L(0); PG8_BAR; PG8_MMA(1, 0, At, B0); PG8_MMA(1, 1, At, B1); PG8_BAR; PG8_SCHED;
            PG8_LDB(B0, 1, 0); PG8_LDB(B1, 1, 1); PG8_SCHED; PG8_LDA(At, 1, 0); PG8_STAGE(PG8_SA(0, 1), a2 + hstep, voffA);
            PG8_WAIT_V(8); PG8_WAIT_L(0); PG8_BAR; PG8_MMA(0, 0, At, B0); PG8_MMA(0, 1, At, B1); PG8_BAR; PG8_SCHED;
            PG8_LDA(At, 1, 1); PG8_STAGE(PG8_SB(1, 0), b3, voffB); PG8_STAGE(PG8_SB(1, 1), b3 + hstep, voffB); PG8_STAGE(PG8_SA(1, 0), a3, voffA);
            PG8_WAIT_V(8); PG8_WAIT_L(0); PG8_BAR; PG8_MMA(1, 0, At, B0); PG8_MMA(1, 1, At, B1); PG8_BAR; PG8_SCHED;
            } else {
            PG8_LDB(B0, 0, 0); PG8_SCHED; PG8_LDA(At, 0, 0); PG8_STAGE(PG8_SA(1, 1), a1 + hstep, voffA);
            PG8_WAIT_L(8); PG8_BAR; PG8_WAIT_L(0); PG8_MMA(0, 0, At, B0); PG8_BAR; PG8_SCHED;
            PG8_LDB(B1, 0, 1); PG8_STAGE(PG8_SB(0, 0), b2, voffB);
            PG8_BAR; PG8_WAIT_L(0); PG8_MMA(0, 1, At, B1); PG8_BAR;
            PG8_LDA(At, 0, 1); PG8_STAGE(PG8_SA(0, 0), a2, voffA);
            PG8_BAR; PG8_WAIT_L(0); PG8_MMA(1, 0, At, B0); PG8_BAR; PG8_SCHED;
            PG8_STAGE(PG8_SB(0, 1), b2 + hstep, voffB);
            PG8_WAIT_V(6); PG8_BAR; PG8_MMA(1, 1, At, B1); PG8_BAR;
            PG8_LDB(B0, 1, 0); PG8_SCHED; PG8_LDA(At, 1, 0); PG8_STAGE(PG8_SA(0, 1), a2 + hstep, voffA);
            PG8_WAIT_L(8); PG8_BAR; PG8_WAIT_L(0); PG8_MMA(0, 0, At, B0); PG8_BAR; PG8_SCHED;
            PG8_LDB(B1, 1, 1); PG8_STAGE(PG8_SB(1, 0), b3, voffB);
            PG8_BAR; PG8_WAIT_L(0); PG8_MMA(0, 1, At, B1); PG8_BAR;
            PG8_LDA(At, 1, 1); PG8_STAGE(PG8_SA(1, 0), a3, voffA);
            PG8_BAR; PG8_WAIT_L(0); PG8_MMA(1, 0, At, B0); PG8_BAR; PG8_SCHED;
            PG8_STAGE(PG8_SB(1, 1), b3 + hstep, voffB);
            PG8_WAIT_V(6); PG8_BAR; PG8_MMA(1, 1, At, B1); PG8_BAR;
            }
        }
        if constexpr (FP8) asm volatile("s_nop 15\n\ts_nop 15\n\ts_nop 15" ::: "memory");
        if constexpr (ALIGN_EPI) { if (wr == 0) PG8_BAR; }
        if constexpr (!Epi::AFTER_DRAIN) { E(acc, cur, wr, wc, fr, fq); S.done(cur); }
        if (!has_next) break;
        { float zf; asm volatile("v_mov_b32 %0, 0" : "=v"(zf));
#pragma unroll
        for (int a = 0; a < 2; ++a)
#pragma unroll
            for (int b = 0; b < 2; ++b)
#pragma unroll
                for (int m = 0; m < 4; ++m)
#pragma unroll
                    for (int n = 0; n < 2; ++n) acc[a][b][m][n] = (f32x4){zf, zf, zf, zf}; }
        cur = nxt; cA = nA; cB = nB; ++ui;
        if constexpr (ALIGN_EPI) { if (wr == 1) PG8_BAR; }
    }
    PG8_WAIT_V(0);
    if constexpr (!ALIGN_EPI) { if (wr == 0) PG8_BAR; }
    PG8_BAR;
    if constexpr (Epi::AFTER_DRAIN) { E.fused(acc, cur, wr, wc, fr, fq, lds, wid, lane); S.done(cur); }
#undef PG8_SA
#undef PG8_SB
#undef PG8_STAGE
#undef PG8_LDA
#undef PG8_LDB
#undef PG8_MMA
#undef PG8_WAIT_V
#undef PG8_WAIT_L
#undef PG8_BAR
#undef PG8_SCHED
}
}
#include <hip/hip_bf16.h>
#include <cmath>
namespace attn_body {
using bf16=__hip_bfloat16;
using bf16x8=__attribute__((ext_vector_type(8)))short;
using s16x4=__attribute__((ext_vector_type(4)))short;
using f32x16=__attribute__((ext_vector_type(16)))float;
using u32x4=__attribute__((ext_vector_type(4)))unsigned;
constexpr int BATCH=4,NHEAD=8,SEQ=4096,D=64,DM=512,DMO=1024,KVSEQ=4224;
constexpr int NW=8,QBLK=32,QB=QBLK*NW,KVBLK=64,NQB=SEQ/QB;
constexpr int ATTN_UNIT_ROWS=QB;
__device__ __forceinline__ int crow(int r,int hi){return (r&3)+8*(r>>2)+4*hi;}
#define SBAR() __builtin_amdgcn_sched_barrier(0)
__device__ __forceinline__ void cmask(f32x16&p0,f32x16&p1,int jb,int qrel,int hi){
  const float NEG=-INFINITY; int kb=64*jb+4*hi;
  #pragma unroll
  for(int r=0;r<16;++r){int kv=kb+(r&3)+8*(r>>2); if(kv>qrel)p0[r]=NEG; if(kv+32>qrel)p1[r]=NEG;}
}

constexpr int NSLOT=3, SLOTB=8192;
constexpr int LDS_K=0, LDS_V=NSLOT*SLOTB, LDS_V2=2*NSLOT*SLOTB, LDS_WS=3*NSLOT*SLOTB, LDS_OST=LDS_WS+NW*64*4, LDS_BYTES=LDS_OST+NW*4096;
constexpr float C2=0.125f*1.4426950408889634f;
__device__ __forceinline__ void glds16(const void*gsrc,unsigned lds_dst){unsigned keep;
  asm volatile("s_mov_b32 %0, m0\n\ts_mov_b32 m0, %2\n\ts_nop 0\n\tglobal_load_lds_dwordx4 %1, off\n\ts_mov_b32 m0, %0":"=&s"(keep):"v"(gsrc),"s"(lds_dst):"memory");}
__device__ __forceinline__ void glds16s(const void*sbase,unsigned voff,unsigned lds_dst){unsigned keep;
  asm volatile("s_mov_b32 %0, m0\n\ts_mov_b32 m0, %3\n\ts_nop 0\n\tglobal_load_lds_dwordx4 %1, %2\n\ts_mov_b32 m0, %0":"=&s"(keep):"v"(voff),"s"(sbase),"s"(lds_dst):"memory");}
__device__ __forceinline__ float max3f(float a,float b,float c){float r;asm("v_max3_f32 %0, %1, %2, %3":"=v"(r):"v"(a),"v"(b),"v"(c));return r;}
__device__ __forceinline__ float max2f(float a,float b){float r;asm("v_max_f32_e32 %0, %1, %2":"=v"(r):"v"(a),"v"(b));return r;}
__device__ __forceinline__ float fadd_s(float a,float b){float r;asm("v_add_f32_e32 %0, %1, %2":"=v"(r):"v"(a),"v"(b));return r;}
__device__ __forceinline__ float fsub_s(float a,float b){float r;asm("v_sub_f32_e32 %0, %1, %2":"=v"(r):"v"(a),"v"(b));return r;}
typedef float f32x2_t __attribute__((ext_vector_type(2))); typedef __bf16 bf16x2_t __attribute__((ext_vector_type(2)));
__device__ __forceinline__ unsigned cvtpk_s(float lo,float hi){f32x2_t v={lo,hi};bf16x2_t b=__builtin_convertvector(v,bf16x2_t);return __builtin_bit_cast(unsigned,b);}
#define WAIT_BAR(N) asm volatile("s_waitcnt vmcnt(" #N ") lgkmcnt(0)\n\ts_barrier":::"memory")

typedef __attribute__((address_space(3))) const char* lds_cptr;
__device__ __forceinline__ void qkt(f32x16&p0,f32x16&p1,lds_cptr Kslot,const bf16x8*qr,const f32x16&negm0,const f32x16&negm1,int r32,int hi){
  const lds_cptr kb=Kslot+hi*1024+r32*16;
  #pragma unroll
  for(int d0=0;d0<4;++d0){
    const bf16x8 b0=*(const __attribute__((address_space(3))) bf16x8*)(kb+d0*2048);
    const bf16x8 b1=*(const __attribute__((address_space(3))) bf16x8*)(kb+d0*2048+512);
    if(d0==0){p0=__builtin_amdgcn_mfma_f32_32x32x16_bf16(b0,qr[0],negm0,0,0,0);p1=__builtin_amdgcn_mfma_f32_32x32x16_bf16(b1,qr[0],negm1,0,0,0);}
    else{p0=__builtin_amdgcn_mfma_f32_32x32x16_bf16(b0,qr[d0],p0,0,0,0);p1=__builtin_amdgcn_mfma_f32_32x32x16_bf16(b1,qr[d0],p1,0,0,0);}}
}
typedef short v4i16_t __attribute__((ext_vector_type(4)));
__device__ __forceinline__ void kload8(bf16x8*kf,lds_cptr kp){
  kf[0]=*(const __attribute__((address_space(3))) bf16x8*)(kp);      kf[1]=*(const __attribute__((address_space(3))) bf16x8*)(kp+512);
  kf[2]=*(const __attribute__((address_space(3))) bf16x8*)(kp+2048); kf[3]=*(const __attribute__((address_space(3))) bf16x8*)(kp+2560);
  kf[4]=*(const __attribute__((address_space(3))) bf16x8*)(kp+4096); kf[5]=*(const __attribute__((address_space(3))) bf16x8*)(kp+4608);
  kf[6]=*(const __attribute__((address_space(3))) bf16x8*)(kp+6144); kf[7]=*(const __attribute__((address_space(3))) bf16x8*)(kp+6656);
}
__device__ __forceinline__ void kload2(bf16x8*kf,lds_cptr kp,int j){ kf[2*j]=*(const __attribute__((address_space(3))) bf16x8*)(kp+j*2048); kf[2*j+1]=*(const __attribute__((address_space(3))) bf16x8*)(kp+j*2048+512); }
__device__ __forceinline__ s16x4 vtr(lds_cptr p){ return __builtin_bit_cast(s16x4,__builtin_amdgcn_ds_read_tr16_b64_v4i16((__attribute__((address_space(3))) v4i16_t*)p)); }
__device__ __forceinline__ float rowmax(const f32x16&p0,const f32x16&p1){
  float a=max3f(p0[0],p0[1],p1[0]),b=max3f(p0[2],p0[3],p1[1]);a=max3f(a,p1[2],p1[3]);
  #pragma unroll
  for(int r=4;r<16;r+=4){a=max3f(a,p0[r],p0[r+1]);b=max3f(b,p0[r+2],p0[r+3]);a=max3f(a,p1[r],p1[r+1]);b=max3f(b,p1[r+2],p1[r+3]);}
  const float m=max2f(a,b);
  auto rr=__builtin_amdgcn_permlane32_swap(__float_as_uint(m),__float_as_uint(m),false,false);
  return max2f(__uint_as_float(rr[0]),__uint_as_float(rr[1]));
}
__device__ __forceinline__ void pv(f32x16*o,int vb,bf16x8 pa0,bf16x8 pa1,bf16x8 pa2,bf16x8 pa3){
  #pragma unroll
  for(int d0=0;d0<2;++d0){s16x4 lo[4],hi[4];
    #pragma unroll
    for(int ks=0;ks<4;++ks){
      asm volatile("ds_read_b64_tr_b16 %0,%1 offset:%c2":"=&v"(lo[ks]):"v"(vb),"i"(d0*4096+ks*1024):"memory");
      asm volatile("ds_read_b64_tr_b16 %0,%1 offset:%c2":"=&v"(hi[ks]):"v"(vb),"i"(d0*4096+ks*1024+512):"memory");}
    asm volatile("s_waitcnt lgkmcnt(0)":::"memory");SBAR();
    #define PK(k) (bf16x8){lo[k][0],lo[k][1],lo[k][2],lo[k][3],hi[k][0],hi[k][1],hi[k][2],hi[k][3]}
    o[d0]=__builtin_amdgcn_mfma_f32_32x32x16_bf16(pa0,PK(0),o[d0],0,0,0);
    o[d0]=__builtin_amdgcn_mfma_f32_32x32x16_bf16(pa1,PK(1),o[d0],0,0,0);
    o[d0]=__builtin_amdgcn_mfma_f32_32x32x16_bf16(pa2,PK(2),o[d0],0,0,0);
    o[d0]=__builtin_amdgcn_mfma_f32_32x32x16_bf16(pa3,PK(3),o[d0],0,0,0);
    #undef PK
  }
}

#ifndef ATTN_STORE16
#define ATTN_STORE16(p,v) (*(u32x4*)(p)=(v))
#endif
template<int THRL> __device__ __forceinline__ void attn_unit(int b,int hc,int qb,const bf16*Q,const bf16*__restrict__ K,const bf16*__restrict__ V,bf16*O,char*shm,int tid_in){
  int tid_=tid_in; asm volatile("":"+v"(tid_)); const int tid=tid_,lane=tid&63,r32=lane&31,hi=lane>>5; const int wid=__builtin_amdgcn_readfirstlane(tid>>6);
  const long rowbase=(long)b*SEQ, kvbase=(long)b*KVSEQ; const int q0=qb*QB;
  const bf16*Qw=Q+(rowbase+q0+wid*QBLK)*DM+hc*D;
  const bf16*Kh=K+kvbase*DM+hc*D,*Vh=V+kvbase*DM+(hc>>1)*128;
  const unsigned lds0=(unsigned)(uintptr_t)shm;
  typedef __attribute__((address_space(3))) float lds_f32; typedef __attribute__((address_space(3))) unsigned short lds_u16; typedef __attribute__((address_space(3))) char lds_char;
  lds_f32*wsf=(lds_f32*)((lds_char*)shm+LDS_WS)+wid*64;
  const bf16*ksb=Kh+wid*8; const unsigned kvo=(unsigned)lane*(DM*2);
  const bf16*vsb=Vh+(long)(16*(wid&3))*DM+(wid>>2)*32; const unsigned vvo=(unsigned)((lane>>2)*DM+(lane&3)*8)*2u;
  const unsigned kdst=lds0+LDS_K+wid*1024, vdst=lds0+LDS_V+wid*1024, vdst2=lds0+LDS_V2+wid*1024;
  #define DMA_K(t,slot) glds16s(ksb+(long)(t)*KVBLK*DM,kvo,(unsigned)__builtin_amdgcn_readfirstlane(kdst+(slot)))
  #define DMA_V(t,slot) do{ glds16s(vsb+(long)(t)*KVBLK*DM,vvo,(unsigned)__builtin_amdgcn_readfirstlane(vdst+(slot))); glds16s(vsb+(long)(t)*KVBLK*DM+64,vvo,(unsigned)__builtin_amdgcn_readfirstlane(vdst2+(slot))); }while(0)
  const int vb0=(int)(lds0+LDS_V)+((lane>>4)&1)*32+(lane&3)*8+(4*hi+((lane&15)>>2))*64;
  bf16x8 kf[8];
  const lds_cptr shm3=(lds_cptr)shm; const lds_cptr kp0=shm3+LDS_K+hi*1024+r32*16; const lds_cptr vp0=shm3+LDS_V+((lane>>4)&1)*32+(lane&3)*8+(4*hi+((lane&15)>>2))*64;
  const int NT=(q0+QB)/KVBLK+2;
  DMA_K(0,0);DMA_V(0,0);DMA_K(1,SLOTB);
  bf16x8 qr[4];
  #pragma unroll
  for(int d0=0;d0<4;++d0)qr[d0]=*reinterpret_cast<const bf16x8*>(&Qw[(long)r32*DM+d0*16+hi*8]);
  float mhat=0.f,l_reg=0.f;f32x16 o[4];o[0]=f32x16{};o[1]=f32x16{};o[2]=f32x16{};o[3]=f32x16{};f32x16 negm=f32x16{};asm volatile("":"+v"(negm));
  const int qrel=wid*QBLK+r32;
  #define CMASK(P0,P1,t) do{int jb_=(t)-(NT-4); if(jb_>=0)cmask(P0,P1,jb_,qrel,hi);}while(0)
  bool resc=false;
  #define START(P0,P1) do{ const float rm=rowmax(P0,P1); resc=false; \
    { const float dl=rm; mhat=fadd_s(mhat,dl); \
      _Pragma("unroll") for(int r=0;r<16;++r){P0[r]=fsub_s(P0[r],dl);P1[r]=fsub_s(P1[r],dl);} \
      _Pragma("unroll") for(int r=0;r<16;++r)negm[r]=-mhat; asm volatile("":"+v"(negm)); } \
    _Pragma("unroll") for(int r=0;r<16;++r)P0[r]=__builtin_amdgcn_exp2f(P0[r]); }while(0)
  #define RESC() do{ if(resc){ asm volatile("s_waitcnt lgkmcnt(0)":::"memory"); \
      _Pragma("unroll") for(int d_=0;d_<4;++d_) _Pragma("unroll") for(int r=0;r<16;++r)o[d_][r]*=wsf[crow(r,hi)]; } }while(0)
  f32x16 pA0,pA1,pB0,pB1;
  int sl_prev=0,sl_cur=0,sl_next=SLOTB;
  #define ROT() do{sl_prev=sl_cur;sl_cur=sl_next;sl_next=(sl_next==(NSLOT-1)*SLOTB)?0:sl_next+SLOTB;}while(0)
  DMA_K(2,2*SLOTB);
  WAIT_BAR(4);
  { f32x16 cm0,cm1; _Pragma("unroll") for(int r=0;r<16;++r){cm0[r]=-INFINITY;cm1[r]=(r<8)?-INFINITY:0.f;} asm volatile("":"+v"(cm0),"+v"(cm1));
    qkt(pA0,pA1,shm3+LDS_K,qr,cm0,cm1,r32,hi); }
  asm volatile("s_nop 15\n\ts_nop 7":"+v"(pA0),"+v"(pA1));CMASK(pA0,pA1,0);
  START(pA0,pA1);
  _Pragma("unroll") for(int r=0;r<16;++r)pA1[r]=__builtin_amdgcn_exp2f(pA1[r]);
  _Pragma("unroll") for(int r=0;r<16;++r)negm[r]=-INFINITY; asm volatile("":"+v"(negm));
  WAIT_BAR(0);
  DMA_K(3,0);DMA_V(1,SLOTB);
  ROT();
  kload8(kf,kp0+sl_cur);
  WAIT_BAR(3);
  s16x4 vlo[8],vhi[8],wlo[8],whi[8]; u32x4 pw0,pw1,pw2,pw3;
  #define PKW(P,B) cvtpk_s(P[B],P[B+1])
  #define PAF(k) __builtin_bit_cast(bf16x8,pw##k)
  #define VFR(i) (bf16x8){vlo[i][0],vlo[i][1],vlo[i][2],vlo[i][3],vhi[i][0],vhi[i][1],vhi[i][2],vhi[i][3]}
  #define WFR(i) (bf16x8){wlo[i][0],wlo[i][1],wlo[i][2],wlo[i][3],whi[i][0],whi[i][1],whi[i][2],whi[i][3]}
  #define PIN(x) asm volatile("":"+v"(x))
  #define MX3(a,b,c) __builtin_fmaxf(__builtin_fmaxf((a),(b)),(c))
  #define GAPA(MF,A0,A1,A2,A3,W0,W1,PW) do{ MF; sacc+=A0; sacc+=A1; sacc+=A2; sacc+=A3; PIN(sacc); W0; W1; PIN(PW); SBAR(); }while(0)
  #define EX(v) __builtin_amdgcn_exp2f(v)
  #define GAPB(MF,X,B) do{ MF; X[B]=EX(X[B]); X[B+1]=EX(X[B+1]); PIN(X); SBAR(); }while(0)
  #define VRD(i) do{ vlo[i]=vtr(vp_+(((i)>>2)*4096+((i)&3)*1024)); vhi[i]=vtr(vp_+(((i)>>2)*4096+((i)&3)*1024+512)); }while(0)
  #define WRD(i) do{ wlo[i]=vtr(vp_+((LDS_V2-LDS_V)+((i)>>2)*4096+((i)&3)*1024)); whi[i]=vtr(vp_+((LDS_V2-LDS_V)+((i)>>2)*4096+((i)&3)*1024+512)); SBAR(); }while(0)
  #define KRD(G,j) do{ if(G){ kload2(kf,kp0+sl_next,j); SBAR(); } }while(0)
  #define STEP(C0,C1,P0,P1,t,GK,GV,GL) do{ SBAR(); \
    const lds_cptr vp_=vp0+sl_prev; \
    float sacc=(P0[0]+P0[1]); \
    GAPA(C0=__builtin_amdgcn_mfma_f32_32x32x16_bf16(kf[0],qr[0],negm,0,0,0), P0[2],P0[3],P0[4],P0[5],     pw0[0]=PKW(P0,0), pw0[1]=PKW(P0,2), pw0); \
    GAPA(C1=__builtin_amdgcn_mfma_f32_32x32x16_bf16(kf[1],qr[0],negm,0,0,0), P0[6],P0[7],P0[8],P0[9],     pw0[2]=PKW(P0,4), pw0[3]=PKW(P0,6), pw0); \
    GAPA(C0=__builtin_amdgcn_mfma_f32_32x32x16_bf16(kf[2],qr[1],C0,0,0,0),   P0[10],P0[11],P0[12],P0[13], pw1[0]=PKW(P0,8), pw1[1]=PKW(P0,10), pw1); \
    GAPA(C1=__builtin_amdgcn_mfma_f32_32x32x16_bf16(kf[3],qr[1],C1,0,0,0),   P0[14],P0[15],P1[0],P1[1],   pw1[2]=PKW(P0,12),pw1[3]=PKW(P0,14), pw1); \
    GAPA(C0=__builtin_amdgcn_mfma_f32_32x32x16_bf16(kf[4],qr[2],C0,0,0,0),   P1[2],P1[3],P1[4],P1[5],     pw2[0]=PKW(P1,0), pw2[1]=PKW(P1,2), pw2); \
    GAPA(C1=__builtin_amdgcn_mfma_f32_32x32x16_bf16(kf[5],qr[2],C1,0,0,0),   P1[6],P1[7],P1[8],P1[9],     pw2[2]=PKW(P1,4), pw2[3]=PKW(P1,6), pw2); \
    GAPA(C0=__builtin_amdgcn_mfma_f32_32x32x16_bf16(kf[6],qr[3],C0,0,0,0),   P1[10],P1[11],P1[12],P1[13], pw3[0]=PKW(P1,8), pw3[1]=PKW(P1,10), pw3); \
    GAPA(C1=__builtin_amdgcn_mfma_f32_32x32x16_bf16(kf[7],qr[3],C1,0,0,0),   P1[14],P1[15],0.f,0.f,       pw3[2]=PKW(P1,12),pw3[3]=PKW(P1,14), pw3); \
    l_reg+=sacc; \
    VRD(0);VRD(4);VRD(1);VRD(5);VRD(2);VRD(6);VRD(3);VRD(7); SBAR();     \
    if(GK){DMA_K((t)+3,sl_cur);} if(GV){DMA_V((t)+1,sl_next);} \
    CMASK(C0,C1,t); \
    { float a=MX3(C0[0],C0[1],C1[0]),b=MX3(C0[2],C0[3],C1[1]); a=MX3(a,C1[2],C1[3]); \
      _Pragma("unroll") for(int r=4;r<16;r+=4){a=MX3(a,C0[r],C0[r+1]);b=MX3(b,C0[r+2],C0[r+3]);a=MX3(a,C1[r],C1[r+1]);b=MX3(b,C1[r+2],C1[r+3]);} \
      float rm=__builtin_fmaxf(a,b); { auto rr=__builtin_amdgcn_permlane32_swap(__float_as_uint(rm),__float_as_uint(rm),false,false); rm=__builtin_fmaxf(__uint_as_float(rr[0]),__uint_as_float(rr[1])); } \
      resc=false; \
      if(__builtin_expect(__any(rm>(float)THRL),0)){ const float dl=__builtin_fmaxf(rm,0.f); mhat+=dl; \
        _Pragma("unroll") for(int r=0;r<16;++r){C0[r]-=dl;C1[r]-=dl;} \
        _Pragma("unroll") for(int r=0;r<16;++r)negm[r]=-mhat; asm volatile("":"+v"(negm)); \
        const float f=__builtin_amdgcn_exp2f(-dl); l_reg*=f; if(hi==0)wsf[r32]=f; resc=true; } } \
    SBAR(); \
    GAPB(o[0]=__builtin_amdgcn_mfma_f32_32x32x16_bf16(PAF(0),VFR(0),o[0],0,0,0), C0,0);  WRD(0); \
    GAPB(o[1]=__builtin_amdgcn_mfma_f32_32x32x16_bf16(PAF(0),VFR(4),o[1],0,0,0), C0,2);  WRD(4); \
    KRD(GL,0); GAPB(o[0]=__builtin_amdgcn_mfma_f32_32x32x16_bf16(PAF(1),VFR(1),o[0],0,0,0), C0,4);  WRD(1); \
    KRD(GL,1); GAPB(o[1]=__builtin_amdgcn_mfma_f32_32x32x16_bf16(PAF(1),VFR(5),o[1],0,0,0), C0,6);  WRD(5); \
    KRD(GL,2); GAPB(o[0]=__builtin_amdgcn_mfma_f32_32x32x16_bf16(PAF(2),VFR(2),o[0],0,0,0), C0,8);  WRD(2); \
    KRD(GL,3); GAPB(o[1]=__builtin_amdgcn_mfma_f32_32x32x16_bf16(PAF(2),VFR(6),o[1],0,0,0), C0,10); WRD(6); \
    GAPB(o[0]=__builtin_amdgcn_mfma_f32_32x32x16_bf16(PAF(3),VFR(3),o[0],0,0,0), C0,12); WRD(3); \
    GAPB(o[1]=__builtin_amdgcn_mfma_f32_32x32x16_bf16(PAF(3),VFR(7),o[1],0,0,0), C0,14); WRD(7); \
    GAPB(o[2]=__builtin_amdgcn_mfma_f32_32x32x16_bf16(PAF(0),WFR(0),o[2],0,0,0), C1,0); \
    GAPB(o[3]=__builtin_amdgcn_mfma_f32_32x32x16_bf16(PAF(0),WFR(4),o[3],0,0,0), C1,2); \
    GAPB(o[2]=__builtin_amdgcn_mfma_f32_32x32x16_bf16(PAF(1),WFR(1),o[2],0,0,0), C1,4); \
    GAPB(o[3]=__builtin_amdgcn_mfma_f32_32x32x16_bf16(PAF(1),WFR(5),o[3],0,0,0), C1,6); \
    GAPB(o[2]=__builtin_amdgcn_mfma_f32_32x32x16_bf16(PAF(2),WFR(2),o[2],0,0,0), C1,8); \
    GAPB(o[3]=__builtin_amdgcn_mfma_f32_32x32x16_bf16(PAF(2),WFR(6),o[3],0,0,0), C1,10); \
    GAPB(o[2]=__builtin_amdgcn_mfma_f32_32x32x16_bf16(PAF(3),WFR(3),o[2],0,0,0), C1,12); \
    GAPB(o[3]=__builtin_amdgcn_mfma_f32_32x32x16_bf16(PAF(3),WFR(7),o[3],0,0,0), C1,14); \
    }while(0)
  int t=1;
  #define FIX1(tt) do{ if((tt)==1){ _Pragma("unroll") for(int r=0;r<16;++r)negm[r]=-mhat; asm volatile("":"+v"(negm)); } }while(0)
  #undef CMASK
  #define CMASK(P0,P1,t) do{}while(0)
  for(;t+5<NT;t+=2){
    STEP(pB0,pB1,pA0,pA1,t,true,true,true);     WAIT_BAR(3); RESC(); ROT(); FIX1(t);
    STEP(pA0,pA1,pB0,pB1,t+1,true,true,true);   WAIT_BAR(3); RESC(); ROT();
  }
  #undef CMASK
  #define CMASK(P0,P1,t) do{int jb_=(t)-(NT-4); if(jb_>=0)cmask(P0,P1,jb_,qrel,hi);}while(0)
  #define ENDW(tt) do{ if((tt)+3<NT){WAIT_BAR(3);} else if((tt)+2<NT){WAIT_BAR(2);} else {WAIT_BAR(0);} }while(0)
  for(;t+1<NT;t+=2){
    STEP(pB0,pB1,pA0,pA1,t,(t+3<NT),(t+1<NT),(t+1<NT));       ENDW(t);   RESC(); ROT(); FIX1(t);
    STEP(pA0,pA1,pB0,pB1,t+1,(t+4<NT),(t+2<NT),(t+2<NT));     ENDW(t+1); RESC(); ROT();
  }
  STEP(pB0,pB1,pA0,pA1,NT-1,false,false,false); RESC();
  { float sacc=pB0[0]+pB0[1]; _Pragma("unroll") for(int r=2;r<16;++r)sacc+=pB0[r]; _Pragma("unroll") for(int r=0;r<16;++r)sacc+=pB1[r]; l_reg+=sacc;
    pw0=(u32x4){PKW(pB0,0),PKW(pB0,2),PKW(pB0,4),PKW(pB0,6)};pw1=(u32x4){PKW(pB0,8),PKW(pB0,10),PKW(pB0,12),PKW(pB0,14)};pw2=(u32x4){PKW(pB1,0),PKW(pB1,2),PKW(pB1,4),PKW(pB1,6)};pw3=(u32x4){PKW(pB1,8),PKW(pB1,10),PKW(pB1,12),PKW(pB1,14)};
    SBAR(); pv(o,vb0+sl_cur,PAF(0),PAF(1),PAF(2),PAF(3)); pv(o+2,vb0+(LDS_V2-LDS_V)+sl_cur,PAF(0),PAF(1),PAF(2),PAF(3)); }
  #undef PKW
  #undef PAF
  #undef VFR
  #undef WFR
  #undef WRD
  #undef PIN
  #undef MX3
  #undef GAPA
  #undef GAPB
  #undef EX
  #undef VRD
  #undef KRD
  #undef STEP
  #undef ENDW
  {auto rr=__builtin_amdgcn_permlane32_swap(__float_as_uint(l_reg),__float_as_uint(l_reg),false,false);l_reg=__uint_as_float(rr[0])+__uint_as_float(rr[1]);}
  if(hi==0)wsf[32+r32]=l_reg;asm volatile("s_waitcnt lgkmcnt(0)":::"memory");
  float rli[16];
  #pragma unroll
  for(int r=0;r<16;++r)rli[r]=__builtin_amdgcn_rcpf(wsf[32+crow(r,hi)]);
  bf16*Ow=O+(rowbase+q0+wid*QBLK)*DMO+hc*128;
  { lds_u16*stg=(lds_u16*)((lds_char*)shm+LDS_OST)+wid*2048;
    #pragma unroll
    for(int half=0;half<2;++half){
      #pragma unroll
      for(int r=0;r<16;++r){const int orow=crow(r,hi);
        #pragma unroll
        for(int d0=0;d0<2;++d0)stg[orow*64+d0*32+r32]=(unsigned short)(cvtpk_s(o[2*half+d0][r]*rli[r],0.f)&0xffffu);}
      asm volatile("s_waitcnt lgkmcnt(0)":::"memory");
      #pragma unroll
      for(int i=0;i<4;++i){const int row=i*8+(lane>>3),ch=lane&7; const u32x4 v=*(const __attribute__((address_space(3))) u32x4*)(stg+row*64+ch*8); ATTN_STORE16(Ow+(long)row*DMO+half*64+ch*8,v);}
      asm volatile("s_waitcnt lgkmcnt(0)":::"memory"); } }
  asm volatile("s_waitcnt lgkmcnt(0)\n\ts_barrier":::"memory");
  #undef DMA_K
  #undef DMA_V
  #undef CMASK
  #undef START
  #undef RESC
  #undef ROT
}
constexpr int ATTN_LDS_BYTES=LDS_BYTES;
struct AttnTensors { const bf16* Q; const bf16* K; const bf16* V; bf16* O; };
struct AttnUnit { int bh; int qb; };
struct StaticOrder {
  int vcu;
  __device__ __forceinline__ explicit StaticOrder(int grid,int block):vcu((block%8)*(grid/8)+block/8){}
  __device__ __forceinline__ bool next(int i,AttnUnit&u)const{ if(i>=4||vcu>=256)return false; const int s=vcu&3; u.bh=vcu>>2; u.qb=(i==0)?s:(i==1)?7-s:(i==2)?8+s:15-s; return true; }
  __device__ __forceinline__ void a_ready(const AttnUnit&)const{}
  __device__ __forceinline__ void done(const AttnUnit&)const{}
};
struct QueueOrder {
  unsigned* ctr; __attribute__((address_space(3))) unsigned* slot; int x; int tid0;
  __device__ __forceinline__ bool next(int,AttnUnit&u)const{
    if(tid0==0){ const unsigned e=__hip_atomic_fetch_add(ctr,1u,__ATOMIC_RELAXED,__HIP_MEMORY_SCOPE_AGENT); *slot=e; }
    asm volatile("s_waitcnt vmcnt(0) lgkmcnt(0)\n\ts_barrier":::"memory");
    const unsigned e=*slot;
    asm volatile("s_waitcnt lgkmcnt(0)\n\ts_barrier":::"memory");
    if(e>=64u)return false; u.bh=(int)(e&3u)*8+x; u.qb=15-(int)(e>>2); return true; }
  __device__ __forceinline__ void a_ready(const AttnUnit&)const{}
  __device__ __forceinline__ void done(const AttnUnit&)const{}
};
template<class Sched,int THRL=8> __device__ __forceinline__ void attn_phase(char*lds,const AttnTensors&T,const Sched&S,int tid_in){
  AttnUnit u;
  for(int i=0;S.next(i,u);++i){ S.a_ready(u); attn_unit<THRL>(u.bh/NHEAD,u.bh%NHEAD,u.qb,T.Q,T.K,T.V,T.O,lds,tid_in); S.done(u); }
}
#undef SBAR
#undef WAIT_BAR
}
#define GAS __attribute__((address_space(1)))
#define LAS __attribute__((address_space(3)))
typedef unsigned short bf16;
typedef unsigned v4u __attribute__((ext_vector_type(4)));
typedef float f32x4 __attribute__((ext_vector_type(4)));
typedef short bf16x8 __attribute__((ext_vector_type(8)));
typedef GAS unsigned gu32;
typedef GAS unsigned long long gu64;
#define RLX_AGENT __ATOMIC_RELAXED, __HIP_MEMORY_SCOPE_AGENT
#define LDS_WAIT() asm volatile("s_waitcnt lgkmcnt(0)" ::: "memory")
#define VM_WAIT() asm volatile("s_waitcnt vmcnt(0)" ::: "memory")
__device__ __forceinline__ unsigned long long rt() { return __builtin_amdgcn_s_memrealtime(); }
__device__ __forceinline__ unsigned f2bf(float f) { unsigned u = __builtin_bit_cast(unsigned, f); return (u + 0x7fffu + ((u >> 16) & 1u)) >> 16; }
__device__ __forceinline__ unsigned pk2(float lo, float hi) { return f2bf(lo) | (f2bf(hi) << 16); }

#define XB_TMO      128
#define XB_XCNT(j)  (256  + 64 * (j))
#define XB_XSUB(j)  (1280 + 64 * (j))
#define XB_XGEN(j)  (2304 + 64 * (j))
#define XB_TOP      3328
#define XB_TOPGEN   3392
#define XCD_BAR_WORDS 3456
#define XB_SPIN_CAP (1u << 18)

__device__ __forceinline__ unsigned xb_ld(unsigned* p)              { return __hip_atomic_load(p, __ATOMIC_RELAXED, __HIP_MEMORY_SCOPE_AGENT); }
__device__ __forceinline__ unsigned xb_add(unsigned* p, unsigned v) { return __hip_atomic_fetch_add(p, v, __ATOMIC_RELAXED, __HIP_MEMORY_SCOPE_AGENT); }
__device__ __forceinline__ unsigned xb_xcc_id() { return (unsigned)__builtin_amdgcn_s_getreg((3 << 11) | 20) & 0xFu; }
#define XB_SPIN(cond, bar) do { unsigned _sp = 0; while (cond) { __builtin_amdgcn_s_sleep(1); \
    if ((++_sp & 255u) == 0u) { if (xb_ld(&(bar)[XB_TMO])) break; if (_sp > XB_SPIN_CAP) { atomicAdd(&(bar)[XB_TMO], 1u); break; } } } } while (0)

struct XcdBarrier {
    unsigned* bar; unsigned x; int wv;
    volatile LAS unsigned* st;
};

__device__ __forceinline__ XcdBarrier xcd_barrier_post(unsigned* bar, volatile LAS unsigned* st) {
    XcdBarrier b; b.bar = bar; b.x = xb_xcc_id(); b.st = st;
    if (threadIdx.x == 0) (void)xb_add(&bar[XB_XCNT(b.x)], 1u);
    return b;
}
__device__ __forceinline__ void xcd_barrier_complete(unsigned* bar, unsigned x, unsigned& nloc, unsigned& nx) {
    const unsigned G = gridDim.x * gridDim.y * gridDim.z;
    unsigned sum, cnt, mine, sp = 0u;
    for (;;) {
        sum = 0u; cnt = 0u; mine = 0u;
#pragma unroll
        for (unsigned j = 0; j < 16; ++j) { const unsigned c = xb_ld(&bar[XB_XCNT(j)]); sum += c; cnt += (c > 0u) ? 1u : 0u; mine = (j == x) ? c : mine; }
        if (sum == G) break;
        __builtin_amdgcn_s_sleep(1);
        if ((++sp & 255u) == 0u) { if (xb_ld(&bar[XB_TMO])) break; if (sp > XB_SPIN_CAP) { atomicAdd(&bar[XB_TMO], 1u); break; } }
    }
    nloc = mine > 0u ? mine : 1u; nx = cnt > 0u ? cnt : 1u;
}

__device__ __forceinline__ void xcd_barrier(const XcdBarrier& b) {
    asm volatile("s_waitcnt vmcnt(0)" ::: "memory");
    __syncthreads();
    unsigned ln_; asm volatile("v_mbcnt_lo_u32_b32 %0, -1, 0\n\tv_mbcnt_hi_u32_b32 %0, -1, %0" : "=v"(ln_));
    if (b.wv == 0 && ln_ == 0u) {
        unsigned* bar = b.bar;
        __builtin_amdgcn_s_waitcnt(0);
        unsigned nloc = b.st[0], nx = b.st[1];
        if (nloc == 0u) { xcd_barrier_complete(bar, b.x, nloc, nx); b.st[0] = nloc; b.st[1] = nx; }
        const unsigned old = xb_add(&bar[XB_XSUB(b.x)], 1u);
        const unsigned gen = old / nloc;
        if (old + 1u == (gen + 1u) * nloc) {
            __builtin_amdgcn_fence(__ATOMIC_RELEASE, "agent");
            asm volatile("s_waitcnt vmcnt(0)" ::: "memory");
            const unsigned og = xb_add(&bar[XB_TOP], 1u);
            const unsigned tg = og / nx;
            if (og + 1u == (tg + 1u) * nx) xb_add(&bar[XB_TOPGEN], 1u);
            else XB_SPIN(xb_ld(&bar[XB_TOPGEN]) == tg, bar);
            __builtin_amdgcn_fence(__ATOMIC_ACQUIRE, "agent");
            xb_add(&bar[XB_XGEN(b.x)], 1u);
            asm volatile("s_waitcnt vmcnt(0)" ::: "memory");
        } else {
            XB_SPIN(xb_ld(&bar[XB_XGEN(b.x)]) == gen, bar);
            __builtin_amdgcn_fence(__ATOMIC_ACQUIRE, "agent");
            asm volatile("s_waitcnt vmcnt(0)" ::: "memory");
        }
    }
    __syncthreads();
}

constexpr int NWAVES = 8;
constexpr int DM = 1024, NB = 4, SEQ = 4096, NMETA = 16, DEPTH = 4;
constexpr int NREAL = NB * SEQ;
constexpr int NTOK = NREAL + NMETA;
constexpr int MPAD = 16640;
constexpr int INC = 3200, INP = 3328;
constexpr int RCOLS = 896, QOFF = 896, KOFF = 896 + 512, VOFF = 896 + 1024, COFF = 2432;
constexpr int FF = 2816, FF2 = 5632, NE = 8;
constexpr int KVROWS = 128 + SEQ;
constexpr int MOEP = 35072;
constexpr float C2Q = 0.125f * 1.4426950408889634f;

constexpr size_t MiB = 1u << 20;
constexpr size_t WS_CTL = 0, CTL_ZERO_BYTES = 1 * MiB;
constexpr size_t WS_COS = 1 * MiB, WS_SIN = 1 * MiB + 192 * 1024;
constexpr size_t WS_RSTD = 1 * MiB + 512 * 1024;
constexpr size_t WS_RSROW = 1 * MiB + 768 * 1024;
constexpr size_t WS_TOKE = 2 * MiB, WS_TOKS = 2 * MiB + 256 * 1024, WS_TOKG = 2 * MiB + 512 * 1024;
constexpr size_t WS_WIN = 4 * MiB;
constexpr size_t WS_WOUT = 30 * MiB;
constexpr size_t WS_WGU = 38 * MiB;
constexpr size_t WS_WD = 60 * MiB;
constexpr size_t WS_MWGU = 72 * MiB;
constexpr size_t WS_MWD = 160 * MiB;
constexpr size_t WS_H = 204 * MiB;
constexpr size_t WS_HB = 269 * MiB;
constexpr size_t WS_PH = 302 * MiB;
constexpr size_t WS_PROJ = WS_PH;
constexpr size_t WS_QN = 408 * MiB;
constexpr size_t WS_KP = 425 * MiB;
constexpr size_t WS_VP = 442 * MiB;
constexpr size_t WS_OC = 459 * MiB;
constexpr size_t WS_OMIX = 492 * MiB;
constexpr size_t WS_SC = 525 * MiB, SC_STRIDE = 17 * MiB;
constexpr size_t WS_MIX_END = WS_SC + 9 * SC_STRIDE;
constexpr size_t WS_G = WS_PH;
constexpr size_t WS_AROWS = 491 * MiB;
constexpr size_t WS_YM = 560 * MiB;
constexpr size_t WS_LORA = 680 * MiB;
constexpr size_t WS_END = 714 * MiB;
static_assert(WS_PROJ + (size_t)MPAD * INP * 2 <= WS_QN && WS_G + (size_t)MOEP * FF * 2 <= WS_AROWS && WS_AROWS + (size_t)MOEP * 1024 * 2 <= WS_YM && WS_YM + (size_t)MOEP * 1024 * 2 <= WS_END, "ws map");
static_assert((size_t)8 * FF2 * DM <= 44 * MiB && 44 * MiB + (size_t)4112 * 11008 + 1024 <= 88 * MiB && (size_t)4112 * 8192 <= (size_t)MPAD * 2048, "chunk buffers");
static_assert(WS_H + (size_t)MPAD * 1024 * 4 <= WS_HB && WS_HB + (size_t)MPAD * 1024 * 2 <= WS_PH && WS_MIX_END <= WS_END, "ws map 2");
static_assert((size_t)NTOK * 256 * 4 <= SC_STRIDE && WS_OC + (size_t)NTOK * 2048 <= WS_OMIX && WS_OMIX + (size_t)MPAD * 2048 <= WS_SC, "ws map 3");
constexpr int CW_MOECNT = 1024;
constexpr int CW_BAR = 4096;
constexpr int CW_ATTQ = 8192;

constexpr int LDS_BYTES = 147456;
constexpr int MISC_OFF = LDS_BYTES - 128;

struct Args { const float* in[32]; float* out; unsigned char* ws; int ph_lo, ph_hi; };

__device__ __forceinline__ v4u zero_v4u() { unsigned z; asm volatile("v_mov_b32 %0, 0" : "=v"(z)); return (v4u){z, z, z, z}; }
__device__ __forceinline__ unsigned pk4_fp8(float a, float b, float c, float d) {
    a = __builtin_amdgcn_fmed3f(a, -448.f, 448.f); b = __builtin_amdgcn_fmed3f(b, -448.f, 448.f); c = __builtin_amdgcn_fmed3f(c, -448.f, 448.f); d = __builtin_amdgcn_fmed3f(d, -448.f, 448.f);
    unsigned p = (unsigned)__builtin_amdgcn_cvt_pk_fp8_f32(a, b, 0, false); return (unsigned)__builtin_amdgcn_cvt_pk_fp8_f32(c, d, (int)p, true); }
#ifndef INP8_MASK
#define INP8_MASK 0xC
#endif
constexpr int INP8 = INP8_MASK;
constexpr float W8_SCALE = 64.f, A8_SCALE = 16.f, G8_SCALE = 4.f, H8_SCALE = 4.f;
__device__ __forceinline__ float bf2f(unsigned short b) { return __uint_as_float(((unsigned)b) << 16); }
#define DPP_F(x, ctrl) __int_as_float(__builtin_amdgcn_update_dpp(0, __float_as_int(x), ctrl, 0xF, 0xF, true))
__device__ __forceinline__ float lane_xor1(float v) { return DPP_F(v, 0xB1); }
__device__ __forceinline__ float sum8(float v) { v += DPP_F(v, 0xB1); v += DPP_F(v, 0x4E); v += DPP_F(v, 0x141); return v; }
__device__ __forceinline__ float sum16(float v) { v = sum8(v); v += DPP_F(v, 0x140); return v; }
__device__ __forceinline__ float wave_sum_dpp(float p) {
    p = sum16(p);
    asm volatile("s_nop 1\n\tv_add_f32_dpp %0, %0, %0 row_bcast:15 row_mask:0xa bank_mask:0xf\n\ts_nop 1\n\tv_add_f32_dpp %0, %0, %0 row_bcast:31 row_mask:0xc bank_mask:0xf\n\ts_nop 0" : "+v"(p));
    return __int_as_float(__builtin_amdgcn_readlane(__float_as_int(p), 63));
}
__device__ __forceinline__ float wave_sum(float v) { return wave_sum_dpp(v); }
__device__ __forceinline__ float wave_max(float v) {
    v = fmaxf(v, DPP_F(v, 0xB1)); v = fmaxf(v, DPP_F(v, 0x4E)); v = fmaxf(v, DPP_F(v, 0x141)); v = fmaxf(v, DPP_F(v, 0x140));
    asm volatile("s_nop 1\n\tv_max_f32_dpp %0, %0, %0 row_bcast:15 row_mask:0xa bank_mask:0xf\n\ts_nop 1\n\tv_max_f32_dpp %0, %0, %0 row_bcast:31 row_mask:0xc bank_mask:0xf\n\ts_nop 0" : "+v"(v));
    return __int_as_float(__builtin_amdgcn_readlane(__float_as_int(v), 63));
}
__device__ __forceinline__ float sigmoidf_(float x) { return 1.f / (1.f + __expf(-x)); }
__device__ __forceinline__ int prevrow(int row) { if (row < 0) return -1; if (row >= NREAL) return row == NREAL ? -1 : row - 1; return (row & (SEQ - 1)) == 0 ? NTOK - 1 : row - 1; }

__device__ __forceinline__ void tr_item(const float* W, int K, int N, bf16* WT, int rowmode, const float* gk, LAS float* scr, int item, int lane) {
    const int nblk = N / 32, kb = item / nblk, nb = item % nblk, k0 = 64 * kb, n0 = 32 * nb;
    const float* src = W + (size_t)(k0 + (lane >> 5)) * N + n0 + (lane & 31);
    float v[32];
#pragma unroll
    for (int i = 0; i < 32; ++i) v[i] = src[(size_t)(2 * i) * N];
#pragma unroll
    for (int i = 0; i < 32; ++i) scr[(2 * i + (lane >> 5)) * 33 + (lane & 31)] = v[i];
    LDS_WAIT(); asm volatile("" ::: "memory");
    const int c = lane & 7;
    f32x4 g0 = (f32x4){1.f, 1.f, 1.f, 1.f}, g1 = g0;
    if (gk) { g0 = *(const f32x4*)(gk + k0 + 8 * c); g1 = *(const f32x4*)(gk + k0 + 8 * c + 4); }
#pragma unroll
    for (int j = 0; j < 4; ++j) { const int n = (lane >> 3) + 8 * j; const LAS float* s = scr + (8 * c) * 33 + n;
        v4u o; o.x = pk2(s[0 * 33] * g0.x, s[1 * 33] * g0.y); o.y = pk2(s[2 * 33] * g0.z, s[3 * 33] * g0.w); o.z = pk2(s[4 * 33] * g1.x, s[5 * 33] * g1.y); o.w = pk2(s[6 * 33] * g1.z, s[7 * 33] * g1.w);
        const int nn = n0 + n; const int drow = rowmode == 0 ? nn : ((nn >> 7) * 256 + (nn & 127) + (rowmode == 2 ? 128 : 0));
        *(GAS v4u*)(WT + (size_t)drow * K + k0 + 8 * c) = o; }
    LDS_WAIT(); asm volatile("" ::: "memory");
}

__device__ __forceinline__ void tr_item2(const float* W0, int K0, int N0, bf16* WT0, int rm0, const float* gk0, int item0,
                                         const float* W1, int K1, int N1, bf16* WT1, int rm1, const float* gk1, int item1, LAS float* scr, int lane, bool f8_0 = false, bool f8_1 = false) {
    const int nb0_ = N0 / 32, nb1_ = N1 / 32;
    const int k00 = 64 * (item0 / nb0_), n00 = 32 * (item0 % nb0_), k01 = 64 * (item1 / nb1_), n01 = 32 * (item1 % nb1_);
    const float* s0 = W0 + (size_t)(k00 + (lane >> 5)) * N0 + n00 + (lane & 31); const float* s1 = W1 + (size_t)(k01 + (lane >> 5)) * N1 + n01 + (lane & 31);
    float v0[32], v1[32];
#pragma unroll
    for (int i = 0; i < 32; ++i) { v0[i] = s0[(size_t)(2 * i) * N0]; v1[i] = s1[(size_t)(2 * i) * N1]; }
    LAS float* t0 = scr; LAS float* t1 = scr + 64 * 33;
#pragma unroll
    for (int i = 0; i < 32; ++i) { t0[(2 * i + (lane >> 5)) * 33 + (lane & 31)] = v0[i]; t1[(2 * i + (lane >> 5)) * 33 + (lane & 31)] = v1[i]; }
    LDS_WAIT(); asm volatile("" ::: "memory");
    const int c = lane & 7;
#pragma unroll
    for (int q = 0; q < 2; ++q) { const float* gk = q ? gk1 : gk0; const int k0 = q ? k01 : k00, n0 = q ? n01 : n00, K = q ? K1 : K0, rowmode = q ? rm1 : rm0; bf16* WT = q ? WT1 : WT0; const LAS float* tt = q ? t1 : t0;
        f32x4 g0 = (f32x4){1.f, 1.f, 1.f, 1.f}, g1 = g0;
        if (gk) { g0 = *(const f32x4*)(gk + k0 + 8 * c); g1 = *(const f32x4*)(gk + k0 + 8 * c + 4); }
#pragma unroll
        for (int j = 0; j < 4; ++j) { const int n = (lane >> 3) + 8 * j; const LAS float* s = tt + (8 * c) * 33 + n;
            v4u o; o.x = pk2(s[0 * 33] * g0.x, s[1 * 33] * g0.y); o.y = pk2(s[2 * 33] * g0.z, s[3 * 33] * g0.w); o.z = pk2(s[4 * 33] * g1.x, s[5 * 33] * g1.y); o.w = pk2(s[6 * 33] * g1.z, s[7 * 33] * g1.w);
            const int nn = n0 + n; const int drow = rowmode == 0 ? nn : ((nn >> 7) * 256 + (nn & 127) + (rowmode == 2 ? 128 : 0));
            if (q ? f8_1 : f8_0) { const unsigned lo = pk4_fp8(s[0 * 33] * g0.x * W8_SCALE, s[1 * 33] * g0.y * W8_SCALE, s[2 * 33] * g0.z * W8_SCALE, s[3 * 33] * g0.w * W8_SCALE), hi8 = pk4_fp8(s[4 * 33] * g1.x * W8_SCALE, s[5 * 33] * g1.y * W8_SCALE, s[6 * 33] * g1.z * W8_SCALE, s[7 * 33] * g1.w * W8_SCALE);
                *(GAS unsigned long long*)((GAS unsigned char*)WT + (size_t)drow * K + k0 + 8 * c) = (unsigned long long)lo | ((unsigned long long)hi8 << 32); }
            else *(GAS v4u*)(WT + (size_t)drow * K + k0 + 8 * c) = o; } }
    LDS_WAIT(); asm volatile("" ::: "memory");
}

__device__ __forceinline__ void meta_gemm_res(const bf16* A, int K, const bf16* Bt, float* Hm, LAS unsigned char* lds, int bx, int wave, int lane, int hbmode = 0, bf16* HBm = nullptr, unsigned long long* rsqm = nullptr) {
    if (bx < 32) {
        typedef short bfx8 __attribute__((ext_vector_type(8)));
        const int ct = 2 * bx + (wave >> 2), ksp = wave & 3, n = lane & 15, kq = lane >> 4; const int kc = K >> 2, steps = kc >> 5;
        const bf16* ap = A + (size_t)n * K + ksp * kc + 8 * kq; const bf16* wp = Bt + (size_t)(16 * ct + n) * K + ksp * kc + 8 * kq;
        f32x4 acc = (f32x4){0.f, 0.f, 0.f, 0.f};
#pragma unroll 11
        for (int s = 0; s < steps; ++s) { const v4u a = *(const v4u*)(wp + 32 * s), b = *(const v4u*)(ap + 32 * s);
            acc = __builtin_amdgcn_mfma_f32_16x16x32_bf16(__builtin_bit_cast(bfx8, a), __builtin_bit_cast(bfx8, b), acc, 0, 0, 0); }
        LAS f32x4* red = (LAS f32x4*)lds;
        red[wave * 64 + lane] = acc;
        __syncthreads();
        if (ksp == 0) { const f32x4 s = (red[wave * 64 + lane] + red[(wave + 1) * 64 + lane]) + (red[(wave + 2) * 64 + lane] + red[(wave + 3) * 64 + lane]);
            f32x4* hp = (f32x4*)(Hm + (size_t)n * 1024 + 16 * ct + 4 * kq); const f32x4 hn = *hp + s; *hp = hn;
            if (hbmode) { const int cc = 16 * ct + 4 * kq;
                if (hbmode == 1) *(unsigned long long*)(HBm + (size_t)n * 1024 + cc) = (unsigned long long)pk2(hn.x, hn.y) | ((unsigned long long)pk2(hn.z, hn.w) << 32);
                else *(unsigned*)((unsigned char*)HBm + (size_t)n * 1024 + cc) = pk4_fp8(hn.x * H8_SCALE, hn.y * H8_SCALE, hn.z * H8_SCALE, hn.w * H8_SCALE);
                __hip_atomic_fetch_add(rsqm + n, (unsigned long long)(((hn.x * hn.x + hn.y * hn.y) + (hn.z * hn.z + hn.w * hn.w)) * 16777216.f), RLX_AGENT); } }
        __syncthreads();
    }
}

__device__ __forceinline__ void meta_gemm_res8(const unsigned char* A, int K, const unsigned char* Bt, float* Hm, float sc, LAS unsigned char* lds, int bx, int wave, int lane) {
    if (bx < 32) {
        typedef int v8i_ __attribute__((ext_vector_type(8)));
        const int ct = 2 * bx + (wave >> 2), ksp = wave & 3, n = lane & 15, kq = lane >> 4; const int kc = K >> 2, steps = kc >> 7;
        const int s0 = ksp < 2 ? 6 * ksp : 12 + 5 * (ksp - 2), ns = ksp < 2 ? 6 : 5; (void)kc; (void)steps;
        const unsigned char* ap = A + (size_t)n * K + 32 * kq; const unsigned char* wp = Bt + (size_t)(16 * ct + n) * K + 32 * kq;
        f32x4 acc = (f32x4){0.f, 0.f, 0.f, 0.f};
#pragma unroll 6
        for (int s = s0; s < s0 + ns; ++s) { const v4u a0 = *(const v4u*)(wp + 128 * s), a1 = *(const v4u*)(wp + 128 * s + 16), b0 = *(const v4u*)(ap + 128 * s), b1 = *(const v4u*)(ap + 128 * s + 16);
            const v8i_ aa = (v8i_){(int)a0.x, (int)a0.y, (int)a0.z, (int)a0.w, (int)a1.x, (int)a1.y, (int)a1.z, (int)a1.w}, bb = (v8i_){(int)b0.x, (int)b0.y, (int)b0.z, (int)b0.w, (int)b1.x, (int)b1.y, (int)b1.z, (int)b1.w};
            acc = __builtin_amdgcn_mfma_scale_f32_16x16x128_f8f6f4(aa, bb, acc, 0, 0, 0, 0x7f7f7f7f, 0, 0x7f7f7f7f); }
        LAS f32x4* red = (LAS f32x4*)lds;
        red[wave * 64 + lane] = acc;
        __syncthreads();
        if (ksp == 0) { const f32x4 s = (red[wave * 64 + lane] + red[(wave + 1) * 64 + lane]) + (red[(wave + 2) * 64 + lane] + red[(wave + 3) * 64 + lane]);
            f32x4* hp = (f32x4*)(Hm + (size_t)n * 1024 + 16 * ct + 4 * kq); *hp = *hp + s * sc; }
        __syncthreads();
    }
}

__global__ void __launch_bounds__(NWAVES * 64, 2) hymba_fwd(Args args) {
    extern __shared__ __attribute__((aligned(16))) unsigned char lds_raw[];
    LAS unsigned char* lds = (LAS unsigned char*)lds_raw;
    volatile LAS unsigned* MISC = (volatile LAS unsigned*)(lds + MISC_OFF);
    const int wave = __builtin_amdgcn_readfirstlane((int)threadIdx.x >> 6);
#define PH_TID int tid; asm volatile("v_mbcnt_lo_u32_b32 %0, -1, 0\n\tv_mbcnt_hi_u32_b32 %0, -1, %0" : "=v"(tid)); tid += wave * 64; const int lane = tid & 63; (void)lane; unsigned char* ws = ws0; asm volatile("" : "+s"(ws)); const char* ka = ka0; asm volatile("" : "+s"(ka)); (void)ka
    const int G = gridDim.x, bx = blockIdx.x;
    const int gw = bx * NWAVES + wave, NGW = G * NWAVES;
    unsigned char* const ws0 = args.ws;
    const char* const ka0 = (const char*)__builtin_amdgcn_kernarg_segment_ptr();
    { const int t0_ = (int)threadIdx.x; if (t0_ < 32) ((LAS unsigned*)(lds + MISC_OFF))[t0_] = 0u; }
    __syncthreads();
    const int lo = args.ph_lo, hi = args.ph_hi;
    const bool multi = (hi - lo) > 1;
    XcdBarrier bar; bar.bar = (unsigned*)(ws0 + WS_CTL) + CW_BAR; bar.x = 0; bar.st = nullptr; bar.wv = wave;
    if (multi) { bar = xcd_barrier_post((unsigned*)(ws0 + WS_CTL) + CW_BAR, MISC + 8); bar.wv = wave; }
#ifndef ENMASK
#define ENMASK 0xFFFF
#endif
#define EN(k) (((ENMASK) >> (k)) & 1)
#ifndef REPMASK
#define REPMASK 0
#endif
#define NREP(k) ((((REPMASK) >> (k)) & 1) ? 2 : 1)
#define IN(k) (lo <= (k) && (k) < hi)
#define SEAM(k) do { if (hi > (k) + 1) xcd_barrier(bar); } while (0)

#define Hf ((float*)(ws + WS_H))
#define HB ((bf16*)(ws + WS_HB))
#define RSTD ((float*)(ws + WS_RSTD))
#define PROJ ((bf16*)(ws + WS_PROJ))
#define QN ((bf16*)(ws + WS_QN))
#define KP ((bf16*)(ws + WS_KP))
#define VP ((bf16*)(ws + WS_VP))
#define OC ((bf16*)(ws + WS_OC))
#define OMIX ((bf16*)(ws + WS_OMIX))
#define SP4 ((f32x4*)(ws + WS_SC + 0 * SC_STRIDE))
#define SR ((float*)(ws + WS_SC + 4 * SC_STRIDE))
#define SV ((float*)(ws + WS_SC + 5 * SC_STRIDE))
#define SG ((float*)(ws + WS_SC + 6 * SC_STRIDE))
#define SBON ((float*)(ws + WS_SC + 7 * SC_STRIDE))
#define SY ((float*)(ws + WS_SC + 8 * SC_STRIDE))
#define COS ((float*)(ws + WS_COS))
#define SIN ((float*)(ws + WS_SIN))
#define GB ((bf16*)(ws + WS_G))
#define AROWS ((bf16*)(ws + WS_AROWS))
#define YM ((bf16*)(ws + WS_YM))
#define RSQA ((unsigned long long*)(ws + WS_RSROW))
#define TOKE ((int*)(ws + WS_TOKE))
#define TOKS ((int*)(ws + WS_TOKS))
#define TOKG ((float*)(ws + WS_TOKG))
#define ctl ((gu32*)(ws + WS_CTL))
#define INP(i) (*(const float* const*)(ka + 8 * (i)))
#define LORA_W ((float*)(ws + WS_LORA))
#define LORA_AG ((bf16*)(ws + WS_LORA + 17 * MiB))
#define CH_REC ((unsigned char*)(ws + WS_MWGU + 44 * MiB))
#define CH_RB 11008
#define CH_SPK ((unsigned char*)(ws + WS_HB))
#ifndef SCAN_CHUNKED
#define SCAN_CHUNKED 1
#endif

    for (int rep_ = 0; rep_ < NREP(15); ++rep_) if (EN(15) && IN(0)) { PH_TID;
        LAS float* scr = (LAS float*)(lds + wave * 17408);
        constexpr int I_IN = 16 * 100, I_OUT = 16 * 32, I_GU = 16 * 88, I_DN = 44 * 32;
        constexpr int NITEMS = DEPTH * (I_IN + I_OUT) + 2 * (2 * I_GU + I_DN);
        for (int it0 = 2 * gw; it0 < NITEMS; it0 += 2 * NGW) {
            const float* W_[2]; bf16* D_[2]; int K_[2], N_[2], rm_[2], r_[2]; const float* g_[2]; bool f8_[2] = {false, false};
#pragma unroll
            for (int q = 0; q < 2; ++q) { int r = it0 + q;
                if (r < DEPTH * I_IN) { const int l = r / I_IN; W_[q] = INP(3) + (size_t)l * DM * INC; K_[q] = DM; N_[q] = INC; D_[q] = (bf16*)(ws + WS_WIN) + (size_t)l * INP * DM; rm_[q] = 0; g_[q] = INP(2) + l * DM; r_[q] = r % I_IN; f8_[q] = ((INP8 >> l) & 1) != 0; continue; } r -= DEPTH * I_IN;
                if (r < DEPTH * I_OUT) { const int l = r / I_OUT; W_[q] = INP(23) + (size_t)l * DM * DM; K_[q] = DM; N_[q] = DM; D_[q] = (bf16*)(ws + WS_WOUT) + (size_t)l * DM * DM; rm_[q] = 0; g_[q] = nullptr; r_[q] = r % I_OUT; continue; } r -= DEPTH * I_OUT;
                if (r < 2 * I_GU) { const int j = r / I_GU; W_[q] = INP(25) + (size_t)j * DM * FF; K_[q] = DM; N_[q] = FF; D_[q] = (bf16*)(ws + WS_WGU) + (size_t)j * FF2 * DM; rm_[q] = 1; g_[q] = INP(24) + (2 * j) * DM; r_[q] = r % I_GU; f8_[q] = (j == 1); continue; } r -= 2 * I_GU;
                if (r < 2 * I_GU) { const int j = r / I_GU; W_[q] = INP(26) + (size_t)j * DM * FF; K_[q] = DM; N_[q] = FF; D_[q] = (bf16*)(ws + WS_WGU) + (size_t)j * FF2 * DM; rm_[q] = 2; g_[q] = INP(24) + (2 * j) * DM; r_[q] = r % I_GU; f8_[q] = (j == 1); continue; } r -= 2 * I_GU;
                { const int j = r / I_DN; W_[q] = INP(27) + (size_t)j * FF * DM; K_[q] = FF; N_[q] = DM; D_[q] = (bf16*)(ws + WS_WD) + (size_t)j * DM * FF; rm_[q] = 0; g_[q] = nullptr; r_[q] = r % I_DN; f8_[q] = (j == 1); } }
            tr_item2(W_[0], K_[0], N_[0], D_[0], rm_[0], g_[0], r_[0], W_[1], K_[1], N_[1], D_[1], rm_[1], g_[1], r_[1], scr, lane, f8_[0], f8_[1]);
        }
        const int gt = bx * (NWAVES * 64) + tid, NGT = G * NWAVES * 64;
        for (int i = gt; i < DEPTH * 128 * (DM / 8); i += NGT) { const int l = i / (128 * (DM / 8)), r = i % (128 * (DM / 8));
            if ((INP8 >> l) & 1) { if (r < 128 * (DM / 16)) ((v4u*)((unsigned char*)(ws + WS_WIN) + (size_t)l * INP * DM * 2 + (size_t)INC * DM))[r] = zero_v4u(); }
            else ((v4u*)((bf16*)(ws + WS_WIN) + ((size_t)l * INP + INC) * DM))[r] = zero_v4u(); }
        for (int row = gw; row < MPAD; row += NGW) {
            f32x4 v[4]; float s = 0.f;
#pragma unroll
            for (int j = 0; j < 4; ++j) { const int c4 = lane + 64 * j; v[j] = __builtin_bit_cast(f32x4, zero_v4u());
                if (row < NREAL) v[j] = ((const f32x4*)INP(0))[(size_t)row * (DM / 4) + c4]; else if (row < NTOK) v[j] = ((const f32x4*)INP(1))[(row - NREAL) * (DM / 4) + c4];
                ((f32x4*)Hf)[(size_t)row * (DM / 4) + c4] = v[j]; s += (v[j].x * v[j].x + v[j].y * v[j].y) + (v[j].z * v[j].z + v[j].w * v[j].w); }
            if (row < NTOK) { s = wave_sum(s); const float rstd = 1.f / sqrtf(s * (1.f / DM) + 1e-6f);
                if (INP8 & 1) { const float sn = rstd * A8_SCALE;
#pragma unroll
                    for (int j = 0; j < 4; ++j) ((unsigned*)((unsigned char*)HB + (size_t)row * DM))[lane + 64 * j] = pk4_fp8(v[j].x * sn, v[j].y * sn, v[j].z * sn, v[j].w * sn); }
                else {
#pragma unroll
                    for (int j = 0; j < 4; ++j) ((unsigned long long*)(HB + (size_t)row * DM))[lane + 64 * j] = (unsigned long long)pk2(v[j].x, v[j].y) | ((unsigned long long)pk2(v[j].z, v[j].w) << 32); }
                if (lane == 0) RSTD[row] = rstd; }
        }
        if (INP8 & 1) { for (int i = gt; i < (MPAD - NTOK) * (DM / 16); i += NGT) ((v4u*)((unsigned char*)HB + (size_t)NTOK * DM))[i] = zero_v4u(); }
        else
        for (int i = gt; i < (MPAD - NTOK) * (DM / 8); i += NGT) ((v4u*)(HB + (size_t)NTOK * DM))[i] = zero_v4u();
        for (int i = gt; i < MPAD - NTOK; i += NGT) RSTD[NTOK + i] = 0.f;
        for (int i = gt; i < (SEQ + NMETA) * 8; i += NGT) { const int pos = i >> 3, j = i & 7;
            const float invf = j == 0 ? 1.000000000e+00f : j == 1 ? 1.939227432e-01f : j == 2 ? 3.760603070e-02f : j == 3 ? 7.292664610e-03f : j == 4 ? 1.414213562e-03f : j == 5 ? 2.742481884e-04f : j == 6 ? 5.318296098e-05f : 1.031338616e-05f;
            const float angf = (float)pos * invf; const double a = (double)angf; const double n = __builtin_rint(a * 0.15915494309189535);
            const double rr = (a - n * 6.283185307179586) - n * 2.4492935982947064e-16; const float rev = (float)(rr * 0.15915494309189535);
            COS[i] = __builtin_amdgcn_cosf(rev); SIN[i] = __builtin_amdgcn_sinf(rev); }
        SEAM(0);
    }

#pragma nounroll
    for (int layer = 0; layer < DEPTH; ++layer) {
        const int pb = 1 + 12 * layer; const bool moe = (layer & 1) != 0; const int jj = layer >> 1;
        if (hi <= pb || lo >= pb + 12) continue;
        const float lam_init = 0.8f - 0.6f * __expf(-0.3f * (float)layer);

        for (int rep_ = 0; rep_ < NREP(0); ++rep_) if (EN(0) && IN(pb + 0) && moe) { PH_TID;
            for (int row = gw; row < NTOK; row += NGW) {
                const GAS f32x4* xr = (const GAS f32x4*)(Hf + (size_t)row * DM) + lane; f32x4 v[4]; float s = 0.f;
#pragma unroll
                for (int j = 0; j < 4; ++j) { v[j] = xr[64 * j]; s += (v[j].x * v[j].x + v[j].y * v[j].y) + (v[j].z * v[j].z + v[j].w * v[j].w); }
                s = wave_sum(s); const float rstd = 1.f / sqrtf(s * (1.f / DM) + 1e-6f);
                if ((INP8 >> layer) & 1) { GAS unsigned* o4 = (GAS unsigned*)((GAS unsigned char*)HB + (size_t)row * DM) + lane; const float sn = rstd * A8_SCALE;
#pragma unroll
                    for (int j = 0; j < 4; ++j) o4[64 * j] = pk4_fp8(v[j].x * sn, v[j].y * sn, v[j].z * sn, v[j].w * sn); }
                else { GAS unsigned long long* o8 = (GAS unsigned long long*)(HB + (size_t)row * DM) + lane;
#pragma unroll
                    for (int j = 0; j < 4; ++j) o8[64 * j] = (unsigned long long)pk2(v[j].x, v[j].y) | ((unsigned long long)pk2(v[j].z, v[j].w) << 32); }
                if (lane == 0) RSTD[row] = rstd;
            }
            if ((INP8 >> layer) & 1) { const int gt = bx * (NWAVES * 64) + tid, NGT = G * NWAVES * 64;
                for (int i = gt; i < (MPAD - NTOK) * (DM / 16); i += NGT) ((v4u*)((unsigned char*)HB + (size_t)NTOK * DM))[i] = zero_v4u(); }
            if (moe) {
                LAS float* scr = (LAS float*)(lds + wave * 17408);
                constexpr int I_GU = 16 * 88, I_DN = 44 * 32, PER_E = 2 * I_GU + I_DN;
                const float* gff = INP(24) + layer * DM;
                for (int it0 = 2 * gw; it0 < NE * PER_E; it0 += 2 * NGW) {
                    const float* W_[2]; bf16* D_[2]; int K_[2], N_[2], rm_[2], r_[2]; const float* g_[2];
#pragma unroll
                    for (int q = 0; q < 2; ++q) { const int it = it0 + q; const int e = it / PER_E; int r = it % PER_E; const size_t eo = (size_t)(jj * NE + e) * DM * FF;
                        if (r < I_GU) { W_[q] = INP(29) + eo; K_[q] = DM; N_[q] = FF; D_[q] = (bf16*)(ws + WS_MWGU) + (size_t)e * FF2 * DM / 2; rm_[q] = 1; g_[q] = gff; }
                        else if (r < 2 * I_GU) { r -= I_GU; W_[q] = INP(30) + eo; K_[q] = DM; N_[q] = FF; D_[q] = (bf16*)(ws + WS_MWGU) + (size_t)e * FF2 * DM / 2; rm_[q] = 2; g_[q] = gff; }
                        else { r -= 2 * I_GU; W_[q] = INP(31) + eo; K_[q] = FF; N_[q] = DM; D_[q] = (bf16*)(ws + WS_MWD) + (size_t)e * DM * FF / 2; rm_[q] = 0; g_[q] = nullptr; }
                        r_[q] = r; }
                    tr_item2(W_[0], K_[0], N_[0], D_[0], rm_[0], g_[0], r_[0], W_[1], K_[1], N_[1], D_[1], rm_[1], g_[1], r_[1], scr, lane, true, true);
                }
            }
            SEAM(pb + 0);
        }
        for (int rep_ = 0; rep_ < NREP(1); ++rep_) if (EN(1) && IN(pb + 1)) { PH_TID;
            pg8::StaticOrder S; S.init(MPAD, INP, G, bx);
            if ((INP8 >> layer) & 1) { pg8::Gemm g{HB, (const bf16*)(ws + WS_WIN) + (size_t)layer * INP * DM, MPAD, INP, DM / 2}; pg8::EpiBf16Rs E{PROJ, INP, nullptr, 1.f / (W8_SCALE * A8_SCALE)};
                pg8::gemm_phase<pg8::EpiBf16Rs, pg8::StaticOrder, true, true, true>(lds, g, S, E, tid); }
            else { pg8::Gemm g{HB, (const bf16*)(ws + WS_WIN) + (size_t)layer * INP * DM, MPAD, INP, DM}; pg8::EpiBf16Rs E{PROJ, INP, RSTD, 1.f};
                pg8::gemm_phase<pg8::EpiBf16Rs, pg8::StaticOrder, true, true>(lds, g, S, E, tid); }
            SEAM(pb + 1);
        }
        for (int rep_ = 0; rep_ < NREP(2); ++rep_) if (EN(2) && IN(pb + 2)) { PH_TID;
            const int gt = bx * (NWAVES * 64) + tid, NGT = G * NWAVES * 64;
            if (tid < 65) { const v4u z_ = zero_v4u(); RSQA[bx * 65 + tid] = (unsigned long long)z_.x | ((unsigned long long)z_.y << 32); }
            for (int i = gt; i < NB * 112 * 64; i += NGT) { const int b = i / (112 * 64), r = (i / 64) % 112, c = i % 64; const int row = b * KVROWS + (r < 48 ? r : r + 16);
                ((v4u*)(KP + (size_t)row * 512))[c] = zero_v4u(); ((v4u*)(VP + (size_t)row * 512))[c] = zero_v4u(); }
            const int ngrp = (1025 - bx + 255) / 256, nrows = 16 * ngrp;
#define MP_ROW(idx) (16 * (bx + 256 * ((idx) >> 4)) + ((idx) & 15))
            LAS unsigned char* WT = lds;
            { const int nn = tid & 255, hf = tid >> 8;
              const float* sd = INP(6) + layer * 32 * 256 + (hf * 16) * 256 + nn; const float* sa = INP(8) + layer * 32 * 256 + (hf * 16) * 256 + nn; const float* sg = INP(9) + layer * 64 * 256 + (hf * 32) * 256 + nn;
              v4u wv[2];
#pragma unroll
              for (int i = 0; i < 2; ++i) { wv[i].x = pk2(sd[(8 * i) * 256], sd[(8 * i + 1) * 256]); wv[i].y = pk2(sd[(8 * i + 2) * 256], sd[(8 * i + 3) * 256]); wv[i].z = pk2(sd[(8 * i + 4) * 256], sd[(8 * i + 5) * 256]); wv[i].w = pk2(sd[(8 * i + 6) * 256], sd[(8 * i + 7) * 256]); }
              *(LAS v4u*)(WT + nn * 64 + hf * 32) = wv[0]; *(LAS v4u*)(WT + nn * 64 + hf * 32 + 16) = wv[1];
#pragma unroll
              for (int i = 0; i < 2; ++i) { wv[i].x = pk2(sa[(8 * i) * 256], sa[(8 * i + 1) * 256]); wv[i].y = pk2(sa[(8 * i + 2) * 256], sa[(8 * i + 3) * 256]); wv[i].z = pk2(sa[(8 * i + 4) * 256], sa[(8 * i + 5) * 256]); wv[i].w = pk2(sa[(8 * i + 6) * 256], sa[(8 * i + 7) * 256]); }
              *(LAS v4u*)(WT + 16384 + nn * 64 + hf * 32) = wv[0]; *(LAS v4u*)(WT + 16384 + nn * 64 + hf * 32 + 16) = wv[1];
#pragma unroll
              for (int i = 0; i < 4; ++i) { v4u t; t.x = pk2(sg[(8 * i) * 256], sg[(8 * i + 1) * 256]); t.y = pk2(sg[(8 * i + 2) * 256], sg[(8 * i + 3) * 256]); t.z = pk2(sg[(8 * i + 4) * 256], sg[(8 * i + 5) * 256]); t.w = pk2(sg[(8 * i + 6) * 256], sg[(8 * i + 7) * 256]);
                  *(LAS v4u*)(WT + 32768 + nn * 128 + hf * 64 + 16 * i) = t; } }
            __syncthreads();
            const float* mu = INP(4) + layer * RCOLS; const float* w0 = INP(5) + layer * 256; const float* a0 = INP(7) + layer * 256;
            const float* k_k = INP(10) + layer * 256; const float* k_a = INP(11) + layer * 256; const float* r_k = INP(12) + layer * 256;
            const float* qg = INP(15) + layer * 64; const float* kg = INP(16) + layer * 64; const float* cw = INP(22) + layer * 3 * 256;
            for (int rep3_ = 0; rep3_ < NREP(5); ++rep3_)
            if (wave < ngrp) {
                typedef attn_body::bf16x8 bfx8;
                const int rowbase = 16 * (bx + 256 * wave);
                LAS unsigned char* XT = lds + 65536 + wave * 4096;
                { const float mu0 = mu[768 + 2 * lane], mu1 = mu[768 + 2 * lane + 1]; const int p0 = prevrow(rowbase);
                  unsigned cur = p0 < 0 ? 0u : *(const unsigned*)(PROJ + (size_t)p0 * INP + 768 + 2 * lane); float pl = __uint_as_float(cur << 16), ph = __uint_as_float(cur & 0xffff0000u);
#pragma unroll
                  for (int r = 0; r < 16; ++r) { cur = *(const unsigned*)(PROJ + (size_t)(rowbase + r) * INP + 768 + 2 * lane); const float xl = __uint_as_float(cur << 16), xh = __uint_as_float(cur & 0xffff0000u);
                      float h0 = xl + (pl - xl) * mu0, h1 = xh + (ph - xh) * mu1; pl = xl; ph = xh;
                      if (lane < 16) { h0 = 1.f - 2.f / (1.f + __expf(2.f * h0)); h1 = 1.f - 2.f / (1.f + __expf(2.f * h1)); } else if (lane >= 32) { h0 = sigmoidf_(h0); h1 = sigmoidf_(h1); }
                      *(LAS unsigned*)(XT + r * 256 + 4 * lane) = pk2(h0, h1); } }
                LDS_WAIT();
                const int n = lane & 15, kq = lane >> 4;
                const v4u xd = *(const LAS v4u*)(XT + n * 256 + (8 * kq) * 2), xa = *(const LAS v4u*)(XT + n * 256 + (32 + 8 * kq) * 2);
                const v4u xg0 = *(const LAS v4u*)(XT + n * 256 + (64 + 8 * kq) * 2), xg1 = *(const LAS v4u*)(XT + n * 256 + (96 + 8 * kq) * 2);
                float* lw = LORA_W + (size_t)(rowbase + n) * 256 + 4 * kq; bf16* lag = LORA_AG + (size_t)(rowbase + n) * 512 + 4 * kq;
#pragma unroll 4
                for (int ct = 0; ct < 16; ++ct) {
                    const v4u ad = *(const LAS v4u*)(WT + (16 * ct + n) * 64 + (8 * kq) * 2), aa = *(const LAS v4u*)(WT + 16384 + (16 * ct + n) * 64 + (8 * kq) * 2);
                    const v4u ag0 = *(const LAS v4u*)(WT + 32768 + (16 * ct + n) * 128 + (8 * kq) * 2), ag1 = *(const LAS v4u*)(WT + 32768 + (16 * ct + n) * 128 + (32 + 8 * kq) * 2);
                    f32x4 dd = __builtin_amdgcn_mfma_f32_16x16x32_bf16(__builtin_bit_cast(bfx8, ad), __builtin_bit_cast(bfx8, xd), (f32x4){0.f, 0.f, 0.f, 0.f}, 0, 0, 0);
                    f32x4 da = __builtin_amdgcn_mfma_f32_16x16x32_bf16(__builtin_bit_cast(bfx8, aa), __builtin_bit_cast(bfx8, xa), (f32x4){0.f, 0.f, 0.f, 0.f}, 0, 0, 0);
                    f32x4 dg = __builtin_amdgcn_mfma_f32_16x16x32_bf16(__builtin_bit_cast(bfx8, ag0), __builtin_bit_cast(bfx8, xg0), (f32x4){0.f, 0.f, 0.f, 0.f}, 0, 0, 0);
                    dg = __builtin_amdgcn_mfma_f32_16x16x32_bf16(__builtin_bit_cast(bfx8, ag1), __builtin_bit_cast(bfx8, xg1), dg, 0, 0, 0);
                    *(f32x4*)(lw + 16 * ct) = dd;
                    *(unsigned long long*)(lag + 16 * ct) = (unsigned long long)pk2(da.x, da.y) | ((unsigned long long)pk2(da.z, da.w) << 32);
                    *(unsigned long long*)(lag + 256 + 16 * ct) = (unsigned long long)pk2(dg.x, dg.y) | ((unsigned long long)pk2(dg.z, dg.w) << 32);
                }
            }
            asm volatile("s_waitcnt vmcnt(0)" ::: "memory");
            __syncthreads();
#pragma nounroll
            for (int rep3_ = 0; rep3_ < NREP(10); ++rep3_)
            {
                typedef unsigned u32x2_ __attribute__((ext_vector_type(2)));
                const int sub = lane & 7; const int c4 = 4 * lane;
                const f32x4 qg0 = *(const f32x4*)(qg + 8 * sub), qg1 = *(const f32x4*)(qg + 8 * sub + 4), kg0 = *(const f32x4*)(kg + 8 * sub), kg1 = *(const f32x4*)(kg + 8 * sub + 4);
                const f32x4 cw0 = *(const f32x4*)(cw + c4), cw1 = *(const f32x4*)(cw + 256 + c4), cw2 = *(const f32x4*)(cw + 512 + c4);
                v4u rq, rk, rv; u32x2_ b0, g0_, u0, g1_, u1, g2_, u2;
#define AP_LOAD(rw) do { const int p1_ = prevrow(rw), p2_ = prevrow(p1_); const bf16* q_ = PROJ + (size_t)(rw) * INP; const bf16* q1_ = PROJ + (size_t)(p1_ < 0 ? (rw) : p1_) * INP; const bf16* q2_ = PROJ + (size_t)(p2_ < 0 ? (rw) : p2_) * INP; \
                    rq = *(const v4u*)(q_ + QOFF + 8 * lane); rk = *(const v4u*)(q_ + KOFF + 8 * lane); rv = *(const v4u*)(q_ + VOFF + 8 * lane); (void)q1_; (void)q2_; } while (0)
#define CV_LOAD(rw) do { const int p1_ = prevrow(rw), p2_ = prevrow(p1_); const bf16* q_ = PROJ + (size_t)(rw) * INP; const bf16* q1_ = PROJ + (size_t)(p1_ < 0 ? (rw) : p1_) * INP; const bf16* q2_ = PROJ + (size_t)(p2_ < 0 ? (rw) : p2_) * INP; \
                    b0 = *(const u32x2_*)(q_ + COFF + c4); g0_ = *(const u32x2_*)(q_ + COFF + 256 + c4); u0 = *(const u32x2_*)(q_ + COFF + 512 + c4); \
                    g1_ = *(const u32x2_*)(q1_ + COFF + 256 + c4); u1 = *(const u32x2_*)(q1_ + COFF + 512 + c4); g2_ = *(const u32x2_*)(q2_ + COFF + 256 + c4); u2 = *(const u32x2_*)(q2_ + COFF + 512 + c4); } while (0)
#define U2F4(t_) ((f32x4){__uint_as_float((t_).x << 16), __uint_as_float((t_).x & 0xffff0000u), __uint_as_float((t_).y << 16), __uint_as_float((t_).y & 0xffff0000u)})
                int idx = wave; AP_LOAD(MP_ROW(idx));
                for (; idx < nrows; idx += 8) { const int row = MP_ROW(idx);
                    const int p1 = prevrow(row), p2 = prevrow(p1); const float m1 = p1 < 0 ? 0.f : 1.f, m2 = p2 < 0 ? 0.f : 1.f;
                    const v4u cq = rq, ck = rk, cv = rv;
                    CV_LOAD(row);
                    if (idx + 8 < nrows) AP_LOAD(MP_ROW(idx + 8));
                    const int pos = row >= NREAL ? row - NREAL : NMETA + (row & (SEQ - 1));
                    const f32x4 c0 = *(const f32x4*)(COS + pos * 8), c1 = *(const f32x4*)(COS + pos * 8 + 4), n0 = *(const f32x4*)(SIN + pos * 8), n1 = *(const f32x4*)(SIN + pos * 8 + 4);
                    const float cs[8] = {c0.x, c0.y, c0.z, c0.w, c1.x, c1.y, c1.z, c1.w}; const float sn[8] = {n0.x, n0.y, n0.z, n0.w, n1.x, n1.y, n1.z, n1.w};
#pragma unroll
                    for (int which = 0; which < 2; ++which) {
                        const v4u raw = which ? ck : cq;
                        float x[8] = {__uint_as_float(raw.x << 16), __uint_as_float(raw.x & 0xffff0000u), __uint_as_float(raw.y << 16), __uint_as_float(raw.y & 0xffff0000u),
                                      __uint_as_float(raw.z << 16), __uint_as_float(raw.z & 0xffff0000u), __uint_as_float(raw.w << 16), __uint_as_float(raw.w & 0xffff0000u)};
                        float s2 = 0.f;
#pragma unroll
                        for (int i = 0; i < 8; ++i) s2 += x[i] * x[i];
                        s2 = sum8(s2);
                        const float rs = 1.f / sqrtf(s2 * (1.f / 64.f) + 1e-6f);
                        const f32x4 ga = which ? kg0 : qg0, gb = which ? kg1 : qg1;
                        const float gg[8] = {ga.x, ga.y, ga.z, ga.w, gb.x, gb.y, gb.z, gb.w};
                        float o[8];
#pragma unroll
                        for (int i = 0; i < 8; ++i) { const float xn = x[i] * rs * gg[i]; const float xp = lane_xor1(xn);
                            o[i] = sub == 0 ? xn * cs[i] - xp * sn[i] : (sub == 1 ? xn * cs[i] + xp * sn[i] : xn); if (!which) o[i] *= C2Q; }
                        v4u w; w.x = pk2(o[0], o[1]); w.y = pk2(o[2], o[3]); w.z = pk2(o[4], o[5]); w.w = pk2(o[6], o[7]);
                        if (!which) *(v4u*)(QN + (size_t)row * 512 + 8 * lane) = w;
                        else {
                            if (row < NREAL) { const size_t kr = (size_t)((row >> 12) * KVROWS + 128 + (row & (SEQ - 1))) * 512 + 8 * lane; *(v4u*)(KP + kr) = w; *(v4u*)(VP + kr) = cv; }
                            else {
#pragma unroll
                                for (int b = 0; b < NB; ++b) { const size_t kr = (size_t)(b * KVROWS + 48 + (row - NREAL)) * 512 + 8 * lane; *(v4u*)(KP + kr) = w; *(v4u*)(VP + kr) = cv; } } }
                    }
                    { const f32x4 fb0 = U2F4(b0), z0 = U2F4(g0_) * U2F4(u0), z1 = U2F4(g1_) * U2F4(u1) * m1, z2 = U2F4(g2_) * U2F4(u2) * m2;
                      const f32x4 y = cw0 * z2 + cw1 * z1 + cw2 * z0; const f32x4 o = fb0 * y;
                      *(unsigned long long*)(OMIX + (size_t)row * DM + 768 + c4) = (unsigned long long)pk2(o.x, o.y) | ((unsigned long long)pk2(o.z, o.w) << 32); }
                }
#undef AP_LOAD
#undef CV_LOAD
#undef U2F4
            }
            {
                LAS float* XL = (LAS float*)(lds + wave * 17408);
                LAS float* YL = XL + 32 * 65;
                const int nreal_g = ngrp - (bx == 0 ? 1 : 0);
                for (int lt = wave; lt < 4 * nreal_g + (bx == 0 ? 4 : 0); lt += NWAVES) {
                    int bh, ch; if (lt < 4 * nreal_g) { const int g = bx + 256 * (lt >> 2); bh = (g >> 8) * 4 + (lt & 3); ch = (g & 255) + 1; } else { bh = lt - 4 * nreal_g; ch = 0; }
                    const int task = bh * 257 + ch, b = bh >> 2, cb = (bh & 3) * 64; const int rowbase = ch == 0 ? NREAL : b * SEQ + 16 * (ch - 1);
                    float at[16], rt[16], bt[16], kt[16], vsv[16]; float gam = 1.f;
                    { const int c = cb + lane;
                      const float mu_r = mu[c], mu_k = mu[256 + c], mu_v = mu[512 + c], w0c = w0[c], a0c = a0[c], kkc = k_k[c], kac = k_a[c], rkc = r_k[c];
                      const int p0 = prevrow(rowbase); const bf16* q0 = PROJ + (size_t)(p0 < 0 ? rowbase : p0) * INP + c; const float pm = p0 < 0 ? 0.f : 1.f;
                      float pr_ = pm * bf2f(q0[0]), pk_ = pm * bf2f(q0[256]), pv_ = pm * bf2f(q0[512]);
                      unsigned short xr[16], xk[16], xv[16], la[16], lg[16]; float lw[16];
#pragma unroll
                      for (int t = 0; t < 16; ++t) { const bf16* q_ = PROJ + (size_t)(rowbase + t) * INP + c; xr[t] = q_[0]; xk[t] = q_[256]; xv[t] = q_[512];
                          lw[t] = LORA_W[(size_t)(rowbase + t) * 256 + c]; la[t] = LORA_AG[(size_t)(rowbase + t) * 512 + c]; lg[t] = LORA_AG[(size_t)(rowbase + t) * 512 + 256 + c]; }
#pragma unroll
                      for (int t = 0; t < 16; ++t) {
                          const float fr = bf2f(xr[t]), fk = bf2f(xk[t]), fv = bf2f(xv[t]);
                          const float r = fr + (pr_ - fr) * mu_r, k = fk + (pk_ - fk) * mu_k, v = fv + (pv_ - fv) * mu_v; pr_ = fr; pk_ = fk; pv_ = fv;
                          const float wacc = w0c + lw[t], aacc = a0c + bf2f(la[t]), gacc = bf2f(lg[t]);
                          const float nx = -wacc; const float sp = fmaxf(nx, 0.f) + __logf(1.f + __expf(-fabsf(nx)));
                          const float wlog = -sp - 0.5f; const float decay = __expf(-__expf(wlog));
                          const float a = sigmoidf_(aacc);
                          const float kkr = k * kkc; const float ss = wave_sum_dpp(kkr * kkr); const float kk = kkr / fmaxf(sqrtf(ss), 1e-12f);
                          const float k2 = k * (1.f + (a - 1.f) * kac);
                          const float bs = wave_sum_dpp(r * k2 * rkc);
                          const size_t si = (size_t)(rowbase + t) * 256 + c;
                          SG[si] = gacc; SBON[si] = bs * v;
                          at[t] = -kk * gam; gam *= decay; rt[t] = r * gam; const float ig = 1.f / gam; bt[t] = kk * a * ig; kt[t] = k2 * ig; vsv[t] = v; } }
#pragma unroll
                    for (int t = 0; t < 16; ++t) { XL[t * 65 + lane] = bt[t]; XL[(16 + t) * 65 + lane] = kt[t]; YL[t * 65 + lane] = at[t]; YL[(16 + t) * 65 + lane] = rt[t]; }
                    attn_body::f32x16 gm = attn_body::f32x16{};
#pragma unroll 8
                    for (int kk = 0; kk < 32; ++kk) gm = __builtin_amdgcn_mfma_f32_32x32x2f32(XL[(lane & 31) * 65 + 2 * kk + (lane >> 5)], YL[(lane & 31) * 65 + 2 * kk + (lane >> 5)], gm, 0, 0, 0);
                    LDS_WAIT();
                    LAS float* GL = YL; LAS float* TL = YL + 1056; LAS float* XM = YL + 1328;
#pragma unroll
                    for (int r = 0; r < 16; ++r) GL[((r & 3) + 8 * (r >> 2) + 4 * (lane >> 5)) * 33 + (lane & 31)] = gm[r];
                    float tr[16];
#pragma unroll
                    for (int t = 0; t < 16; ++t) tr[t] = ((lane & 15) == t) ? 1.f : 0.f;
#pragma unroll
                    for (int s = 0; s < 15; ++s)
#pragma unroll
                        for (int t = s + 1; t < 16; ++t) tr[t] = fmaf(tr[s], GL[s * 33 + t], tr[t]);
                    if (lane < 16) {
#pragma unroll
                        for (int t = 0; t < 16; ++t) TL[lane * 17 + t] = tr[t]; }
                    { const int s = lane & 15, q = lane >> 4; float x0 = 0.f, x1 = 0.f, x2 = 0.f, x3 = 0.f;
#pragma unroll
                      for (int u = 1; u < 16; ++u) { const float l = (u > s) ? GL[(16 + s) * 33 + u] : 0.f; x0 = fmaf(l, TL[u * 17 + 4 * q], x0); x1 = fmaf(l, TL[u * 17 + 4 * q + 1], x1); x2 = fmaf(l, TL[u * 17 + 4 * q + 2], x2); x3 = fmaf(l, TL[u * 17 + 4 * q + 3], x3); }
                      XM[s * 17 + 4 * q] = x0; XM[s * 17 + 4 * q + 1] = x1; XM[s * 17 + 4 * q + 2] = x2; XM[s * 17 + 4 * q + 3] = x3; }
                    float atT[16];
#pragma unroll
                    for (int sp = 0; sp < 16; ++sp) { float acc = 0.f;
#pragma unroll
                        for (int s = 0; s <= sp; ++s) acc = fmaf(at[s], TL[s * 17 + sp], acc);
                        atT[sp] = acc; }
                    unsigned char* rec = CH_REC + (size_t)task * CH_RB;
                    ((float*)rec)[lane] = gam;
                    LAS unsigned short* ST = (LAS unsigned short*)XL;
                    const int kpos = (lane & ~15) + 8 * ((lane >> 2) & 1) + (lane & 3) + 4 * ((lane >> 3) & 1);
                    float zz[16];
#pragma unroll
                    for (int s = 0; s < 16; ++s) { float acc = kt[s] * gam;
#pragma unroll
                        for (int sp = s + 1; sp < 16; ++sp) acc = fmaf(XM[s * 17 + sp], bt[sp] * gam, acc);
                        zz[s] = acc; }
#pragma unroll
                    for (int t = 0; t < 16; ++t) { float acc = rt[t];
#pragma unroll
                        for (int s = 0; s <= t; ++s) acc = fmaf(atT[s], GL[s * 33 + 16 + t], acc);
                        ST[t * 64 + kpos] = (unsigned short)f2bf(atT[t]); ST[(16 + t) * 64 + kpos] = (unsigned short)f2bf(acc); }
                    { v4u w0, w1;
                      w0.x = pk2(bt[0] * gam, bt[1] * gam); w0.y = pk2(bt[2] * gam, bt[3] * gam); w0.z = pk2(bt[8] * gam, bt[9] * gam); w0.w = pk2(bt[10] * gam, bt[11] * gam);
                      w1.x = pk2(bt[4] * gam, bt[5] * gam); w1.y = pk2(bt[6] * gam, bt[7] * gam); w1.z = pk2(bt[12] * gam, bt[13] * gam); w1.w = pk2(bt[14] * gam, bt[15] * gam);
                      v4u* d = (v4u*)(rec + 4352 + lane * 32); d[0] = w0; d[1] = w1;
                      v4u z0, z1; z0.x = pk2(zz[0], zz[1]); z0.y = pk2(zz[2], zz[3]); z0.z = pk2(zz[4], zz[5]); z0.w = pk2(zz[6], zz[7]);
                      z1.x = pk2(zz[8], zz[9]); z1.y = pk2(zz[10], zz[11]); z1.z = pk2(zz[12], zz[13]); z1.w = pk2(zz[14], zz[15]);
                      v4u* dz = (v4u*)(rec + 6400 + lane * 32); dz[0] = z0; dz[1] = z1; }
                    { float vs[16];
#pragma unroll
                      for (int s = 0; s < 16; ++s) vs[s] = vsv[s];
                      v4u a0, a1; a0.x = pk2(vs[0], vs[1]); a0.y = pk2(vs[2], vs[3]); a0.z = pk2(vs[4], vs[5]); a0.w = pk2(vs[6], vs[7]);
                      a1.x = pk2(vs[8], vs[9]); a1.y = pk2(vs[10], vs[11]); a1.z = pk2(vs[12], vs[13]); a1.w = pk2(vs[14], vs[15]);
                      v4u* dv = (v4u*)(rec + 8448 + lane * 32); dv[0] = a0; dv[1] = a1; }
                    { const int s = lane & 15, q = lane >> 4;
#pragma unroll
                      for (int e = 0; e < 4; ++e) { const int t = 4 * q + e; float acc = (t >= s) ? GL[(16 + s) * 33 + 16 + t] : 0.f;
#pragma unroll
                          for (int sp = 1; sp < 16; ++sp) { const float m = (sp <= t) ? GL[sp * 33 + 16 + t] : 0.f; acc = fmaf(XM[s * 17 + sp], m, acc); }
                          ((unsigned short*)(rec + 10496))[t * 16 + s] = (unsigned short)f2bf(acc); } }
                    LDS_WAIT();
                    { const LAS v4u* sv = (const LAS v4u*)ST + lane; v4u* d = (v4u*)(rec + 256) + lane;
#pragma unroll
                      for (int i = 0; i < 4; ++i) d[64 * i] = sv[64 * i]; }
                    LDS_WAIT();
                    if (ch == 0) {
                        asm volatile("s_waitcnt vmcnt(0)" ::: "memory");
                        const v4u* src = (const v4u*)rec;
#pragma unroll 1
                        for (int i = lane; i < CH_RB / 16; i += 64) { const v4u w = src[i];
#pragma unroll
                            for (int cp = 1; cp < 4; ++cp) ((v4u*)(CH_REC + (size_t)((bh + 4 * cp) * 257) * CH_RB))[i] = w; }
                    }
                }
            }
            SEAM(pb + 2);
        }
        for (int rep_ = 0; rep_ < NREP(3); ++rep_) if (EN(3) && IN(pb + 3)) { PH_TID;
#define PK8(T, o) ((v4u){attn_body::cvtpk_s(T[o], T[o + 1]), attn_body::cvtpk_s(T[o + 2], T[o + 3]), attn_body::cvtpk_s(T[o + 4], T[o + 5]), attn_body::cvtpk_s(T[o + 6], T[o + 7])})
            for (int rep2_ = 0; rep2_ < NREP(13); ++rep2_)
            if (bx < 32) {
                typedef attn_body::bf16x8 bfx8; typedef attn_body::f32x16 fx16;
                const int bh = bx >> 1, vh = bx & 1, n = lane & 31, hh = lane >> 5;
                const unsigned char* rec0 = CH_REC + (size_t)(bh * 257) * CH_RB;
                const unsigned lds0 = (unsigned)(uintptr_t)lds_raw;
                constexpr int RBUF = 6 * CH_RB;
#define S2_ISSUE(rnd) do { if (wave >= 1 && wave <= 6) { const int c_ = 6 * (rnd) + wave - 1; if (c_ < 257) { const unsigned dst_ = lds0 + ((rnd) & 1) * RBUF + (wave - 1) * CH_RB; \
                    for (int p_ = 0; p_ < 11; ++p_) attn_body::glds16s(rec0 + (size_t)c_ * CH_RB + p_ * 1024, (unsigned)lane * 16u, (unsigned)__builtin_amdgcn_readfirstlane(dst_ + p_ * 1024)); } } } while (0)
                S2_ISSUE(0);
                asm volatile("s_waitcnt vmcnt(0)\n\ts_barrier" ::: "memory");
                v4u* spk = (v4u*)(CH_SPK + (size_t)(bh * 257) * 8192 + vh * 4096) + lane;
                fx16 st0 = fx16{}, st1 = fx16{};
                for (int rnd = 0; rnd < 43; ++rnd) {
                    S2_ISSUE(rnd + 1);
                    if (wave == 0) {
                        v4u atf[4], bhf[2], ztf[2], vtf; f32x4 gq[8];
#define S2_FRAGS(j_) do { const LAS unsigned char* r_ = lds + (rnd & 1) * RBUF + (j_) * CH_RB; \
                            _Pragma("unroll") for (int ks = 0; ks < 4; ++ks) atf[ks] = *(const LAS v4u*)(r_ + 256 + ((lane & 15) * 64 + 16 * ks + 8 * hh) * 2); \
                            _Pragma("unroll") for (int i = 0; i < 2; ++i) { bhf[i] = *(const LAS v4u*)(r_ + 4352 + ((32 * i + n) * 16 + 8 * hh) * 2); ztf[i] = *(const LAS v4u*)(r_ + 6400 + ((32 * i + n) * 16 + 8 * hh) * 2); } \
                            vtf = *(const LAS v4u*)(r_ + 8448 + ((32 * vh + n) * 16 + 8 * hh) * 2); \
                            _Pragma("unroll") for (int i = 0; i < 2; ++i) _Pragma("unroll") for (int q = 0; q < 4; ++q) gq[4 * i + q] = *(const LAS f32x4*)(r_ + (32 * i + 8 * q + 4 * hh) * 4); } while (0)
                        S2_FRAGS(0);
                        for (int j = 0; j < 6; ++j) { const int ch = 6 * rnd + j; if (ch >= 257) break;
                            const v4u a0 = atf[0], a1 = atf[1], a2 = atf[2], a3 = atf[3], b0 = bhf[0], b1 = bhf[1], z0 = ztf[0], z1 = ztf[1], vt = vtf;
                            f32x4 g_[8];
#pragma unroll
                            for (int i = 0; i < 8; ++i) g_[i] = gq[i];
                            if (j < 5) S2_FRAGS(j + 1);
                            const v4u s0 = PK8(st0, 0), s1 = PK8(st0, 8), s2 = PK8(st1, 0), s3 = PK8(st1, 8);
                            spk[(size_t)ch * 512 + 0] = s0; spk[(size_t)ch * 512 + 64] = s1; spk[(size_t)ch * 512 + 128] = s2; spk[(size_t)ch * 512 + 192] = s3;
                            fx16 pt = fx16{};
                            pt = __builtin_amdgcn_mfma_f32_32x32x16_bf16(__builtin_bit_cast(bfx8, a0), __builtin_bit_cast(bfx8, s0), pt, 0, 0, 0);
                            pt = __builtin_amdgcn_mfma_f32_32x32x16_bf16(__builtin_bit_cast(bfx8, a1), __builtin_bit_cast(bfx8, s1), pt, 0, 0, 0);
                            pt = __builtin_amdgcn_mfma_f32_32x32x16_bf16(__builtin_bit_cast(bfx8, a2), __builtin_bit_cast(bfx8, s2), pt, 0, 0, 0);
                            pt = __builtin_amdgcn_mfma_f32_32x32x16_bf16(__builtin_bit_cast(bfx8, a3), __builtin_bit_cast(bfx8, s3), pt, 0, 0, 0);
#pragma unroll
                            for (int q = 0; q < 4; ++q) { st0[4 * q] *= g_[q].x; st0[4 * q + 1] *= g_[q].y; st0[4 * q + 2] *= g_[q].z; st0[4 * q + 3] *= g_[q].w;
                                                          st1[4 * q] *= g_[4 + q].x; st1[4 * q + 1] *= g_[4 + q].y; st1[4 * q + 2] *= g_[4 + q].z; st1[4 * q + 3] *= g_[4 + q].w; }
                            st0 = __builtin_amdgcn_mfma_f32_32x32x16_bf16(__builtin_bit_cast(bfx8, z0), __builtin_bit_cast(bfx8, vt), st0, 0, 0, 0);
                            st1 = __builtin_amdgcn_mfma_f32_32x32x16_bf16(__builtin_bit_cast(bfx8, z1), __builtin_bit_cast(bfx8, vt), st1, 0, 0, 0);
                            const v4u pp = PK8(pt, 0);
                            st0 = __builtin_amdgcn_mfma_f32_32x32x16_bf16(__builtin_bit_cast(bfx8, b0), __builtin_bit_cast(bfx8, pp), st0, 0, 0, 0);
                            st1 = __builtin_amdgcn_mfma_f32_32x32x16_bf16(__builtin_bit_cast(bfx8, b1), __builtin_bit_cast(bfx8, pp), st1, 0, 0, 0);
                        }
#undef S2_FRAGS
                        asm volatile("s_waitcnt lgkmcnt(0)\n\ts_barrier" ::: "memory");
                    } else asm volatile("s_waitcnt vmcnt(0) lgkmcnt(0)\n\ts_barrier" ::: "memory");
                }
#undef S2_ISSUE
            }
            __syncthreads();
            for (int rep2_ = 0; rep2_ < NREP(12); ++rep2_)
            { const attn_body::AttnTensors AT{(const attn_body::bf16*)QN, (const attn_body::bf16*)KP, (const attn_body::bf16*)VP, (attn_body::bf16*)OC};
              const attn_body::QueueOrder SO{(unsigned*)(ctl + CW_ATTQ + (layer * 8 + (bx & 7)) * 64), (LAS unsigned*)(lds + MISC_OFF + 64), bx & 7, tid};
              attn_body::attn_phase<attn_body::QueueOrder>((char*)lds_raw, AT, SO, tid); }
            __syncthreads();
#ifndef NO_META
            {
                LAS float* sc = (LAS float*)(lds + wave * 1024); LAS float* qs = sc + 64;
                for (int task = gw; task < NMETA * 8; task += NGW) {
                    const int row = NREAL + (task >> 3), hc = task & 7, h = hc >> 1; const int n = row - NREAL + 1;
                    qs[lane] = bf2f(QN[(size_t)row * 512 + hc * 64 + lane]);
                    float m = -INFINITY;
                    { const int idx = lane;
                        if (idx < n) { const size_t kr = 48 + idx; const v4u* kp = (const v4u*)(KP + kr * 512 + hc * 64); float dot = 0.f;
#pragma unroll
                            for (int c8 = 0; c8 < 8; ++c8) { const v4u kv = kp[c8];
                                dot += qs[c8 * 8 + 0] * __uint_as_float(kv.x << 16) + qs[c8 * 8 + 1] * __uint_as_float(kv.x & 0xffff0000u) + qs[c8 * 8 + 2] * __uint_as_float(kv.y << 16) + qs[c8 * 8 + 3] * __uint_as_float(kv.y & 0xffff0000u)
                                     + qs[c8 * 8 + 4] * __uint_as_float(kv.z << 16) + qs[c8 * 8 + 5] * __uint_as_float(kv.z & 0xffff0000u) + qs[c8 * 8 + 6] * __uint_as_float(kv.w << 16) + qs[c8 * 8 + 7] * __uint_as_float(kv.w & 0xffff0000u); }
                            sc[idx] = dot; m = dot; } }
                    m = wave_max(m);
                    float l = 0.f;
                    if (lane < n) { const float p = __builtin_amdgcn_exp2f(sc[lane] - m); sc[lane] = p; l = p; }
                    l = wave_sum(l);
                    float o0 = 0.f, o1 = 0.f;
                    for (int idx = 0; idx < n; ++idx) { const float p = sc[idx]; const size_t vr = 48 + idx;
                        const unsigned v2 = *(const unsigned*)(VP + vr * 512 + h * 128 + 2 * lane); o0 += p * __uint_as_float(v2 << 16); o1 += p * __uint_as_float(v2 & 0xffff0000u); }
                    const float inv = 1.f / l;
                    *(unsigned*)(OC + (size_t)row * 1024 + hc * 128 + 2 * lane) = pk2(o0 * inv, o1 * inv);
                    LDS_WAIT();
                }
            }
#endif
            SEAM(pb + 3);
        }
        for (int rep_ = 0; rep_ < NREP(4); ++rep_) if (EN(4) && IN(pb + 4)) { PH_TID;
            const float* gn_g = INP(13) + layer * 256; const float* gn_b = INP(14) + layer * 256; const float* subg = INP(21) + layer * 128;
            const float s1 = wave_sum(INP(17)[layer * 64 + lane] * INP(18)[layer * 64 + lane]); const float s2 = wave_sum(INP(19)[layer * 64 + lane] * INP(20)[layer * 64 + lane]);
            const float lam = __expf(s1) - __expf(s2) + lam_init;
            const int ngrp = (1025 - bx + 255) / 256, nrows = 16 * ngrp;
            {
                typedef attn_body::bf16x8 bfx8; typedef attn_body::f32x16 fx16;
                const int n = lane & 31, hh = lane >> 5;
                for (int lt = wave; lt < 8 * ngrp; lt += NWAVES) {
                    const int g = bx + 256 * (lt >> 3), hd = (lt >> 1) & 3, vh = lt & 1; const int bh = g < 1024 ? (g >> 8) * 4 + hd : hd, ch = g < 1024 ? (g & 255) + 1 : 0;
                    const int ct = bh * 257 + ch, b = bh >> 2, cb = (bh & 3) * 64; const int rowbase = ch == 0 ? NREAL : b * SEQ + 16 * (ch - 1);
                    const unsigned char* r_ = CH_REC + (size_t)ct * CH_RB; const v4u* spk = (const v4u*)(CH_SPK + (size_t)ct * 8192 + vh * 4096) + lane;
                    fx16 y = fx16{};
#pragma unroll
                    for (int ks = 0; ks < 4; ++ks) { const v4u a = *(const v4u*)(r_ + 2304 + ((lane & 15) * 64 + 16 * ks + 8 * hh) * 2); const v4u s = spk[64 * ks];
                        y = __builtin_amdgcn_mfma_f32_32x32x16_bf16(__builtin_bit_cast(bfx8, a), __builtin_bit_cast(bfx8, s), y, 0, 0, 0); }
                    { const v4u a = *(const v4u*)(r_ + 10496 + ((lane & 15) * 16 + 8 * hh) * 2); const v4u vt = *(const v4u*)(r_ + 8448 + ((32 * vh + n) * 16 + 8 * hh) * 2);
                      y = __builtin_amdgcn_mfma_f32_32x32x16_bf16(__builtin_bit_cast(bfx8, a), __builtin_bit_cast(bfx8, vt), y, 0, 0, 0); }
                    {
#pragma unroll
                        for (int r = 0; r < 8; ++r) SY[(size_t)(rowbase + (r & 3) + 8 * (r >> 2) + 4 * hh) * 256 + cb + 32 * vh + n] = y[r]; }
                }
            }
#undef PK8
            asm volatile("s_waitcnt vmcnt(0)" ::: "memory");
            __syncthreads();
            {
                const int h = lane >> 4, j8 = (lane & 15) * 8;
                f32x4 ny, nbon, ngt; v4u na0, na1;
#define POST_LOAD(rw) do { const int r_ = (rw); ny = *(const f32x4*)(SY + (size_t)r_ * 256 + 4 * lane); nbon = *(const f32x4*)(SBON + (size_t)r_ * 256 + 4 * lane); ngt = *(const f32x4*)(SG + (size_t)r_ * 256 + 4 * lane); \
                    na0 = *(const v4u*)(OC + (size_t)r_ * 1024 + (h * 2 + 0) * 128 + j8); na1 = *(const v4u*)(OC + (size_t)r_ * 1024 + (h * 2 + 1) * 128 + j8); } while (0)
                const f32x4 gg = *(const f32x4*)(gn_g + 4 * lane), gb = *(const f32x4*)(gn_b + 4 * lane), g0 = *(const f32x4*)(subg + j8), g1 = *(const f32x4*)(subg + j8 + 4);
                int idx = wave; POST_LOAD(MP_ROW(idx));
                for (; idx < nrows; idx += NWAVES) { const int row = MP_ROW(idx);
                    const f32x4 y = ny, bon = nbon, gt = ngt; const v4u a0 = na0, a1 = na1;
                    if (idx + NWAVES < nrows) POST_LOAD(MP_ROW(idx + NWAVES));
                    { const float mean = sum16((y.x + y.y) + (y.z + y.w)) * (1.f / 64.f);
                      const f32x4 dlt = y - mean; const float var = sum16((dlt.x * dlt.x + dlt.y * dlt.y) + (dlt.z * dlt.z + dlt.w * dlt.w)) * (1.f / 64.f); const float rs = 1.f / sqrtf(var + 64e-5f);
                      const f32x4 o = (dlt * rs * gg + gb + bon) * gt;
                      *(unsigned long long*)(OMIX + (size_t)row * DM + 4 * lane) = (unsigned long long)pk2(o.x, o.y) | ((unsigned long long)pk2(o.z, o.w) << 32); }
                    { float dv[8];
                      dv[0] = __uint_as_float(a0.x << 16) - lam * __uint_as_float(a1.x << 16); dv[1] = __uint_as_float(a0.x & 0xffff0000u) - lam * __uint_as_float(a1.x & 0xffff0000u);
                      dv[2] = __uint_as_float(a0.y << 16) - lam * __uint_as_float(a1.y << 16); dv[3] = __uint_as_float(a0.y & 0xffff0000u) - lam * __uint_as_float(a1.y & 0xffff0000u);
                      dv[4] = __uint_as_float(a0.z << 16) - lam * __uint_as_float(a1.z << 16); dv[5] = __uint_as_float(a0.z & 0xffff0000u) - lam * __uint_as_float(a1.z & 0xffff0000u);
                      dv[6] = __uint_as_float(a0.w << 16) - lam * __uint_as_float(a1.w << 16); dv[7] = __uint_as_float(a0.w & 0xffff0000u) - lam * __uint_as_float(a1.w & 0xffff0000u);
                      float ss = 0.f;
#pragma unroll
                      for (int i = 0; i < 8; ++i) ss += dv[i] * dv[i];
                      ss = sum16(ss); const float sc_ = (1.f / sqrtf(ss * (1.f / 128.f) + 1e-5f)) * (1.f - lam_init);
                      v4u o; o.x = pk2(dv[0] * sc_ * g0.x, dv[1] * sc_ * g0.y); o.y = pk2(dv[2] * sc_ * g0.z, dv[3] * sc_ * g0.w); o.z = pk2(dv[4] * sc_ * g1.x, dv[5] * sc_ * g1.y); o.w = pk2(dv[6] * sc_ * g1.z, dv[7] * sc_ * g1.w);
                      *(v4u*)(OMIX + (size_t)row * DM + 256 + h * 128 + j8) = o; }
                }
#undef POST_LOAD
            }
            { const int gt = bx * (NWAVES * 64) + tid, NGT = G * NWAVES * 64;
              for (int i = gt; i < (MPAD - NTOK) * (DM / 8); i += NGT) ((v4u*)(OMIX + (size_t)NTOK * DM))[i] = zero_v4u(); }
            SEAM(pb + 4);
        }
        if (EN(5) && IN(pb + 5)) { PH_TID;
            pg8::Gemm g{OMIX, (const bf16*)(ws + WS_WOUT) + (size_t)layer * DM * DM, NREAL, DM, DM}; pg8::StaticOrder S; S.init(NREAL, DM, G, bx);
            if (!moe) {
                if (layer == 2) {
                    meta_gemm_res(OMIX + (size_t)NREAL * DM, DM, (const bf16*)(ws + WS_WOUT) + (size_t)layer * DM * DM, Hf + (size_t)NREAL * DM, lds, bx, wave, lane, 2, (bf16*)((unsigned char*)HB + (size_t)NREAL * DM), RSQA + NREAL);
                    typedef pg8::EpiResAddHB<2, (long long)WS_HB - (long long)WS_H, (long long)WS_RSROW - (long long)WS_H> EpiHB2; EpiHB2 E{Hf, DM, 1.f};
                    pg8::gemm_phase<EpiHB2, pg8::StaticOrder, true, true>(lds, g, S, E, tid);
                } else {
                    meta_gemm_res(OMIX + (size_t)NREAL * DM, DM, (const bf16*)(ws + WS_WOUT) + (size_t)layer * DM * DM, Hf + (size_t)NREAL * DM, lds, bx, wave, lane, 1, HB + (size_t)NREAL * DM, RSQA + NREAL);
                    typedef pg8::EpiResAddHB<1, (long long)WS_HB - (long long)WS_H, (long long)WS_RSROW - (long long)WS_H> EpiHB1; EpiHB1 E{Hf, DM, 1.f};
                    pg8::gemm_phase<EpiHB1, pg8::StaticOrder, true, true>(lds, g, S, E, tid);
                }
            } else {
                meta_gemm_res(OMIX + (size_t)NREAL * DM, DM, (const bf16*)(ws + WS_WOUT) + (size_t)layer * DM * DM, Hf + (size_t)NREAL * DM, lds, bx, wave, lane);
                pg8::EpiResAdd E{Hf, DM, 1.f};
                pg8::gemm_phase<pg8::EpiResAdd, pg8::StaticOrder, true, true>(lds, g, S, E, tid);
            }
            SEAM(pb + 5);
        }
        if (EN(6) && IN(pb + 6) && moe) { PH_TID;
            LAS int* lcnt = (LAS int*)lds; LAS int* lbase = lcnt + 8; LAS int* lrow = lcnt + 16;
            if (tid < 16) lcnt[tid] = 0;
            __syncthreads();
            const float* gff = INP(24) + layer * DM; const float* Wr = INP(28) + (size_t)jj * DM * NE;
            for (int i = wave; i < 72; i += NWAVES) { const int row = bx + G * i;
                if (row < NTOK) {
                    const GAS f32x4* xr = (const GAS f32x4*)(Hf + (size_t)row * DM) + lane; f32x4 v[4]; float s = 0.f;
#pragma unroll
                    for (int j = 0; j < 4; ++j) { v[j] = xr[64 * j]; s += (v[j].x * v[j].x + v[j].y * v[j].y) + (v[j].z * v[j].z + v[j].w * v[j].w); }
                    s = wave_sum(s); const float rstd = 1.f / sqrtf(s * (1.f / DM) + 1e-6f);
                    if (moe) { LAS unsigned* o4 = (LAS unsigned*)(lds + 4096 + i * 1024) + lane; const float sn = rstd * A8_SCALE;
#pragma unroll
                      for (int j = 0; j < 4; ++j) o4[64 * j] = pk4_fp8(v[j].x * sn, v[j].y * sn, v[j].z * sn, v[j].w * sn); }
                    else if (layer == 2) { GAS unsigned* o4 = (GAS unsigned*)((GAS unsigned char*)HB + (size_t)row * DM) + lane; const float sn = rstd * A8_SCALE;
#pragma unroll
                      for (int j = 0; j < 4; ++j) o4[64 * j] = pk4_fp8(v[j].x * sn, v[j].y * sn, v[j].z * sn, v[j].w * sn); }
                    else { GAS unsigned long long* o8 = (GAS unsigned long long*)(HB + (size_t)row * DM) + lane;
#pragma unroll
                      for (int j = 0; j < 4; ++j) o8[64 * j] = (unsigned long long)pk2(v[j].x, v[j].y) | ((unsigned long long)pk2(v[j].z, v[j].w) << 32); }
                    if (lane == 0) RSTD[row] = rstd;
                    if (moe) {
                        float lg[8];
#pragma unroll
                        for (int e = 0; e < 8; ++e) lg[e] = 0.f;
#pragma unroll
                        for (int j = 0; j < 4; ++j) { const int k0 = 4 * lane + 256 * j; const f32x4 gv = *(const f32x4*)(gff + k0);
#pragma unroll
                            for (int q = 0; q < 4; ++q) { const float hv = v[j][q] * gv[q]; const f32x4 wa = *(const f32x4*)(Wr + (size_t)(k0 + q) * 8), wb = *(const f32x4*)(Wr + (size_t)(k0 + q) * 8 + 4);
                                lg[0] += hv * wa.x; lg[1] += hv * wa.y; lg[2] += hv * wa.z; lg[3] += hv * wa.w; lg[4] += hv * wb.x; lg[5] += hv * wb.y; lg[6] += hv * wb.z; lg[7] += hv * wb.w; } }
#pragma unroll
                        for (int e = 0; e < 8; ++e) lg[e] = wave_sum(lg[e]) * rstd;
                        int e1 = 0; float l1 = lg[0];
#pragma unroll
                        for (int e = 1; e < 8; ++e) if (lg[e] > l1) { l1 = lg[e]; e1 = e; }
                        int e2 = -1; float l2 = -INFINITY;
#pragma unroll
                        for (int e = 0; e < 8; ++e) if (e != e1 && lg[e] > l2) { l2 = lg[e]; e2 = e; }
                        if (lane == 0) { const float g2 = 1.f / (1.f + __expf(l1 - l2)); const float g1 = 1.f - g2;
                            const int sl1 = atomicAdd((int*)&lcnt[e1], 1), sl2 = atomicAdd((int*)&lcnt[e2], 1);
                            lrow[i * 4 + 0] = e1; lrow[i * 4 + 1] = sl1; lrow[i * 4 + 2] = e2; lrow[i * 4 + 3] = sl2;
                            TOKG[row * 2 + 0] = g1; TOKG[row * 2 + 1] = g2; }
                    }
                }
            }
            if (moe) {
                __syncthreads();
                if (tid < 8) lbase[tid] = (int)__hip_atomic_fetch_add((unsigned*)(ctl + CW_MOECNT + 64 * jj + tid), (unsigned)lcnt[tid], RLX_AGENT);
                __syncthreads();
                if (tid < 72) { const int row = bx + G * tid; if (row < NTOK) { const int e1 = lrow[tid * 4 + 0], e2 = lrow[tid * 4 + 2];
                    TOKE[row * 2 + 0] = e1; TOKE[row * 2 + 1] = e2; TOKS[row * 2 + 0] = lbase[e1] + lrow[tid * 4 + 1]; TOKS[row * 2 + 1] = lbase[e2] + lrow[tid * 4 + 3]; } }
                __syncthreads();
            }
            SEAM(pb + 6);
        }
        if (!moe) {
            for (int rep_ = 0; rep_ < NREP(7); ++rep_) if (EN(7) && IN(pb + 7)) { PH_TID;
                pg8::StaticOrder S; S.init(MPAD, FF2, G, bx);
                if (layer == 2) { pg8::Gemm g{HB, (const bf16*)(ws + WS_WGU) + (size_t)jj * FF2 * DM, MPAD, FF2, DM / 2}; pg8::EpiSwiglu8 E{GB, FF, nullptr, 1.f / (W8_SCALE * H8_SCALE), G8_SCALE, RSQA};
                    pg8::gemm_phase<pg8::EpiSwiglu8, pg8::StaticOrder, true, true, true>(lds, g, S, E, tid); }
                else { pg8::Gemm g{HB, (const bf16*)(ws + WS_WGU) + (size_t)jj * FF2 * DM, MPAD, FF2, DM}; pg8::EpiSwiglu E{GB, FF, nullptr, 1.f, 0.f, RSQA};
                    pg8::gemm_phase<pg8::EpiSwiglu, pg8::StaticOrder, true, true>(lds, g, S, E, tid); }
                SEAM(pb + 7);
            }
            if (EN(8) && IN(pb + 8)) { PH_TID;
                pg8::StaticOrder S; S.init(NREAL, DM, G, bx);
                if (layer == 2) {
                    meta_gemm_res8((const unsigned char*)GB + (size_t)NREAL * FF, FF, (const unsigned char*)((const bf16*)(ws + WS_WD) + (size_t)jj * DM * FF), Hf + (size_t)NREAL * DM, 1.f / (W8_SCALE * G8_SCALE), lds, bx, wave, lane);
                    pg8::Gemm g{GB, (const bf16*)(ws + WS_WD) + (size_t)jj * DM * FF, NREAL, DM, FF / 2}; pg8::EpiResAdd E{Hf, DM, 1.f / (W8_SCALE * G8_SCALE)};
                    pg8::gemm_phase<pg8::EpiResAdd, pg8::StaticOrder, true, true, true>(lds, g, S, E, tid);
                } else {
                    meta_gemm_res(GB + (size_t)NREAL * FF, FF, (const bf16*)(ws + WS_WD) + (size_t)jj * DM * FF, Hf + (size_t)NREAL * DM, lds, bx, wave, lane);
                    pg8::Gemm g{GB, (const bf16*)(ws + WS_WD) + (size_t)jj * DM * FF, NREAL, DM, FF}; pg8::EpiResAdd E{Hf, DM, 1.f};
                    pg8::gemm_phase<pg8::EpiResAdd, pg8::StaticOrder, true, true>(lds, g, S, E, tid);
                }
                SEAM(pb + 8);
            }
        } else {
#define cnt ((const int*)(ctl + CW_MOECNT + 64 * jj))
            for (int rep_ = 0; rep_ < NREP(7); ++rep_) if (EN(7) && IN(pb + 7)) { PH_TID;
                int ts[8]; { int a = 0;
#pragma unroll
                    for (int e = 0; e < 8; ++e) { ts[e] = a; a += (__hip_atomic_load(cnt + e, RLX_AGENT) + 255) >> 8; } }
                { LAS const int* lbase = (LAS const int*)lds + 8; LAS const int* lrow = (LAS const int*)lds + 16;
                  for (int i = wave; i < 72; i += NWAVES) { const int row = bx + G * i;
                      if (row < NTOK) { const v4u d = *(const LAS v4u*)(lds + 4096 + i * 1024 + lane * 16);
#pragma unroll
                          for (int c = 0; c < 2; ++c) { const int e = lrow[i * 4 + 2 * c]; int tse = 0, lb = 0;
#pragma unroll
                              for (int x = 0; x < 8; ++x) { tse = (e == x) ? ts[x] : tse; lb = (e == x) ? lbase[x] : lb; }
                              const size_t p = (size_t)tse * 256 + lb + lrow[i * 4 + 2 * c + 1];
                              ((v4u*)((unsigned char*)AROWS + p * DM))[lane] = d; } } } }
                SEAM(pb + 7);
            }
            for (int rep_ = 0; rep_ < NREP(8); ++rep_) if (EN(8) && IN(pb + 8)) { PH_TID;
                pg8::Gemm g{AROWS, (const bf16*)(ws + WS_MWGU), MOEP, FF2, DM / 2}; pg8::MoeOrder S; S.init(cnt, FF2 / 256, G, bx);
                pg8::EpiSwiglu8 E{GB, FF, nullptr, 1.f / (W8_SCALE * A8_SCALE), G8_SCALE};
                pg8::gemm_phase<pg8::EpiSwiglu8, pg8::MoeOrder, true, true, true>(lds, g, S, E, tid);
                SEAM(pb + 8);
            }
            for (int rep_ = 0; rep_ < NREP(9); ++rep_) if (EN(9) && IN(pb + 9)) { PH_TID;
                pg8::Gemm g{GB, (const bf16*)(ws + WS_MWD), MOEP, DM, FF / 2}; pg8::MoeOrder S; S.init(cnt, DM / 256, G, bx);
                pg8::EpiBf16Rs E{YM, DM, nullptr, 1.f / (W8_SCALE * G8_SCALE)};
                pg8::gemm_phase<pg8::EpiBf16Rs, pg8::MoeOrder, true, true, true>(lds, g, S, E, tid);
                SEAM(pb + 9);
            }
            if (EN(10) && IN(pb + 10)) { PH_TID;
                int ts[8]; { int a = 0;
#pragma unroll
                    for (int e = 0; e < 8; ++e) { ts[e] = a; a += (__hip_atomic_load(cnt + e, RLX_AGENT) + 255) >> 8; } }
                int ie1, ie2, is1, is2; float ig1, ig2;
                v4u ny1[2], ny2[2]; f32x4 nha[2], nhb[2]; float ng1, ng2;
#define CB_IDX(rw) do { const int r_ = (rw) < NTOK ? (rw) : NTOK - 1; ie1 = TOKE[r_ * 2]; ie2 = TOKE[r_ * 2 + 1]; is1 = TOKS[r_ * 2]; is2 = TOKS[r_ * 2 + 1]; ig1 = TOKG[r_ * 2]; ig2 = TOKG[r_ * 2 + 1]; } while (0)
#define CB_DATA(rw) do { const int r_ = (rw) < NTOK ? (rw) : NTOK - 1; int t1 = 0, t2 = 0; \
                    _Pragma("unroll") for (int q = 0; q < 8; ++q) { t1 = (ie1 == q) ? ts[q] : t1; t2 = (ie2 == q) ? ts[q] : t2; } \
                    const size_t p1 = (size_t)t1 * 256 + is1, p2 = (size_t)t2 * 256 + is2; ng1 = ig1; ng2 = ig2; const float* hr_ = Hf + (size_t)r_ * DM; \
                    _Pragma("unroll") for (int j = 0; j < 2; ++j) { const int c8 = (lane + 64 * j) * 8; ny1[j] = *(const v4u*)(YM + p1 * DM + c8); ny2[j] = *(const v4u*)(YM + p2 * DM + c8); nha[j] = *(const f32x4*)(hr_ + c8); nhb[j] = *(const f32x4*)(hr_ + c8 + 4); } } while (0)
                CB_IDX(gw); CB_DATA(gw); CB_IDX(gw + NGW);
                for (int row = gw; row < NTOK; row += NGW) {
                    const float g1 = ng1, g2 = ng2; v4u cy1[2], cy2[2]; f32x4 cha[2], chb[2];
#pragma unroll
                    for (int j = 0; j < 2; ++j) { cy1[j] = ny1[j]; cy2[j] = ny2[j]; cha[j] = nha[j]; chb[j] = nhb[j]; }
                    CB_DATA(row + NGW); CB_IDX(row + 2 * NGW);
                    float* hr = Hf + (size_t)row * DM; f32x4 hv[2][2]; float ssq = 0.f;
#pragma unroll
                    for (int j = 0; j < 2; ++j) { const v4u y1 = cy1[j], y2 = cy2[j];
                        f32x4 ha = cha[j], hb2 = chb[j];
                        ha.x += g1 * __uint_as_float(y1.x << 16) + g2 * __uint_as_float(y2.x << 16); ha.y += g1 * __uint_as_float(y1.x & 0xffff0000u) + g2 * __uint_as_float(y2.x & 0xffff0000u);
                        ha.z += g1 * __uint_as_float(y1.y << 16) + g2 * __uint_as_float(y2.y << 16); ha.w += g1 * __uint_as_float(y1.y & 0xffff0000u) + g2 * __uint_as_float(y2.y & 0xffff0000u);
                        hb2.x += g1 * __uint_as_float(y1.z << 16) + g2 * __uint_as_float(y2.z << 16); hb2.y += g1 * __uint_as_float(y1.z & 0xffff0000u) + g2 * __uint_as_float(y2.z & 0xffff0000u);
                        hb2.z += g1 * __uint_as_float(y1.w << 16) + g2 * __uint_as_float(y2.w << 16); hb2.w += g1 * __uint_as_float(y1.w & 0xffff0000u) + g2 * __uint_as_float(y2.w & 0xffff0000u);
                        hv[j][0] = ha; hv[j][1] = hb2; ssq += (ha.x * ha.x + ha.y * ha.y) + (ha.z * ha.z + ha.w * ha.w) + (hb2.x * hb2.x + hb2.y * hb2.y) + (hb2.z * hb2.z + hb2.w * hb2.w); }
                    if (layer == DEPTH - 1) {
                        if (row < NREAL) { float* orow = (*(float* const*)(ka + 256)) + (size_t)row * DM;
#pragma unroll
                            for (int j = 0; j < 2; ++j) { const int c8 = (lane + 64 * j) * 8; *(f32x4*)(orow + c8) = hv[j][0]; *(f32x4*)(orow + c8 + 4) = hv[j][1]; } }
                    } else {
                        ssq = wave_sum(ssq); const float rstd = 1.f / sqrtf(ssq * (1.f / DM) + 1e-6f), sn = rstd * A8_SCALE;
#pragma unroll
                        for (int j = 0; j < 2; ++j) { const int c8 = (lane + 64 * j) * 8; *(f32x4*)(hr + c8) = hv[j][0]; *(f32x4*)(hr + c8 + 4) = hv[j][1];
                            if ((INP8 >> (layer + 1)) & 1) { const unsigned lo = pk4_fp8(hv[j][0].x * sn, hv[j][0].y * sn, hv[j][0].z * sn, hv[j][0].w * sn), hi8 = pk4_fp8(hv[j][1].x * sn, hv[j][1].y * sn, hv[j][1].z * sn, hv[j][1].w * sn);
                                *(unsigned long long*)((unsigned char*)HB + (size_t)row * DM + c8) = (unsigned long long)lo | ((unsigned long long)hi8 << 32); }
                            else { v4u w; w.x = pk2(hv[j][0].x, hv[j][0].y); w.y = pk2(hv[j][0].z, hv[j][0].w); w.z = pk2(hv[j][1].x, hv[j][1].y); w.w = pk2(hv[j][1].z, hv[j][1].w);
                                *(v4u*)(HB + (size_t)row * DM + c8) = w; } }
                        if (lane == 0) RSTD[row] = rstd;
                    }
                }
#undef CB_IDX
#undef CB_DATA
                SEAM(pb + 10);
            }
        }
    }
#ifdef UBENCH
    if (hi >= 48 && bx == 255) { PH_TID;
        float x = (float)lane * 1e-3f, y = 1.0001f; float acc = 0.f;
        for (int it = 0; it < UBENCH_ITERS; ++it) {
#if UBENCH == 1
#pragma unroll
            for (int k = 0; k < 64; ++k) { asm volatile("v_fma_f32 %0, %0, %1, %0" : "+v"(x) : "v"(y)); }
#elif UBENCH == 2
#pragma unroll
            for (int k = 0; k < 64; ++k) { asm volatile("s_nop 1\n\tv_add_f32_dpp %0, %0, %0 row_mirror row_mask:0xf bank_mask:0xf bound_ctrl:1" : "+v"(x)); }
#elif UBENCH == 3
#pragma unroll
            for (int k = 0; k < 32; ++k) { asm volatile("s_nop 0\n\tv_readlane_b32 s20, %0, 63\n\tv_fmac_f32 %0, s20, %1" : "+v"(x) : "v"(y) : "s20"); }
#elif UBENCH == 5
            { float y2 = x + 1.f;
#pragma unroll
            for (int k = 0; k < 64; ++k) { asm volatile("s_nop 1\n\tv_add_f32_dpp %0, %0, %0 row_mirror row_mask:0xf bank_mask:0xf bound_ctrl:1\n\tv_add_f32_dpp %1, %1, %1 row_mirror row_mask:0xf bank_mask:0xf bound_ctrl:1" : "+v"(x), "+v"(y2)); }
            x += y2; }
#elif UBENCH == 6
            if (wave < 4) {
#pragma unroll
            for (int k = 0; k < 64; ++k) { asm volatile("s_nop 1\n\tv_add_f32_dpp %0, %0, %0 row_mirror row_mask:0xf bank_mask:0xf bound_ctrl:1" : "+v"(x)); } }
#elif UBENCH == 7
            if (wave < 4) {
#pragma unroll
            for (int k = 0; k < 64; ++k) { asm volatile("v_fma_f32 %0, %0, %1, %0" : "+v"(x) : "v"(y)); } }
#elif UBENCH == 8
            { float y2 = x + 1.f, y3 = x + 2.f, y4 = x + 3.f;
#pragma unroll
            for (int k = 0; k < 64; ++k) { asm volatile("s_nop 1\n\tv_add_f32_dpp %0, %0, %0 row_mirror row_mask:0xf bank_mask:0xf bound_ctrl:1\n\tv_add_f32_dpp %1, %1, %1 row_mirror row_mask:0xf bank_mask:0xf bound_ctrl:1\n\tv_add_f32_dpp %2, %2, %2 row_mirror row_mask:0xf bank_mask:0xf bound_ctrl:1\n\tv_add_f32_dpp %3, %3, %3 row_mirror row_mask:0xf bank_mask:0xf bound_ctrl:1" : "+v"(x), "+v"(y2), "+v"(y3), "+v"(y4)); }
            x += y2 + y3 + y4; }
#elif UBENCH == 4
#pragma unroll
            for (int k = 0; k < 64; ++k) { asm volatile("s_nop 1\n\tv_add_f32_dpp %0, %0, %0 row_bcast:15 row_mask:0xa bank_mask:0xf" : "+v"(x)); }
#endif
        }
        acc += x;
        if (acc == 123.456f) ((float*)(ws + WS_CTL))[2000 + tid] = acc;
    }
#endif
#undef IN
#undef SEAM
}

#ifndef MK_ONE_LAUNCH
#define MK_ONE_LAUNCH 1
#endif
extern "C" void kernel_launch(void* const* d_in, const int* in_sizes, int n_in, void* d_out, int out_size, void* d_ws, size_t ws_size, hipStream_t stream) {
    static int grid = 0;
    if (grid == 0) {
        if (n_in != 32 || out_size != NREAL * DM || ws_size < WS_END) { fprintf(stderr, "kernel_launch: unexpected shapes (n_in %d out %d ws %zu need %zu); nothing launched\n", n_in, out_size, ws_size, (size_t)WS_END); grid = -1; return; }
        int dev = 0, cus = 0, per_cu = 0;
        if (hipGetDevice(&dev) != hipSuccess || hipDeviceGetAttribute(&cus, hipDeviceAttributeMultiprocessorCount, dev) != hipSuccess) { grid = -1; return; }
        if (hipFuncSetAttribute((const void*)hymba_fwd, hipFuncAttributeMaxDynamicSharedMemorySize, LDS_BYTES) != hipSuccess) { fprintf(stderr, "kernel_launch: hipFuncSetAttribute failed\n"); grid = -1; return; }
        if (hipOccupancyMaxActiveBlocksPerMultiprocessor(&per_cu, (const void*)hymba_fwd, NWAVES * 64, LDS_BYTES) != hipSuccess || per_cu < 1) fprintf(stderr, "kernel_launch: occupancy query says %d\n", per_cu);
        (void)hipGetLastError();
        grid = cus;
        if (grid != 256) { fprintf(stderr, "kernel_launch: built for 256 CUs, device has %d; nothing launched\n", cus); grid = -1; return; }
    }
    if (grid < 0) return;
    if (hipMemsetAsync((char*)d_ws + WS_CTL, 0, CTL_ZERO_BYTES, stream) != hipSuccess) return;
    Args a{};
    for (int i = 0; i < 32; ++i) a.in[i] = (const float*)d_in[i];
    a.out = (float*)d_out; a.ws = (unsigned char*)d_ws;
#if MK_ONE_LAUNCH
    a.ph_lo = 0; a.ph_hi = 48;
    hipLaunchKernelGGL(hymba_fwd, dim3(grid), dim3(NWAVES * 64), LDS_BYTES, stream, a);
#else
    for (int ph = 0; ph < 50; ++ph) {
        if (ph >= 1 && ph <= 48) { const int l = (ph - 1) / 12, k = (ph - 1) % 12; const bool moe = l & 1; if (k == 11 || (!moe && k >= 9)) continue; }
        a.ph_lo = ph; a.ph_hi = ph + 1;
        hipLaunchKernelGGL(hymba_fwd, dim3(grid), dim3(NWAVES * 64), LDS_BYTES, stream, a);
    }
#endif
}
```

```cpp
#include <hip/hip_runtime.h>
#include <hip/hip_bf16.h>
#include <cmath>
#include <cstdio>
#include <cstdint>
namespace pg8 {
#define PG8_LAS __attribute__((address_space(3)))
typedef unsigned short bf16_t;
typedef short bf16x8 __attribute__((ext_vector_type(8)));
typedef float f32x4 __attribute__((ext_vector_type(4)));
typedef float f32x2 __attribute__((ext_vector_type(2)));
typedef unsigned u32x4 __attribute__((ext_vector_type(4)));
constexpr int BM = 256, BK = 64, HALF = 128, HTB = HALF * BK * 2  , STAGE_BYTES = 8 * HTB, NXCD = 8, WGM = 8;

__host__ __device__ __forceinline__ int lds_byte(int r, int c) { const int st = (r >> 4) * 2 + (c >> 5), rr = r & 15, cc = c & 31, ob = rr * 64 + cc * 2; return st * 1024 + (ob ^ (((ob >> 9) & 1) << 5)); }
__host__ __device__ __forceinline__ void stage_rc(int b, int& R, int& C) { const int st = b / 1024, sb = b % 1024, swz = sb ^ (((sb >> 9) & 1) << 5); R = (st >> 1) * 16 + swz / 64; C = (st & 1) * 32 + (swz % 64) / 2; }
__host__ __device__ __forceinline__ int perm32(int rho) { const int n = rho >> 4, i = rho & 15; return 8 * (i >> 2) + 4 * n + (i & 3); }

struct Unit { int pm, pn, pc; };
struct Gemm { const bf16_t* A; const bf16_t* Bt; int M, N, K; };

struct StaticOrder {
    int nM, nN, nwg, G, c;
    __host__ __device__ void init(int M, int N, int G_, int c_) { nM = M / BM; nN = N / BM; nwg = nM * nN; G = G_; c = c_; }
    __host__ __device__ bool next(int i, Unit& u) const {
        const long L = (long)i * G + c; if (L >= nwg) return false;
        int wgid = (int)L; { const int q = nwg / NXCD, r = nwg % NXCD, xcd = wgid % NXCD, off = wgid / NXCD; wgid = (xcd < r ? xcd * (q + 1) : r * (q + 1) + (xcd - r) * q) + off; }
        const int nig = WGM * nN, gid = wgid / nig, fm = gid * WGM, gsz = (nM - fm) < WGM ? (nM - fm) : WGM;
        u.pm = fm + ((wgid % nig) % gsz); u.pn = (wgid % nig) / gsz; u.pc = u.pn; return true;
    }
    __device__ __forceinline__ void a_ready(const Unit&) const {}
    __device__ __forceinline__ void done(const Unit&) const {}
};
struct MoeOrder {
    int G, c, nN, total; int t1, t2, t3, t4, t5, t6, t7;
    __device__ __forceinline__ void init(const int* cnt, int nN_, int G_, int c_) {
        G = G_; c = c_; nN = nN_; int a = 0;
        a += (__builtin_amdgcn_readfirstlane(__hip_atomic_load(cnt + 0, __ATOMIC_RELAXED, __HIP_MEMORY_SCOPE_AGENT)) + 255) >> 8; t1 = a;
        a += (__builtin_amdgcn_readfirstlane(__hip_atomic_load(cnt + 1, __ATOMIC_RELAXED, __HIP_MEMORY_SCOPE_AGENT)) + 255) >> 8; t2 = a;
        a += (__builtin_amdgcn_readfirstlane(__hip_atomic_load(cnt + 2, __ATOMIC_RELAXED, __HIP_MEMORY_SCOPE_AGENT)) + 255) >> 8; t3 = a;
        a += (__builtin_amdgcn_readfirstlane(__hip_atomic_load(cnt + 3, __ATOMIC_RELAXED, __HIP_MEMORY_SCOPE_AGENT)) + 255) >> 8; t4 = a;
        a += (__builtin_amdgcn_readfirstlane(__hip_atomic_load(cnt + 4, __ATOMIC_RELAXED, __HIP_MEMORY_SCOPE_AGENT)) + 255) >> 8; t5 = a;
        a += (__builtin_amdgcn_readfirstlane(__hip_atomic_load(cnt + 5, __ATOMIC_RELAXED, __HIP_MEMORY_SCOPE_AGENT)) + 255) >> 8; t6 = a;
        a += (__builtin_amdgcn_readfirstlane(__hip_atomic_load(cnt + 6, __ATOMIC_RELAXED, __HIP_MEMORY_SCOPE_AGENT)) + 255) >> 8; t7 = a;
        a += (__builtin_amdgcn_readfirstlane(__hip_atomic_load(cnt + 7, __ATOMIC_RELAXED, __HIP_MEMORY_SCOPE_AGENT)) + 255) >> 8;
        total = a * nN;
    }
    __device__ __forceinline__ bool next(int i, Unit& u) const {
        const int x = c & 7, per = G >> 3; const int e_ = i * per + (c >> 3);
        const int ntile = total / nN; const int mine = (ntile - x + 7) >> 3;
        if (e_ >= mine * nN) return false;
        const int rt = x + 8 * (e_ / nN), j = e_ % nN;
        const int e = (rt >= t1) + (rt >= t2) + (rt >= t3) + (rt >= t4) + (rt >= t5) + (rt >= t6) + (rt >= t7);
        u.pm = rt; u.pn = e * nN + j; u.pc = j; return true;
    }
    __device__ __forceinline__ void a_ready(const Unit&) const {}
    __device__ __forceinline__ void done(const Unit&) const {}
};

__device__ __forceinline__ unsigned cvt_pk_bf16(float lo, float hi) { unsigned r; asm volatile("v_cvt_pk_bf16_f32 %0, %1, %2" : "=v"(r) : "v"(lo), "v"(hi)); return r; }

#define PG8_GAS __attribute__((address_space(1)))
struct EpiBf16Rs {
    static constexpr bool PERM = true, AFTER_DRAIN = false;
    bf16_t* O; int ldc; const float* rs; float sc;
    __device__ __forceinline__ void operator()(const f32x4 (&acc)[2][2][4][2], const Unit& u, int wr, int wc, int fr, int fq) const {
        const int row0 = u.pm * BM + wr * 64 + fr; const int col0 = u.pc * BM + wc * 32 + 8 * fq;
        float sv[2][4];
#pragma unroll
        for (int ai = 0; ai < 2; ++ai)
#pragma unroll
            for (int m = 0; m < 4; ++m) sv[ai][m] = rs ? ((const PG8_GAS float*)rs)[row0 + ai * HALF + m * 16] : sc;
#pragma unroll
        for (int ai = 0; ai < 2; ++ai)
#pragma unroll
            for (int m = 0; m < 4; ++m) { const int row = row0 + ai * HALF + m * 16; const float s = sv[ai][m]; PG8_GAS bf16_t* rowp = (PG8_GAS bf16_t*)O + (size_t)row * ldc + col0;
#pragma unroll
                for (int bj = 0; bj < 2; ++bj) { const f32x4 v0 = acc[ai][bj][m][0] * s, v1 = acc[ai][bj][m][1] * s;
                    u32x4 w; w.x = cvt_pk_bf16(v0[0], v0[1]); w.y = cvt_pk_bf16(v0[2], v0[3]); w.z = cvt_pk_bf16(v1[0], v1[1]); w.w = cvt_pk_bf16(v1[2], v1[3]);
                    *(PG8_GAS u32x4*)(rowp + bj * HALF) = w; } }
    }
};
struct EpiResAdd {
    static constexpr bool PERM = false, AFTER_DRAIN = false;
    float* H; int ldc; float sc;
    __device__ __forceinline__ void operator()(const f32x4 (&acc)[2][2][4][2], const Unit& u, int wr, int wc, int fr, int fq) const {
        const int row0 = u.pm * BM + wr * 64 + fr; const int col0 = u.pc * BM + wc * 32 + 4 * fq;
#pragma unroll
        for (int ai = 0; ai < 2; ++ai)
#pragma unroll
            for (int mp = 0; mp < 2; ++mp) {
                f32x4 res[2][2][2];
#pragma unroll
                for (int m2 = 0; m2 < 2; ++m2) { const PG8_GAS float* rowp = (const PG8_GAS float*)H + (size_t)(row0 + ai * HALF + (2 * mp + m2) * 16) * ldc + col0;
#pragma unroll
                    for (int bj = 0; bj < 2; ++bj)
#pragma unroll
                        for (int n = 0; n < 2; ++n) res[m2][bj][n] = *(const PG8_GAS f32x4*)(rowp + bj * HALF + n * 16); }
#pragma unroll
                for (int m2 = 0; m2 < 2; ++m2) { PG8_GAS float* rowp = (PG8_GAS float*)H + (size_t)(row0 + ai * HALF + (2 * mp + m2) * 16) * ldc + col0;
#pragma unroll
                    for (int bj = 0; bj < 2; ++bj)
#pragma unroll
                        for (int n = 0; n < 2; ++n) *(PG8_GAS f32x4*)(rowp + bj * HALF + n * 16) = res[m2][bj][n] + acc[ai][bj][2 * mp + m2][n] * sc; }
                asm volatile("" ::: "memory");
            }
    }
};
template <int MODE, long long HB_OFF, long long RSQ_OFF> struct EpiResAddHB {
    static constexpr bool PERM = true, AFTER_DRAIN = false; static constexpr float hs = 4.f;
    float* H; int ldc; float sc;
    __device__ __forceinline__ void operator()(const f32x4 (&acc)[2][2][4][2], const Unit& u, int wr, int wc, int fr, int fq) const {
        const int row0 = u.pm * BM + wr * 64 + fr; const int col0 = u.pc * BM + wc * 32 + 8 * fq;
        PG8_GAS unsigned char* const HBo = (PG8_GAS unsigned char*)H + HB_OFF; PG8_GAS unsigned long long* const rsq = (PG8_GAS unsigned long long*)((PG8_GAS unsigned char*)H + RSQ_OFF);
#pragma unroll
        for (int ai = 0; ai < 2; ++ai)
#pragma unroll
            for (int m = 0; m < 4; ++m) { const int row = row0 + ai * HALF + m * 16; PG8_GAS float* rowp = (PG8_GAS float*)H + (size_t)row * ldc + col0;
                f32x4 r_[2][2];
#pragma unroll
                for (int bj = 0; bj < 2; ++bj)
#pragma unroll
                    for (int n = 0; n < 2; ++n) r_[bj][n] = *(const PG8_GAS f32x4*)(rowp + bj * HALF + n * 4);
                float ss = 0.f;
#pragma unroll
                for (int bj = 0; bj < 2; ++bj) { const f32x4 v0 = r_[bj][0] + acc[ai][bj][m][0] * sc, v1 = r_[bj][1] + acc[ai][bj][m][1] * sc;
                    *(PG8_GAS f32x4*)(rowp + bj * HALF) = v0; *(PG8_GAS f32x4*)(rowp + bj * HALF + 4) = v1;
                    ss += ((v0[0] * v0[0] + v0[1] * v0[1]) + (v0[2] * v0[2] + v0[3] * v0[3])) + ((v1[0] * v1[0] + v1[1] * v1[1]) + (v1[2] * v1[2] + v1[3] * v1[3]));
                    if constexpr (MODE == 1) { u32x4 w; w.x = cvt_pk_bf16(v0[0], v0[1]); w.y = cvt_pk_bf16(v0[2], v0[3]); w.z = cvt_pk_bf16(v1[0], v1[1]); w.w = cvt_pk_bf16(v1[2], v1[3]);
                        *(PG8_GAS u32x4*)((PG8_GAS bf16_t*)HBo + (size_t)row * ldc + col0 + bj * HALF) = w; }
                    else {
#define PG8_C8(x) __builtin_amdgcn_fmed3f((x) * hs, -448.f, 448.f)
                        unsigned lo = (unsigned)__builtin_amdgcn_cvt_pk_fp8_f32(PG8_C8(v0[0]), PG8_C8(v0[1]), 0, false); lo = (unsigned)__builtin_amdgcn_cvt_pk_fp8_f32(PG8_C8(v0[2]), PG8_C8(v0[3]), (int)lo, true);
                        unsigned hi = (unsigned)__builtin_amdgcn_cvt_pk_fp8_f32(PG8_C8(v1[0]), PG8_C8(v1[1]), 0, false); hi = (unsigned)__builtin_amdgcn_cvt_pk_fp8_f32(PG8_C8(v1[2]), PG8_C8(v1[3]), (int)hi, true);
#undef PG8_C8
                        *(PG8_GAS unsigned long long*)(HBo + (size_t)row * ldc + col0 + bj * HALF) = (unsigned long long)lo | ((unsigned long long)hi << 32); } }
                { auto p_ = __builtin_amdgcn_permlane16_swap(__float_as_uint(ss), __float_as_uint(ss), false, false); ss = __uint_as_float(p_[0]) + __uint_as_float(p_[1]); }
                { auto p_ = __builtin_amdgcn_permlane32_swap(__float_as_uint(ss), __float_as_uint(ss), false, false); ss = __uint_as_float(p_[0]) + __uint_as_float(p_[1]); }
                if (fq == 0) __hip_atomic_fetch_add(rsq + row, (unsigned long long)(ss * 16777216.f), __ATOMIC_RELAXED, __HIP_MEMORY_SCOPE_AGENT);
                asm volatile("" ::: "memory"); }
    }
};
template <bool OUT8> struct EpiSwigluT {
    static constexpr bool PERM = true, AFTER_DRAIN = false;
    bf16_t* O; int ldc; const float* rs; float sc; float o8; const unsigned long long* rsq;
    __device__ __forceinline__ void operator()(const f32x4 (&acc)[2][2][4][2], const Unit& u, int wr, int wc, int fr, int fq) const {
        const int row0 = u.pm * BM + wr * 64 + fr; const int col0 = u.pc * HALF + wc * 32 + 8 * fq;
        float sv[2][4];
#pragma unroll
        for (int ai = 0; ai < 2; ++ai)
#pragma unroll
            for (int m = 0; m < 4; ++m) sv[ai][m] = rsq ? sc * __builtin_amdgcn_rsqf((float)((const PG8_GAS unsigned long long*)rsq)[row0 + ai * HALF + m * 16] * (1.f / (16777216.f * 1024.f)) + 1e-6f) : (rs ? ((const PG8_GAS float*)rs)[row0 + ai * HALF + m * 16] : sc);
#pragma unroll
        for (int ai = 0; ai < 2; ++ai)
#pragma unroll
            for (int m = 0; m < 4; ++m) { const int row = row0 + ai * HALF + m * 16; const float s = sv[ai][m]; PG8_GAS bf16_t* rowp = (PG8_GAS bf16_t*)O + (size_t)row * ldc + col0;
                const float c1 = -1.4426950408889634f * s, c2 = OUT8 ? s * s * o8 : s * s;
                f32x2 q[4];
#pragma unroll
                for (int n = 0; n < 2; ++n)
#pragma unroll
                    for (int h = 0; h < 2; ++h) { const f32x4 av = acc[ai][0][m][n], bv = acc[ai][1][m][n];
                        const f32x2 a = h ? (f32x2){av[2], av[3]} : (f32x2){av[0], av[1]}, b = h ? (f32x2){bv[2], bv[3]} : (f32x2){bv[0], bv[1]};
                        const f32x2 t = a * c1; f32x2 e; e.x = __builtin_amdgcn_exp2f(t.x); e.y = __builtin_amdgcn_exp2f(t.y);
                        const f32x2 d = e + 1.f; f32x2 r; r.x = __builtin_amdgcn_rcpf(d.x); r.y = __builtin_amdgcn_rcpf(d.y);
                        q[2 * n + h] = ((a * b) * r) * c2; }
                if constexpr (OUT8) { PG8_GAS unsigned char* rp8 = (PG8_GAS unsigned char*)O + (size_t)row * ldc + col0;
#define PG8_C8(x) __builtin_amdgcn_fmed3f((x), -448.f, 448.f)
                    unsigned lo = (unsigned)__builtin_amdgcn_cvt_pk_fp8_f32(PG8_C8(q[0].x), PG8_C8(q[0].y), 0, false); lo = (unsigned)__builtin_amdgcn_cvt_pk_fp8_f32(PG8_C8(q[1].x), PG8_C8(q[1].y), (int)lo, true);
                    unsigned hi = (unsigned)__builtin_amdgcn_cvt_pk_fp8_f32(PG8_C8(q[2].x), PG8_C8(q[2].y), 0, false); hi = (unsigned)__builtin_amdgcn_cvt_pk_fp8_f32(PG8_C8(q[3].x), PG8_C8(q[3].y), (int)hi, true);
#undef PG8_C8
                    *(PG8_GAS unsigned long long*)rp8 = (unsigned long long)lo | ((unsigned long long)hi << 32); }
                else { u32x4 w; w.x = cvt_pk_bf16(q[0].x, q[0].y); w.y = cvt_pk_bf16(q[1].x, q[1].y); w.z = cvt_pk_bf16(q[2].x, q[2].y); w.w = cvt_pk_bf16(q[3].x, q[3].y);
                    *(PG8_GAS u32x4*)rowp = w; } }
    }
};
typedef EpiSwigluT<false> EpiSwiglu; typedef EpiSwigluT<true> EpiSwiglu8;

template <class Epi, class Sched, bool ALIGN_EPI = false, bool SP2 = false, bool FP8 = false>
__device__ __forceinline__ void gemm_phase(PG8_LAS unsigned char* lds, const Gemm g, const Sched& S, const Epi& E, int tid_in) {
    int tid_ = tid_in; asm volatile("" : "+v"(tid_));
    const int tid = tid_, wid = __builtin_amdgcn_readfirstlane(tid >> 6), lane = tid & 63, wr = wid >> 2, wc = wid & 3, fr = lane & 15, fq = lane >> 4;
    const int K = g.K, nt = K / BK;
    unsigned voffA[2], voffB[2];
#pragma unroll
    for (int i = 0; i < 2; ++i) { int R, C; stage_rc(tid * 16 + i * 8192, R, C); const int Rb = Epi::PERM ? ((R & ~31) + perm32(R & 31)) : R;
        voffA[i] = (unsigned)(R * K + C) * 2u; voffB[i] = (unsigned)(Rb * K + C) * 2u; }
    const size_t kstep = (size_t)(BK * 2);
    const size_t hstep = (size_t)HALF * K * 2;
    const size_t tstep = 2 * hstep;
    const unsigned ldsw = (unsigned)wid * 1024u;
    const int aoff = lds_byte(wr * 64 + fr, fq * 8), boff = lds_byte(wc * 32 + fr, fq * 8);
#define PG8_SA(b, h) (((b) * 2 + (h)) * HTB)
#define PG8_SB(b, h) ((4 + (b) * 2 + (h)) * HTB)
#define PG8_STAGE(bufoff, gbase, voff) do { _Pragma("unroll") for (int _i = 0; _i < 2; ++_i) \
        __builtin_amdgcn_global_load_lds((const unsigned*)((const char*)(gbase) + (voff)[_i]), (PG8_LAS unsigned*)(lds + (bufoff) + ldsw + _i * 8192), 16, 0, 0); } while (0)
#define PG8_LDA(dst, b, h) do { _Pragma("unroll") for (int m = 0; m < 4; ++m) _Pragma("unroll") for (int k = 0; k < 2; ++k) dst[m][k] = *(const PG8_LAS bf16x8*)(lds + PG8_SA(b, h) + aoff + m * 2048 + k * 1024); } while (0)
#define PG8_LDB(dst, b, h) do { _Pragma("unroll") for (int n = 0; n < 2; ++n) _Pragma("unroll") for (int k = 0; k < 2; ++k) dst[n][k] = *(const PG8_LAS bf16x8*)(lds + PG8_SB(b, h) + boff + n * 2048 + k * 1024); } while (0)
#define PG8_MMA(ai, bj, At, Bt) do { __builtin_amdgcn_s_setprio(1); \
        if constexpr (FP8) { typedef int v8i_ __attribute__((ext_vector_type(8))); typedef int v4i_ __attribute__((ext_vector_type(4))); const int sc8_ = 0x7f7f7f7f;     \
            _Pragma("unroll") for (int m = 0; m < 4; ++m) _Pragma("unroll") for (int n = 0; n < 2; ++n) { \
                const v4i_ b0_ = __builtin_bit_cast(v4i_, Bt[n][0]), b1_ = __builtin_bit_cast(v4i_, Bt[n][1]), a0_ = __builtin_bit_cast(v4i_, At[m][0]), a1_ = __builtin_bit_cast(v4i_, At[m][1]); \
                const v8i_ bb_ = (v8i_){b0_.x, b0_.y, b0_.z, b0_.w, b1_.x, b1_.y, b1_.z, b1_.w}, aa_ = (v8i_){a0_.x, a0_.y, a0_.z, a0_.w, a1_.x, a1_.y, a1_.z, a1_.w}; \
                asm volatile("v_mfma_scale_f32_16x16x128_f8f6f4 %0, %1, %2, %0, %3, %3 op_sel_hi:[0,0,0]" : "+v"(acc[ai][bj][m][n]) : "v"(bb_), "v"(aa_), "v"(sc8_)); } \
        } else { _Pragma("unroll") for (int m = 0; m < 4; ++m) _Pragma("unroll") for (int n = 0; n < 2; ++n) _Pragma("unroll") for (int k = 0; k < 2; ++k) \
            acc[ai][bj][m][n] = __builtin_amdgcn_mfma_f32_16x16x32_bf16(Bt[n][k], At[m][k], acc[ai][bj][m][n], 0, 0, 0); } \
        __builtin_amdgcn_s_setprio(0); } while (0)
#define PG8_WAIT_V(n) asm volatile("s_waitcnt vmcnt(" #n ")" ::: "memory")
#define PG8_WAIT_L(n) asm volatile("s_waitcnt lgkmcnt(" #n ")" ::: "memory")
#define PG8_BAR __builtin_amdgcn_s_barrier()
#define PG8_SCHED __builtin_amdgcn_sched_barrier(0)
    Unit cur, nxt; int ui = 0;
    if (!S.next(0, cur)) return;
    f32x4 acc[2][2][4][2];
    { float zf; asm volatile("v_mov_b32 %0, 0" : "=v"(zf));
#pragma unroll
    for (int a = 0; a < 2; ++a)
#pragma unroll
        for (int b = 0; b < 2; ++b)
#pragma unroll
            for (int m = 0; m < 4; ++m)
#pragma unroll
                for (int n = 0; n < 2; ++n) acc[a][b][m][n] = (f32x4){zf, zf, zf, zf}; }
    bf16x8 At[4][2], B0[2][2], B1[2][2];
    const char* cA = (const char*)g.A + (size_t)cur.pm * tstep; const char* cB = (const char*)g.Bt + (size_t)cur.pn * tstep;
    S.a_ready(cur);
    if constexpr (SP2) {
        PG8_STAGE(PG8_SB(0, 0), cB, voffB); PG8_STAGE(PG8_SB(0, 1), cB + hstep, voffB); PG8_STAGE(PG8_SA(0, 0), cA, voffA); PG8_STAGE(PG8_SA(0, 1), cA + hstep, voffA);
        if (wr == 1) PG8_BAR;
        PG8_WAIT_V(2); PG8_BAR;
        PG8_STAGE(PG8_SB(1, 0), cB + kstep, voffB); PG8_STAGE(PG8_SA(1, 0), cA + kstep, voffA); PG8_STAGE(PG8_SB(1, 1), cB + hstep + kstep, voffB);
        PG8_WAIT_V(6); PG8_BAR;
    } else {
        PG8_STAGE(PG8_SB(0, 0), cB, voffB); PG8_STAGE(PG8_SA(0, 0), cA, voffA); PG8_STAGE(PG8_SB(0, 1), cB + hstep, voffB); PG8_STAGE(PG8_SA(0, 1), cA + hstep, voffA);
        if (wr == 1) PG8_BAR;
        PG8_WAIT_V(4); PG8_BAR;
        PG8_STAGE(PG8_SB(1, 0), cB + kstep, voffB); PG8_STAGE(PG8_SA(1, 0), cA + kstep, voffA); PG8_STAGE(PG8_SB(1, 1), cB + hstep + kstep, voffB);
        PG8_WAIT_V(6); PG8_BAR;
    }
    for (;;) {
        const bool has_next = S.next(ui + 1, nxt);
        const char* nA = has_next ? (const char*)g.A + (size_t)nxt.pm * tstep : cA; const char* nB = has_next ? (const char*)g.Bt + (size_t)nxt.pn * tstep : cB;
        for (int t = 0; t < nt; t += 2) {
            const bool last = (t == nt - 2);
            const char* a1 = cA + (size_t)(t + 1) * kstep;
            const char* a2 = last ? nA : cA + (size_t)(t + 2) * kstep; const char* b2 = last ? nB : cB + (size_t)(t + 2) * kstep;
            const char* a3 = a2 + kstep; const char* b3 = b2 + kstep;
            if (last && has_next) S.a_ready(nxt);
            if constexpr (SP2) {
            PG8_LDB(B0, 0, 0); PG8_LDB(B1, 0, 1); PG8_SCHED; PG8_LDA(At, 0, 0); PG8_STAGE(PG8_SA(1, 1), a1 + hstep, voffA);
            PG8_WAIT_V(8); PG8_WAIT_L(0); PG8_BAR; PG8_MMA(0, 0, At, B0); PG8_MMA(0, 1, At, B1); PG8_BAR; PG8_SCHED;
            PG8_LDA(At, 0, 1); PG8_STAGE(PG8_SB(0, 0), b2, voffB); PG8_STAGE(PG8_SB(0, 1), b2 + hstep, voffB); PG8_STAGE(PG8_SA(0, 0), a2, voffA);
            PG8_WAIT_V(8); PG8_WAIT_L(0); PG8_BAR; PG8_MMA(1, 0, At, B0); PG8_MMA(1, 1, At, B1); PG8_BAR; PG8_SCHED;
            PG8_LDB(B0, 1, 0); PG8_LDB(B1, 1, 1); PG8_SCHED; PG8_LDA(At, 1, 0); PG8_STAGE(PG8_SA(0, 1), a2 + hstep, voffA);
            PG8_WAIT_V(8); PG8_WAIT_L(0); PG8_BAR; PG8_MMA(0, 0, At, B0); PG8_MMA(0, 1, At, B1); PG8_BAR; PG8_SCHED;
            PG8_LDA(At, 1, 1); PG8_STAGE(PG8_SB(1, 0), b3, voffB); PG8_STAGE(PG8_SB(1, 1), b3 + hstep, voffB); PG8_STAGE(PG8_SA(1, 0), a3, voffA);
            PG8_WAIT_V(8); PG8_WAIT_L(0); PG8_BAR; PG8_MMA(1, 0, At, B0); PG8_MMA(1, 1, At, B1); PG8_BAR; PG8_SCHED;
            } else {
            PG8_LDB(B0, 0, 0); PG8_SCHED; PG8_LDA(At, 0, 0); PG8_STAGE(PG8_SA(1, 1), a1 + hstep, voffA);
            PG8_WAIT_L(8); PG8_BAR; PG8_WAIT_L(0); PG8_MMA(0, 0, At, B0); PG8_BAR; PG8_SCHED;
            PG8_LDB(B1, 0, 1); PG8_STAGE(PG8_SB(0, 0), b2, voffB);
            PG8_BAR; PG8_WAIT_L(0); PG8_MMA(0, 1, At, B1); PG8_BAR;
            PG8_LDA(At, 0, 1); PG8_STAGE(PG8_SA(0, 0), a2, voffA);
            PG8_BAR; PG8_WAIT_L(0); PG8_MMA(1, 0, At, B0); PG8_BAR; PG8_SCHED;
            PG8_STAGE(PG8_SB(0, 1), b2 + hstep, voffB);
            PG8_WAIT_V(6); PG8_BAR; PG8_MMA(1, 1, At, B1); PG8_BAR;
            PG8_LDB(B0, 1, 0); PG8_SCHED; PG8_LDA(At, 1, 0); PG8_STAGE(PG8_SA(0, 1), a2 + hstep, voffA);
            PG8_WAIT_L(8); PG8_BAR; PG8_WAIT_L(0); PG8_MMA(0, 0, At, B0); PG8_BAR; PG8_SCHED;
            PG8_LDB(B1, 1, 1); PG8_STAGE(PG8_SB(1, 0), b3, voffB);
            PG8_BAR; PG8_WAIT_L(0); PG8_MMA(0, 1, At, B1); PG8_BAR;
            PG8_LDA(At, 1, 1); PG8_STAGE(PG8_SA(1, 0), a3, voffA);
            PG8_BAR; PG8_WAIT_L(0); PG8_MMA(1, 0, At, B0); PG8_BAR; PG8_SCHED;
            PG8_STAGE(PG8_SB(1, 1), b3 + hstep, voffB);
            PG8_WAIT_V(6); PG8_BAR; PG8_MMA(1, 1, At, B1); PG8_BAR;
            }
        }
        if constexpr (FP8) asm volatile("s_nop 15\n\ts_nop 15\n\ts_nop 15" ::: "memory");
        if constexpr (ALIGN_EPI) { if (wr == 0) PG8_BAR; }
        if constexpr (!Epi::AFTER_DRAIN) { E(acc, cur, wr, wc, fr, fq); S.done(cur); }
        if (!has_next) break;
        { float zf; asm volatile("v_mov_b32 %0, 0" : "=v"(zf));
#pragma unroll
        for (int a = 0; a < 2; ++a)
#pragma unroll
            for (int b = 0; b < 2; ++b)
#pragma unroll
                for (int m = 0; m < 4; ++m)
#pragma unroll
                    for (int n = 0; n < 2; ++n) acc[a][b][m][n] = (f32x4){zf, zf, zf, zf}; }
        cur = nxt; cA = nA; cB = nB; ++ui;
        if constexpr (ALIGN_EPI) { if (wr == 1) PG8_BAR; }
    }
    PG8_WAIT_V(0);
    if constexpr (!ALIGN_EPI) { if (wr == 0) PG8_BAR; }
    PG8_BAR;
    if constexpr (Epi::AFTER_DRAIN) { E.fused(acc, cur, wr, wc, fr, fq, lds, wid, lane); S.done(cur); }
#undef PG8_SA
#undef PG8_SB
#undef PG8_STAGE
#undef PG8_LDA
#undef PG8_LDB
#undef PG8_MMA
#undef PG8_WAIT_V
#undef PG8_WAIT_L
#undef PG8_BAR
#undef PG8_SCHED
}
}
#include <hip/hip_bf16.h>
#include <cmath>
namespace attn_body {
using bf16=__hip_bfloat16;
using bf16x8=__attribute__((ext_vector_type(8)))short;
using s16x4=__attribute__((ext_vector_type(4)))short;
using f32x16=__attribute__((ext_vector_type(16)))float;
using u32x4=__attribute__((ext_vector_type(4)))unsigned;
constexpr int BATCH=4,NHEAD=8,SEQ=4096,D=64,DM=512,DMO=1024,KVSEQ=4224;
constexpr int NW=8,QBLK=32,QB=QBLK*NW,KVBLK=64,NQB=SEQ/QB;
constexpr int ATTN_UNIT_ROWS=QB;
__device__ __forceinline__ int crow(int r,int hi){return (r&3)+8*(r>>2)+4*hi;}
#define SBAR() __builtin_amdgcn_sched_barrier(0)
__device__ __forceinline__ void cmask(f32x16&p0,f32x16&p1,int jb,int qrel,int hi){
  const float NEG=-INFINITY; int kb=64*jb+4*hi;
  #pragma unroll
  for(int r=0;r<16;++r){int kv=kb+(r&3)+8*(r>>2); if(kv>qrel)p0[r]=NEG; if(kv+32>qrel)p1[r]=NEG;}
}

constexpr int NSLOT=3, SLOTB=8192;
constexpr int LDS_K=0, LDS_V=NSLOT*SLOTB, LDS_V2=2*NSLOT*SLOTB, LDS_WS=3*NSLOT*SLOTB, LDS_OST=LDS_WS+NW*64*4, LDS_BYTES=LDS_OST+NW*4096;
constexpr float C2=0.125f*1.4426950408889634f;
__device__ __forceinline__ void glds16(const void*gsrc,unsigned lds_dst){unsigned keep;
  asm volatile("s_mov_b32 %0, m0\n\ts_mov_b32 m0, %2\n\ts_nop 0\n\tglobal_load_lds_dwordx4 %1, off\n\ts_mov_b32 m0, %0":"=&s"(keep):"v"(gsrc),"s"(lds_dst):"memory");}
__device__ __forceinline__ void glds16s(const void*sbase,unsigned voff,unsigned lds_dst){unsigned keep;
  asm volatile("s_mov_b32 %0, m0\n\ts_mov_b32 m0, %3\n\ts_nop 0\n\tglobal_load_lds_dwordx4 %1, %2\n\ts_mov_b32 m0, %0":"=&s"(keep):"v"(voff),"s"(sbase),"s"(lds_dst):"memory");}
__device__ __forceinline__ float max3f(float a,float b,float c){float r;asm("v_max3_f32 %0, %1, %2, %3":"=v"(r):"v"(a),"v"(b),"v"(c));return r;}
__device__ __forceinline__ float max2f(float a,float b){float r;asm("v_max_f32_e32 %0, %1, %2":"=v"(r):"v"(a),"v"(b));return r;}
__device__ __forceinline__ float fadd_s(float a,float b){float r;asm("v_add_f32_e32 %0, %1, %2":"=v"(r):"v"(a),"v"(b));return r;}
__device__ __forceinline__ float fsub_s(float a,float b){float r;asm("v_sub_f32_e32 %0, %1, %2":"=v"(r):"v"(a),"v"(b));return r;}
typedef float f32x2_t __attribute__((ext_vector_type(2))); typedef __bf16 bf16x2_t __attribute__((ext_vector_type(2)));
__device__ __forceinline__ unsigned cvtpk_s(float lo,float hi){f32x2_t v={lo,hi};bf16x2_t b=__builtin_convertvector(v,bf16x2_t);return __builtin_bit_cast(unsigned,b);}
#define WAIT_BAR(N) asm volatile("s_waitcnt vmcnt(" #N ") lgkmcnt(0)\n\ts_barrier":::"memory")

typedef __attribute__((address_space(3))) const char* lds_cptr;
__device__ __forceinline__ void qkt(f32x16&p0,f32x16&p1,lds_cptr Kslot,const bf16x8*qr,const f32x16&negm0,const f32x16&negm1,int r32,int hi){
  const lds_cptr kb=Kslot+hi*1024+r32*16;
  #pragma unroll
  for(int d0=0;d0<4;++d0){
    const bf16x8 b0=*(const __attribute__((address_space(3))) bf16x8*)(kb+d0*2048);
    const bf16x8 b1=*(const __attribute__((address_space(3))) bf16x8*)(kb+d0*2048+512);
    if(d0==0){p0=__builtin_amdgcn_mfma_f32_32x32x16_bf16(b0,qr[0],negm0,0,0,0);p1=__builtin_amdgcn_mfma_f32_32x32x16_bf16(b1,qr[0],negm1,0,0,0);}
    else{p0=__builtin_amdgcn_mfma_f32_32x32x16_bf16(b0,qr[d0],p0,0,0,0);p1=__builtin_amdgcn_mfma_f32_32x32x16_bf16(b1,qr[d0],p1,0,0,0);}}
}
typedef short v4i16_t __attribute__((ext_vector_type(4)));
__device__ __forceinline__ void kload8(bf16x8*kf,lds_cptr kp){
  kf[0]=*(const __attribute__((address_space(3))) bf16x8*)(kp);      kf[1]=*(const __attribute__((address_space(3))) bf16x8*)(kp+512);
  kf[2]=*(const __attribute__((address_space(3))) bf16x8*)(kp+2048); kf[3]=*(const __attribute__((address_space(3))) bf16x8*)(kp+2560);
  kf[4]=*(const __attribute__((address_space(3))) bf16x8*)(kp+4096); kf[5]=*(const __attribute__((address_space(3))) bf16x8*)(kp+4608);
  kf[6]=*(const __attribute__((address_space(3))) bf16x8*)(kp+6144); kf[7]=*(const __attribute__((address_space(3))) bf16x8*)(kp+6656);
}
__device__ __forceinline__ void kload2(bf16x8*kf,lds_cptr kp,int j){ kf[2*j]=*(const __attribute__((address_space(3))) bf16x8*)(kp+j*2048); kf[2*j+1]=*(const __attribute__((address_space(3))) bf16x8*)(kp+j*2048+512); }
__device__ __forceinline__ s16x4 vtr(lds_cptr p){ return __builtin_bit_cast(s16x4,__builtin_amdgcn_ds_read_tr16_b64_v4i16((__attribute__((address_space(3))) v4i16_t*)p)); }
__device__ __forceinline__ float rowmax(const f32x16&p0,const f32x16&p1){
  float a=max3f(p0[0],p0[1],p1[0]),b=max3f(p0[2],p0[3],p1[1]);a=max3f(a,p1[2],p1[3]);
  #pragma unroll
  for(int r=4;r<16;r+=4){a=max3f(a,p0[r],p0[r+1]);b=max3f(b,p0[r+2],p0[r+3]);a=max3f(a,p1[r],p1[r+1]);b=max3f(b,p1[r+2],p1[r+3]);}
  const float m=max2f(a,b);
  auto rr=__builtin_amdgcn_permlane32_swap(__float_as_uint(m),__float_as_uint(m),false,false);
  return max2f(__uint_as_float(rr[0]),__uint_as_float(rr[1]));
}
__device__ __forceinline__ void pv(f32x16*o,int vb,bf16x8 pa0,bf16x8 pa1,bf16x8 pa2,bf16x8 pa3){
  #pragma unroll
  for(int d0=0;d0<2;++d0){s16x4 lo[4],hi[4];
    #pragma unroll
    for(int ks=0;ks<4;++ks){
      asm volatile("ds_read_b64_tr_b16 %0,%1 offset:%c2":"=&v"(lo[ks]):"v"(vb),"i"(d0*4096+ks*1024):"memory");
      asm volatile("ds_read_b64_tr_b16 %0,%1 offset:%c2":"=&v"(hi[ks]):"v"(vb),"i"(d0*4096+ks*1024+512):"memory");}
    asm volatile("s_waitcnt lgkmcnt(0)":::"memory");SBAR();
    #define PK(k) (bf16x8){lo[k][0],lo[k][1],lo[k][2],lo[k][3],hi[k][0],hi[k][1],hi[k][2],hi[k][3]}
    o[d0]=__builtin_amdgcn_mfma_f32_32x32x16_bf16(pa0,PK(0),o[d0],0,0,0);
    o[d0]=__builtin_amdgcn_mfma_f32_32x32x16_bf16(pa1,PK(1),o[d0],0,0,0);
    o[d0]=__builtin_amdgcn_mfma_f32_32x32x16_bf16(pa2,PK(2),o[d0],0,0,0);
    o[d0]=__builtin_amdgcn_mfma_f32_32x32x16_bf16(pa3,PK(3),o[d0],0,0,0);
    #undef PK
  }
}

#ifndef ATTN_STORE16
#define ATTN_STORE16(p,v) (*(u32x4*)(p)=(v))
#endif
template<int THRL> __device__ __forceinline__ void attn_unit(int b,int hc,int qb,const bf16*Q,const bf16*__restrict__ K,const bf16*__restrict__ V,bf16*O,char*shm,int tid_in){
  int tid_=tid_in; asm volatile("":"+v"(tid_)); const int tid=tid_,lane=tid&63,r32=lane&31,hi=lane>>5; const int wid=__builtin_amdgcn_readfirstlane(tid>>6);
  const long rowbase=(long)b*SEQ, kvbase=(long)b*KVSEQ; const int q0=qb*QB;
  const bf16*Qw=Q+(rowbase+q0+wid*QBLK)*DM+hc*D;
  const bf16*Kh=K+kvbase*DM+hc*D,*Vh=V+kvbase*DM+(hc>>1)*128;
  const unsigned lds0=(unsigned)(uintptr_t)shm;
  typedef __attribute__((address_space(3))) float lds_f32; typedef __attribute__((address_space(3))) unsigned short lds_u16; typedef __attribute__((address_space(3))) char lds_char;
  lds_f32*wsf=(lds_f32*)((lds_char*)shm+LDS_WS)+wid*64;
  const bf16*ksb=Kh+wid*8; const unsigned kvo=(unsigned)lane*(DM*2);
  const bf16*vsb=Vh+(long)(16*(wid&3))*DM+(wid>>2)*32; const unsigned vvo=(unsigned)((lane>>2)*DM+(lane&3)*8)*2u;
  const unsigned kdst=lds0+LDS_K+wid*1024, vdst=lds0+LDS_V+wid*1024, vdst2=lds0+LDS_V2+wid*1024;
  #define DMA_K(t,slot) glds16s(ksb+(long)(t)*KVBLK*DM,kvo,(unsigned)__builtin_amdgcn_readfirstlane(kdst+(slot)))
  #define DMA_V(t,slot) do{ glds16s(vsb+(long)(t)*KVBLK*DM,vvo,(unsigned)__builtin_amdgcn_readfirstlane(vdst+(slot))); glds16s(vsb+(long)(t)*KVBLK*DM+64,vvo,(unsigned)__builtin_amdgcn_readfirstlane(vdst2+(slot))); }while(0)
  const int vb0=(int)(lds0+LDS_V)+((lane>>4)&1)*32+(lane&3)*8+(4*hi+((lane&15)>>2))*64;
  bf16x8 kf[8];
  const lds_cptr shm3=(lds_cptr)shm; const lds_cptr kp0=shm3+LDS_K+hi*1024+r32*16; const lds_cptr vp0=shm3+LDS_V+((lane>>4)&1)*32+(lane&3)*8+(4*hi+((lane&15)>>2))*64;
  const int NT=(q0+QB)/KVBLK+2;
  DMA_K(0,0);DMA_V(0,0);DMA_K(1,SLOTB);
  bf16x8 qr[4];
  #pragma unroll
  for(int d0=0;d0<4;++d0)qr[d0]=*reinterpret_cast<const bf16x8*>(&Qw[(long)r32*DM+d0*16+hi*8]);
  float mhat=0.f,l_reg=0.f;f32x16 o[4];o[0]=f32x16{};o[1]=f32x16{};o[2]=f32x16{};o[3]=f32x16{};f32x16 negm=f32x16{};asm volatile("":"+v"(negm));
  const int qrel=wid*QBLK+r32;
  #define CMASK(P0,P1,t) do{int jb_=(t)-(NT-4); if(jb_>=0)cmask(P0,P1,jb_,qrel,hi);}while(0)
  bool resc=false;
  #define START(P0,P1) do{ const float rm=rowmax(P0,P1); resc=false; \
    { const float dl=rm; mhat=fadd_s(mhat,dl); \
      _Pragma("unroll") for(int r=0;r<16;++r){P0[r]=fsub_s(P0[r],dl);P1[r]=fsub_s(P1[r],dl);} \
      _Pragma("unroll") for(int r=0;r<16;++r)negm[r]=-mhat; asm volatile("":"+v"(negm)); } \
    _Pragma("unroll") for(int r=0;r<16;++r)P0[r]=__builtin_amdgcn_exp2f(P0[r]); }while(0)
  #define RESC() do{ if(resc){ asm volatile("s_waitcnt lgkmcnt(0)":::"memory"); \
      _Pragma("unroll") for(int d_=0;d_<4;++d_) _Pragma("unroll") for(int r=0;r<16;++r)o[d_][r]*=wsf[crow(r,hi)]; } }while(0)
  f32x16 pA0,pA1,pB0,pB1;
  int sl_prev=0,sl_cur=0,sl_next=SLOTB;
  #define ROT() do{sl_prev=sl_cur;sl_cur=sl_next;sl_next=(sl_next==(NSLOT-1)*SLOTB)?0:sl_next+SLOTB;}while(0)
  DMA_K(2,2*SLOTB);
  WAIT_BAR(4);
  { f32x16 cm0,cm1; _Pragma("unroll") for(int r=0;r<16;++r){cm0[r]=-INFINITY;cm1[r]=(r<8)?-INFINITY:0.f;} asm volatile("":"+v"(cm0),"+v"(cm1));
    qkt(pA0,pA1,shm3+LDS_K,qr,cm0,cm1,r32,hi); }
  asm volatile("s_nop 15\n\ts_nop 7":"+v"(pA0),"+v"(pA1));CMASK(pA0,pA1,0);
  START(pA0,pA1);
  _Pragma("unroll") for(int r=0;r<16;++r)pA1[r]=__builtin_amdgcn_exp2f(pA1[r]);
  _Pragma("unroll") for(int r=0;r<16;++r)negm[r]=-INFINITY; asm volatile("":"+v"(negm));
  WAIT_BAR(0);
  DMA_K(3,0);DMA_V(1,SLOTB);
  ROT();
  kload8(kf,kp0+sl_cur);
  WAIT_BAR(3);
  s16x4 vlo[8],vhi[8],wlo[8],whi[8]; u32x4 pw0,pw1,pw2,pw3;
  #define PKW(P,B) cvtpk_s(P[B],P[B+1])
  #define PAF(k) __builtin_bit_cast(bf16x8,pw##k)
  #define VFR(i) (bf16x8){vlo[i][0],vlo[i][1],vlo[i][2],vlo[i][3],vhi[i][0],vhi[i][1],vhi[i][2],vhi[i][3]}
  #define WFR(i) (bf16x8){wlo[i][0],wlo[i][1],wlo[i][2],wlo[i][3],whi[i][0],whi[i][1],whi[i][2],whi[i][3]}
  #define PIN(x) asm volatile("":"+v"(x))
  #define MX3(a,b,c) __builtin_fmaxf(__builtin_fmaxf((a),(b)),(c))
  #define GAPA(MF,A0,A1,A2,A3,W0,W1,PW) do{ MF; sacc+=A0; sacc+=A1; sacc+=A2; sacc+=A3; PIN(sacc); W0; W1; PIN(PW); SBAR(); }while(0)
  #define EX(v) __builtin_amdgcn_exp2f(v)
  #define GAPB(MF,X,B) do{ MF; X[B]=EX(X[B]); X[B+1]=EX(X[B+1]); PIN(X); SBAR(); }while(0)
  #define VRD(i) do{ vlo[i]=vtr(vp_+(((i)>>2)*4096+((i)&3)*1024)); vhi[i]=vtr(vp_+(((i)>>2)*4096+((i)&3)*1024+512)); }while(0)
  #define WRD(i) do{ wlo[i]=vtr(vp_+((LDS_V2-LDS_V)+((i)>>2)*4096+((i)&3)*1024)); whi[i]=vtr(vp_+((LDS_V2-LDS_V)+((i)>>2)*4096+((i)&3)*1024+512)); SBAR(); }while(0)
  #define KRD(G,j) do{ if(G){ kload2(kf,kp0+sl_next,j); SBAR(); } }while(0)
  #define STEP(C0,C1,P0,P1,t,GK,GV,GL) do{ SBAR(); \
    const lds_cptr vp_=vp0+sl_prev; \
    float sacc=(P0[0]+P0[1]); \
    GAPA(C0=__builtin_amdgcn_mfma_f32_32x32x16_bf16(kf[0],qr[0],negm,0,0,0), P0[2],P0[3],P0[4],P0[5],     pw0[0]=PKW(P0,0), pw0[1]=PKW(P0,2), pw0); \
    GAPA(C1=__builtin_amdgcn_mfma_f32_32x32x16_bf16(kf[1],qr[0],negm,0,0,0), P0[6],P0[7],P0[8],P0[9],     pw0[2]=PKW(P0,4), pw0[3]=PKW(P0,6), pw0); \
    GAPA(C0=__builtin_amdgcn_mfma_f32_32x32x16_bf16(kf[2],qr[1],C0,0,0,0),   P0[10],P0[11],P0[12],P0[13], pw1[0]=PKW(P0,8), pw1[1]=PKW(P0,10), pw1); \
    GAPA(C1=__builtin_amdgcn_mfma_f32_32x32x16_bf16(kf[3],qr[1],C1,0,0,0),   P0[14],P0[15],P1[0],P1[1],   pw1[2]=PKW(P0,12),pw1[3]=PKW(P0,14), pw1); \
    GAPA(C0=__builtin_amdgcn_mfma_f32_32x32x16_bf16(kf[4],qr[2],C0,0,0,0),   P1[2],P1[3],P1[4],P1[5],     pw2[0]=PKW(P1,0), pw2[1]=PKW(P1,2), pw2); \
    GAPA(C1=__builtin_amdgcn_mfma_f32_32x32x16_bf16(kf[5],qr[2],C1,0,0,0),   P1[6],P1[7],P1[8],P1[9],     pw2[2]=PKW(P1,4), pw2[3]=PKW(P1,6), pw2); \
    GAPA(C0=__builtin_amdgcn_mfma_f32_32x32x16_bf16(kf[6],qr[3],C0,0,0,0),   P1[10],P1[11],P1[12],P1[13], pw3[0]=PKW(P1,8), pw3[1]=PKW(P1,10), pw3); \
    GAPA(C1=__builtin_amdgcn_mfma_f32_32x32x16_bf16(kf[7],qr[3],C1,0,0,0),   P1[14],P1[15],0.f,0.f,       pw3[2]=PKW(P1,12),pw3[3]=PKW(P1,14), pw3); \
    l_reg+=sacc; \
    VRD(0);VRD(4);VRD(1);VRD(5);VRD(2);VRD(6);VRD(3);VRD(7); SBAR();     \
    if(GK){DMA_K((t)+3,sl_cur);} if(GV){DMA_V((t)+1,sl_next);} \
    CMASK(C0,C1,t); \
    { float a=MX3(C0[0],C0[1],C1[0]),b=MX3(C0[2],C0[3],C1[1]); a=MX3(a,C1[2],C1[3]); \
      _Pragma("unroll") for(int r=4;r<16;r+=4){a=MX3(a,C0[r],C0[r+1]);b=MX3(b,C0[r+2],C0[r+3]);a=MX3(a,C1[r],C1[r+1]);b=MX3(b,C1[r+2],C1[r+3]);} \
      float rm=__builtin_fmaxf(a,b); { auto rr=__builtin_amdgcn_permlane32_swap(__float_as_uint(rm),__float_as_uint(rm),false,false); rm=__builtin_fmaxf(__uint_as_float(rr[0]),__uint_as_float(rr[1])); } \
      resc=false; \
      if(__builtin_expect(__any(rm>(float)THRL),0)){ const float dl=__builtin_fmaxf(rm,0.f); mhat+=dl; \
        _Pragma("unroll") for(int r=0;r<16;++r){C0[r]-=dl;C1[r]-=dl;} \
        _Pragma("unroll") for(int r=0;r<16;++r)negm[r]=-mhat; asm volatile("":"+v"(negm)); \
        const float f=__builtin_amdgcn_exp2f(-dl); l_reg*=f; if(hi==0)wsf[r32]=f; resc=true; } } \
    SBAR(); \
    GAPB(o[0]=__builtin_amdgcn_mfma_f32_32x32x16_bf16(PAF(0),VFR(0),o[0],0,0,0), C0,0);  WRD(0); \
    GAPB(o[1]=__builtin_amdgcn_mfma_f32_32x32x16_bf16(PAF(0),VFR(4),o[1],0,0,0), C0,2);  WRD(4); \
    KRD(GL,0); GAPB(o[0]=__builtin_amdgcn_mfma_f32_32x32x16_bf16(PAF(1),VFR(1),o[0],0,0,0), C0,4);  WRD(1); \
    KRD(GL,1); GAPB(o[1]=__builtin_amdgcn_mfma_f32_32x32x16_bf16(PAF(1),VFR(5),o[1],0,0,0), C0,6);  WRD(5); \
    KRD(GL,2); GAPB(o[0]=__builtin_amdgcn_mfma_f32_32x32x16_bf16(PAF(2),VFR(2),o[0],0,0,0), C0,8);  WRD(2); \
    KRD(GL,3); GAPB(o[1]=__builtin_amdgcn_mfma_f32_32x32x16_bf16(PAF(2),VFR(6),o[1],0,0,0), C0,10); WRD(6); \
    GAPB(o[0]=__builtin_amdgcn_mfma_f32_32x32x16_bf16(PAF(3),VFR(3),o[0],0,0,0), C0,12); WRD(3); \
    GAPB(o[1]=__builtin_amdgcn_mfma_f32_32x32x16_bf16(PAF(3),VFR(7),o[1],0,0,0), C0,14); WRD(7); \
    GAPB(o[2]=__builtin_amdgcn_mfma_f32_32x32x16_bf16(PAF(0),WFR(0),o[2],0,0,0), C1,0); \
    GAPB(o[3]=__builtin_amdgcn_mfma_f32_32x32x16_bf16(PAF(0),WFR(4),o[3],0,0,0), C1,2); \
    GAPB(o[2]=__builtin_amdgcn_mfma_f32_32x32x16_bf16(PAF(1),WFR(1),o[2],0,0,0), C1,4); \
    GAPB(o[3]=__builtin_amdgcn_mfma_f32_32x32x16_bf16(PAF(1),WFR(5),o[3],0,0,0), C1,6); \
    GAPB(o[2]=__builtin_amdgcn_mfma_f32_32x32x16_bf16(PAF(2),WFR(2),o[2],0,0,0), C1,8); \
    GAPB(o[3]=__builtin_amdgcn_mfma_f32_32x32x16_bf16(PAF(2),WFR(6),o[3],0,0,0), C1,10); \
    GAPB(o[2]=__builtin_amdgcn_mfma_f32_32x32x16_bf16(PAF(3),WFR(3),o[2],0,0,0), C1,12); \
    GAPB(o[3]=__builtin_amdgcn_mfma_f32_32x32x16_bf16(PAF(3),WFR(7),o[3],0,0,0), C1,14); \
    }while(0)
  int t=1;
  #define FIX1(tt) do{ if((tt)==1){ _Pragma("unroll") for(int r=0;r<16;++r)negm[r]=-mhat; asm volatile("":"+v"(negm)); } }while(0)
  #undef CMASK
  #define CMASK(P0,P1,t) do{}while(0)
  for(;t+5<NT;t+=2){
    STEP(pB0,pB1,pA0,pA1,t,true,true,true);     WAIT_BAR(3); RESC(); ROT(); FIX1(t);
    STEP(pA0,pA1,pB0,pB1,t+1,true,true,true);   WAIT_BAR(3); RESC(); ROT();
  }
  #undef CMASK
  #define CMASK(P0,P1,t) do{int jb_=(t)-(NT-4); if(jb_>=0)cmask(P0,P1,jb_,qrel,hi);}while(0)
  #define ENDW(tt) do{ if((tt)+3<NT){WAIT_BAR(3);} else if((tt)+2<NT){WAIT_BAR(2);} else {WAIT_BAR(0);} }while(0)
  for(;t+1<NT;t+=2){
    STEP(pB0,pB1,pA0,pA1,t,(t+3<NT),(t+1<NT),(t+1<NT));       ENDW(t);   RESC(); ROT(); FIX1(t);
    STEP(pA0,pA1,pB0,pB1,t+1,(t+4<NT),(t+2<NT),(t+2<NT));     ENDW(t+1); RESC(); ROT();
  }
  STEP(pB0,pB1,pA0,pA1,NT-1,false,false,false); RESC();
  { float sacc=pB0[0]+pB0[1]; _Pragma("unroll") for(int r=2;r<16;++r)sacc+=pB0[r]; _Pragma("unroll") for(int r=0;r<16;++r)sacc+=pB1[r]; l_reg+=sacc;
    pw0=(u32x4){PKW(pB0,0),PKW(pB0,2),PKW(pB0,4),PKW(pB0,6)};pw1=(u32x4){PKW(pB0,8),PKW(pB0,10),PKW(pB0,12),PKW(pB0,14)};pw2=(u32x4){PKW(pB1,0),PKW(pB1,2),PKW(pB1,4),PKW(pB1,6)};pw3=(u32x4){PKW(pB1,8),PKW(pB1,10),PKW(pB1,12),PKW(pB1,14)};
    SBAR(); pv(o,vb0+sl_cur,PAF(0),PAF(1),PAF(2),PAF(3)); pv(o+2,vb0+(LDS_V2-LDS_V)+sl_cur,PAF(0),PAF(1),PAF(2),PAF(3)); }
  #undef PKW
  #undef PAF
  #undef VFR
  #undef WFR
  #undef WRD
  #undef PIN
  #undef MX3
  #undef GAPA
  #undef GAPB
  #undef EX
  #undef VRD
  #undef KRD
  #undef STEP
  #undef ENDW
  {auto rr=__builtin_amdgcn_permlane32_swap(__float_as_uint(l_reg),__float_as_uint(l_reg),false,false);l_reg=__uint_as_float(rr[0])+__uint_as_float(rr[1]);}
  if(hi==0)wsf[32+r32]=l_reg;asm volatile("s_waitcnt lgkmcnt(0)":::"memory");
  float rli[16];
  #pragma unroll
  for(int r=0;r<16;++r)rli[r]=__builtin_amdgcn_rcpf(wsf[32+crow(r,hi)]);
  bf16*Ow=O+(rowbase+q0+wid*QBLK)*DMO+hc*128;
  { lds_u16*stg=(lds_u16*)((lds_char*)shm+LDS_OST)+wid*2048;
    #pragma unroll
    for(int half=0;half<2;++half){
      #pragma unroll
      for(int r=0;r<16;++r){const int orow=crow(r,hi);
        #pragma unroll
        for(int d0=0;d0<2;++d0)stg[orow*64+d0*32+r32]=(unsigned short)(cvtpk_s(o[2*half+d0][r]*rli[r],0.f)&0xffffu);}
      asm volatile("s_waitcnt lgkmcnt(0)":::"memory");
      #pragma unroll
      for(int i=0;i<4;++i){const int row=i*8+(lane>>3),ch=lane&7; const u32x4 v=*(const __attribute__((address_space(3))) u32x4*)(stg+row*64+ch*8); ATTN_STORE16(Ow+(long)row*DMO+half*64+ch*8,v);}
      asm volatile("s_waitcnt lgkmcnt(0)":::"memory"); } }
  asm volatile("s_waitcnt lgkmcnt(0)\n\ts_barrier":::"memory");
  #undef DMA_K
  #undef DMA_V
  #undef CMASK
  #undef START
  #undef RESC
  #undef ROT
}
constexpr int ATTN_LDS_BYTES=LDS_BYTES;
struct AttnTensors { const bf16* Q; const bf16* K; const bf16* V; bf16* O; };
struct AttnUnit { int bh; int qb; };
struct StaticOrder {
  int vcu;
  __device__ __forceinline__ explicit StaticOrder(int grid,int block):vcu((block%8)*(grid/8)+block/8){}
  __device__ __forceinline__ bool next(int i,AttnUnit&u)const{ if(i>=4||vcu>=256)return false; const int s=vcu&3; u.bh=vcu>>2; u.qb=(i==0)?s:(i==1)?7-s:(i==2)?8+s:15-s; return true; }
  __device__ __forceinline__ void a_ready(const AttnUnit&)const{}
  __device__ __forceinline__ void done(const AttnUnit&)const{}
};
struct QueueOrder {
  unsigned* ctr; __attribute__((address_space(3))) unsigned* slot; int x; int tid0;
  __device__ __forceinline__ bool next(int,AttnUnit&u)const{
    if(tid0==0){ const unsigned e=__hip_atomic_fetch_add(ctr,1u,__ATOMIC_RELAXED,__HIP_MEMORY_SCOPE_AGENT); *slot=e; }
    asm volatile("s_waitcnt vmcnt(0) lgkmcnt(0)\n\ts_barrier":::"memory");
    const unsigned e=*slot;
    asm volatile("s_waitcnt lgkmcnt(0)\n\ts_barrier":::"memory");
    if(e>=64u)return false; u.bh=(int)(e&3u)*8+x; u.qb=15-(int)(e>>2); return true; }
  __device__ __forceinline__ void a_ready(const AttnUnit&)const{}
  __device__ __forceinline__ void done(const AttnUnit&)const{}
};
template<class Sched,int THRL=8> __device__ __forceinline__ void attn_phase(char*lds,const AttnTensors&T,const Sched&S,int tid_in){
  AttnUnit u;
  for(int i=0;S.next(i,u);++i){ S.a_ready(u); attn_unit<THRL>(u.bh/NHEAD,u.bh%NHEAD,u.qb,T.Q,T.K,T.V,T.O,lds,tid_in); S.done(u); }
}
#undef SBAR
#undef WAIT_BAR
}
#define GAS __attribute__((address_space(1)))
#define LAS __attribute__((address_space(3)))
typedef unsigned short bf16;
typedef unsigned v4u __attribute__((ext_vector_type(4)));
typedef float f32x4 __attribute__((ext_vector_type(4)));
typedef short bf16x8 __attribute__((ext_vector_type(8)));
typedef GAS unsigned gu32;
typedef GAS unsigned long long gu64;
#define RLX_AGENT __ATOMIC_RELAXED, __HIP_MEMORY_SCOPE_AGENT
#define LDS_WAIT() asm volatile("s_waitcnt lgkmcnt(0)" ::: "memory")
#define VM_WAIT() asm volatile("s_waitcnt vmcnt(0)" ::: "memory")
__device__ __forceinline__ unsigned long long rt() { return __builtin_amdgcn_s_memrealtime(); }
__device__ __forceinline__ unsigned f2bf(float f) { unsigned u = __builtin_bit_cast(unsigned, f); return (u + 0x7fffu + ((u >> 16) & 1u)) >> 16; }
__device__ __forceinline__ unsigned pk2(float lo, float hi) { return f2bf(lo) | (f2bf(hi) << 16); }

#define XB_TMO      128
#define XB_XCNT(j)  (256  + 64 * (j))
#define XB_XSUB(j)  (1280 + 64 * (j))
#define XB_XGEN(j)  (2304 + 64 * (j))
#define XB_TOP      3328
#define XB_TOPGEN   3392
#define XCD_BAR_WORDS 3456
#define XB_SPIN_CAP (1u << 18)

__device__ __forceinline__ unsigned xb_ld(unsigned* p)              { return __hip_atomic_load(p, __ATOMIC_RELAXED, __HIP_MEMORY_SCOPE_AGENT); }
__device__ __forceinline__ unsigned xb_add(unsigned* p, unsigned v) { return __hip_atomic_fetch_add(p, v, __ATOMIC_RELAXED, __HIP_MEMORY_SCOPE_AGENT); }
__device__ __forceinline__ unsigned xb_xcc_id() { return (unsigned)__builtin_amdgcn_s_getreg((3 << 11) | 20) & 0xFu; }
#define XB_SPIN(cond, bar) do { unsigned _sp = 0; while (cond) { __builtin_amdgcn_s_sleep(1); \
    if ((++_sp & 255u) == 0u) { if (xb_ld(&(bar)[XB_TMO])) break; if (_sp > XB_SPIN_CAP) { atomicAdd(&(bar)[XB_TMO], 1u); break; } } } } while (0)

struct XcdBarrier {
    unsigned* bar; unsigned x; int wv;
    volatile LAS unsigned* st;
};

__device__ __forceinline__ XcdBarrier xcd_barrier_post(unsigned* bar, volatile LAS unsigned* st) {
    XcdBarrier b; b.bar = bar; b.x = xb_xcc_id(); b.st = st;
    if (threadIdx.x == 0) (void)xb_add(&bar[XB_XCNT(b.x)], 1u);
    return b;
}
__device__ __forceinline__ void xcd_barrier_complete(unsigned* bar, unsigned x, unsigned& nloc, unsigned& nx) {
    const unsigned G = gridDim.x * gridDim.y * gridDim.z;
    unsigned sum, cnt, mine, sp = 0u;
    for (;;) {
        sum = 0u; cnt = 0u; mine = 0u;
#pragma unroll
        for (unsigned j = 0; j < 16; ++j) { const unsigned c = xb_ld(&bar[XB_XCNT(j)]); sum += c; cnt += (c > 0u) ? 1u : 0u; mine = (j == x) ? c : mine; }
        if (sum == G) break;
        __builtin_amdgcn_s_sleep(1);
        if ((++sp & 255u) == 0u) { if (xb_ld(&bar[XB_TMO])) break; if (sp > XB_SPIN_CAP) { atomicAdd(&bar[XB_TMO], 1u); break; } }
    }
    nloc = mine > 0u ? mine : 1u; nx = cnt > 0u ? cnt : 1u;
}

__device__ __forceinline__ void xcd_barrier(const XcdBarrier& b) {
    asm volatile("s_waitcnt vmcnt(0)" ::: "memory");
    __syncthreads();
    unsigned ln_; asm volatile("v_mbcnt_lo_u32_b32 %0, -1, 0\n\tv_mbcnt_hi_u32_b32 %0, -1, %0" : "=v"(ln_));
    if (b.wv == 0 && ln_ == 0u) {
        unsigned* bar = b.bar;
        __builtin_amdgcn_s_waitcnt(0);
        unsigned nloc = b.st[0], nx = b.st[1];
        if (nloc == 0u) { xcd_barrier_complete(bar, b.x, nloc, nx); b.st[0] = nloc; b.st[1] = nx; }
        const unsigned old = xb_add(&bar[XB_XSUB(b.x)], 1u);
        const unsigned gen = old / nloc;
        if (old + 1u == (gen + 1u) * nloc) {
            __builtin_amdgcn_fence(__ATOMIC_RELEASE, "agent");
            asm volatile("s_waitcnt vmcnt(0)" ::: "memory");
            const unsigned og = xb_add(&bar[XB_TOP], 1u);
            const unsigned tg = og / nx;
            if (og + 1u == (tg + 1u) * nx) xb_add(&bar[XB_TOPGEN], 1u);
            else XB_SPIN(xb_ld(&bar[XB_TOPGEN]) == tg, bar);
            __builtin_amdgcn_fence(__ATOMIC_ACQUIRE, "agent");
            xb_add(&bar[XB_XGEN(b.x)], 1u);
            asm volatile("s_waitcnt vmcnt(0)" ::: "memory");
        } else {
            XB_SPIN(xb_ld(&bar[XB_XGEN(b.x)]) == gen, bar);
            __builtin_amdgcn_fence(__ATOMIC_ACQUIRE, "agent");
            asm volatile("s_waitcnt vmcnt(0)" ::: "memory");
        }
    }
    __syncthreads();
}

constexpr int NWAVES = 8;
constexpr int DM = 1024, NB = 4, SEQ = 4096, NMETA = 16, DEPTH = 4;
constexpr int NREAL = NB * SEQ;
constexpr int NTOK = NREAL + NMETA;
constexpr int MPAD = 16640;
constexpr int INC = 3200, INP = 3328;
constexpr int RCOLS = 896, QOFF = 896, KOFF = 896 + 512, VOFF = 896 + 1024, COFF = 2432;
constexpr int FF = 2816, FF2 = 5632, NE = 8;
constexpr int KVROWS = 128 + SEQ;
constexpr int MOEP = 35072;
constexpr float C2Q = 0.125f * 1.4426950408889634f;

constexpr size_t MiB = 1u << 20;
constexpr size_t WS_CTL = 0, CTL_ZERO_BYTES = 1 * MiB;
constexpr size_t WS_COS = 1 * MiB, WS_SIN = 1 * MiB + 192 * 1024;
constexpr size_t WS_RSTD = 1 * MiB + 512 * 1024;
constexpr size_t WS_RSROW = 1 * MiB + 768 * 1024;
constexpr size_t WS_TOKE = 2 * MiB, WS_TOKS = 2 * MiB + 256 * 1024, WS_TOKG = 2 * MiB + 512 * 1024;
constexpr size_t WS_WIN = 4 * MiB;
constexpr size_t WS_WOUT = 30 * MiB;
constexpr size_t WS_WGU = 38 * MiB;
constexpr size_t WS_WD = 60 * MiB;
constexpr size_t WS_MWGU = 72 * MiB;
constexpr size_t WS_MWD = 160 * MiB;
constexpr size_t WS_H = 204 * MiB;
constexpr size_t WS_HB = 269 * MiB;
constexpr size_t WS_PH = 302 * MiB;
constexpr size_t WS_PROJ = WS_PH;
constexpr size_t WS_QN = 408 * MiB;
constexpr size_t WS_KP = 425 * MiB;
constexpr size_t WS_VP = 442 * MiB;
constexpr size_t WS_OC = 459 * MiB;
constexpr size_t WS_OMIX = 492 * MiB;
constexpr size_t WS_SC = 525 * MiB, SC_STRIDE = 17 * MiB;
constexpr size_t WS_MIX_END = WS_SC + 9 * SC_STRIDE;
constexpr size_t WS_G = WS_PH;
constexpr size_t WS_AROWS = 491 * MiB;
constexpr size_t WS_YM = 560 * MiB;
constexpr size_t WS_LORA = 680 * MiB;
constexpr size_t WS_END = 714 * MiB;
static_assert(WS_PROJ + (size_t)MPAD * INP * 2 <= WS_QN && WS_G + (size_t)MOEP * FF * 2 <= WS_AROWS && WS_AROWS + (size_t)MOEP * 1024 * 2 <= WS_YM && WS_YM + (size_t)MOEP * 1024 * 2 <= WS_END, "ws map");
static_assert((size_t)8 * FF2 * DM <= 44 * MiB && 44 * MiB + (size_t)4112 * 11008 + 1024 <= 88 * MiB && (size_t)4112 * 8192 <= (size_t)MPAD * 2048, "chunk buffers");
static_assert(WS_H + (size_t)MPAD * 1024 * 4 <= WS_HB && WS_HB + (size_t)MPAD * 1024 * 2 <= WS_PH && WS_MIX_END <= WS_END, "ws map 2");
static_assert((size_t)NTOK * 256 * 4 <= SC_STRIDE && WS_OC + (size_t)NTOK * 2048 <= WS_OMIX && WS_OMIX + (size_t)MPAD * 2048 <= WS_SC, "ws map 3");
constexpr int CW_MOECNT = 1024;
constexpr int CW_BAR = 4096;
constexpr int CW_ATTQ = 8192;

constexpr int LDS_BYTES = 147456;
constexpr int MISC_OFF = LDS_BYTES - 128;

struct Args { const float* in[32]; float* out; unsigned char* ws; int ph_lo, ph_hi; };

__device__ __forceinline__ v4u zero_v4u() { unsigned z; asm volatile("v_mov_b32 %0, 0" : "=v"(z)); return (v4u){z, z, z, z}; }
__device__ __forceinline__ unsigned pk4_fp8(float a, float b, float c, float d) {
    a = __builtin_amdgcn_fmed3f(a, -448.f, 448.f); b = __builtin_amdgcn_fmed3f(b, -448.f, 448.f); c = __builtin_amdgcn_fmed3f(c, -448.f, 448.f); d = __builtin_amdgcn_fmed3f(d, -448.f, 448.f);
    unsigned p = (unsigned)__builtin_amdgcn_cvt_pk_fp8_f32(a, b, 0, false); return (unsigned)__builtin_amdgcn_cvt_pk_fp8_f32(c, d, (int)p, true); }
#ifndef INP8_MASK
#define INP8_MASK 0xC
#endif
constexpr int INP8 = INP8_MASK;
constexpr float W8_SCALE = 64.f, A8_SCALE = 16.f, G8_SCALE = 4.f, H8_SCALE = 4.f;
__device__ __forceinline__ float bf2f(unsigned short b) { return __uint_as_float(((unsigned)b) << 16); }
#define DPP_F(x, ctrl) __int_as_float(__builtin_amdgcn_update_dpp(0, __float_as_int(x), ctrl, 0xF, 0xF, true))
__device__ __forceinline__ float lane_xor1(float v) { return DPP_F(v, 0xB1); }
__device__ __forceinline__ float sum8(float v) { v += DPP_F(v, 0xB1); v += DPP_F(v, 0x4E); v += DPP_F(v, 0x141); return v; }
__device__ __forceinline__ float sum16(float v) { v = sum8(v); v += DPP_F(v, 0x140); return v; }
__device__ __forceinline__ float wave_sum_dpp(float p) {
    p = sum16(p);
    asm volatile("s_nop 1\n\tv_add_f32_dpp %0, %0, %0 row_bcast:15 row_mask:0xa bank_mask:0xf\n\ts_nop 1\n\tv_add_f32_dpp %0, %0, %0 row_bcast:31 row_mask:0xc bank_mask:0xf\n\ts_nop 0" : "+v"(p));
    return __int_as_float(__builtin_amdgcn_readlane(__float_as_int(p), 63));
}
__device__ __forceinline__ float wave_sum(float v) { return wave_sum_dpp(v); }
__device__ __forceinline__ float wave_max(float v) {
    v = fmaxf(v, DPP_F(v, 0xB1)); v = fmaxf(v, DPP_F(v, 0x4E)); v = fmaxf(v, DPP_F(v, 0x141)); v = fmaxf(v, DPP_F(v, 0x140));
    asm volatile("s_nop 1\n\tv_max_f32_dpp %0, %0, %0 row_bcast:15 row_mask:0xa bank_mask:0xf\n\ts_nop 1\n\tv_max_f32_dpp %0, %0, %0 row_bcast:31 row_mask:0xc bank_mask:0xf\n\ts_nop 0" : "+v"(v));
    return __int_as_float(__builtin_amdgcn_readlane(__float_as_int(v), 63));
}
__device__ __forceinline__ float sigmoidf_(float x) { return 1.f / (1.f + __expf(-x)); }
__device__ __forceinline__ int prevrow(int row) { if (row < 0) return -1; if (row >= NREAL) return row == NREAL ? -1 : row - 1; return (row & (SEQ - 1)) == 0 ? NTOK - 1 : row - 1; }

__device__ __forceinline__ void tr_item(const float* W, int K, int N, bf16* WT, int rowmode, const float* gk, LAS float* scr, int item, int lane) {
    const int nblk = N / 32, kb = item / nblk, nb = item % nblk, k0 = 64 * kb, n0 = 32 * nb;
    const float* src = W + (size_t)(k0 + (lane >> 5)) * N + n0 + (lane & 31);
    float v[32];
#pragma unroll
    for (int i = 0; i < 32; ++i) v[i] = src[(size_t)(2 * i) * N];
#pragma unroll
    for (int i = 0; i < 32; ++i) scr[(2 * i + (lane >> 5)) * 33 + (lane & 31)] = v[i];
    LDS_WAIT(); asm volatile("" ::: "memory");
    const int c = lane & 7;
    f32x4 g0 = (f32x4){1.f, 1.f, 1.f, 1.f}, g1 = g0;
    if (gk) { g0 = *(const f32x4*)(gk + k0 + 8 * c); g1 = *(const f32x4*)(gk + k0 + 8 * c + 4); }
#pragma unroll
    for (int j = 0; j < 4; ++j) { const int n = (lane >> 3) + 8 * j; const LAS float* s = scr + (8 * c) * 33 + n;
        v4u o; o.x = pk2(s[0 * 33] * g0.x, s[1 * 33] * g0.y); o.y = pk2(s[2 * 33] * g0.z, s[3 * 33] * g0.w); o.z = pk2(s[4 * 33] * g1.x, s[5 * 33] * g1.y); o.w = pk2(s[6 * 33] * g1.z, s[7 * 33] * g1.w);
        const int nn = n0 + n; const int drow = rowmode == 0 ? nn : ((nn >> 7) * 256 + (nn & 127) + (rowmode == 2 ? 128 : 0));
        *(GAS v4u*)(WT + (size_t)drow * K + k0 + 8 * c) = o; }
    LDS_WAIT(); asm volatile("" ::: "memory");
}

__device__ __forceinline__ void tr_item2(const float* W0, int K0, int N0, bf16* WT0, int rm0, const float* gk0, int item0,
                                         const float* W1, int K1, int N1, bf16* WT1, int rm1, const float* gk1, int item1, LAS float* scr, int lane, bool f8_0 = false, bool f8_1 = false) {
    const int nb0_ = N0 / 32, nb1_ = N1 / 32;
    const int k00 = 64 * (item0 / nb0_), n00 = 32 * (item0 % nb0_), k01 = 64 * (item1 / nb1_), n01 = 32 * (item1 % nb1_);
    const float* s0 = W0 + (size_t)(k00 + (lane >> 5)) * N0 + n00 + (lane & 31); const float* s1 = W1 + (size_t)(k01 + (lane >> 5)) * N1 + n01 + (lane & 31);
    float v0[32], v1[32];
#pragma unroll
    for (int i = 0; i < 32; ++i) { v0[i] = s0[(size_t)(2 * i) * N0]; v1[i] = s1[(size_t)(2 * i) * N1]; }
    LAS float* t0 = scr; LAS float* t1 = scr + 64 * 33;
#pragma unroll
    for (int i = 0; i < 32; ++i) { t0[(2 * i + (lane >> 5)) * 33 + (lane & 31)] = v0[i]; t1[(2 * i + (lane >> 5)) * 33 + (lane & 31)] = v1[i]; }
    LDS_WAIT(); asm volatile("" ::: "memory");
    const int c = lane & 7;
#pragma unroll
    for (int q = 0; q < 2; ++q) { const float* gk = q ? gk1 : gk0; const int k0 = q ? k01 : k00, n0 = q ? n01 : n00, K = q ? K1 : K0, rowmode = q ? rm1 : rm0; bf16* WT = q ? WT1 : WT0; const LAS float* tt = q ? t1 : t0;
        f32x4 g0 = (f32x4){1.f, 1.f, 1.f, 1.f}, g1 = g0;
        if (gk) { g0 = *(const f32x4*)(gk + k0 + 8 * c); g1 = *(const f32x4*)(gk + k0 + 8 * c + 4); }
#pragma unroll
        for (int j = 0; j < 4; ++j) { const int n = (lane >> 3) + 8 * j; const LAS float* s = tt + (8 * c) * 33 + n;
            v4u o; o.x = pk2(s[0 * 33] * g0.x, s[1 * 33] * g0.y); o.y = pk2(s[2 * 33] * g0.z, s[3 * 33] * g0.w); o.z = pk2(s[4 * 33] * g1.x, s[5 * 33] * g1.y); o.w = pk2(s[6 * 33] * g1.z, s[7 * 33] * g1.w);
            const int nn = n0 + n; const int drow = rowmode == 0 ? nn : ((nn >> 7) * 256 + (nn & 127) + (rowmode == 2 ? 128 : 0));
            if (q ? f8_1 : f8_0) { const unsigned lo = pk4_fp8(s[0 * 33] * g0.x * W8_SCALE, s[1 * 33] * g0.y * W8_SCALE, s[2 * 33] * g0.z * W8_SCALE, s[3 * 33] * g0.w * W8_SCALE), hi8 = pk4_fp8(s[4 * 33] * g1.x * W8_SCALE, s[5 * 33] * g1.y * W8_SCALE, s[6 * 33] * g1.z * W8_SCALE, s[7 * 33] * g1.w * W8_SCALE);
                *(GAS unsigned long long*)((GAS unsigned char*)WT + (size_t)drow * K + k0 + 8 * c) = (unsigned long long)lo | ((unsigned long long)hi8 << 32); }
            else *(GAS v4u*)(WT + (size_t)drow * K + k0 + 8 * c) = o; } }
    LDS_WAIT(); asm volatile("" ::: "memory");
}

__device__ __forceinline__ void meta_gemm_res(const bf16* A, int K, const bf16* Bt, float* Hm, LAS unsigned char* lds, int bx, int wave, int lane, int hbmode = 0, bf16* HBm = nullptr, unsigned long long* rsqm = nullptr) {
    if (bx < 32) {
        typedef short bfx8 __attribute__((ext_vector_type(8)));
        const int ct = 2 * bx + (wave >> 2), ksp = wave & 3, n = lane & 15, kq = lane >> 4; const int kc = K >> 2, steps = kc >> 5;
        const bf16* ap = A + (size_t)n * K + ksp * kc + 8 * kq; const bf16* wp = Bt + (size_t)(16 * ct + n) * K + ksp * kc + 8 * kq;
        f32x4 acc = (f32x4){0.f, 0.f, 0.f, 0.f};
#pragma unroll 11
        for (int s = 0; s < steps; ++s) { const v4u a = *(const v4u*)(wp + 32 * s), b = *(const v4u*)(ap + 32 * s);
            acc = __builtin_amdgcn_mfma_f32_16x16x32_bf16(__builtin_bit_cast(bfx8, a), __builtin_bit_cast(bfx8, b), acc, 0, 0, 0); }
        LAS f32x4* red = (LAS f32x4*)lds;
        red[wave * 64 + lane] = acc;
        __syncthreads();
        if (ksp == 0) { const f32x4 s = (red[wave * 64 + lane] + red[(wave + 1) * 64 + lane]) + (red[(wave + 2) * 64 + lane] + red[(wave + 3) * 64 + lane]);
            f32x4* hp = (f32x4*)(Hm + (size_t)n * 1024 + 16 * ct + 4 * kq); const f32x4 hn = *hp + s; *hp = hn;
            if (hbmode) { const int cc = 16 * ct + 4 * kq;
                if (hbmode == 1) *(unsigned long long*)(HBm + (size_t)n * 1024 + cc) = (unsigned long long)pk2(hn.x, hn.y) | ((unsigned long long)pk2(hn.z, hn.w) << 32);
                else *(unsigned*)((unsigned char*)HBm + (size_t)n * 1024 + cc) = pk4_fp8(hn.x * H8_SCALE, hn.y * H8_SCALE, hn.z * H8_SCALE, hn.w * H8_SCALE);
                __hip_atomic_fetch_add(rsqm + n, (unsigned long long)(((hn.x * hn.x + hn.y * hn.y) + (hn.z * hn.z + hn.w * hn.w)) * 16777216.f), RLX_AGENT); } }
        __syncthreads();
    }
}

__device__ __forceinline__ void meta_gemm_res8(const unsigned char* A, int K, const unsigned char* Bt, float* Hm, float sc, LAS unsigned char* lds, int bx, int wave, int lane) {
    if (bx < 32) {
        typedef int v8i_ __attribute__((ext_vector_type(8)));
        const int ct = 2 * bx + (wave >> 2), ksp = wave & 3, n = lane & 15, kq = lane >> 4; const int kc = K >> 2, steps = kc >> 7;
        const int s0 = ksp < 2 ? 6 * ksp : 12 + 5 * (ksp - 2), ns = ksp < 2 ? 6 : 5; (void)kc; (void)steps;
        const unsigned char* ap = A + (size_t)n * K + 32 * kq; const unsigned char* wp = Bt + (size_t)(16 * ct + n) * K + 32 * kq;
        f32x4 acc = (f32x4){0.f, 0.f, 0.f, 0.f};
#pragma unroll 6
        for (int s = s0; s < s0 + ns; ++s) { const v4u a0 = *(const v4u*)(wp + 128 * s), a1 = *(const v4u*)(wp + 128 * s + 16), b0 = *(const v4u*)(ap + 128 * s), b1 = *(const v4u*)(ap + 128 * s + 16);
            const v8i_ aa = (v8i_){(int)a0.x, (int)a0.y, (int)a0.z, (int)a0.w, (int)a1.x, (int)a1.y, (int)a1.z, (int)a1.w}, bb = (v8i_){(int)b0.x, (int)b0.y, (int)b0.z, (int)b0.w, (int)b1.x, (int)b1.y, (int)b1.z, (int)b1.w};
            acc = __builtin_amdgcn_mfma_scale_f32_16x16x128_f8f6f4(aa, bb, acc, 0, 0, 0, 0x7f7f7f7f, 0, 0x7f7f7f7f); }
        LAS f32x4* red = (LAS f32x4*)lds;
        red[wave * 64 + lane] = acc;
        __syncthreads();
        if (ksp == 0) { const f32x4 s = (red[wave * 64 + lane] + red[(wave + 1) * 64 + lane]) + (red[(wave + 2) * 64 + lane] + red[(wave + 3) * 64 + lane]);
            f32x4* hp = (f32x4*)(Hm + (size_t)n * 1024 + 16 * ct + 4 * kq); *hp = *hp + s * sc; }
        __syncthreads();
    }
}

__global__ void __launch_bounds__(NWAVES * 64, 2) hymba_fwd(Args args) {
    extern __shared__ __attribute__((aligned(16))) unsigned char lds_raw[];
    LAS unsigned char* lds = (LAS unsigned char*)lds_raw;
    volatile LAS unsigned* MISC = (volatile LAS unsigned*)(lds + MISC_OFF);
    const int wave = __builtin_amdgcn_readfirstlane((int)threadIdx.x >> 6);
#define PH_TID int tid; asm volatile("v_mbcnt_lo_u32_b32 %0, -1, 0\n\tv_mbcnt_hi_u32_b32 %0, -1, %0" : "=v"(tid)); tid += wave * 64; const int lane = tid & 63; (void)lane; unsigned char* ws = ws0; asm volatile("" : "+s"(ws)); const char* ka = ka0; asm volatile("" : "+s"(ka)); (void)ka
    const int G = gridDim.x, bx = blockIdx.x;
    const int gw = bx * NWAVES + wave, NGW = G * NWAVES;
    unsigned char* const ws0 = args.ws;
    const char* const ka0 = (const char*)__builtin_amdgcn_kernarg_segment_ptr();
    { const int t0_ = (int)threadIdx.x; if (t0_ < 32) ((LAS unsigned*)(lds + MISC_OFF))[t0_] = 0u; }
    __syncthreads();
    const int lo = args.ph_lo, hi = args.ph_hi;
    const bool multi = (hi - lo) > 1;
    XcdBarrier bar; bar.bar = (unsigned*)(ws0 + WS_CTL) + CW_BAR; bar.x = 0; bar.st = nullptr; bar.wv = wave;
    if (multi) { bar = xcd_barrier_post((unsigned*)(ws0 + WS_CTL) + CW_BAR, MISC + 8); bar.wv = wave; }
#ifndef ENMASK
#define ENMASK 0xFFFF
#endif
#define EN(k) (((ENMASK) >> (k)) & 1)
#ifndef REPMASK
#define REPMASK 0
#endif
#define NREP(k) ((((REPMASK) >> (k)) & 1) ? 2 : 1)
#define IN(k) (lo <= (k) && (k) < hi)
#define SEAM(k) do { if (hi > (k) + 1) xcd_barrier(bar); } while (0)

#define Hf ((float*)(ws + WS_H))
#define HB ((bf16*)(ws + WS_HB))
#define RSTD ((float*)(ws + WS_RSTD))
#define PROJ ((bf16*)(ws + WS_PROJ))
#define QN ((bf16*)(ws + WS_QN))
#define KP ((bf16*)(ws + WS_KP))
#define VP ((bf16*)(ws + WS_VP))
#define OC ((bf16*)(ws + WS_OC))
#define OMIX ((bf16*)(ws + WS_OMIX))
#define SP4 ((f32x4*)(ws + WS_SC + 0 * SC_STRIDE))
#define SR ((float*)(ws + WS_SC + 4 * SC_STRIDE))
#define SV ((float*)(ws + WS_SC + 5 * SC_STRIDE))
#define SG ((float*)(ws + WS_SC + 6 * SC_STRIDE))
#define SBON ((float*)(ws + WS_SC + 7 * SC_STRIDE))
#define SY ((float*)(ws + WS_SC + 8 * SC_STRIDE))
#define COS ((float*)(ws + WS_COS))
#define SIN ((float*)(ws + WS_SIN))
#define GB ((bf16*)(ws + WS_G))
#define AROWS ((bf16*)(ws + WS_AROWS))
#define YM ((bf16*)(ws + WS_YM))
#define RSQA ((unsigned long long*)(ws + WS_RSROW))
#define TOKE ((int*)(ws + WS_TOKE))
#define TOKS ((int*)(ws + WS_TOKS))
#define TOKG ((float*)(ws + WS_TOKG))
#define ctl ((gu32*)(ws + WS_CTL))
#define INP(i) (*(const float* const*)(ka + 8 * (i)))
#define LORA_W ((float*)(ws + WS_LORA))
#define LORA_AG ((bf16*)(ws + WS_LORA + 17 * MiB))
#define CH_REC ((unsigned char*)(ws + WS_MWGU + 44 * MiB))
#define CH_RB 11008
#define CH_SPK ((unsigned char*)(ws + WS_HB))
#ifndef SCAN_CHUNKED
#define SCAN_CHUNKED 1
#endif

    for (int rep_ = 0; rep_ < NREP(15); ++rep_) if (EN(15) && IN(0)) { PH_TID;
        LAS float* scr = (LAS float*)(lds + wave * 17408);
        constexpr int I_IN = 16 * 100, I_OUT = 16 * 32, I_GU = 16 * 88, I_DN = 44 * 32;
        constexpr int NITEMS = DEPTH * (I_IN + I_OUT) + 2 * (2 * I_GU + I_DN);
        for (int it0 = 2 * gw; it0 < NITEMS; it0 += 2 * NGW) {
            const float* W_[2]; bf16* D_[2]; int K_[2], N_[2], rm_[2], r_[2]; const float* g_[2]; bool f8_[2] = {false, false};
#pragma unroll
            for (int q = 0; q < 2; ++q) { int r = it0 + q;
                if (r < DEPTH * I_IN) { const int l = r / I_IN; W_[q] = INP(3) + (size_t)l * DM * INC; K_[q] = DM; N_[q] = INC; D_[q] = (bf16*)(ws + WS_WIN) + (size_t)l * INP * DM; rm_[q] = 0; g_[q] = INP(2) + l * DM; r_[q] = r % I_IN; f8_[q] = ((INP8 >> l) & 1) != 0; continue; } r -= DEPTH * I_IN;
                if (r < DEPTH * I_OUT) { const int l = r / I_OUT; W_[q] = INP(23) + (size_t)l * DM * DM; K_[q] = DM; N_[q] = DM; D_[q] = (bf16*)(ws + WS_WOUT) + (size_t)l * DM * DM; rm_[q] = 0; g_[q] = nullptr; r_[q] = r % I_OUT; continue; } r -= DEPTH * I_OUT;
                if (r < 2 * I_GU) { const int j = r / I_GU; W_[q] = INP(25) + (size_t)j * DM * FF; K_[q] = DM; N_[q] = FF; D_[q] = (bf16*)(ws + WS_WGU) + (size_t)j * FF2 * DM; rm_[q] = 1; g_[q] = INP(24) + (2 * j) * DM; r_[q] = r % I_GU; f8_[q] = (j == 1); continue; } r -= 2 * I_GU;
                if (r < 2 * I_GU) { const int j = r / I_GU; W_[q] = INP(26) + (size_t)j * DM * FF; K_[q] = DM; N_[q] = FF; D_[q] = (bf16*)(ws + WS_WGU) + (size_t)j * FF2 * DM; rm_[q] = 2; g_[q] = INP(24) + (2 * j) * DM; r_[q] = r % I_GU; f8_[q] = (j == 1); continue; } r -= 2 * I_GU;
                { const int j = r / I_DN; W_[q] = INP(27) + (size_t)j * FF * DM; K_[q] = FF; N_[q] = DM; D_[q] = (bf16*)(ws + WS_WD) + (size_t)j * DM * FF; rm_[q] = 0; g_[q] = nullptr; r_[q] = r % I_DN; f8_[q] = (j == 1); } }
            tr_item2(W_[0], K_[0], N_[0], D_[0], rm_[0], g_[0], r_[0], W_[1], K_[1], N_[1], D_[1], rm_[1], g_[1], r_[1], scr, lane, f8_[0], f8_[1]);
        }
        const int gt = bx * (NWAVES * 64) + tid, NGT = G * NWAVES * 64;
        for (int i = gt; i < DEPTH * 128 * (DM / 8); i += NGT) { const int l = i / (128 * (DM / 8)), r = i % (128 * (DM / 8));
            if ((INP8 >> l) & 1) { if (r < 128 * (DM / 16)) ((v4u*)((unsigned char*)(ws + WS_WIN) + (size_t)l * INP * DM * 2 + (size_t)INC * DM))[r] = zero_v4u(); }
            else ((v4u*)((bf16*)(ws + WS_WIN) + ((size_t)l * INP + INC) * DM))[r] = zero_v4u(); }
        for (int row = gw; row < MPAD; row += NGW) {
            f32x4 v[4]; float s = 0.f;
#pragma unroll
            for (int j = 0; j < 4; ++j) { const int c4 = lane + 64 * j; v[j] = __builtin_bit_cast(f32x4, zero_v4u());
                if (row < NREAL) v[j] = ((const f32x4*)INP(0))[(size_t)row * (DM / 4) + c4]; else if (row < NTOK) v[j] = ((const f32x4*)INP(1))[(row - NREAL) * (DM / 4) + c4];
                ((f32x4*)Hf)[(size_t)row * (DM / 4) + c4] = v[j]; s += (v[j].x * v[j].x + v[j].y * v[j].y) + (v[j].z * v[j].z + v[j].w * v[j].w); }
            if (row < NTOK) { s = wave_sum(s); const float rstd = 1.f / sqrtf(s * (1.f / DM) + 1e-6f);
                if (INP8 & 1) { const float sn = rstd * A8_SCALE;
#pragma unroll
                    for (int j = 0; j < 4; ++j) ((unsigned*)((unsigned char*)HB + (size_t)row * DM))[lane + 64 * j] = pk4_fp8(v[j].x * sn, v[j].y * sn, v[j].z * sn, v[j].w * sn); }
                else {
#pragma unroll
                    for (int j = 0; j < 4; ++j) ((unsigned long long*)(HB + (size_t)row * DM))[lane + 64 * j] = (unsigned long long)pk2(v[j].x, v[j].y) | ((unsigned long long)pk2(v[j].z, v[j].w) << 32); }
                if (lane == 0) RSTD[row] = rstd; }
        }
        if (INP8 & 1) { for (int i = gt; i < (MPAD - NTOK) * (DM / 16); i += NGT) ((v4u*)((unsigned char*)HB + (size_t)NTOK * DM))[i] = zero_v4u(); }
        else
        for (int i = gt; i < (MPAD - NTOK) * (DM / 8); i += NGT) ((v4u*)(HB + (size_t)NTOK * DM))[i] = zero_v4u();
        for (int i = gt; i < MPAD - NTOK; i += NGT) RSTD[NTOK + i] = 0.f;
        for (int i = gt; i < (SEQ + NMETA) * 8; i += NGT) { const int pos = i >> 3, j = i & 7;
            const float invf = j == 0 ? 1.000000000e+00f : j == 1 ? 1.939227432e-01f : j == 2 ? 3.760603070e-02f : j == 3 ? 7.292664610e-03f : j == 4 ? 1.414213562e-03f : j == 5 ? 2.742481884e-04f : j == 6 ? 5.318296098e-05f : 1.031338616e-05f;
            const float angf = (float)pos * invf; const double a = (double)angf; const double n = __builtin_rint(a * 0.15915494309189535);
            const double rr = (a - n * 6.283185307179586) - n * 2.4492935982947064e-16; const float rev = (float)(rr * 0.15915494309189535);
            COS[i] = __builtin_amdgcn_cosf(rev); SIN[i] = __builtin_amdgcn_sinf(rev); }
        SEAM(0);
    }

#pragma nounroll
    for (int layer = 0; layer < DEPTH; ++layer) {
        const int pb = 1 + 12 * layer; const bool moe = (layer & 1) != 0; const int jj = layer >> 1;
        if (hi <= pb || lo >= pb + 12) continue;
        const float lam_init = 0.8f - 0.6f * __expf(-0.3f * (float)layer);

        for (int rep_ = 0; rep_ < NREP(0); ++rep_) if (EN(0) && IN(pb + 0) && moe) { PH_TID;
            f32x4 nv_[4];
            { const GAS f32x4* xr = (const GAS f32x4*)(Hf + (size_t)gw * DM) + lane;
#pragma unroll
              for (int j = 0; j < 4; ++j) nv_[j] = xr[64 * j]; }
            for (int row = gw; row < NTOK; row += NGW) {
                f32x4 v[4]; float s = 0.f;
#pragma unroll
                for (int j = 0; j < 4; ++j) v[j] = nv_[j];
                { const int rn_ = row + NGW < NTOK ? row + NGW : row; const GAS f32x4* xr = (const GAS f32x4*)(Hf + (size_t)rn_ * DM) + lane;
#pragma unroll
                  for (int j = 0; j < 4; ++j) nv_[j] = xr[64 * j]; }
#pragma unroll
                for (int j = 0; j < 4; ++j) s += (v[j].x * v[j].x + v[j].y * v[j].y) + (v[j].z * v[j].z + v[j].w * v[j].w);
                s = wave_sum(s); const float rstd = 1.f / sqrtf(s * (1.f / DM) + 1e-6f);
                if ((INP8 >> layer) & 1) { GAS unsigned* o4 = (GAS unsigned*)((GAS unsigned char*)HB + (size_t)row * DM) + lane; const float sn = rstd * A8_SCALE;
#pragma unroll
                    for (int j = 0; j < 4; ++j) o4[64 * j] = pk4_fp8(v[j].x * sn, v[j].y * sn, v[j].z * sn, v[j].w * sn); }
                else { GAS unsigned long long* o8 = (GAS unsigned long long*)(HB + (size_t)row * DM) + lane;
#pragma unroll
                    for (int j = 0; j < 4; ++j) o8[64 * j] = (unsigned long long)pk2(v[j].x, v[j].y) | ((unsigned long long)pk2(v[j].z, v[j].w) << 32); }
                if (lane == 0) RSTD[row] = rstd;
            }
            if ((INP8 >> layer) & 1) { const int gt = bx * (NWAVES * 64) + tid, NGT = G * NWAVES * 64;
                for (int i = gt; i < (MPAD - NTOK) * (DM / 16); i += NGT) ((v4u*)((unsigned char*)HB + (size_t)NTOK * DM))[i] = zero_v4u(); }
            if (moe) {
                LAS float* scr = (LAS float*)(lds + wave * 17408);
                constexpr int I_GU = 16 * 88, I_DN = 44 * 32, PER_E = 2 * I_GU + I_DN;
                const float* gff = INP(24) + layer * DM;
                for (int it0 = 2 * gw; it0 < NE * PER_E; it0 += 2 * NGW) {
                    const float* W_[2]; bf16* D_[2]; int K_[2], N_[2], rm_[2], r_[2]; const float* g_[2];
#pragma unroll
                    for (int q = 0; q < 2; ++q) { const int it = it0 + q; const int e = it / PER_E; int r = it % PER_E; const size_t eo = (size_t)(jj * NE + e) * DM * FF;
                        if (r < I_GU) { W_[q] = INP(29) + eo; K_[q] = DM; N_[q] = FF; D_[q] = (bf16*)(ws + WS_MWGU) + (size_t)e * FF2 * DM / 2; rm_[q] = 1; g_[q] = gff; }
                        else if (r < 2 * I_GU) { r -= I_GU; W_[q] = INP(30) + eo; K_[q] = DM; N_[q] = FF; D_[q] = (bf16*)(ws + WS_MWGU) + (size_t)e * FF2 * DM / 2; rm_[q] = 2; g_[q] = gff; }
                        else { r -= 2 * I_GU; W_[q] = INP(31) + eo; K_[q] = FF; N_[q] = DM; D_[q] = (bf16*)(ws + WS_MWD) + (size_t)e * DM * FF / 2; rm_[q] = 0; g_[q] = nullptr; }
                        r_[q] = r; }
                    tr_item2(W_[0], K_[0], N_[0], D_[0], rm_[0], g_[0], r_[0], W_[1], K_[1], N_[1], D_[1], rm_[1], g_[1], r_[1], scr, lane, true, true);
                }
            }
            SEAM(pb + 0);
        }
        for (int rep_ = 0; rep_ < NREP(1); ++rep_) if (EN(1) && IN(pb + 1)) { PH_TID;
            pg8::StaticOrder S; S.init(MPAD, INP, G, bx);
            if ((INP8 >> layer) & 1) { pg8::Gemm g{HB, (const bf16*)(ws + WS_WIN) + (size_t)layer * INP * DM, MPAD, INP, DM / 2}; pg8::EpiBf16Rs E{PROJ, INP, nullptr, 1.f / (W8_SCALE * A8_SCALE)};
                pg8::gemm_phase<pg8::EpiBf16Rs, pg8::StaticOrder, true, true, true>(lds, g, S, E, tid); }
            else { pg8::Gemm g{HB, (const bf16*)(ws + WS_WIN) + (size_t)layer * INP * DM, MPAD, INP, DM}; pg8::EpiBf16Rs E{PROJ, INP, RSTD, 1.f};
                pg8::gemm_phase<pg8::EpiBf16Rs, pg8::StaticOrder, true, true>(lds, g, S, E, tid); }
            SEAM(pb + 1);
        }
        for (int rep_ = 0; rep_ < NREP(2); ++rep_) if (EN(2) && IN(pb + 2)) { PH_TID;
            const int gt = bx * (NWAVES * 64) + tid, NGT = G * NWAVES * 64;
            if (tid < 65) { const v4u z_ = zero_v4u(); RSQA[bx * 65 + tid] = (unsigned long long)z_.x | ((unsigned long long)z_.y << 32); }
            for (int i = gt; i < NB * 112 * 64; i += NGT) { const int b = i / (112 * 64), r = (i / 64) % 112, c = i % 64; const int row = b * KVROWS + (r < 48 ? r : r + 16);
                ((v4u*)(KP + (size_t)row * 512))[c] = zero_v4u(); ((v4u*)(VP + (size_t)row * 512))[c] = zero_v4u(); }
            const int ngrp = (1025 - bx + 255) / 256, nrows = 16 * ngrp;
#define MP_ROW(idx) (16 * (bx + 256 * ((idx) >> 4)) + ((idx) & 15))
            LAS unsigned char* WT = lds;
            { const int nn = tid & 255, hf = tid >> 8;
              const float* sd = INP(6) + layer * 32 * 256 + (hf * 16) * 256 + nn; const float* sa = INP(8) + layer * 32 * 256 + (hf * 16) * 256 + nn; const float* sg = INP(9) + layer * 64 * 256 + (hf * 32) * 256 + nn;
              v4u wv[2];
#pragma unroll
              for (int i = 0; i < 2; ++i) { wv[i].x = pk2(sd[(8 * i) * 256], sd[(8 * i + 1) * 256]); wv[i].y = pk2(sd[(8 * i + 2) * 256], sd[(8 * i + 3) * 256]); wv[i].z = pk2(sd[(8 * i + 4) * 256], sd[(8 * i + 5) * 256]); wv[i].w = pk2(sd[(8 * i + 6) * 256], sd[(8 * i + 7) * 256]); }
              *(LAS v4u*)(WT + nn * 64 + hf * 32) = wv[0]; *(LAS v4u*)(WT + nn * 64 + hf * 32 + 16) = wv[1];
#pragma unroll
              for (int i = 0; i < 2; ++i) { wv[i].x = pk2(sa[(8 * i) * 256], sa[(8 * i + 1) * 256]); wv[i].y = pk2(sa[(8 * i + 2) * 256], sa[(8 * i + 3) * 256]); wv[i].z = pk2(sa[(8 * i + 4) * 256], sa[(8 * i + 5) * 256]); wv[i].w = pk2(sa[(8 * i + 6) * 256], sa[(8 * i + 7) * 256]); }
              *(LAS v4u*)(WT + 16384 + nn * 64 + hf * 32) = wv[0]; *(LAS v4u*)(WT + 16384 + nn * 64 + hf * 32 + 16) = wv[1];
#pragma unroll
              for (int i = 0; i < 4; ++i) { v4u t; t.x = pk2(sg[(8 * i) * 256], sg[(8 * i + 1) * 256]); t.y = pk2(sg[(8 * i + 2) * 256], sg[(8 * i + 3) * 256]); t.z = pk2(sg[(8 * i + 4) * 256], sg[(8 * i + 5) * 256]); t.w = pk2(sg[(8 * i + 6) * 256], sg[(8 * i + 7) * 256]);
                  *(LAS v4u*)(WT + 32768 + nn * 128 + hf * 64 + 16 * i) = t; } }
            __syncthreads();
            const float* mu = INP(4) + layer * RCOLS; const float* w0 = INP(5) + layer * 256; const float* a0 = INP(7) + layer * 256;
            const float* k_k = INP(10) + layer * 256; const float* k_a = INP(11) + layer * 256; const float* r_k = INP(12) + layer * 256;
            const float* qg = INP(15) + layer * 64; const float* kg = INP(16) + layer * 64; const float* cw = INP(22) + layer * 3 * 256;
            for (int rep3_ = 0; rep3_ < NREP(5); ++rep3_)
            if (wave < ngrp) {
                typedef attn_body::bf16x8 bfx8;
                const int rowbase = 16 * (bx + 256 * wave);
                LAS unsigned char* XT = lds + 65536 + wave * 4096;
                { const float mu0 = mu[768 + 2 * lane], mu1 = mu[768 + 2 * lane + 1]; const int p0 = prevrow(rowbase);
                  unsigned cur = p0 < 0 ? 0u : *(const unsigned*)(PROJ + (size_t)p0 * INP + 768 + 2 * lane); float pl = __uint_as_float(cur << 16), ph = __uint_as_float(cur & 0xffff0000u);
#pragma unroll
                  for (int r = 0; r < 16; ++r) { cur = *(const unsigned*)(PROJ + (size_t)(rowbase + r) * INP + 768 + 2 * lane); const float xl = __uint_as_float(cur << 16), xh = __uint_as_float(cur & 0xffff0000u);
                      float h0 = xl + (pl - xl) * mu0, h1 = xh + (ph - xh) * mu1; pl = xl; ph = xh;
                      if (lane < 16) { h0 = 1.f - 2.f / (1.f + __expf(2.f * h0)); h1 = 1.f - 2.f / (1.f + __expf(2.f * h1)); } else if (lane >= 32) { h0 = sigmoidf_(h0); h1 = sigmoidf_(h1); }
                      *(LAS unsigned*)(XT + r * 256 + 4 * lane) = pk2(h0, h1); } }
                LDS_WAIT();
                const int n = lane & 15, kq = lane >> 4;
                const v4u xd = *(const LAS v4u*)(XT + n * 256 + (8 * kq) * 2), xa = *(const LAS v4u*)(XT + n * 256 + (32 + 8 * kq) * 2);
                const v4u xg0 = *(const LAS v4u*)(XT + n * 256 + (64 + 8 * kq) * 2), xg1 = *(const LAS v4u*)(XT + n * 256 + (96 + 8 * kq) * 2);
                float* lw = LORA_W + (size_t)(rowbase + n) * 256 + 4 * kq; bf16* lag = LORA_AG + (size_t)(rowbase + n) * 512 + 4 * kq;
#pragma unroll 4
                for (int ct = 0; ct < 16; ++ct) {
                    const v4u ad = *(const LAS v4u*)(WT + (16 * ct + n) * 64 + (8 * kq) * 2), aa = *(const LAS v4u*)(WT + 16384 + (16 * ct + n) * 64 + (8 * kq) * 2);
                    const v4u ag0 = *(const LAS v4u*)(WT + 32768 + (16 * ct + n) * 128 + (8 * kq) * 2), ag1 = *(const LAS v4u*)(WT + 32768 + (16 * ct + n) * 128 + (32 + 8 * kq) * 2);
                    f32x4 dd = __builtin_amdgcn_mfma_f32_16x16x32_bf16(__builtin_bit_cast(bfx8, ad), __builtin_bit_cast(bfx8, xd), (f32x4){0.f, 0.f, 0.f, 0.f}, 0, 0, 0);
                    f32x4 da = __builtin_amdgcn_mfma_f32_16x16x32_bf16(__builtin_bit_cast(bfx8, aa), __builtin_bit_cast(bfx8, xa), (f32x4){0.f, 0.f, 0.f, 0.f}, 0, 0, 0);
                    f32x4 dg = __builtin_amdgcn_mfma_f32_16x16x32_bf16(__builtin_bit_cast(bfx8, ag0), __builtin_bit_cast(bfx8, xg0), (f32x4){0.f, 0.f, 0.f, 0.f}, 0, 0, 0);
                    dg = __builtin_amdgcn_mfma_f32_16x16x32_bf16(__builtin_bit_cast(bfx8, ag1), __builtin_bit_cast(bfx8, xg1), dg, 0, 0, 0);
                    *(f32x4*)(lw + 16 * ct) = dd;
                    *(unsigned long long*)(lag + 16 * ct) = (unsigned long long)pk2(da.x, da.y) | ((unsigned long long)pk2(da.z, da.w) << 32);
                    *(unsigned long long*)(lag + 256 + 16 * ct) = (unsigned long long)pk2(dg.x, dg.y) | ((unsigned long long)pk2(dg.z, dg.w) << 32);
                }
            }
            asm volatile("s_waitcnt vmcnt(0)" ::: "memory");
            __syncthreads();
#pragma nounroll
            for (int rep3_ = 0; rep3_ < NREP(10); ++rep3_)
            {
                typedef unsigned u32x2_ __attribute__((ext_vector_type(2)));
                const int sub = lane & 7; const int c4 = 4 * lane;
                const f32x4 qg0 = *(const f32x4*)(qg + 8 * sub), qg1 = *(const f32x4*)(qg + 8 * sub + 4), kg0 = *(const f32x4*)(kg + 8 * sub), kg1 = *(const f32x4*)(kg + 8 * sub + 4);
                const f32x4 cw0 = *(const f32x4*)(cw + c4), cw1 = *(const f32x4*)(cw + 256 + c4), cw2 = *(const f32x4*)(cw + 512 + c4);
                v4u rq, rk, rv; u32x2_ b0, g0_, u0, g1_, u1, g2_, u2;
#define AP_LOAD(rw) do { const int p1_ = prevrow(rw), p2_ = prevrow(p1_); const bf16* q_ = PROJ + (size_t)(rw) * INP; const bf16* q1_ = PROJ + (size_t)(p1_ < 0 ? (rw) : p1_) * INP; const bf16* q2_ = PROJ + (size_t)(p2_ < 0 ? (rw) : p2_) * INP; \
                    rq = *(const v4u*)(q_ + QOFF + 8 * lane); rk = *(const v4u*)(q_ + KOFF + 8 * lane); rv = *(const v4u*)(q_ + VOFF + 8 * lane); (void)q1_; (void)q2_; } while (0)
#define CV_LOAD(rw) do { const int p1_ = prevrow(rw), p2_ = prevrow(p1_); const bf16* q_ = PROJ + (size_t)(rw) * INP; const bf16* q1_ = PROJ + (size_t)(p1_ < 0 ? (rw) : p1_) * INP; const bf16* q2_ = PROJ + (size_t)(p2_ < 0 ? (rw) : p2_) * INP; \
                    b0 = *(const u32x2_*)(q_ + COFF + c4); g0_ = *(const u32x2_*)(q_ + COFF + 256 + c4); u0 = *(const u32x2_*)(q_ + COFF + 512 + c4); \
                    g1_ = *(const u32x2_*)(q1_ + COFF + 256 + c4); u1 = *(const u32x2_*)(q1_ + COFF + 512 + c4); g2_ = *(const u32x2_*)(q2_ + COFF + 256 + c4); u2 = *(const u32x2_*)(q2_ + COFF + 512 + c4); } while (0)
#define U2F4(t_) ((f32x4){__uint_as_float((t_).x << 16), __uint_as_float((t_).x & 0xffff0000u), __uint_as_float((t_).y << 16), __uint_as_float((t_).y & 0xffff0000u)})
                int idx = wave; AP_LOAD(MP_ROW(idx));
                for (; idx < nrows; idx += 8) { const int row = MP_ROW(idx);
                    const int p1 = prevrow(row), p2 = prevrow(p1); const float m1 = p1 < 0 ? 0.f : 1.f, m2 = p2 < 0 ? 0.f : 1.f;
                    const v4u cq = rq, ck = rk, cv = rv;
                    CV_LOAD(row);
                    if (idx + 8 < nrows) AP_LOAD(MP_ROW(idx + 8));
                    const int pos = row >= NREAL ? row - NREAL : NMETA + (row & (SEQ - 1));
                    const f32x4 c0 = *(const f32x4*)(COS + pos * 8), c1 = *(const f32x4*)(COS + pos * 8 + 4), n0 = *(const f32x4*)(SIN + pos * 8), n1 = *(const f32x4*)(SIN + pos * 8 + 4);
                    const float cs[8] = {c0.x, c0.y, c0.z, c0.w, c1.x, c1.y, c1.z, c1.w}; const float sn[8] = {n0.x, n0.y, n0.z, n0.w, n1.x, n1.y, n1.z, n1.w};
#pragma unroll
                    for (int which = 0; which < 2; ++which) {
                        const v4u raw = which ? ck : cq;
                        float x[8] = {__uint_as_float(raw.x << 16), __uint_as_float(raw.x & 0xffff0000u), __uint_as_float(raw.y << 16), __uint_as_float(raw.y & 0xffff0000u),
                                      __uint_as_float(raw.z << 16), __uint_as_float(raw.z & 0xffff0000u), __uint_as_float(raw.w << 16), __uint_as_float(raw.w & 0xffff0000u)};
                        float s2 = 0.f;
#pragma unroll
                        for (int i = 0; i < 8; ++i) s2 += x[i] * x[i];
                        s2 = sum8(s2);
                        const float rs = 1.f / sqrtf(s2 * (1.f / 64.f) + 1e-6f);
                        const f32x4 ga = which ? kg0 : qg0, gb = which ? kg1 : qg1;
                        const float gg[8] = {ga.x, ga.y, ga.z, ga.w, gb.x, gb.y, gb.z, gb.w};
                        float o[8];
#pragma unroll
                        for (int i = 0; i < 8; ++i) { const float xn = x[i] * rs * gg[i]; const float xp = lane_xor1(xn);
                            o[i] = sub == 0 ? xn * cs[i] - xp * sn[i] : (sub == 1 ? xn * cs[i] + xp * sn[i] : xn); if (!which) o[i] *= C2Q; }
                        v4u w; w.x = pk2(o[0], o[1]); w.y = pk2(o[2], o[3]); w.z = pk2(o[4], o[5]); w.w = pk2(o[6], o[7]);
                        if (!which) *(v4u*)(QN + (size_t)row * 512 + 8 * lane) = w;
                        else {
                            if (row < NREAL) { const size_t kr = (size_t)((row >> 12) * KVROWS + 128 + (row & (SEQ - 1))) * 512 + 8 * lane; *(v4u*)(KP + kr) = w; *(v4u*)(VP + kr) = cv; }
                            else {
#pragma unroll
                                for (int b = 0; b < NB; ++b) { const size_t kr = (size_t)(b * KVROWS + 48 + (row - NREAL)) * 512 + 8 * lane; *(v4u*)(KP + kr) = w; *(v4u*)(VP + kr) = cv; } } }
                    }
                    { const f32x4 fb0 = U2F4(b0), z0 = U2F4(g0_) * U2F4(u0), z1 = U2F4(g1_) * U2F4(u1) * m1, z2 = U2F4(g2_) * U2F4(u2) * m2;
                      const f32x4 y = cw0 * z2 + cw1 * z1 + cw2 * z0; const f32x4 o = fb0 * y;
                      *(unsigned long long*)(OMIX + (size_t)row * DM + 768 + c4) = (unsigned long long)pk2(o.x, o.y) | ((unsigned long long)pk2(o.z, o.w) << 32); }
                }
#undef AP_LOAD
#undef CV_LOAD
#undef U2F4
            }
            {
                LAS float* XL = (LAS float*)(lds + wave * 17408);
                LAS float* YL = XL + 32 * 65;
                const int nreal_g = ngrp - (bx == 0 ? 1 : 0);
                for (int lt = wave; lt < 4 * nreal_g + (bx == 0 ? 4 : 0); lt += NWAVES) {
                    int bh, ch; if (lt < 4 * nreal_g) { const int g = bx + 256 * (lt >> 2); bh = (g >> 8) * 4 + (lt & 3); ch = (g & 255) + 1; } else { bh = lt - 4 * nreal_g; ch = 0; }
                    const int task = bh * 257 + ch, b = bh >> 2, cb = (bh & 3) * 64; const int rowbase = ch == 0 ? NREAL : b * SEQ + 16 * (ch - 1);
                    float at[16], rt[16], bt[16], kt[16], vsv[16]; float gam = 1.f;
                    { const int c = cb + lane;
                      const float mu_r = mu[c], mu_k = mu[256 + c], mu_v = mu[512 + c], w0c = w0[c], a0c = a0[c], kkc = k_k[c], kac = k_a[c], rkc = r_k[c];
                      const int p0 = prevrow(rowbase); const bf16* q0 = PROJ + (size_t)(p0 < 0 ? rowbase : p0) * INP + c; const float pm = p0 < 0 ? 0.f : 1.f;
                      float pr_ = pm * bf2f(q0[0]), pk_ = pm * bf2f(q0[256]), pv_ = pm * bf2f(q0[512]);
                      unsigned short xr[16], xk[16], xv[16], la[16], lg[16]; float lw[16];
#pragma unroll
                      for (int t = 0; t < 16; ++t) { const bf16* q_ = PROJ + (size_t)(rowbase + t) * INP + c; xr[t] = q_[0]; xk[t] = q_[256]; xv[t] = q_[512];
                          lw[t] = LORA_W[(size_t)(rowbase + t) * 256 + c]; la[t] = LORA_AG[(size_t)(rowbase + t) * 512 + c]; lg[t] = LORA_AG[(size_t)(rowbase + t) * 512 + 256 + c]; }
#pragma unroll
                      for (int t = 0; t < 16; ++t) {
                          const float fr = bf2f(xr[t]), fk = bf2f(xk[t]), fv = bf2f(xv[t]);
                          const float r = fr + (pr_ - fr) * mu_r, k = fk + (pk_ - fk) * mu_k, v = fv + (pv_ - fv) * mu_v; pr_ = fr; pk_ = fk; pv_ = fv;
                          const float wacc = w0c + lw[t], aacc = a0c + bf2f(la[t]), gacc = bf2f(lg[t]);
                          const float nx = -wacc; const float sp = fmaxf(nx, 0.f) + __logf(1.f + __expf(-fabsf(nx)));
                          const float wlog = -sp - 0.5f; const float decay = __expf(-__expf(wlog));
                          const float a = sigmoidf_(aacc);
                          const float kkr = k * kkc; const float ss = wave_sum_dpp(kkr * kkr); const float kk = kkr / fmaxf(sqrtf(ss), 1e-12f);
                          const float k2 = k * (1.f + (a - 1.f) * kac);
                          const float bs = wave_sum_dpp(r * k2 * rkc);
                          const size_t si = (size_t)(rowbase + t) * 256 + c;
                          SG[si] = gacc; SBON[si] = bs * v;
                          at[t] = -kk * gam; gam *= decay; rt[t] = r * gam; const float ig = 1.f / gam; bt[t] = kk * a * ig; kt[t] = k2 * ig; vsv[t] = v; } }
#pragma unroll
                    for (int t = 0; t < 16; ++t) { XL[t * 65 + lane] = bt[t]; XL[(16 + t) * 65 + lane] = kt[t]; YL[t * 65 + lane] = at[t]; YL[(16 + t) * 65 + lane] = rt[t]; }
                    attn_body::f32x16 gm = attn_body::f32x16{};
#pragma unroll 8
                    for (int kk = 0; kk < 32; ++kk) gm = __builtin_amdgcn_mfma_f32_32x32x2f32(XL[(lane & 31) * 65 + 2 * kk + (lane >> 5)], YL[(lane & 31) * 65 + 2 * kk + (lane >> 5)], gm, 0, 0, 0);
                    LDS_WAIT();
                    LAS float* GL = YL; LAS float* TL = YL + 1056; LAS float* XM = YL + 1328;
#pragma unroll
                    for (int r = 0; r < 16; ++r) GL[((r & 3) + 8 * (r >> 2) + 4 * (lane >> 5)) * 33 + (lane & 31)] = gm[r];
                    float tr[16];
#pragma unroll
                    for (int t = 0; t < 16; ++t) tr[t] = ((lane & 15) == t) ? 1.f : 0.f;
#pragma unroll
                    for (int s = 0; s < 15; ++s)
#pragma unroll
                        for (int t = s + 1; t < 16; ++t) tr[t] = fmaf(tr[s], GL[s * 33 + t], tr[t]);
                    if (lane < 16) {
#pragma unroll
                        for (int t = 0; t < 16; ++t) TL[lane * 17 + t] = tr[t]; }
                    { const int s = lane & 15, q = lane >> 4; float x0 = 0.f, x1 = 0.f, x2 = 0.f, x3 = 0.f;
#pragma unroll
                      for (int u = 1; u < 16; ++u) { const float l = (u > s) ? GL[(16 + s) * 33 + u] : 0.f; x0 = fmaf(l, TL[u * 17 + 4 * q], x0); x1 = fmaf(l, TL[u * 17 + 4 * q + 1], x1); x2 = fmaf(l, TL[u * 17 + 4 * q + 2], x2); x3 = fmaf(l, TL[u * 17 + 4 * q + 3], x3); }
                      XM[s * 17 + 4 * q] = x0; XM[s * 17 + 4 * q + 1] = x1; XM[s * 17 + 4 * q + 2] = x2; XM[s * 17 + 4 * q + 3] = x3; }
                    float atT[16];
#pragma unroll
                    for (int sp = 0; sp < 16; ++sp) { float acc = 0.f;
#pragma unroll
                        for (int s = 0; s <= sp; ++s) acc = fmaf(at[s], TL[s * 17 + sp], acc);
                        atT[sp] = acc; }
                    unsigned char* rec = CH_REC + (size_t)task * CH_RB;
                    ((float*)rec)[lane] = gam;
                    LAS unsigned short* ST = (LAS unsigned short*)XL;
                    const int kpos = (lane & ~15) + 8 * ((lane >> 2) & 1) + (lane & 3) + 4 * ((lane >> 3) & 1);
                    float zz[16];
#pragma unroll
                    for (int s = 0; s < 16; ++s) { float acc = kt[s] * gam;
#pragma unroll
                        for (int sp = s + 1; sp < 16; ++sp) acc = fmaf(XM[s * 17 + sp], bt[sp] * gam, acc);
                        zz[s] = acc; }
#pragma unroll
                    for (int t = 0; t < 16; ++t) { float acc = rt[t];
#pragma unroll
                        for (int s = 0; s <= t; ++s) acc = fmaf(atT[s], GL[s * 33 + 16 + t], acc);
                        ST[t * 64 + kpos] = (unsigned short)f2bf(atT[t]); ST[(16 + t) * 64 + kpos] = (unsigned short)f2bf(acc); }
                    { v4u w0, w1;
                      w0.x = pk2(bt[0] * gam, bt[1] * gam); w0.y = pk2(bt[2] * gam, bt[3] * gam); w0.z = pk2(bt[8] * gam, bt[9] * gam); w0.w = pk2(bt[10] * gam, bt[11] * gam);
                      w1.x = pk2(bt[4] * gam, bt[5] * gam); w1.y = pk2(bt[6] * gam, bt[7] * gam); w1.z = pk2(bt[12] * gam, bt[13] * gam); w1.w = pk2(bt[14] * gam, bt[15] * gam);
                      v4u* d = (v4u*)(rec + 4352 + lane * 32); d[0] = w0; d[1] = w1;
                      v4u z0, z1; z0.x = pk2(zz[0], zz[1]); z0.y = pk2(zz[2], zz[3]); z0.z = pk2(zz[4], zz[5]); z0.w = pk2(zz[6], zz[7]);
                      z1.x = pk2(zz[8], zz[9]); z1.y = pk2(zz[10], zz[11]); z1.z = pk2(zz[12], zz[13]); z1.w = pk2(zz[14], zz[15]);
                      v4u* dz = (v4u*)(rec + 6400 + lane * 32); dz[0] = z0; dz[1] = z1; }
                    { float vs[16];
#pragma unroll
                      for (int s = 0; s < 16; ++s) vs[s] = vsv[s];
                      v4u a0, a1; a0.x = pk2(vs[0], vs[1]); a0.y = pk2(vs[2], vs[3]); a0.z = pk2(vs[4], vs[5]); a0.w = pk2(vs[6], vs[7]);
                      a1.x = pk2(vs[8], vs[9]); a1.y = pk2(vs[10], vs[11]); a1.z = pk2(vs[12], vs[13]); a1.w = pk2(vs[14], vs[15]);
                      v4u* dv = (v4u*)(rec + 8448 + lane * 32); dv[0] = a0; dv[1] = a1; }
                    { const int s = lane & 15, q = lane >> 4;
#pragma unroll
                      for (int e = 0; e < 4; ++e) { const int t = 4 * q + e; float acc = (t >= s) ? GL[(16 + s) * 33 + 16 + t] : 0.f;
#pragma unroll
                          for (int sp = 1; sp < 16; ++sp) { const float m = (sp <= t) ? GL[sp * 33 + 16 + t] : 0.f; acc = fmaf(XM[s * 17 + sp], m, acc); }
                          ((unsigned short*)(rec + 10496))[t * 16 + s] = (unsigned short)f2bf(acc); } }
                    LDS_WAIT();
                    { const LAS v4u* sv = (const LAS v4u*)ST + lane; v4u* d = (v4u*)(rec + 256) + lane;
#pragma unroll
                      for (int i = 0; i < 4; ++i) d[64 * i] = sv[64 * i]; }
                    LDS_WAIT();
                    if (ch == 0) {
                        asm volatile("s_waitcnt vmcnt(0)" ::: "memory");
                        const v4u* src = (const v4u*)rec;
#pragma unroll 1
                        for (int i = lane; i < CH_RB / 16; i += 64) { const v4u w = src[i];
#pragma unroll
                            for (int cp = 1; cp < 4; ++cp) ((v4u*)(CH_REC + (size_t)((bh + 4 * cp) * 257) * CH_RB))[i] = w; }
                    }
                }
            }
            SEAM(pb + 2);
        }
        for (int rep_ = 0; rep_ < NREP(3); ++rep_) if (EN(3) && IN(pb + 3)) { PH_TID;
#define PK8(T, o) ((v4u){attn_body::cvtpk_s(T[o], T[o + 1]), attn_body::cvtpk_s(T[o + 2], T[o + 3]), attn_body::cvtpk_s(T[o + 4], T[o + 5]), attn_body::cvtpk_s(T[o + 6], T[o + 7])})
            for (int rep2_ = 0; rep2_ < NREP(13); ++rep2_)
            if (bx < 32) {
                typedef attn_body::bf16x8 bfx8; typedef attn_body::f32x16 fx16;
                const int bh = bx >> 1, vh = bx & 1, n = lane & 31, hh = lane >> 5;
                const unsigned char* rec0 = CH_REC + (size_t)(bh * 257) * CH_RB;
                const unsigned lds0 = (unsigned)(uintptr_t)lds_raw;
                constexpr int RBUF = 6 * CH_RB;
#define S2_ISSUE(rnd) do { if (wave >= 1 && wave <= 6) { const int c_ = 6 * (rnd) + wave - 1; if (c_ < 257) { const unsigned dst_ = lds0 + ((rnd) & 1) * RBUF + (wave - 1) * CH_RB; \
                    for (int p_ = 0; p_ < 11; ++p_) attn_body::glds16s(rec0 + (size_t)c_ * CH_RB + p_ * 1024, (unsigned)lane * 16u, (unsigned)__builtin_amdgcn_readfirstlane(dst_ + p_ * 1024)); } } } while (0)
                S2_ISSUE(0);
                asm volatile("s_waitcnt vmcnt(0)\n\ts_barrier" ::: "memory");
                v4u* spk = (v4u*)(CH_SPK + (size_t)(bh * 257) * 8192 + vh * 4096) + lane;
                fx16 st0 = fx16{}, st1 = fx16{};
                for (int rnd = 0; rnd < 43; ++rnd) {
                    S2_ISSUE(rnd + 1);
                    if (wave == 0) {
                        v4u atf[4], bhf[2], ztf[2], vtf; f32x4 gq[8];
#define S2_FRAGS(j_) do { const LAS unsigned char* r_ = lds + (rnd & 1) * RBUF + (j_) * CH_RB; \
                            _Pragma("unroll") for (int ks = 0; ks < 4; ++ks) atf[ks] = *(const LAS v4u*)(r_ + 256 + ((lane & 15) * 64 + 16 * ks + 8 * hh) * 2); \
                            _Pragma("unroll") for (int i = 0; i < 2; ++i) { bhf[i] = *(const LAS v4u*)(r_ + 4352 + ((32 * i + n) * 16 + 8 * hh) * 2); ztf[i] = *(const LAS v4u*)(r_ + 6400 + ((32 * i + n) * 16 + 8 * hh) * 2); } \
                            vtf = *(const LAS v4u*)(r_ + 8448 + ((32 * vh + n) * 16 + 8 * hh) * 2); \
                            _Pragma("unroll") for (int i = 0; i < 2; ++i) _Pragma("unroll") for (int q = 0; q < 4; ++q) gq[4 * i + q] = *(const LAS f32x4*)(r_ + (32 * i + 8 * q + 4 * hh) * 4); } while (0)
                        S2_FRAGS(0);
                        for (int j = 0; j < 6; ++j) { const int ch = 6 * rnd + j; if (ch >= 257) break;
                            const v4u a0 = atf[0], a1 = atf[1], a2 = atf[2], a3 = atf[3], b0 = bhf[0], b1 = bhf[1], z0 = ztf[0], z1 = ztf[1], vt = vtf;
                            f32x4 g_[8];
#pragma unroll
                            for (int i = 0; i < 8; ++i) g_[i] = gq[i];
                            if (j < 5) S2_FRAGS(j + 1);
                            const v4u s0 = PK8(st0, 0), s1 = PK8(st0, 8), s2 = PK8(st1, 0), s3 = PK8(st1, 8);
                            spk[(size_t)ch * 512 + 0] = s0; spk[(size_t)ch * 512 + 64] = s1; spk[(size_t)ch * 512 + 128] = s2; spk[(size_t)ch * 512 + 192] = s3;
                            fx16 pt = fx16{};
                            pt = __builtin_amdgcn_mfma_f32_32x32x16_bf16(__builtin_bit_cast(bfx8, a0), __builtin_bit_cast(bfx8, s0), pt, 0, 0, 0);
                            pt = __builtin_amdgcn_mfma_f32_32x32x16_bf16(__builtin_bit_cast(bfx8, a1), __builtin_bit_cast(bfx8, s1), pt, 0, 0, 0);
                            pt = __builtin_amdgcn_mfma_f32_32x32x16_bf16(__builtin_bit_cast(bfx8, a2), __builtin_bit_cast(bfx8, s2), pt, 0, 0, 0);
                            pt = __builtin_amdgcn_mfma_f32_32x32x16_bf16(__builtin_bit_cast(bfx8, a3), __builtin_bit_cast(bfx8, s3), pt, 0, 0, 0);
#pragma unroll
                            for (int q = 0; q < 4; ++q) { st0[4 * q] *= g_[q].x; st0[4 * q + 1] *= g_[q].y; st0[4 * q + 2] *= g_[q].z; st0[4 * q + 3] *= g_[q].w;
                                                          st1[4 * q] *= g_[4 + q].x; st1[4 * q + 1] *= g_[4 + q].y; st1[4 * q + 2] *= g_[4 + q].z; st1[4 * q + 3] *= g_[4 + q].w; }
                            st0 = __builtin_amdgcn_mfma_f32_32x32x16_bf16(__builtin_bit_cast(bfx8, z0), __builtin_bit_cast(bfx8, vt), st0, 0, 0, 0);
                            st1 = __builtin_amdgcn_mfma_f32_32x32x16_bf16(__builtin_bit_cast(bfx8, z1), __builtin_bit_cast(bfx8, vt), st1, 0, 0, 0);
                            const v4u pp = PK8(pt, 0);
                            st0 = __builtin_amdgcn_mfma_f32_32x32x16_bf16(__builtin_bit_cast(bfx8, b0), __builtin_bit_cast(bfx8, pp), st0, 0, 0, 0);
                            st1 = __builtin_amdgcn_mfma_f32_32x32x16_bf16(__builtin_bit_cast(bfx8, b1), __builtin_bit_cast(bfx8, pp), st1, 0, 0, 0);
                        }
#undef S2_FRAGS
                        asm volatile("s_waitcnt lgkmcnt(0)\n\ts_barrier" ::: "memory");
                    } else asm volatile("s_waitcnt vmcnt(0) lgkmcnt(0)\n\ts_barrier" ::: "memory");
                }
#undef S2_ISSUE
            }
            __syncthreads();
            for (int rep2_ = 0; rep2_ < NREP(12); ++rep2_)
            { const attn_body::AttnTensors AT{(const attn_body::bf16*)QN, (const attn_body::bf16*)KP, (const attn_body::bf16*)VP, (attn_body::bf16*)OC};
              const attn_body::QueueOrder SO{(unsigned*)(ctl + CW_ATTQ + (layer * 8 + (bx & 7)) * 64), (LAS unsigned*)(lds + MISC_OFF + 64), bx & 7, tid};
              attn_body::attn_phase<attn_body::QueueOrder>((char*)lds_raw, AT, SO, tid); }
            __syncthreads();
#ifndef NO_META
            {
                LAS float* sc = (LAS float*)(lds + wave * 1024); LAS float* qs = sc + 64;
                for (int task = gw; task < NMETA * 8; task += NGW) {
                    const int row = NREAL + (task >> 3), hc = task & 7, h = hc >> 1; const int n = row - NREAL + 1;
                    qs[lane] = bf2f(QN[(size_t)row * 512 + hc * 64 + lane]);
                    float m = -INFINITY;
                    { const int idx = lane;
                        if (idx < n) { const size_t kr = 48 + idx; const v4u* kp = (const v4u*)(KP + kr * 512 + hc * 64); float dot = 0.f;
#pragma unroll
                            for (int c8 = 0; c8 < 8; ++c8) { const v4u kv = kp[c8];
                                dot += qs[c8 * 8 + 0] * __uint_as_float(kv.x << 16) + qs[c8 * 8 + 1] * __uint_as_float(kv.x & 0xffff0000u) + qs[c8 * 8 + 2] * __uint_as_float(kv.y << 16) + qs[c8 * 8 + 3] * __uint_as_float(kv.y & 0xffff0000u)
                                     + qs[c8 * 8 + 4] * __uint_as_float(kv.z << 16) + qs[c8 * 8 + 5] * __uint_as_float(kv.z & 0xffff0000u) + qs[c8 * 8 + 6] * __uint_as_float(kv.w << 16) + qs[c8 * 8 + 7] * __uint_as_float(kv.w & 0xffff0000u); }
                            sc[idx] = dot; m = dot; } }
                    m = wave_max(m);
                    float l = 0.f;
                    if (lane < n) { const float p = __builtin_amdgcn_exp2f(sc[lane] - m); sc[lane] = p; l = p; }
                    l = wave_sum(l);
                    float o0 = 0.f, o1 = 0.f;
                    for (int idx = 0; idx < n; ++idx) { const float p = sc[idx]; const size_t vr = 48 + idx;
                        const unsigned v2 = *(const unsigned*)(VP + vr * 512 + h * 128 + 2 * lane); o0 += p * __uint_as_float(v2 << 16); o1 += p * __uint_as_float(v2 & 0xffff0000u); }
                    const float inv = 1.f / l;
                    *(unsigned*)(OC + (size_t)row * 1024 + hc * 128 + 2 * lane) = pk2(o0 * inv, o1 * inv);
                    LDS_WAIT();
                }
            }
#endif
            SEAM(pb + 3);
        }
        for (int rep_ = 0; rep_ < NREP(4); ++rep_) if (EN(4) && IN(pb + 4)) { PH_TID;
            const float* gn_g = INP(13) + layer * 256; const float* gn_b = INP(14) + layer * 256; const float* subg = INP(21) + layer * 128;
            const float s1 = wave_sum(INP(17)[layer * 64 + lane] * INP(18)[layer * 64 + lane]); const float s2 = wave_sum(INP(19)[layer * 64 + lane] * INP(20)[layer * 64 + lane]);
            const float lam = __expf(s1) - __expf(s2) + lam_init;
            const int ngrp = (1025 - bx + 255) / 256, nrows = 16 * ngrp;
            {
                typedef attn_body::bf16x8 bfx8; typedef attn_body::f32x16 fx16;
                const int n = lane & 31, hh = lane >> 5;
                for (int lt = wave; lt < 8 * ngrp; lt += NWAVES) {
                    const int g = bx + 256 * (lt >> 3), hd = (lt >> 1) & 3, vh = lt & 1; const int bh = g < 1024 ? (g >> 8) * 4 + hd : hd, ch = g < 1024 ? (g & 255) + 1 : 0;
                    const int ct = bh * 257 + ch, b = bh >> 2, cb = (bh & 3) * 64; const int rowbase = ch == 0 ? NREAL : b * SEQ + 16 * (ch - 1);
                    const unsigned char* r_ = CH_REC + (size_t)ct * CH_RB; const v4u* spk = (const v4u*)(CH_SPK + (size_t)ct * 8192 + vh * 4096) + lane;
                    fx16 y = fx16{};
#pragma unroll
                    for (int ks = 0; ks < 4; ++ks) { const v4u a = *(const v4u*)(r_ + 2304 + ((lane & 15) * 64 + 16 * ks + 8 * hh) * 2); const v4u s = spk[64 * ks];
                        y = __builtin_amdgcn_mfma_f32_32x32x16_bf16(__builtin_bit_cast(bfx8, a), __builtin_bit_cast(bfx8, s), y, 0, 0, 0); }
                    { const v4u a = *(const v4u*)(r_ + 10496 + ((lane & 15) * 16 + 8 * hh) * 2); const v4u vt = *(const v4u*)(r_ + 8448 + ((32 * vh + n) * 16 + 8 * hh) * 2);
                      y = __builtin_amdgcn_mfma_f32_32x32x16_bf16(__builtin_bit_cast(bfx8, a), __builtin_bit_cast(bfx8, vt), y, 0, 0, 0); }
                    {
#pragma unroll
                        for (int r = 0; r < 8; ++r) SY[(size_t)(rowbase + (r & 3) + 8 * (r >> 2) + 4 * hh) * 256 + cb + 32 * vh + n] = y[r]; }
                }
            }
#undef PK8
            asm volatile("s_waitcnt vmcnt(0)" ::: "memory");
            __syncthreads();
            {
                const int h = lane >> 4, j8 = (lane & 15) * 8;
                f32x4 ny, nbon, ngt; v4u na0, na1;
#define POST_LOAD(rw) do { const int r_ = (rw); ny = *(const f32x4*)(SY + (size_t)r_ * 256 + 4 * lane); nbon = *(const f32x4*)(SBON + (size_t)r_ * 256 + 4 * lane); ngt = *(const f32x4*)(SG + (size_t)r_ * 256 + 4 * lane); \
                    na0 = *(const v4u*)(OC + (size_t)r_ * 1024 + (h * 2 + 0) * 128 + j8); na1 = *(const v4u*)(OC + (size_t)r_ * 1024 + (h * 2 + 1) * 128 + j8); } while (0)
                const f32x4 gg = *(const f32x4*)(gn_g + 4 * lane), gb = *(const f32x4*)(gn_b + 4 * lane), g0 = *(const f32x4*)(subg + j8), g1 = *(const f32x4*)(subg + j8 + 4);
                int idx = wave; POST_LOAD(MP_ROW(idx));
                for (; idx < nrows; idx += NWAVES) { const int row = MP_ROW(idx);
                    const f32x4 y = ny, bon = nbon, gt = ngt; const v4u a0 = na0, a1 = na1;
                    if (idx + NWAVES < nrows) POST_LOAD(MP_ROW(idx + NWAVES));
                    { const float mean = sum16((y.x + y.y) + (y.z + y.w)) * (1.f / 64.f);
                      const f32x4 dlt = y - mean; const float var = sum16((dlt.x * dlt.x + dlt.y * dlt.y) + (dlt.z * dlt.z + dlt.w * dlt.w)) * (1.f / 64.f); const float rs = 1.f / sqrtf(var + 64e-5f);
                      const f32x4 o = (dlt * rs * gg + gb + bon) * gt;
                      *(unsigned long long*)(OMIX + (size_t)row * DM + 4 * lane) = (unsigned long long)pk2(o.x, o.y) | ((unsigned long long)pk2(o.z, o.w) << 32); }
                    { float dv[8];
                      dv[0] = __uint_as_float(a0.x << 16) - lam * __uint_as_float(a1.x << 16); dv[1] = __uint_as_float(a0.x & 0xffff0000u) - lam * __uint_as_float(a1.x & 0xffff0000u);
                      dv[2] = __uint_as_float(a0.y << 16) - lam * __uint_as_float(a1.y << 16); dv[3] = __uint_as_float(a0.y & 0xffff0000u) - lam * __uint_as_float(a1.y & 0xffff0000u);
                      dv[4] = __uint_as_float(a0.z << 16) - lam * __uint_as_float(a1.z << 16); dv[5] = __uint_as_float(a0.z & 0xffff0000u) - lam * __uint_as_float(a1.z & 0xffff0000u);
                      dv[6] = __uint_as_float(a0.w << 16) - lam * __uint_as_float(a1.w << 16); dv[7] = __uint_as_float(a0.w & 0xffff0000u) - lam * __uint_as_float(a1.w & 0xffff0000u);
                      float ss = 0.f;
#pragma unroll
                      for (int i = 0; i < 8; ++i) ss += dv[i] * dv[i];
                      ss = sum16(ss); const float sc_ = (1.f / sqrtf(ss * (1.f / 128.f) + 1e-5f)) * (1.f - lam_init);
                      v4u o; o.x = pk2(dv[0] * sc_ * g0.x, dv[1] * sc_ * g0.y); o.y = pk2(dv[2] * sc_ * g0.z, dv[3] * sc_ * g0.w); o.z = pk2(dv[4] * sc_ * g1.x, dv[5] * sc_ * g1.y); o.w = pk2(dv[6] * sc_ * g1.z, dv[7] * sc_ * g1.w);
                      *(v4u*)(OMIX + (size_t)row * DM + 256 + h * 128 + j8) = o; }
                }
#undef POST_LOAD
            }
            { const int gt = bx * (NWAVES * 64) + tid, NGT = G * NWAVES * 64;
              for (int i = gt; i < (MPAD - NTOK) * (DM / 8); i += NGT) ((v4u*)(OMIX + (size_t)NTOK * DM))[i] = zero_v4u(); }
            SEAM(pb + 4);
        }
        if (EN(5) && IN(pb + 5)) { PH_TID;
            pg8::Gemm g{OMIX, (const bf16*)(ws + WS_WOUT) + (size_t)layer * DM * DM, NREAL, DM, DM}; pg8::StaticOrder S; S.init(NREAL, DM, G, bx);
            if (!moe) {
                if (layer == 2) {
                    meta_gemm_res(OMIX + (size_t)NREAL * DM, DM, (const bf16*)(ws + WS_WOUT) + (size_t)layer * DM * DM, Hf + (size_t)NREAL * DM, lds, bx, wave, lane, 2, (bf16*)((unsigned char*)HB + (size_t)NREAL * DM), RSQA + NREAL);
                    typedef pg8::EpiResAddHB<2, (long long)WS_HB - (long long)WS_H, (long long)WS_RSROW - (long long)WS_H> EpiHB2; EpiHB2 E{Hf, DM, 1.f};
                    pg8::gemm_phase<EpiHB2, pg8::StaticOrder, true, true>(lds, g, S, E, tid);
                } else {
                    meta_gemm_res(OMIX + (size_t)NREAL * DM, DM, (const bf16*)(ws + WS_WOUT) + (size_t)layer * DM * DM, Hf + (size_t)NREAL * DM, lds, bx, wave, lane, 1, HB + (size_t)NREAL * DM, RSQA + NREAL);
                    typedef pg8::EpiResAddHB<1, (long long)WS_HB - (long long)WS_H, (long long)WS_RSROW - (long long)WS_H> EpiHB1; EpiHB1 E{Hf, DM, 1.f};
                    pg8::gemm_phase<EpiHB1, pg8::StaticOrder, true, true>(lds, g, S, E, tid);
                }
            } else {
                meta_gemm_res(OMIX + (size_t)NREAL * DM, DM, (const bf16*)(ws + WS_WOUT) + (size_t)layer * DM * DM, Hf + (size_t)NREAL * DM, lds, bx, wave, lane);
                pg8::EpiResAdd E{Hf, DM, 1.f};
                pg8::gemm_phase<pg8::EpiResAdd, pg8::StaticOrder, true, true>(lds, g, S, E, tid);
            }
            SEAM(pb + 5);
        }
        if (EN(6) && IN(pb + 6) && moe) { PH_TID;
            LAS int* lcnt = (LAS int*)lds; LAS int* lbase = lcnt + 8; LAS int* lrow = lcnt + 16;
            if (tid < 16) lcnt[tid] = 0;
            __syncthreads();
            const float* gff = INP(24) + layer * DM; const float* Wr = INP(28) + (size_t)jj * DM * NE;
            f32x4 nv6_[4];
            { const GAS f32x4* xr = (const GAS f32x4*)(Hf + (size_t)(bx + G * wave) * DM) + lane;
#pragma unroll
              for (int j = 0; j < 4; ++j) nv6_[j] = xr[64 * j]; }
            for (int i = wave; i < 72; i += NWAVES) { const int row = bx + G * i;
                if (row < NTOK) {
                    f32x4 v[4]; float s = 0.f;
#pragma unroll
                    for (int j = 0; j < 4; ++j) v[j] = nv6_[j];
                    { const int rn_ = row + G * NWAVES < NTOK ? row + G * NWAVES : row; const GAS f32x4* xr = (const GAS f32x4*)(Hf + (size_t)rn_ * DM) + lane;
#pragma unroll
                      for (int j = 0; j < 4; ++j) nv6_[j] = xr[64 * j]; }
#pragma unroll
                    for (int j = 0; j < 4; ++j) s += (v[j].x * v[j].x + v[j].y * v[j].y) + (v[j].z * v[j].z + v[j].w * v[j].w);
                    s = wave_sum(s); const float rstd = 1.f / sqrtf(s * (1.f / DM) + 1e-6f);
                    if (moe) { LAS unsigned* o4 = (LAS unsigned*)(lds + 4096 + i * 1024) + lane; const float sn = rstd * A8_SCALE;
#pragma unroll
                      for (int j = 0; j < 4; ++j) o4[64 * j] = pk4_fp8(v[j].x * sn, v[j].y * sn, v[j].z * sn, v[j].w * sn); }
                    else if (layer == 2) { GAS unsigned* o4 = (GAS unsigned*)((GAS unsigned char*)HB + (size_t)row * DM) + lane; const float sn = rstd * A8_SCALE;
#pragma unroll
                      for (int j = 0; j < 4; ++j) o4[64 * j] = pk4_fp8(v[j].x * sn, v[j].y * sn, v[j].z * sn, v[j].w * sn); }
                    else { GAS unsigned long long* o8 = (GAS unsigned long long*)(HB + (size_t)row * DM) + lane;
#pragma unroll
                      for (int j = 0; j < 4; ++j) o8[64 * j] = (unsigned long long)pk2(v[j].x, v[j].y) | ((unsigned long long)pk2(v[j].z, v[j].w) << 32); }
                    if (lane == 0) RSTD[row] = rstd;
                    if (moe) {
                        float lg[8];
#pragma unroll
                        for (int e = 0; e < 8; ++e) lg[e] = 0.f;
#pragma unroll
                        for (int j = 0; j < 4; ++j) { const int k0 = 4 * lane + 256 * j; const f32x4 gv = *(const f32x4*)(gff + k0);
#pragma unroll
                            for (int q = 0; q < 4; ++q) { const float hv = v[j][q] * gv[q]; const f32x4 wa = *(const f32x4*)(Wr + (size_t)(k0 + q) * 8), wb = *(const f32x4*)(Wr + (size_t)(k0 + q) * 8 + 4);
                                lg[0] += hv * wa.x; lg[1] += hv * wa.y; lg[2] += hv * wa.z; lg[3] += hv * wa.w; lg[4] += hv * wb.x; lg[5] += hv * wb.y; lg[6] += hv * wb.z; lg[7] += hv * wb.w; } }
#pragma unroll
                        for (int e = 0; e < 8; ++e) lg[e] = wave_sum(lg[e]) * rstd;
                        int e1 = 0; float l1 = lg[0];
#pragma unroll
                        for (int e = 1; e < 8; ++e) if (lg[e] > l1) { l1 = lg[e]; e1 = e; }
                        int e2 = -1; float l2 = -INFINITY;
#pragma unroll
                        for (int e = 0; e < 8; ++e) if (e != e1 && lg[e] > l2) { l2 = lg[e]; e2 = e; }
                        if (lane == 0) { const float g2 = 1.f / (1.f + __expf(l1 - l2)); const float g1 = 1.f - g2;
                            const int sl1 = atomicAdd((int*)&lcnt[e1], 1), sl2 = atomicAdd((int*)&lcnt[e2], 1);
                            lrow[i * 4 + 0] = e1; lrow[i * 4 + 1] = sl1; lrow[i * 4 + 2] = e2; lrow[i * 4 + 3] = sl2;
                            TOKG[row * 2 + 0] = g1; TOKG[row * 2 + 1] = g2; }
                    }
                }
            }
            if (moe) {
                __syncthreads();
                if (tid < 8) lbase[tid] = (int)__hip_atomic_fetch_add((unsigned*)(ctl + CW_MOECNT + 64 * jj + tid), (unsigned)lcnt[tid], RLX_AGENT);
                __syncthreads();
                if (tid < 72) { const int row = bx + G * tid; if (row < NTOK) { const int e1 = lrow[tid * 4 + 0], e2 = lrow[tid * 4 + 2];
                    TOKE[row * 2 + 0] = e1; TOKE[row * 2 + 1] = e2; TOKS[row * 2 + 0] = lbase[e1] + lrow[tid * 4 + 1]; TOKS[row * 2 + 1] = lbase[e2] + lrow[tid * 4 + 3]; } }
                __syncthreads();
            }
            SEAM(pb + 6);
        }
        if (!moe) {
            for (int rep_ = 0; rep_ < NREP(7); ++rep_) if (EN(7) && IN(pb + 7)) { PH_TID;
                pg8::StaticOrder S; S.init(MPAD, FF2, G, bx);
                if (layer == 2) { pg8::Gemm g{HB, (const bf16*)(ws + WS_WGU) + (size_t)jj * FF2 * DM, MPAD, FF2, DM / 2}; pg8::EpiSwiglu8 E{GB, FF, nullptr, 1.f / (W8_SCALE * H8_SCALE), G8_SCALE, RSQA};
                    pg8::gemm_phase<pg8::EpiSwiglu8, pg8::StaticOrder, true, true, true>(lds, g, S, E, tid); }
                else { pg8::Gemm g{HB, (const bf16*)(ws + WS_WGU) + (size_t)jj * FF2 * DM, MPAD, FF2, DM}; pg8::EpiSwiglu E{GB, FF, nullptr, 1.f, 0.f, RSQA};
                    pg8::gemm_phase<pg8::EpiSwiglu, pg8::StaticOrder, true, true>(lds, g, S, E, tid); }
                SEAM(pb + 7);
            }
            if (EN(8) && IN(pb + 8)) { PH_TID;
                pg8::StaticOrder S; S.init(NREAL, DM, G, bx);
                if (layer == 2) {
                    meta_gemm_res8((const unsigned char*)GB + (size_t)NREAL * FF, FF, (const unsigned char*)((const bf16*)(ws + WS_WD) + (size_t)jj * DM * FF), Hf + (size_t)NREAL * DM, 1.f / (W8_SCALE * G8_SCALE), lds, bx, wave, lane);
                    pg8::Gemm g{GB, (const bf16*)(ws + WS_WD) + (size_t)jj * DM * FF, NREAL, DM, FF / 2}; pg8::EpiResAdd E{Hf, DM, 1.f / (W8_SCALE * G8_SCALE)};
                    pg8::gemm_phase<pg8::EpiResAdd, pg8::StaticOrder, true, true, true>(lds, g, S, E, tid);
                } else {
                    meta_gemm_res(GB + (size_t)NREAL * FF, FF, (const bf16*)(ws + WS_WD) + (size_t)jj * DM * FF, Hf + (size_t)NREAL * DM, lds, bx, wave, lane);
                    pg8::Gemm g{GB, (const bf16*)(ws + WS_WD) + (size_t)jj * DM * FF, NREAL, DM, FF}; pg8::EpiResAdd E{Hf, DM, 1.f};
                    pg8::gemm_phase<pg8::EpiResAdd, pg8::StaticOrder, true, true>(lds, g, S, E, tid);
                }
                SEAM(pb + 8);
            }
        } else {
#define cnt ((const int*)(ctl + CW_MOECNT + 64 * jj))
            for (int rep_ = 0; rep_ < NREP(7); ++rep_) if (EN(7) && IN(pb + 7)) { PH_TID;
                int ts[8]; { int a = 0;
#pragma unroll
                    for (int e = 0; e < 8; ++e) { ts[e] = a; a += (__hip_atomic_load(cnt + e, RLX_AGENT) + 255) >> 8; } }
                { LAS const int* lbase = (LAS const int*)lds + 8; LAS const int* lrow = (LAS const int*)lds + 16;
                  for (int i = wave; i < 72; i += NWAVES) { const int row = bx + G * i;
                      if (row < NTOK) { const v4u d = *(const LAS v4u*)(lds + 4096 + i * 1024 + lane * 16);
#pragma unroll
                          for (int c = 0; c < 2; ++c) { const int e = lrow[i * 4 + 2 * c]; int tse = 0, lb = 0;
#pragma unroll
                              for (int x = 0; x < 8; ++x) { tse = (e == x) ? ts[x] : tse; lb = (e == x) ? lbase[x] : lb; }
                              const size_t p = (size_t)tse * 256 + lb + lrow[i * 4 + 2 * c + 1];
                              ((v4u*)((unsigned char*)AROWS + p * DM))[lane] = d; } } } }
                SEAM(pb + 7);
            }
            for (int rep_ = 0; rep_ < NREP(8); ++rep_) if (EN(8) && IN(pb + 8)) { PH_TID;
                pg8::Gemm g{AROWS, (const bf16*)(ws + WS_MWGU), MOEP, FF2, DM / 2}; pg8::MoeOrder S; S.init(cnt, FF2 / 256, G, bx);
                pg8::EpiSwiglu8 E{GB, FF, nullptr, 1.f / (W8_SCALE * A8_SCALE), G8_SCALE};
                pg8::gemm_phase<pg8::EpiSwiglu8, pg8::MoeOrder, true, true, true>(lds, g, S, E, tid);
                SEAM(pb + 8);
            }
            for (int rep_ = 0; rep_ < NREP(9); ++rep_) if (EN(9) && IN(pb + 9)) { PH_TID;
                pg8::Gemm g{GB, (const bf16*)(ws + WS_MWD), MOEP, DM, FF / 2}; pg8::MoeOrder S; S.init(cnt, DM / 256, G, bx);
                pg8::EpiBf16Rs E{YM, DM, nullptr, 1.f / (W8_SCALE * G8_SCALE)};
                pg8::gemm_phase<pg8::EpiBf16Rs, pg8::MoeOrder, true, true, true>(lds, g, S, E, tid);
                SEAM(pb + 9);
            }
            if (EN(10) && IN(pb + 10)) { PH_TID;
                int ts[8]; { int a = 0;
#pragma unroll
                    for (int e = 0; e < 8; ++e) { ts[e] = a; a += (__hip_atomic_load(cnt + e, RLX_AGENT) + 255) >> 8; } }
                int ie1, ie2, is1, is2; float ig1, ig2;
                v4u ny1[2], ny2[2]; f32x4 nha[2], nhb[2]; float ng1, ng2;
#define CB_IDX(rw) do { const int r_ = (rw) < NTOK ? (rw) : NTOK - 1; ie1 = TOKE[r_ * 2]; ie2 = TOKE[r_ * 2 + 1]; is1 = TOKS[r_ * 2]; is2 = TOKS[r_ * 2 + 1]; ig1 = TOKG[r_ * 2]; ig2 = TOKG[r_ * 2 + 1]; } while (0)
#define CB_DATA(rw) do { const int r_ = (rw) < NTOK ? (rw) : NTOK - 1; int t1 = 0, t2 = 0; \
                    _Pragma("unroll") for (int q = 0; q < 8; ++q) { t1 = (ie1 == q) ? ts[q] : t1; t2 = (ie2 == q) ? ts[q] : t2; } \
                    const size_t p1 = (size_t)t1 * 256 + is1, p2 = (size_t)t2 * 256 + is2; ng1 = ig1; ng2 = ig2; const float* hr_ = Hf + (size_t)r_ * DM; \
                    _Pragma("unroll") for (int j = 0; j < 2; ++j) { const int c8 = (lane + 64 * j) * 8; ny1[j] = *(const v4u*)(YM + p1 * DM + c8); ny2[j] = *(const v4u*)(YM + p2 * DM + c8); nha[j] = *(const f32x4*)(hr_ + c8); nhb[j] = *(const f32x4*)(hr_ + c8 + 4); } } while (0)
                CB_IDX(gw); CB_DATA(gw); CB_IDX(gw + NGW);
                for (int row = gw; row < NTOK; row += NGW) {
                    const float g1 = ng1, g2 = ng2; v4u cy1[2], cy2[2]; f32x4 cha[2], chb[2];
#pragma unroll
                    for (int j = 0; j < 2; ++j) { cy1[j] = ny1[j]; cy2[j] = ny2[j]; cha[j] = nha[j]; chb[j] = nhb[j]; }
                    CB_DATA(row + NGW); CB_IDX(row + 2 * NGW);
                    float* hr = Hf + (size_t)row * DM; f32x4 hv[2][2]; float ssq = 0.f;
#pragma unroll
                    for (int j = 0; j < 2; ++j) { const v4u y1 = cy1[j], y2 = cy2[j];
                        f32x4 ha = cha[j], hb2 = chb[j];
                        ha.x += g1 * __uint_as_float(y1.x << 16) + g2 * __uint_as_float(y2.x << 16); ha.y += g1 * __uint_as_float(y1.x & 0xffff0000u) + g2 * __uint_as_float(y2.x & 0xffff0000u);
                        ha.z += g1 * __uint_as_float(y1.y << 16) + g2 * __uint_as_float(y2.y << 16); ha.w += g1 * __uint_as_float(y1.y & 0xffff0000u) + g2 * __uint_as_float(y2.y & 0xffff0000u);
                        hb2.x += g1 * __uint_as_float(y1.z << 16) + g2 * __uint_as_float(y2.z << 16); hb2.y += g1 * __uint_as_float(y1.z & 0xffff0000u) + g2 * __uint_as_float(y2.z & 0xffff0000u);
                        hb2.z += g1 * __uint_as_float(y1.w << 16) + g2 * __uint_as_float(y2.w << 16); hb2.w += g1 * __uint_as_float(y1.w & 0xffff0000u) + g2 * __uint_as_float(y2.w & 0xffff0000u);
                        hv[j][0] = ha; hv[j][1] = hb2; ssq += (ha.x * ha.x + ha.y * ha.y) + (ha.z * ha.z + ha.w * ha.w) + (hb2.x * hb2.x + hb2.y * hb2.y) + (hb2.z * hb2.z + hb2.w * hb2.w); }
                    if (layer == DEPTH - 1) {
                        if (row < NREAL) { float* orow = (*(float* const*)(ka + 256)) + (size_t)row * DM;
#pragma unroll
                            for (int j = 0; j < 2; ++j) { const int c8 = (lane + 64 * j) * 8; *(f32x4*)(orow + c8) = hv[j][0]; *(f32x4*)(orow + c8 + 4) = hv[j][1]; } }
                    } else {
                        ssq = wave_sum(ssq); const float rstd = 1.f / sqrtf(ssq * (1.f / DM) + 1e-6f), sn = rstd * A8_SCALE;
#pragma unroll
                        for (int j = 0; j < 2; ++j) { const int c8 = (lane + 64 * j) * 8; *(f32x4*)(hr + c8) = hv[j][0]; *(f32x4*)(hr + c8 + 4) = hv[j][1];
                            if ((INP8 >> (layer + 1)) & 1) { const unsigned lo = pk4_fp8(hv[j][0].x * sn, hv[j][0].y * sn, hv[j][0].z * sn, hv[j][0].w * sn), hi8 = pk4_fp8(hv[j][1].x * sn, hv[j][1].y * sn, hv[j][1].z * sn, hv[j][1].w * sn);
                                *(unsigned long long*)((unsigned char*)HB + (size_t)row * DM + c8) = (unsigned long long)lo | ((unsigned long long)hi8 << 32); }
                            else { v4u w; w.x = pk2(hv[j][0].x, hv[j][0].y); w.y = pk2(hv[j][0].z, hv[j][0].w); w.z = pk2(hv[j][1].x, hv[j][1].y); w.w = pk2(hv[j][1].z, hv[j][1].w);
                                *(v4u*)(HB + (size_t)row * DM + c8) = w; } }
                        if (lane == 0) RSTD[row] = rstd;
                    }
                }
#undef CB_IDX
#undef CB_DATA
                SEAM(pb + 10);
            }
        }
    }
#ifdef UBENCH
    if (hi >= 48 && bx == 255) { PH_TID;
        float x = (float)lane * 1e-3f, y = 1.0001f; float acc = 0.f;
        for (int it = 0; it < UBENCH_ITERS; ++it) {
#if UBENCH == 1
#pragma unroll
            for (int k = 0; k < 64; ++k) { asm volatile("v_fma_f32 %0, %0, %1, %0" : "+v"(x) : "v"(y)); }
#elif UBENCH == 2
#pragma unroll
            for (int k = 0; k < 64; ++k) { asm volatile("s_nop 1\n\tv_add_f32_dpp %0, %0, %0 row_mirror row_mask:0xf bank_mask:0xf bound_ctrl:1" : "+v"(x)); }
#elif UBENCH == 3
#pragma unroll
            for (int k = 0; k < 32; ++k) { asm volatile("s_nop 0\n\tv_readlane_b32 s20, %0, 63\n\tv_fmac_f32 %0, s20, %1" : "+v"(x) : "v"(y) : "s20"); }
#elif UBENCH == 5
            { float y2 = x + 1.f;
#pragma unroll
            for (int k = 0; k < 64; ++k) { asm volatile("s_nop 1\n\tv_add_f32_dpp %0, %0, %0 row_mirror row_mask:0xf bank_mask:0xf bound_ctrl:1\n\tv_add_f32_dpp %1, %1, %1 row_mirror row_mask:0xf bank_mask:0xf bound_ctrl:1" : "+v"(x), "+v"(y2)); }
            x += y2; }
#elif UBENCH == 6
            if (wave < 4) {
#pragma unroll
            for (int k = 0; k < 64; ++k) { asm volatile("s_nop 1\n\tv_add_f32_dpp %0, %0, %0 row_mirror row_mask:0xf bank_mask:0xf bound_ctrl:1" : "+v"(x)); } }
#elif UBENCH == 7
            if (wave < 4) {
#pragma unroll
            for (int k = 0; k < 64; ++k) { asm volatile("v_fma_f32 %0, %0, %1, %0" : "+v"(x) : "v"(y)); } }
#elif UBENCH == 8
            { float y2 = x + 1.f, y3 = x + 2.f, y4 = x + 3.f;
#pragma unroll
            for (int k = 0; k < 64; ++k) { asm volatile("s_nop 1\n\tv_add_f32_dpp %0, %0, %0 row_mirror row_mask:0xf bank_mask:0xf bound_ctrl:1\n\tv_add_f32_dpp %1, %1, %1 row_mirror row_mask:0xf bank_mask:0xf bound_ctrl:1\n\tv_add_f32_dpp %2, %2, %2 row_mirror row_mask:0xf bank_mask:0xf bound_ctrl:1\n\tv_add_f32_dpp %3, %3, %3 row_mirror row_mask:0xf bank_mask:0xf bound_ctrl:1" : "+v"(x), "+v"(y2), "+v"(y3), "+v"(y4)); }
            x += y2 + y3 + y4; }
#elif UBENCH == 4
#pragma unroll
            for (int k = 0; k < 64; ++k) { asm volatile("s_nop 1\n\tv_add_f32_dpp %0, %0, %0 row_bcast:15 row_mask:0xa bank_mask:0xf" : "+v"(x)); }
#endif
        }
        acc += x;
        if (acc == 123.456f) ((float*)(ws + WS_CTL))[2000 + tid] = acc;
    }
#endif
#undef IN
#undef SEAM
}

#ifndef MK_ONE_LAUNCH
#define MK_ONE_LAUNCH 1
#endif
extern "C" void kernel_launch(void* const* d_in, const int* in_sizes, int n_in, void* d_out, int out_size, void* d_ws, size_t ws_size, hipStream_t stream) {
    static int grid = 0;
    if (grid == 0) {
        if (n_in != 32 || out_size != NREAL * DM || ws_size < WS_END) { fprintf(stderr, "kernel_launch: unexpected shapes (n_in %d out %d ws %zu need %zu); nothing launched\n", n_in, out_size, ws_size, (size_t)WS_END); grid = -1; return; }
        int dev = 0, cus = 0, per_cu = 0;
        if (hipGetDevice(&dev) != hipSuccess || hipDeviceGetAttribute(&cus, hipDeviceAttributeMultiprocessorCount, dev) != hipSuccess) { grid = -1; return; }
        if (hipFuncSetAttribute((const void*)hymba_fwd, hipFuncAttributeMaxDynamicSharedMemorySize, LDS_BYTES) != hipSuccess) { fprintf(stderr, "kernel_launch: hipFuncSetAttribute failed\n"); grid = -1; return; }
        if (hipOccupancyMaxActiveBlocksPerMultiprocessor(&per_cu, (const void*)hymba_fwd, NWAVES * 64, LDS_BYTES) != hipSuccess || per_cu < 1) fprintf(stderr, "kernel_launch: occupancy query says %d\n", per_cu);
        (void)hipGetLastError();
        grid = cus;
        if (grid != 256) { fprintf(stderr, "kernel_launch: built for 256 CUs, device has %d; nothing launched\n", cus); grid = -1; return; }
    }
    if (grid < 0) return;
    if (hipMemsetAsync((char*)d_ws + WS_CTL, 0, CTL_ZERO_BYTES, stream) != hipSuccess) return;
    Args a{};
    for (int i = 0; i < 32; ++i) a.in[i] = (const float*)d_in[i];
    a.out = (float*)d_out; a.ws = (unsigned char*)d_ws;
#if MK_ONE_LAUNCH
    a.ph_lo = 0; a.ph_hi = 48;
    hipLaunchKernelGGL(hymba_fwd, dim3(grid), dim3(NWAVES * 64), LDS_BYTES, stream, a);
#else
    for (int ph = 0; ph < 50; ++ph) {
        if (ph >= 1 && ph <= 48) { const int l = (ph - 1) / 12, k = (ph - 1) % 12; const bool moe = l & 1; if (k == 11 || (!moe && k >= 9)) continue; }
        a.ph_lo = ph; a.ph_hi = ph + 1;
        hipLaunchKernelGGL(hymba_fwd, dim3(grid), dim3(NWAVES * 64), LDS_BYTES, stream, a);
    }
#endif
}
```

```cpp
#include <hip/hip_runtime.h>
#include <hip/hip_bf16.h>
#include <cmath>
#include <cstdio>
#include <cstdint>
namespace pg8 {
#define PG8_LAS __attribute__((address_space(3)))
typedef unsigned short bf16_t;
typedef short bf16x8 __attribute__((ext_vector_type(8)));
typedef float f32x4 __attribute__((ext_vector_type(4)));
typedef float f32x2 __attribute__((ext_vector_type(2)));
typedef unsigned u32x4 __attribute__((ext_vector_type(4)));
constexpr int BM = 256, BK = 64, HALF = 128, HTB = HALF * BK * 2  , STAGE_BYTES = 8 * HTB, NXCD = 8, WGM = 8;

__host__ __device__ __forceinline__ int lds_byte(int r, int c) { const int st = (r >> 4) * 2 + (c >> 5), rr = r & 15, cc = c & 31, ob = rr * 64 + cc * 2; return st * 1024 + (ob ^ (((ob >> 9) & 1) << 5)); }
__host__ __device__ __forceinline__ void stage_rc(int b, int& R, int& C) { const int st = b / 1024, sb = b % 1024, swz = sb ^ (((sb >> 9) & 1) << 5); R = (st >> 1) * 16 + swz / 64; C = (st & 1) * 32 + (swz % 64) / 2; }
__host__ __device__ __forceinline__ int perm32(int rho) { const int n = rho >> 4, i = rho & 15; return 8 * (i >> 2) + 4 * n + (i & 3); }

struct Unit { int pm, pn, pc; };
struct Gemm { const bf16_t* A; const bf16_t* Bt; int M, N, K; };

struct StaticOrder {
    int nM, nN, nwg, G, c;
    __host__ __device__ void init(int M, int N, int G_, int c_) { nM = M / BM; nN = N / BM; nwg = nM * nN; G = G_; c = c_; }
    __host__ __device__ bool next(int i, Unit& u) const {
        const long L = (long)i * G + c; if (L >= nwg) return false;
        int wgid = (int)L; { const int q = nwg / NXCD, r = nwg % NXCD, xcd = wgid % NXCD, off = wgid / NXCD; wgid = (xcd < r ? xcd * (q + 1) : r * (q + 1) + (xcd - r) * q) + off; }
        const int nig = WGM * nN, gid = wgid / nig, fm = gid * WGM, gsz = (nM - fm) < WGM ? (nM - fm) : WGM;
        u.pm = fm + ((wgid % nig) % gsz); u.pn = (wgid % nig) / gsz; u.pc = u.pn; return true;
    }
    __device__ __forceinline__ void a_ready(const Unit&) const {}
    __device__ __forceinline__ void done(const Unit&) const {}
};
struct MoeOrder {
    int G, c, nN, total; int t1, t2, t3, t4, t5, t6, t7;
    __device__ __forceinline__ void init(const int* cnt, int nN_, int G_, int c_) {
        G = G_; c = c_; nN = nN_; int a = 0;
        a += (__builtin_amdgcn_readfirstlane(__hip_atomic_load(cnt + 0, __ATOMIC_RELAXED, __HIP_MEMORY_SCOPE_AGENT)) + 255) >> 8; t1 = a;
        a += (__builtin_amdgcn_readfirstlane(__hip_atomic_load(cnt + 1, __ATOMIC_RELAXED, __HIP_MEMORY_SCOPE_AGENT)) + 255) >> 8; t2 = a;
        a += (__builtin_amdgcn_readfirstlane(__hip_atomic_load(cnt + 2, __ATOMIC_RELAXED, __HIP_MEMORY_SCOPE_AGENT)) + 255) >> 8; t3 = a;
        a += (__builtin_amdgcn_readfirstlane(__hip_atomic_load(cnt + 3, __ATOMIC_RELAXED, __HIP_MEMORY_SCOPE_AGENT)) + 255) >> 8; t4 = a;
        a += (__builtin_amdgcn_readfirstlane(__hip_atomic_load(cnt + 4, __ATOMIC_RELAXED, __HIP_MEMORY_SCOPE_AGENT)) + 255) >> 8; t5 = a;
        a += (__builtin_amdgcn_readfirstlane(__hip_atomic_load(cnt + 5, __ATOMIC_RELAXED, __HIP_MEMORY_SCOPE_AGENT)) + 255) >> 8; t6 = a;
        a += (__builtin_amdgcn_readfirstlane(__hip_atomic_load(cnt + 6, __ATOMIC_RELAXED, __HIP_MEMORY_SCOPE_AGENT)) + 255) >> 8; t7 = a;
        a += (__builtin_amdgcn_readfirstlane(__hip_atomic_load(cnt + 7, __ATOMIC_RELAXED, __HIP_MEMORY_SCOPE_AGENT)) + 255) >> 8;
        total = a * nN;
    }
    __device__ __forceinline__ bool next(int i, Unit& u) const {
        const int x = c & 7, per = G >> 3; const int e_ = i * per + (c >> 3);
        const int ntile = total / nN; const int mine = (ntile - x + 7) >> 3;
        if (e_ >= mine * nN) return false;
        const int rt = x + 8 * (e_ / nN), j = e_ % nN;
        const int e = (rt >= t1) + (rt >= t2) + (rt >= t3) + (rt >= t4) + (rt >= t5) + (rt >= t6) + (rt >= t7);
        u.pm = rt; u.pn = e * nN + j; u.pc = j; return true;
    }
    __device__ __forceinline__ void a_ready(const Unit&) const {}
    __device__ __forceinline__ void done(const Unit&) const {}
};

__device__ __forceinline__ unsigned cvt_pk_bf16(float lo, float hi) { unsigned r; asm volatile("v_cvt_pk_bf16_f32 %0, %1, %2" : "=v"(r) : "v"(lo), "v"(hi)); return r; }

#define PG8_GAS __attribute__((address_space(1)))
struct EpiBf16Rs {
    static constexpr bool PERM = true, AFTER_DRAIN = false;
    bf16_t* O; int ldc; const float* rs; float sc;
    __device__ __forceinline__ void operator()(const f32x4 (&acc)[2][2][4][2], const Unit& u, int wr, int wc, int fr, int fq) const {
        const int row0 = u.pm * BM + wr * 64 + fr; const int col0 = u.pc * BM + wc * 32 + 8 * fq;
        float sv[2][4];
#pragma unroll
        for (int ai = 0; ai < 2; ++ai)
#pragma unroll
            for (int m = 0; m < 4; ++m) sv[ai][m] = rs ? ((const PG8_GAS float*)rs)[row0 + ai * HALF + m * 16] : sc;
#pragma unroll
        for (int ai = 0; ai < 2; ++ai)
#pragma unroll
            for (int m = 0; m < 4; ++m) { const int row = row0 + ai * HALF + m * 16; const float s = sv[ai][m]; PG8_GAS bf16_t* rowp = (PG8_GAS bf16_t*)O + (size_t)row * ldc + col0;
#pragma unroll
                for (int bj = 0; bj < 2; ++bj) { const f32x4 v0 = acc[ai][bj][m][0] * s, v1 = acc[ai][bj][m][1] * s;
                    u32x4 w; w.x = cvt_pk_bf16(v0[0], v0[1]); w.y = cvt_pk_bf16(v0[2], v0[3]); w.z = cvt_pk_bf16(v1[0], v1[1]); w.w = cvt_pk_bf16(v1[2], v1[3]);
                    *(PG8_GAS u32x4*)(rowp + bj * HALF) = w; } }
    }
};
struct EpiResAdd {
    static constexpr bool PERM = false, AFTER_DRAIN = false;
    float* H; int ldc; float sc;
    __device__ __forceinline__ void operator()(const f32x4 (&acc)[2][2][4][2], const Unit& u, int wr, int wc, int fr, int fq) const {
        const int row0 = u.pm * BM + wr * 64 + fr; const int col0 = u.pc * BM + wc * 32 + 4 * fq;
#pragma unroll
        for (int ai = 0; ai < 2; ++ai)
#pragma unroll
            for (int mp = 0; mp < 2; ++mp) {
                f32x4 res[2][2][2];
#pragma unroll
                for (int m2 = 0; m2 < 2; ++m2) { const PG8_GAS float* rowp = (const PG8_GAS float*)H + (size_t)(row0 + ai * HALF + (2 * mp + m2) * 16) * ldc + col0;
#pragma unroll
                    for (int bj = 0; bj < 2; ++bj)
#pragma unroll
                        for (int n = 0; n < 2; ++n) res[m2][bj][n] = *(const PG8_GAS f32x4*)(rowp + bj * HALF + n * 16); }
#pragma unroll
                for (int m2 = 0; m2 < 2; ++m2) { PG8_GAS float* rowp = (PG8_GAS float*)H + (size_t)(row0 + ai * HALF + (2 * mp + m2) * 16) * ldc + col0;
#pragma unroll
                    for (int bj = 0; bj < 2; ++bj)
#pragma unroll
                        for (int n = 0; n < 2; ++n) *(PG8_GAS f32x4*)(rowp + bj * HALF + n * 16) = res[m2][bj][n] + acc[ai][bj][2 * mp + m2][n] * sc; }
                asm volatile("" ::: "memory");
            }
    }
};
template <int MODE, long long HB_OFF, long long RSQ_OFF> struct EpiResAddHB {
    static constexpr bool PERM = true, AFTER_DRAIN = false; static constexpr float hs = 4.f;
    float* H; int ldc; float sc;
    __device__ __forceinline__ void operator()(const f32x4 (&acc)[2][2][4][2], const Unit& u, int wr, int wc, int fr, int fq) const {
        const int row0 = u.pm * BM + wr * 64 + fr; const int col0 = u.pc * BM + wc * 32 + 8 * fq;
        PG8_GAS unsigned char* const HBo = (PG8_GAS unsigned char*)H + HB_OFF; PG8_GAS unsigned long long* const rsq = (PG8_GAS unsigned long long*)((PG8_GAS unsigned char*)H + RSQ_OFF);
#pragma unroll
        for (int ai = 0; ai < 2; ++ai)
#pragma unroll
            for (int m = 0; m < 4; ++m) { const int row = row0 + ai * HALF + m * 16; PG8_GAS float* rowp = (PG8_GAS float*)H + (size_t)row * ldc + col0;
                f32x4 r_[2][2];
#pragma unroll
                for (int bj = 0; bj < 2; ++bj)
#pragma unroll
                    for (int n = 0; n < 2; ++n) r_[bj][n] = *(const PG8_GAS f32x4*)(rowp + bj * HALF + n * 4);
                float ss = 0.f;
#pragma unroll
                for (int bj = 0; bj < 2; ++bj) { const f32x4 v0 = r_[bj][0] + acc[ai][bj][m][0] * sc, v1 = r_[bj][1] + acc[ai][bj][m][1] * sc;
                    *(PG8_GAS f32x4*)(rowp + bj * HALF) = v0; *(PG8_GAS f32x4*)(rowp + bj * HALF + 4) = v1;
                    ss += ((v0[0] * v0[0] + v0[1] * v0[1]) + (v0[2] * v0[2] + v0[3] * v0[3])) + ((v1[0] * v1[0] + v1[1] * v1[1]) + (v1[2] * v1[2] + v1[3] * v1[3]));
                    if constexpr (MODE == 1) { u32x4 w; w.x = cvt_pk_bf16(v0[0], v0[1]); w.y = cvt_pk_bf16(v0[2], v0[3]); w.z = cvt_pk_bf16(v1[0], v1[1]); w.w = cvt_pk_bf16(v1[2], v1[3]);
                        *(PG8_GAS u32x4*)((PG8_GAS bf16_t*)HBo + (size_t)row * ldc + col0 + bj * HALF) = w; }
                    else {
#define PG8_C8(x) __builtin_amdgcn_fmed3f((x) * hs, -448.f, 448.f)
                        unsigned lo = (unsigned)__builtin_amdgcn_cvt_pk_fp8_f32(PG8_C8(v0[0]), PG8_C8(v0[1]), 0, false); lo = (unsigned)__builtin_amdgcn_cvt_pk_fp8_f32(PG8_C8(v0[2]), PG8_C8(v0[3]), (int)lo, true);
                        unsigned hi = (unsigned)__builtin_amdgcn_cvt_pk_fp8_f32(PG8_C8(v1[0]), PG8_C8(v1[1]), 0, false); hi = (unsigned)__builtin_amdgcn_cvt_pk_fp8_f32(PG8_C8(v1[2]), PG8_C8(v1[3]), (int)hi, true);
#undef PG8_C8
                        *(PG8_GAS unsigned long long*)(HBo + (size_t)row * ldc + col0 + bj * HALF) = (unsigned long long)lo | ((unsigned long long)hi << 32); } }
                { auto p_ = __builtin_amdgcn_permlane16_swap(__float_as_uint(ss), __float_as_uint(ss), false, false); ss = __uint_as_float(p_[0]) + __uint_as_float(p_[1]); }
                { auto p_ = __builtin_amdgcn_permlane32_swap(__float_as_uint(ss), __float_as_uint(ss), false, false); ss = __uint_as_float(p_[0]) + __uint_as_float(p_[1]); }
                if (fq == 0) __hip_atomic_fetch_add(rsq + row, (unsigned long long)(ss * 16777216.f), __ATOMIC_RELAXED, __HIP_MEMORY_SCOPE_AGENT);
                asm volatile("" ::: "memory"); }
    }
};
template <bool OUT8> struct EpiSwigluT {
    static constexpr bool PERM = true, AFTER_DRAIN = false;
    bf16_t* O; int ldc; const float* rs; float sc; float o8; const unsigned long long* rsq;
    __device__ __forceinline__ void operator()(const f32x4 (&acc)[2][2][4][2], const Unit& u, int wr, int wc, int fr, int fq) const {
        const int row0 = u.pm * BM + wr * 64 + fr; const int col0 = u.pc * HALF + wc * 32 + 8 * fq;
        float sv[2][4];
#pragma unroll
        for (int ai = 0; ai < 2; ++ai)
#pragma unroll
            for (int m = 0; m < 4; ++m) sv[ai][m] = rsq ? sc * __builtin_amdgcn_rsqf((float)((const PG8_GAS unsigned long long*)rsq)[row0 + ai * HALF + m * 16] * (1.f / (16777216.f * 1024.f)) + 1e-6f) : (rs ? ((const PG8_GAS float*)rs)[row0 + ai * HALF + m * 16] : sc);
#pragma unroll
        for (int ai = 0; ai < 2; ++ai)
#pragma unroll
            for (int m = 0; m < 4; ++m) { const int row = row0 + ai * HALF + m * 16; const float s = sv[ai][m]; PG8_GAS bf16_t* rowp = (PG8_GAS bf16_t*)O + (size_t)row * ldc + col0;
                const float c1 = -1.4426950408889634f * s, c2 = OUT8 ? s * s * o8 : s * s;
                f32x2 q[4];
#pragma unroll
                for (int n = 0; n < 2; ++n)
#pragma unroll
                    for (int h = 0; h < 2; ++h) { const f32x4 av = acc[ai][0][m][n], bv = acc[ai][1][m][n];
                        const f32x2 a = h ? (f32x2){av[2], av[3]} : (f32x2){av[0], av[1]}, b = h ? (f32x2){bv[2], bv[3]} : (f32x2){bv[0], bv[1]};
                        const f32x2 t = a * c1; f32x2 e; e.x = __builtin_amdgcn_exp2f(t.x); e.y = __builtin_amdgcn_exp2f(t.y);
                        const f32x2 d = e + 1.f; f32x2 r; r.x = __builtin_amdgcn_rcpf(d.x); r.y = __builtin_amdgcn_rcpf(d.y);
                        q[2 * n + h] = ((a * b) * r) * c2; }
                if constexpr (OUT8) { PG8_GAS unsigned char* rp8 = (PG8_GAS unsigned char*)O + (size_t)row * ldc + col0;
#define PG8_C8(x) __builtin_amdgcn_fmed3f((x), -448.f, 448.f)
                    unsigned lo = (unsigned)__builtin_amdgcn_cvt_pk_fp8_f32(PG8_C8(q[0].x), PG8_C8(q[0].y), 0, false); lo = (unsigned)__builtin_amdgcn_cvt_pk_fp8_f32(PG8_C8(q[1].x), PG8_C8(q[1].y), (int)lo, true);
                    unsigned hi = (unsigned)__builtin_amdgcn_cvt_pk_fp8_f32(PG8_C8(q[2].x), PG8_C8(q[2].y), 0, false); hi = (unsigned)__builtin_amdgcn_cvt_pk_fp8_f32(PG8_C8(q[3].x), PG8_C8(q[3].y), (int)hi, true);
#undef PG8_C8
                    *(PG8_GAS unsigned long long*)rp8 = (unsigned long long)lo | ((unsigned long long)hi << 32); }
                else { u32x4 w; w.x = cvt_pk_bf16(q[0].x, q[0].y); w.y = cvt_pk_bf16(q[1].x, q[1].y); w.z = cvt_pk_bf16(q[2].x, q[2].y); w.w = cvt_pk_bf16(q[3].x, q[3].y);
                    *(PG8_GAS u32x4*)rowp = w; } }
    }
};
typedef EpiSwigluT<false> EpiSwiglu; typedef EpiSwigluT<true> EpiSwiglu8;

template <class Epi, class Sched, bool ALIGN_EPI = false, bool SP2 = false, bool FP8 = false>
__device__ __forceinline__ void gemm_phase(PG8_LAS unsigned char* lds, const Gemm g, const Sched& S, const Epi& E, int tid_in) {
    int tid_ = tid_in; asm volatile("" : "+v"(tid_));
    const int tid = tid_, wid = __builtin_amdgcn_readfirstlane(tid >> 6), lane = tid & 63, wr = wid >> 2, wc = wid & 3, fr = lane & 15, fq = lane >> 4;
    const int K = g.K, nt = K / BK;
    unsigned voffA[2], voffB[2];
#pragma unroll
    for (int i = 0; i < 2; ++i) { int R, C; stage_rc(tid * 16 + i * 8192, R, C); const int Rb = Epi::PERM ? ((R & ~31) + perm32(R & 31)) : R;
        voffA[i] = (unsigned)(R * K + C) * 2u; voffB[i] = (unsigned)(Rb * K + C) * 2u; }
    const size_t kstep = (size_t)(BK * 2);
    const size_t hstep = (size_t)HALF * K * 2;
    const size_t tstep = 2 * hstep;
    const unsigned ldsw = (unsigned)wid * 1024u;
    const int aoff = lds_byte(wr * 64 + fr, fq * 8), boff = lds_byte(wc * 32 + fr, fq * 8);
#define PG8_SA(b, h) (((b) * 2 + (h)) * HTB)
#define PG8_SB(b, h) ((4 + (b) * 2 + (h)) * HTB)
#define PG8_STAGE(bufoff, gbase, voff) do { _Pragma("unroll") for (int _i = 0; _i < 2; ++_i) \
        __builtin_amdgcn_global_load_lds((const unsigned*)((const char*)(gbase) + (voff)[_i]), (PG8_LAS unsigned*)(lds + (bufoff) + ldsw + _i * 8192), 16, 0, 0); } while (0)
#define PG8_LDA(dst, b, h) do { _Pragma("unroll") for (int m = 0; m < 4; ++m) _Pragma("unroll") for (int k = 0; k < 2; ++k) dst[m][k] = *(const PG8_LAS bf16x8*)(lds + PG8_SA(b, h) + aoff + m * 2048 + k * 1024); } while (0)
#define PG8_LDB(dst, b, h) do { _Pragma("unroll") for (int n = 0; n < 2; ++n) _Pragma("unroll") for (int k = 0; k < 2; ++k) dst[n][k] = *(const PG8_LAS bf16x8*)(lds + PG8_SB(b, h) + boff + n * 2048 + k * 1024); } while (0)
#define PG8_MMA(ai, bj, At, Bt) do { __builtin_amdgcn_s_setprio(1); \
        if constexpr (FP8) { typedef int v8i_ __attribute__((ext_vector_type(8))); typedef int v4i_ __attribute__((ext_vector_type(4))); const int sc8_ = 0x7f7f7f7f;     \
            _Pragma("unroll") for (int m = 0; m < 4; ++m) _Pragma("unroll") for (int n = 0; n < 2; ++n) { \
                const v4i_ b0_ = __builtin_bit_cast(v4i_, Bt[n][0]), b1_ = __builtin_bit_cast(v4i_, Bt[n][1]), a0_ = __builtin_bit_cast(v4i_, At[m][0]), a1_ = __builtin_bit_cast(v4i_, At[m][1]); \
                const v8i_ bb_ = (v8i_){b0_.x, b0_.y, b0_.z, b0_.w, b1_.x, b1_.y, b1_.z, b1_.w}, aa_ = (v8i_){a0_.x, a0_.y, a0_.z, a0_.w, a1_.x, a1_.y, a1_.z, a1_.w}; \
                asm volatile("v_mfma_scale_f32_16x16x128_f8f6f4 %0, %1, %2, %0, %3, %3 op_sel_hi:[0,0,0]" : "+v"(acc[ai][bj][m][n]) : "v"(bb_), "v"(aa_), "v"(sc8_)); } \
        } else { _Pragma("unroll") for (int m = 0; m < 4; ++m) _Pragma("unroll") for (int n = 0; n < 2; ++n) _Pragma("unroll") for (int k = 0; k < 2; ++k) \
            acc[ai][bj][m][n] = __builtin_amdgcn_mfma_f32_16x16x32_bf16(Bt[n][k], At[m][k], acc[ai][bj][m][n], 0, 0, 0); } \
        __builtin_amdgcn_s_setprio(0); } while (0)
#define PG8_WAIT_V(n) asm volatile("s_waitcnt vmcnt(" #n ")" ::: "memory")
#define PG8_WAIT_L(n) asm volatile("s_waitcnt lgkmcnt(" #n ")" ::: "memory")
#define PG8_BAR __builtin_amdgcn_s_barrier()
#define PG8_SCHED __builtin_amdgcn_sched_barrier(0)
    Unit cur, nxt; int ui = 0;
    if (!S.next(0, cur)) return;
    f32x4 acc[2][2][4][2];
    { float zf; asm volatile("v_mov_b32 %0, 0" : "=v"(zf));
#pragma unroll
    for (int a = 0; a < 2; ++a)
#pragma unroll
        for (int b = 0; b < 2; ++b)
#pragma unroll
            for (int m = 0; m < 4; ++m)
#pragma unroll
                for (int n = 0; n < 2; ++n) acc[a][b][m][n] = (f32x4){zf, zf, zf, zf}; }
    bf16x8 At[4][2], B0[2][2], B1[2][2];
    const char* cA = (const char*)g.A + (size_t)cur.pm * tstep; const char* cB = (const char*)g.Bt + (size_t)cur.pn * tstep;
    S.a_ready(cur);
    if constexpr (SP2) {
        PG8_STAGE(PG8_SB(0, 0), cB, voffB); PG8_STAGE(PG8_SB(0, 1), cB + hstep, voffB); PG8_STAGE(PG8_SA(0, 0), cA, voffA); PG8_STAGE(PG8_SA(0, 1), cA + hstep, voffA);
        if (wr == 1) PG8_BAR;
        PG8_WAIT_V(2); PG8_BAR;
        PG8_STAGE(PG8_SB(1, 0), cB + kstep, voffB); PG8_STAGE(PG8_SA(1, 0), cA + kstep, voffA); PG8_STAGE(PG8_SB(1, 1), cB + hstep + kstep, voffB);
        PG8_WAIT_V(6); PG8_BAR;
    } else {
        PG8_STAGE(PG8_SB(0, 0), cB, voffB); PG8_STAGE(PG8_SA(0, 0), cA, voffA); PG8_STAGE(PG8_SB(0, 1), cB + hstep, voffB); PG8_STAGE(PG8_SA(0, 1), cA + hstep, voffA);
        if (wr == 1) PG8_BAR;
        PG8_WAIT_V(4); PG8_BAR;
        PG8_STAGE(PG8_SB(1, 0), cB + kstep, voffB); PG8_STAGE(PG8_SA(1, 0), cA + kstep, voffA); PG8_STAGE(PG8_SB(1, 1), cB + hstep + kstep, voffB);
        PG8_WAIT_V(6); PG8_BAR;
    }
    for (;;) {
        const bool has_next = S.next(ui + 1, nxt);
        const char* nA = has_next ? (const char*)g.A + (size_t)nxt.pm * tstep : cA; const char* nB = has_next ? (const char*)g.Bt + (size_t)nxt.pn * tstep : cB;
        for (int t = 0; t < nt; t += 2) {
            const bool last = (t == nt - 2);
            const char* a1 = cA + (size_t)(t + 1) * kstep;
            const char* a2 = last ? nA : cA + (size_t)(t + 2) * kstep; const char* b2 = last ? nB : cB + (size_t)(t + 2) * kstep;
            const char* a3 = a2 + kstep; const char* b3 = b2 + kstep;
            if (last && has_next) S.a_ready(nxt);
            if constexpr (SP2) {
            PG8_LDB(B0, 0, 0); PG8_LDB(B1, 0, 1); PG8_SCHED; PG8_LDA(At, 0, 0); PG8_STAGE(PG8_SA(1, 1), a1 + hstep, voffA);
            PG8_WAIT_V(8); PG8_WAIT_L(0); PG8_BAR; PG8_MMA(0, 0, At, B0); PG8_MMA(0, 1, At, B1); PG8_BAR; PG8_SCHED;
            PG8_LDA(At, 0, 1); PG8_STAGE(PG8_SB(0, 0), b2, voffB); PG8_STAGE(PG8_SB(0, 1), b2 + hstep, voffB); PG8_STAGE(PG8_SA(0, 0), a2, voffA);
            PG8_WAIT_V(8); PG8_WAIT_L(0); PG8_BAR; PG8_MMA(1, 0, At, B0); PG8_MMA(1, 1, At, B1); PG8_BAR; PG8_SCHED;
            PG8_LDB(B0, 1, 0); PG8_LDB(B1, 1, 1); PG8_SCHED; PG8_LDA(At, 1, 0); PG8_STAGE(PG8_SA(0, 1), a2 + hstep, voffA);
            PG8_WAIT_V(8); PG8_WAIT_L(0); PG8_BAR; PG8_MMA(0, 0, At, B0); PG8_MMA(0, 1, At, B1); PG8_BAR; PG8_SCHED;
            PG8_LDA(At, 1, 1); PG8_STAGE(PG8_SB(1, 0), b3, voffB); PG8_STAGE(PG8_SB(1, 1), b3 + hstep, voffB); PG8_STAGE(PG8_SA(1, 0), a3, voffA);
            PG8_WAIT_V(8); PG8_WAIT_L(0); PG8_BAR; PG8_MMA(1, 0, At, B0); PG8_MMA(1, 1, At, B1); PG8_BAR; PG8_SCHED;
            } else {
            PG8_LDB(B0, 0, 0); PG8_SCHED; PG8_LDA(At, 0, 0); PG8_STAGE(PG8_SA(1, 1), a1 + hstep, voffA);
            PG8_WAIT_L(8); PG8_BAR; PG8_WAIT_L(0); PG8_MMA(0, 0, At, B0); PG8_BAR; PG8_SCHED;
            PG8_LDB(B1, 0, 1); PG8_STAGE(PG8_SB(0, 0), b2, voffB);
            PG8_BAR; PG8_WAIT_L(0); PG8_MMA(0, 1, At, B1); PG8_BAR;
            PG8_LDA(At, 0, 1); PG8_STAGE(PG8_SA(0, 0), a2, voffA);
            PG8_BAR; PG8_WAIT_L(0); PG8_MMA(1, 0, At, B0); PG8_BAR; PG8_SCHED;
            PG8_STAGE(PG8_SB(0, 1), b2 + hstep, voffB);
            PG8_WAIT_V(6); PG8_BAR; PG8_MMA(1, 1, At, B1); PG8_BAR;
            PG8_LDB(B0, 1, 0); PG8_SCHED; PG8_LDA(At, 1, 0); PG8_STAGE(PG8_SA(0, 1), a2 + hstep, voffA);
            PG8_WAIT_L(8); PG8_BAR; PG8_WAIT_L(0); PG8_MMA(0, 0, At, B0); PG8_BAR; PG8_SCHED;
            PG8_LDB(B1, 1, 1); PG8_STAGE(PG8_SB(1, 0), b3, voffB);
            PG8_BAR; PG8_WAIT_L(0); PG8_MMA(0, 1, At, B1); PG8_BAR;
            PG8_LDA(At, 1, 1); PG8_STAGE(PG8_SA(1, 0), a3, voffA);
            PG8_BAR; PG8_WAIT_L(0); PG8_MMA(1, 0, At, B0); PG8_BAR; PG8_SCHED;
            PG8_STAGE(PG8_SB(1, 1), b3 + hstep, voffB);
            PG8_WAIT_V(6); PG8_BAR; PG8_MMA(1, 1, At, B1); PG8_BAR;
            }
        }
        if constexpr (FP8) asm volatile("s_nop 15\n\ts_nop 15\n\ts_nop 15" ::: "memory");
        if constexpr (ALIGN_EPI) { if (wr == 0) PG8_BAR; }
        if constexpr (!Epi::AFTER_DRAIN) { E(acc, cur, wr, wc, fr, fq); S.done(cur); }
        if (!has_next) break;
        { float zf; asm volatile("v_mov_b32 %0, 0" : "=v"(zf));
#pragma unroll
        for (int a = 0; a < 2; ++a)
#pragma unroll
            for (int b = 0; b < 2; ++b)
#pragma unroll
                for (int m = 0; m < 4; ++m)
#pragma unroll
                    for (int n = 0; n < 2; ++n) acc[a][b][m][n] = (f32x4){zf, zf, zf, zf}; }
        cur = nxt; cA = nA; cB = nB; ++ui;
        if constexpr (ALIGN_EPI) { if (wr == 1) PG8_BAR; }
    }
    PG8_WAIT_V(0);
    if constexpr (!ALIGN_EPI) { if (wr == 0) PG8_BAR; }
    PG8_BAR;
    if constexpr (Epi::AFTER_DRAIN) { E.fused(acc, cur, wr, wc, fr, fq, lds, wid, lane); S.done(cur); }
#undef PG8_SA
#undef PG8_SB
#undef PG8_STAGE
#undef PG8_LDA
#undef PG8_LDB
#undef PG8_MMA
#undef PG8_WAIT_V
#undef PG8_WAIT_L
#undef PG8_BAR
#undef PG8_SCHED
}
}
#include <hip/hip_bf16.h>
#include <cmath>
namespace attn_body {
using bf16=__hip_bfloat16;
using bf16x8=__attribute__((ext_vector_type(8)))short;
using s16x4=__attribute__((ext_vector_type(4)))short;
using f32x16=__attribute__((ext_vector_type(16)))float;
using u32x4=__attribute__((ext_vector_type(4)))unsigned;
constexpr int BATCH=4,NHEAD=8,SEQ=4096,D=64,DM=512,DMO=1024,KVSEQ=4224;
constexpr int NW=8,QBLK=32,QB=QBLK*NW,KVBLK=64,NQB=SEQ/QB;
constexpr int ATTN_UNIT_ROWS=QB;
__device__ __forceinline__ int crow(int r,int hi){return (r&3)+8*(r>>2)+4*hi;}
#define SBAR() __builtin_amdgcn_sched_barrier(0)
__device__ __forceinline__ void cmask(f32x16&p0,f32x16&p1,int jb,int qrel,int hi){
  const float NEG=-INFINITY; int kb=64*jb+4*hi;
  #pragma unroll
  for(int r=0;r<16;++r){int kv=kb+(r&3)+8*(r>>2); if(kv>qrel)p0[r]=NEG; if(kv+32>qrel)p1[r]=NEG;}
}

constexpr int NSLOT=3, SLOTB=8192;
constexpr int LDS_K=0, LDS_V=NSLOT*SLOTB, LDS_V2=2*NSLOT*SLOTB, LDS_WS=3*NSLOT*SLOTB, LDS_OST=LDS_WS+NW*64*4, LDS_BYTES=LDS_OST+NW*4096;
constexpr float C2=0.125f*1.4426950408889634f;
__device__ __forceinline__ void glds16(const void*gsrc,unsigned lds_dst){unsigned keep;
  asm volatile("s_mov_b32 %0, m0\n\ts_mov_b32 m0, %2\n\ts_nop 0\n\tglobal_load_lds_dwordx4 %1, off\n\ts_mov_b32 m0, %0":"=&s"(keep):"v"(gsrc),"s"(lds_dst):"memory");}
__device__ __forceinline__ void glds16s(const void*sbase,unsigned voff,unsigned lds_dst){unsigned keep;
  asm volatile("s_mov_b32 %0, m0\n\ts_mov_b32 m0, %3\n\ts_nop 0\n\tglobal_load_lds_dwordx4 %1, %2\n\ts_mov_b32 m0, %0":"=&s"(keep):"v"(voff),"s"(sbase),"s"(lds_dst):"memory");}
__device__ __forceinline__ float max3f(float a,float b,float c){float r;asm("v_max3_f32 %0, %1, %2, %3":"=v"(r):"v"(a),"v"(b),"v"(c));return r;}
__device__ __forceinline__ float max2f(float a,float b){float r;asm("v_max_f32_e32 %0, %1, %2":"=v"(r):"v"(a),"v"(b));return r;}
__device__ __forceinline__ float fadd_s(float a,float b){float r;asm("v_add_f32_e32 %0, %1, %2":"=v"(r):"v"(a),"v"(b));return r;}
__device__ __forceinline__ float fsub_s(float a,float b){float r;asm("v_sub_f32_e32 %0, %1, %2":"=v"(r):"v"(a),"v"(b));return r;}
typedef float f32x2_t __attribute__((ext_vector_type(2))); typedef __bf16 bf16x2_t __attribute__((ext_vector_type(2)));
__device__ __forceinline__ unsigned cvtpk_s(float lo,float hi){f32x2_t v={lo,hi};bf16x2_t b=__builtin_convertvector(v,bf16x2_t);return __builtin_bit_cast(unsigned,b);}
#define WAIT_BAR(N) asm volatile("s_waitcnt vmcnt(" #N ") lgkmcnt(0)\n\ts_barrier":::"memory")

typedef __attribute__((address_space(3))) const char* lds_cptr;
__device__ __forceinline__ void qkt(f32x16&p0,f32x16&p1,lds_cptr Kslot,const bf16x8*qr,const f32x16&negm0,const f32x16&negm1,int r32,int hi){
  const lds_cptr kb=Kslot+hi*1024+r32*16;
  #pragma unroll
  for(int d0=0;d0<4;++d0){
    const bf16x8 b0=*(const __attribute__((address_space(3))) bf16x8*)(kb+d0*2048);
    const bf16x8 b1=*(const __attribute__((address_space(3))) bf16x8*)(kb+d0*2048+512);
    if(d0==0){p0=__builtin_amdgcn_mfma_f32_32x32x16_bf16(b0,qr[0],negm0,0,0,0);p1=__builtin_amdgcn_mfma_f32_32x32x16_bf16(b1,qr[0],negm1,0,0,0);}
    else{p0=__builtin_amdgcn_mfma_f32_32x32x16_bf16(b0,qr[d0],p0,0,0,0);p1=__builtin_amdgcn_mfma_f32_32x32x16_bf16(b1,qr[d0],p1,0,0,0);}}
}
typedef short v4i16_t __attribute__((ext_vector_type(4)));
__device__ __forceinline__ void kload8(bf16x8*kf,lds_cptr kp){
  kf[0]=*(const __attribute__((address_space(3))) bf16x8*)(kp);      kf[1]=*(const __attribute__((address_space(3))) bf16x8*)(kp+512);
  kf[2]=*(const __attribute__((address_space(3))) bf16x8*)(kp+2048); kf[3]=*(const __attribute__((address_space(3))) bf16x8*)(kp+2560);
  kf[4]=*(const __attribute__((address_space(3))) bf16x8*)(kp+4096); kf[5]=*(const __attribute__((address_space(3))) bf16x8*)(kp+4608);
  kf[6]=*(const __attribute__((address_space(3))) bf16x8*)(kp+6144); kf[7]=*(const __attribute__((address_space(3))) bf16x8*)(kp+6656);
}
__device__ __forceinline__ void kload2(bf16x8*kf,lds_cptr kp,int j){ kf[2*j]=*(const __attribute__((address_space(3))) bf16x8*)(kp+j*2048); kf[2*j+1]=*(const __attribute__((address_space(3))) bf16x8*)(kp+j*2048+512); }
__device__ __forceinline__ s16x4 vtr(lds_cptr p){ return __builtin_bit_cast(s16x4,__builtin_amdgcn_ds_read_tr16_b64_v4i16((__attribute__((address_space(3))) v4i16_t*)p)); }
__device__ __forceinline__ float rowmax(const f32x16&p0,const f32x16&p1){
  float a=max3f(p0[0],p0[1],p1[0]),b=max3f(p0[2],p0[3],p1[1]);a=max3f(a,p1[2],p1[3]);
  #pragma unroll
  for(int r=4;r<16;r+=4){a=max3f(a,p0[r],p0[r+1]);b=max3f(b,p0[r+2],p0[r+3]);a=max3f(a,p1[r],p1[r+1]);b=max3f(b,p1[r+2],p1[r+3]);}
  const float m=max2f(a,b);
  auto rr=__builtin_amdgcn_permlane32_swap(__float_as_uint(m),__float_as_uint(m),false,false);
  return max2f(__uint_as_float(rr[0]),__uint_as_float(rr[1]));
}
__device__ __forceinline__ void pv(f32x16*o,int vb,bf16x8 pa0,bf16x8 pa1,bf16x8 pa2,bf16x8 pa3){
  #pragma unroll
  for(int d0=0;d0<2;++d0){s16x4 lo[4],hi[4];
    #pragma unroll
    for(int ks=0;ks<4;++ks){
      asm volatile("ds_read_b64_tr_b16 %0,%1 offset:%c2":"=&v"(lo[ks]):"v"(vb),"i"(d0*4096+ks*1024):"memory");
      asm volatile("ds_read_b64_tr_b16 %0,%1 offset:%c2":"=&v"(hi[ks]):"v"(vb),"i"(d0*4096+ks*1024+512):"memory");}
    asm volatile("s_waitcnt lgkmcnt(0)":::"memory");SBAR();
    #define PK(k) (bf16x8){lo[k][0],lo[k][1],lo[k][2],lo[k][3],hi[k][0],hi[k][1],hi[k][2],hi[k][3]}
    o[d0]=__builtin_amdgcn_mfma_f32_32x32x16_bf16(pa0,PK(0),o[d0],0,0,0);
    o[d0]=__builtin_amdgcn_mfma_f32_32x32x16_bf16(pa1,PK(1),o[d0],0,0,0);
    o[d0]=__builtin_amdgcn_mfma_f32_32x32x16_bf16(pa2,PK(2),o[d0],0,0,0);
    o[d0]=__builtin_amdgcn_mfma_f32_32x32x16_bf16(pa3,PK(3),o[d0],0,0,0);
    #undef PK
  }
}

#ifndef ATTN_STORE16
#define ATTN_STORE16(p,v) (*(u32x4*)(p)=(v))
#endif
template<int THRL> __device__ __forceinline__ void attn_unit(int b,int hc,int qb,const bf16*Q,const bf16*__restrict__ K,const bf16*__restrict__ V,bf16*O,char*shm,int tid_in){
  int tid_=tid_in; asm volatile("":"+v"(tid_)); const int tid=tid_,lane=tid&63,r32=lane&31,hi=lane>>5; const int wid=__builtin_amdgcn_readfirstlane(tid>>6);
  const long rowbase=(long)b*SEQ, kvbase=(long)b*KVSEQ; const int q0=qb*QB;
  const bf16*Qw=Q+(rowbase+q0+wid*QBLK)*DM+hc*D;
  const bf16*Kh=K+kvbase*DM+hc*D,*Vh=V+kvbase*DM+(hc>>1)*128;
  const unsigned lds0=(unsigned)(uintptr_t)shm;
  typedef __attribute__((address_space(3))) float lds_f32; typedef __attribute__((address_space(3))) unsigned short lds_u16; typedef __attribute__((address_space(3))) char lds_char;
  lds_f32*wsf=(lds_f32*)((lds_char*)shm+LDS_WS)+wid*64;
  const bf16*ksb=Kh+wid*8; const unsigned kvo=(unsigned)lane*(DM*2);
  const bf16*vsb=Vh+(long)(16*(wid&3))*DM+(wid>>2)*32; const unsigned vvo=(unsigned)((lane>>2)*DM+(lane&3)*8)*2u;
  const unsigned kdst=lds0+LDS_K+wid*1024, vdst=lds0+LDS_V+wid*1024, vdst2=lds0+LDS_V2+wid*1024;
  #define DMA_K(t,slot) glds16s(ksb+(long)(t)*KVBLK*DM,kvo,(unsigned)__builtin_amdgcn_readfirstlane(kdst+(slot)))
  #define DMA_V(t,slot) do{ glds16s(vsb+(long)(t)*KVBLK*DM,vvo,(unsigned)__builtin_amdgcn_readfirstlane(vdst+(slot))); glds16s(vsb+(long)(t)*KVBLK*DM+64,vvo,(unsigned)__builtin_amdgcn_readfirstlane(vdst2+(slot))); }while(0)
  const int vb0=(int)(lds0+LDS_V)+((lane>>4)&1)*32+(lane&3)*8+(4*hi+((lane&15)>>2))*64;
  bf16x8 kf[8];
  const lds_cptr shm3=(lds_cptr)shm; const lds_cptr kp0=shm3+LDS_K+hi*1024+r32*16; const lds_cptr vp0=shm3+LDS_V+((lane>>4)&1)*32+(lane&3)*8+(4*hi+((lane&15)>>2))*64;
  const int NT=(q0+QB)/KVBLK+2;
  DMA_K(0,0);DMA_V(0,0);DMA_K(1,SLOTB);
  bf16x8 qr[4];
  #pragma unroll
  for(int d0=0;d0<4;++d0)qr[d0]=*reinterpret_cast<const bf16x8*>(&Qw[(long)r32*DM+d0*16+hi*8]);
  float mhat=0.f,l_reg=0.f;f32x16 o[4];o[0]=f32x16{};o[1]=f32x16{};o[2]=f32x16{};o[3]=f32x16{};f32x16 negm=f32x16{};asm volatile("":"+v"(negm));
  const int qrel=wid*QBLK+r32;
  #define CMASK(P0,P1,t) do{int jb_=(t)-(NT-4); if(jb_>=0)cmask(P0,P1,jb_,qrel,hi);}while(0)
  bool resc=false;
  #define START(P0,P1) do{ const float rm=rowmax(P0,P1); resc=false; \
    { const float dl=rm; mhat=fadd_s(mhat,dl); \
      _Pragma("unroll") for(int r=0;r<16;++r){P0[r]=fsub_s(P0[r],dl);P1[r]=fsub_s(P1[r],dl);} \
      _Pragma("unroll") for(int r=0;r<16;++r)negm[r]=-mhat; asm volatile("":"+v"(negm)); } \
    _Pragma("unroll") for(int r=0;r<16;++r)P0[r]=__builtin_amdgcn_exp2f(P0[r]); }while(0)
  #define RESC() do{ if(resc){ asm volatile("s_waitcnt lgkmcnt(0)":::"memory"); \
      _Pragma("unroll") for(int d_=0;d_<4;++d_) _Pragma("unroll") for(int r=0;r<16;++r)o[d_][r]*=wsf[crow(r,hi)]; } }while(0)
  f32x16 pA0,pA1,pB0,pB1;
  int sl_prev=0,sl_cur=0,sl_next=SLOTB;
  #define ROT() do{sl_prev=sl_cur;sl_cur=sl_next;sl_next=(sl_next==(NSLOT-1)*SLOTB)?0:sl_next+SLOTB;}while(0)
  DMA_K(2,2*SLOTB);
  WAIT_BAR(4);
  { f32x16 cm0,cm1; _Pragma("unroll") for(int r=0;r<16;++r){cm0[r]=-INFINITY;cm1[r]=(r<8)?-INFINITY:0.f;} asm volatile("":"+v"(cm0),"+v"(cm1));
    qkt(pA0,pA1,shm3+LDS_K,qr,cm0,cm1,r32,hi); }
  asm volatile("s_nop 15\n\ts_nop 7":"+v"(pA0),"+v"(pA1));CMASK(pA0,pA1,0);
  START(pA0,pA1);
  _Pragma("unroll") for(int r=0;r<16;++r)pA1[r]=__builtin_amdgcn_exp2f(pA1[r]);
  _Pragma("unroll") for(int r=0;r<16;++r)negm[r]=-INFINITY; asm volatile("":"+v"(negm));
  WAIT_BAR(0);
  DMA_K(3,0);DMA_V(1,SLOTB);
  ROT();
  kload8(kf,kp0+sl_cur);
  WAIT_BAR(3);
  s16x4 vlo[8],vhi[8],wlo[8],whi[8]; u32x4 pw0,pw1,pw2,pw3;
  #define PKW(P,B) cvtpk_s(P[B],P[B+1])
  #define PAF(k) __builtin_bit_cast(bf16x8,pw##k)
  #define VFR(i) (bf16x8){vlo[i][0],vlo[i][1],vlo[i][2],vlo[i][3],vhi[i][0],vhi[i][1],vhi[i][2],vhi[i][3]}
  #define WFR(i) (bf16x8){wlo[i][0],wlo[i][1],wlo[i][2],wlo[i][3],whi[i][0],whi[i][1],whi[i][2],whi[i][3]}
  #define PIN(x) asm volatile("":"+v"(x))
  #define MX3(a,b,c) __builtin_fmaxf(__builtin_fmaxf((a),(b)),(c))
  #define GAPA(MF,A0,A1,A2,A3,W0,W1,PW) do{ MF; sacc+=A0; sacc+=A1; sacc+=A2; sacc+=A3; PIN(sacc); W0; W1; PIN(PW); SBAR(); }while(0)
  #define EX(v) __builtin_amdgcn_exp2f(v)
  #define GAPB(MF,X,B) do{ MF; X[B]=EX(X[B]); X[B+1]=EX(X[B+1]); PIN(X); SBAR(); }while(0)
  #define VRD(i) do{ vlo[i]=vtr(vp_+(((i)>>2)*4096+((i)&3)*1024)); vhi[i]=vtr(vp_+(((i)>>2)*4096+((i)&3)*1024+512)); }while(0)
  #define WRD(i) do{ wlo[i]=vtr(vp_+((LDS_V2-LDS_V)+((i)>>2)*4096+((i)&3)*1024)); whi[i]=vtr(vp_+((LDS_V2-LDS_V)+((i)>>2)*4096+((i)&3)*1024+512)); SBAR(); }while(0)
  #define KRD(G,j) do{ if(G){ kload2(kf,kp0+sl_next,j); SBAR(); } }while(0)
  #define STEP(C0,C1,P0,P1,t,GK,GV,GL) do{ SBAR(); \
    const lds_cptr vp_=vp0+sl_prev; \
    float sacc=(P0[0]+P0[1]); \
    GAPA(C0=__builtin_amdgcn_mfma_f32_32x32x16_bf16(kf[0],qr[0],negm,0,0,0), P0[2],P0[3],P0[4],P0[5],     pw0[0]=PKW(P0,0), pw0[1]=PKW(P0,2), pw0); \
    GAPA(C1=__builtin_amdgcn_mfma_f32_32x32x16_bf16(kf[1],qr[0],negm,0,0,0), P0[6],P0[7],P0[8],P0[9],     pw0[2]=PKW(P0,4), pw0[3]=PKW(P0,6), pw0); \
    GAPA(C0=__builtin_amdgcn_mfma_f32_32x32x16_bf16(kf[2],qr[1],C0,0,0,0),   P0[10],P0[11],P0[12],P0[13], pw1[0]=PKW(P0,8), pw1[1]=PKW(P0,10), pw1); \
    GAPA(C1=__builtin_amdgcn_mfma_f32_32x32x16_bf16(kf[3],qr[1],C1,0,0,0),   P0[14],P0[15],P1[0],P1[1],   pw1[2]=PKW(P0,12),pw1[3]=PKW(P0,14), pw1); \
    GAPA(C0=__builtin_amdgcn_mfma_f32_32x32x16_bf16(kf[4],qr[2],C0,0,0,0),   P1[2],P1[3],P1[4],P1[5],     pw2[0]=PKW(P1,0), pw2[1]=PKW(P1,2), pw2); \
    GAPA(C1=__builtin_amdgcn_mfma_f32_32x32x16_bf16(kf[5],qr[2],C1,0,0,0),   P1[6],P1[7],P1[8],P1[9],     pw2[2]=PKW(P1,4), pw2[3]=PKW(P1,6), pw2); \
    GAPA(C0=__builtin_amdgcn_mfma_f32_32x32x16_bf16(kf[6],qr[3],C0,0,0,0),   P1[10],P1[11],P1[12],P1[13], pw3[0]=PKW(P1,8), pw3[1]=PKW(P1,10), pw3); \
    GAPA(C1=__builtin_amdgcn_mfma_f32_32x32x16_bf16(kf[7],qr[3],C1,0,0,0),   P1[14],P1[15],0.f,0.f,       pw3[2]=PKW(P1,12),pw3[3]=PKW(P1,14), pw3); \
    l_reg+=sacc; \
    VRD(0);VRD(4);VRD(1);VRD(5);VRD(2);VRD(6);VRD(3);VRD(7); SBAR();     \
    if(GK){DMA_K((t)+3,sl_cur);} if(GV){DMA_V((t)+1,sl_next);} \
    CMASK(C0,C1,t); \
    { float a=MX3(C0[0],C0[1],C1[0]),b=MX3(C0[2],C0[3],C1[1]); a=MX3(a,C1[2],C1[3]); \
      _Pragma("unroll") for(int r=4;r<16;r+=4){a=MX3(a,C0[r],C0[r+1]);b=MX3(b,C0[r+2],C0[r+3]);a=MX3(a,C1[r],C1[r+1]);b=MX3(b,C1[r+2],C1[r+3]);} \
      float rm=__builtin_fmaxf(a,b); { auto rr=__builtin_amdgcn_permlane32_swap(__float_as_uint(rm),__float_as_uint(rm),false,false); rm=__builtin_fmaxf(__uint_as_float(rr[0]),__uint_as_float(rr[1])); } \
      resc=false; \
      if(__builtin_expect(__any(rm>(float)THRL),0)){ const float dl=__builtin_fmaxf(rm,0.f); mhat+=dl; \
        _Pragma("unroll") for(int r=0;r<16;++r){C0[r]-=dl;C1[r]-=dl;} \
        _Pragma("unroll") for(int r=0;r<16;++r)negm[r]=-mhat; asm volatile("":"+v"(negm)); \
        const float f=__builtin_amdgcn_exp2f(-dl); l_reg*=f; if(hi==0)wsf[r32]=f; resc=true; } } \
    SBAR(); \
    GAPB(o[0]=__builtin_amdgcn_mfma_f32_32x32x16_bf16(PAF(0),VFR(0),o[0],0,0,0), C0,0);  WRD(0); \
    GAPB(o[1]=__builtin_amdgcn_mfma_f32_32x32x16_bf16(PAF(0),VFR(4),o[1],0,0,0), C0,2);  WRD(4); \
    KRD(GL,0); GAPB(o[0]=__builtin_amdgcn_mfma_f32_32x32x16_bf16(PAF(1),VFR(1),o[0],0,0,0), C0,4);  WRD(1); \
    KRD(GL,1); GAPB(o[1]=__builtin_amdgcn_mfma_f32_32x32x16_bf16(PAF(1),VFR(5),o[1],0,0,0), C0,6);  WRD(5); \
    KRD(GL,2); GAPB(o[0]=__builtin_amdgcn_mfma_f32_32x32x16_bf16(PAF(2),VFR(2),o[0],0,0,0), C0,8);  WRD(2); \
    KRD(GL,3); GAPB(o[1]=__builtin_amdgcn_mfma_f32_32x32x16_bf16(PAF(2),VFR(6),o[1],0,0,0), C0,10); WRD(6); \
    GAPB(o[0]=__builtin_amdgcn_mfma_f32_32x32x16_bf16(PAF(3),VFR(3),o[0],0,0,0), C0,12); WRD(3); \
    GAPB(o[1]=__builtin_amdgcn_mfma_f32_32x32x16_bf16(PAF(3),VFR(7),o[1],0,0,0), C0,14); WRD(7); \
    GAPB(o[2]=__builtin_amdgcn_mfma_f32_32x32x16_bf16(PAF(0),WFR(0),o[2],0,0,0), C1,0); \
    GAPB(o[3]=__builtin_amdgcn_mfma_f32_32x32x16_bf16(PAF(0),WFR(4),o[3],0,0,0), C1,2); \
    GAPB(o[2]=__builtin_amdgcn_mfma_f32_32x32x16_bf16(PAF(1),WFR(1),o[2],0,0,0), C1,4); \
    GAPB(o[3]=__builtin_amdgcn_mfma_f32_32x32x16_bf16(PAF(1),WFR(5),o[3],0,0,0), C1,6); \
    GAPB(o[2]=__builtin_amdgcn_mfma_f32_32x32x16_bf16(PAF(2),WFR(2),o[2],0,0,0), C1,8); \
    GAPB(o[3]=__builtin_amdgcn_mfma_f32_32x32x16_bf16(PAF(2),WFR(6),o[3],0,0,0), C1,10); \
    GAPB(o[2]=__builtin_amdgcn_mfma_f32_32x32x16_bf16(PAF(3),WFR(3),o[2],0,0,0), C1,12); \
    GAPB(o[3]=__builtin_amdgcn_mfma_f32_32x32x16_bf16(PAF(3),WFR(7),o[3],0,0,0), C1,14); \
    }while(0)
  int t=1;
  #define FIX1(tt) do{ if((tt)==1){ _Pragma("unroll") for(int r=0;r<16;++r)negm[r]=-mhat; asm volatile("":"+v"(negm)); } }while(0)
  #undef CMASK
  #define CMASK(P0,P1,t) do{}while(0)
  for(;t+5<NT;t+=2){
    STEP(pB0,pB1,pA0,pA1,t,true,true,true);     WAIT_BAR(3); RESC(); ROT(); FIX1(t);
    STEP(pA0,pA1,pB0,pB1,t+1,true,true,true);   WAIT_BAR(3); RESC(); ROT();
  }
  #undef CMASK
  #define CMASK(P0,P1,t) do{int jb_=(t)-(NT-4); if(jb_>=0)cmask(P0,P1,jb_,qrel,hi);}while(0)
  #define ENDW(tt) do{ if((tt)+3<NT){WAIT_BAR(3);} else if((tt)+2<NT){WAIT_BAR(2);} else {WAIT_BAR(0);} }while(0)
  for(;t+1<NT;t+=2){
    STEP(pB0,pB1,pA0,pA1,t,(t+3<NT),(t+1<NT),(t+1<NT));       ENDW(t);   RESC(); ROT(); FIX1(t);
    STEP(pA0,pA1,pB0,pB1,t+1,(t+4<NT),(t+2<NT),(t+2<NT));     ENDW(t+1); RESC(); ROT();
  }
  STEP(pB0,pB1,pA0,pA1,NT-1,false,false,false); RESC();
  { float sacc=pB0[0]+pB0[1]; _Pragma("unroll") for(int r=2;r<16;++r)sacc+=pB0[r]; _Pragma("unroll") for(int r=0;r<16;++r)sacc+=pB1[r]; l_reg+=sacc;
    pw0=(u32x4){PKW(pB0,0),PKW(pB0,2),PKW(pB0,4),PKW(pB0,6)};pw1=(u32x4){PKW(pB0,8),PKW(pB0,10),PKW(pB0,12),PKW(pB0,14)};pw2=(u32x4){PKW(pB1,0),PKW(pB1,2),PKW(pB1,4),PKW(pB1,6)};pw3=(u32x4){PKW(pB1,8),PKW(pB1,10),PKW(pB1,12),PKW(pB1,14)};
    SBAR(); pv(o,vb0+sl_cur,PAF(0),PAF(1),PAF(2),PAF(3)); pv(o+2,vb0+(LDS_V2-LDS_V)+sl_cur,PAF(0),PAF(1),PAF(2),PAF(3)); }
  #undef PKW
  #undef PAF
  #undef VFR
  #undef WFR
  #undef WRD
  #undef PIN
  #undef MX3
  #undef GAPA
  #undef GAPB
  #undef EX
  #undef VRD
  #undef KRD
  #undef STEP
  #undef ENDW
  {auto rr=__builtin_amdgcn_permlane32_swap(__float_as_uint(l_reg),__float_as_uint(l_reg),false,false);l_reg=__uint_as_float(rr[0])+__uint_as_float(rr[1]);}
  if(hi==0)wsf[32+r32]=l_reg;asm volatile("s_waitcnt lgkmcnt(0)":::"memory");
  float rli[16];
  #pragma unroll
  for(int r=0;r<16;++r)rli[r]=__builtin_amdgcn_rcpf(wsf[32+crow(r,hi)]);
  bf16*Ow=O+(rowbase+q0+wid*QBLK)*DMO+hc*128;
  { lds_u16*stg=(lds_u16*)((lds_char*)shm+LDS_OST)+wid*2048;
    #pragma unroll
    for(int half=0;half<2;++half){
      #pragma unroll
      for(int r=0;r<16;++r){const int orow=crow(r,hi);
        #pragma unroll
        for(int d0=0;d0<2;++d0)stg[orow*64+d0*32+r32]=(unsigned short)(cvtpk_s(o[2*half+d0][r]*rli[r],0.f)&0xffffu);}
      asm volatile("s_waitcnt lgkmcnt(0)":::"memory");
      #pragma unroll
      for(int i=0;i<4;++i){const int row=i*8+(lane>>3),ch=lane&7; const u32x4 v=*(const __attribute__((address_space(3))) u32x4*)(stg+row*64+ch*8); ATTN_STORE16(Ow+(long)row*DMO+half*64+ch*8,v);}
      asm volatile("s_waitcnt lgkmcnt(0)":::"memory"); } }
  asm volatile("s_waitcnt lgkmcnt(0)\n\ts_barrier":::"memory");
  #undef DMA_K
  #undef DMA_V
  #undef CMASK
  #undef START
  #undef RESC
  #undef ROT
}
constexpr int ATTN_LDS_BYTES=LDS_BYTES;
struct AttnTensors { const bf16* Q; const bf16* K; const bf16* V; bf16* O; };
struct AttnUnit { int bh; int qb; };
struct StaticOrder {
  int vcu;
  __device__ __forceinline__ explicit StaticOrder(int grid,int block):vcu((block%8)*(grid/8)+block/8){}
  __device__ __forceinline__ bool next(int i,AttnUnit&u)const{ if(i>=4||vcu>=256)return false; const int s=vcu&3; u.bh=vcu>>2; u.qb=(i==0)?s:(i==1)?7-s:(i==2)?8+s:15-s; return true; }
  __device__ __forceinline__ void a_ready(const AttnUnit&)const{}
  __device__ __forceinline__ void done(const AttnUnit&)const{}
};
struct QueueOrder {
  unsigned* ctr; __attribute__((address_space(3))) unsigned* slot; int x; int tid0;
  __device__ __forceinline__ bool next(int,AttnUnit&u)const{
    if(tid0==0){ const unsigned e=__hip_atomic_fetch_add(ctr,1u,__ATOMIC_RELAXED,__HIP_MEMORY_SCOPE_AGENT); *slot=e; }
    asm volatile("s_waitcnt vmcnt(0) lgkmcnt(0)\n\ts_barrier":::"memory");
    const unsigned e=*slot;
    asm volatile("s_waitcnt lgkmcnt(0)\n\ts_barrier":::"memory");
    if(e>=64u)return false; u.bh=(int)(e&3u)*8+x; u.qb=15-(int)(e>>2); return true; }
  __device__ __forceinline__ void a_ready(const AttnUnit&)const{}
  __device__ __forceinline__ void done(const AttnUnit&)const{}
};
template<class Sched,int THRL=8> __device__ __forceinline__ void attn_phase(char*lds,const AttnTensors&T,const Sched&S,int tid_in){
  AttnUnit u;
  for(int i=0;S.next(i,u);++i){ S.a_ready(u); attn_unit<THRL>(u.bh/NHEAD,u.bh%NHEAD,u.qb,T.Q,T.K,T.V,T.O,lds,tid_in); S.done(u); }
}
#undef SBAR
#undef WAIT_BAR
}
#define GAS __attribute__((address_space(1)))
#define LAS __attribute__((address_space(3)))
typedef unsigned short bf16;
typedef unsigned v4u __attribute__((ext_vector_type(4)));
typedef float f32x4 __attribute__((ext_vector_type(4)));
typedef short bf16x8 __attribute__((ext_vector_type(8)));
typedef GAS unsigned gu32;
typedef GAS unsigned long long gu64;
#define RLX_AGENT __ATOMIC_RELAXED, __HIP_MEMORY_SCOPE_AGENT
#define LDS_WAIT() asm volatile("s_waitcnt lgkmcnt(0)" ::: "memory")
#define VM_WAIT() asm volatile("s_waitcnt vmcnt(0)" ::: "memory")
__device__ __forceinline__ unsigned long long rt() { return __builtin_amdgcn_s_memrealtime(); }
__device__ __forceinline__ unsigned f2bf(float f) { unsigned u = __builtin_bit_cast(unsigned, f); return (u + 0x7fffu + ((u >> 16) & 1u)) >> 16; }
__device__ __forceinline__ unsigned pk2(float lo, float hi) { return f2bf(lo) | (f2bf(hi) << 16); }

#define XB_TMO      128
#define XB_XCNT(j)  (256  + 64 * (j))
#define XB_XSUB(j)  (1280 + 64 * (j))
#define XB_XGEN(j)  (2304 + 64 * (j))
#define XB_TOP      3328
#define XB_TOPGEN   3392
#define XCD_BAR_WORDS 3456
#define XB_SPIN_CAP (1u << 18)

__device__ __forceinline__ unsigned xb_ld(unsigned* p)              { return __hip_atomic_load(p, __ATOMIC_RELAXED, __HIP_MEMORY_SCOPE_AGENT); }
__device__ __forceinline__ unsigned xb_add(unsigned* p, unsigned v) { return __hip_atomic_fetch_add(p, v, __ATOMIC_RELAXED, __HIP_MEMORY_SCOPE_AGENT); }
__device__ __forceinline__ unsigned xb_xcc_id() { return (unsigned)__builtin_amdgcn_s_getreg((3 << 11) | 20) & 0xFu; }
#define XB_SPIN(cond, bar) do { unsigned _sp = 0; while (cond) { __builtin_amdgcn_s_sleep(1); \
    if ((++_sp & 255u) == 0u) { if (xb_ld(&(bar)[XB_TMO])) break; if (_sp > XB_SPIN_CAP) { atomicAdd(&(bar)[XB_TMO], 1u); break; } } } } while (0)

struct XcdBarrier {
    unsigned* bar; unsigned x; int wv;
    volatile LAS unsigned* st;
};

__device__ __forceinline__ XcdBarrier xcd_barrier_post(unsigned* bar, volatile LAS unsigned* st) {
    XcdBarrier b; b.bar = bar; b.x = xb_xcc_id(); b.st = st;
    if (threadIdx.x == 0) (void)xb_add(&bar[XB_XCNT(b.x)], 1u);
    return b;
}
__device__ __forceinline__ void xcd_barrier_complete(unsigned* bar, unsigned x, unsigned& nloc, unsigned& nx) {
    const unsigned G = gridDim.x * gridDim.y * gridDim.z;
    unsigned sum, cnt, mine, sp = 0u;
    for (;;) {
        sum = 0u; cnt = 0u; mine = 0u;
#pragma unroll
        for (unsigned j = 0; j < 16; ++j) { const unsigned c = xb_ld(&bar[XB_XCNT(j)]); sum += c; cnt += (c > 0u) ? 1u : 0u; mine = (j == x) ? c : mine; }
        if (sum == G) break;
        __builtin_amdgcn_s_sleep(1);
        if ((++sp & 255u) == 0u) { if (xb_ld(&bar[XB_TMO])) break; if (sp > XB_SPIN_CAP) { atomicAdd(&bar[XB_TMO], 1u); break; } }
    }
    nloc = mine > 0u ? mine : 1u; nx = cnt > 0u ? cnt : 1u;
}

__device__ __forceinline__ void xcd_barrier(const XcdBarrier& b) {
    asm volatile("s_waitcnt vmcnt(0)" ::: "memory");
    __syncthreads();
    unsigned ln_; asm volatile("v_mbcnt_lo_u32_b32 %0, -1, 0\n\tv_mbcnt_hi_u32_b32 %0, -1, %0" : "=v"(ln_));
    if (b.wv == 0 && ln_ == 0u) {
        unsigned* bar = b.bar;
        __builtin_amdgcn_s_waitcnt(0);
        unsigned nloc = b.st[0], nx = b.st[1];
        if (nloc == 0u) { xcd_barrier_complete(bar, b.x, nloc, nx); b.st[0] = nloc; b.st[1] = nx; }
        const unsigned old = xb_add(&bar[XB_XSUB(b.x)], 1u);
        const unsigned gen = old / nloc;
        if (old + 1u == (gen + 1u) * nloc) {
            __builtin_amdgcn_fence(__ATOMIC_RELEASE, "agent");
            asm volatile("s_waitcnt vmcnt(0)" ::: "memory");
            const unsigned og = xb_add(&bar[XB_TOP], 1u);
            const unsigned tg = og / nx;
            if (og + 1u == (tg + 1u) * nx) xb_add(&bar[XB_TOPGEN], 1u);
            else XB_SPIN(xb_ld(&bar[XB_TOPGEN]) == tg, bar);
            __builtin_amdgcn_fence(__ATOMIC_ACQUIRE, "agent");
            xb_add(&bar[XB_XGEN(b.x)], 1u);
            asm volatile("s_waitcnt vmcnt(0)" ::: "memory");
        } else {
            XB_SPIN(xb_ld(&bar[XB_XGEN(b.x)]) == gen, bar);
            __builtin_amdgcn_fence(__ATOMIC_ACQUIRE, "agent");
            asm volatile("s_waitcnt vmcnt(0)" ::: "memory");
        }
    }
    __syncthreads();
}

constexpr int NWAVES = 8;
constexpr int DM = 1024, NB = 4, SEQ = 4096, NMETA = 16, DEPTH = 4;
constexpr int NREAL = NB * SEQ;
constexpr int NTOK = NREAL + NMETA;
constexpr int MPAD = 16640;
constexpr int INC = 3200, INP = 3328;
constexpr int RCOLS = 896, QOFF = 896, KOFF = 896 + 512, VOFF = 896 + 1024, COFF = 2432;
constexpr int FF = 2816, FF2 = 5632, NE = 8;
constexpr int KVROWS = 128 + SEQ;
constexpr int MOEP = 35072;
constexpr float C2Q = 0.125f * 1.4426950408889634f;

constexpr size_t MiB = 1u << 20;
constexpr size_t WS_CTL = 0, CTL_ZERO_BYTES = 1 * MiB;
constexpr size_t WS_COS = 1 * MiB, WS_SIN = 1 * MiB + 192 * 1024;
constexpr size_t WS_RSTD = 1 * MiB + 512 * 1024;
constexpr size_t WS_RSROW = 1 * MiB + 768 * 1024;
constexpr size_t WS_TOKE = 2 * MiB, WS_TOKS = 2 * MiB + 256 * 1024, WS_TOKG = 2 * MiB + 512 * 1024;
constexpr size_t WS_WIN = 4 * MiB;
constexpr size_t WS_WOUT = 30 * MiB;
constexpr size_t WS_WGU = 38 * MiB;
constexpr size_t WS_WD = 60 * MiB;
constexpr size_t WS_MWGU = 72 * MiB;
constexpr size_t WS_MWD = 160 * MiB;
constexpr size_t WS_H = 204 * MiB;
constexpr size_t WS_HB = 269 * MiB;
constexpr size_t WS_PH = 302 * MiB;
constexpr size_t WS_PROJ = WS_PH;
constexpr size_t WS_QN = 408 * MiB;
constexpr size_t WS_KP = 425 * MiB;
constexpr size_t WS_VP = 442 * MiB;
constexpr size_t WS_OC = 459 * MiB;
constexpr size_t WS_OMIX = 492 * MiB;
constexpr size_t WS_SC = 525 * MiB, SC_STRIDE = 17 * MiB;
constexpr size_t WS_MIX_END = WS_SC + 9 * SC_STRIDE;
constexpr size_t WS_G = WS_PH;
constexpr size_t WS_AROWS = 491 * MiB;
constexpr size_t WS_YM = 560 * MiB;
constexpr size_t WS_LORA = 680 * MiB;
constexpr size_t WS_END = 714 * MiB;
static_assert(WS_PROJ + (size_t)MPAD * INP * 2 <= WS_QN && WS_G + (size_t)MOEP * FF * 2 <= WS_AROWS && WS_AROWS + (size_t)MOEP * 1024 * 2 <= WS_YM && WS_YM + (size_t)MOEP * 1024 * 2 <= WS_END, "ws map");
static_assert((size_t)8 * FF2 * DM <= 44 * MiB && 44 * MiB + (size_t)4112 * 11008 + 1024 <= 88 * MiB && (size_t)4112 * 8192 <= (size_t)MPAD * 2048, "chunk buffers");
static_assert(WS_H + (size_t)MPAD * 1024 * 4 <= WS_HB && WS_HB + (size_t)MPAD * 1024 * 2 <= WS_PH && WS_MIX_END <= WS_END, "ws map 2");
static_assert((size_t)NTOK * 256 * 4 <= SC_STRIDE && WS_OC + (size_t)NTOK * 2048 <= WS_OMIX && WS_OMIX + (size_t)MPAD * 2048 <= WS_SC, "ws map 3");
constexpr int CW_MOECNT = 1024;
constexpr int CW_BAR = 4096;
constexpr int CW_ATTQ = 8192;

constexpr int LDS_BYTES = 147456;
constexpr int MISC_OFF = LDS_BYTES - 128;

struct Args { const float* in[32]; float* out; unsigned char* ws; int ph_lo, ph_hi; };

__device__ __forceinline__ v4u zero_v4u() { unsigned z; asm volatile("v_mov_b32 %0, 0" : "=v"(z)); return (v4u){z, z, z, z}; }
__device__ __forceinline__ unsigned pk4_fp8(float a, float b, float c, float d) {
    a = __builtin_amdgcn_fmed3f(a, -448.f, 448.f); b = __builtin_amdgcn_fmed3f(b, -448.f, 448.f); c = __builtin_amdgcn_fmed3f(c, -448.f, 448.f); d = __builtin_amdgcn_fmed3f(d, -448.f, 448.f);
    unsigned p = (unsigned)__builtin_amdgcn_cvt_pk_fp8_f32(a, b, 0, false); return (unsigned)__builtin_amdgcn_cvt_pk_fp8_f32(c, d, (int)p, true); }
#ifndef INP8_MASK
#define INP8_MASK 0xC
#endif
constexpr int INP8 = INP8_MASK;
constexpr float W8_SCALE = 64.f, A8_SCALE = 16.f, G8_SCALE = 4.f, H8_SCALE = 4.f;
__device__ __forceinline__ float bf2f(unsigned short b) { return __uint_as_float(((unsigned)b) << 16); }
#define DPP_F(x, ctrl) __int_as_float(__builtin_amdgcn_update_dpp(0, __float_as_int(x), ctrl, 0xF, 0xF, true))
__device__ __forceinline__ float lane_xor1(float v) { return DPP_F(v, 0xB1); }
__device__ __forceinline__ float sum8(float v) { v += DPP_F(v, 0xB1); v += DPP_F(v, 0x4E); v += DPP_F(v, 0x141); return v; }
__device__ __forceinline__ float sum16(float v) { v = sum8(v); v += DPP_F(v, 0x140); return v; }
__device__ __forceinline__ float wave_sum_dpp(float p) {
    p = sum16(p);
    asm volatile("s_nop 1\n\tv_add_f32_dpp %0, %0, %0 row_bcast:15 row_mask:0xa bank_mask:0xf\n\ts_nop 1\n\tv_add_f32_dpp %0, %0, %0 row_bcast:31 row_mask:0xc bank_mask:0xf\n\ts_nop 0" : "+v"(p));
    return __int_as_float(__builtin_amdgcn_readlane(__float_as_int(p), 63));
}
__device__ __forceinline__ float wave_sum(float v) { return wave_sum_dpp(v); }
__device__ __forceinline__ float wave_max(float v) {
    v = fmaxf(v, DPP_F(v, 0xB1)); v = fmaxf(v, DPP_F(v, 0x4E)); v = fmaxf(v, DPP_F(v, 0x141)); v = fmaxf(v, DPP_F(v, 0x140));
    asm volatile("s_nop 1\n\tv_max_f32_dpp %0, %0, %0 row_bcast:15 row_mask:0xa bank_mask:0xf\n\ts_nop 1\n\tv_max_f32_dpp %0, %0, %0 row_bcast:31 row_mask:0xc bank_mask:0xf\n\ts_nop 0" : "+v"(v));
    return __int_as_float(__builtin_amdgcn_readlane(__float_as_int(v), 63));
}
__device__ __forceinline__ float sigmoidf_(float x) { return 1.f / (1.f + __expf(-x)); }
__device__ __forceinline__ int prevrow(int row) { if (row < 0) return -1; if (row >= NREAL) return row == NREAL ? -1 : row - 1; return (row & (SEQ - 1)) == 0 ? NTOK - 1 : row - 1; }

__device__ __forceinline__ void tr_item(const float* W, int K, int N, bf16* WT, int rowmode, const float* gk, LAS float* scr, int item, int lane) {
    const int nblk = N / 32, kb = item / nblk, nb = item % nblk, k0 = 64 * kb, n0 = 32 * nb;
    const float* src = W + (size_t)(k0 + (lane >> 5)) * N + n0 + (lane & 31);
    float v[32];
#pragma unroll
    for (int i = 0; i < 32; ++i) v[i] = src[(size_t)(2 * i) * N];
#pragma unroll
    for (int i = 0; i < 32; ++i) scr[(2 * i + (lane >> 5)) * 33 + (lane & 31)] = v[i];
    LDS_WAIT(); asm volatile("" ::: "memory");
    const int c = lane & 7;
    f32x4 g0 = (f32x4){1.f, 1.f, 1.f, 1.f}, g1 = g0;
    if (gk) { g0 = *(const f32x4*)(gk + k0 + 8 * c); g1 = *(const f32x4*)(gk + k0 + 8 * c + 4); }
#pragma unroll
    for (int j = 0; j < 4; ++j) { const int n = (lane >> 3) + 8 * j; const LAS float* s = scr + (8 * c) * 33 + n;
        v4u o; o.x = pk2(s[0 * 33] * g0.x, s[1 * 33] * g0.y); o.y = pk2(s[2 * 33] * g0.z, s[3 * 33] * g0.w); o.z = pk2(s[4 * 33] * g1.x, s[5 * 33] * g1.y); o.w = pk2(s[6 * 33] * g1.z, s[7 * 33] * g1.w);
        const int nn = n0 + n; const int drow = rowmode == 0 ? nn : ((nn >> 7) * 256 + (nn & 127) + (rowmode == 2 ? 128 : 0));
        *(GAS v4u*)(WT + (size_t)drow * K + k0 + 8 * c) = o; }
    LDS_WAIT(); asm volatile("" ::: "memory");
}

__device__ __forceinline__ void tr_item2(const float* W0, int K0, int N0, bf16* WT0, int rm0, const float* gk0, int item0,
                                         const float* W1, int K1, int N1, bf16* WT1, int rm1, const float* gk1, int item1, LAS float* scr, int lane, bool f8_0 = false, bool f8_1 = false) {
    const int nb0_ = N0 / 32, nb1_ = N1 / 32;
    const int k00 = 64 * (item0 / nb0_), n00 = 32 * (item0 % nb0_), k01 = 64 * (item1 / nb1_), n01 = 32 * (item1 % nb1_);
    const float* s0 = W0 + (size_t)(k00 + (lane >> 5)) * N0 + n00 + (lane & 31); const float* s1 = W1 + (size_t)(k01 + (lane >> 5)) * N1 + n01 + (lane & 31);
    float v0[32], v1[32];
#pragma unroll
    for (int i = 0; i < 32; ++i) { v0[i] = s0[(size_t)(2 * i) * N0]; v1[i] = s1[(size_t)(2 * i) * N1]; }
    LAS float* t0 = scr; LAS float* t1 = scr + 64 * 33;
#pragma unroll
    for (int i = 0; i < 32; ++i) { t0[(2 * i + (lane >> 5)) * 33 + (lane & 31)] = v0[i]; t1[(2 * i + (lane >> 5)) * 33 + (lane & 31)] = v1[i]; }
    LDS_WAIT(); asm volatile("" ::: "memory");
    const int c = lane & 7;
#pragma unroll
    for (int q = 0; q < 2; ++q) { const float* gk = q ? gk1 : gk0; const int k0 = q ? k01 : k00, n0 = q ? n01 : n00, K = q ? K1 : K0, rowmode = q ? rm1 : rm0; bf16* WT = q ? WT1 : WT0; const LAS float* tt = q ? t1 : t0;
        f32x4 g0 = (f32x4){1.f, 1.f, 1.f, 1.f}, g1 = g0;
        if (gk) { g0 = *(const f32x4*)(gk + k0 + 8 * c); g1 = *(const f32x4*)(gk + k0 + 8 * c + 4); }
#pragma unroll
        for (int j = 0; j < 4; ++j) { const int n = (lane >> 3) + 8 * j; const LAS float* s = tt + (8 * c) * 33 + n;
            v4u o; o.x = pk2(s[0 * 33] * g0.x, s[1 * 33] * g0.y); o.y = pk2(s[2 * 33] * g0.z, s[3 * 33] * g0.w); o.z = pk2(s[4 * 33] * g1.x, s[5 * 33] * g1.y); o.w = pk2(s[6 * 33] * g1.z, s[7 * 33] * g1.w);
            const int nn = n0 + n; const int drow = rowmode == 0 ? nn : ((nn >> 7) * 256 + (nn & 127) + (rowmode == 2 ? 128 : 0));
            if (q ? f8_1 : f8_0) { const unsigned lo = pk4_fp8(s[0 * 33] * g0.x * W8_SCALE, s[1 * 33] * g0.y * W8_SCALE, s[2 * 33] * g0.z * W8_SCALE, s[3 * 33] * g0.w * W8_SCALE), hi8 = pk4_fp8(s[4 * 33] * g1.x * W8_SCALE, s[5 * 33] * g1.y * W8_SCALE, s[6 * 33] * g1.z * W8_SCALE, s[7 * 33] * g1.w * W8_SCALE);
                *(GAS unsigned long long*)((GAS unsigned char*)WT + (size_t)drow * K + k0 + 8 * c) = (unsigned long long)lo | ((unsigned long long)hi8 << 32); }
            else *(GAS v4u*)(WT + (size_t)drow * K + k0 + 8 * c) = o; } }
    LDS_WAIT(); asm volatile("" ::: "memory");
}

__device__ __forceinline__ void meta_gemm_res(const bf16* A, int K, const bf16* Bt, float* Hm, LAS unsigned char* lds, int bx, int wave, int lane, int hbmode = 0, bf16* HBm = nullptr, unsigned long long* rsqm = nullptr) {
    if (bx < 32) {
        typedef short bfx8 __attribute__((ext_vector_type(8)));
        const int ct = 2 * bx + (wave >> 2), ksp = wave & 3, n = lane & 15, kq = lane >> 4; const int kc = K >> 2, steps = kc >> 5;
        const bf16* ap = A + (size_t)n * K + ksp * kc + 8 * kq; const bf16* wp = Bt + (size_t)(16 * ct + n) * K + ksp * kc + 8 * kq;
        f32x4 acc = (f32x4){0.f, 0.f, 0.f, 0.f};
#pragma unroll 11
        for (int s = 0; s < steps; ++s) { const v4u a = *(const v4u*)(wp + 32 * s), b = *(const v4u*)(ap + 32 * s);
            acc = __builtin_amdgcn_mfma_f32_16x16x32_bf16(__builtin_bit_cast(bfx8, a), __builtin_bit_cast(bfx8, b), acc, 0, 0, 0); }
        LAS f32x4* red = (LAS f32x4*)lds;
        red[wave * 64 + lane] = acc;
        __syncthreads();
        if (ksp == 0) { const f32x4 s = (red[wave * 64 + lane] + red[(wave + 1) * 64 + lane]) + (red[(wave + 2) * 64 + lane] + red[(wave + 3) * 64 + lane]);
            f32x4* hp = (f32x4*)(Hm + (size_t)n * 1024 + 16 * ct + 4 * kq); const f32x4 hn = *hp + s; *hp = hn;
            if (hbmode) { const int cc = 16 * ct + 4 * kq;
                if (hbmode == 1) *(unsigned long long*)(HBm + (size_t)n * 1024 + cc) = (unsigned long long)pk2(hn.x, hn.y) | ((unsigned long long)pk2(hn.z, hn.w) << 32);
                else *(unsigned*)((unsigned char*)HBm + (size_t)n * 1024 + cc) = pk4_fp8(hn.x * H8_SCALE, hn.y * H8_SCALE, hn.z * H8_SCALE, hn.w * H8_SCALE);
                __hip_atomic_fetch_add(rsqm + n, (unsigned long long)(((hn.x * hn.x + hn.y * hn.y) + (hn.z * hn.z + hn.w * hn.w)) * 16777216.f), RLX_AGENT); } }
        __syncthreads();
    }
}

__device__ __forceinline__ void meta_gemm_res8(const unsigned char* A, int K, const unsigned char* Bt, float* Hm, float sc, LAS unsigned char* lds, int bx, int wave, int lane) {
    if (bx < 32) {
        typedef int v8i_ __attribute__((ext_vector_type(8)));
        const int ct = 2 * bx + (wave >> 2), ksp = wave & 3, n = lane & 15, kq = lane >> 4; const int kc = K >> 2, steps = kc >> 7;
        const int s0 = ksp < 2 ? 6 * ksp : 12 + 5 * (ksp - 2), ns = ksp < 2 ? 6 : 5; (void)kc; (void)steps;
        const unsigned char* ap = A + (size_t)n * K + 32 * kq; const unsigned char* wp = Bt + (size_t)(16 * ct + n) * K + 32 * kq;
        f32x4 acc = (f32x4){0.f, 0.f, 0.f, 0.f};
#pragma unroll 6
        for (int s = s0; s < s0 + ns; ++s) { const v4u a0 = *(const v4u*)(wp + 128 * s), a1 = *(const v4u*)(wp + 128 * s + 16), b0 = *(const v4u*)(ap + 128 * s), b1 = *(const v4u*)(ap + 128 * s + 16);
            const v8i_ aa = (v8i_){(int)a0.x, (int)a0.y, (int)a0.z, (int)a0.w, (int)a1.x, (int)a1.y, (int)a1.z, (int)a1.w}, bb = (v8i_){(int)b0.x, (int)b0.y, (int)b0.z, (int)b0.w, (int)b1.x, (int)b1.y, (int)b1.z, (int)b1.w};
            acc = __builtin_amdgcn_mfma_scale_f32_16x16x128_f8f6f4(aa, bb, acc, 0, 0, 0, 0x7f7f7f7f, 0, 0x7f7f7f7f); }
        LAS f32x4* red = (LAS f32x4*)lds;
        red[wave * 64 + lane] = acc;
        __syncthreads();
        if (ksp == 0) { const f32x4 s = (red[wave * 64 + lane] + red[(wave + 1) * 64 + lane]) + (red[(wave + 2) * 64 + lane] + red[(wave + 3) * 64 + lane]);
            f32x4* hp = (f32x4*)(Hm + (size_t)n * 1024 + 16 * ct + 4 * kq); *hp = *hp + s * sc; }
        __syncthreads();
    }
}

__global__ void __launch_bounds__(NWAVES * 64, 2) hymba_fwd(Args args) {
    extern __shared__ __attribute__((aligned(16))) unsigned char lds_raw[];
    LAS unsigned char* lds = (LAS unsigned char*)lds_raw;
    volatile LAS unsigned* MISC = (volatile LAS unsigned*)(lds + MISC_OFF);
    const int wave = __builtin_amdgcn_readfirstlane((int)threadIdx.x >> 6);
#define PH_TID int tid; asm volatile("v_mbcnt_lo_u32_b32 %0, -1, 0\n\tv_mbcnt_hi_u32_b32 %0, -1, %0" : "=v"(tid)); tid += wave * 64; const int lane = tid & 63; (void)lane; unsigned char* ws = ws0; asm volatile("" : "+s"(ws)); const char* ka = ka0; asm volatile("" : "+s"(ka)); (void)ka
    const int G = gridDim.x, bx = blockIdx.x;
    const int gw = bx * NWAVES + wave, NGW = G * NWAVES;
    unsigned char* const ws0 = args.ws;
    const char* const ka0 = (const char*)__builtin_amdgcn_kernarg_segment_ptr();
    { const int t0_ = (int)threadIdx.x; if (t0_ < 32) ((LAS unsigned*)(lds + MISC_OFF))[t0_] = 0u; }
    __syncthreads();
    const int lo = args.ph_lo, hi = args.ph_hi;
    const bool multi = (hi - lo) > 1;
    XcdBarrier bar; bar.bar = (unsigned*)(ws0 + WS_CTL) + CW_BAR; bar.x = 0; bar.st = nullptr; bar.wv = wave;
    if (multi) { bar = xcd_barrier_post((unsigned*)(ws0 + WS_CTL) + CW_BAR, MISC + 8); bar.wv = wave; }
#ifndef ENMASK
#define ENMASK 0xFFFF
#endif
#define EN(k) (((ENMASK) >> (k)) & 1)
#ifndef REPMASK
#define REPMASK 0
#endif
#define NREP(k) ((((REPMASK) >> (k)) & 1) ? 2 : 1)
#define IN(k) (lo <= (k) && (k) < hi)
#define SEAM(k) do { if (hi > (k) + 1) xcd_barrier(bar); } while (0)

#define Hf ((float*)(ws + WS_H))
#define HB ((bf16*)(ws + WS_HB))
#define RSTD ((float*)(ws + WS_RSTD))
#define PROJ ((bf16*)(ws + WS_PROJ))
#define QN ((bf16*)(ws + WS_QN))
#define KP ((bf16*)(ws + WS_KP))
#define VP ((bf16*)(ws + WS_VP))
#define OC ((bf16*)(ws + WS_OC))
#define OMIX ((bf16*)(ws + WS_OMIX))
#define SP4 ((f32x4*)(ws + WS_SC + 0 * SC_STRIDE))
#define SR ((float*)(ws + WS_SC + 4 * SC_STRIDE))
#define SV ((float*)(ws + WS_SC + 5 * SC_STRIDE))
#define SG ((float*)(ws + WS_SC + 6 * SC_STRIDE))
#define SBON ((float*)(ws + WS_SC + 7 * SC_STRIDE))
#define SY ((float*)(ws + WS_SC + 8 * SC_STRIDE))
#define COS ((float*)(ws + WS_COS))
#define SIN ((float*)(ws + WS_SIN))
#define GB ((bf16*)(ws + WS_G))
#define AROWS ((bf16*)(ws + WS_AROWS))
#define YM ((bf16*)(ws + WS_YM))
#define RSQA ((unsigned long long*)(ws + WS_RSROW))
#define TOKE ((int*)(ws + WS_TOKE))
#define TOKS ((int*)(ws + WS_TOKS))
#define TOKG ((float*)(ws + WS_TOKG))
#define ctl ((gu32*)(ws + WS_CTL))
#define INP(i) (*(const float* const*)(ka + 8 * (i)))
#define LORA_W ((float*)(ws + WS_LORA))
#define LORA_AG ((bf16*)(ws + WS_LORA + 17 * MiB))
#define CH_REC ((unsigned char*)(ws + WS_MWGU + 44 * MiB))
#define CH_RB 11008
#define CH_SPK ((unsigned char*)(ws + WS_HB))
#ifndef SCAN_CHUNKED
#define SCAN_CHUNKED 1
#endif

    for (int rep_ = 0; rep_ < NREP(15); ++rep_) if (EN(15) && IN(0)) { PH_TID;
        LAS float* scr = (LAS float*)(lds + wave * 17408);
        constexpr int I_IN = 16 * 100, I_OUT = 16 * 32, I_GU = 16 * 88, I_DN = 44 * 32;
        constexpr int NITEMS = DEPTH * (I_IN + I_OUT) + 2 * (2 * I_GU + I_DN);
        for (int it0 = 2 * gw; it0 < NITEMS; it0 += 2 * NGW) {
            const float* W_[2]; bf16* D_[2]; int K_[2], N_[2], rm_[2], r_[2]; const float* g_[2]; bool f8_[2] = {false, false};
#pragma unroll
            for (int q = 0; q < 2; ++q) { int r = it0 + q;
                if (r < DEPTH * I_IN) { const int l = r / I_IN; W_[q] = INP(3) + (size_t)l * DM * INC; K_[q] = DM; N_[q] = INC; D_[q] = (bf16*)(ws + WS_WIN) + (size_t)l * INP * DM; rm_[q] = 0; g_[q] = INP(2) + l * DM; r_[q] = r % I_IN; f8_[q] = ((INP8 >> l) & 1) != 0; continue; } r -= DEPTH * I_IN;
                if (r < DEPTH * I_OUT) { const int l = r / I_OUT; W_[q] = INP(23) + (size_t)l * DM * DM; K_[q] = DM; N_[q] = DM; D_[q] = (bf16*)(ws + WS_WOUT) + (size_t)l * DM * DM; rm_[q] = 0; g_[q] = nullptr; r_[q] = r % I_OUT; continue; } r -= DEPTH * I_OUT;
                if (r < 2 * I_GU) { const int j = r / I_GU; W_[q] = INP(25) + (size_t)j * DM * FF; K_[q] = DM; N_[q] = FF; D_[q] = (bf16*)(ws + WS_WGU) + (size_t)j * FF2 * DM; rm_[q] = 1; g_[q] = INP(24) + (2 * j) * DM; r_[q] = r % I_GU; f8_[q] = (j == 1); continue; } r -= 2 * I_GU;
                if (r < 2 * I_GU) { const int j = r / I_GU; W_[q] = INP(26) + (size_t)j * DM * FF; K_[q] = DM; N_[q] = FF; D_[q] = (bf16*)(ws + WS_WGU) + (size_t)j * FF2 * DM; rm_[q] = 2; g_[q] = INP(24) + (2 * j) * DM; r_[q] = r % I_GU; f8_[q] = (j == 1); continue; } r -= 2 * I_GU;
                { const int j = r / I_DN; W_[q] = INP(27) + (size_t)j * FF * DM; K_[q] = FF; N_[q] = DM; D_[q] = (bf16*)(ws + WS_WD) + (size_t)j * DM * FF; rm_[q] = 0; g_[q] = nullptr; r_[q] = r % I_DN; f8_[q] = (j == 1); } }
            tr_item2(W_[0], K_[0], N_[0], D_[0], rm_[0], g_[0], r_[0], W_[1], K_[1], N_[1], D_[1], rm_[1], g_[1], r_[1], scr, lane, f8_[0], f8_[1]);
        }
        const int gt = bx * (NWAVES * 64) + tid, NGT = G * NWAVES * 64;
        for (int i = gt; i < DEPTH * 128 * (DM / 8); i += NGT) { const int l = i / (128 * (DM / 8)), r = i % (128 * (DM / 8));
            if ((INP8 >> l) & 1) { if (r < 128 * (DM / 16)) ((v4u*)((unsigned char*)(ws + WS_WIN) + (size_t)l * INP * DM * 2 + (size_t)INC * DM))[r] = zero_v4u(); }
            else ((v4u*)((bf16*)(ws + WS_WIN) + ((size_t)l * INP + INC) * DM))[r] = zero_v4u(); }
        f32x4 nvp_[4];
#define P0_LOAD(rw) do { const int r_ = (rw); _Pragma("unroll") for (int j = 0; j < 4; ++j) { const int c4 = lane + 64 * j; nvp_[j] = __builtin_bit_cast(f32x4, zero_v4u()); \
                if (r_ < NREAL) nvp_[j] = ((const f32x4*)INP(0))[(size_t)r_ * (DM / 4) + c4]; else if (r_ < NTOK) nvp_[j] = ((const f32x4*)INP(1))[(r_ - NREAL) * (DM / 4) + c4]; } } while (0)
        P0_LOAD(gw);
        for (int row = gw; row < MPAD; row += NGW) {
            f32x4 v[4]; float s = 0.f;
#pragma unroll
            for (int j = 0; j < 4; ++j) v[j] = nvp_[j];
            if (row + NGW < MPAD) P0_LOAD(row + NGW);
#pragma unroll
            for (int j = 0; j < 4; ++j) { const int c4 = lane + 64 * j;
                ((f32x4*)Hf)[(size_t)row * (DM / 4) + c4] = v[j]; s += (v[j].x * v[j].x + v[j].y * v[j].y) + (v[j].z * v[j].z + v[j].w * v[j].w); }
            if (row < NTOK) { s = wave_sum(s); const float rstd = 1.f / sqrtf(s * (1.f / DM) + 1e-6f);
                if (INP8 & 1) { const float sn = rstd * A8_SCALE;
#pragma unroll
                    for (int j = 0; j < 4; ++j) ((unsigned*)((unsigned char*)HB + (size_t)row * DM))[lane + 64 * j] = pk4_fp8(v[j].x * sn, v[j].y * sn, v[j].z * sn, v[j].w * sn); }
                else {
#pragma unroll
                    for (int j = 0; j < 4; ++j) ((unsigned long long*)(HB + (size_t)row * DM))[lane + 64 * j] = (unsigned long long)pk2(v[j].x, v[j].y) | ((unsigned long long)pk2(v[j].z, v[j].w) << 32); }
                if (lane == 0) RSTD[row] = rstd; }
        }
        if (INP8 & 1) { for (int i = gt; i < (MPAD - NTOK) * (DM / 16); i += NGT) ((v4u*)((unsigned char*)HB + (size_t)NTOK * DM))[i] = zero_v4u(); }
        else
        for (int i = gt; i < (MPAD - NTOK) * (DM / 8); i += NGT) ((v4u*)(HB + (size_t)NTOK * DM))[i] = zero_v4u();
        for (int i = gt; i < MPAD - NTOK; i += NGT) RSTD[NTOK + i] = 0.f;
        for (int i = gt; i < (SEQ + NMETA) * 8; i += NGT) { const int pos = i >> 3, j = i & 7;
            const float invf = j == 0 ? 1.000000000e+00f : j == 1 ? 1.939227432e-01f : j == 2 ? 3.760603070e-02f : j == 3 ? 7.292664610e-03f : j == 4 ? 1.414213562e-03f : j == 5 ? 2.742481884e-04f : j == 6 ? 5.318296098e-05f : 1.031338616e-05f;
            const float angf = (float)pos * invf; const double a = (double)angf; const double n = __builtin_rint(a * 0.15915494309189535);
            const double rr = (a - n * 6.283185307179586) - n * 2.4492935982947064e-16; const float rev = (float)(rr * 0.15915494309189535);
            COS[i] = __builtin_amdgcn_cosf(rev); SIN[i] = __builtin_amdgcn_sinf(rev); }
        SEAM(0);
    }

#pragma nounroll
    for (int layer = 0; layer < DEPTH; ++layer) {
        const int pb = 1 + 12 * layer; const bool moe = (layer & 1) != 0; const int jj = layer >> 1;
        if (hi <= pb || lo >= pb + 12) continue;
        const float lam_init = 0.8f - 0.6f * __expf(-0.3f * (float)layer);

        for (int rep_ = 0; rep_ < NREP(0); ++rep_) if (EN(0) && IN(pb + 0) && moe) { PH_TID;
            f32x4 nv_[4];
            { const GAS f32x4* xr = (const GAS f32x4*)(Hf + (size_t)gw * DM) + lane;
#pragma unroll
              for (int j = 0; j < 4; ++j) nv_[j] = xr[64 * j]; }
            for (int row = gw; row < NTOK; row += NGW) {
                f32x4 v[4]; float s = 0.f;
#pragma unroll
                for (int j = 0; j < 4; ++j) v[j] = nv_[j];
                { const int rn_ = row + NGW < NTOK ? row + NGW : row; const GAS f32x4* xr = (const GAS f32x4*)(Hf + (size_t)rn_ * DM) + lane;
#pragma unroll
                  for (int j = 0; j < 4; ++j) nv_[j] = xr[64 * j]; }
#pragma unroll
                for (int j = 0; j < 4; ++j) s += (v[j].x * v[j].x + v[j].y * v[j].y) + (v[j].z * v[j].z + v[j].w * v[j].w);
                s = wave_sum(s); const float rstd = 1.f / sqrtf(s * (1.f / DM) + 1e-6f);
                if ((INP8 >> layer) & 1) { GAS unsigned* o4 = (GAS unsigned*)((GAS unsigned char*)HB + (size_t)row * DM) + lane; const float sn = rstd * A8_SCALE;
#pragma unroll
                    for (int j = 0; j < 4; ++j) o4[64 * j] = pk4_fp8(v[j].x * sn, v[j].y * sn, v[j].z * sn, v[j].w * sn); }
                else { GAS unsigned long long* o8 = (GAS unsigned long long*)(HB + (size_t)row * DM) + lane;
#pragma unroll
                    for (int j = 0; j < 4; ++j) o8[64 * j] = (unsigned long long)pk2(v[j].x, v[j].y) | ((unsigned long long)pk2(v[j].z, v[j].w) << 32); }
                if (lane == 0) RSTD[row] = rstd;
            }
            if ((INP8 >> layer) & 1) { const int gt = bx * (NWAVES * 64) + tid, NGT = G * NWAVES * 64;
                for (int i = gt; i < (MPAD - NTOK) * (DM / 16); i += NGT) ((v4u*)((unsigned char*)HB + (size_t)NTOK * DM))[i] = zero_v4u(); }
            if (moe) {
                LAS float* scr = (LAS float*)(lds + wave * 17408);
                constexpr int I_GU = 16 * 88, I_DN = 44 * 32, PER_E = 2 * I_GU + I_DN;
                const float* gff = INP(24) + layer * DM;
                for (int it0 = 2 * gw; it0 < NE * PER_E; it0 += 2 * NGW) {
                    const float* W_[2]; bf16* D_[2]; int K_[2], N_[2], rm_[2], r_[2]; const float* g_[2];
#pragma unroll
                    for (int q = 0; q < 2; ++q) { const int it = it0 + q; const int e = it / PER_E; int r = it % PER_E; const size_t eo = (size_t)(jj * NE + e) * DM * FF;
                        if (r < I_GU) { W_[q] = INP(29) + eo; K_[q] = DM; N_[q] = FF; D_[q] = (bf16*)(ws + WS_MWGU) + (size_t)e * FF2 * DM / 2; rm_[q] = 1; g_[q] = gff; }
                        else if (r < 2 * I_GU) { r -= I_GU; W_[q] = INP(30) + eo; K_[q] = DM; N_[q] = FF; D_[q] = (bf16*)(ws + WS_MWGU) + (size_t)e * FF2 * DM / 2; rm_[q] = 2; g_[q] = gff; }
                        else { r -= 2 * I_GU; W_[q] = INP(31) + eo; K_[q] = FF; N_[q] = DM; D_[q] = (bf16*)(ws + WS_MWD) + (size_t)e * DM * FF / 2; rm_[q] = 0; g_[q] = nullptr; }
                        r_[q] = r; }
                    tr_item2(W_[0], K_[0], N_[0], D_[0], rm_[0], g_[0], r_[0], W_[1], K_[1], N_[1], D_[1], rm_[1], g_[1], r_[1], scr, lane, true, true);
                }
            }
            SEAM(pb + 0);
        }
        for (int rep_ = 0; rep_ < NREP(1); ++rep_) if (EN(1) && IN(pb + 1)) { PH_TID;
            pg8::StaticOrder S; S.init(MPAD, INP, G, bx);
            if ((INP8 >> layer) & 1) { pg8::Gemm g{HB, (const bf16*)(ws + WS_WIN) + (size_t)layer * INP * DM, MPAD, INP, DM / 2}; pg8::EpiBf16Rs E{PROJ, INP, nullptr, 1.f / (W8_SCALE * A8_SCALE)};
                pg8::gemm_phase<pg8::EpiBf16Rs, pg8::StaticOrder, true, true, true>(lds, g, S, E, tid); }
            else { pg8::Gemm g{HB, (const bf16*)(ws + WS_WIN) + (size_t)layer * INP * DM, MPAD, INP, DM}; pg8::EpiBf16Rs E{PROJ, INP, RSTD, 1.f};
                pg8::gemm_phase<pg8::EpiBf16Rs, pg8::StaticOrder, true, true>(lds, g, S, E, tid); }
            SEAM(pb + 1);
        }
        for (int rep_ = 0; rep_ < NREP(2); ++rep_) if (EN(2) && IN(pb + 2)) { PH_TID;
            const int gt = bx * (NWAVES * 64) + tid, NGT = G * NWAVES * 64;
            if (tid < 65) { const v4u z_ = zero_v4u(); RSQA[bx * 65 + tid] = (unsigned long long)z_.x | ((unsigned long long)z_.y << 32); }
            for (int i = gt; i < NB * 112 * 64; i += NGT) { const int b = i / (112 * 64), r = (i / 64) % 112, c = i % 64; const int row = b * KVROWS + (r < 48 ? r : r + 16);
                ((v4u*)(KP + (size_t)row * 512))[c] = zero_v4u(); ((v4u*)(VP + (size_t)row * 512))[c] = zero_v4u(); }
            const int ngrp = (1025 - bx + 255) / 256, nrows = 16 * ngrp;
#define MP_ROW(idx) (16 * (bx + 256 * ((idx) >> 4)) + ((idx) & 15))
            LAS unsigned char* WT = lds;
            { const int nn = tid & 255, hf = tid >> 8;
              const float* sd = INP(6) + layer * 32 * 256 + (hf * 16) * 256 + nn; const float* sa = INP(8) + layer * 32 * 256 + (hf * 16) * 256 + nn; const float* sg = INP(9) + layer * 64 * 256 + (hf * 32) * 256 + nn;
              v4u wv[2];
#pragma unroll
              for (int i = 0; i < 2; ++i) { wv[i].x = pk2(sd[(8 * i) * 256], sd[(8 * i + 1) * 256]); wv[i].y = pk2(sd[(8 * i + 2) * 256], sd[(8 * i + 3) * 256]); wv[i].z = pk2(sd[(8 * i + 4) * 256], sd[(8 * i + 5) * 256]); wv[i].w = pk2(sd[(8 * i + 6) * 256], sd[(8 * i + 7) * 256]); }
              *(LAS v4u*)(WT + nn * 64 + hf * 32) = wv[0]; *(LAS v4u*)(WT + nn * 64 + hf * 32 + 16) = wv[1];
#pragma unroll
              for (int i = 0; i < 2; ++i) { wv[i].x = pk2(sa[(8 * i) * 256], sa[(8 * i + 1) * 256]); wv[i].y = pk2(sa[(8 * i + 2) * 256], sa[(8 * i + 3) * 256]); wv[i].z = pk2(sa[(8 * i + 4) * 256], sa[(8 * i + 5) * 256]); wv[i].w = pk2(sa[(8 * i + 6) * 256], sa[(8 * i + 7) * 256]); }
              *(LAS v4u*)(WT + 16384 + nn * 64 + hf * 32) = wv[0]; *(LAS v4u*)(WT + 16384 + nn * 64 + hf * 32 + 16) = wv[1];
#pragma unroll
              for (int i = 0; i < 4; ++i) { v4u t; t.x = pk2(sg[(8 * i) * 256], sg[(8 * i + 1) * 256]); t.y = pk2(sg[(8 * i + 2) * 256], sg[(8 * i + 3) * 256]); t.z = pk2(sg[(8 * i + 4) * 256], sg[(8 * i + 5) * 256]); t.w = pk2(sg[(8 * i + 6) * 256], sg[(8 * i + 7) * 256]);
                  *(LAS v4u*)(WT + 32768 + nn * 128 + hf * 64 + 16 * i) = t; } }
            __syncthreads();
            const float* mu = INP(4) + layer * RCOLS; const float* w0 = INP(5) + layer * 256; const float* a0 = INP(7) + layer * 256;
            const float* k_k = INP(10) + layer * 256; const float* k_a = INP(11) + layer * 256; const float* r_k = INP(12) + layer * 256;
            const float* qg = INP(15) + layer * 64; const float* kg = INP(16) + layer * 64; const float* cw = INP(22) + layer * 3 * 256;
            for (int rep3_ = 0; rep3_ < NREP(5); ++rep3_)
            if (wave < ngrp) {
                typedef attn_body::bf16x8 bfx8;
                const int rowbase = 16 * (bx + 256 * wave);
                LAS unsigned char* XT = lds + 65536 + wave * 4096;
                { const float mu0 = mu[768 + 2 * lane], mu1 = mu[768 + 2 * lane + 1]; const int p0 = prevrow(rowbase);
                  unsigned cur = p0 < 0 ? 0u : *(const unsigned*)(PROJ + (size_t)p0 * INP + 768 + 2 * lane); float pl = __uint_as_float(cur << 16), ph = __uint_as_float(cur & 0xffff0000u);
#pragma unroll
                  for (int r = 0; r < 16; ++r) { cur = *(const unsigned*)(PROJ + (size_t)(rowbase + r) * INP + 768 + 2 * lane); const float xl = __uint_as_float(cur << 16), xh = __uint_as_float(cur & 0xffff0000u);
                      float h0 = xl + (pl - xl) * mu0, h1 = xh + (ph - xh) * mu1; pl = xl; ph = xh;
                      if (lane < 16) { h0 = 1.f - 2.f / (1.f + __expf(2.f * h0)); h1 = 1.f - 2.f / (1.f + __expf(2.f * h1)); } else if (lane >= 32) { h0 = sigmoidf_(h0); h1 = sigmoidf_(h1); }
                      *(LAS unsigned*)(XT + r * 256 + 4 * lane) = pk2(h0, h1); } }
                LDS_WAIT();
                const int n = lane & 15, kq = lane >> 4;
                const v4u xd = *(const LAS v4u*)(XT + n * 256 + (8 * kq) * 2), xa = *(const LAS v4u*)(XT + n * 256 + (32 + 8 * kq) * 2);
                const v4u xg0 = *(const LAS v4u*)(XT + n * 256 + (64 + 8 * kq) * 2), xg1 = *(const LAS v4u*)(XT + n * 256 + (96 + 8 * kq) * 2);
                float* lw = LORA_W + (size_t)(rowbase + n) * 256 + 4 * kq; bf16* lag = LORA_AG + (size_t)(rowbase + n) * 512 + 4 * kq;
#pragma unroll 4
                for (int ct = 0; ct < 16; ++ct) {
                    const v4u ad = *(const LAS v4u*)(WT + (16 * ct + n) * 64 + (8 * kq) * 2), aa = *(const LAS v4u*)(WT + 16384 + (16 * ct + n) * 64 + (8 * kq) * 2);
                    const v4u ag0 = *(const LAS v4u*)(WT + 32768 + (16 * ct + n) * 128 + (8 * kq) * 2), ag1 = *(const LAS v4u*)(WT + 32768 + (16 * ct + n) * 128 + (32 + 8 * kq) * 2);
                    f32x4 dd = __builtin_amdgcn_mfma_f32_16x16x32_bf16(__builtin_bit_cast(bfx8, ad), __builtin_bit_cast(bfx8, xd), (f32x4){0.f, 0.f, 0.f, 0.f}, 0, 0, 0);
                    f32x4 da = __builtin_amdgcn_mfma_f32_16x16x32_bf16(__builtin_bit_cast(bfx8, aa), __builtin_bit_cast(bfx8, xa), (f32x4){0.f, 0.f, 0.f, 0.f}, 0, 0, 0);
                    f32x4 dg = __builtin_amdgcn_mfma_f32_16x16x32_bf16(__builtin_bit_cast(bfx8, ag0), __builtin_bit_cast(bfx8, xg0), (f32x4){0.f, 0.f, 0.f, 0.f}, 0, 0, 0);
                    dg = __builtin_amdgcn_mfma_f32_16x16x32_bf16(__builtin_bit_cast(bfx8, ag1), __builtin_bit_cast(bfx8, xg1), dg, 0, 0, 0);
                    *(f32x4*)(lw + 16 * ct) = dd;
                    *(unsigned long long*)(lag + 16 * ct) = (unsigned long long)pk2(da.x, da.y) | ((unsigned long long)pk2(da.z, da.w) << 32);
                    *(unsigned long long*)(lag + 256 + 16 * ct) = (unsigned long long)pk2(dg.x, dg.y) | ((unsigned long long)pk2(dg.z, dg.w) << 32);
                }
            }
            asm volatile("s_waitcnt vmcnt(0)" ::: "memory");
            __syncthreads();
#pragma nounroll
            for (int rep3_ = 0; rep3_ < NREP(10); ++rep3_)
            {
                typedef unsigned u32x2_ __attribute__((ext_vector_type(2)));
                const int sub = lane & 7; const int c4 = 4 * lane;
                const f32x4 qg0 = *(const f32x4*)(qg + 8 * sub), qg1 = *(const f32x4*)(qg + 8 * sub + 4), kg0 = *(const f32x4*)(kg + 8 * sub), kg1 = *(const f32x4*)(kg + 8 * sub + 4);
                const f32x4 cw0 = *(const f32x4*)(cw + c4), cw1 = *(const f32x4*)(cw + 256 + c4), cw2 = *(const f32x4*)(cw + 512 + c4);
                v4u rq, rk, rv; u32x2_ b0, g0_, u0, g1_, u1, g2_, u2;
#define AP_LOAD(rw) do { const int p1_ = prevrow(rw), p2_ = prevrow(p1_); const bf16* q_ = PROJ + (size_t)(rw) * INP; const bf16* q1_ = PROJ + (size_t)(p1_ < 0 ? (rw) : p1_) * INP; const bf16* q2_ = PROJ + (size_t)(p2_ < 0 ? (rw) : p2_) * INP; \
                    rq = *(const v4u*)(q_ + QOFF + 8 * lane); rk = *(const v4u*)(q_ + KOFF + 8 * lane); rv = *(const v4u*)(q_ + VOFF + 8 * lane); (void)q1_; (void)q2_; } while (0)
#define CV_LOAD(rw) do { const int p1_ = prevrow(rw), p2_ = prevrow(p1_); const bf16* q_ = PROJ + (size_t)(rw) * INP; const bf16* q1_ = PROJ + (size_t)(p1_ < 0 ? (rw) : p1_) * INP; const bf16* q2_ = PROJ + (size_t)(p2_ < 0 ? (rw) : p2_) * INP; \
                    b0 = *(const u32x2_*)(q_ + COFF + c4); g0_ = *(const u32x2_*)(q_ + COFF + 256 + c4); u0 = *(const u32x2_*)(q_ + COFF + 512 + c4); \
                    g1_ = *(const u32x2_*)(q1_ + COFF + 256 + c4); u1 = *(const u32x2_*)(q1_ + COFF + 512 + c4); g2_ = *(const u32x2_*)(q2_ + COFF + 256 + c4); u2 = *(const u32x2_*)(q2_ + COFF + 512 + c4); } while (0)
#define U2F4(t_) ((f32x4){__uint_as_float((t_).x << 16), __uint_as_float((t_).x & 0xffff0000u), __uint_as_float((t_).y << 16), __uint_as_float((t_).y & 0xffff0000u)})
                int idx = wave; AP_LOAD(MP_ROW(idx));
                for (; idx < nrows; idx += 8) { const int row = MP_ROW(idx);
                    const int p1 = prevrow(row), p2 = prevrow(p1); const float m1 = p1 < 0 ? 0.f : 1.f, m2 = p2 < 0 ? 0.f : 1.f;
                    const v4u cq = rq, ck = rk, cv = rv;
                    CV_LOAD(row);
                    if (idx + 8 < nrows) AP_LOAD(MP_ROW(idx + 8));
                    const int pos = row >= NREAL ? row - NREAL : NMETA + (row & (SEQ - 1));
                    const f32x4 c0 = *(const f32x4*)(COS + pos * 8), c1 = *(const f32x4*)(COS + pos * 8 + 4), n0 = *(const f32x4*)(SIN + pos * 8), n1 = *(const f32x4*)(SIN + pos * 8 + 4);
                    const float cs[8] = {c0.x, c0.y, c0.z, c0.w, c1.x, c1.y, c1.z, c1.w}; const float sn[8] = {n0.x, n0.y, n0.z, n0.w, n1.x, n1.y, n1.z, n1.w};
#pragma unroll
                    for (int which = 0; which < 2; ++which) {
                        const v4u raw = which ? ck : cq;
                        float x[8] = {__uint_as_float(raw.x << 16), __uint_as_float(raw.x & 0xffff0000u), __uint_as_float(raw.y << 16), __uint_as_float(raw.y & 0xffff0000u),
                                      __uint_as_float(raw.z << 16), __uint_as_float(raw.z & 0xffff0000u), __uint_as_float(raw.w << 16), __uint_as_float(raw.w & 0xffff0000u)};
                        float s2 = 0.f;
#pragma unroll
                        for (int i = 0; i < 8; ++i) s2 += x[i] * x[i];
                        s2 = sum8(s2);
                        const float rs = 1.f / sqrtf(s2 * (1.f / 64.f) + 1e-6f);
                        const f32x4 ga = which ? kg0 : qg0, gb = which ? kg1 : qg1;
                        const float gg[8] = {ga.x, ga.y, ga.z, ga.w, gb.x, gb.y, gb.z, gb.w};
                        float o[8];
#pragma unroll
                        for (int i = 0; i < 8; ++i) { const float xn = x[i] * rs * gg[i]; const float xp = lane_xor1(xn);
                            o[i] = sub == 0 ? xn * cs[i] - xp * sn[i] : (sub == 1 ? xn * cs[i] + xp * sn[i] : xn); if (!which) o[i] *= C2Q; }
                        v4u w; w.x = pk2(o[0], o[1]); w.y = pk2(o[2], o[3]); w.z = pk2(o[4], o[5]); w.w = pk2(o[6], o[7]);
                        if (!which) *(v4u*)(QN + (size_t)row * 512 + 8 * lane) = w;
                        else {
                            if (row < NREAL) { const size_t kr = (size_t)((row >> 12) * KVROWS + 128 + (row & (SEQ - 1))) * 512 + 8 * lane; *(v4u*)(KP + kr) = w; *(v4u*)(VP + kr) = cv; }
                            else {
#pragma unroll
                                for (int b = 0; b < NB; ++b) { const size_t kr = (size_t)(b * KVROWS + 48 + (row - NREAL)) * 512 + 8 * lane; *(v4u*)(KP + kr) = w; *(v4u*)(VP + kr) = cv; } } }
                    }
                    { const f32x4 fb0 = U2F4(b0), z0 = U2F4(g0_) * U2F4(u0), z1 = U2F4(g1_) * U2F4(u1) * m1, z2 = U2F4(g2_) * U2F4(u2) * m2;
                      const f32x4 y = cw0 * z2 + cw1 * z1 + cw2 * z0; const f32x4 o = fb0 * y;
                      *(unsigned long long*)(OMIX + (size_t)row * DM + 768 + c4) = (unsigned long long)pk2(o.x, o.y) | ((unsigned long long)pk2(o.z, o.w) << 32); }
                }
#undef AP_LOAD
#undef CV_LOAD
#undef U2F4
            }
            {
                LAS float* XL = (LAS float*)(lds + wave * 17408);
                LAS float* YL = XL + 32 * 65;
                const int nreal_g = ngrp - (bx == 0 ? 1 : 0);
                for (int lt = wave; lt < 4 * nreal_g + (bx == 0 ? 4 : 0); lt += NWAVES) {
                    int bh, ch; if (lt < 4 * nreal_g) { const int g = bx + 256 * (lt >> 2); bh = (g >> 8) * 4 + (lt & 3); ch = (g & 255) + 1; } else { bh = lt - 4 * nreal_g; ch = 0; }
                    const int task = bh * 257 + ch, b = bh >> 2, cb = (bh & 3) * 64; const int rowbase = ch == 0 ? NREAL : b * SEQ + 16 * (ch - 1);
                    float at[16], rt[16], bt[16], kt[16], vsv[16]; float gam = 1.f;
                    { const int c = cb + lane;
                      const float mu_r = mu[c], mu_k = mu[256 + c], mu_v = mu[512 + c], w0c = w0[c], a0c = a0[c], kkc = k_k[c], kac = k_a[c], rkc = r_k[c];
                      const int p0 = prevrow(rowbase); const bf16* q0 = PROJ + (size_t)(p0 < 0 ? rowbase : p0) * INP + c; const float pm = p0 < 0 ? 0.f : 1.f;
                      float pr_ = pm * bf2f(q0[0]), pk_ = pm * bf2f(q0[256]), pv_ = pm * bf2f(q0[512]);
                      unsigned short xr[16], xk[16], xv[16], la[16], lg[16]; float lw[16];
#pragma unroll
                      for (int t = 0; t < 16; ++t) { const bf16* q_ = PROJ + (size_t)(rowbase + t) * INP + c; xr[t] = q_[0]; xk[t] = q_[256]; xv[t] = q_[512];
                          lw[t] = LORA_W[(size_t)(rowbase + t) * 256 + c]; la[t] = LORA_AG[(size_t)(rowbase + t) * 512 + c]; lg[t] = LORA_AG[(size_t)(rowbase + t) * 512 + 256 + c]; }
#pragma unroll
                      for (int t = 0; t < 16; ++t) {
                          const float fr = bf2f(xr[t]), fk = bf2f(xk[t]), fv = bf2f(xv[t]);
                          const float r = fr + (pr_ - fr) * mu_r, k = fk + (pk_ - fk) * mu_k, v = fv + (pv_ - fv) * mu_v; pr_ = fr; pk_ = fk; pv_ = fv;
                          const float wacc = w0c + lw[t], aacc = a0c + bf2f(la[t]), gacc = bf2f(lg[t]);
                          const float nx = -wacc; const float sp = fmaxf(nx, 0.f) + __logf(1.f + __expf(-fabsf(nx)));
                          const float wlog = -sp - 0.5f; const float decay = __expf(-__expf(wlog));
                          const float a = sigmoidf_(aacc);
                          const float kkr = k * kkc; const float ss = wave_sum_dpp(kkr * kkr); const float kk = kkr / fmaxf(sqrtf(ss), 1e-12f);
                          const float k2 = k * (1.f + (a - 1.f) * kac);
                          const float bs = wave_sum_dpp(r * k2 * rkc);
                          const size_t si = (size_t)(rowbase + t) * 256 + c;
                          SG[si] = gacc; SBON[si] = bs * v;
                          at[t] = -kk * gam; gam *= decay; rt[t] = r * gam; const float ig = 1.f / gam; bt[t] = kk * a * ig; kt[t] = k2 * ig; vsv[t] = v; } }
#pragma unroll
                    for (int t = 0; t < 16; ++t) { XL[t * 65 + lane] = bt[t]; XL[(16 + t) * 65 + lane] = kt[t]; YL[t * 65 + lane] = at[t]; YL[(16 + t) * 65 + lane] = rt[t]; }
                    attn_body::f32x16 gm = attn_body::f32x16{};
#pragma unroll 8
                    for (int kk = 0; kk < 32; ++kk) gm = __builtin_amdgcn_mfma_f32_32x32x2f32(XL[(lane & 31) * 65 + 2 * kk + (lane >> 5)], YL[(lane & 31) * 65 + 2 * kk + (lane >> 5)], gm, 0, 0, 0);
                    LDS_WAIT();
                    LAS float* GL = YL; LAS float* TL = YL + 1056; LAS float* XM = YL + 1328;
#pragma unroll
                    for (int r = 0; r < 16; ++r) GL[((r & 3) + 8 * (r >> 2) + 4 * (lane >> 5)) * 33 + (lane & 31)] = gm[r];
                    float tr[16];
#pragma unroll
                    for (int t = 0; t < 16; ++t) tr[t] = ((lane & 15) == t) ? 1.f : 0.f;
#pragma unroll
                    for (int s = 0; s < 15; ++s)
#pragma unroll
                        for (int t = s + 1; t < 16; ++t) tr[t] = fmaf(tr[s], GL[s * 33 + t], tr[t]);
                    if (lane < 16) {
#pragma unroll
                        for (int t = 0; t < 16; ++t) TL[lane * 17 + t] = tr[t]; }
                    { const int s = lane & 15, q = lane >> 4; float x0 = 0.f, x1 = 0.f, x2 = 0.f, x3 = 0.f;
#pragma unroll
                      for (int u = 1; u < 16; ++u) { const float l = (u > s) ? GL[(16 + s) * 33 + u] : 0.f; x0 = fmaf(l, TL[u * 17 + 4 * q], x0); x1 = fmaf(l, TL[u * 17 + 4 * q + 1], x1); x2 = fmaf(l, TL[u * 17 + 4 * q + 2], x2); x3 = fmaf(l, TL[u * 17 + 4 * q + 3], x3); }
                      XM[s * 17 + 4 * q] = x0; XM[s * 17 + 4 * q + 1] = x1; XM[s * 17 + 4 * q + 2] = x2; XM[s * 17 + 4 * q + 3] = x3; }
                    float atT[16];
#pragma unroll
                    for (int sp = 0; sp < 16; ++sp) { float acc = 0.f;
#pragma unroll
                        for (int s = 0; s <= sp; ++s) acc = fmaf(at[s], TL[s * 17 + sp], acc);
                        atT[sp] = acc; }
                    unsigned char* rec = CH_REC + (size_t)task * CH_RB;
                    ((float*)rec)[lane] = gam;
                    LAS unsigned short* ST = (LAS unsigned short*)XL;
                    const int kpos = (lane & ~15) + 8 * ((lane >> 2) & 1) + (lane & 3) + 4 * ((lane >> 3) & 1);
                    float zz[16];
#pragma unroll
                    for (int s = 0; s < 16; ++s) { float acc = kt[s] * gam;
#pragma unroll
                        for (int sp = s + 1; sp < 16; ++sp) acc = fmaf(XM[s * 17 + sp], bt[sp] * gam, acc);
                        zz[s] = acc; }
#pragma unroll
                    for (int t = 0; t < 16; ++t) { float acc = rt[t];
#pragma unroll
                        for (int s = 0; s <= t; ++s) acc = fmaf(atT[s], GL[s * 33 + 16 + t], acc);
                        ST[t * 64 + kpos] = (unsigned short)f2bf(atT[t]); ST[(16 + t) * 64 + kpos] = (unsigned short)f2bf(acc); }
                    { v4u w0, w1;
                      w0.x = pk2(bt[0] * gam, bt[1] * gam); w0.y = pk2(bt[2] * gam, bt[3] * gam); w0.z = pk2(bt[8] * gam, bt[9] * gam); w0.w = pk2(bt[10] * gam, bt[11] * gam);
                      w1.x = pk2(bt[4] * gam, bt[5] * gam); w1.y = pk2(bt[6] * gam, bt[7] * gam); w1.z = pk2(bt[12] * gam, bt[13] * gam); w1.w = pk2(bt[14] * gam, bt[15] * gam);
                      v4u* d = (v4u*)(rec + 4352 + lane * 32); d[0] = w0; d[1] = w1;
                      v4u z0, z1; z0.x = pk2(zz[0], zz[1]); z0.y = pk2(zz[2], zz[3]); z0.z = pk2(zz[4], zz[5]); z0.w = pk2(zz[6], zz[7]);
                      z1.x = pk2(zz[8], zz[9]); z1.y = pk2(zz[10], zz[11]); z1.z = pk2(zz[12], zz[13]); z1.w = pk2(zz[14], zz[15]);
                      v4u* dz = (v4u*)(rec + 6400 + lane * 32); dz[0] = z0; dz[1] = z1; }
                    { float vs[16];
#pragma unroll
                      for (int s = 0; s < 16; ++s) vs[s] = vsv[s];
                      v4u a0, a1; a0.x = pk2(vs[0], vs[1]); a0.y = pk2(vs[2], vs[3]); a0.z = pk2(vs[4], vs[5]); a0.w = pk2(vs[6], vs[7]);
                      a1.x = pk2(vs[8], vs[9]); a1.y = pk2(vs[10], vs[11]); a1.z = pk2(vs[12], vs[13]); a1.w = pk2(vs[14], vs[15]);
                      v4u* dv = (v4u*)(rec + 8448 + lane * 32); dv[0] = a0; dv[1] = a1; }
                    { const int s = lane & 15, q = lane >> 4;
#pragma unroll
                      for (int e = 0; e < 4; ++e) { const int t = 4 * q + e; float acc = (t >= s) ? GL[(16 + s) * 33 + 16 + t] : 0.f;
#pragma unroll
                          for (int sp = 1; sp < 16; ++sp) { const float m = (sp <= t) ? GL[sp * 33 + 16 + t] : 0.f; acc = fmaf(XM[s * 17 + sp], m, acc); }
                          ((unsigned short*)(rec + 10496))[t * 16 + s] = (unsigned short)f2bf(acc); } }
                    LDS_WAIT();
                    { const LAS v4u* sv = (const LAS v4u*)ST + lane; v4u* d = (v4u*)(rec + 256) + lane;
#pragma unroll
                      for (int i = 0; i < 4; ++i) d[64 * i] = sv[64 * i]; }
                    LDS_WAIT();
                    if (ch == 0) {
                        asm volatile("s_waitcnt vmcnt(0)" ::: "memory");
                        const v4u* src = (const v4u*)rec;
#pragma unroll 1
                        for (int i = lane; i < CH_RB / 16; i += 64) { const v4u w = src[i];
#pragma unroll
                            for (int cp = 1; cp < 4; ++cp) ((v4u*)(CH_REC + (size_t)((bh + 4 * cp) * 257) * CH_RB))[i] = w; }
                    }
                }
            }
            SEAM(pb + 2);
        }
        for (int rep_ = 0; rep_ < NREP(3); ++rep_) if (EN(3) && IN(pb + 3)) { PH_TID;
#define PK8(T, o) ((v4u){attn_body::cvtpk_s(T[o], T[o + 1]), attn_body::cvtpk_s(T[o + 2], T[o + 3]), attn_body::cvtpk_s(T[o + 4], T[o + 5]), attn_body::cvtpk_s(T[o + 6], T[o + 7])})
            for (int rep2_ = 0; rep2_ < NREP(13); ++rep2_)
            if (bx < 32) {
                typedef attn_body::bf16x8 bfx8; typedef attn_body::f32x16 fx16;
                const int bh = bx >> 1, vh = bx & 1, n = lane & 31, hh = lane >> 5;
                const unsigned char* rec0 = CH_REC + (size_t)(bh * 257) * CH_RB;
                const unsigned lds0 = (unsigned)(uintptr_t)lds_raw;
                constexpr int RBUF = 6 * CH_RB;
#define S2_ISSUE(rnd) do { if (wave >= 1 && wave <= 6) { const int c_ = 6 * (rnd) + wave - 1; if (c_ < 257) { const unsigned dst_ = lds0 + ((rnd) & 1) * RBUF + (wave - 1) * CH_RB; \
                    for (int p_ = 0; p_ < 11; ++p_) attn_body::glds16s(rec0 + (size_t)c_ * CH_RB + p_ * 1024, (unsigned)lane * 16u, (unsigned)__builtin_amdgcn_readfirstlane(dst_ + p_ * 1024)); } } } while (0)
                S2_ISSUE(0);
                asm volatile("s_waitcnt vmcnt(0)\n\ts_barrier" ::: "memory");
                v4u* spk = (v4u*)(CH_SPK + (size_t)(bh * 257) * 8192 + vh * 4096) + lane;
                fx16 st0 = fx16{}, st1 = fx16{};
                for (int rnd = 0; rnd < 43; ++rnd) {
                    S2_ISSUE(rnd + 1);
                    if (wave == 0) {
                        v4u atf[4], bhf[2], ztf[2], vtf; f32x4 gq[8];
#define S2_FRAGS(j_) do { const LAS unsigned char* r_ = lds + (rnd & 1) * RBUF + (j_) * CH_RB; \
                            _Pragma("unroll") for (int ks = 0; ks < 4; ++ks) atf[ks] = *(const LAS v4u*)(r_ + 256 + ((lane & 15) * 64 + 16 * ks + 8 * hh) * 2); \
                            _Pragma("unroll") for (int i = 0; i < 2; ++i) { bhf[i] = *(const LAS v4u*)(r_ + 4352 + ((32 * i + n) * 16 + 8 * hh) * 2); ztf[i] = *(const LAS v4u*)(r_ + 6400 + ((32 * i + n) * 16 + 8 * hh) * 2); } \
                            vtf = *(const LAS v4u*)(r_ + 8448 + ((32 * vh + n) * 16 + 8 * hh) * 2); \
                            _Pragma("unroll") for (int i = 0; i < 2; ++i) _Pragma("unroll") for (int q = 0; q < 4; ++q) gq[4 * i + q] = *(const LAS f32x4*)(r_ + (32 * i + 8 * q + 4 * hh) * 4); } while (0)
                        S2_FRAGS(0);
                        for (int j = 0; j < 6; ++j) { const int ch = 6 * rnd + j; if (ch >= 257) break;
                            const v4u a0 = atf[0], a1 = atf[1], a2 = atf[2], a3 = atf[3], b0 = bhf[0], b1 = bhf[1], z0 = ztf[0], z1 = ztf[1], vt = vtf;
                            f32x4 g_[8];
#pragma unroll
                            for (int i = 0; i < 8; ++i) g_[i] = gq[i];
                            if (j < 5) S2_FRAGS(j + 1);
                            const v4u s0 = PK8(st0, 0), s1 = PK8(st0, 8), s2 = PK8(st1, 0), s3 = PK8(st1, 8);
                            spk[(size_t)ch * 512 + 0] = s0; spk[(size_t)ch * 512 + 64] = s1; spk[(size_t)ch * 512 + 128] = s2; spk[(size_t)ch * 512 + 192] = s3;
                            fx16 pt = fx16{};
                            pt = __builtin_amdgcn_mfma_f32_32x32x16_bf16(__builtin_bit_cast(bfx8, a0), __builtin_bit_cast(bfx8, s0), pt, 0, 0, 0);
                            pt = __builtin_amdgcn_mfma_f32_32x32x16_bf16(__builtin_bit_cast(bfx8, a1), __builtin_bit_cast(bfx8, s1), pt, 0, 0, 0);
                            pt = __builtin_amdgcn_mfma_f32_32x32x16_bf16(__builtin_bit_cast(bfx8, a2), __builtin_bit_cast(bfx8, s2), pt, 0, 0, 0);
                            pt = __builtin_amdgcn_mfma_f32_32x32x16_bf16(__builtin_bit_cast(bfx8, a3), __builtin_bit_cast(bfx8, s3), pt, 0, 0, 0);
#pragma unroll
                            for (int q = 0; q < 4; ++q) { st0[4 * q] *= g_[q].x; st0[4 * q + 1] *= g_[q].y; st0[4 * q + 2] *= g_[q].z; st0[4 * q + 3] *= g_[q].w;
                                                          st1[4 * q] *= g_[4 + q].x; st1[4 * q + 1] *= g_[4 + q].y; st1[4 * q + 2] *= g_[4 + q].z; st1[4 * q + 3] *= g_[4 + q].w; }
                            st0 = __builtin_amdgcn_mfma_f32_32x32x16_bf16(__builtin_bit_cast(bfx8, z0), __builtin_bit_cast(bfx8, vt), st0, 0, 0, 0);
                            st1 = __builtin_amdgcn_mfma_f32_32x32x16_bf16(__builtin_bit_cast(bfx8, z1), __builtin_bit_cast(bfx8, vt), st1, 0, 0, 0);
                            const v4u pp = PK8(pt, 0);
                            st0 = __builtin_amdgcn_mfma_f32_32x32x16_bf16(__builtin_bit_cast(bfx8, b0), __builtin_bit_cast(bfx8, pp), st0, 0, 0, 0);
                            st1 = __builtin_amdgcn_mfma_f32_32x32x16_bf16(__builtin_bit_cast(bfx8, b1), __builtin_bit_cast(bfx8, pp), st1, 0, 0, 0);
                        }
#undef S2_FRAGS
                        asm volatile("s_waitcnt lgkmcnt(0)\n\ts_barrier" ::: "memory");
                    } else asm volatile("s_waitcnt vmcnt(0) lgkmcnt(0)\n\ts_barrier" ::: "memory");
                }
#undef S2_ISSUE
            }
            __syncthreads();
            for (int rep2_ = 0; rep2_ < NREP(12); ++rep2_)
            { const attn_body::AttnTensors AT{(const attn_body::bf16*)QN, (const attn_body::bf16*)KP, (const attn_body::bf16*)VP, (attn_body::bf16*)OC};
              const attn_body::QueueOrder SO{(unsigned*)(ctl + CW_ATTQ + (layer * 8 + (bx & 7)) * 64), (LAS unsigned*)(lds + MISC_OFF + 64), bx & 7, tid};
              attn_body::attn_phase<attn_body::QueueOrder>((char*)lds_raw, AT, SO, tid); }
            __syncthreads();
#ifndef NO_META
            {
                LAS float* sc = (LAS float*)(lds + wave * 1024); LAS float* qs = sc + 64;
                for (int task = gw; task < NMETA * 8; task += NGW) {
                    const int row = NREAL + (task >> 3), hc = task & 7, h = hc >> 1; const int n = row - NREAL + 1;
                    qs[lane] = bf2f(QN[(size_t)row * 512 + hc * 64 + lane]);
                    float m = -INFINITY;
                    { const int idx = lane;
                        if (idx < n) { const size_t kr = 48 + idx; const v4u* kp = (const v4u*)(KP + kr * 512 + hc * 64); float dot = 0.f;
#pragma unroll
                            for (int c8 = 0; c8 < 8; ++c8) { const v4u kv = kp[c8];
                                dot += qs[c8 * 8 + 0] * __uint_as_float(kv.x << 16) + qs[c8 * 8 + 1] * __uint_as_float(kv.x & 0xffff0000u) + qs[c8 * 8 + 2] * __uint_as_float(kv.y << 16) + qs[c8 * 8 + 3] * __uint_as_float(kv.y & 0xffff0000u)
                                     + qs[c8 * 8 + 4] * __uint_as_float(kv.z << 16) + qs[c8 * 8 + 5] * __uint_as_float(kv.z & 0xffff0000u) + qs[c8 * 8 + 6] * __uint_as_float(kv.w << 16) + qs[c8 * 8 + 7] * __uint_as_float(kv.w & 0xffff0000u); }
                            sc[idx] = dot; m = dot; } }
                    m = wave_max(m);
                    float l = 0.f;
                    if (lane < n) { const float p = __builtin_amdgcn_exp2f(sc[lane] - m); sc[lane] = p; l = p; }
                    l = wave_sum(l);
                    float o0 = 0.f, o1 = 0.f;
                    for (int idx = 0; idx < n; ++idx) { const float p = sc[idx]; const size_t vr = 48 + idx;
                        const unsigned v2 = *(const unsigned*)(VP + vr * 512 + h * 128 + 2 * lane); o0 += p * __uint_as_float(v2 << 16); o1 += p * __uint_as_float(v2 & 0xffff0000u); }
                    const float inv = 1.f / l;
                    *(unsigned*)(OC + (size_t)row * 1024 + hc * 128 + 2 * lane) = pk2(o0 * inv, o1 * inv);
                    LDS_WAIT();
                }
            }
#endif
            SEAM(pb + 3);
        }
        for (int rep_ = 0; rep_ < NREP(4); ++rep_) if (EN(4) && IN(pb + 4)) { PH_TID;
            const float* gn_g = INP(13) + layer * 256; const float* gn_b = INP(14) + layer * 256; const float* subg = INP(21) + layer * 128;
            const float s1 = wave_sum(INP(17)[layer * 64 + lane] * INP(18)[layer * 64 + lane]); const float s2 = wave_sum(INP(19)[layer * 64 + lane] * INP(20)[layer * 64 + lane]);
            const float lam = __expf(s1) - __expf(s2) + lam_init;
            const int ngrp = (1025 - bx + 255) / 256, nrows = 16 * ngrp;
            {
                typedef attn_body::bf16x8 bfx8; typedef attn_body::f32x16 fx16;
                const int n = lane & 31, hh = lane >> 5;
                v4u na_[4], ns_[4], nx_, nv_;
#define S3_LOAD(lt_) do { const int g_ = bx + 256 * ((lt_) >> 3), hd_ = ((lt_) >> 1) & 3, vh_ = (lt_) & 1; const int bh_ = g_ < 1024 ? (g_ >> 8) * 4 + hd_ : hd_, ch_ = g_ < 1024 ? (g_ & 255) + 1 : 0; const int ct_ = bh_ * 257 + ch_; \
                    const unsigned char* q_ = CH_REC + (size_t)ct_ * CH_RB; const v4u* sp_ = (const v4u*)(CH_SPK + (size_t)ct_ * 8192 + vh_ * 4096) + lane; \
                    _Pragma("unroll") for (int ks = 0; ks < 4; ++ks) { na_[ks] = *(const v4u*)(q_ + 2304 + ((lane & 15) * 64 + 16 * ks + 8 * hh) * 2); ns_[ks] = sp_[64 * ks]; } \
                    nx_ = *(const v4u*)(q_ + 10496 + ((lane & 15) * 16 + 8 * hh) * 2); nv_ = *(const v4u*)(q_ + 8448 + ((32 * vh_ + n) * 16 + 8 * hh) * 2); } while (0)
                S3_LOAD(wave);
                for (int lt = wave; lt < 8 * ngrp; lt += NWAVES) {
                    const int g = bx + 256 * (lt >> 3), hd = (lt >> 1) & 3, vh = lt & 1; const int bh = g < 1024 ? (g >> 8) * 4 + hd : hd, ch = g < 1024 ? (g & 255) + 1 : 0;
                    const int b = bh >> 2, cb = (bh & 3) * 64; const int rowbase = ch == 0 ? NREAL : b * SEQ + 16 * (ch - 1);
                    v4u ca_[4], cs_[4]; const v4u cx_ = nx_, cv_ = nv_;
#pragma unroll
                    for (int ks = 0; ks < 4; ++ks) { ca_[ks] = na_[ks]; cs_[ks] = ns_[ks]; }
                    if (lt + NWAVES < 8 * ngrp) S3_LOAD(lt + NWAVES);
                    fx16 y = fx16{};
#pragma unroll
                    for (int ks = 0; ks < 4; ++ks) y = __builtin_amdgcn_mfma_f32_32x32x16_bf16(__builtin_bit_cast(bfx8, ca_[ks]), __builtin_bit_cast(bfx8, cs_[ks]), y, 0, 0, 0);
                    y = __builtin_amdgcn_mfma_f32_32x32x16_bf16(__builtin_bit_cast(bfx8, cx_), __builtin_bit_cast(bfx8, cv_), y, 0, 0, 0);
                    {
#pragma unroll
                        for (int r = 0; r < 8; ++r) SY[(size_t)(rowbase + (r & 3) + 8 * (r >> 2) + 4 * hh) * 256 + cb + 32 * vh + n] = y[r]; }
                }
#undef S3_LOAD
            }
#undef PK8
            asm volatile("s_waitcnt vmcnt(0)" ::: "memory");
            __syncthreads();
            {
                const int h = lane >> 4, j8 = (lane & 15) * 8;
                f32x4 ny, nbon, ngt; v4u na0, na1;
#define POST_LOAD(rw) do { const int r_ = (rw); ny = *(const f32x4*)(SY + (size_t)r_ * 256 + 4 * lane); nbon = *(const f32x4*)(SBON + (size_t)r_ * 256 + 4 * lane); ngt = *(const f32x4*)(SG + (size_t)r_ * 256 + 4 * lane); \
                    na0 = *(const v4u*)(OC + (size_t)r_ * 1024 + (h * 2 + 0) * 128 + j8); na1 = *(const v4u*)(OC + (size_t)r_ * 1024 + (h * 2 + 1) * 128 + j8); } while (0)
                const f32x4 gg = *(const f32x4*)(gn_g + 4 * lane), gb = *(const f32x4*)(gn_b + 4 * lane), g0 = *(const f32x4*)(subg + j8), g1 = *(const f32x4*)(subg + j8 + 4);
                int idx = wave; POST_LOAD(MP_ROW(idx));
                for (; idx < nrows; idx += NWAVES) { const int row = MP_ROW(idx);
                    const f32x4 y = ny, bon = nbon, gt = ngt; const v4u a0 = na0, a1 = na1;
                    if (idx + NWAVES < nrows) POST_LOAD(MP_ROW(idx + NWAVES));
                    { const float mean = sum16((y.x + y.y) + (y.z + y.w)) * (1.f / 64.f);
                      const f32x4 dlt = y - mean; const float var = sum16((dlt.x * dlt.x + dlt.y * dlt.y) + (dlt.z * dlt.z + dlt.w * dlt.w)) * (1.f / 64.f); const float rs = 1.f / sqrtf(var + 64e-5f);
                      const f32x4 o = (dlt * rs * gg + gb + bon) * gt;
                      *(unsigned long long*)(OMIX + (size_t)row * DM + 4 * lane) = (unsigned long long)pk2(o.x, o.y) | ((unsigned long long)pk2(o.z, o.w) << 32); }
                    { float dv[8];
                      dv[0] = __uint_as_float(a0.x << 16) - lam * __uint_as_float(a1.x << 16); dv[1] = __uint_as_float(a0.x & 0xffff0000u) - lam * __uint_as_float(a1.x & 0xffff0000u);
                      dv[2] = __uint_as_float(a0.y << 16) - lam * __uint_as_float(a1.y << 16); dv[3] = __uint_as_float(a0.y & 0xffff0000u) - lam * __uint_as_float(a1.y & 0xffff0000u);
                      dv[4] = __uint_as_float(a0.z << 16) - lam * __uint_as_float(a1.z << 16); dv[5] = __uint_as_float(a0.z & 0xffff0000u) - lam * __uint_as_float(a1.z & 0xffff0000u);
                      dv[6] = __uint_as_float(a0.w << 16) - lam * __uint_as_float(a1.w << 16); dv[7] = __uint_as_float(a0.w & 0xffff0000u) - lam * __uint_as_float(a1.w & 0xffff0000u);
                      float ss = 0.f;
#pragma unroll
                      for (int i = 0; i < 8; ++i) ss += dv[i] * dv[i];
                      ss = sum16(ss); const float sc_ = (1.f / sqrtf(ss * (1.f / 128.f) + 1e-5f)) * (1.f - lam_init);
                      v4u o; o.x = pk2(dv[0] * sc_ * g0.x, dv[1] * sc_ * g0.y); o.y = pk2(dv[2] * sc_ * g0.z, dv[3] * sc_ * g0.w); o.z = pk2(dv[4] * sc_ * g1.x, dv[5] * sc_ * g1.y); o.w = pk2(dv[6] * sc_ * g1.z, dv[7] * sc_ * g1.w);
                      *(v4u*)(OMIX + (size_t)row * DM + 256 + h * 128 + j8) = o; }
                }
#undef POST_LOAD
            }
            { const int gt = bx * (NWAVES * 64) + tid, NGT = G * NWAVES * 64;
              for (int i = gt; i < (MPAD - NTOK) * (DM / 8); i += NGT) ((v4u*)(OMIX + (size_t)NTOK * DM))[i] = zero_v4u(); }
            SEAM(pb + 4);
        }
        if (EN(5) && IN(pb + 5)) { PH_TID;
            pg8::Gemm g{OMIX, (const bf16*)(ws + WS_WOUT) + (size_t)layer * DM * DM, NREAL, DM, DM}; pg8::StaticOrder S; S.init(NREAL, DM, G, bx);
            if (!moe) {
                if (layer == 2) {
                    meta_gemm_res(OMIX + (size_t)NREAL * DM, DM, (const bf16*)(ws + WS_WOUT) + (size_t)layer * DM * DM, Hf + (size_t)NREAL * DM, lds, bx, wave, lane, 2, (bf16*)((unsigned char*)HB + (size_t)NREAL * DM), RSQA + NREAL);
                    typedef pg8::EpiResAddHB<2, (long long)WS_HB - (long long)WS_H, (long long)WS_RSROW - (long long)WS_H> EpiHB2; EpiHB2 E{Hf, DM, 1.f};
                    pg8::gemm_phase<EpiHB2, pg8::StaticOrder, true, true>(lds, g, S, E, tid);
                } else {
                    meta_gemm_res(OMIX + (size_t)NREAL * DM, DM, (const bf16*)(ws + WS_WOUT) + (size_t)layer * DM * DM, Hf + (size_t)NREAL * DM, lds, bx, wave, lane, 1, HB + (size_t)NREAL * DM, RSQA + NREAL);
                    typedef pg8::EpiResAddHB<1, (long long)WS_HB - (long long)WS_H, (long long)WS_RSROW - (long long)WS_H> EpiHB1; EpiHB1 E{Hf, DM, 1.f};
                    pg8::gemm_phase<EpiHB1, pg8::StaticOrder, true, true>(lds, g, S, E, tid);
                }
            } else {
                meta_gemm_res(OMIX + (size_t)NREAL * DM, DM, (const bf16*)(ws + WS_WOUT) + (size_t)layer * DM * DM, Hf + (size_t)NREAL * DM, lds, bx, wave, lane);
                pg8::EpiResAdd E{Hf, DM, 1.f};
                pg8::gemm_phase<pg8::EpiResAdd, pg8::StaticOrder, true, true>(lds, g, S, E, tid);
            }
            SEAM(pb + 5);
        }
        if (EN(6) && IN(pb + 6) && moe) { PH_TID;
            LAS int* lcnt = (LAS int*)lds; LAS int* lbase = lcnt + 8; LAS int* lrow = lcnt + 16;
            if (tid < 16) lcnt[tid] = 0;
            __syncthreads();
            const float* gff = INP(24) + layer * DM; const float* Wr = INP(28) + (size_t)jj * DM * NE;
            f32x4 nv6_[4];
            { const GAS f32x4* xr = (const GAS f32x4*)(Hf + (size_t)(bx + G * wave) * DM) + lane;
#pragma unroll
              for (int j = 0; j < 4; ++j) nv6_[j] = xr[64 * j]; }
            for (int i = wave; i < 72; i += NWAVES) { const int row = bx + G * i;
                if (row < NTOK) {
                    f32x4 v[4]; float s = 0.f;
#pragma unroll
                    for (int j = 0; j < 4; ++j) v[j] = nv6_[j];
                    { const int rn_ = row + G * NWAVES < NTOK ? row + G * NWAVES : row; const GAS f32x4* xr = (const GAS f32x4*)(Hf + (size_t)rn_ * DM) + lane;
#pragma unroll
                      for (int j = 0; j < 4; ++j) nv6_[j] = xr[64 * j]; }
#pragma unroll
                    for (int j = 0; j < 4; ++j) s += (v[j].x * v[j].x + v[j].y * v[j].y) + (v[j].z * v[j].z + v[j].w * v[j].w);
                    s = wave_sum(s); const float rstd = 1.f / sqrtf(s * (1.f / DM) + 1e-6f);
                    if (moe) { LAS unsigned* o4 = (LAS unsigned*)(lds + 4096 + i * 1024) + lane; const float sn = rstd * A8_SCALE;
#pragma unroll
                      for (int j = 0; j < 4; ++j) o4[64 * j] = pk4_fp8(v[j].x * sn, v[j].y * sn, v[j].z * sn, v[j].w * sn); }
                    else if (layer == 2) { GAS unsigned* o4 = (GAS unsigned*)((GAS unsigned char*)HB + (size_t)row * DM) + lane; const float sn = rstd * A8_SCALE;
#pragma unroll
                      for (int j = 0; j < 4; ++j) o4[64 * j] = pk4_fp8(v[j].x * sn, v[j].y * sn, v[j].z * sn, v[j].w * sn); }
                    else { GAS unsigned long long* o8 = (GAS unsigned long long*)(HB + (size_t)row * DM) + lane;
#pragma unroll
                      for (int j = 0; j < 4; ++j) o8[64 * j] = (unsigned long long)pk2(v[j].x, v[j].y) | ((unsigned long long)pk2(v[j].z, v[j].w) << 32); }
                    if (lane == 0) RSTD[row] = rstd;
                    if (moe) {
                        float lg[8];
#pragma unroll
                        for (int e = 0; e < 8; ++e) lg[e] = 0.f;
#pragma unroll
                        for (int j = 0; j < 4; ++j) { const int k0 = 4 * lane + 256 * j; const f32x4 gv = *(const f32x4*)(gff + k0);
#pragma unroll
                            for (int q = 0; q < 4; ++q) { const float hv = v[j][q] * gv[q]; const f32x4 wa = *(const f32x4*)(Wr + (size_t)(k0 + q) * 8), wb = *(const f32x4*)(Wr + (size_t)(k0 + q) * 8 + 4);
                                lg[0] += hv * wa.x; lg[1] += hv * wa.y; lg[2] += hv * wa.z; lg[3] += hv * wa.w; lg[4] += hv * wb.x; lg[5] += hv * wb.y; lg[6] += hv * wb.z; lg[7] += hv * wb.w; } }
#pragma unroll
                        for (int e = 0; e < 8; ++e) lg[e] = wave_sum(lg[e]) * rstd;
                        int e1 = 0; float l1 = lg[0];
#pragma unroll
                        for (int e = 1; e < 8; ++e) if (lg[e] > l1) { l1 = lg[e]; e1 = e; }
                        int e2 = -1; float l2 = -INFINITY;
#pragma unroll
                        for (int e = 0; e < 8; ++e) if (e != e1 && lg[e] > l2) { l2 = lg[e]; e2 = e; }
                        if (lane == 0) { const float g2 = 1.f / (1.f + __expf(l1 - l2)); const float g1 = 1.f - g2;
                            const int sl1 = atomicAdd((int*)&lcnt[e1], 1), sl2 = atomicAdd((int*)&lcnt[e2], 1);
                            lrow[i * 4 + 0] = e1; lrow[i * 4 + 1] = sl1; lrow[i * 4 + 2] = e2; lrow[i * 4 + 3] = sl2;
                            TOKG[row * 2 + 0] = g1; TOKG[row * 2 + 1] = g2; }
                    }
                }
            }
            if (moe) {
                __syncthreads();
                if (tid < 8) lbase[tid] = (int)__hip_atomic_fetch_add((unsigned*)(ctl + CW_MOECNT + 64 * jj + tid), (unsigned)lcnt[tid], RLX_AGENT);
                __syncthreads();
                if (tid < 72) { const int row = bx + G * tid; if (row < NTOK) { const int e1 = lrow[tid * 4 + 0], e2 = lrow[tid * 4 + 2];
                    TOKE[row * 2 + 0] = e1; TOKE[row * 2 + 1] = e2; TOKS[row * 2 + 0] = lbase[e1] + lrow[tid * 4 + 1]; TOKS[row * 2 + 1] = lbase[e2] + lrow[tid * 4 + 3]; } }
                __syncthreads();
            }
            SEAM(pb + 6);
        }
        if (!moe) {
            for (int rep_ = 0; rep_ < NREP(7); ++rep_) if (EN(7) && IN(pb + 7)) { PH_TID;
                pg8::StaticOrder S; S.init(MPAD, FF2, G, bx);
                if (layer == 2) { pg8::Gemm g{HB, (const bf16*)(ws + WS_WGU) + (size_t)jj * FF2 * DM, MPAD, FF2, DM / 2}; pg8::EpiSwiglu8 E{GB, FF, nullptr, 1.f / (W8_SCALE * H8_SCALE), G8_SCALE, RSQA};
                    pg8::gemm_phase<pg8::EpiSwiglu8, pg8::StaticOrder, true, true, true>(lds, g, S, E, tid); }
                else { pg8::Gemm g{HB, (const bf16*)(ws + WS_WGU) + (size_t)jj * FF2 * DM, MPAD, FF2, DM}; pg8::EpiSwiglu E{GB, FF, nullptr, 1.f, 0.f, RSQA};
                    pg8::gemm_phase<pg8::EpiSwiglu, pg8::StaticOrder, true, true>(lds, g, S, E, tid); }
                SEAM(pb + 7);
            }
            if (EN(8) && IN(pb + 8)) { PH_TID;
                pg8::StaticOrder S; S.init(NREAL, DM, G, bx);
                if (layer == 2) {
                    meta_gemm_res8((const unsigned char*)GB + (size_t)NREAL * FF, FF, (const unsigned char*)((const bf16*)(ws + WS_WD) + (size_t)jj * DM * FF), Hf + (size_t)NREAL * DM, 1.f / (W8_SCALE * G8_SCALE), lds, bx, wave, lane);
                    pg8::Gemm g{GB, (const bf16*)(ws + WS_WD) + (size_t)jj * DM * FF, NREAL, DM, FF / 2}; pg8::EpiResAdd E{Hf, DM, 1.f / (W8_SCALE * G8_SCALE)};
                    pg8::gemm_phase<pg8::EpiResAdd, pg8::StaticOrder, true, true, true>(lds, g, S, E, tid);
                } else {
                    meta_gemm_res(GB + (size_t)NREAL * FF, FF, (const bf16*)(ws + WS_WD) + (size_t)jj * DM * FF, Hf + (size_t)NREAL * DM, lds, bx, wave, lane);
                    pg8::Gemm g{GB, (const bf16*)(ws + WS_WD) + (size_t)jj * DM * FF, NREAL, DM, FF}; pg8::EpiResAdd E{Hf, DM, 1.f};
                    pg8::gemm_phase<pg8::EpiResAdd, pg8::StaticOrder, true, true>(lds, g, S, E, tid);
                }
                SEAM(pb + 8);
            }
        } else {
#define cnt ((const int*)(ctl + CW_MOECNT + 64 * jj))
            for (int rep_ = 0; rep_ < NREP(7); ++rep_) if (EN(7) && IN(pb + 7)) { PH_TID;
                int ts[8]; { int a = 0;
#pragma unroll
                    for (int e = 0; e < 8; ++e) { ts[e] = a; a += (__hip_atomic_load(cnt + e, RLX_AGENT) + 255) >> 8; } }
                { LAS const int* lbase = (LAS const int*)lds + 8; LAS const int* lrow = (LAS const int*)lds + 16;
                  for (int i = wave; i < 72; i += NWAVES) { const int row = bx + G * i;
                      if (row < NTOK) { const v4u d = *(const LAS v4u*)(lds + 4096 + i * 1024 + lane * 16);
#pragma unroll
                          for (int c = 0; c < 2; ++c) { const int e = lrow[i * 4 + 2 * c]; int tse = 0, lb = 0;
#pragma unroll
                              for (int x = 0; x < 8; ++x) { tse = (e == x) ? ts[x] : tse; lb = (e == x) ? lbase[x] : lb; }
                              const size_t p = (size_t)tse * 256 + lb + lrow[i * 4 + 2 * c + 1];
                              ((v4u*)((unsigned char*)AROWS + p * DM))[lane] = d; } } } }
                SEAM(pb + 7);
            }
            for (int rep_ = 0; rep_ < NREP(8); ++rep_) if (EN(8) && IN(pb + 8)) { PH_TID;
                pg8::Gemm g{AROWS, (const bf16*)(ws + WS_MWGU), MOEP, FF2, DM / 2}; pg8::MoeOrder S; S.init(cnt, FF2 / 256, G, bx);
                pg8::EpiSwiglu8 E{GB, FF, nullptr, 1.f / (W8_SCALE * A8_SCALE), G8_SCALE};
                pg8::gemm_phase<pg8::EpiSwiglu8, pg8::MoeOrder, true, true, true>(lds, g, S, E, tid);
                SEAM(pb + 8);
            }
            for (int rep_ = 0; rep_ < NREP(9); ++rep_) if (EN(9) && IN(pb + 9)) { PH_TID;
                pg8::Gemm g{GB, (const bf16*)(ws + WS_MWD), MOEP, DM, FF / 2}; pg8::MoeOrder S; S.init(cnt, DM / 256, G, bx);
                pg8::EpiBf16Rs E{YM, DM, nullptr, 1.f / (W8_SCALE * G8_SCALE)};
                pg8::gemm_phase<pg8::EpiBf16Rs, pg8::MoeOrder, true, true, true>(lds, g, S, E, tid);
                SEAM(pb + 9);
            }
            if (EN(10) && IN(pb + 10)) { PH_TID;
                int ts[8]; { int a = 0;
#pragma unroll
                    for (int e = 0; e < 8; ++e) { ts[e] = a; a += (__hip_atomic_load(cnt + e, RLX_AGENT) + 255) >> 8; } }
                int ie1, ie2, is1, is2; float ig1, ig2;
                v4u ny1[2], ny2[2]; f32x4 nha[2], nhb[2]; float ng1, ng2;
#define CB_IDX(rw) do { const int r_ = (rw) < NTOK ? (rw) : NTOK - 1; ie1 = TOKE[r_ * 2]; ie2 = TOKE[r_ * 2 + 1]; is1 = TOKS[r_ * 2]; is2 = TOKS[r_ * 2 + 1]; ig1 = TOKG[r_ * 2]; ig2 = TOKG[r_ * 2 + 1]; } while (0)
#define CB_DATA(rw) do { const int r_ = (rw) < NTOK ? (rw) : NTOK - 1; int t1 = 0, t2 = 0; \
                    _Pragma("unroll") for (int q = 0; q < 8; ++q) { t1 = (ie1 == q) ? ts[q] : t1; t2 = (ie2 == q) ? ts[q] : t2; } \
                    const size_t p1 = (size_t)t1 * 256 + is1, p2 = (size_t)t2 * 256 + is2; ng1 = ig1; ng2 = ig2; const float* hr_ = Hf + (size_t)r_ * DM; \
                    _Pragma("unroll") for (int j = 0; j < 2; ++j) { const int c8 = (lane + 64 * j) * 8; ny1[j] = *(const v4u*)(YM + p1 * DM + c8); ny2[j] = *(const v4u*)(YM + p2 * DM + c8); nha[j] = *(const f32x4*)(hr_ + c8); nhb[j] = *(const f32x4*)(hr_ + c8 + 4); } } while (0)
                CB_IDX(gw); CB_DATA(gw); CB_IDX(gw + NGW);
                for (int row = gw; row < NTOK; row += NGW) {
                    const float g1 = ng1, g2 = ng2; v4u cy1[2], cy2[2]; f32x4 cha[2], chb[2];
#pragma unroll
                    for (int j = 0; j < 2; ++j) { cy1[j] = ny1[j]; cy2[j] = ny2[j]; cha[j] = nha[j]; chb[j] = nhb[j]; }
                    CB_DATA(row + NGW); CB_IDX(row + 2 * NGW);
                    float* hr = Hf + (size_t)row * DM; f32x4 hv[2][2]; float ssq = 0.f;
#pragma unroll
                    for (int j = 0; j < 2; ++j) { const v4u y1 = cy1[j], y2 = cy2[j];
                        f32x4 ha = cha[j], hb2 = chb[j];
                        ha.x += g1 * __uint_as_float(y1.x << 16) + g2 * __uint_as_float(y2.x << 16); ha.y += g1 * __uint_as_float(y1.x & 0xffff0000u) + g2 * __uint_as_float(y2.x & 0xffff0000u);
                        ha.z += g1 * __uint_as_float(y1.y << 16) + g2 * __uint_as_float(y2.y << 16); ha.w += g1 * __uint_as_float(y1.y & 0xffff0000u) + g2 * __uint_as_float(y2.y & 0xffff0000u);
                        hb2.x += g1 * __uint_as_float(y1.z << 16) + g2 * __uint_as_float(y2.z << 16); hb2.y += g1 * __uint_as_float(y1.z & 0xffff0000u) + g2 * __uint_as_float(y2.z & 0xffff0000u);
                        hb2.z += g1 * __uint_as_float(y1.w << 16) + g2 * __uint_as_float(y2.w << 16); hb2.w += g1 * __uint_as_float(y1.w & 0xffff0000u) + g2 * __uint_as_float(y2.w & 0xffff0000u);
                        hv[j][0] = ha; hv[j][1] = hb2; ssq += (ha.x * ha.x + ha.y * ha.y) + (ha.z * ha.z + ha.w * ha.w) + (hb2.x * hb2.x + hb2.y * hb2.y) + (hb2.z * hb2.z + hb2.w * hb2.w); }
                    if (layer == DEPTH - 1) {
                        if (row < NREAL) { float* orow = (*(float* const*)(ka + 256)) + (size_t)row * DM;
#pragma unroll
                            for (int j = 0; j < 2; ++j) { const int c8 = (lane + 64 * j) * 8; *(f32x4*)(orow + c8) = hv[j][0]; *(f32x4*)(orow + c8 + 4) = hv[j][1]; } }
                    } else {
                        ssq = wave_sum(ssq); const float rstd = 1.f / sqrtf(ssq * (1.f / DM) + 1e-6f), sn = rstd * A8_SCALE;
#pragma unroll
                        for (int j = 0; j < 2; ++j) { const int c8 = (lane + 64 * j) * 8; *(f32x4*)(hr + c8) = hv[j][0]; *(f32x4*)(hr + c8 + 4) = hv[j][1];
                            if ((INP8 >> (layer + 1)) & 1) { const unsigned lo = pk4_fp8(hv[j][0].x * sn, hv[j][0].y * sn, hv[j][0].z * sn, hv[j][0].w * sn), hi8 = pk4_fp8(hv[j][1].x * sn, hv[j][1].y * sn, hv[j][1].z * sn, hv[j][1].w * sn);
                                *(unsigned long long*)((unsigned char*)HB + (size_t)row * DM + c8) = (unsigned long long)lo | ((unsigned long long)hi8 << 32); }
                            else { v4u w; w.x = pk2(hv[j][0].x, hv[j][0].y); w.y = pk2(hv[j][0].z, hv[j][0].w); w.z = pk2(hv[j][1].x, hv[j][1].y); w.w = pk2(hv[j][1].z, hv[j][1].w);
                                *(v4u*)(HB + (size_t)row * DM + c8) = w; } }
                        if (lane == 0) RSTD[row] = rstd;
                    }
                }
#undef CB_IDX
#undef CB_DATA
                SEAM(pb + 10);
            }
        }
    }
#ifdef UBENCH
    if (hi >= 48 && bx == 255) { PH_TID;
        float x = (float)lane * 1e-3f, y = 1.0001f; float acc = 0.f;
        for (int it = 0; it < UBENCH_ITERS; ++it) {
#if UBENCH == 1
#pragma unroll
            for (int k = 0; k < 64; ++k) { asm volatile("v_fma_f32 %0, %0, %1, %0" : "+v"(x) : "v"(y)); }
#elif UBENCH == 2
#pragma unroll
            for (int k = 0; k < 64; ++k) { asm volatile("s_nop 1\n\tv_add_f32_dpp %0, %0, %0 row_mirror row_mask:0xf bank_mask:0xf bound_ctrl:1" : "+v"(x)); }
#elif UBENCH == 3
#pragma unroll
            for (int k = 0; k < 32; ++k) { asm volatile("s_nop 0\n\tv_readlane_b32 s20, %0, 63\n\tv_fmac_f32 %0, s20, %1" : "+v"(x) : "v"(y) : "s20"); }
#elif UBENCH == 5
            { float y2 = x + 1.f;
#pragma unroll
            for (int k = 0; k < 64; ++k) { asm volatile("s_nop 1\n\tv_add_f32_dpp %0, %0, %0 row_mirror row_mask:0xf bank_mask:0xf bound_ctrl:1\n\tv_add_f32_dpp %1, %1, %1 row_mirror row_mask:0xf bank_mask:0xf bound_ctrl:1" : "+v"(x), "+v"(y2)); }
            x += y2; }
#elif UBENCH == 6
            if (wave < 4) {
#pragma unroll
            for (int k = 0; k < 64; ++k) { asm volatile("s_nop 1\n\tv_add_f32_dpp %0, %0, %0 row_mirror row_mask:0xf bank_mask:0xf bound_ctrl:1" : "+v"(x)); } }
#elif UBENCH == 7
            if (wave < 4) {
#pragma unroll
            for (int k = 0; k < 64; ++k) { asm volatile("v_fma_f32 %0, %0, %1, %0" : "+v"(x) : "v"(y)); } }
#elif UBENCH == 8
            { float y2 = x + 1.f, y3 = x + 2.f, y4 = x + 3.f;
#pragma unroll
            for (int k = 0; k < 64; ++k) { asm volatile("s_nop 1\n\tv_add_f32_dpp %0, %0, %0 row_mirror row_mask:0xf bank_mask:0xf bound_ctrl:1\n\tv_add_f32_dpp %1, %1, %1 row_mirror row_mask:0xf bank_mask:0xf bound_ctrl:1\n\tv_add_f32_dpp %2, %2, %2 row_mirror row_mask:0xf bank_mask:0xf bound_ctrl:1\n\tv_add_f32_dpp %3, %3, %3 row_mirror row_mask:0xf bank_mask:0xf bound_ctrl:1" : "+v"(x), "+v"(y2), "+v"(y3), "+v"(y4)); }
            x += y2 + y3 + y4; }
#elif UBENCH == 4
#pragma unroll
            for (int k = 0; k < 64; ++k) { asm volatile("s_nop 1\n\tv_add_f32_dpp %0, %0, %0 row_bcast:15 row_mask:0xa bank_mask:0xf" : "+v"(x)); }
#endif
        }
        acc += x;
        if (acc == 123.456f) ((float*)(ws + WS_CTL))[2000 + tid] = acc;
    }
#endif
#undef IN
#undef SEAM
}

#ifndef MK_ONE_LAUNCH
#define MK_ONE_LAUNCH 1
#endif
extern "C" void kernel_launch(void* const* d_in, const int* in_sizes, int n_in, void* d_out, int out_size, void* d_ws, size_t ws_size, hipStream_t stream) {
    static int grid = 0;
    if (grid == 0) {
        if (n_in != 32 || out_size != NREAL * DM || ws_size < WS_END) { fprintf(stderr, "kernel_launch: unexpected shapes (n_in %d out %d ws %zu need %zu); nothing launched\n", n_in, out_size, ws_size, (size_t)WS_END); grid = -1; return; }
        int dev = 0, cus = 0, per_cu = 0;
        if (hipGetDevice(&dev) != hipSuccess || hipDeviceGetAttribute(&cus, hipDeviceAttributeMultiprocessorCount, dev) != hipSuccess) { grid = -1; return; }
        if (hipFuncSetAttribute((const void*)hymba_fwd, hipFuncAttributeMaxDynamicSharedMemorySize, LDS_BYTES) != hipSuccess) { fprintf(stderr, "kernel_launch: hipFuncSetAttribute failed\n"); grid = -1; return; }
        if (hipOccupancyMaxActiveBlocksPerMultiprocessor(&per_cu, (const void*)hymba_fwd, NWAVES * 64, LDS_BYTES) != hipSuccess || per_cu < 1) fprintf(stderr, "kernel_launch: occupancy query says %d\n", per_cu);
        (void)hipGetLastError();
        grid = cus;
        if (grid != 256) { fprintf(stderr, "kernel_launch: built for 256 CUs, device has %d; nothing launched\n", cus); grid = -1; return; }
    }
    if (grid < 0) return;
    if (hipMemsetAsync((char*)d_ws + WS_CTL, 0, CTL_ZERO_BYTES, stream) != hipSuccess) return;
    Args a{};
    for (int i = 0; i < 32; ++i) a.in[i] = (const float*)d_in[i];
    a.out = (float*)d_out; a.ws = (unsigned char*)d_ws;
#if MK_ONE_LAUNCH
    a.ph_lo = 0; a.ph_hi = 48;
    hipLaunchKernelGGL(hymba_fwd, dim3(grid), dim3(NWAVES * 64), LDS_BYTES, stream, a);
#else
    for (int ph = 0; ph < 50; ++ph) {
        if (ph >= 1 && ph <= 48) { const int l = (ph - 1) / 12, k = (ph - 1) % 12; const bool moe = l & 1; if (k == 11 || (!moe && k >= 9)) continue; }
        a.ph_lo = ph; a.ph_hi = ph + 1;
        hipLaunchKernelGGL(hymba_fwd, dim3(grid), dim3(NWAVES * 64), LDS_BYTES, stream, a);
    }
#endif
}
```

```cpp
#include <hip/hip_runtime.h>
#include <hip/hip_bf16.h>
#include <cmath>
#include <cstdio>
#include <cstdint>
namespace pg8 {
#define PG8_LAS __attribute__((address_space(3)))
typedef unsigned short bf16_t;
typedef short bf16x8 __attribute__((ext_vector_type(8)));
typedef float f32x4 __attribute__((ext_vector_type(4)));
typedef float f32x2 __attribute__((ext_vector_type(2)));
typedef unsigned u32x4 __attribute__((ext_vector_type(4)));
constexpr int BM = 256, BK = 64, HALF = 128, HTB = HALF * BK * 2  , STAGE_BYTES = 8 * HTB, NXCD = 8, WGM = 8;

__host__ __device__ __forceinline__ int lds_byte(int r, int c) { const int st = (r >> 4) * 2 + (c >> 5), rr = r & 15, cc = c & 31, ob = rr * 64 + cc * 2; return st * 1024 + (ob ^ (((ob >> 9) & 1) << 5)); }
__host__ __device__ __forceinline__ void stage_rc(int b, int& R, int& C) { const int st = b / 1024, sb = b % 1024, swz = sb ^ (((sb >> 9) & 1) << 5); R = (st >> 1) * 16 + swz / 64; C = (st & 1) * 32 + (swz % 64) / 2; }
__host__ __device__ __forceinline__ int perm32(int rho) { const int n = rho >> 4, i = rho & 15; return 8 * (i >> 2) + 4 * n + (i & 3); }

struct Unit { int pm, pn, pc; };
struct Gemm { const bf16_t* A; const bf16_t* Bt; int M, N, K; };

struct StaticOrder {
    int nM, nN, nwg, G, c;
    __host__ __device__ void init(int M, int N, int G_, int c_) { nM = M / BM; nN = N / BM; nwg = nM * nN; G = G_; c = c_; }
    __host__ __device__ bool next(int i, Unit& u) const {
        const long L = (long)i * G + c; if (L >= nwg) return false;
        int wgid = (int)L; { const int q = nwg / NXCD, r = nwg % NXCD, xcd = wgid % NXCD, off = wgid / NXCD; wgid = (xcd < r ? xcd * (q + 1) : r * (q + 1) + (xcd - r) * q) + off; }
        const int nig = WGM * nN, gid = wgid / nig, fm = gid * WGM, gsz = (nM - fm) < WGM ? (nM - fm) : WGM;
        u.pm = fm + ((wgid % nig) % gsz); u.pn = (wgid % nig) / gsz; u.pc = u.pn; return true;
    }
    __device__ __forceinline__ void a_ready(const Unit&) const {}
    __device__ __forceinline__ void done(const Unit&) const {}
};
struct MoeOrder {
    int G, c, nN, total; int t1, t2, t3, t4, t5, t6, t7;
    __device__ __forceinline__ void init(const int* cnt, int nN_, int G_, int c_) {
        G = G_; c = c_; nN = nN_; int a = 0;
        a += (__builtin_amdgcn_readfirstlane(__hip_atomic_load(cnt + 0, __ATOMIC_RELAXED, __HIP_MEMORY_SCOPE_AGENT)) + 255) >> 8; t1 = a;
        a += (__builtin_amdgcn_readfirstlane(__hip_atomic_load(cnt + 1, __ATOMIC_RELAXED, __HIP_MEMORY_SCOPE_AGENT)) + 255) >> 8; t2 = a;
        a += (__builtin_amdgcn_readfirstlane(__hip_atomic_load(cnt + 2, __ATOMIC_RELAXED, __HIP_MEMORY_SCOPE_AGENT)) + 255) >> 8; t3 = a;
        a += (__builtin_amdgcn_readfirstlane(__hip_atomic_load(cnt + 3, __ATOMIC_RELAXED, __HIP_MEMORY_SCOPE_AGENT)) + 255) >> 8; t4 = a;
        a += (__builtin_amdgcn_readfirstlane(__hip_atomic_load(cnt + 4, __ATOMIC_RELAXED, __HIP_MEMORY_SCOPE_AGENT)) + 255) >> 8; t5 = a;
        a += (__builtin_amdgcn_readfirstlane(__hip_atomic_load(cnt + 5, __ATOMIC_RELAXED, __HIP_MEMORY_SCOPE_AGENT)) + 255) >> 8; t6 = a;
        a += (__builtin_amdgcn_readfirstlane(__hip_atomic_load(cnt + 6, __ATOMIC_RELAXED, __HIP_MEMORY_SCOPE_AGENT)) + 255) >> 8; t7 = a;
        a += (__builtin_amdgcn_readfirstlane(__hip_atomic_load(cnt + 7, __ATOMIC_RELAXED, __HIP_MEMORY_SCOPE_AGENT)) + 255) >> 8;
        total = a * nN;
    }
    __device__ __forceinline__ bool next(int i, Unit& u) const {
        const int x = c & 7, per = G >> 3; const int e_ = i * per + (c >> 3);
        const int ntile = total / nN; const int mine = (ntile - x + 7) >> 3;
        if (e_ >= mine * nN) return false;
        const int rt = x + 8 * (e_ / nN), j = e_ % nN;
        const int e = (rt >= t1) + (rt >= t2) + (rt >= t3) + (rt >= t4) + (rt >= t5) + (rt >= t6) + (rt >= t7);
        u.pm = rt; u.pn = e * nN + j; u.pc = j; return true;
    }
    __device__ __forceinline__ void a_ready(const Unit&) const {}
    __device__ __forceinline__ void done(const Unit&) const {}
};

__device__ __forceinline__ unsigned cvt_pk_bf16(float lo, float hi) { unsigned r; asm volatile("v_cvt_pk_bf16_f32 %0, %1, %2" : "=v"(r) : "v"(lo), "v"(hi)); return r; }

#define PG8_GAS __attribute__((address_space(1)))
struct EpiBf16Rs {
    static constexpr bool PERM = true, AFTER_DRAIN = false;
    bf16_t* O; int ldc; const float* rs; float sc;
    __device__ __forceinline__ void operator()(const f32x4 (&acc)[2][2][4][2], const Unit& u, int wr, int wc, int fr, int fq) const {
        const int row0 = u.pm * BM + wr * 64 + fr; const int col0 = u.pc * BM + wc * 32 + 8 * fq;
        float sv[2][4];
#pragma unroll
        for (int ai = 0; ai < 2; ++ai)
#pragma unroll
            for (int m = 0; m < 4; ++m) sv[ai][m] = rs ? ((const PG8_GAS float*)rs)[row0 + ai * HALF + m * 16] : sc;
#pragma unroll
        for (int ai = 0; ai < 2; ++ai)
#pragma unroll
            for (int m = 0; m < 4; ++m) { const int row = row0 + ai * HALF + m * 16; const float s = sv[ai][m]; PG8_GAS bf16_t* rowp = (PG8_GAS bf16_t*)O + (size_t)row * ldc + col0;
#pragma unroll
                for (int bj = 0; bj < 2; ++bj) { const f32x4 v0 = acc[ai][bj][m][0] * s, v1 = acc[ai][bj][m][1] * s;
                    u32x4 w; w.x = cvt_pk_bf16(v0[0], v0[1]); w.y = cvt_pk_bf16(v0[2], v0[3]); w.z = cvt_pk_bf16(v1[0], v1[1]); w.w = cvt_pk_bf16(v1[2], v1[3]);
                    *(PG8_GAS u32x4*)(rowp + bj * HALF) = w; } }
    }
};
struct EpiResAdd {
    static constexpr bool PERM = false, AFTER_DRAIN = false;
    float* H; int ldc; float sc;
    __device__ __forceinline__ void operator()(const f32x4 (&acc)[2][2][4][2], const Unit& u, int wr, int wc, int fr, int fq) const {
        const int row0 = u.pm * BM + wr * 64 + fr; const int col0 = u.pc * BM + wc * 32 + 4 * fq;
#pragma unroll
        for (int ai = 0; ai < 2; ++ai)
#pragma unroll
            for (int mp = 0; mp < 2; ++mp) {
                f32x4 res[2][2][2];
#pragma unroll
                for (int m2 = 0; m2 < 2; ++m2) { const PG8_GAS float* rowp = (const PG8_GAS float*)H + (size_t)(row0 + ai * HALF + (2 * mp + m2) * 16) * ldc + col0;
#pragma unroll
                    for (int bj = 0; bj < 2; ++bj)
#pragma unroll
                        for (int n = 0; n < 2; ++n) res[m2][bj][n] = *(const PG8_GAS f32x4*)(rowp + bj * HALF + n * 16); }
#pragma unroll
                for (int m2 = 0; m2 < 2; ++m2) { PG8_GAS float* rowp = (PG8_GAS float*)H + (size_t)(row0 + ai * HALF + (2 * mp + m2) * 16) * ldc + col0;
#pragma unroll
                    for (int bj = 0; bj < 2; ++bj)
#pragma unroll
                        for (int n = 0; n < 2; ++n) *(PG8_GAS f32x4*)(rowp + bj * HALF + n * 16) = res[m2][bj][n] + acc[ai][bj][2 * mp + m2][n] * sc; }
                asm volatile("" ::: "memory");
            }
    }
};
template <int MODE, long long HB_OFF, long long RSQ_OFF> struct EpiResAddHB {
    static constexpr bool PERM = true, AFTER_DRAIN = false; static constexpr float hs = 4.f;
    float* H; int ldc; float sc;
    __device__ __forceinline__ void operator()(const f32x4 (&acc)[2][2][4][2], const Unit& u, int wr, int wc, int fr, int fq) const {
        const int row0 = u.pm * BM + wr * 64 + fr; const int col0 = u.pc * BM + wc * 32 + 8 * fq;
        PG8_GAS unsigned char* const HBo = (PG8_GAS unsigned char*)H + HB_OFF; PG8_GAS unsigned long long* const rsq = (PG8_GAS unsigned long long*)((PG8_GAS unsigned char*)H + RSQ_OFF);
        f32x4 nr_[2][2];
#define PG8_RLOAD(g_) do { PG8_GAS float* p_ = (PG8_GAS float*)H + (size_t)(row0 + ((g_) >> 2) * HALF + ((g_) & 3) * 16) * ldc + col0; \
            _Pragma("unroll") for (int bj = 0; bj < 2; ++bj) _Pragma("unroll") for (int n = 0; n < 2; ++n) nr_[bj][n] = *(const PG8_GAS f32x4*)(p_ + bj * HALF + n * 4); } while (0)
        PG8_RLOAD(0);
#pragma unroll
        for (int g8 = 0; g8 < 8; ++g8) { const int ai = g8 >> 2, m = g8 & 3; const int row = row0 + ai * HALF + m * 16; PG8_GAS float* rowp = (PG8_GAS float*)H + (size_t)row * ldc + col0;
                f32x4 r_[2][2];
#pragma unroll
                for (int bj = 0; bj < 2; ++bj)
#pragma unroll
                    for (int n = 0; n < 2; ++n) r_[bj][n] = nr_[bj][n];
                if (g8 < 7) PG8_RLOAD(g8 + 1);
                float ss = 0.f;
#pragma unroll
                for (int bj = 0; bj < 2; ++bj) { const f32x4 v0 = r_[bj][0] + acc[ai][bj][m][0] * sc, v1 = r_[bj][1] + acc[ai][bj][m][1] * sc;
                    *(PG8_GAS f32x4*)(rowp + bj * HALF) = v0; *(PG8_GAS f32x4*)(rowp + bj * HALF + 4) = v1;
                    ss += ((v0[0] * v0[0] + v0[1] * v0[1]) + (v0[2] * v0[2] + v0[3] * v0[3])) + ((v1[0] * v1[0] + v1[1] * v1[1]) + (v1[2] * v1[2] + v1[3] * v1[3]));
                    if constexpr (MODE == 1) { u32x4 w; w.x = cvt_pk_bf16(v0[0], v0[1]); w.y = cvt_pk_bf16(v0[2], v0[3]); w.z = cvt_pk_bf16(v1[0], v1[1]); w.w = cvt_pk_bf16(v1[2], v1[3]);
                        *(PG8_GAS u32x4*)((PG8_GAS bf16_t*)HBo + (size_t)row * ldc + col0 + bj * HALF) = w; }
                    else {
#define PG8_C8(x) __builtin_amdgcn_fmed3f((x) * hs, -448.f, 448.f)
                        unsigned lo = (unsigned)__builtin_amdgcn_cvt_pk_fp8_f32(PG8_C8(v0[0]), PG8_C8(v0[1]), 0, false); lo = (unsigned)__builtin_amdgcn_cvt_pk_fp8_f32(PG8_C8(v0[2]), PG8_C8(v0[3]), (int)lo, true);
                        unsigned hi = (unsigned)__builtin_amdgcn_cvt_pk_fp8_f32(PG8_C8(v1[0]), PG8_C8(v1[1]), 0, false); hi = (unsigned)__builtin_amdgcn_cvt_pk_fp8_f32(PG8_C8(v1[2]), PG8_C8(v1[3]), (int)hi, true);
#undef PG8_C8
                        *(PG8_GAS unsigned long long*)(HBo + (size_t)row * ldc + col0 + bj * HALF) = (unsigned long long)lo | ((unsigned long long)hi << 32); } }
                { auto p_ = __builtin_amdgcn_permlane16_swap(__float_as_uint(ss), __float_as_uint(ss), false, false); ss = __uint_as_float(p_[0]) + __uint_as_float(p_[1]); }
                { auto p_ = __builtin_amdgcn_permlane32_swap(__float_as_uint(ss), __float_as_uint(ss), false, false); ss = __uint_as_float(p_[0]) + __uint_as_float(p_[1]); }
                if (fq == 0) __hip_atomic_fetch_add(rsq + row, (unsigned long long)(ss * 16777216.f), __ATOMIC_RELAXED, __HIP_MEMORY_SCOPE_AGENT);
                asm volatile("" ::: "memory"); }
#undef PG8_RLOAD
    }
};
template <bool OUT8> struct EpiSwigluT {
    static constexpr bool PERM = true, AFTER_DRAIN = false;
    bf16_t* O; int ldc; const float* rs; float sc; float o8; const unsigned long long* rsq;
    __device__ __forceinline__ void operator()(const f32x4 (&acc)[2][2][4][2], const Unit& u, int wr, int wc, int fr, int fq) const {
        const int row0 = u.pm * BM + wr * 64 + fr; const int col0 = u.pc * HALF + wc * 32 + 8 * fq;
        float sv[2][4];
#pragma unroll
        for (int ai = 0; ai < 2; ++ai)
#pragma unroll
            for (int m = 0; m < 4; ++m) sv[ai][m] = rsq ? sc * __builtin_amdgcn_rsqf((float)((const PG8_GAS unsigned long long*)rsq)[row0 + ai * HALF + m * 16] * (1.f / (16777216.f * 1024.f)) + 1e-6f) : (rs ? ((const PG8_GAS float*)rs)[row0 + ai * HALF + m * 16] : sc);
#pragma unroll
        for (int ai = 0; ai < 2; ++ai)
#pragma unroll
            for (int m = 0; m < 4; ++m) { const int row = row0 + ai * HALF + m * 16; const float s = sv[ai][m]; PG8_GAS bf16_t* rowp = (PG8_GAS bf16_t*)O + (size_t)row * ldc + col0;
                const float c1 = -1.4426950408889634f * s, c2 = OUT8 ? s * s * o8 : s * s;
                f32x2 q[4];
#pragma unroll
                for (int n = 0; n < 2; ++n)
#pragma unroll
                    for (int h = 0; h < 2; ++h) { const f32x4 av = acc[ai][0][m][n], bv = acc[ai][1][m][n];
                        const f32x2 a = h ? (f32x2){av[2], av[3]} : (f32x2){av[0], av[1]}, b = h ? (f32x2){bv[2], bv[3]} : (f32x2){bv[0], bv[1]};
                        const f32x2 t = a * c1; f32x2 e; e.x = __builtin_amdgcn_exp2f(t.x); e.y = __builtin_amdgcn_exp2f(t.y);
                        const f32x2 d = e + 1.f; f32x2 r; r.x = __builtin_amdgcn_rcpf(d.x); r.y = __builtin_amdgcn_rcpf(d.y);
                        q[2 * n + h] = ((a * b) * r) * c2; }
                if constexpr (OUT8) { PG8_GAS unsigned char* rp8 = (PG8_GAS unsigned char*)O + (size_t)row * ldc + col0;
#define PG8_C8(x) __builtin_amdgcn_fmed3f((x), -448.f, 448.f)
                    unsigned lo = (unsigned)__builtin_amdgcn_cvt_pk_fp8_f32(PG8_C8(q[0].x), PG8_C8(q[0].y), 0, false); lo = (unsigned)__builtin_amdgcn_cvt_pk_fp8_f32(PG8_C8(q[1].x), PG8_C8(q[1].y), (int)lo, true);
                    unsigned hi = (unsigned)__builtin_amdgcn_cvt_pk_fp8_f32(PG8_C8(q[2].x), PG8_C8(q[2].y), 0, false); hi = (unsigned)__builtin_amdgcn_cvt_pk_fp8_f32(PG8_C8(q[3].x), PG8_C8(q[3].y), (int)hi, true);
#undef PG8_C8
                    *(PG8_GAS unsigned long long*)rp8 = (unsigned long long)lo | ((unsigned long long)hi << 32); }
                else { u32x4 w; w.x = cvt_pk_bf16(q[0].x, q[0].y); w.y = cvt_pk_bf16(q[1].x, q[1].y); w.z = cvt_pk_bf16(q[2].x, q[2].y); w.w = cvt_pk_bf16(q[3].x, q[3].y);
                    *(PG8_GAS u32x4*)rowp = w; } }
    }
};
typedef EpiSwigluT<false> EpiSwiglu; typedef EpiSwigluT<true> EpiSwiglu8;

template <class Epi, class Sched, bool ALIGN_EPI = false, bool SP2 = false, bool FP8 = false>
__device__ __forceinline__ void gemm_phase(PG8_LAS unsigned char* lds, const Gemm g, const Sched& S, const Epi& E, int tid_in) {
    int tid_ = tid_in; asm volatile("" : "+v"(tid_));
    const int tid = tid_, wid = __builtin_amdgcn_readfirstlane(tid >> 6), lane = tid & 63, wr = wid >> 2, wc = wid & 3, fr = lane & 15, fq = lane >> 4;
    const int K = g.K, nt = K / BK;
    unsigned voffA[2], voffB[2];
#pragma unroll
    for (int i = 0; i < 2; ++i) { int R, C; stage_rc(tid * 16 + i * 8192, R, C); const int Rb = Epi::PERM ? ((R & ~31) + perm32(R & 31)) : R;
        voffA[i] = (unsigned)(R * K + C) * 2u; voffB[i] = (unsigned)(Rb * K + C) * 2u; }
    const size_t kstep = (size_t)(BK * 2);
    const size_t hstep = (size_t)HALF * K * 2;
    const size_t tstep = 2 * hstep;
    const unsigned ldsw = (unsigned)wid * 1024u;
    const int aoff = lds_byte(wr * 64 + fr, fq * 8), boff = lds_byte(wc * 32 + fr, fq * 8);
#define PG8_SA(b, h) (((b) * 2 + (h)) * HTB)
#define PG8_SB(b, h) ((4 + (b) * 2 + (h)) * HTB)
#define PG8_STAGE(bufoff, gbase, voff) do { _Pragma("unroll") for (int _i = 0; _i < 2; ++_i) \
        __builtin_amdgcn_global_load_lds((const unsigned*)((const char*)(gbase) + (voff)[_i]), (PG8_LAS unsigned*)(lds + (bufoff) + ldsw + _i * 8192), 16, 0, 0); } while (0)
#define PG8_LDA(dst, b, h) do { _Pragma("unroll") for (int m = 0; m < 4; ++m) _Pragma("unroll") for (int k = 0; k < 2; ++k) dst[m][k] = *(const PG8_LAS bf16x8*)(lds + PG8_SA(b, h) + aoff + m * 2048 + k * 1024); } while (0)
#define PG8_LDB(dst, b, h) do { _Pragma("unroll") for (int n = 0; n < 2; ++n) _Pragma("unroll") for (int k = 0; k < 2; ++k) dst[n][k] = *(const PG8_LAS bf16x8*)(lds + PG8_SB(b, h) + boff + n * 2048 + k * 1024); } while (0)
#define PG8_MMA(ai, bj, At, Bt) do { __builtin_amdgcn_s_setprio(1); \
        if constexpr (FP8) { typedef int v8i_ __attribute__((ext_vector_type(8))); typedef int v4i_ __attribute__((ext_vector_type(4))); const int sc8_ = 0x7f7f7f7f;     \
            _Pragma("unroll") for (int m = 0; m < 4; ++m) _Pragma("unroll") for (int n = 0; n < 2; ++n) { \
                const v4i_ b0_ = __builtin_bit_cast(v4i_, Bt[n][0]), b1_ = __builtin_bit_cast(v4i_, Bt[n][1]), a0_ = __builtin_bit_cast(v4i_, At[m][0]), a1_ = __builtin_bit_cast(v4i_, At[m][1]); \
                const v8i_ bb_ = (v8i_){b0_.x, b0_.y, b0_.z, b0_.w, b1_.x, b1_.y, b1_.z, b1_.w}, aa_ = (v8i_){a0_.x, a0_.y, a0_.z, a0_.w, a1_.x, a1_.y, a1_.z, a1_.w}; \
                asm volatile("v_mfma_scale_f32_16x16x128_f8f6f4 %0, %1, %2, %0, %3, %3 op_sel_hi:[0,0,0]" : "+v"(acc[ai][bj][m][n]) : "v"(bb_), "v"(aa_), "v"(sc8_)); } \
        } else { _Pragma("unroll") for (int m = 0; m < 4; ++m) _Pragma("unroll") for (int n = 0; n < 2; ++n) _Pragma("unroll") for (int k = 0; k < 2; ++k) \
            acc[ai][bj][m][n] = __builtin_amdgcn_mfma_f32_16x16x32_bf16(Bt[n][k], At[m][k], acc[ai][bj][m][n], 0, 0, 0); } \
        __builtin_amdgcn_s_setprio(0); } while (0)
#define PG8_WAIT_V(n) asm volatile("s_waitcnt vmcnt(" #n ")" ::: "memory")
#define PG8_WAIT_L(n) asm volatile("s_waitcnt lgkmcnt(" #n ")" ::: "memory")
#define PG8_BAR __builtin_amdgcn_s_barrier()
#define PG8_SCHED __builtin_amdgcn_sched_barrier(0)
    Unit cur, nxt; int ui = 0;
    if (!S.next(0, cur)) return;
    f32x4 acc[2][2][4][2];
    { float zf; asm volatile("v_mov_b32 %0, 0" : "=v"(zf));
#pragma unroll
    for (int a = 0; a < 2; ++a)
#pragma unroll
        for (int b = 0; b < 2; ++b)
#pragma unroll
            for (int m = 0; m < 4; ++m)
#pragma unroll
                for (int n = 0; n < 2; ++n) acc[a][b][m][n] = (f32x4){zf, zf, zf, zf}; }
    bf16x8 At[4][2], B0[2][2], B1[2][2];
    const char* cA = (const char*)g.A + (size_t)cur.pm * tstep; const char* cB = (const char*)g.Bt + (size_t)cur.pn * tstep;
    S.a_ready(cur);
    if constexpr (SP2) {
        PG8_STAGE(PG8_SB(0, 0), cB, voffB); PG8_STAGE(PG8_SB(0, 1), cB + hstep, voffB); PG8_STAGE(PG8_SA(0, 0), cA, voffA); PG8_STAGE(PG8_SA(0, 1), cA + hstep, voffA);
        if (wr == 1) PG8_BAR;
        PG8_WAIT_V(2); PG8_BAR;
        PG8_STAGE(PG8_SB(1, 0), cB + kstep, voffB); PG8_STAGE(PG8_SA(1, 0), cA + kstep, voffA); PG8_STAGE(PG8_SB(1, 1), cB + hstep + kstep, voffB);
        PG8_WAIT_V(6); PG8_BAR;
    } else {
        PG8_STAGE(PG8_SB(0, 0), cB, voffB); PG8_STAGE(PG8_SA(0, 0), cA, voffA); PG8_STAGE(PG8_SB(0, 1), cB + hstep, voffB); PG8_STAGE(PG8_SA(0, 1), cA + hstep, voffA);
        if (wr == 1) PG8_BAR;
        PG8_WAIT_V(4); PG8_BAR;
        PG8_STAGE(PG8_SB(1, 0), cB + kstep, voffB); PG8_STAGE(PG8_SA(1, 0), cA + kstep, voffA); PG8_STAGE(PG8_SB(1, 1), cB + hstep + kstep, voffB);
        PG8_WAIT_V(6); PG8_BAR;
    }
    for (;;) {
        const bool has_next = S.next(ui + 1, nxt);
        const char* nA = has_next ? (const char*)g.A + (size_t)nxt.pm * tstep : cA; const char* nB = has_next ? (const char*)g.Bt + (size_t)nxt.pn * tstep : cB;
        for (int t = 0; t < nt; t += 2) {
            const bool last = (t == nt - 2);
            const char* a1 = cA + (size_t)(t + 1) * kstep;
            const char* a2 = last ? nA : cA + (size_t)(t + 2) * kstep; const char* b2 = last ? nB : cB + (size_t)(t + 2) * kstep;
            const char* a3 = a2 + kstep; const char* b3 = b2 + kstep;
            if (last && has_next) S.a_ready(nxt);
            if constexpr (SP2) {
            PG8_LDB(B0, 0, 0); PG8_LDB(B1, 0, 1); PG8_SCHED; PG8_LDA(At, 0, 0); PG8_STAGE(PG8_SA(1, 1), a1 + hstep, voffA);
            PG8_WAIT_V(8); PG8_WAIT_L(0); PG8_BAR; PG8_MMA(0, 0, At, B0); PG8_MMA(0, 1, At, B1); PG8_BAR; PG8_SCHED;
            PG8_LDA(At, 0, 1); PG8_STAGE(PG8_SB(0, 0), b2, voffB); PG8_STAGE(PG8_SB(0, 1), b2 + hstep, voffB); PG8_STAGE(PG8_SA(0, 0), a2, voffA);
            PG8_WAIT_V(8); PG8_WAIT_L(0); PG8_BAR; PG8_MMA(1, 0, At, B0); PG8_MMA(1, 1, At, B1); PG8_BAR; PG8_SCHED;
            PG8_LDB(B0, 1, 0); PG8_LDB(B1, 1, 1); PG8_SCHED; PG8_LDA(At, 1, 0); PG8_STAGE(PG8_SA(0, 1), a2 + hstep, voffA);
            PG8_WAIT_V(8); PG8_WAIT_L(0); PG8_BAR; PG8_MMA(0, 0, At, B0); PG8_MMA(0, 1, At, B1); PG8_BAR; PG8_SCHED;
            PG8_LDA(At, 1, 1); PG8_STAGE(PG8_SB(1, 0), b3, voffB); PG8_STAGE(PG8_SB(1, 1), b3 + hstep, voffB); PG8_STAGE(PG8_SA(1, 0), a3, voffA);
            PG8_WAIT_V(8); PG8_WAIT_L(0); PG8_BAR; PG8_MMA(1, 0, At, B0); PG8_MMA(1, 1, At, B1); PG8_BAR; PG8_SCHED;
            } else {
            PG8_LDB(B0, 0, 0); PG8_SCHED; PG8_LDA(At, 0, 0); PG8_STAGE(PG8_SA(1, 1), a1 + hstep, voffA);
            PG8_WAIT_L(8); PG8_BAR; PG8_WAIT_L(0); PG8_MMA(0, 0, At, B0); PG8_BAR; PG8_SCHED;
            PG8_LDB(B1, 0, 1); PG8_STAGE(PG8_SB(0, 0), b2, voffB);
            PG8_BAR; PG8_WAIT_L(0); PG8_MMA(0, 1, At, B1); PG8_BAR;
            PG8_LDA(At, 0, 1); PG8_STAGE(PG8_SA(0, 0), a2, voffA);
            PG8_BAR; PG8_WAIT_L(0); PG8_MMA(1, 0, At, B0); PG8_BAR; PG8_SCHED;
            PG8_STAGE(PG8_SB(0, 1), b2 + hstep, voffB);
            PG8_WAIT_V(6); PG8_BAR; PG8_MMA(1, 1, At, B1); PG8_BAR;
            PG8_LDB(B0, 1, 0); PG8_SCHED; PG8_LDA(At, 1, 0); PG8_STAGE(PG8_SA(0, 1), a2 + hstep, voffA);
            PG8_WAIT_L(8); PG8_BAR; PG8_WAIT_L(0); PG8_MMA(0, 0, At, B0); PG8_BAR; PG8_SCHED;
            PG8_LDB(B1, 1, 1); PG8_STAGE(PG8_SB(1, 0), b3, voffB);
            PG8_BAR; PG8_WAIT_L(0); PG8_MMA(0, 1, At, B1); PG8_BAR;
            PG8_LDA(At, 1, 1); PG8_STAGE(PG8_SA(1, 0), a3, voffA);
            PG8_BAR; PG8_WAIT_L(0); PG8_MMA(1, 0, At, B0); PG8_BAR; PG8_SCHED;
            PG8_STAGE(PG8_SB(1, 1), b3 + hstep, voffB);
            PG8_WAIT_V(6); PG8_BAR; PG8_MMA(1, 1, At, B1); PG8_BAR;
            }
        }
        if constexpr (FP8) asm volatile("s_nop 15\n\ts_nop 15\n\ts_nop 15" ::: "memory");
        if constexpr (ALIGN_EPI) { if (wr == 0) PG8_BAR; }
        if constexpr (!Epi::AFTER_DRAIN) { E(acc, cur, wr, wc, fr, fq); S.done(cur); }
        if (!has_next) break;
        { float zf; asm volatile("v_mov_b32 %0, 0" : "=v"(zf));
#pragma unroll
        for (int a = 0; a < 2; ++a)
#pragma unroll
            for (int b = 0; b < 2; ++b)
#pragma unroll
                for (int m = 0; m < 4; ++m)
#pragma unroll
                    for (int n = 0; n < 2; ++n) acc[a][b][m][n] = (f32x4){zf, zf, zf, zf}; }
        cur = nxt; cA = nA; cB = nB; ++ui;
        if constexpr (ALIGN_EPI) { if (wr == 1) PG8_BAR; }
    }
    PG8_WAIT_V(0);
    if constexpr (!ALIGN_EPI) { if (wr == 0) PG8_BAR; }
    PG8_BAR;
    if constexpr (Epi::AFTER_DRAIN) { E.fused(acc, cur, wr, wc, fr, fq, lds, wid, lane); S.done(cur); }
#undef PG8_SA
#undef PG8_SB
#undef PG8_STAGE
#undef PG8_LDA
#undef PG8_LDB
#undef PG8_MMA
#undef PG8_WAIT_V
#undef PG8_WAIT_L
#undef PG8_BAR
#undef PG8_SCHED
}
}
#include <hip/hip_bf16.h>
#include <cmath>
namespace attn_body {
using bf16=__hip_bfloat16;
using bf16x8=__attribute__((ext_vector_type(8)))short;
using s16x4=__attribute__((ext_vector_type(4)))short;
using f32x16=__attribute__((ext_vector_type(16)))float;
using u32x4=__attribute__((ext_vector_type(4)))unsigned;
constexpr int BATCH=4,NHEAD=8,SEQ=4096,D=64,DM=512,DMO=1024,KVSEQ=4224;
constexpr int NW=8,QBLK=32,QB=QBLK*NW,KVBLK=64,NQB=SEQ/QB;
constexpr int ATTN_UNIT_ROWS=QB;
__device__ __forceinline__ int crow(int r,int hi){return (r&3)+8*(r>>2)+4*hi;}
#define SBAR() __builtin_amdgcn_sched_barrier(0)
__device__ __forceinline__ void cmask(f32x16&p0,f32x16&p1,int jb,int qrel,int hi){
  const float NEG=-INFINITY; int kb=64*jb+4*hi;
  #pragma unroll
  for(int r=0;r<16;++r){int kv=kb+(r&3)+8*(r>>2); if(kv>qrel)p0[r]=NEG; if(kv+32>qrel)p1[r]=NEG;}
}

constexpr int NSLOT=3, SLOTB=8192;
constexpr int LDS_K=0, LDS_V=NSLOT*SLOTB, LDS_V2=2*NSLOT*SLOTB, LDS_WS=3*NSLOT*SLOTB, LDS_OST=LDS_WS+NW*64*4, LDS_BYTES=LDS_OST+NW*4096;
constexpr float C2=0.125f*1.4426950408889634f;
__device__ __forceinline__ void glds16(const void*gsrc,unsigned lds_dst){unsigned keep;
  asm volatile("s_mov_b32 %0, m0\n\ts_mov_b32 m0, %2\n\ts_nop 0\n\tglobal_load_lds_dwordx4 %1, off\n\ts_mov_b32 m0, %0":"=&s"(keep):"v"(gsrc),"s"(lds_dst):"memory");}
__device__ __forceinline__ void glds16s(const void*sbase,unsigned voff,unsigned lds_dst){unsigned keep;
  asm volatile("s_mov_b32 %0, m0\n\ts_mov_b32 m0, %3\n\ts_nop 0\n\tglobal_load_lds_dwordx4 %1, %2\n\ts_mov_b32 m0, %0":"=&s"(keep):"v"(voff),"s"(sbase),"s"(lds_dst):"memory");}
__device__ __forceinline__ float max3f(float a,float b,float c){float r;asm("v_max3_f32 %0, %1, %2, %3":"=v"(r):"v"(a),"v"(b),"v"(c));return r;}
__device__ __forceinline__ float max2f(float a,float b){float r;asm("v_max_f32_e32 %0, %1, %2":"=v"(r):"v"(a),"v"(b));return r;}
__device__ __forceinline__ float fadd_s(float a,float b){float r;asm("v_add_f32_e32 %0, %1, %2":"=v"(r):"v"(a),"v"(b));return r;}
__device__ __forceinline__ float fsub_s(float a,float b){float r;asm("v_sub_f32_e32 %0, %1, %2":"=v"(r):"v"(a),"v"(b));return r;}
typedef float f32x2_t __attribute__((ext_vector_type(2))); typedef __bf16 bf16x2_t __attribute__((ext_vector_type(2)));
__device__ __forceinline__ unsigned cvtpk_s(float lo,float hi){f32x2_t v={lo,hi};bf16x2_t b=__builtin_convertvector(v,bf16x2_t);return __builtin_bit_cast(unsigned,b);}
#define WAIT_BAR(N) asm volatile("s_waitcnt vmcnt(" #N ") lgkmcnt(0)\n\ts_barrier":::"memory")

typedef __attribute__((address_space(3))) const char* lds_cptr;
__device__ __forceinline__ void qkt(f32x16&p0,f32x16&p1,lds_cptr Kslot,const bf16x8*qr,const f32x16&negm0,const f32x16&negm1,int r32,int hi){
  const lds_cptr kb=Kslot+hi*1024+r32*16;
  #pragma unroll
  for(int d0=0;d0<4;++d0){
    const bf16x8 b0=*(const __attribute__((address_space(3))) bf16x8*)(kb+d0*2048);
    const bf16x8 b1=*(const __attribute__((address_space(3))) bf16x8*)(kb+d0*2048+512);
    if(d0==0){p0=__builtin_amdgcn_mfma_f32_32x32x16_bf16(b0,qr[0],negm0,0,0,0);p1=__builtin_amdgcn_mfma_f32_32x32x16_bf16(b1,qr[0],negm1,0,0,0);}
    else{p0=__builtin_amdgcn_mfma_f32_32x32x16_bf16(b0,qr[d0],p0,0,0,0);p1=__builtin_amdgcn_mfma_f32_32x32x16_bf16(b1,qr[d0],p1,0,0,0);}}
}
typedef short v4i16_t __attribute__((ext_vector_type(4)));
__device__ __forceinline__ void kload8(bf16x8*kf,lds_cptr kp){
  kf[0]=*(const __attribute__((address_space(3))) bf16x8*)(kp);      kf[1]=*(const __attribute__((address_space(3))) bf16x8*)(kp+512);
  kf[2]=*(const __attribute__((address_space(3))) bf16x8*)(kp+2048); kf[3]=*(const __attribute__((address_space(3))) bf16x8*)(kp+2560);
  kf[4]=*(const __attribute__((address_space(3))) bf16x8*)(kp+4096); kf[5]=*(const __attribute__((address_space(3))) bf16x8*)(kp+4608);
  kf[6]=*(const __attribute__((address_space(3))) bf16x8*)(kp+6144); kf[7]=*(const __attribute__((address_space(3))) bf16x8*)(kp+6656);
}
__device__ __forceinline__ void kload2(bf16x8*kf,lds_cptr kp,int j){ kf[2*j]=*(const __attribute__((address_space(3))) bf16x8*)(kp+j*2048); kf[2*j+1]=*(const __attribute__((address_space(3))) bf16x8*)(kp+j*2048+512); }
__device__ __forceinline__ s16x4 vtr(lds_cptr p){ return __builtin_bit_cast(s16x4,__builtin_amdgcn_ds_read_tr16_b64_v4i16((__attribute__((address_space(3))) v4i16_t*)p)); }
__device__ __forceinline__ float rowmax(const f32x16&p0,const f32x16&p1){
  float a=max3f(p0[0],p0[1],p1[0]),b=max3f(p0[2],p0[3],p1[1]);a=max3f(a,p1[2],p1[3]);
  #pragma unroll
  for(int r=4;r<16;r+=4){a=max3f(a,p0[r],p0[r+1]);b=max3f(b,p0[r+2],p0[r+3]);a=max3f(a,p1[r],p1[r+1]);b=max3f(b,p1[r+2],p1[r+3]);}
  const float m=max2f(a,b);
  auto rr=__builtin_amdgcn_permlane32_swap(__float_as_uint(m),__float_as_uint(m),false,false);
  return max2f(__uint_as_float(rr[0]),__uint_as_float(rr[1]));
}
__device__ __forceinline__ void pv(f32x16*o,int vb,bf16x8 pa0,bf16x8 pa1,bf16x8 pa2,bf16x8 pa3){
  #pragma unroll
  for(int d0=0;d0<2;++d0){s16x4 lo[4],hi[4];
    #pragma unroll
    for(int ks=0;ks<4;++ks){
      asm volatile("ds_read_b64_tr_b16 %0,%1 offset:%c2":"=&v"(lo[ks]):"v"(vb),"i"(d0*4096+ks*1024):"memory");
      asm volatile("ds_read_b64_tr_b16 %0,%1 offset:%c2":"=&v"(hi[ks]):"v"(vb),"i"(d0*4096+ks*1024+512):"memory");}
    asm volatile("s_waitcnt lgkmcnt(0)":::"memory");SBAR();
    #define PK(k) (bf16x8){lo[k][0],lo[k][1],lo[k][2],lo[k][3],hi[k][0],hi[k][1],hi[k][2],hi[k][3]}
    o[d0]=__builtin_amdgcn_mfma_f32_32x32x16_bf16(pa0,PK(0),o[d0],0,0,0);
    o[d0]=__builtin_amdgcn_mfma_f32_32x32x16_bf16(pa1,PK(1),o[d0],0,0,0);
    o[d0]=__builtin_amdgcn_mfma_f32_32x32x16_bf16(pa2,PK(2),o[d0],0,0,0);
    o[d0]=__builtin_amdgcn_mfma_f32_32x32x16_bf16(pa3,PK(3),o[d0],0,0,0);
    #undef PK
  }
}

#ifndef ATTN_STORE16
#define ATTN_STORE16(p,v) (*(u32x4*)(p)=(v))
#endif
template<int THRL> __device__ __forceinline__ void attn_unit(int b,int hc,int qb,const bf16*Q,const bf16*__restrict__ K,const bf16*__restrict__ V,bf16*O,char*shm,int tid_in){
  int tid_=tid_in; asm volatile("":"+v"(tid_)); const int tid=tid_,lane=tid&63,r32=lane&31,hi=lane>>5; const int wid=__builtin_amdgcn_readfirstlane(tid>>6);
  const long rowbase=(long)b*SEQ, kvbase=(long)b*KVSEQ; const int q0=qb*QB;
  const bf16*Qw=Q+(rowbase+q0+wid*QBLK)*DM+hc*D;
  const bf16*Kh=K+kvbase*DM+hc*D,*Vh=V+kvbase*DM+(hc>>1)*128;
  const unsigned lds0=(unsigned)(uintptr_t)shm;
  typedef __attribute__((address_space(3))) float lds_f32; typedef __attribute__((address_space(3))) unsigned short lds_u16; typedef __attribute__((address_space(3))) char lds_char;
  lds_f32*wsf=(lds_f32*)((lds_char*)shm+LDS_WS)+wid*64;
  const bf16*ksb=Kh+wid*8; const unsigned kvo=(unsigned)lane*(DM*2);
  const bf16*vsb=Vh+(long)(16*(wid&3))*DM+(wid>>2)*32; const unsigned vvo=(unsigned)((lane>>2)*DM+(lane&3)*8)*2u;
  const unsigned kdst=lds0+LDS_K+wid*1024, vdst=lds0+LDS_V+wid*1024, vdst2=lds0+LDS_V2+wid*1024;
  #define DMA_K(t,slot) glds16s(ksb+(long)(t)*KVBLK*DM,kvo,(unsigned)__builtin_amdgcn_readfirstlane(kdst+(slot)))
  #define DMA_V(t,slot) do{ glds16s(vsb+(long)(t)*KVBLK*DM,vvo,(unsigned)__builtin_amdgcn_readfirstlane(vdst+(slot))); glds16s(vsb+(long)(t)*KVBLK*DM+64,vvo,(unsigned)__builtin_amdgcn_readfirstlane(vdst2+(slot))); }while(0)
  const int vb0=(int)(lds0+LDS_V)+((lane>>4)&1)*32+(lane&3)*8+(4*hi+((lane&15)>>2))*64;
  bf16x8 kf[8];
  const lds_cptr shm3=(lds_cptr)shm; const lds_cptr kp0=shm3+LDS_K+hi*1024+r32*16; const lds_cptr vp0=shm3+LDS_V+((lane>>4)&1)*32+(lane&3)*8+(4*hi+((lane&15)>>2))*64;
  const int NT=(q0+QB)/KVBLK+2;
  DMA_K(0,0);DMA_V(0,0);DMA_K(1,SLOTB);
  bf16x8 qr[4];
  #pragma unroll
  for(int d0=0;d0<4;++d0)qr[d0]=*reinterpret_cast<const bf16x8*>(&Qw[(long)r32*DM+d0*16+hi*8]);
  float mhat=0.f,l_reg=0.f;f32x16 o[4];o[0]=f32x16{};o[1]=f32x16{};o[2]=f32x16{};o[3]=f32x16{};f32x16 negm=f32x16{};asm volatile("":"+v"(negm));
  const int qrel=wid*QBLK+r32;
  #define CMASK(P0,P1,t) do{int jb_=(t)-(NT-4); if(jb_>=0)cmask(P0,P1,jb_,qrel,hi);}while(0)
  bool resc=false;
  #define START(P0,P1) do{ const float rm=rowmax(P0,P1); resc=false; \
    { const float dl=rm; mhat=fadd_s(mhat,dl); \
      _Pragma("unroll") for(int r=0;r<16;++r){P0[r]=fsub_s(P0[r],dl);P1[r]=fsub_s(P1[r],dl);} \
      _Pragma("unroll") for(int r=0;r<16;++r)negm[r]=-mhat; asm volatile("":"+v"(negm)); } \
    _Pragma("unroll") for(int r=0;r<16;++r)P0[r]=__builtin_amdgcn_exp2f(P0[r]); }while(0)
  #define RESC() do{ if(resc){ asm volatile("s_waitcnt lgkmcnt(0)":::"memory"); \
      _Pragma("unroll") for(int d_=0;d_<4;++d_) _Pragma("unroll") for(int r=0;r<16;++r)o[d_][r]*=wsf[crow(r,hi)]; } }while(0)
  f32x16 pA0,pA1,pB0,pB1;
  int sl_prev=0,sl_cur=0,sl_next=SLOTB;
  #define ROT() do{sl_prev=sl_cur;sl_cur=sl_next;sl_next=(sl_next==(NSLOT-1)*SLOTB)?0:sl_next+SLOTB;}while(0)
  DMA_K(2,2*SLOTB);
  WAIT_BAR(4);
  { f32x16 cm0,cm1; _Pragma("unroll") for(int r=0;r<16;++r){cm0[r]=-INFINITY;cm1[r]=(r<8)?-INFINITY:0.f;} asm volatile("":"+v"(cm0),"+v"(cm1));
    qkt(pA0,pA1,shm3+LDS_K,qr,cm0,cm1,r32,hi); }
  asm volatile("s_nop 15\n\ts_nop 7":"+v"(pA0),"+v"(pA1));CMASK(pA0,pA1,0);
  START(pA0,pA1);
  _Pragma("unroll") for(int r=0;r<16;++r)pA1[r]=__builtin_amdgcn_exp2f(pA1[r]);
  _Pragma("unroll") for(int r=0;r<16;++r)negm[r]=-INFINITY; asm volatile("":"+v"(negm));
  WAIT_BAR(0);
  DMA_K(3,0);DMA_V(1,SLOTB);
  ROT();
  kload8(kf,kp0+sl_cur);
  WAIT_BAR(3);
  s16x4 vlo[8],vhi[8],wlo[8],whi[8]; u32x4 pw0,pw1,pw2,pw3;
  #define PKW(P,B) cvtpk_s(P[B],P[B+1])
  #define PAF(k) __builtin_bit_cast(bf16x8,pw##k)
  #define VFR(i) (bf16x8){vlo[i][0],vlo[i][1],vlo[i][2],vlo[i][3],vhi[i][0],vhi[i][1],vhi[i][2],vhi[i][3]}
  #define WFR(i) (bf16x8){wlo[i][0],wlo[i][1],wlo[i][2],wlo[i][3],whi[i][0],whi[i][1],whi[i][2],whi[i][3]}
  #define PIN(x) asm volatile("":"+v"(x))
  #define MX3(a,b,c) __builtin_fmaxf(__builtin_fmaxf((a),(b)),(c))
  #define GAPA(MF,A0,A1,A2,A3,W0,W1,PW) do{ MF; sacc+=A0; sacc+=A1; sacc+=A2; sacc+=A3; PIN(sacc); W0; W1; PIN(PW); SBAR(); }while(0)
  #define EX(v) __builtin_amdgcn_exp2f(v)
  #define GAPB(MF,X,B) do{ MF; X[B]=EX(X[B]); X[B+1]=EX(X[B+1]); PIN(X); SBAR(); }while(0)
  #define VRD(i) do{ vlo[i]=vtr(vp_+(((i)>>2)*4096+((i)&3)*1024)); vhi[i]=vtr(vp_+(((i)>>2)*4096+((i)&3)*1024+512)); }while(0)
  #define WRD(i) do{ wlo[i]=vtr(vp_+((LDS_V2-LDS_V)+((i)>>2)*4096+((i)&3)*1024)); whi[i]=vtr(vp_+((LDS_V2-LDS_V)+((i)>>2)*4096+((i)&3)*1024+512)); SBAR(); }while(0)
  #define KRD(G,j) do{ if(G){ kload2(kf,kp0+sl_next,j); SBAR(); } }while(0)
  #define STEP(C0,C1,P0,P1,t,GK,GV,GL) do{ SBAR(); \
    const lds_cptr vp_=vp0+sl_prev; \
    float sacc=(P0[0]+P0[1]); \
    GAPA(C0=__builtin_amdgcn_mfma_f32_32x32x16_bf16(kf[0],qr[0],negm,0,0,0), P0[2],P0[3],P0[4],P0[5],     pw0[0]=PKW(P0,0), pw0[1]=PKW(P0,2), pw0); \
    GAPA(C1=__builtin_amdgcn_mfma_f32_32x32x16_bf16(kf[1],qr[0],negm,0,0,0), P0[6],P0[7],P0[8],P0[9],     pw0[2]=PKW(P0,4), pw0[3]=PKW(P0,6), pw0); \
    GAPA(C0=__builtin_amdgcn_mfma_f32_32x32x16_bf16(kf[2],qr[1],C0,0,0,0),   P0[10],P0[11],P0[12],P0[13], pw1[0]=PKW(P0,8), pw1[1]=PKW(P0,10), pw1); \
    GAPA(C1=__builtin_amdgcn_mfma_f32_32x32x16_bf16(kf[3],qr[1],C1,0,0,0),   P0[14],P0[15],P1[0],P1[1],   pw1[2]=PKW(P0,12),pw1[3]=PKW(P0,14), pw1); \
    GAPA(C0=__builtin_amdgcn_mfma_f32_32x32x16_bf16(kf[4],qr[2],C0,0,0,0),   P1[2],P1[3],P1[4],P1[5],     pw2[0]=PKW(P1,0), pw2[1]=PKW(P1,2), pw2); \
    GAPA(C1=__builtin_amdgcn_mfma_f32_32x32x16_bf16(kf[5],qr[2],C1,0,0,0),   P1[6],P1[7],P1[8],P1[9],     pw2[2]=PKW(P1,4), pw2[3]=PKW(P1,6), pw2); \
    GAPA(C0=__builtin_amdgcn_mfma_f32_32x32x16_bf16(kf[6],qr[3],C0,0,0,0),   P1[10],P1[11],P1[12],P1[13], pw3[0]=PKW(P1,8), pw3[1]=PKW(P1,10), pw3); \
    GAPA(C1=__builtin_amdgcn_mfma_f32_32x32x16_bf16(kf[7],qr[3],C1,0,0,0),   P1[14],P1[15],0.f,0.f,       pw3[2]=PKW(P1,12),pw3[3]=PKW(P1,14), pw3); \
    l_reg+=sacc; \
    VRD(0);VRD(4);VRD(1);VRD(5);VRD(2);VRD(6);VRD(3);VRD(7); SBAR();     \
    if(GK){DMA_K((t)+3,sl_cur);} if(GV){DMA_V((t)+1,sl_next);} \
    CMASK(C0,C1,t); \
    { float a=MX3(C0[0],C0[1],C1[0]),b=MX3(C0[2],C0[3],C1[1]); a=MX3(a,C1[2],C1[3]); \
      _Pragma("unroll") for(int r=4;r<16;r+=4){a=MX3(a,C0[r],C0[r+1]);b=MX3(b,C0[r+2],C0[r+3]);a=MX3(a,C1[r],C1[r+1]);b=MX3(b,C1[r+2],C1[r+3]);} \
      float rm=__builtin_fmaxf(a,b); { auto rr=__builtin_amdgcn_permlane32_swap(__float_as_uint(rm),__float_as_uint(rm),false,false); rm=__builtin_fmaxf(__uint_as_float(rr[0]),__uint_as_float(rr[1])); } \
      resc=false; \
      if(__builtin_expect(__any(rm>(float)THRL),0)){ const float dl=__builtin_fmaxf(rm,0.f); mhat+=dl; \
        _Pragma("unroll") for(int r=0;r<16;++r){C0[r]-=dl;C1[r]-=dl;} \
        _Pragma("unroll") for(int r=0;r<16;++r)negm[r]=-mhat; asm volatile("":"+v"(negm)); \
        const float f=__builtin_amdgcn_exp2f(-dl); l_reg*=f; if(hi==0)wsf[r32]=f; resc=true; } } \
    SBAR(); \
    GAPB(o[0]=__builtin_amdgcn_mfma_f32_32x32x16_bf16(PAF(0),VFR(0),o[0],0,0,0), C0,0);  WRD(0); \
    GAPB(o[1]=__builtin_amdgcn_mfma_f32_32x32x16_bf16(PAF(0),VFR(4),o[1],0,0,0), C0,2);  WRD(4); \
    KRD(GL,0); GAPB(o[0]=__builtin_amdgcn_mfma_f32_32x32x16_bf16(PAF(1),VFR(1),o[0],0,0,0), C0,4);  WRD(1); \
    KRD(GL,1); GAPB(o[1]=__builtin_amdgcn_mfma_f32_32x32x16_bf16(PAF(1),VFR(5),o[1],0,0,0), C0,6);  WRD(5); \
    KRD(GL,2); GAPB(o[0]=__builtin_amdgcn_mfma_f32_32x32x16_bf16(PAF(2),VFR(2),o[0],0,0,0), C0,8);  WRD(2); \
    KRD(GL,3); GAPB(o[1]=__builtin_amdgcn_mfma_f32_32x32x16_bf16(PAF(2),VFR(6),o[1],0,0,0), C0,10); WRD(6); \
    GAPB(o[0]=__builtin_amdgcn_mfma_f32_32x32x16_bf16(PAF(3),VFR(3),o[0],0,0,0), C0,12); WRD(3); \
    GAPB(o[1]=__builtin_amdgcn_mfma_f32_32x32x16_bf16(PAF(3),VFR(7),o[1],0,0,0), C0,14); WRD(7); \
    GAPB(o[2]=__builtin_amdgcn_mfma_f32_32x32x16_bf16(PAF(0),WFR(0),o[2],0,0,0), C1,0); \
    GAPB(o[3]=__builtin_amdgcn_mfma_f32_32x32x16_bf16(PAF(0),WFR(4),o[3],0,0,0), C1,2); \
    GAPB(o[2]=__builtin_amdgcn_mfma_f32_32x32x16_bf16(PAF(1),WFR(1),o[2],0,0,0), C1,4); \
    GAPB(o[3]=__builtin_amdgcn_mfma_f32_32x32x16_bf16(PAF(1),WFR(5),o[3],0,0,0), C1,6); \
    GAPB(o[2]=__builtin_amdgcn_mfma_f32_32x32x16_bf16(PAF(2),WFR(2),o[2],0,0,0), C1,8); \
    GAPB(o[3]=__builtin_amdgcn_mfma_f32_32x32x16_bf16(PAF(2),WFR(6),o[3],0,0,0), C1,10); \
    GAPB(o[2]=__builtin_amdgcn_mfma_f32_32x32x16_bf16(PAF(3),WFR(3),o[2],0,0,0), C1,12); \
    GAPB(o[3]=__builtin_amdgcn_mfma_f32_32x32x16_bf16(PAF(3),WFR(7),o[3],0,0,0), C1,14); \
    }while(0)
  int t=1;
  #define FIX1(tt) do{ if((tt)==1){ _Pragma("unroll") for(int r=0;r<16;++r)negm[r]=-mhat; asm volatile("":"+v"(negm)); } }while(0)
  #undef CMASK
  #define CMASK(P0,P1,t) do{}while(0)
  for(;t+5<NT;t+=2){
    STEP(pB0,pB1,pA0,pA1,t,true,true,true);     WAIT_BAR(3); RESC(); ROT(); FIX1(t);
    STEP(pA0,pA1,pB0,pB1,t+1,true,true,true);   WAIT_BAR(3); RESC(); ROT();
  }
  #undef CMASK
  #define CMASK(P0,P1,t) do{int jb_=(t)-(NT-4); if(jb_>=0)cmask(P0,P1,jb_,qrel,hi);}while(0)
  #define ENDW(tt) do{ if((tt)+3<NT){WAIT_BAR(3);} else if((tt)+2<NT){WAIT_BAR(2);} else {WAIT_BAR(0);} }while(0)
  for(;t+1<NT;t+=2){
    STEP(pB0,pB1,pA0,pA1,t,(t+3<NT),(t+1<NT),(t+1<NT));       ENDW(t);   RESC(); ROT(); FIX1(t);
    STEP(pA0,pA1,pB0,pB1,t+1,(t+4<NT),(t+2<NT),(t+2<NT));     ENDW(t+1); RESC(); ROT();
  }
  STEP(pB0,pB1,pA0,pA1,NT-1,false,false,false); RESC();
  { float sacc=pB0[0]+pB0[1]; _Pragma("unroll") for(int r=2;r<16;++r)sacc+=pB0[r]; _Pragma("unroll") for(int r=0;r<16;++r)sacc+=pB1[r]; l_reg+=sacc;
    pw0=(u32x4){PKW(pB0,0),PKW(pB0,2),PKW(pB0,4),PKW(pB0,6)};pw1=(u32x4){PKW(pB0,8),PKW(pB0,10),PKW(pB0,12),PKW(pB0,14)};pw2=(u32x4){PKW(pB1,0),PKW(pB1,2),PKW(pB1,4),PKW(pB1,6)};pw3=(u32x4){PKW(pB1,8),PKW(pB1,10),PKW(pB1,12),PKW(pB1,14)};
    SBAR(); pv(o,vb0+sl_cur,PAF(0),PAF(1),PAF(2),PAF(3)); pv(o+2,vb0+(LDS_V2-LDS_V)+sl_cur,PAF(0),PAF(1),PAF(2),PAF(3)); }
  #undef PKW
  #undef PAF
  #undef VFR
  #undef WFR
  #undef WRD
  #undef PIN
  #undef MX3
  #undef GAPA
  #undef GAPB
  #undef EX
  #undef VRD
  #undef KRD
  #undef STEP
  #undef ENDW
  {auto rr=__builtin_amdgcn_permlane32_swap(__float_as_uint(l_reg),__float_as_uint(l_reg),false,false);l_reg=__uint_as_float(rr[0])+__uint_as_float(rr[1]);}
  if(hi==0)wsf[32+r32]=l_reg;asm volatile("s_waitcnt lgkmcnt(0)":::"memory");
  float rli[16];
  #pragma unroll
  for(int r=0;r<16;++r)rli[r]=__builtin_amdgcn_rcpf(wsf[32+crow(r,hi)]);
  bf16*Ow=O+(rowbase+q0+wid*QBLK)*DMO+hc*128;
  { lds_u16*stg=(lds_u16*)((lds_char*)shm+LDS_OST)+wid*2048;
    #pragma unroll
    for(int half=0;half<2;++half){
      #pragma unroll
      for(int r=0;r<16;++r){const int orow=crow(r,hi);
        #pragma unroll
        for(int d0=0;d0<2;++d0)stg[orow*64+d0*32+r32]=(unsigned short)(cvtpk_s(o[2*half+d0][r]*rli[r],0.f)&0xffffu);}
      asm volatile("s_waitcnt lgkmcnt(0)":::"memory");
      #pragma unroll
      for(int i=0;i<4;++i){const int row=i*8+(lane>>3),ch=lane&7; const u32x4 v=*(const __attribute__((address_space(3))) u32x4*)(stg+row*64+ch*8); ATTN_STORE16(Ow+(long)row*DMO+half*64+ch*8,v);}
      asm volatile("s_waitcnt lgkmcnt(0)":::"memory"); } }
  asm volatile("s_waitcnt lgkmcnt(0)\n\ts_barrier":::"memory");
  #undef DMA_K
  #undef DMA_V
  #undef CMASK
  #undef START
  #undef RESC
  #undef ROT
}
constexpr int ATTN_LDS_BYTES=LDS_BYTES;
struct AttnTensors { const bf16* Q; const bf16* K; const bf16* V; bf16* O; };
struct AttnUnit { int bh; int qb; };
struct StaticOrder {
  int vcu;
  __device__ __forceinline__ explicit StaticOrder(int grid,int block):vcu((block%8)*(grid/8)+block/8){}
  __device__ __forceinline__ bool next(int i,AttnUnit&u)const{ if(i>=4||vcu>=256)return false; const int s=vcu&3; u.bh=vcu>>2; u.qb=(i==0)?s:(i==1)?7-s:(i==2)?8+s:15-s; return true; }
  __device__ __forceinline__ void a_ready(const AttnUnit&)const{}
  __device__ __forceinline__ void done(const AttnUnit&)const{}
};
struct QueueOrder {
  unsigned* ctr; __attribute__((address_space(3))) unsigned* slot; int x; int tid0;
  __device__ __forceinline__ bool next(int,AttnUnit&u)const{
    if(tid0==0){ const unsigned e=__hip_atomic_fetch_add(ctr,1u,__ATOMIC_RELAXED,__HIP_MEMORY_SCOPE_AGENT); *slot=e; }
    asm volatile("s_waitcnt vmcnt(0) lgkmcnt(0)\n\ts_barrier":::"memory");
    const unsigned e=*slot;
    asm volatile("s_waitcnt lgkmcnt(0)\n\ts_barrier":::"memory");
    if(e>=64u)return false; u.bh=(int)(e&3u)*8+x; u.qb=15-(int)(e>>2); return true; }
  __device__ __forceinline__ void a_ready(const AttnUnit&)const{}
  __device__ __forceinline__ void done(const AttnUnit&)const{}
};
template<class Sched,int THRL=8> __device__ __forceinline__ void attn_phase(char*lds,const AttnTensors&T,const Sched&S,int tid_in){
  AttnUnit u;
  for(int i=0;S.next(i,u);++i){ S.a_ready(u); attn_unit<THRL>(u.bh/NHEAD,u.bh%NHEAD,u.qb,T.Q,T.K,T.V,T.O,lds,tid_in); S.done(u); }
}
#undef SBAR
#undef WAIT_BAR
}
#define GAS __attribute__((address_space(1)))
#define LAS __attribute__((address_space(3)))
typedef unsigned short bf16;
typedef unsigned v4u __attribute__((ext_vector_type(4)));
typedef float f32x4 __attribute__((ext_vector_type(4)));
typedef short bf16x8 __attribute__((ext_vector_type(8)));
typedef GAS unsigned gu32;
typedef GAS unsigned long long gu64;
#define RLX_AGENT __ATOMIC_RELAXED, __HIP_MEMORY_SCOPE_AGENT
#define LDS_WAIT() asm volatile("s_waitcnt lgkmcnt(0)" ::: "memory")
#define VM_WAIT() asm volatile("s_waitcnt vmcnt(0)" ::: "memory")
__device__ __forceinline__ unsigned long long rt() { return __builtin_amdgcn_s_memrealtime(); }
__device__ __forceinline__ unsigned f2bf(float f) { unsigned u = __builtin_bit_cast(unsigned, f); return (u + 0x7fffu + ((u >> 16) & 1u)) >> 16; }
__device__ __forceinline__ unsigned pk2(float lo, float hi) { return f2bf(lo) | (f2bf(hi) << 16); }

#define XB_TMO      128
#define XB_XCNT(j)  (256  + 64 * (j))
#define XB_XSUB(j)  (1280 + 64 * (j))
#define XB_XGEN(j)  (2304 + 64 * (j))
#define XB_TOP      3328
#define XB_TOPGEN   3392
#define XCD_BAR_WORDS 3456
#define XB_SPIN_CAP (1u << 18)

__device__ __forceinline__ unsigned xb_ld(unsigned* p)              { return __hip_atomic_load(p, __ATOMIC_RELAXED, __HIP_MEMORY_SCOPE_AGENT); }
__device__ __forceinline__ unsigned xb_add(unsigned* p, unsigned v) { return __hip_atomic_fetch_add(p, v, __ATOMIC_RELAXED, __HIP_MEMORY_SCOPE_AGENT); }
__device__ __forceinline__ unsigned xb_xcc_id() { return (unsigned)__builtin_amdgcn_s_getreg((3 << 11) | 20) & 0xFu; }
#define XB_SPIN(cond, bar) do { unsigned _sp = 0; while (cond) { __builtin_amdgcn_s_sleep(1); \
    if ((++_sp & 255u) == 0u) { if (xb_ld(&(bar)[XB_TMO])) break; if (_sp > XB_SPIN_CAP) { atomicAdd(&(bar)[XB_TMO], 1u); break; } } } } while (0)

struct XcdBarrier {
    unsigned* bar; unsigned x; int wv;
    volatile LAS unsigned* st;
};

__device__ __forceinline__ XcdBarrier xcd_barrier_post(unsigned* bar, volatile LAS unsigned* st) {
    XcdBarrier b; b.bar = bar; b.x = xb_xcc_id(); b.st = st;
    if (threadIdx.x == 0) (void)xb_add(&bar[XB_XCNT(b.x)], 1u);
    return b;
}
__device__ __forceinline__ void xcd_barrier_complete(unsigned* bar, unsigned x, unsigned& nloc, unsigned& nx) {
    const unsigned G = gridDim.x * gridDim.y * gridDim.z;
    unsigned sum, cnt, mine, sp = 0u;
    for (;;) {
        sum = 0u; cnt = 0u; mine = 0u;
#pragma unroll
        for (unsigned j = 0; j < 16; ++j) { const unsigned c = xb_ld(&bar[XB_XCNT(j)]); sum += c; cnt += (c > 0u) ? 1u : 0u; mine = (j == x) ? c : mine; }
        if (sum == G) break;
        __builtin_amdgcn_s_sleep(1);
        if ((++sp & 255u) == 0u) { if (xb_ld(&bar[XB_TMO])) break; if (sp > XB_SPIN_CAP) { atomicAdd(&bar[XB_TMO], 1u); break; } }
    }
    nloc = mine > 0u ? mine : 1u; nx = cnt > 0u ? cnt : 1u;
}

__device__ __forceinline__ void xcd_barrier(const XcdBarrier& b) {
    asm volatile("s_waitcnt vmcnt(0)" ::: "memory");
    __syncthreads();
    unsigned ln_; asm volatile("v_mbcnt_lo_u32_b32 %0, -1, 0\n\tv_mbcnt_hi_u32_b32 %0, -1, %0" : "=v"(ln_));
    if (b.wv == 0 && ln_ == 0u) {
        unsigned* bar = b.bar;
        __builtin_amdgcn_s_waitcnt(0);
        unsigned nloc = b.st[0], nx = b.st[1];
        if (nloc == 0u) { xcd_barrier_complete(bar, b.x, nloc, nx); b.st[0] = nloc; b.st[1] = nx; }
        const unsigned old = xb_add(&bar[XB_XSUB(b.x)], 1u);
        const unsigned gen = old / nloc;
        if (old + 1u == (gen + 1u) * nloc) {
            __builtin_amdgcn_fence(__ATOMIC_RELEASE, "agent");
            asm volatile("s_waitcnt vmcnt(0)" ::: "memory");
            const unsigned og = xb_add(&bar[XB_TOP], 1u);
            const unsigned tg = og / nx;
            if (og + 1u == (tg + 1u) * nx) xb_add(&bar[XB_TOPGEN], 1u);
            else XB_SPIN(xb_ld(&bar[XB_TOPGEN]) == tg, bar);
            __builtin_amdgcn_fence(__ATOMIC_ACQUIRE, "agent");
            xb_add(&bar[XB_XGEN(b.x)], 1u);
            asm volatile("s_waitcnt vmcnt(0)" ::: "memory");
        } else {
            XB_SPIN(xb_ld(&bar[XB_XGEN(b.x)]) == gen, bar);
            __builtin_amdgcn_fence(__ATOMIC_ACQUIRE, "agent");
            asm volatile("s_waitcnt vmcnt(0)" ::: "memory");
        }
    }
    __syncthreads();
}

constexpr int NWAVES = 8;
constexpr int DM = 1024, NB = 4, SEQ = 4096, NMETA = 16, DEPTH = 4;
constexpr int NREAL = NB * SEQ;
constexpr int NTOK = NREAL + NMETA;
constexpr int MPAD = 16640;
constexpr int INC = 3200, INP = 3328;
constexpr int RCOLS = 896, QOFF = 896, KOFF = 896 + 512, VOFF = 896 + 1024, COFF = 2432;
constexpr int FF = 2816, FF2 = 5632, NE = 8;
constexpr int KVROWS = 128 + SEQ;
constexpr int MOEP = 35072;
constexpr float C2Q = 0.125f * 1.4426950408889634f;

constexpr size_t MiB = 1u << 20;
constexpr size_t WS_CTL = 0, CTL_ZERO_BYTES = 1 * MiB;
constexpr size_t WS_COS = 1 * MiB, WS_SIN = 1 * MiB + 192 * 1024;
constexpr size_t WS_RSTD = 1 * MiB + 512 * 1024;
constexpr size_t WS_RSROW = 1 * MiB + 768 * 1024;
constexpr size_t WS_TOKE = 2 * MiB, WS_TOKS = 2 * MiB + 256 * 1024, WS_TOKG = 2 * MiB + 512 * 1024;
constexpr size_t WS_WIN = 4 * MiB;
constexpr size_t WS_WOUT = 30 * MiB;
constexpr size_t WS_WGU = 38 * MiB;
constexpr size_t WS_WD = 60 * MiB;
constexpr size_t WS_MWGU = 72 * MiB;
constexpr size_t WS_MWD = 160 * MiB;
constexpr size_t WS_H = 204 * MiB;
constexpr size_t WS_HB = 269 * MiB;
constexpr size_t WS_PH = 302 * MiB;
constexpr size_t WS_PROJ = WS_PH;
constexpr size_t WS_QN = 408 * MiB;
constexpr size_t WS_KP = 425 * MiB;
constexpr size_t WS_VP = 442 * MiB;
constexpr size_t WS_OC = 459 * MiB;
constexpr size_t WS_OMIX = 492 * MiB;
constexpr size_t WS_SC = 525 * MiB, SC_STRIDE = 17 * MiB;
constexpr size_t WS_MIX_END = WS_SC + 9 * SC_STRIDE;
constexpr size_t WS_G = WS_PH;
constexpr size_t WS_AROWS = 491 * MiB;
constexpr size_t WS_YM = 560 * MiB;
constexpr size_t WS_LORA = 680 * MiB;
constexpr size_t WS_END = 714 * MiB;
static_assert(WS_PROJ + (size_t)MPAD * INP * 2 <= WS_QN && WS_G + (size_t)MOEP * FF * 2 <= WS_AROWS && WS_AROWS + (size_t)MOEP * 1024 * 2 <= WS_YM && WS_YM + (size_t)MOEP * 1024 * 2 <= WS_END, "ws map");
static_assert((size_t)8 * FF2 * DM <= 44 * MiB && 44 * MiB + (size_t)4112 * 11008 + 1024 <= 88 * MiB && (size_t)4112 * 8192 <= (size_t)MPAD * 2048, "chunk buffers");
static_assert(WS_H + (size_t)MPAD * 1024 * 4 <= WS_HB && WS_HB + (size_t)MPAD * 1024 * 2 <= WS_PH && WS_MIX_END <= WS_END, "ws map 2");
static_assert((size_t)NTOK * 256 * 4 <= SC_STRIDE && WS_OC + (size_t)NTOK * 2048 <= WS_OMIX && WS_OMIX + (size_t)MPAD * 2048 <= WS_SC, "ws map 3");
constexpr int CW_MOECNT = 1024;
constexpr int CW_BAR = 4096;
constexpr int CW_ATTQ = 8192;

constexpr int LDS_BYTES = 147456;
constexpr int MISC_OFF = LDS_BYTES - 128;

struct Args { const float* in[32]; float* out; unsigned char* ws; int ph_lo, ph_hi; };

__device__ __forceinline__ v4u zero_v4u() { unsigned z; asm volatile("v_mov_b32 %0, 0" : "=v"(z)); return (v4u){z, z, z, z}; }
__device__ __forceinline__ unsigned pk4_fp8(float a, float b, float c, float d) {
    a = __builtin_amdgcn_fmed3f(a, -448.f, 448.f); b = __builtin_amdgcn_fmed3f(b, -448.f, 448.f); c = __builtin_amdgcn_fmed3f(c, -448.f, 448.f); d = __builtin_amdgcn_fmed3f(d, -448.f, 448.f);
    unsigned p = (unsigned)__builtin_amdgcn_cvt_pk_fp8_f32(a, b, 0, false); return (unsigned)__builtin_amdgcn_cvt_pk_fp8_f32(c, d, (int)p, true); }
#ifndef INP8_MASK
#define INP8_MASK 0xC
#endif
constexpr int INP8 = INP8_MASK;
constexpr float W8_SCALE = 64.f, A8_SCALE = 16.f, G8_SCALE = 4.f, H8_SCALE = 4.f;
__device__ __forceinline__ float bf2f(unsigned short b) { return __uint_as_float(((unsigned)b) << 16); }
#define DPP_F(x, ctrl) __int_as_float(__builtin_amdgcn_update_dpp(0, __float_as_int(x), ctrl, 0xF, 0xF, true))
__device__ __forceinline__ float lane_xor1(float v) { return DPP_F(v, 0xB1); }
__device__ __forceinline__ float sum8(float v) { v += DPP_F(v, 0xB1); v += DPP_F(v, 0x4E); v += DPP_F(v, 0x141); return v; }
__device__ __forceinline__ float sum16(float v) { v = sum8(v); v += DPP_F(v, 0x140); return v; }
__device__ __forceinline__ float wave_sum_dpp(float p) {
    p = sum16(p);
    asm volatile("s_nop 1\n\tv_add_f32_dpp %0, %0, %0 row_bcast:15 row_mask:0xa bank_mask:0xf\n\ts_nop 1\n\tv_add_f32_dpp %0, %0, %0 row_bcast:31 row_mask:0xc bank_mask:0xf\n\ts_nop 0" : "+v"(p));
    return __int_as_float(__builtin_amdgcn_readlane(__float_as_int(p), 63));
}
__device__ __forceinline__ float wave_sum(float v) { return wave_sum_dpp(v); }
__device__ __forceinline__ float wave_max(float v) {
    v = fmaxf(v, DPP_F(v, 0xB1)); v = fmaxf(v, DPP_F(v, 0x4E)); v = fmaxf(v, DPP_F(v, 0x141)); v = fmaxf(v, DPP_F(v, 0x140));
    asm volatile("s_nop 1\n\tv_max_f32_dpp %0, %0, %0 row_bcast:15 row_mask:0xa bank_mask:0xf\n\ts_nop 1\n\tv_max_f32_dpp %0, %0, %0 row_bcast:31 row_mask:0xc bank_mask:0xf\n\ts_nop 0" : "+v"(v));
    return __int_as_float(__builtin_amdgcn_readlane(__float_as_int(v), 63));
}
__device__ __forceinline__ float sigmoidf_(float x) { return 1.f / (1.f + __expf(-x)); }
__device__ __forceinline__ int prevrow(int row) { if (row < 0) return -1; if (row >= NREAL) return row == NREAL ? -1 : row - 1; return (row & (SEQ - 1)) == 0 ? NTOK - 1 : row - 1; }

__device__ __forceinline__ void tr_item(const float* W, int K, int N, bf16* WT, int rowmode, const float* gk, LAS float* scr, int item, int lane) {
    const int nblk = N / 32, kb = item / nblk, nb = item % nblk, k0 = 64 * kb, n0 = 32 * nb;
    const float* src = W + (size_t)(k0 + (lane >> 5)) * N + n0 + (lane & 31);
    float v[32];
#pragma unroll
    for (int i = 0; i < 32; ++i) v[i] = src[(size_t)(2 * i) * N];
#pragma unroll
    for (int i = 0; i < 32; ++i) scr[(2 * i + (lane >> 5)) * 33 + (lane & 31)] = v[i];
    LDS_WAIT(); asm volatile("" ::: "memory");
    const int c = lane & 7;
    f32x4 g0 = (f32x4){1.f, 1.f, 1.f, 1.f}, g1 = g0;
    if (gk) { g0 = *(const f32x4*)(gk + k0 + 8 * c); g1 = *(const f32x4*)(gk + k0 + 8 * c + 4); }
#pragma unroll
    for (int j = 0; j < 4; ++j) { const int n = (lane >> 3) + 8 * j; const LAS float* s = scr + (8 * c) * 33 + n;
        v4u o; o.x = pk2(s[0 * 33] * g0.x, s[1 * 33] * g0.y); o.y = pk2(s[2 * 33] * g0.z, s[3 * 33] * g0.w); o.z = pk2(s[4 * 33] * g1.x, s[5 * 33] * g1.y); o.w = pk2(s[6 * 33] * g1.z, s[7 * 33] * g1.w);
        const int nn = n0 + n; const int drow = rowmode == 0 ? nn : ((nn >> 7) * 256 + (nn & 127) + (rowmode == 2 ? 128 : 0));
        *(GAS v4u*)(WT + (size_t)drow * K + k0 + 8 * c) = o; }
    LDS_WAIT(); asm volatile("" ::: "memory");
}

__device__ __forceinline__ void tr_item2(const float* W0, int K0, int N0, bf16* WT0, int rm0, const float* gk0, int item0,
                                         const float* W1, int K1, int N1, bf16* WT1, int rm1, const float* gk1, int item1, LAS float* scr, int lane, bool f8_0 = false, bool f8_1 = false) {
    const int nb0_ = N0 / 32, nb1_ = N1 / 32;
    const int k00 = 64 * (item0 / nb0_), n00 = 32 * (item0 % nb0_), k01 = 64 * (item1 / nb1_), n01 = 32 * (item1 % nb1_);
    const float* s0 = W0 + (size_t)(k00 + (lane >> 5)) * N0 + n00 + (lane & 31); const float* s1 = W1 + (size_t)(k01 + (lane >> 5)) * N1 + n01 + (lane & 31);
    float v0[32], v1[32];
#pragma unroll
    for (int i = 0; i < 32; ++i) { v0[i] = s0[(size_t)(2 * i) * N0]; v1[i] = s1[(size_t)(2 * i) * N1]; }
    LAS float* t0 = scr; LAS float* t1 = scr + 64 * 33;
#pragma unroll
    for (int i = 0; i < 32; ++i) { t0[(2 * i + (lane >> 5)) * 33 + (lane & 31)] = v0[i]; t1[(2 * i + (lane >> 5)) * 33 + (lane & 31)] = v1[i]; }
    LDS_WAIT(); asm volatile("" ::: "memory");
    const int c = lane & 7;
#pragma unroll
    for (int q = 0; q < 2; ++q) { const float* gk = q ? gk1 : gk0; const int k0 = q ? k01 : k00, n0 = q ? n01 : n00, K = q ? K1 : K0, rowmode = q ? rm1 : rm0; bf16* WT = q ? WT1 : WT0; const LAS float* tt = q ? t1 : t0;
        f32x4 g0 = (f32x4){1.f, 1.f, 1.f, 1.f}, g1 = g0;
        if (gk) { g0 = *(const f32x4*)(gk + k0 + 8 * c); g1 = *(const f32x4*)(gk + k0 + 8 * c + 4); }
#pragma unroll
        for (int j = 0; j < 4; ++j) { const int n = (lane >> 3) + 8 * j; const LAS float* s = tt + (8 * c) * 33 + n;
            v4u o; o.x = pk2(s[0 * 33] * g0.x, s[1 * 33] * g0.y); o.y = pk2(s[2 * 33] * g0.z, s[3 * 33] * g0.w); o.z = pk2(s[4 * 33] * g1.x, s[5 * 33] * g1.y); o.w = pk2(s[6 * 33] * g1.z, s[7 * 33] * g1.w);
            const int nn = n0 + n; const int drow = rowmode == 0 ? nn : ((nn >> 7) * 256 + (nn & 127) + (rowmode == 2 ? 128 : 0));
            if (q ? f8_1 : f8_0) { const unsigned lo = pk4_fp8(s[0 * 33] * g0.x * W8_SCALE, s[1 * 33] * g0.y * W8_SCALE, s[2 * 33] * g0.z * W8_SCALE, s[3 * 33] * g0.w * W8_SCALE), hi8 = pk4_fp8(s[4 * 33] * g1.x * W8_SCALE, s[5 * 33] * g1.y * W8_SCALE, s[6 * 33] * g1.z * W8_SCALE, s[7 * 33] * g1.w * W8_SCALE);
                *(GAS unsigned long long*)((GAS unsigned char*)WT + (size_t)drow * K + k0 + 8 * c) = (unsigned long long)lo | ((unsigned long long)hi8 << 32); }
            else *(GAS v4u*)(WT + (size_t)drow * K + k0 + 8 * c) = o; } }
    LDS_WAIT(); asm volatile("" ::: "memory");
}

__device__ __forceinline__ void meta_gemm_res(const bf16* A, int K, const bf16* Bt, float* Hm, LAS unsigned char* lds, int bx, int wave, int lane, int hbmode = 0, bf16* HBm = nullptr, unsigned long long* rsqm = nullptr) {
    if (bx < 32) {
        typedef short bfx8 __attribute__((ext_vector_type(8)));
        const int ct = 2 * bx + (wave >> 2), ksp = wave & 3, n = lane & 15, kq = lane >> 4; const int kc = K >> 2, steps = kc >> 5;
        const bf16* ap = A + (size_t)n * K + ksp * kc + 8 * kq; const bf16* wp = Bt + (size_t)(16 * ct + n) * K + ksp * kc + 8 * kq;
        f32x4 acc = (f32x4){0.f, 0.f, 0.f, 0.f};
#pragma unroll 11
        for (int s = 0; s < steps; ++s) { const v4u a = *(const v4u*)(wp + 32 * s), b = *(const v4u*)(ap + 32 * s);
            acc = __builtin_amdgcn_mfma_f32_16x16x32_bf16(__builtin_bit_cast(bfx8, a), __builtin_bit_cast(bfx8, b), acc, 0, 0, 0); }
        LAS f32x4* red = (LAS f32x4*)lds;
        red[wave * 64 + lane] = acc;
        __syncthreads();
        if (ksp == 0) { const f32x4 s = (red[wave * 64 + lane] + red[(wave + 1) * 64 + lane]) + (red[(wave + 2) * 64 + lane] + red[(wave + 3) * 64 + lane]);
            f32x4* hp = (f32x4*)(Hm + (size_t)n * 1024 + 16 * ct + 4 * kq); const f32x4 hn = *hp + s; *hp = hn;
            if (hbmode) { const int cc = 16 * ct + 4 * kq;
                if (hbmode == 1) *(unsigned long long*)(HBm + (size_t)n * 1024 + cc) = (unsigned long long)pk2(hn.x, hn.y) | ((unsigned long long)pk2(hn.z, hn.w) << 32);
                else *(unsigned*)((unsigned char*)HBm + (size_t)n * 1024 + cc) = pk4_fp8(hn.x * H8_SCALE, hn.y * H8_SCALE, hn.z * H8_SCALE, hn.w * H8_SCALE);
                __hip_atomic_fetch_add(rsqm + n, (unsigned long long)(((hn.x * hn.x + hn.y * hn.y) + (hn.z * hn.z + hn.w * hn.w)) * 16777216.f), RLX_AGENT); } }
        __syncthreads();
    }
}

__device__ __forceinline__ void meta_gemm_res8(const unsigned char* A, int K, const unsigned char* Bt, float* Hm, float sc, LAS unsigned char* lds, int bx, int wave, int lane) {
    if (bx < 32) {
        typedef int v8i_ __attribute__((ext_vector_type(8)));
        const int ct = 2 * bx + (wave >> 2), ksp = wave & 3, n = lane & 15, kq = lane >> 4; const int kc = K >> 2, steps = kc >> 7;
        const int s0 = ksp < 2 ? 6 * ksp : 12 + 5 * (ksp - 2), ns = ksp < 2 ? 6 : 5; (void)kc; (void)steps;
        const unsigned char* ap = A + (size_t)n * K + 32 * kq; const unsigned char* wp = Bt + (size_t)(16 * ct + n) * K + 32 * kq;
        f32x4 acc = (f32x4){0.f, 0.f, 0.f, 0.f};
#pragma unroll 6
        for (int s = s0; s < s0 + ns; ++s) { const v4u a0 = *(const v4u*)(wp + 128 * s), a1 = *(const v4u*)(wp + 128 * s + 16), b0 = *(const v4u*)(ap + 128 * s), b1 = *(const v4u*)(ap + 128 * s + 16);
            const v8i_ aa = (v8i_){(int)a0.x, (int)a0.y, (int)a0.z, (int)a0.w, (int)a1.x, (int)a1.y, (int)a1.z, (int)a1.w}, bb = (v8i_){(int)b0.x, (int)b0.y, (int)b0.z, (int)b0.w, (int)b1.x, (int)b1.y, (int)b1.z, (int)b1.w};
            acc = __builtin_amdgcn_mfma_scale_f32_16x16x128_f8f6f4(aa, bb, acc, 0, 0, 0, 0x7f7f7f7f, 0, 0x7f7f7f7f); }
        LAS f32x4* red = (LAS f32x4*)lds;
        red[wave * 64 + lane] = acc;
        __syncthreads();
        if (ksp == 0) { const f32x4 s = (red[wave * 64 + lane] + red[(wave + 1) * 64 + lane]) + (red[(wave + 2) * 64 + lane] + red[(wave + 3) * 64 + lane]);
            f32x4* hp = (f32x4*)(Hm + (size_t)n * 1024 + 16 * ct + 4 * kq); *hp = *hp + s * sc; }
        __syncthreads();
    }
}

__global__ void __launch_bounds__(NWAVES * 64, 2) hymba_fwd(Args args) {
    extern __shared__ __attribute__((aligned(16))) unsigned char lds_raw[];
    LAS unsigned char* lds = (LAS unsigned char*)lds_raw;
    volatile LAS unsigned* MISC = (volatile LAS unsigned*)(lds + MISC_OFF);
    const int wave = __builtin_amdgcn_readfirstlane((int)threadIdx.x >> 6);
#define PH_TID int tid; asm volatile("v_mbcnt_lo_u32_b32 %0, -1, 0\n\tv_mbcnt_hi_u32_b32 %0, -1, %0" : "=v"(tid)); tid += wave * 64; const int lane = tid & 63; (void)lane; unsigned char* ws = ws0; asm volatile("" : "+s"(ws)); const char* ka = ka0; asm volatile("" : "+s"(ka)); (void)ka
    const int G = gridDim.x, bx = blockIdx.x;
    const int gw = bx * NWAVES + wave, NGW = G * NWAVES;
    unsigned char* const ws0 = args.ws;
    const char* const ka0 = (const char*)__builtin_amdgcn_kernarg_segment_ptr();
    { const int t0_ = (int)threadIdx.x; if (t0_ < 32) ((LAS unsigned*)(lds + MISC_OFF))[t0_] = 0u; }
    __syncthreads();
    const int lo = args.ph_lo, hi = args.ph_hi;
    const bool multi = (hi - lo) > 1;
    XcdBarrier bar; bar.bar = (unsigned*)(ws0 + WS_CTL) + CW_BAR; bar.x = 0; bar.st = nullptr; bar.wv = wave;
    if (multi) { bar = xcd_barrier_post((unsigned*)(ws0 + WS_CTL) + CW_BAR, MISC + 8); bar.wv = wave; }
#ifndef ENMASK
#define ENMASK 0xFFFF
#endif
#define EN(k) (((ENMASK) >> (k)) & 1)
#ifndef REPMASK
#define REPMASK 0
#endif
#define NREP(k) ((((REPMASK) >> (k)) & 1) ? 2 : 1)
#define IN(k) (lo <= (k) && (k) < hi)
#define SEAM(k) do { if (hi > (k) + 1) xcd_barrier(bar); } while (0)

#define Hf ((float*)(ws + WS_H))
#define HB ((bf16*)(ws + WS_HB))
#define RSTD ((float*)(ws + WS_RSTD))
#define PROJ ((bf16*)(ws + WS_PROJ))
#define QN ((bf16*)(ws + WS_QN))
#define KP ((bf16*)(ws + WS_KP))
#define VP ((bf16*)(ws + WS_VP))
#define OC ((bf16*)(ws + WS_OC))
#define OMIX ((bf16*)(ws + WS_OMIX))
#define SP4 ((f32x4*)(ws + WS_SC + 0 * SC_STRIDE))
#define SR ((float*)(ws + WS_SC + 4 * SC_STRIDE))
#define SV ((float*)(ws + WS_SC + 5 * SC_STRIDE))
#define SG ((float*)(ws + WS_SC + 6 * SC_STRIDE))
#define SBON ((float*)(ws + WS_SC + 7 * SC_STRIDE))
#define SY ((float*)(ws + WS_SC + 8 * SC_STRIDE))
#define COS ((float*)(ws + WS_COS))
#define SIN ((float*)(ws + WS_SIN))
#define GB ((bf16*)(ws + WS_G))
#define AROWS ((bf16*)(ws + WS_AROWS))
#define YM ((bf16*)(ws + WS_YM))
#define RSQA ((unsigned long long*)(ws + WS_RSROW))
#define TOKE ((int*)(ws + WS_TOKE))
#define TOKS ((int*)(ws + WS_TOKS))
#define TOKG ((float*)(ws + WS_TOKG))
#define ctl ((gu32*)(ws + WS_CTL))
#define INP(i) (*(const float* const*)(ka + 8 * (i)))
#define LORA_W ((float*)(ws + WS_LORA))
#define LORA_AG ((bf16*)(ws + WS_LORA + 17 * MiB))
#define CH_REC ((unsigned char*)(ws + WS_MWGU + 44 * MiB))
#define CH_RB 11008
#define CH_SPK ((unsigned char*)(ws + WS_HB))
#ifndef SCAN_CHUNKED
#define SCAN_CHUNKED 1
#endif

    for (int rep_ = 0; rep_ < NREP(15); ++rep_) if (EN(15) && IN(0)) { PH_TID;
        LAS float* scr = (LAS float*)(lds + wave * 17408);
        constexpr int I_IN = 16 * 100, I_OUT = 16 * 32, I_GU = 16 * 88, I_DN = 44 * 32;
        constexpr int NITEMS = DEPTH * (I_IN + I_OUT) + 2 * (2 * I_GU + I_DN);
        for (int it0 = 2 * gw; it0 < NITEMS; it0 += 2 * NGW) {
            const float* W_[2]; bf16* D_[2]; int K_[2], N_[2], rm_[2], r_[2]; const float* g_[2]; bool f8_[2] = {false, false};
#pragma unroll
            for (int q = 0; q < 2; ++q) { int r = it0 + q;
                if (r < DEPTH * I_IN) { const int l = r / I_IN; W_[q] = INP(3) + (size_t)l * DM * INC; K_[q] = DM; N_[q] = INC; D_[q] = (bf16*)(ws + WS_WIN) + (size_t)l * INP * DM; rm_[q] = 0; g_[q] = INP(2) + l * DM; r_[q] = r % I_IN; f8_[q] = ((INP8 >> l) & 1) != 0; continue; } r -= DEPTH * I_IN;
                if (r < DEPTH * I_OUT) { const int l = r / I_OUT; W_[q] = INP(23) + (size_t)l * DM * DM; K_[q] = DM; N_[q] = DM; D_[q] = (bf16*)(ws + WS_WOUT) + (size_t)l * DM * DM; rm_[q] = 0; g_[q] = nullptr; r_[q] = r % I_OUT; continue; } r -= DEPTH * I_OUT;
                if (r < 2 * I_GU) { const int j = r / I_GU; W_[q] = INP(25) + (size_t)j * DM * FF; K_[q] = DM; N_[q] = FF; D_[q] = (bf16*)(ws + WS_WGU) + (size_t)j * FF2 * DM; rm_[q] = 1; g_[q] = INP(24) + (2 * j) * DM; r_[q] = r % I_GU; f8_[q] = (j == 1); continue; } r -= 2 * I_GU;
                if (r < 2 * I_GU) { const int j = r / I_GU; W_[q] = INP(26) + (size_t)j * DM * FF; K_[q] = DM; N_[q] = FF; D_[q] = (bf16*)(ws + WS_WGU) + (size_t)j * FF2 * DM; rm_[q] = 2; g_[q] = INP(24) + (2 * j) * DM; r_[q] = r % I_GU; f8_[q] = (j == 1); continue; } r -= 2 * I_GU;
                { const int j = r / I_DN; W_[q] = INP(27) + (size_t)j * FF * DM; K_[q] = FF; N_[q] = DM; D_[q] = (bf16*)(ws + WS_WD) + (size_t)j * DM * FF; rm_[q] = 0; g_[q] = nullptr; r_[q] = r % I_DN; f8_[q] = (j == 1); } }
            tr_item2(W_[0], K_[0], N_[0], D_[0], rm_[0], g_[0], r_[0], W_[1], K_[1], N_[1], D_[1], rm_[1], g_[1], r_[1], scr, lane, f8_[0], f8_[1]);
        }
        const int gt = bx * (NWAVES * 64) + tid, NGT = G * NWAVES * 64;
        for (int i = gt; i < DEPTH * 128 * (DM / 8); i += NGT) { const int l = i / (128 * (DM / 8)), r = i % (128 * (DM / 8));
            if ((INP8 >> l) & 1) { if (r < 128 * (DM / 16)) ((v4u*)((unsigned char*)(ws + WS_WIN) + (size_t)l * INP * DM * 2 + (size_t)INC * DM))[r] = zero_v4u(); }
            else ((v4u*)((bf16*)(ws + WS_WIN) + ((size_t)l * INP + INC) * DM))[r] = zero_v4u(); }
        f32x4 nvp_[4];
#define P0_LOAD(rw) do { const int r_ = (rw); _Pragma("unroll") for (int j = 0; j < 4; ++j) { const int c4 = lane + 64 * j; nvp_[j] = __builtin_bit_cast(f32x4, zero_v4u()); \
                if (r_ < NREAL) nvp_[j] = ((const f32x4*)INP(0))[(size_t)r_ * (DM / 4) + c4]; else if (r_ < NTOK) nvp_[j] = ((const f32x4*)INP(1))[(r_ - NREAL) * (DM / 4) + c4]; } } while (0)
        P0_LOAD(gw);
        for (int row = gw; row < MPAD; row += NGW) {
            f32x4 v[4]; float s = 0.f;
#pragma unroll
            for (int j = 0; j < 4; ++j) v[j] = nvp_[j];
            if (row + NGW < MPAD) P0_LOAD(row + NGW);
#pragma unroll
            for (int j = 0; j < 4; ++j) { const int c4 = lane + 64 * j;
                ((f32x4*)Hf)[(size_t)row * (DM / 4) + c4] = v[j]; s += (v[j].x * v[j].x + v[j].y * v[j].y) + (v[j].z * v[j].z + v[j].w * v[j].w); }
            if (row < NTOK) { s = wave_sum(s); const float rstd = 1.f / sqrtf(s * (1.f / DM) + 1e-6f);
                if (INP8 & 1) { const float sn = rstd * A8_SCALE;
#pragma unroll
                    for (int j = 0; j < 4; ++j) ((unsigned*)((unsigned char*)HB + (size_t)row * DM))[lane + 64 * j] = pk4_fp8(v[j].x * sn, v[j].y * sn, v[j].z * sn, v[j].w * sn); }
                else {
#pragma unroll
                    for (int j = 0; j < 4; ++j) ((unsigned long long*)(HB + (size_t)row * DM))[lane + 64 * j] = (unsigned long long)pk2(v[j].x, v[j].y) | ((unsigned long long)pk2(v[j].z, v[j].w) << 32); }
                if (lane == 0) RSTD[row] = rstd; }
        }
        if (INP8 & 1) { for (int i = gt; i < (MPAD - NTOK) * (DM / 16); i += NGT) ((v4u*)((unsigned char*)HB + (size_t)NTOK * DM))[i] = zero_v4u(); }
        else
        for (int i = gt; i < (MPAD - NTOK) * (DM / 8); i += NGT) ((v4u*)(HB + (size_t)NTOK * DM))[i] = zero_v4u();
        for (int i = gt; i < MPAD - NTOK; i += NGT) RSTD[NTOK + i] = 0.f;
        for (int i = gt; i < (SEQ + NMETA) * 8; i += NGT) { const int pos = i >> 3, j = i & 7;
            const float invf = j == 0 ? 1.000000000e+00f : j == 1 ? 1.939227432e-01f : j == 2 ? 3.760603070e-02f : j == 3 ? 7.292664610e-03f : j == 4 ? 1.414213562e-03f : j == 5 ? 2.742481884e-04f : j == 6 ? 5.318296098e-05f : 1.031338616e-05f;
            const float angf = (float)pos * invf; const double a = (double)angf; const double n = __builtin_rint(a * 0.15915494309189535);
            const double rr = (a - n * 6.283185307179586) - n * 2.4492935982947064e-16; const float rev = (float)(rr * 0.15915494309189535);
            COS[i] = __builtin_amdgcn_cosf(rev); SIN[i] = __builtin_amdgcn_sinf(rev); }
        SEAM(0);
    }

#pragma nounroll
    for (int layer = 0; layer < DEPTH; ++layer) {
        const int pb = 1 + 12 * layer; const bool moe = (layer & 1) != 0; const int jj = layer >> 1;
        if (hi <= pb || lo >= pb + 12) continue;
        const float lam_init = 0.8f - 0.6f * __expf(-0.3f * (float)layer);

        for (int rep_ = 0; rep_ < NREP(0); ++rep_) if (EN(0) && IN(pb + 0) && moe) { PH_TID;
            f32x4 nv_[4];
            { const GAS f32x4* xr = (const GAS f32x4*)(Hf + (size_t)gw * DM) + lane;
#pragma unroll
              for (int j = 0; j < 4; ++j) nv_[j] = xr[64 * j]; }
            for (int row = gw; row < NTOK; row += NGW) {
                f32x4 v[4]; float s = 0.f;
#pragma unroll
                for (int j = 0; j < 4; ++j) v[j] = nv_[j];
                { const int rn_ = row + NGW < NTOK ? row + NGW : row; const GAS f32x4* xr = (const GAS f32x4*)(Hf + (size_t)rn_ * DM) + lane;
#pragma unroll
                  for (int j = 0; j < 4; ++j) nv_[j] = xr[64 * j]; }
#pragma unroll
                for (int j = 0; j < 4; ++j) s += (v[j].x * v[j].x + v[j].y * v[j].y) + (v[j].z * v[j].z + v[j].w * v[j].w);
                s = wave_sum(s); const float rstd = 1.f / sqrtf(s * (1.f / DM) + 1e-6f);
                if ((INP8 >> layer) & 1) { GAS unsigned* o4 = (GAS unsigned*)((GAS unsigned char*)HB + (size_t)row * DM) + lane; const float sn = rstd * A8_SCALE;
#pragma unroll
                    for (int j = 0; j < 4; ++j) o4[64 * j] = pk4_fp8(v[j].x * sn, v[j].y * sn, v[j].z * sn, v[j].w * sn); }
                else { GAS unsigned long long* o8 = (GAS unsigned long long*)(HB + (size_t)row * DM) + lane;
#pragma unroll
                    for (int j = 0; j < 4; ++j) o8[64 * j] = (unsigned long long)pk2(v[j].x, v[j].y) | ((unsigned long long)pk2(v[j].z, v[j].w) << 32); }
                if (lane == 0) RSTD[row] = rstd;
            }
            if ((INP8 >> layer) & 1) { const int gt = bx * (NWAVES * 64) + tid, NGT = G * NWAVES * 64;
                for (int i = gt; i < (MPAD - NTOK) * (DM / 16); i += NGT) ((v4u*)((unsigned char*)HB + (size_t)NTOK * DM))[i] = zero_v4u(); }
            if (moe) {
                LAS float* scr = (LAS float*)(lds + wave * 17408);
                constexpr int I_GU = 16 * 88, I_DN = 44 * 32, PER_E = 2 * I_GU + I_DN;
                const float* gff = INP(24) + layer * DM;
                for (int it0 = 2 * gw; it0 < NE * PER_E; it0 += 2 * NGW) {
                    const float* W_[2]; bf16* D_[2]; int K_[2], N_[2], rm_[2], r_[2]; const float* g_[2];
#pragma unroll
                    for (int q = 0; q < 2; ++q) { const int it = it0 + q; const int e = it / PER_E; int r = it % PER_E; const size_t eo = (size_t)(jj * NE + e) * DM * FF;
                        if (r < I_GU) { W_[q] = INP(29) + eo; K_[q] = DM; N_[q] = FF; D_[q] = (bf16*)(ws + WS_MWGU) + (size_t)e * FF2 * DM / 2; rm_[q] = 1; g_[q] = gff; }
                        else if (r < 2 * I_GU) { r -= I_GU; W_[q] = INP(30) + eo; K_[q] = DM; N_[q] = FF; D_[q] = (bf16*)(ws + WS_MWGU) + (size_t)e * FF2 * DM / 2; rm_[q] = 2; g_[q] = gff; }
                        else { r -= 2 * I_GU; W_[q] = INP(31) + eo; K_[q] = FF; N_[q] = DM; D_[q] = (bf16*)(ws + WS_MWD) + (size_t)e * DM * FF / 2; rm_[q] = 0; g_[q] = nullptr; }
                        r_[q] = r; }
                    tr_item2(W_[0], K_[0], N_[0], D_[0], rm_[0], g_[0], r_[0], W_[1], K_[1], N_[1], D_[1], rm_[1], g_[1], r_[1], scr, lane, true, true);
                }
            }
            SEAM(pb + 0);
        }
        for (int rep_ = 0; rep_ < NREP(1); ++rep_) if (EN(1) && IN(pb + 1)) { PH_TID;
            pg8::StaticOrder S; S.init(MPAD, INP, G, bx);
            if ((INP8 >> layer) & 1) { pg8::Gemm g{HB, (const bf16*)(ws + WS_WIN) + (size_t)layer * INP * DM, MPAD, INP, DM / 2}; pg8::EpiBf16Rs E{PROJ, INP, nullptr, 1.f / (W8_SCALE * A8_SCALE)};
                pg8::gemm_phase<pg8::EpiBf16Rs, pg8::StaticOrder, true, true, true>(lds, g, S, E, tid); }
            else { pg8::Gemm g{HB, (const bf16*)(ws + WS_WIN) + (size_t)layer * INP * DM, MPAD, INP, DM}; pg8::EpiBf16Rs E{PROJ, INP, RSTD, 1.f};
                pg8::gemm_phase<pg8::EpiBf16Rs, pg8::StaticOrder, true, true>(lds, g, S, E, tid); }
            SEAM(pb + 1);
        }
        for (int rep_ = 0; rep_ < NREP(2); ++rep_) if (EN(2) && IN(pb + 2)) { PH_TID;
            const int gt = bx * (NWAVES * 64) + tid, NGT = G * NWAVES * 64;
            if (tid < 65) { const v4u z_ = zero_v4u(); RSQA[bx * 65 + tid] = (unsigned long long)z_.x | ((unsigned long long)z_.y << 32); }
            for (int i = gt; i < NB * 112 * 64; i += NGT) { const int b = i / (112 * 64), r = (i / 64) % 112, c = i % 64; const int row = b * KVROWS + (r < 48 ? r : r + 16);
                ((v4u*)(KP + (size_t)row * 512))[c] = zero_v4u(); ((v4u*)(VP + (size_t)row * 512))[c] = zero_v4u(); }
            const int ngrp = (1025 - bx + 255) / 256, nrows = 16 * ngrp;
#define MP_ROW(idx) (16 * (bx + 256 * ((idx) >> 4)) + ((idx) & 15))
            LAS unsigned char* WT = lds;
            { const int nn = tid & 255, hf = tid >> 8;
              const float* sd = INP(6) + layer * 32 * 256 + (hf * 16) * 256 + nn; const float* sa = INP(8) + layer * 32 * 256 + (hf * 16) * 256 + nn; const float* sg = INP(9) + layer * 64 * 256 + (hf * 32) * 256 + nn;
              v4u wv[2];
#pragma unroll
              for (int i = 0; i < 2; ++i) { wv[i].x = pk2(sd[(8 * i) * 256], sd[(8 * i + 1) * 256]); wv[i].y = pk2(sd[(8 * i + 2) * 256], sd[(8 * i + 3) * 256]); wv[i].z = pk2(sd[(8 * i + 4) * 256], sd[(8 * i + 5) * 256]); wv[i].w = pk2(sd[(8 * i + 6) * 256], sd[(8 * i + 7) * 256]); }
              *(LAS v4u*)(WT + nn * 64 + hf * 32) = wv[0]; *(LAS v4u*)(WT + nn * 64 + hf * 32 + 16) = wv[1];
#pragma unroll
              for (int i = 0; i < 2; ++i) { wv[i].x = pk2(sa[(8 * i) * 256], sa[(8 * i + 1) * 256]); wv[i].y = pk2(sa[(8 * i + 2) * 256], sa[(8 * i + 3) * 256]); wv[i].z = pk2(sa[(8 * i + 4) * 256], sa[(8 * i + 5) * 256]); wv[i].w = pk2(sa[(8 * i + 6) * 256], sa[(8 * i + 7) * 256]); }
              *(LAS v4u*)(WT + 16384 + nn * 64 + hf * 32) = wv[0]; *(LAS v4u*)(WT + 16384 + nn * 64 + hf * 32 + 16) = wv[1];
#pragma unroll
              for (int i = 0; i < 4; ++i) { v4u t; t.x = pk2(sg[(8 * i) * 256], sg[(8 * i + 1) * 256]); t.y = pk2(sg[(8 * i + 2) * 256], sg[(8 * i + 3) * 256]); t.z = pk2(sg[(8 * i + 4) * 256], sg[(8 * i + 5) * 256]); t.w = pk2(sg[(8 * i + 6) * 256], sg[(8 * i + 7) * 256]);
                  *(LAS v4u*)(WT + 32768 + nn * 128 + hf * 64 + 16 * i) = t; } }
            __syncthreads();
            const float* mu = INP(4) + layer * RCOLS; const float* w0 = INP(5) + layer * 256; const float* a0 = INP(7) + layer * 256;
            const float* k_k = INP(10) + layer * 256; const float* k_a = INP(11) + layer * 256; const float* r_k = INP(12) + layer * 256;
            const float* qg = INP(15) + layer * 64; const float* kg = INP(16) + layer * 64; const float* cw = INP(22) + layer * 3 * 256;
            for (int rep3_ = 0; rep3_ < NREP(5); ++rep3_)
            if (wave < ngrp) {
                typedef attn_body::bf16x8 bfx8;
                const int rowbase = 16 * (bx + 256 * wave);
                LAS unsigned char* XT = lds + 65536 + wave * 4096;
                { const float mu0 = mu[768 + 2 * lane], mu1 = mu[768 + 2 * lane + 1]; const int p0 = prevrow(rowbase);
                  unsigned cur = p0 < 0 ? 0u : *(const unsigned*)(PROJ + (size_t)p0 * INP + 768 + 2 * lane); float pl = __uint_as_float(cur << 16), ph = __uint_as_float(cur & 0xffff0000u);
#pragma unroll
                  for (int r = 0; r < 16; ++r) { cur = *(const unsigned*)(PROJ + (size_t)(rowbase + r) * INP + 768 + 2 * lane); const float xl = __uint_as_float(cur << 16), xh = __uint_as_float(cur & 0xffff0000u);
                      float h0 = xl + (pl - xl) * mu0, h1 = xh + (ph - xh) * mu1; pl = xl; ph = xh;
                      if (lane < 16) { h0 = 1.f - 2.f / (1.f + __expf(2.f * h0)); h1 = 1.f - 2.f / (1.f + __expf(2.f * h1)); } else if (lane >= 32) { h0 = sigmoidf_(h0); h1 = sigmoidf_(h1); }
                      *(LAS unsigned*)(XT + r * 256 + 4 * lane) = pk2(h0, h1); } }
                LDS_WAIT();
                const int n = lane & 15, kq = lane >> 4;
                const v4u xd = *(const LAS v4u*)(XT + n * 256 + (8 * kq) * 2), xa = *(const LAS v4u*)(XT + n * 256 + (32 + 8 * kq) * 2);
                const v4u xg0 = *(const LAS v4u*)(XT + n * 256 + (64 + 8 * kq) * 2), xg1 = *(const LAS v4u*)(XT + n * 256 + (96 + 8 * kq) * 2);
                float* lw = LORA_W + (size_t)(rowbase + n) * 256 + 4 * kq; bf16* lag = LORA_AG + (size_t)(rowbase + n) * 512 + 4 * kq;
#pragma unroll 4
                for (int ct = 0; ct < 16; ++ct) {
                    const v4u ad = *(const LAS v4u*)(WT + (16 * ct + n) * 64 + (8 * kq) * 2), aa = *(const LAS v4u*)(WT + 16384 + (16 * ct + n) * 64 + (8 * kq) * 2);
                    const v4u ag0 = *(const LAS v4u*)(WT + 32768 + (16 * ct + n) * 128 + (8 * kq) * 2), ag1 = *(const LAS v4u*)(WT + 32768 + (16 * ct + n) * 128 + (32 + 8 * kq) * 2);
                    f32x4 dd = __builtin_amdgcn_mfma_f32_16x16x32_bf16(__builtin_bit_cast(bfx8, ad), __builtin_bit_cast(bfx8, xd), (f32x4){0.f, 0.f, 0.f, 0.f}, 0, 0, 0);
                    f32x4 da = __builtin_amdgcn_mfma_f32_16x16x32_bf16(__builtin_bit_cast(bfx8, aa), __builtin_bit_cast(bfx8, xa), (f32x4){0.f, 0.f, 0.f, 0.f}, 0, 0, 0);
                    f32x4 dg = __builtin_amdgcn_mfma_f32_16x16x32_bf16(__builtin_bit_cast(bfx8, ag0), __builtin_bit_cast(bfx8, xg0), (f32x4){0.f, 0.f, 0.f, 0.f}, 0, 0, 0);
                    dg = __builtin_amdgcn_mfma_f32_16x16x32_bf16(__builtin_bit_cast(bfx8, ag1), __builtin_bit_cast(bfx8, xg1), dg, 0, 0, 0);
                    *(f32x4*)(lw + 16 * ct) = dd;
                    *(unsigned long long*)(lag + 16 * ct) = (unsigned long long)pk2(da.x, da.y) | ((unsigned long long)pk2(da.z, da.w) << 32);
                    *(unsigned long long*)(lag + 256 + 16 * ct) = (unsigned long long)pk2(dg.x, dg.y) | ((unsigned long long)pk2(dg.z, dg.w) << 32);
                }
            }
            asm volatile("s_waitcnt vmcnt(0)" ::: "memory");
            __syncthreads();
#pragma nounroll
            for (int rep3_ = 0; rep3_ < NREP(10); ++rep3_)
            {
                typedef unsigned u32x2_ __attribute__((ext_vector_type(2)));
                const int sub = lane & 7; const int c4 = 4 * lane;
                const f32x4 qg0 = *(const f32x4*)(qg + 8 * sub), qg1 = *(const f32x4*)(qg + 8 * sub + 4), kg0 = *(const f32x4*)(kg + 8 * sub), kg1 = *(const f32x4*)(kg + 8 * sub + 4);
                const f32x4 cw0 = *(const f32x4*)(cw + c4), cw1 = *(const f32x4*)(cw + 256 + c4), cw2 = *(const f32x4*)(cw + 512 + c4);
                v4u rq, rk, rv; f32x4 rc0, rc1, rn0, rn1; u32x2_ b0, g0_, u0, g1_, u1, g2_, u2;
#define AP_LOAD(rw) do { const int p1_ = prevrow(rw), p2_ = prevrow(p1_); const bf16* q_ = PROJ + (size_t)(rw) * INP; const bf16* q1_ = PROJ + (size_t)(p1_ < 0 ? (rw) : p1_) * INP; const bf16* q2_ = PROJ + (size_t)(p2_ < 0 ? (rw) : p2_) * INP; \
                    rq = *(const v4u*)(q_ + QOFF + 8 * lane); rk = *(const v4u*)(q_ + KOFF + 8 * lane); rv = *(const v4u*)(q_ + VOFF + 8 * lane); (void)q1_; (void)q2_; \
                    { const int ps_ = (rw) >= NREAL ? (rw) - NREAL : NMETA + ((rw) & (SEQ - 1)); rc0 = *(const f32x4*)(COS + ps_ * 8); rc1 = *(const f32x4*)(COS + ps_ * 8 + 4); rn0 = *(const f32x4*)(SIN + ps_ * 8); rn1 = *(const f32x4*)(SIN + ps_ * 8 + 4); } } while (0)
#define CV_LOAD(rw) do { const int p1_ = prevrow(rw), p2_ = prevrow(p1_); const bf16* q_ = PROJ + (size_t)(rw) * INP; const bf16* q1_ = PROJ + (size_t)(p1_ < 0 ? (rw) : p1_) * INP; const bf16* q2_ = PROJ + (size_t)(p2_ < 0 ? (rw) : p2_) * INP; \
                    b0 = *(const u32x2_*)(q_ + COFF + c4); g0_ = *(const u32x2_*)(q_ + COFF + 256 + c4); u0 = *(const u32x2_*)(q_ + COFF + 512 + c4); \
                    g1_ = *(const u32x2_*)(q1_ + COFF + 256 + c4); u1 = *(const u32x2_*)(q1_ + COFF + 512 + c4); g2_ = *(const u32x2_*)(q2_ + COFF + 256 + c4); u2 = *(const u32x2_*)(q2_ + COFF + 512 + c4); } while (0)
#define U2F4(t_) ((f32x4){__uint_as_float((t_).x << 16), __uint_as_float((t_).x & 0xffff0000u), __uint_as_float((t_).y << 16), __uint_as_float((t_).y & 0xffff0000u)})
                int idx = wave; AP_LOAD(MP_ROW(idx));
                for (; idx < nrows; idx += 8) { const int row = MP_ROW(idx);
                    const int p1 = prevrow(row), p2 = prevrow(p1); const float m1 = p1 < 0 ? 0.f : 1.f, m2 = p2 < 0 ? 0.f : 1.f;
                    const v4u cq = rq, ck = rk, cv = rv; const f32x4 c0 = rc0, c1 = rc1, n0 = rn0, n1 = rn1;
                    CV_LOAD(row);
                    if (idx + 8 < nrows) AP_LOAD(MP_ROW(idx + 8));
                    const float cs[8] = {c0.x, c0.y, c0.z, c0.w, c1.x, c1.y, c1.z, c1.w}; const float sn[8] = {n0.x, n0.y, n0.z, n0.w, n1.x, n1.y, n1.z, n1.w};
#pragma unroll
                    for (int which = 0; which < 2; ++which) {
                        const v4u raw = which ? ck : cq;
                        float x[8] = {__uint_as_float(raw.x << 16), __uint_as_float(raw.x & 0xffff0000u), __uint_as_float(raw.y << 16), __uint_as_float(raw.y & 0xffff0000u),
                                      __uint_as_float(raw.z << 16), __uint_as_float(raw.z & 0xffff0000u), __uint_as_float(raw.w << 16), __uint_as_float(raw.w & 0xffff0000u)};
                        float s2 = 0.f;
#pragma unroll
                        for (int i = 0; i < 8; ++i) s2 += x[i] * x[i];
                        s2 = sum8(s2);
                        const float rs = 1.f / sqrtf(s2 * (1.f / 64.f) + 1e-6f);
                        const f32x4 ga = which ? kg0 : qg0, gb = which ? kg1 : qg1;
                        const float gg[8] = {ga.x, ga.y, ga.z, ga.w, gb.x, gb.y, gb.z, gb.w};
                        float o[8];
#pragma unroll
                        for (int i = 0; i < 8; ++i) { const float xn = x[i] * rs * gg[i]; const float xp = lane_xor1(xn);
                            o[i] = sub == 0 ? xn * cs[i] - xp * sn[i] : (sub == 1 ? xn * cs[i] + xp * sn[i] : xn); if (!which) o[i] *= C2Q; }
                        v4u w; w.x = pk2(o[0], o[1]); w.y = pk2(o[2], o[3]); w.z = pk2(o[4], o[5]); w.w = pk2(o[6], o[7]);
                        if (!which) *(v4u*)(QN + (size_t)row * 512 + 8 * lane) = w;
                        else {
                            if (row < NREAL) { const size_t kr = (size_t)((row >> 12) * KVROWS + 128 + (row & (SEQ - 1))) * 512 + 8 * lane; *(v4u*)(KP + kr) = w; *(v4u*)(VP + kr) = cv; }
                            else {
#pragma unroll
                                for (int b = 0; b < NB; ++b) { const size_t kr = (size_t)(b * KVROWS + 48 + (row - NREAL)) * 512 + 8 * lane; *(v4u*)(KP + kr) = w; *(v4u*)(VP + kr) = cv; } } }
                    }
                    { const f32x4 fb0 = U2F4(b0), z0 = U2F4(g0_) * U2F4(u0), z1 = U2F4(g1_) * U2F4(u1) * m1, z2 = U2F4(g2_) * U2F4(u2) * m2;
                      const f32x4 y = cw0 * z2 + cw1 * z1 + cw2 * z0; const f32x4 o = fb0 * y;
                      *(unsigned long long*)(OMIX + (size_t)row * DM + 768 + c4) = (unsigned long long)pk2(o.x, o.y) | ((unsigned long long)pk2(o.z, o.w) << 32); }
                }
#undef AP_LOAD
#undef CV_LOAD
#undef U2F4
            }
            {
                LAS float* XL = (LAS float*)(lds + wave * 17408);
                LAS float* YL = XL + 32 * 65;
                const int nreal_g = ngrp - (bx == 0 ? 1 : 0);
                for (int lt = wave; lt < 4 * nreal_g + (bx == 0 ? 4 : 0); lt += NWAVES) {
                    int bh, ch; if (lt < 4 * nreal_g) { const int g = bx + 256 * (lt >> 2); bh = (g >> 8) * 4 + (lt & 3); ch = (g & 255) + 1; } else { bh = lt - 4 * nreal_g; ch = 0; }
                    const int task = bh * 257 + ch, b = bh >> 2, cb = (bh & 3) * 64; const int rowbase = ch == 0 ? NREAL : b * SEQ + 16 * (ch - 1);
                    float at[16], rt[16], bt[16], kt[16], vsv[16]; float gam = 1.f;
                    { const int c = cb + lane;
                      const float mu_r = mu[c], mu_k = mu[256 + c], mu_v = mu[512 + c], w0c = w0[c], a0c = a0[c], kkc = k_k[c], kac = k_a[c], rkc = r_k[c];
                      const int p0 = prevrow(rowbase); const bf16* q0 = PROJ + (size_t)(p0 < 0 ? rowbase : p0) * INP + c; const float pm = p0 < 0 ? 0.f : 1.f;
                      float pr_ = pm * bf2f(q0[0]), pk_ = pm * bf2f(q0[256]), pv_ = pm * bf2f(q0[512]);
                      unsigned short xr[16], xk[16], xv[16], la[16], lg[16]; float lw[16];
#pragma unroll
                      for (int t = 0; t < 16; ++t) { const bf16* q_ = PROJ + (size_t)(rowbase + t) * INP + c; xr[t] = q_[0]; xk[t] = q_[256]; xv[t] = q_[512];
                          lw[t] = LORA_W[(size_t)(rowbase + t) * 256 + c]; la[t] = LORA_AG[(size_t)(rowbase + t) * 512 + c]; lg[t] = LORA_AG[(size_t)(rowbase + t) * 512 + 256 + c]; }
#pragma unroll
                      for (int t = 0; t < 16; ++t) {
                          const float fr = bf2f(xr[t]), fk = bf2f(xk[t]), fv = bf2f(xv[t]);
                          const float r = fr + (pr_ - fr) * mu_r, k = fk + (pk_ - fk) * mu_k, v = fv + (pv_ - fv) * mu_v; pr_ = fr; pk_ = fk; pv_ = fv;
                          const float wacc = w0c + lw[t], aacc = a0c + bf2f(la[t]), gacc = bf2f(lg[t]);
                          const float nx = -wacc; const float sp = fmaxf(nx, 0.f) + __logf(1.f + __expf(-fabsf(nx)));
                          const float wlog = -sp - 0.5f; const float decay = __expf(-__expf(wlog));
                          const float a = sigmoidf_(aacc);
                          const float kkr = k * kkc; const float ss = wave_sum_dpp(kkr * kkr); const float kk = kkr / fmaxf(sqrtf(ss), 1e-12f);
                          const float k2 = k * (1.f + (a - 1.f) * kac);
                          const float bs = wave_sum_dpp(r * k2 * rkc);
                          const size_t si = (size_t)(rowbase + t) * 256 + c;
                          SG[si] = gacc; SBON[si] = bs * v;
                          at[t] = -kk * gam; gam *= decay; rt[t] = r * gam; const float ig = 1.f / gam; bt[t] = kk * a * ig; kt[t] = k2 * ig; vsv[t] = v; } }
#pragma unroll
                    for (int t = 0; t < 16; ++t) { XL[t * 65 + lane] = bt[t]; XL[(16 + t) * 65 + lane] = kt[t]; YL[t * 65 + lane] = at[t]; YL[(16 + t) * 65 + lane] = rt[t]; }
                    attn_body::f32x16 gm = attn_body::f32x16{};
#pragma unroll 8
                    for (int kk = 0; kk < 32; ++kk) gm = __builtin_amdgcn_mfma_f32_32x32x2f32(XL[(lane & 31) * 65 + 2 * kk + (lane >> 5)], YL[(lane & 31) * 65 + 2 * kk + (lane >> 5)], gm, 0, 0, 0);
                    LDS_WAIT();
                    LAS float* GL = YL; LAS float* TL = YL + 1056; LAS float* XM = YL + 1328;
#pragma unroll
                    for (int r = 0; r < 16; ++r) GL[((r & 3) + 8 * (r >> 2) + 4 * (lane >> 5)) * 33 + (lane & 31)] = gm[r];
                    float tr[16];
#pragma unroll
                    for (int t = 0; t < 16; ++t) tr[t] = ((lane & 15) == t) ? 1.f : 0.f;
#pragma unroll
                    for (int s = 0; s < 15; ++s)
#pragma unroll
                        for (int t = s + 1; t < 16; ++t) tr[t] = fmaf(tr[s], GL[s * 33 + t], tr[t]);
                    if (lane < 16) {
#pragma unroll
                        for (int t = 0; t < 16; ++t) TL[lane * 17 + t] = tr[t]; }
                    { const int s = lane & 15, q = lane >> 4; float x0 = 0.f, x1 = 0.f, x2 = 0.f, x3 = 0.f;
#pragma unroll
                      for (int u = 1; u < 16; ++u) { const float l = (u > s) ? GL[(16 + s) * 33 + u] : 0.f; x0 = fmaf(l, TL[u * 17 + 4 * q], x0); x1 = fmaf(l, TL[u * 17 + 4 * q + 1], x1); x2 = fmaf(l, TL[u * 17 + 4 * q + 2], x2); x3 = fmaf(l, TL[u * 17 + 4 * q + 3], x3); }
                      XM[s * 17 + 4 * q] = x0; XM[s * 17 + 4 * q + 1] = x1; XM[s * 17 + 4 * q + 2] = x2; XM[s * 17 + 4 * q + 3] = x3; }
                    float atT[16];
#pragma unroll
                    for (int sp = 0; sp < 16; ++sp) { float acc = 0.f;
#pragma unroll
                        for (int s = 0; s <= sp; ++s) acc = fmaf(at[s], TL[s * 17 + sp], acc);
                        atT[sp] = acc; }
                    unsigned char* rec = CH_REC + (size_t)task * CH_RB;
                    ((float*)rec)[lane] = gam;
                    LAS unsigned short* ST = (LAS unsigned short*)XL;
                    const int kpos = (lane & ~15) + 8 * ((lane >> 2) & 1) + (lane & 3) + 4 * ((lane >> 3) & 1);
                    float zz[16];
#pragma unroll
                    for (int s = 0; s < 16; ++s) { float acc = kt[s] * gam;
#pragma unroll
                        for (int sp = s + 1; sp < 16; ++sp) acc = fmaf(XM[s * 17 + sp], bt[sp] * gam, acc);
                        zz[s] = acc; }
#pragma unroll
                    for (int t = 0; t < 16; ++t) { float acc = rt[t];
#pragma unroll
                        for (int s = 0; s <= t; ++s) acc = fmaf(atT[s], GL[s * 33 + 16 + t], acc);
                        ST[t * 64 + kpos] = (unsigned short)f2bf(atT[t]); ST[(16 + t) * 64 + kpos] = (unsigned short)f2bf(acc); }
                    { v4u w0, w1;
                      w0.x = pk2(bt[0] * gam, bt[1] * gam); w0.y = pk2(bt[2] * gam, bt[3] * gam); w0.z = pk2(bt[8] * gam, bt[9] * gam); w0.w = pk2(bt[10] * gam, bt[11] * gam);
                      w1.x = pk2(bt[4] * gam, bt[5] * gam); w1.y = pk2(bt[6] * gam, bt[7] * gam); w1.z = pk2(bt[12] * gam, bt[13] * gam); w1.w = pk2(bt[14] * gam, bt[15] * gam);
                      v4u* d = (v4u*)(rec + 4352 + lane * 32); d[0] = w0; d[1] = w1;
                      v4u z0, z1; z0.x = pk2(zz[0], zz[1]); z0.y = pk2(zz[2], zz[3]); z0.z = pk2(zz[4], zz[5]); z0.w = pk2(zz[6], zz[7]);
                      z1.x = pk2(zz[8], zz[9]); z1.y = pk2(zz[10], zz[11]); z1.z = pk2(zz[12], zz[13]); z1.w = pk2(zz[14], zz[15]);
                      v4u* dz = (v4u*)(rec + 6400 + lane * 32); dz[0] = z0; dz[1] = z1; }
                    { float vs[16];
#pragma unroll
                      for (int s = 0; s < 16; ++s) vs[s] = vsv[s];
                      v4u a0, a1; a0.x = pk2(vs[0], vs[1]); a0.y = pk2(vs[2], vs[3]); a0.z = pk2(vs[4], vs[5]); a0.w = pk2(vs[6], vs[7]);
                      a1.x = pk2(vs[8], vs[9]); a1.y = pk2(vs[10], vs[11]); a1.z = pk2(vs[12], vs[13]); a1.w = pk2(vs[14], vs[15]);
                      v4u* dv = (v4u*)(rec + 8448 + lane * 32); dv[0] = a0; dv[1] = a1; }
                    { const int s = lane & 15, q = lane >> 4;
#pragma unroll
                      for (int e = 0; e < 4; ++e) { const int t = 4 * q + e; float acc = (t >= s) ? GL[(16 + s) * 33 + 16 + t] : 0.f;
#pragma unroll
                          for (int sp = 1; sp < 16; ++sp) { const float m = (sp <= t) ? GL[sp * 33 + 16 + t] : 0.f; acc = fmaf(XM[s * 17 + sp], m, acc); }
                          ((unsigned short*)(rec + 10496))[t * 16 + s] = (unsigned short)f2bf(acc); } }
                    LDS_WAIT();
                    { const LAS v4u* sv = (const LAS v4u*)ST + lane; v4u* d = (v4u*)(rec + 256) + lane;
#pragma unroll
                      for (int i = 0; i < 4; ++i) d[64 * i] = sv[64 * i]; }
                    LDS_WAIT();
                    if (ch == 0) {
                        asm volatile("s_waitcnt vmcnt(0)" ::: "memory");
                        const v4u* src = (const v4u*)rec;
#pragma unroll 1
                        for (int i = lane; i < CH_RB / 16; i += 64) { const v4u w = src[i];
#pragma unroll
                            for (int cp = 1; cp < 4; ++cp) ((v4u*)(CH_REC + (size_t)((bh + 4 * cp) * 257) * CH_RB))[i] = w; }
                    }
                }
            }
            SEAM(pb + 2);
        }
        for (int rep_ = 0; rep_ < NREP(3); ++rep_) if (EN(3) && IN(pb + 3)) { PH_TID;
#define PK8(T, o) ((v4u){attn_body::cvtpk_s(T[o], T[o + 1]), attn_body::cvtpk_s(T[o + 2], T[o + 3]), attn_body::cvtpk_s(T[o + 4], T[o + 5]), attn_body::cvtpk_s(T[o + 6], T[o + 7])})
            for (int rep2_ = 0; rep2_ < NREP(13); ++rep2_)
            if (bx < 32) {
                typedef attn_body::bf16x8 bfx8; typedef attn_body::f32x16 fx16;
                const int bh = bx >> 1, vh = bx & 1, n = lane & 31, hh = lane >> 5;
                const unsigned char* rec0 = CH_REC + (size_t)(bh * 257) * CH_RB;
                const unsigned lds0 = (unsigned)(uintptr_t)lds_raw;
                constexpr int RBUF = 6 * CH_RB;
#define S2_ISSUE(rnd) do { if (wave >= 1 && wave <= 6) { const int c_ = 6 * (rnd) + wave - 1; if (c_ < 257) { const unsigned dst_ = lds0 + ((rnd) & 1) * RBUF + (wave - 1) * CH_RB; \
                    for (int p_ = 0; p_ < 11; ++p_) attn_body::glds16s(rec0 + (size_t)c_ * CH_RB + p_ * 1024, (unsigned)lane * 16u, (unsigned)__builtin_amdgcn_readfirstlane(dst_ + p_ * 1024)); } } } while (0)
                S2_ISSUE(0);
                asm volatile("s_waitcnt vmcnt(0)\n\ts_barrier" ::: "memory");
                v4u* spk = (v4u*)(CH_SPK + (size_t)(bh * 257) * 8192 + vh * 4096) + lane;
                fx16 st0 = fx16{}, st1 = fx16{};
                for (int rnd = 0; rnd < 43; ++rnd) {
                    S2_ISSUE(rnd + 1);
                    if (wave == 0) {
                        v4u atf[4], bhf[2], ztf[2], vtf; f32x4 gq[8];
#define S2_FRAGS(j_) do { const LAS unsigned char* r_ = lds + (rnd & 1) * RBUF + (j_) * CH_RB; \
                            _Pragma("unroll") for (int ks = 0; ks < 4; ++ks) atf[ks] = *(const LAS v4u*)(r_ + 256 + ((lane & 15) * 64 + 16 * ks + 8 * hh) * 2); \
                            _Pragma("unroll") for (int i = 0; i < 2; ++i) { bhf[i] = *(const LAS v4u*)(r_ + 4352 + ((32 * i + n) * 16 + 8 * hh) * 2); ztf[i] = *(const LAS v4u*)(r_ + 6400 + ((32 * i + n) * 16 + 8 * hh) * 2); } \
                            vtf = *(const LAS v4u*)(r_ + 8448 + ((32 * vh + n) * 16 + 8 * hh) * 2); \
                            _Pragma("unroll") for (int i = 0; i < 2; ++i) _Pragma("unroll") for (int q = 0; q < 4; ++q) gq[4 * i + q] = *(const LAS f32x4*)(r_ + (32 * i + 8 * q + 4 * hh) * 4); } while (0)
                        S2_FRAGS(0);
                        for (int j = 0; j < 6; ++j) { const int ch = 6 * rnd + j; if (ch >= 257) break;
                            const v4u a0 = atf[0], a1 = atf[1], a2 = atf[2], a3 = atf[3], b0 = bhf[0], b1 = bhf[1], z0 = ztf[0], z1 = ztf[1], vt = vtf;
                            f32x4 g_[8];
#pragma unroll
                            for (int i = 0; i < 8; ++i) g_[i] = gq[i];
                            if (j < 5) S2_FRAGS(j + 1);
                            const v4u s0 = PK8(st0, 0), s1 = PK8(st0, 8), s2 = PK8(st1, 0), s3 = PK8(st1, 8);
                            spk[(size_t)ch * 512 + 0] = s0; spk[(size_t)ch * 512 + 64] = s1; spk[(size_t)ch * 512 + 128] = s2; spk[(size_t)ch * 512 + 192] = s3;
                            fx16 pt = fx16{};
                            pt = __builtin_amdgcn_mfma_f32_32x32x16_bf16(__builtin_bit_cast(bfx8, a0), __builtin_bit_cast(bfx8, s0), pt, 0, 0, 0);
                            pt = __builtin_amdgcn_mfma_f32_32x32x16_bf16(__builtin_bit_cast(bfx8, a1), __builtin_bit_cast(bfx8, s1), pt, 0, 0, 0);
                            pt = __builtin_amdgcn_mfma_f32_32x32x16_bf16(__builtin_bit_cast(bfx8, a2), __builtin_bit_cast(bfx8, s2), pt, 0, 0, 0);
                            pt = __builtin_amdgcn_mfma_f32_32x32x16_bf16(__builtin_bit_cast(bfx8, a3), __builtin_bit_cast(bfx8, s3), pt, 0, 0, 0);
#pragma unroll
                            for (int q = 0; q < 4; ++q) { st0[4 * q] *= g_[q].x; st0[4 * q + 1] *= g_[q].y; st0[4 * q + 2] *= g_[q].z; st0[4 * q + 3] *= g_[q].w;
                                                          st1[4 * q] *= g_[4 + q].x; st1[4 * q + 1] *= g_[4 + q].y; st1[4 * q + 2] *= g_[4 + q].z; st1[4 * q + 3] *= g_[4 + q].w; }
                            st0 = __builtin_amdgcn_mfma_f32_32x32x16_bf16(__builtin_bit_cast(bfx8, z0), __builtin_bit_cast(bfx8, vt), st0, 0, 0, 0);
                            st1 = __builtin_amdgcn_mfma_f32_32x32x16_bf16(__builtin_bit_cast(bfx8, z1), __builtin_bit_cast(bfx8, vt), st1, 0, 0, 0);
                            const v4u pp = PK8(pt, 0);
                            st0 = __builtin_amdgcn_mfma_f32_32x32x16_bf16(__builtin_bit_cast(bfx8, b0), __builtin_bit_cast(bfx8, pp), st0, 0, 0, 0);
                            st1 = __builtin_amdgcn_mfma_f32_32x32x16_bf16(__builtin_bit_cast(bfx8, b1), __builtin_bit_cast(bfx8, pp), st1, 0, 0, 0);
                        }
#undef S2_FRAGS
                        asm volatile("s_waitcnt lgkmcnt(0)\n\ts_barrier" ::: "memory");
                    } else asm volatile("s_waitcnt vmcnt(0) lgkmcnt(0)\n\ts_barrier" ::: "memory");
                }
#undef S2_ISSUE
            }
            __syncthreads();
            for (int rep2_ = 0; rep2_ < NREP(12); ++rep2_)
            { const attn_body::AttnTensors AT{(const attn_body::bf16*)QN, (const attn_body::bf16*)KP, (const attn_body::bf16*)VP, (attn_body::bf16*)OC};
              const attn_body::QueueOrder SO{(unsigned*)(ctl + CW_ATTQ + (layer * 8 + (bx & 7)) * 64), (LAS unsigned*)(lds + MISC_OFF + 64), bx & 7, tid};
              attn_body::attn_phase<attn_body::QueueOrder>((char*)lds_raw, AT, SO, tid); }
            __syncthreads();
#ifndef NO_META
            {
                LAS float* sc = (LAS float*)(lds + wave * 1024); LAS float* qs = sc + 64;
                for (int task = gw; task < NMETA * 8; task += NGW) {
                    const int row = NREAL + (task >> 3), hc = task & 7, h = hc >> 1; const int n = row - NREAL + 1;
                    qs[lane] = bf2f(QN[(size_t)row * 512 + hc * 64 + lane]);
                    float m = -INFINITY;
                    { const int idx = lane;
                        if (idx < n) { const size_t kr = 48 + idx; const v4u* kp = (const v4u*)(KP + kr * 512 + hc * 64); float dot = 0.f;
#pragma unroll
                            for (int c8 = 0; c8 < 8; ++c8) { const v4u kv = kp[c8];
                                dot += qs[c8 * 8 + 0] * __uint_as_float(kv.x << 16) + qs[c8 * 8 + 1] * __uint_as_float(kv.x & 0xffff0000u) + qs[c8 * 8 + 2] * __uint_as_float(kv.y << 16) + qs[c8 * 8 + 3] * __uint_as_float(kv.y & 0xffff0000u)
                                     + qs[c8 * 8 + 4] * __uint_as_float(kv.z << 16) + qs[c8 * 8 + 5] * __uint_as_float(kv.z & 0xffff0000u) + qs[c8 * 8 + 6] * __uint_as_float(kv.w << 16) + qs[c8 * 8 + 7] * __uint_as_float(kv.w & 0xffff0000u); }
                            sc[idx] = dot; m = dot; } }
                    m = wave_max(m);
                    float l = 0.f;
                    if (lane < n) { const float p = __builtin_amdgcn_exp2f(sc[lane] - m); sc[lane] = p; l = p; }
                    l = wave_sum(l);
                    float o0 = 0.f, o1 = 0.f;
                    for (int idx = 0; idx < n; ++idx) { const float p = sc[idx]; const size_t vr = 48 + idx;
                        const unsigned v2 = *(const unsigned*)(VP + vr * 512 + h * 128 + 2 * lane); o0 += p * __uint_as_float(v2 << 16); o1 += p * __uint_as_float(v2 & 0xffff0000u); }
                    const float inv = 1.f / l;
                    *(unsigned*)(OC + (size_t)row * 1024 + hc * 128 + 2 * lane) = pk2(o0 * inv, o1 * inv);
                    LDS_WAIT();
                }
            }
#endif
            SEAM(pb + 3);
        }
        for (int rep_ = 0; rep_ < NREP(4); ++rep_) if (EN(4) && IN(pb + 4)) { PH_TID;
            const float* gn_g = INP(13) + layer * 256; const float* gn_b = INP(14) + layer * 256; const float* subg = INP(21) + layer * 128;
            const float s1 = wave_sum(INP(17)[layer * 64 + lane] * INP(18)[layer * 64 + lane]); const float s2 = wave_sum(INP(19)[layer * 64 + lane] * INP(20)[layer * 64 + lane]);
            const float lam = __expf(s1) - __expf(s2) + lam_init;
            const int ngrp = (1025 - bx + 255) / 256, nrows = 16 * ngrp;
            {
                typedef attn_body::bf16x8 bfx8; typedef attn_body::f32x16 fx16;
                const int n = lane & 31, hh = lane >> 5;
                v4u na_[4], ns_[4], nx_, nv_;
#define S3_LOAD(lt_) do { const int g_ = bx + 256 * ((lt_) >> 3), hd_ = ((lt_) >> 1) & 3, vh_ = (lt_) & 1; const int bh_ = g_ < 1024 ? (g_ >> 8) * 4 + hd_ : hd_, ch_ = g_ < 1024 ? (g_ & 255) + 1 : 0; const int ct_ = bh_ * 257 + ch_; \
                    const unsigned char* q_ = CH_REC + (size_t)ct_ * CH_RB; const v4u* sp_ = (const v4u*)(CH_SPK + (size_t)ct_ * 8192 + vh_ * 4096) + lane; \
                    _Pragma("unroll") for (int ks = 0; ks < 4; ++ks) { na_[ks] = *(const v4u*)(q_ + 2304 + ((lane & 15) * 64 + 16 * ks + 8 * hh) * 2); ns_[ks] = sp_[64 * ks]; } \
                    nx_ = *(const v4u*)(q_ + 10496 + ((lane & 15) * 16 + 8 * hh) * 2); nv_ = *(const v4u*)(q_ + 8448 + ((32 * vh_ + n) * 16 + 8 * hh) * 2); } while (0)
                S3_LOAD(wave);
                for (int lt = wave; lt < 8 * ngrp; lt += NWAVES) {
                    const int g = bx + 256 * (lt >> 3), hd = (lt >> 1) & 3, vh = lt & 1; const int bh = g < 1024 ? (g >> 8) * 4 + hd : hd, ch = g < 1024 ? (g & 255) + 1 : 0;
                    const int b = bh >> 2, cb = (bh & 3) * 64; const int rowbase = ch == 0 ? NREAL : b * SEQ + 16 * (ch - 1);
                    v4u ca_[4], cs_[4]; const v4u cx_ = nx_, cv_ = nv_;
#pragma unroll
                    for (int ks = 0; ks < 4; ++ks) { ca_[ks] = na_[ks]; cs_[ks] = ns_[ks]; }
                    if (lt + NWAVES < 8 * ngrp) S3_LOAD(lt + NWAVES);
                    fx16 y = fx16{};
#pragma unroll
                    for (int ks = 0; ks < 4; ++ks) y = __builtin_amdgcn_mfma_f32_32x32x16_bf16(__builtin_bit_cast(bfx8, ca_[ks]), __builtin_bit_cast(bfx8, cs_[ks]), y, 0, 0, 0);
                    y = __builtin_amdgcn_mfma_f32_32x32x16_bf16(__builtin_bit_cast(bfx8, cx_), __builtin_bit_cast(bfx8, cv_), y, 0, 0, 0);
                    {
#pragma unroll
                        for (int r = 0; r < 8; ++r) SY[(size_t)(rowbase + (r & 3) + 8 * (r >> 2) + 4 * hh) * 256 + cb + 32 * vh + n] = y[r]; }
                }
#undef S3_LOAD
            }
#undef PK8
            asm volatile("s_waitcnt vmcnt(0)" ::: "memory");
            __syncthreads();
            {
                const int h = lane >> 4, j8 = (lane & 15) * 8;
                f32x4 ny, nbon, ngt; v4u na0, na1;
#define POST_LOAD(rw) do { const int r_ = (rw); ny = *(const f32x4*)(SY + (size_t)r_ * 256 + 4 * lane); nbon = *(const f32x4*)(SBON + (size_t)r_ * 256 + 4 * lane); ngt = *(const f32x4*)(SG + (size_t)r_ * 256 + 4 * lane); \
                    na0 = *(const v4u*)(OC + (size_t)r_ * 1024 + (h * 2 + 0) * 128 + j8); na1 = *(const v4u*)(OC + (size_t)r_ * 1024 + (h * 2 + 1) * 128 + j8); } while (0)
                const f32x4 gg = *(const f32x4*)(gn_g + 4 * lane), gb = *(const f32x4*)(gn_b + 4 * lane), g0 = *(const f32x4*)(subg + j8), g1 = *(const f32x4*)(subg + j8 + 4);
                int idx = wave; POST_LOAD(MP_ROW(idx));
                for (; idx < nrows; idx += NWAVES) { const int row = MP_ROW(idx);
                    const f32x4 y = ny, bon = nbon, gt = ngt; const v4u a0 = na0, a1 = na1;
                    if (idx + NWAVES < nrows) POST_LOAD(MP_ROW(idx + NWAVES));
                    { const float mean = sum16((y.x + y.y) + (y.z + y.w)) * (1.f / 64.f);
                      const f32x4 dlt = y - mean; const float var = sum16((dlt.x * dlt.x + dlt.y * dlt.y) + (dlt.z * dlt.z + dlt.w * dlt.w)) * (1.f / 64.f); const float rs = 1.f / sqrtf(var + 64e-5f);
                      const f32x4 o = (dlt * rs * gg + gb + bon) * gt;
                      *(unsigned long long*)(OMIX + (size_t)row * DM + 4 * lane) = (unsigned long long)pk2(o.x, o.y) | ((unsigned long long)pk2(o.z, o.w) << 32); }
                    { float dv[8];
                      dv[0] = __uint_as_float(a0.x << 16) - lam * __uint_as_float(a1.x << 16); dv[1] = __uint_as_float(a0.x & 0xffff0000u) - lam * __uint_as_float(a1.x & 0xffff0000u);
                      dv[2] = __uint_as_float(a0.y << 16) - lam * __uint_as_float(a1.y << 16); dv[3] = __uint_as_float(a0.y & 0xffff0000u) - lam * __uint_as_float(a1.y & 0xffff0000u);
                      dv[4] = __uint_as_float(a0.z << 16) - lam * __uint_as_float(a1.z << 16); dv[5] = __uint_as_float(a0.z & 0xffff0000u) - lam * __uint_as_float(a1.z & 0xffff0000u);
                      dv[6] = __uint_as_float(a0.w << 16) - lam * __uint_as_float(a1.w << 16); dv[7] = __uint_as_float(a0.w & 0xffff0000u) - lam * __uint_as_float(a1.w & 0xffff0000u);
                      float ss = 0.f;
#pragma unroll
                      for (int i = 0; i < 8; ++i) ss += dv[i] * dv[i];
                      ss = sum16(ss); const float sc_ = (1.f / sqrtf(ss * (1.f / 128.f) + 1e-5f)) * (1.f - lam_init);
                      v4u o; o.x = pk2(dv[0] * sc_ * g0.x, dv[1] * sc_ * g0.y); o.y = pk2(dv[2] * sc_ * g0.z, dv[3] * sc_ * g0.w); o.z = pk2(dv[4] * sc_ * g1.x, dv[5] * sc_ * g1.y); o.w = pk2(dv[6] * sc_ * g1.z, dv[7] * sc_ * g1.w);
                      *(v4u*)(OMIX + (size_t)row * DM + 256 + h * 128 + j8) = o; }
                }
#undef POST_LOAD
            }
            { const int gt = bx * (NWAVES * 64) + tid, NGT = G * NWAVES * 64;
              for (int i = gt; i < (MPAD - NTOK) * (DM / 8); i += NGT) ((v4u*)(OMIX + (size_t)NTOK * DM))[i] = zero_v4u(); }
            SEAM(pb + 4);
        }
        if (EN(5) && IN(pb + 5)) { PH_TID;
            pg8::Gemm g{OMIX, (const bf16*)(ws + WS_WOUT) + (size_t)layer * DM * DM, NREAL, DM, DM}; pg8::StaticOrder S; S.init(NREAL, DM, G, bx);
            if (!moe) {
                if (layer == 2) {
                    meta_gemm_res(OMIX + (size_t)NREAL * DM, DM, (const bf16*)(ws + WS_WOUT) + (size_t)layer * DM * DM, Hf + (size_t)NREAL * DM, lds, bx, wave, lane, 2, (bf16*)((unsigned char*)HB + (size_t)NREAL * DM), RSQA + NREAL);
                    typedef pg8::EpiResAddHB<2, (long long)WS_HB - (long long)WS_H, (long long)WS_RSROW - (long long)WS_H> EpiHB2; EpiHB2 E{Hf, DM, 1.f};
                    pg8::gemm_phase<EpiHB2, pg8::StaticOrder, true, true>(lds, g, S, E, tid);
                } else {
                    meta_gemm_res(OMIX + (size_t)NREAL * DM, DM, (const bf16*)(ws + WS_WOUT) + (size_t)layer * DM * DM, Hf + (size_t)NREAL * DM, lds, bx, wave, lane, 1, HB + (size_t)NREAL * DM, RSQA + NREAL);
                    typedef pg8::EpiResAddHB<1, (long long)WS_HB - (long long)WS_H, (long long)WS_RSROW - (long long)WS_H> EpiHB1; EpiHB1 E{Hf, DM, 1.f};
                    pg8::gemm_phase<EpiHB1, pg8::StaticOrder, true, true>(lds, g, S, E, tid);
                }
            } else {
                meta_gemm_res(OMIX + (size_t)NREAL * DM, DM, (const bf16*)(ws + WS_WOUT) + (size_t)layer * DM * DM, Hf + (size_t)NREAL * DM, lds, bx, wave, lane);
                pg8::EpiResAdd E{Hf, DM, 1.f};
                pg8::gemm_phase<pg8::EpiResAdd, pg8::StaticOrder, true, true>(lds, g, S, E, tid);
            }
            SEAM(pb + 5);
        }
        if (EN(6) && IN(pb + 6) && moe) { PH_TID;
            LAS int* lcnt = (LAS int*)lds; LAS int* lbase = lcnt + 8; LAS int* lrow = lcnt + 16;
            if (tid < 16) lcnt[tid] = 0;
            __syncthreads();
            const float* gff = INP(24) + layer * DM; const float* Wr = INP(28) + (size_t)jj * DM * NE;
            f32x4 nv6_[4];
            { const GAS f32x4* xr = (const GAS f32x4*)(Hf + (size_t)(bx + G * wave) * DM) + lane;
#pragma unroll
              for (int j = 0; j < 4; ++j) nv6_[j] = xr[64 * j]; }
            for (int i = wave; i < 72; i += NWAVES) { const int row = bx + G * i;
                if (row < NTOK) {
                    f32x4 v[4]; float s = 0.f;
#pragma unroll
                    for (int j = 0; j < 4; ++j) v[j] = nv6_[j];
                    { const int rn_ = row + G * NWAVES < NTOK ? row + G * NWAVES : row; const GAS f32x4* xr = (const GAS f32x4*)(Hf + (size_t)rn_ * DM) + lane;
#pragma unroll
                      for (int j = 0; j < 4; ++j) nv6_[j] = xr[64 * j]; }
#pragma unroll
                    for (int j = 0; j < 4; ++j) s += (v[j].x * v[j].x + v[j].y * v[j].y) + (v[j].z * v[j].z + v[j].w * v[j].w);
                    s = wave_sum(s); const float rstd = 1.f / sqrtf(s * (1.f / DM) + 1e-6f);
                    if (moe) { LAS unsigned* o4 = (LAS unsigned*)(lds + 4096 + i * 1024) + lane; const float sn = rstd * A8_SCALE;
#pragma unroll
                      for (int j = 0; j < 4; ++j) o4[64 * j] = pk4_fp8(v[j].x * sn, v[j].y * sn, v[j].z * sn, v[j].w * sn); }
                    else if (layer == 2) { GAS unsigned* o4 = (GAS unsigned*)((GAS unsigned char*)HB + (size_t)row * DM) + lane; const float sn = rstd * A8_SCALE;
#pragma unroll
                      for (int j = 0; j < 4; ++j) o4[64 * j] = pk4_fp8(v[j].x * sn, v[j].y * sn, v[j].z * sn, v[j].w * sn); }
                    else { GAS unsigned long long* o8 = (GAS unsigned long long*)(HB + (size_t)row * DM) + lane;
#pragma unroll
                      for (int j = 0; j < 4; ++j) o8[64 * j] = (unsigned long long)pk2(v[j].x, v[j].y) | ((unsigned long long)pk2(v[j].z, v[j].w) << 32); }
                    if (lane == 0) RSTD[row] = rstd;
                    if (moe) {
                        float lg[8];
#pragma unroll
                        for (int e = 0; e < 8; ++e) lg[e] = 0.f;
#pragma unroll
                        for (int j = 0; j < 4; ++j) { const int k0 = 4 * lane + 256 * j; const f32x4 gv = *(const f32x4*)(gff + k0);
#pragma unroll
                            for (int q = 0; q < 4; ++q) { const float hv = v[j][q] * gv[q]; const f32x4 wa = *(const f32x4*)(Wr + (size_t)(k0 + q) * 8), wb = *(const f32x4*)(Wr + (size_t)(k0 + q) * 8 + 4);
                                lg[0] += hv * wa.x; lg[1] += hv * wa.y; lg[2] += hv * wa.z; lg[3] += hv * wa.w; lg[4] += hv * wb.x; lg[5] += hv * wb.y; lg[6] += hv * wb.z; lg[7] += hv * wb.w; } }
#pragma unroll
                        for (int e = 0; e < 8; ++e) lg[e] = wave_sum(lg[e]) * rstd;
                        int e1 = 0; float l1 = lg[0];
#pragma unroll
                        for (int e = 1; e < 8; ++e) if (lg[e] > l1) { l1 = lg[e]; e1 = e; }
                        int e2 = -1; float l2 = -INFINITY;
#pragma unroll
                        for (int e = 0; e < 8; ++e) if (e != e1 && lg[e] > l2) { l2 = lg[e]; e2 = e; }
                        if (lane == 0) { const float g2 = 1.f / (1.f + __expf(l1 - l2)); const float g1 = 1.f - g2;
                            const int sl1 = atomicAdd((int*)&lcnt[e1], 1), sl2 = atomicAdd((int*)&lcnt[e2], 1);
                            lrow[i * 4 + 0] = e1; lrow[i * 4 + 1] = sl1; lrow[i * 4 + 2] = e2; lrow[i * 4 + 3] = sl2;
                            TOKG[row * 2 + 0] = g1; TOKG[row * 2 + 1] = g2; }
                    }
                }
            }
            if (moe) {
                __syncthreads();
                if (tid < 8) lbase[tid] = (int)__hip_atomic_fetch_add((unsigned*)(ctl + CW_MOECNT + 64 * jj + tid), (unsigned)lcnt[tid], RLX_AGENT);
                __syncthreads();
                if (tid < 72) { const int row = bx + G * tid; if (row < NTOK) { const int e1 = lrow[tid * 4 + 0], e2 = lrow[tid * 4 + 2];
                    TOKE[row * 2 + 0] = e1; TOKE[row * 2 + 1] = e2; TOKS[row * 2 + 0] = lbase[e1] + lrow[tid * 4 + 1]; TOKS[row * 2 + 1] = lbase[e2] + lrow[tid * 4 + 3]; } }
                __syncthreads();
            }
            SEAM(pb + 6);
        }
        if (!moe) {
            for (int rep_ = 0; rep_ < NREP(7); ++rep_) if (EN(7) && IN(pb + 7)) { PH_TID;
                pg8::StaticOrder S; S.init(MPAD, FF2, G, bx);
                if (layer == 2) { pg8::Gemm g{HB, (const bf16*)(ws + WS_WGU) + (size_t)jj * FF2 * DM, MPAD, FF2, DM / 2}; pg8::EpiSwiglu8 E{GB, FF, nullptr, 1.f / (W8_SCALE * H8_SCALE), G8_SCALE, RSQA};
                    pg8::gemm_phase<pg8::EpiSwiglu8, pg8::StaticOrder, true, true, true>(lds, g, S, E, tid); }
                else { pg8::Gemm g{HB, (const bf16*)(ws + WS_WGU) + (size_t)jj * FF2 * DM, MPAD, FF2, DM}; pg8::EpiSwiglu E{GB, FF, nullptr, 1.f, 0.f, RSQA};
                    pg8::gemm_phase<pg8::EpiSwiglu, pg8::StaticOrder, true, true>(lds, g, S, E, tid); }
                SEAM(pb + 7);
            }
            if (EN(8) && IN(pb + 8)) { PH_TID;
                pg8::StaticOrder S; S.init(NREAL, DM, G, bx);
                if (layer == 2) {
                    meta_gemm_res8((const unsigned char*)GB + (size_t)NREAL * FF, FF, (const unsigned char*)((const bf16*)(ws + WS_WD) + (size_t)jj * DM * FF), Hf + (size_t)NREAL * DM, 1.f / (W8_SCALE * G8_SCALE), lds, bx, wave, lane);
                    pg8::Gemm g{GB, (const bf16*)(ws + WS_WD) + (size_t)jj * DM * FF, NREAL, DM, FF / 2}; pg8::EpiResAdd E{Hf, DM, 1.f / (W8_SCALE * G8_SCALE)};
                    pg8::gemm_phase<pg8::EpiResAdd, pg8::StaticOrder, true, true, true>(lds, g, S, E, tid);
                } else {
                    meta_gemm_res(GB + (size_t)NREAL * FF, FF, (const bf16*)(ws + WS_WD) + (size_t)jj * DM * FF, Hf + (size_t)NREAL * DM, lds, bx, wave, lane);
                    pg8::Gemm g{GB, (const bf16*)(ws + WS_WD) + (size_t)jj * DM * FF, NREAL, DM, FF}; pg8::EpiResAdd E{Hf, DM, 1.f};
                    pg8::gemm_phase<pg8::EpiResAdd, pg8::StaticOrder, true, true>(lds, g, S, E, tid);
                }
                SEAM(pb + 8);
            }
        } else {
#define cnt ((const int*)(ctl + CW_MOECNT + 64 * jj))
            for (int rep_ = 0; rep_ < NREP(7); ++rep_) if (EN(7) && IN(pb + 7)) { PH_TID;
                int ts[8]; { int a = 0;
#pragma unroll
                    for (int e = 0; e < 8; ++e) { ts[e] = a; a += (__hip_atomic_load(cnt + e, RLX_AGENT) + 255) >> 8; } }
                { LAS const int* lbase = (LAS const int*)lds + 8; LAS const int* lrow = (LAS const int*)lds + 16;
                  for (int i = wave; i < 72; i += NWAVES) { const int row = bx + G * i;
                      if (row < NTOK) { const v4u d = *(const LAS v4u*)(lds + 4096 + i * 1024 + lane * 16);
#pragma unroll
                          for (int c = 0; c < 2; ++c) { const int e = lrow[i * 4 + 2 * c]; int tse = 0, lb = 0;
#pragma unroll
                              for (int x = 0; x < 8; ++x) { tse = (e == x) ? ts[x] : tse; lb = (e == x) ? lbase[x] : lb; }
                              const size_t p = (size_t)tse * 256 + lb + lrow[i * 4 + 2 * c + 1];
                              ((v4u*)((unsigned char*)AROWS + p * DM))[lane] = d; } } } }
                SEAM(pb + 7);
            }
            for (int rep_ = 0; rep_ < NREP(8); ++rep_) if (EN(8) && IN(pb + 8)) { PH_TID;
                pg8::Gemm g{AROWS, (const bf16*)(ws + WS_MWGU), MOEP, FF2, DM / 2}; pg8::MoeOrder S; S.init(cnt, FF2 / 256, G, bx);
                pg8::EpiSwiglu8 E{GB, FF, nullptr, 1.f / (W8_SCALE * A8_SCALE), G8_SCALE};
                pg8::gemm_phase<pg8::EpiSwiglu8, pg8::MoeOrder, true, true, true>(lds, g, S, E, tid);
                SEAM(pb + 8);
            }
            for (int rep_ = 0; rep_ < NREP(9); ++rep_) if (EN(9) && IN(pb + 9)) { PH_TID;
                pg8::Gemm g{GB, (const bf16*)(ws + WS_MWD), MOEP, DM, FF / 2}; pg8::MoeOrder S; S.init(cnt, DM / 256, G, bx);
                pg8::EpiBf16Rs E{YM, DM, nullptr, 1.f / (W8_SCALE * G8_SCALE)};
                pg8::gemm_phase<pg8::EpiBf16Rs, pg8::MoeOrder, true, true, true>(lds, g, S, E, tid);
                SEAM(pb + 9);
            }
            if (EN(10) && IN(pb + 10)) { PH_TID;
                int ts[8]; { int a = 0;
#pragma unroll
                    for (int e = 0; e < 8; ++e) { ts[e] = a; a += (__hip_atomic_load(cnt + e, RLX_AGENT) + 255) >> 8; } }
                int ie1, ie2, is1, is2; float ig1, ig2;
                v4u ny1[2], ny2[2]; f32x4 nha[2], nhb[2]; float ng1, ng2;
#define CB_IDX(rw) do { const int r_ = (rw) < NTOK ? (rw) : NTOK - 1; ie1 = TOKE[r_ * 2]; ie2 = TOKE[r_ * 2 + 1]; is1 = TOKS[r_ * 2]; is2 = TOKS[r_ * 2 + 1]; ig1 = TOKG[r_ * 2]; ig2 = TOKG[r_ * 2 + 1]; } while (0)
#define CB_DATA(rw) do { const int r_ = (rw) < NTOK ? (rw) : NTOK - 1; int t1 = 0, t2 = 0; \
                    _Pragma("unroll") for (int q = 0; q < 8; ++q) { t1 = (ie1 == q) ? ts[q] : t1; t2 = (ie2 == q) ? ts[q] : t2; } \
                    const size_t p1 = (size_t)t1 * 256 + is1, p2 = (size_t)t2 * 256 + is2; ng1 = ig1; ng2 = ig2; const float* hr_ = Hf + (size_t)r_ * DM; \
                    _Pragma("unroll") for (int j = 0; j < 2; ++j) { const int c8 = (lane + 64 * j) * 8; ny1[j] = *(const v4u*)(YM + p1 * DM + c8); ny2[j] = *(const v4u*)(YM + p2 * DM + c8); nha[j] = *(const f32x4*)(hr_ + c8); nhb[j] = *(const f32x4*)(hr_ + c8 + 4); } } while (0)
                CB_IDX(gw); CB_DATA(gw); CB_IDX(gw + NGW);
                for (int row = gw; row < NTOK; row += NGW) {
                    const float g1 = ng1, g2 = ng2; v4u cy1[2], cy2[2]; f32x4 cha[2], chb[2];
#pragma unroll
                    for (int j = 0; j < 2; ++j) { cy1[j] = ny1[j]; cy2[j] = ny2[j]; cha[j] = nha[j]; chb[j] = nhb[j]; }
                    CB_DATA(row + NGW); CB_IDX(row + 2 * NGW);
                    float* hr = Hf + (size_t)row * DM; f32x4 hv[2][2]; float ssq = 0.f;
#pragma unroll
                    for (int j = 0; j < 2; ++j) { const v4u y1 = cy1[j], y2 = cy2[j];
                        f32x4 ha = cha[j], hb2 = chb[j];
                        ha.x += g1 * __uint_as_float(y1.x << 16) + g2 * __uint_as_float(y2.x << 16); ha.y += g1 * __uint_as_float(y1.x & 0xffff0000u) + g2 * __uint_as_float(y2.x & 0xffff0000u);
                        ha.z += g1 * __uint_as_float(y1.y << 16) + g2 * __uint_as_float(y2.y << 16); ha.w += g1 * __uint_as_float(y1.y & 0xffff0000u) + g2 * __uint_as_float(y2.y & 0xffff0000u);
                        hb2.x += g1 * __uint_as_float(y1.z << 16) + g2 * __uint_as_float(y2.z << 16); hb2.y += g1 * __uint_as_float(y1.z & 0xffff0000u) + g2 * __uint_as_float(y2.z & 0xffff0000u);
                        hb2.z += g1 * __uint_as_float(y1.w << 16) + g2 * __uint_as_float(y2.w << 16); hb2.w += g1 * __uint_as_float(y1.w & 0xffff0000u) + g2 * __uint_as_float(y2.w & 0xffff0000u);
                        hv[j][0] = ha; hv[j][1] = hb2; ssq += (ha.x * ha.x + ha.y * ha.y) + (ha.z * ha.z + ha.w * ha.w) + (hb2.x * hb2.x + hb2.y * hb2.y) + (hb2.z * hb2.z + hb2.w * hb2.w); }
                    if (layer == DEPTH - 1) {
                        if (row < NREAL) { float* orow = (*(float* const*)(ka + 256)) + (size_t)row * DM;
#pragma unroll
                            for (int j = 0; j < 2; ++j) { const int c8 = (lane + 64 * j) * 8; *(f32x4*)(orow + c8) = hv[j][0]; *(f32x4*)(orow + c8 + 4) = hv[j][1]; } }
                    } else {
                        ssq = wave_sum(ssq); const float rstd = 1.f / sqrtf(ssq * (1.f / DM) + 1e-6f), sn = rstd * A8_SCALE;
#pragma unroll
                        for (int j = 0; j < 2; ++j) { const int c8 = (lane + 64 * j) * 8; *(f32x4*)(hr + c8) = hv[j][0]; *(f32x4*)(hr + c8 + 4) = hv[j][1];
                            if ((INP8 >> (layer + 1)) & 1) { const unsigned lo = pk4_fp8(hv[j][0].x * sn, hv[j][0].y * sn, hv[j][0].z * sn, hv[j][0].w * sn), hi8 = pk4_fp8(hv[j][1].x * sn, hv[j][1].y * sn, hv[j][1].z * sn, hv[j][1].w * sn);
                                *(unsigned long long*)((unsigned char*)HB + (size_t)row * DM + c8) = (unsigned long long)lo | ((unsigned long long)hi8 << 32); }
                            else { v4u w; w.x = pk2(hv[j][0].x, hv[j][0].y); w.y = pk2(hv[j][0].z, hv[j][0].w); w.z = pk2(hv[j][1].x, hv[j][1].y); w.w = pk2(hv[j][1].z, hv[j][1].w);
                                *(v4u*)(HB + (size_t)row * DM + c8) = w; } }
                        if (lane == 0) RSTD[row] = rstd;
                    }
                }
#undef CB_IDX
#undef CB_DATA
                SEAM(pb + 10);
            }
        }
    }
#ifdef UBENCH
    if (hi >= 48 && bx == 255) { PH_TID;
        float x = (float)lane * 1e-3f, y = 1.0001f; float acc = 0.f;
        for (int it = 0; it < UBENCH_ITERS; ++it) {
#if UBENCH == 1
#pragma unroll
            for (int k = 0; k < 64; ++k) { asm volatile("v_fma_f32 %0, %0, %1, %0" : "+v"(x) : "v"(y)); }
#elif UBENCH == 2
#pragma unroll
            for (int k = 0; k < 64; ++k) { asm volatile("s_nop 1\n\tv_add_f32_dpp %0, %0, %0 row_mirror row_mask:0xf bank_mask:0xf bound_ctrl:1" : "+v"(x)); }
#elif UBENCH == 3
#pragma unroll
            for (int k = 0; k < 32; ++k) { asm volatile("s_nop 0\n\tv_readlane_b32 s20, %0, 63\n\tv_fmac_f32 %0, s20, %1" : "+v"(x) : "v"(y) : "s20"); }
#elif UBENCH == 5
            { float y2 = x + 1.f;
#pragma unroll
            for (int k = 0; k < 64; ++k) { asm volatile("s_nop 1\n\tv_add_f32_dpp %0, %0, %0 row_mirror row_mask:0xf bank_mask:0xf bound_ctrl:1\n\tv_add_f32_dpp %1, %1, %1 row_mirror row_mask:0xf bank_mask:0xf bound_ctrl:1" : "+v"(x), "+v"(y2)); }
            x += y2; }
#elif UBENCH == 6
            if (wave < 4) {
#pragma unroll
            for (int k = 0; k < 64; ++k) { asm volatile("s_nop 1\n\tv_add_f32_dpp %0, %0, %0 row_mirror row_mask:0xf bank_mask:0xf bound_ctrl:1" : "+v"(x)); } }
#elif UBENCH == 7
            if (wave < 4) {
#pragma unroll
            for (int k = 0; k < 64; ++k) { asm volatile("v_fma_f32 %0, %0, %1, %0" : "+v"(x) : "v"(y)); } }
#elif UBENCH == 8
            { float y2 = x + 1.f, y3 = x + 2.f, y4 = x + 3.f;
#pragma unroll
            for (int k = 0; k < 64; ++k) { asm volatile("s_nop 1\n\tv_add_f32_dpp %0, %0, %0 row_mirror row_mask:0xf bank_mask:0xf bound_ctrl:1\n\tv_add_f32_dpp %1, %1, %1 row_mirror row_mask:0xf bank_mask:0xf bound_ctrl:1\n\tv_add_f32_dpp %2, %2, %2 row_mirror row_mask:0xf bank_mask:0xf bound_ctrl:1\n\tv_add_f32_dpp %3, %3, %3 row_mirror row_mask:0xf bank_mask:0xf bound_ctrl:1" : "+v"(x), "+v"(y2), "+v"(y3), "+v"(y4)); }
            x += y2 + y3 + y4; }
#elif UBENCH == 4
#pragma unroll
            for (int k = 0; k < 64; ++k) { asm volatile("s_nop 1\n\tv_add_f32_dpp %0, %0, %0 row_bcast:15 row_mask:0xa bank_mask:0xf" : "+v"(x)); }
#endif
        }
        acc += x;
        if (acc == 123.456f) ((float*)(ws + WS_CTL))[2000 + tid] = acc;
    }
#endif
#undef IN
#undef SEAM
}

#ifndef MK_ONE_LAUNCH
#define MK_ONE_LAUNCH 1
#endif
extern "C" void kernel_launch(void* const* d_in, const int* in_sizes, int n_in, void* d_out, int out_size, void* d_ws, size_t ws_size, hipStream_t stream) {
    static int grid = 0;
    if (grid == 0) {
        if (n_in != 32 || out_size != NREAL * DM || ws_size < WS_END) { fprintf(stderr, "kernel_launch: unexpected shapes (n_in %d out %d ws %zu need %zu); nothing launched\n", n_in, out_size, ws_size, (size_t)WS_END); grid = -1; return; }
        int dev = 0, cus = 0, per_cu = 0;
        if (hipGetDevice(&dev) != hipSuccess || hipDeviceGetAttribute(&cus, hipDeviceAttributeMultiprocessorCount, dev) != hipSuccess) { grid = -1; return; }
        if (hipFuncSetAttribute((const void*)hymba_fwd, hipFuncAttributeMaxDynamicSharedMemorySize, LDS_BYTES) != hipSuccess) { fprintf(stderr, "kernel_launch: hipFuncSetAttribute failed\n"); grid = -1; return; }
        if (hipOccupancyMaxActiveBlocksPerMultiprocessor(&per_cu, (const void*)hymba_fwd, NWAVES * 64, LDS_BYTES) != hipSuccess || per_cu < 1) fprintf(stderr, "kernel_launch: occupancy query says %d\n", per_cu);
        (void)hipGetLastError();
        grid = cus;
        if (grid != 256) { fprintf(stderr, "kernel_launch: built for 256 CUs, device has %d; nothing launched\n", cus); grid = -1; return; }
    }
    if (grid < 0) return;
    if (hipMemsetAsync((char*)d_ws + WS_CTL, 0, CTL_ZERO_BYTES, stream) != hipSuccess) return;
    Args a{};
    for (int i = 0; i < 32; ++i) a.in[i] = (const float*)d_in[i];
    a.out = (float*)d_out; a.ws = (unsigned char*)d_ws;
#if MK_ONE_LAUNCH
    a.ph_lo = 0; a.ph_hi = 48;
    hipLaunchKernelGGL(hymba_fwd, dim3(grid), dim3(NWAVES * 64), LDS_BYTES, stream, a);
#else
    for (int ph = 0; ph < 50; ++ph) {
        if (ph >= 1 && ph <= 48) { const int l = (ph - 1) / 12, k = (ph - 1) % 12; const bool moe = l & 1; if (k == 11 || (!moe && k >= 9)) continue; }
        a.ph_lo = ph; a.ph_hi = ph + 1;
        hipLaunchKernelGGL(hymba_fwd, dim3(grid), dim3(NWAVES * 64), LDS_BYTES, stream, a);
    }
#endif
}
```
